# Optimizing an MI355X kernel written in HIP

```python
import jax, jax.numpy as jnp
from jax import lax
import numpy as np

D_MODEL = 1024
BATCH = 8
SEQ = 4096
DEPTH = 4

CHUNK = 64
MEM_LEN = 256
Q_BLOCK = 128
N_MIXERS = 2
DA_HEADS = 6
DA_HEAD_DIM = 64
DA_WIDTH = DA_HEADS * 2 * DA_HEAD_DIM
HG_HEADS = 6
HG_KEY_DIM = 128
HG_VAL_DIM = 128
HG_KEY_WIDTH = HG_HEADS * HG_KEY_DIM
HG_VAL_WIDTH = HG_HEADS * HG_VAL_DIM
MEM_HEADS = 4
MEM_HEAD_DIM = 64
MEM_WIDTH = MEM_HEADS * MEM_HEAD_DIM
MIX_WIDTH = DA_WIDTH + MEM_WIDTH
D_FF_DENSE = 2816
N_EXPERTS = 8
TOP_K = 2
D_FF_EXPERT = 3584
EPS = 1e-6
MASK_VALUE = -1e30
N_A = (DEPTH + 1) // 2
N_B = DEPTH // 2

kernel_name = "hybrid_diffattn_hgrn2_moe_trunk"

F32 = jnp.float32


def rms_norm(x, g):
    xf = x.astype(F32)
    y = xf * lax.rsqrt(jnp.mean(xf * xf, axis=-1, keepdims=True) + EPS)
    return (y * g.astype(F32)).astype(x.dtype)


def alibi_slopes(n):
    return jnp.asarray(2.0 ** (-8.0 * np.arange(1, n + 1) / n), F32)


def memory_attention(q_mem, mem, mem_norm_g, w_mem_kv):
    B, S, _ = q_mem.shape
    kv = rms_norm(mem, mem_norm_g) @ w_mem_kv
    k, v = jnp.split(kv, 2, axis=-1)
    q = q_mem.reshape(B, S, MEM_HEADS, MEM_HEAD_DIM)
    k = k.reshape(B, -1, MEM_HEADS, MEM_HEAD_DIM)
    v = v.reshape(B, -1, MEM_HEADS, MEM_HEAD_DIM)
    s = jnp.einsum('bshd,bmhd->bhsm', q, k).astype(F32) * (MEM_HEAD_DIM ** -0.5)
    p = jax.nn.softmax(s, axis=-1).astype(v.dtype)
    o = jnp.einsum('bhsm,bmhd->bshd', p, v)
    return o.reshape(B, S, MEM_WIDTH)


def diff_attention(q, k, v, lam, lam_init, subln_g):
    B, S = q.shape[:2]
    nb = S // Q_BLOCK
    scale = DA_HEAD_DIM ** -0.5
    slopes = alibi_slopes(DA_HEADS)
    kpos = jnp.arange(S)
    kchunk = kpos // CHUNK
    qb = q.reshape(B, nb, Q_BLOCK, DA_HEADS, 2, DA_HEAD_DIM).transpose(1, 0, 2, 3, 4, 5)
    starts = jnp.arange(nb) * Q_BLOCK

    def block(args):
        q_blk, start = args
        qpos = start + jnp.arange(Q_BLOCK)
        dist = jnp.abs(qpos[:, None] - kpos[None, :]).astype(F32)
        allowed = kchunk[None, :] <= (qpos // CHUNK)[:, None]
        bias = jnp.where(allowed[None], -slopes[:, None, None] * dist[None], MASK_VALUE)
        s = jnp.einsum('bqhmd,bkhmd->bhmqk', q_blk, k).astype(F32) * scale + bias[None, :, None]
        p = jax.nn.softmax(s, axis=-1)
        a = (p[:, :, 0] - lam * p[:, :, 1]).astype(v.dtype)
        return jnp.einsum('bhqk,bkhe->bqhe', a, v)

    o = lax.map(block, (qb, starts))
    o = o.transpose(1, 0, 2, 3, 4).reshape(B, S, DA_HEADS, 2 * DA_HEAD_DIM)
    o = rms_norm(o, subln_g) * (1.0 - lam_init)
    return o.reshape(B, S, DA_WIDTH)


def diff_attention_mixer(h, mem, w_in, lq1, lk1, lq2, lk2, subln_g, mem_norm_g, w_mem_kv, w_out, lam_init):
    B, S, _ = h.shape
    proj = h @ w_in
    q, k, v, qm = jnp.split(proj, [DA_WIDTH, 2 * DA_WIDTH, 3 * DA_WIDTH], axis=-1)
    q = q.reshape(B, S, DA_HEADS, 2, DA_HEAD_DIM)
    k = k.reshape(B, S, DA_HEADS, 2, DA_HEAD_DIM)
    v = v.reshape(B, S, DA_HEADS, 2 * DA_HEAD_DIM)
    lam = (jnp.exp(jnp.sum(lq1.astype(F32) * lk1.astype(F32)))
           - jnp.exp(jnp.sum(lq2.astype(F32) * lk2.astype(F32))) + lam_init)
    o = diff_attention(q, k, v, lam, lam_init, subln_g).astype(h.dtype)
    om = memory_attention(qm, mem, mem_norm_g, w_mem_kv).astype(h.dtype)
    return jnp.concatenate([o, om], axis=-1) @ w_out


def hgrn2_chunkwise(q, k, v, log_f):
    B, S, H, dk = q.shape
    dv = v.shape[-1]
    nc = S // CHUNK

    def to_chunks(t):
        return t.astype(F32).reshape(B, nc, CHUNK, H, t.shape[-1]).transpose(1, 0, 3, 2, 4)

    xs = (to_chunks(q), to_chunks(k), to_chunks(v), to_chunks(log_f))
    causal = jnp.tril(jnp.ones((CHUNK, CHUNK), bool))[None, None, :, :, None]

    def step(state, inp):
        q_, k_, v_, g_ = inp
        b = jnp.cumsum(g_, axis=2)
        b_last = b[:, :, -1:, :]
        diff = jnp.where(causal, b[:, :, :, None, :] - b[:, :, None, :, :], 0.0)
        decay = jnp.where(causal, jnp.exp(diff), 0.0)
        attn = jnp.einsum('bhtsk,bhsk->bhts', q_[:, :, :, None, :] * decay, k_)
        o = (jnp.einsum('bhts,bhsv->bhtv', attn, v_)
             + jnp.einsum('bhtk,bhkv->bhtv', q_ * jnp.exp(b), state))
        state = (jnp.exp(b_last)[:, :, 0, :, None] * state
                 + jnp.einsum('bhsk,bhsv->bhkv', k_ * jnp.exp(b_last - b), v_))
        return state, o

    state0 = jnp.zeros((B, H, dk, dv), F32)
    _, o = lax.scan(step, state0, xs)
    return o.transpose(1, 0, 3, 2, 4).reshape(B, S, H, dv)


def hgrn2_mixer(h, mem, w_in, lb, out_norm_g, mem_norm_g, w_mem_kv, w_out):
    B, S, _ = h.shape
    proj = h @ w_in
    q, fz, i, g, qm = jnp.split(
        proj, [HG_KEY_WIDTH, 2 * HG_KEY_WIDTH, 2 * HG_KEY_WIDTH + HG_VAL_WIDTH,
               2 * HG_KEY_WIDTH + 2 * HG_VAL_WIDTH], axis=-1)
    fz32 = fz.astype(F32)
    f = lb + (1.0 - lb) * jax.nn.sigmoid(fz32)
    log_f = jnp.log(f)
    k = (1.0 - lb) * jax.nn.sigmoid(-fz32)
    heads = lambda t: t.reshape(B, S, HG_HEADS, -1)
    o = hgrn2_chunkwise(heads(q), heads(k), heads(i), heads(log_f))
    o = rms_norm(o, out_norm_g) * jax.nn.silu(heads(g).astype(F32))
    o = o.reshape(B, S, HG_VAL_WIDTH).astype(h.dtype)
    om = memory_attention(qm, mem, mem_norm_g, w_mem_kv).astype(h.dtype)
    return jnp.concatenate([o, om], axis=-1) @ w_out


def dense_swiglu(h, w_gate_up, w_down):
    gt, up = jnp.split(h @ w_gate_up, 2, axis=-1)
    return (jax.nn.silu(gt) * up) @ w_down


def moe_swiglu(h, w_router, w_gate_up, w_down):
    B, S, D = h.shape
    t = h.reshape(-1, D)
    logits = (t @ w_router).astype(F32)
    top_val, top_idx = lax.top_k(logits, TOP_K)
    top_w = jax.nn.softmax(top_val, axis=-1)
    combine = jnp.sum(jax.nn.one_hot(top_idx, N_EXPERTS, dtype=F32) * top_w[..., None], axis=1)
    out = jnp.zeros_like(t)
    for e in range(N_EXPERTS):
        gt, up = jnp.split(t @ w_gate_up[e], 2, axis=-1)
        y = (jax.nn.silu(gt) * up) @ w_down[e]
        out = out + combine[:, e:e + 1].astype(t.dtype) * y
    return out.reshape(B, S, D)


def setup_inputs(seed: int = 0) -> dict:
    key = jax.random.key(seed)
    ks = iter(jax.random.split(key, 40))
    D = D_MODEL
    res = (2.0 * DEPTH) ** -0.5

    def nrm(shape, scale):
        return jax.random.normal(next(ks), shape, F32) * scale

    def gain(shape):
        return 1.0 + 0.02 * jax.random.normal(next(ks), shape, F32)

    return {
        "x": nrm((BATCH, SEQ, D), 1.0),
        "mem": nrm((BATCH, MEM_LEN, D), 1.0),
        "a_norm_mix": gain((N_A, D)),
        "a_w_in": nrm((N_A, D, 3 * DA_WIDTH + MEM_WIDTH), D ** -0.5),
        "a_lam_q1": nrm((N_A, DA_HEAD_DIM), 0.1),
        "a_lam_k1": nrm((N_A, DA_HEAD_DIM), 0.1),
        "a_lam_q2": nrm((N_A, DA_HEAD_DIM), 0.1),
        "a_lam_k2": nrm((N_A, DA_HEAD_DIM), 0.1),
        "a_subln": gain((N_A, 2 * DA_HEAD_DIM)),
        "a_mem_norm": gain((N_A, D)),
        "a_w_mem_kv": nrm((N_A, D, 2 * MEM_WIDTH), D ** -0.5),
        "a_w_out": nrm((N_A, MIX_WIDTH, D), MIX_WIDTH ** -0.5 * res),
        "b_norm_mix": gain((N_B, D)),
        "b_w_in": nrm((N_B, D, 2 * HG_KEY_WIDTH + 2 * HG_VAL_WIDTH + MEM_WIDTH), D ** -0.5),
        "b_lb_logits": nrm((N_B, HG_KEY_WIDTH), 0.5),
        "b_out_norm": gain((N_B, HG_VAL_DIM)),
        "b_mem_norm": gain((N_B, D)),
        "b_w_mem_kv": nrm((N_B, D, 2 * MEM_WIDTH), D ** -0.5),
        "b_w_out": nrm((N_B, HG_VAL_WIDTH + MEM_WIDTH, D), (HG_VAL_WIDTH + MEM_WIDTH) ** -0.5 * res),
        "dense_norm": gain((N_A, D)),
        "dense_w_gate_up": nrm((N_A, D, 2 * D_FF_DENSE), D ** -0.5),
        "dense_w_down": nrm((N_A, D_FF_DENSE, D), D_FF_DENSE ** -0.5 * res),
        "moe_norm": gain((N_B, D)),
        "moe_router": nrm((N_B, D, N_EXPERTS), D ** -0.5),
        "moe_w_gate_up": nrm((N_B, N_EXPERTS, D, 2 * D_FF_EXPERT), D ** -0.5),
        "moe_w_down": nrm((N_B, N_EXPERTS, D_FF_EXPERT, D), D_FF_EXPERT ** -0.5 * res),
        "final_norm": gain((D,)),
    }


def reference(x, mem,
              a_norm_mix, a_w_in, a_lam_q1, a_lam_k1, a_lam_q2, a_lam_k2, a_subln, a_mem_norm, a_w_mem_kv, a_w_out,
              b_norm_mix, b_w_in, b_lb_logits, b_out_norm, b_mem_norm, b_w_mem_kv, b_w_out,
              dense_norm, dense_w_gate_up, dense_w_down,
              moe_norm, moe_router, moe_w_gate_up, moe_w_down,
              final_norm):
    lb_p = jax.nn.softmax(b_lb_logits.astype(F32), axis=0)
    lb_all = jnp.cumsum(lb_p, axis=0) - lb_p[0:1]
    for i in range(DEPTH):
        if i % N_MIXERS == 0:
            j = i // N_MIXERS
            lam_init = 0.8 - 0.6 * float(np.exp(-0.3 * i))
            h = rms_norm(x, a_norm_mix[j])
            x = x + diff_attention_mixer(h, mem, a_w_in[j], a_lam_q1[j], a_lam_k1[j], a_lam_q2[j], a_lam_k2[j],
                                         a_subln[j], a_mem_norm[j], a_w_mem_kv[j], a_w_out[j], lam_init)
        else:
            j = i // N_MIXERS
            h = rms_norm(x, b_norm_mix[j])
            x = x + hgrn2_mixer(h, mem, b_w_in[j], lb_all[j], b_out_norm[j], b_mem_norm[j],
                                b_w_mem_kv[j], b_w_out[j])
        if i % 2 == 0:
            j = i // 2
            x = x + dense_swiglu(rms_norm(x, dense_norm[j]), dense_w_gate_up[j], dense_w_down[j])
        else:
            j = i // 2
            x = x + moe_swiglu(rms_norm(x, moe_norm[j]), moe_router[j], moe_w_gate_up[j], moe_w_down[j])
    return rms_norm(x, final_norm)
```

```cpp
#include <hip/hip_runtime.h>
#include <cstdio>
#include <cstdint>

namespace nv {
constexpr int T = 32768, D = 1024, NB = 8, S = 4096, MEML = 256;
constexpr int DAW = 768, MEMW = 256, AIN = 2560, BIN = 3328;
constexpr int FFD = 2816, FFE = 3584, NE = 8;
constexpr float EPS = 1e-6f;
constexpr size_t MiB = 1u << 20;

__device__ __forceinline__ float wave_sum(float v) {
#pragma unroll
    for (int o = 1; o < 64; o <<= 1) v += __shfl_xor(v, o);
    return v;
}
__device__ __forceinline__ float sigmoidf_(float z) { return 1.f / (1.f + __expf(-z)); }
__device__ __forceinline__ float siluf_(float z) { return z / (1.f + __expf(-z)); }

__global__ void __launch_bounds__(256) k_rmsnorm(const float* __restrict__ in, const float* __restrict__ g, float* __restrict__ out, int rows) {
    const int lane = threadIdx.x & 63, w = (blockIdx.x * 256 + threadIdx.x) >> 6, nw = (gridDim.x * 256) >> 6;
    for (int r = w; r < rows; r += nw) {
        const float4* xr = (const float4*)(in + (size_t)r * D) + lane;
        float4 v[4]; float s = 0.f;
#pragma unroll
        for (int j = 0; j < 4; ++j) { v[j] = xr[64 * j]; s += v[j].x * v[j].x + v[j].y * v[j].y + v[j].z * v[j].z + v[j].w * v[j].w; }
        const float rstd = rsqrtf(wave_sum(s) * (1.f / D) + EPS);
        float4* o = (float4*)(out + (size_t)r * D) + lane;
#pragma unroll
        for (int j = 0; j < 4; ++j) { const float4 gg = ((const float4*)g)[lane + 64 * j];
            o[64 * j] = make_float4(v[j].x * rstd * gg.x, v[j].y * rstd * gg.y, v[j].z * rstd * gg.z, v[j].w * rstd * gg.w); }
    }
}

template <int ADD>
__global__ void __launch_bounds__(256) k_gemm(const float* __restrict__ A, int lda, const float* __restrict__ Bm, int ldb, float* C, int ldc, const float* R, int M, int N, int K, const int* dyn, int offA, int offC) {
    __shared__ float As[8][132];
    __shared__ float Bs[8][128];
    int roffA = 0, roffC = 0;
    if (dyn) { roffA = offA ? dyn[0] : 0; roffC = offC ? dyn[0] : 0; M = dyn[1] < 16384 ? dyn[1] : 16384; }
    const int m0 = blockIdx.y * 128, n0 = blockIdx.x * 128;
    if (m0 >= M) return;
    const int tid = threadIdx.x, ty = tid >> 4, tx = tid & 15;
    float acc[8][8];
#pragma unroll
    for (int i = 0; i < 8; ++i)
#pragma unroll
        for (int j = 0; j < 8; ++j) acc[i][j] = 0.f;
    const int ar = tid >> 1, ak = (tid & 1) * 4;
    int arow = m0 + ar; if (arow >= M) arow = M - 1;
    const float* ap = A + (size_t)(roffA + arow) * lda + ak;
    const int bk = tid >> 5, bn = (tid & 31) * 4;
    const float* bp = Bm + (size_t)bk * ldb + n0 + bn;
    for (int k0 = 0; k0 < K; k0 += 8) {
        const float4 av = *(const float4*)(ap + k0);
        const float4 bv = *(const float4*)(bp + (size_t)k0 * ldb);
        __syncthreads();
        As[ak + 0][ar] = av.x; As[ak + 1][ar] = av.y; As[ak + 2][ar] = av.z; As[ak + 3][ar] = av.w;
        *(float4*)&Bs[bk][bn] = bv;
        __syncthreads();
#pragma unroll
        for (int k = 0; k < 8; ++k) {
            float a[8], b[8];
            *(float4*)&a[0] = *(const float4*)&As[k][ty * 4]; *(float4*)&a[4] = *(const float4*)&As[k][64 + ty * 4];
            *(float4*)&b[0] = *(const float4*)&Bs[k][tx * 4]; *(float4*)&b[4] = *(const float4*)&Bs[k][64 + tx * 4];
#pragma unroll
            for (int i = 0; i < 8; ++i)
#pragma unroll
                for (int j = 0; j < 8; ++j) acc[i][j] += a[i] * b[j];
        }
    }
#pragma unroll
    for (int i = 0; i < 8; ++i) {
        const int r = m0 + (i < 4 ? ty * 4 + i : 64 + ty * 4 + (i - 4));
        if (r >= M) continue;
#pragma unroll
        for (int jh = 0; jh < 2; ++jh) {
            const int c = n0 + jh * 64 + tx * 4;
            float4 v = make_float4(acc[i][jh * 4 + 0], acc[i][jh * 4 + 1], acc[i][jh * 4 + 2], acc[i][jh * 4 + 3]);
            if (ADD) { const float4 rr = *(const float4*)(R + (size_t)(roffC + r) * ldc + c); v.x += rr.x; v.y += rr.y; v.z += rr.z; v.w += rr.w; }
            *(float4*)(C + (size_t)(roffC + r) * ldc + c) = v;
        }
    }
}

__global__ void __launch_bounds__(64) k_diff_attn(const float* __restrict__ proj  , float* __restrict__ O  ) {
    const int c = blockIdx.x, bhm = blockIdx.y, m = bhm & 1, h = (bhm >> 1) % 6, b = bhm / 12;
    const int qpos = c * 64 + threadIdx.x;
    const float slope = exp2f(-8.f * (float)(h + 1) / 6.f);
    float q[64];
    const float* qp = proj + (size_t)(b * S + qpos) * AIN + h * 128 + m * 64;
#pragma unroll
    for (int d = 0; d < 64; d += 4) { const float4 v = *(const float4*)(qp + d); q[d] = v.x * 0.125f; q[d + 1] = v.y * 0.125f; q[d + 2] = v.z * 0.125f; q[d + 3] = v.w * 0.125f; }
    const int nk = (c + 1) * 64;
    const float* kbase = proj + (size_t)b * S * AIN + DAW + h * 128 + m * 64;
    const float* vbase = proj + (size_t)b * S * AIN + 2 * DAW + h * 128;
    float mx = -3.0e38f;
    for (int k = 0; k < nk; ++k) {
        const float* kr = kbase + (size_t)k * AIN;
        float s = 0.f;
#pragma unroll
        for (int d = 0; d < 64; ++d) s += q[d] * kr[d];
        s -= slope * fabsf((float)(qpos - k));
        mx = fmaxf(mx, s);
    }
    float o[128];
#pragma unroll
    for (int e = 0; e < 128; ++e) o[e] = 0.f;
    float l = 0.f;
    for (int k = 0; k < nk; ++k) {
        const float* kr = kbase + (size_t)k * AIN;
        float s = 0.f;
#pragma unroll
        for (int d = 0; d < 64; ++d) s += q[d] * kr[d];
        s -= slope * fabsf((float)(qpos - k));
        const float p = __expf(s - mx);
        l += p;
        const float* vr = vbase + (size_t)k * AIN;
#pragma unroll
        for (int e = 0; e < 128; ++e) o[e] += p * vr[e];
    }
    const float il = 1.f / l;
    float* op = O + (size_t)m * T * DAW + (size_t)(b * S + qpos) * DAW + h * 128;
#pragma unroll
    for (int e = 0; e < 128; e += 4) *(float4*)(op + e) = make_float4(o[e] * il, o[e + 1] * il, o[e + 2] * il, o[e + 3] * il);
}
__global__ void __launch_bounds__(256) k_diff_combine(const float* __restrict__ O, const float* __restrict__ lq1, const float* __restrict__ lk1, const float* __restrict__ lq2, const float* __restrict__ lk2,
                                                       const float* __restrict__ subln, float lam_init, float* __restrict__ OC) {
    float s1 = 0.f, s2 = 0.f;
    for (int d = 0; d < 64; ++d) { s1 += lq1[d] * lk1[d]; s2 += lq2[d] * lk2[d]; }
    const float lam = __expf(s1) - __expf(s2) + lam_init;
    const int idx = blockIdx.x * 256 + threadIdx.x;
    if (idx >= T * 6) return;
    const int t = idx / 6, h = idx % 6;
    const float* o0 = O + (size_t)t * DAW + h * 128; const float* o1 = o0 + (size_t)T * DAW;
    float v[128]; float ss = 0.f;
#pragma unroll
    for (int e = 0; e < 128; ++e) { v[e] = o0[e] - lam * o1[e]; ss += v[e] * v[e]; }
    const float rstd = rsqrtf(ss * (1.f / 128.f) + EPS) * (1.f - lam_init);
    float* oc = OC + (size_t)t * D + h * 128;
#pragma unroll
    for (int e = 0; e < 128; ++e) oc[e] = v[e] * rstd * subln[e];
}
__global__ void __launch_bounds__(64) k_mem_attn(const float* __restrict__ proj, int ldp, int qoff, const float* __restrict__ kv  , float* __restrict__ OC) {
    const int h = blockIdx.y, t = blockIdx.x * 64 + threadIdx.x, b = t / S;
    float q[64];
    const float* qp = proj + (size_t)t * ldp + qoff + h * 64;
#pragma unroll
    for (int d = 0; d < 64; ++d) q[d] = qp[d] * 0.125f;
    const float* kb = kv + (size_t)b * MEML * 512 + h * 64;
    float mx = -3.0e38f;
    for (int k = 0; k < MEML; ++k) { const float* kr = kb + (size_t)k * 512; float s = 0.f;
#pragma unroll
        for (int d = 0; d < 64; ++d) s += q[d] * kr[d];
        mx = fmaxf(mx, s); }
    float o[64]; float l = 0.f;
#pragma unroll
    for (int e = 0; e < 64; ++e) o[e] = 0.f;
    for (int k = 0; k < MEML; ++k) { const float* kr = kb + (size_t)k * 512; float s = 0.f;
#pragma unroll
        for (int d = 0; d < 64; ++d) s += q[d] * kr[d];
        const float p = __expf(s - mx); l += p; const float* vr = kr + 256;
#pragma unroll
        for (int e = 0; e < 64; ++e) o[e] += p * vr[e]; }
    const float il = 1.f / l;
    float* oc = OC + (size_t)t * D + DAW + h * 64;
#pragma unroll
    for (int e = 0; e < 64; ++e) oc[e] = o[e] * il;
}
__global__ void __launch_bounds__(128) k_hgrn(const float* __restrict__ proj  , const float* __restrict__ lbl  , int j, float* __restrict__ Ob  ) {
    __shared__ float sq[16][128], sf[16][128], sk[16][128];
    const int bh = blockIdx.x, b = bh / 6, h = bh % 6, tid = threadIdx.x;
    float lb = 0.f;
    if (j == 1) { const float l0 = lbl[h * 128 + tid], l1 = lbl[768 + h * 128 + tid]; lb = 1.f / (1.f + __expf(l0 - l1)); }
    float St[128];
#pragma unroll
    for (int k = 0; k < 128; ++k) St[k] = 0.f;
    for (int t0 = 0; t0 < S; t0 += 16) {
        __syncthreads();
        for (int jj = 0; jj < 16; ++jj) { const float* pr = proj + (size_t)(b * S + t0 + jj) * BIN + h * 128 + tid;
            const float qv = pr[0], fz = pr[768]; const float sg = sigmoidf_(fz); const float f = lb + (1.f - lb) * sg;
            sq[jj][tid] = qv; sf[jj][tid] = f; sk[jj][tid] = 1.f - f; }
        __syncthreads();
        for (int jj = 0; jj < 16; ++jj) {
            const float v = proj[(size_t)(b * S + t0 + jj) * BIN + 1536 + h * 128 + tid];
            float o = 0.f;
#pragma unroll
            for (int k = 0; k < 128; k += 4) { const float4 f4 = *(const float4*)&sf[jj][k], k4 = *(const float4*)&sk[jj][k], q4 = *(const float4*)&sq[jj][k];
                St[k] = f4.x * St[k] + k4.x * v; o += q4.x * St[k];
                St[k + 1] = f4.y * St[k + 1] + k4.y * v; o += q4.y * St[k + 1];
                St[k + 2] = f4.z * St[k + 2] + k4.z * v; o += q4.z * St[k + 2];
                St[k + 3] = f4.w * St[k + 3] + k4.w * v; o += q4.w * St[k + 3]; }
            Ob[(size_t)(b * S + t0 + jj) * DAW + h * 128 + tid] = o;
        }
    }
}
__global__ void __launch_bounds__(256) k_hgrn_out(const float* __restrict__ Ob, const float* __restrict__ proj, const float* __restrict__ gn, float* __restrict__ OC) {
    const int idx = blockIdx.x * 256 + threadIdx.x; if (idx >= T * 6) return;
    const int t = idx / 6, h = idx % 6;
    const float* o = Ob + (size_t)t * DAW + h * 128; const float* g = proj + (size_t)t * BIN + 2304 + h * 128;
    float ss = 0.f;
#pragma unroll 8
    for (int e = 0; e < 128; ++e) ss += o[e] * o[e];
    const float rstd = rsqrtf(ss * (1.f / 128.f) + EPS);
    float* oc = OC + (size_t)t * D + h * 128;
#pragma unroll 8
    for (int e = 0; e < 128; ++e) oc[e] = o[e] * rstd * gn[e] * siluf_(g[e]);
}
__global__ void __launch_bounds__(256) k_swiglu(const float* __restrict__ GU, float* __restrict__ Hh, int M, int FF, const int* dyn) {
    if (dyn) { M = dyn[1] < 16384 ? dyn[1] : 16384; }
    const size_t n = (size_t)M * FF;
    for (size_t i = (size_t)blockIdx.x * 256 + threadIdx.x; i < n; i += (size_t)gridDim.x * 256) {
        const size_t r = i / FF; const int c = (int)(i % FF);
        const float* gp = GU + r * (size_t)(2 * FF);
        Hh[r * (size_t)FF + c] = siluf_(gp[c]) * gp[FF + c];
    }
}
__global__ void __launch_bounds__(256) k_router(const float* __restrict__ xn, const float* __restrict__ wr  , int* __restrict__ tope  , float* __restrict__ topw  ) {
    const int lane = threadIdx.x & 63, t = (blockIdx.x * 256 + threadIdx.x) >> 6;
    if (t >= T) return;
    float acc[8];
#pragma unroll
    for (int e = 0; e < 8; ++e) acc[e] = 0.f;
    for (int k = lane; k < D; k += 64) { const float xv = xn[(size_t)t * D + k]; const float4 w0 = *(const float4*)(wr + k * 8), w1 = *(const float4*)(wr + k * 8 + 4);
        acc[0] += xv * w0.x; acc[1] += xv * w0.y; acc[2] += xv * w0.z; acc[3] += xv * w0.w; acc[4] += xv * w1.x; acc[5] += xv * w1.y; acc[6] += xv * w1.z; acc[7] += xv * w1.w; }
#pragma unroll
    for (int e = 0; e < 8; ++e) acc[e] = wave_sum(acc[e]);
    if (lane == 0) {
        int e0 = 0; float v0 = acc[0];
#pragma unroll
        for (int e = 1; e < 8; ++e) if (acc[e] > v0) { v0 = acc[e]; e0 = e; }
        int e1 = -1; float v1 = -3.0e38f;
#pragma unroll
        for (int e = 0; e < 8; ++e) if (e != e0 && acc[e] > v1) { v1 = acc[e]; e1 = e; }
        const float p1 = __expf(v1 - v0), inv = 1.f / (1.f + p1);
        tope[t * 2] = e0; tope[t * 2 + 1] = e1; topw[t * 2] = inv; topw[t * 2 + 1] = p1 * inv;
    }
}
__global__ void __launch_bounds__(64) k_route_count(const int* __restrict__ tope, int* __restrict__ cnt) {
    const int e = blockIdx.x, lane = threadIdx.x; int c = 0;
    for (int t = lane; t < T; t += 64) c += (tope[t * 2] == e || tope[t * 2 + 1] == e) ? 1 : 0;
    c = (int)wave_sum((float)c);
    if (lane == 0) cnt[e] = c;
}
__global__ void __launch_bounds__(64) k_route_fill(const int* __restrict__ tope, const int* __restrict__ cnt, int* __restrict__ dyn, int* __restrict__ rowtok, int* __restrict__ tokrow) {
    const int e = blockIdx.x, lane = threadIdx.x; int off = 0;
    for (int i = 0; i < e; ++i) off += cnt[i];
    if (lane == 0) { dyn[e * 2] = off; dyn[e * 2 + 1] = cnt[e]; }
    int base = off;
    for (int t0 = 0; t0 < T; t0 += 64) { const int t = t0 + lane; const int a = tope[t * 2], b2 = tope[t * 2 + 1];
        const bool f = (a == e || b2 == e); const unsigned long long mk = __ballot(f);
        const int pos = base + __popcll(mk & ((1ull << lane) - 1ull));
        if (f) { rowtok[pos] = t; tokrow[t * 2 + (a == e ? 0 : 1)] = pos; }
        base += __popcll(mk); }
}
__global__ void __launch_bounds__(256) k_gather(const float* __restrict__ xn, const int* __restrict__ rowtok, float* __restrict__ Xg, int rows) {
    const int lane = threadIdx.x & 63, w = (blockIdx.x * 256 + threadIdx.x) >> 6, nw = (gridDim.x * 256) >> 6;
    for (int r = w; r < rows; r += nw) { const float4* s = (const float4*)(xn + (size_t)rowtok[r] * D) + lane; float4* d = (float4*)(Xg + (size_t)r * D) + lane;
#pragma unroll
        for (int j = 0; j < 4; ++j) d[64 * j] = s[64 * j]; }
}
__global__ void __launch_bounds__(256) k_moe_combine(float* __restrict__ x, const float* __restrict__ Y, const int* __restrict__ tokrow, const float* __restrict__ topw) {
    const int lane = threadIdx.x & 63, w = (blockIdx.x * 256 + threadIdx.x) >> 6, nw = (gridDim.x * 256) >> 6;
    for (int t = w; t < T; t += nw) { const int r0 = tokrow[t * 2], r1 = tokrow[t * 2 + 1]; const float w0 = topw[t * 2], w1 = topw[t * 2 + 1];
        float4* xr = (float4*)(x + (size_t)t * D) + lane; const float4* y0 = (const float4*)(Y + (size_t)r0 * D) + lane; const float4* y1 = (const float4*)(Y + (size_t)r1 * D) + lane;
#pragma unroll
        for (int j = 0; j < 4; ++j) { float4 v = xr[64 * j]; const float4 a = y0[64 * j], b = y1[64 * j];
            v.x += w0 * a.x + w1 * b.x; v.y += w0 * a.y + w1 * b.y; v.z += w0 * a.z + w1 * b.z; v.w += w0 * a.w + w1 * b.w; xr[64 * j] = v; } }
}
}

extern "C" void kernel_launch(void* const* d_in, const int* in_sizes, int n_in, void* d_out, int out_size, void* d_ws, size_t ws_size, hipStream_t stream) {
    using namespace nv;
    if (n_in != 27 || in_sizes[0] != T * D || out_size != T * D) { fprintf(stderr, "kernel_launch: unexpected shapes n_in %d in0 %d out %d\n", n_in, n_in > 0 ? in_sizes[0] : -1, out_size); return; }
    const float* const* in = (const float* const*)d_in;
    unsigned char* ws = (unsigned char*)d_ws;
    size_t off = 0;
    auto take = [&](size_t bytes) { size_t o = off; off += (bytes + 255) & ~(size_t)255; return o; };
    float* XN = (float*)(ws + take((size_t)T * D * 4));
    float* OC = (float*)(ws + take((size_t)T * D * 4));
    float* MEMN = (float*)(ws + take((size_t)NB * MEML * D * 4));
    float* MKV = (float*)(ws + take((size_t)NB * MEML * 512 * 4));
    int* TOPE = (int*)(ws + take((size_t)T * 2 * 4));
    float* TOPW = (float*)(ws + take((size_t)T * 2 * 4));
    int* TOKROW = (int*)(ws + take((size_t)T * 2 * 4));
    int* ROWTOK = (int*)(ws + take((size_t)T * 2 * 4));
    int* CNT = (int*)(ws + take(256));
    int* DYN = (int*)(ws + take(256));
    const size_t bigA = take((size_t)768 * MiB);
    const size_t bigB = take((size_t)480 * MiB);
    if (off > ws_size) { fprintf(stderr, "kernel_launch: workspace too small: need %zu have %zu\n", off, ws_size); return; }
    float* PROJ = (float*)(ws + bigA);
    float* O01 = (float*)(ws + bigA + (size_t)416 * MiB);
    float* GU = (float*)(ws + bigA);
    float* XG = (float*)(ws + bigA);
    float* GUE = (float*)(ws + bigA + (size_t)256 * MiB);
    float* HD = (float*)(ws + bigB);
    float* HE = (float*)(ws + bigB);
    float* Y = (float*)(ws + bigB + (size_t)224 * MiB);
    float* X = (float*)d_out;

    auto gemm = [&](const float* A, int lda, const float* Bm, int ldb, float* C, int ldc, const float* R, int M, int N, int K, const int* dyn, int offA = 0, int offC = 0) {
        dim3 g(N / 128, (M + 127) / 128);
        if (R) hipLaunchKernelGGL(k_gemm<1>, g, dim3(256), 0, stream, A, lda, Bm, ldb, C, ldc, R, M, N, K, dyn, offA, offC);
        else hipLaunchKernelGGL(k_gemm<0>, g, dim3(256), 0, stream, A, lda, Bm, ldb, C, ldc, R, M, N, K, dyn, offA, offC);
    };
    const float* xcur = in[0];
    for (int i = 0; i < 4; ++i) {
        const int j = i / 2;
        if (i % 2 == 0) {
            const float lam_init = (i == 0) ? 0.2f : (float)(0.8 - 0.6 * 0.5488116360940264);
            hipLaunchKernelGGL(k_rmsnorm, dim3(2048), dim3(256), 0, stream, xcur, in[2] + j * D, XN, T);
            gemm(XN, D, in[3] + (size_t)j * D * AIN, AIN, PROJ, AIN, nullptr, T, AIN, D, nullptr);
            hipLaunchKernelGGL(k_diff_attn, dim3(64, NB * 12), dim3(64), 0, stream, PROJ, O01);
            hipLaunchKernelGGL(k_diff_combine, dim3(T * 6 / 256), dim3(256), 0, stream, O01, in[4] + j * 64, in[5] + j * 64, in[6] + j * 64, in[7] + j * 64, in[8] + j * 128, lam_init, OC);
            hipLaunchKernelGGL(k_rmsnorm, dim3(512), dim3(256), 0, stream, in[1], in[9] + j * D, MEMN, NB * MEML);
            gemm(MEMN, D, in[10] + (size_t)j * D * 512, 512, MKV, 512, nullptr, NB * MEML, 512, D, nullptr);
            hipLaunchKernelGGL(k_mem_attn, dim3(T / 64, 4), dim3(64), 0, stream, PROJ, AIN, 3 * DAW, MKV, OC);
            gemm(OC, D, in[11] + (size_t)j * D * D, D, X, D, xcur, T, D, D, nullptr);
            xcur = X;
            hipLaunchKernelGGL(k_rmsnorm, dim3(2048), dim3(256), 0, stream, X, in[19] + j * D, XN, T);
            gemm(XN, D, in[20] + (size_t)j * D * 2 * FFD, 2 * FFD, GU, 2 * FFD, nullptr, T, 2 * FFD, D, nullptr);
            hipLaunchKernelGGL(k_swiglu, dim3(4096), dim3(256), 0, stream, GU, HD, T, FFD, nullptr);
            gemm(HD, FFD, in[21] + (size_t)j * FFD * D, D, X, D, X, T, D, FFD, nullptr);
        } else {
            hipLaunchKernelGGL(k_rmsnorm, dim3(2048), dim3(256), 0, stream, X, in[12] + j * D, XN, T);
            gemm(XN, D, in[13] + (size_t)j * D * BIN, BIN, PROJ, BIN, nullptr, T, BIN, D, nullptr);
            hipLaunchKernelGGL(k_hgrn, dim3(NB * 6), dim3(128), 0, stream, PROJ, in[14], j, O01);
            hipLaunchKernelGGL(k_hgrn_out, dim3(T * 6 / 256), dim3(256), 0, stream, O01, PROJ, in[15] + j * 128, OC);
            hipLaunchKernelGGL(k_rmsnorm, dim3(512), dim3(256), 0, stream, in[1], in[16] + j * D, MEMN, NB * MEML);
            gemm(MEMN, D, in[17] + (size_t)j * D * 512, 512, MKV, 512, nullptr, NB * MEML, 512, D, nullptr);
            hipLaunchKernelGGL(k_mem_attn, dim3(T / 64, 4), dim3(64), 0, stream, PROJ, BIN, 3072, MKV, OC);
            gemm(OC, D, in[18] + (size_t)j * D * D, D, X, D, X, T, D, D, nullptr);
            hipLaunchKernelGGL(k_rmsnorm, dim3(2048), dim3(256), 0, stream, X, in[22] + j * D, XN, T);
            hipLaunchKernelGGL(k_router, dim3(T / 4), dim3(256), 0, stream, XN, in[23] + (size_t)j * D * 8, TOPE, TOPW);
            hipLaunchKernelGGL(k_route_count, dim3(8), dim3(64), 0, stream, TOPE, CNT);
            hipLaunchKernelGGL(k_route_fill, dim3(8), dim3(64), 0, stream, TOPE, CNT, DYN, ROWTOK, TOKROW);
            hipLaunchKernelGGL(k_gather, dim3(2048), dim3(256), 0, stream, XN, ROWTOK, XG, 2 * T);
            for (int e = 0; e < NE; ++e) {
                const float* wgu = in[24] + ((size_t)j * NE + e) * D * 2 * FFE;
                const float* wdn = in[25] + ((size_t)j * NE + e) * FFE * D;
                gemm(XG, D, wgu, 2 * FFE, GUE, 2 * FFE, nullptr, 16384, 2 * FFE, D, DYN + 2 * e, 1, 0);
                hipLaunchKernelGGL(k_swiglu, dim3(4096), dim3(256), 0, stream, GUE, HE, 0, FFE, DYN + 2 * e);
                gemm(HE, FFE, wdn, D, Y, D, nullptr, 16384, D, FFE, DYN + 2 * e, 0, 1);
            }
            hipLaunchKernelGGL(k_moe_combine, dim3(2048), dim3(256), 0, stream, X, Y, TOKROW, TOPW);
        }
    }
    hipLaunchKernelGGL(k_rmsnorm, dim3(2048), dim3(256), 0, stream, X, in[26], X, T);
}
```

```cpp
#include <hip/hip_runtime.h>
#include <hip/hip_bf16.h>
#include <cstdio>
#include <cstdint>
#include <cmath>
namespace pg8 {
#define PG8_LAS __attribute__((address_space(3)))
typedef unsigned short bf16_t;
typedef short bf16x8 __attribute__((ext_vector_type(8)));
typedef float f32x4 __attribute__((ext_vector_type(4)));
typedef unsigned u32x4 __attribute__((ext_vector_type(4)));
constexpr int BM = 256, BK = 64, HALF = 128, HTB = HALF * BK * 2  , STAGE_BYTES = 8 * HTB, NXCD = 8, WGM = 8;

__host__ __device__ __forceinline__ int lds_byte(int r, int c) { const int st = (r >> 4) * 2 + (c >> 5), rr = r & 15, cc = c & 31, ob = rr * 64 + cc * 2; return st * 1024 + (ob ^ (((ob >> 9) & 1) << 5)); }
__host__ __device__ __forceinline__ void stage_rc(int b, int& R, int& C) { const int st = b / 1024, sb = b % 1024, swz = sb ^ (((sb >> 9) & 1) << 5); R = (st >> 1) * 16 + swz / 64; C = (st & 1) * 32 + (swz % 64) / 2; }
__host__ __device__ __forceinline__ int perm32(int rho) { const int n = rho >> 4, i = rho & 15; return 8 * (i >> 2) + 4 * n + (i & 3); }

struct Unit { int pm, pn, pb; };
struct Gemm { const bf16_t* A; const bf16_t* Bt; int M, N, K; };

struct StaticOrder {
    int nM, nN, nwg, G, c;
    __host__ __device__ void init(int M, int N, int G_, int c_) { nM = M / BM; nN = N / BM; nwg = nM * nN; G = G_; c = c_; }
    __host__ __device__ bool next(int i, Unit& u) const {
        const long L = (long)i * G + c; if (L >= nwg) return false;
        int wgid = (int)L; { const int q = nwg / NXCD, r = nwg % NXCD, xcd = wgid % NXCD, off = wgid / NXCD; wgid = (xcd < r ? xcd * (q + 1) : r * (q + 1) + (xcd - r) * q) + off; }
        const int nig = WGM * nN, gid = wgid / nig, fm = gid * WGM, gsz = (nM - fm) < WGM ? (nM - fm) : WGM;
        u.pm = fm + ((wgid % nig) % gsz); u.pn = (wgid % nig) / gsz; u.pb = u.pn; return true;
    }
    __device__ __forceinline__ void a_ready(const Unit&) const {}
    __device__ __forceinline__ void done(const Unit&) const {}
};

__device__ __forceinline__ unsigned cvt_pk_bf16(float lo, float hi) { unsigned r; asm volatile("v_cvt_pk_bf16_f32 %0, %1, %2" : "=v"(r) : "v"(lo), "v"(hi)); return r; }
typedef float f32x2 __attribute__((ext_vector_type(2)));
#define PG8_G __attribute__((address_space(1)))
__device__ __forceinline__ float row_rstd(const float* ssq, int row) {
    const PG8_G f32x4* p = (const PG8_G f32x4*)(ssq + (size_t)row * 16); const f32x4 a = p[0], b = p[1], c = p[2], d = p[3];
    const f32x4 t = (a + b) + (c + d); return __builtin_amdgcn_rsqf(((t[0] + t[1]) + (t[2] + t[3])) * (1.f / 1024.f) + 1e-6f); }
__device__ __forceinline__ float silu_f(float v) { return v * __builtin_amdgcn_rcpf(1.f + __builtin_amdgcn_exp2f(-1.4426950408889634f * v)); }
struct EpiProj {
    static constexpr bool PERM = true, AFTER_DRAIN = false, FRESH = false;
    bf16_t* O; int ldc; unsigned smask; float sc; int flo, fhi; float* F; int fld; const float* lbt; const float* ssq; unsigned* n2;
    __device__ __forceinline__ void operator()(const f32x4 (&acc)[2][2][4][2], const Unit& u, int wr, int wc, int fr, int fq) const {
        const int row0 = u.pm * BM + wr * 64 + fr, cin = wc * 32 + 8 * fq;
        const float s = ((smask >> u.pn) & 1u) ? sc : 1.f;
        float rs[2][4];
#pragma unroll
        for (int ai = 0; ai < 2; ++ai)
#pragma unroll
            for (int m = 0; m < 4; ++m) rs[ai][m] = ssq ? row_rstd(ssq, row0 + ai * HALF + m * 16) : 1.f;
        if (u.pn >= flo && u.pn < fhi) {
            const int col0 = (u.pn - flo) * BM + cin;
#pragma unroll
            for (int ai = 0; ai < 2; ++ai)
#pragma unroll
                for (int m = 0; m < 4; ++m) { float* rowp = F + (size_t)(row0 + ai * HALF + m * 16) * fld + col0;
#pragma unroll
                    for (int bj = 0; bj < 2; ++bj) { f32x4 v0 = acc[ai][bj][m][0] * rs[ai][m], v1 = acc[ai][bj][m][1] * rs[ai][m];
                        if (lbt) { const f32x4 l0 = *(const PG8_G f32x4*)(lbt + col0 + bj * HALF), l1 = *(const PG8_G f32x4*)(lbt + col0 + bj * HALF + 4);
#pragma unroll
                            for (int i = 0; i < 4; ++i) { v0[i] = __builtin_amdgcn_logf(l0[i] + (1.f - l0[i]) * __builtin_amdgcn_rcpf(1.f + __builtin_amdgcn_exp2f(-1.4426950408889634f * v0[i])));
                                v1[i] = __builtin_amdgcn_logf(l1[i] + (1.f - l1[i]) * __builtin_amdgcn_rcpf(1.f + __builtin_amdgcn_exp2f(-1.4426950408889634f * v1[i]))); } }
                        *(PG8_G f32x4*)(rowp + bj * HALF) = v0; *(PG8_G f32x4*)(rowp + bj * HALF + 4) = v1; } }
        } else {
            const int col0 = u.pn * BM + cin;
            const bool trk = n2 && u.pn < 6;
            const int ln = fq * 16 + fr;
#pragma unroll
            for (int ai = 0; ai < 2; ++ai) { float mx[2] = {0.f, 0.f};
#pragma unroll
                for (int m = 0; m < 4; ++m) { bf16_t* rowp = O + (size_t)(row0 + ai * HALF + m * 16) * ldc + col0;
#pragma unroll
                    for (int bj = 0; bj < 2; ++bj) { const f32x4 v0 = acc[ai][bj][m][0] * (s * rs[ai][m]), v1 = acc[ai][bj][m][1] * (s * rs[ai][m]);
                        u32x4 w; w.x = cvt_pk_bf16(v0[0], v0[1]); w.y = cvt_pk_bf16(v0[2], v0[3]); w.z = cvt_pk_bf16(v1[0], v1[1]); w.w = cvt_pk_bf16(v1[2], v1[3]);
                        *(PG8_G u32x4*)(rowp + bj * HALF) = w;
                        if (trk) { float ss = ((v0[0] * v0[0] + v0[1] * v0[1]) + (v0[2] * v0[2] + v0[3] * v0[3])) + ((v1[0] * v1[0] + v1[1] * v1[1]) + (v1[2] * v1[2] + v1[3] * v1[3]));
                            ss += __builtin_bit_cast(float, __builtin_amdgcn_ds_bpermute((ln ^ 16) << 2, __builtin_bit_cast(int, ss))); ss += __builtin_bit_cast(float, __builtin_amdgcn_ds_bpermute((ln ^ 32) << 2, __builtin_bit_cast(int, ss)));
                            mx[bj] = __builtin_fmaxf(mx[bj], ss); } } }
                if (trk) {
#pragma unroll
                    for (int bj = 0; bj < 2; ++bj) { float mv = mx[bj];
#pragma unroll
                        for (int o = 1; o < 16; o <<= 1) mv = __builtin_fmaxf(mv, __builtin_bit_cast(float, __builtin_amdgcn_ds_bpermute((ln ^ o) << 2, __builtin_bit_cast(int, mv))));
                        if (ln == 0) { const int rw = u.pm * BM + ai * HALF + wr * 64; const int idx = (((rw >> 12) * 24 + u.pn * 4 + 2 * bj + (wc >> 1)) * 64 + ((rw >> 6) & 63)) * 2 + (wc & 1);
                            ((PG8_G float*)n2)[idx] = mv; } } }
            }
        }
    }
};
__device__ __forceinline__ unsigned pk4_fp8(float a, float b, float c, float d) {
    a = __builtin_fminf(__builtin_fmaxf(a, -448.f), 448.f); b = __builtin_fminf(__builtin_fmaxf(b, -448.f), 448.f); c = __builtin_fminf(__builtin_fmaxf(c, -448.f), 448.f); d = __builtin_fminf(__builtin_fmaxf(d, -448.f), 448.f);
    int r = __builtin_amdgcn_cvt_pk_fp8_f32(a, b, 0, false); r = __builtin_amdgcn_cvt_pk_fp8_f32(c, d, r, true); return (unsigned)r; }
struct EpiResid {
    static constexpr bool PERM = true, AFTER_DRAIN = false, FRESH = true;
    float* X; const float* R; int ldc; bf16_t* XN; const float* gn; float* ssq; float asc;
    __device__ __forceinline__ void operator()(const f32x4 (&acc)[2][2][4][2], const Unit& u, int wr, int wc, int fr, int fq) const {
        const int row0 = u.pm * BM + wr * 64 + fr, col0 = u.pn * BM + wc * 32 + 8 * fq;
        f32x4 gv[2][2];
        if (XN) {
#pragma unroll
            for (int bj = 0; bj < 2; ++bj) { gv[bj][0] = *(const PG8_G f32x4*)(gn + col0 + bj * HALF); gv[bj][1] = *(const PG8_G f32x4*)(gn + col0 + bj * HALF + 4); } }
#pragma unroll
        for (int ai = 0; ai < 2; ++ai) {
            f32x4 r[4][2][2];
#pragma unroll
            for (int m = 0; m < 4; ++m) { const size_t off = (size_t)(row0 + ai * HALF + m * 16) * ldc + col0;
#pragma unroll
                for (int bj = 0; bj < 2; ++bj) { r[m][bj][0] = *(const PG8_G f32x4*)(R + off + bj * HALF); r[m][bj][1] = *(const PG8_G f32x4*)(R + off + bj * HALF + 4); } }
#pragma unroll
            for (int m = 0; m < 4; ++m) { const size_t off = (size_t)(row0 + ai * HALF + m * 16) * ldc + col0; float ss = 0.f;
#pragma unroll
                for (int bj = 0; bj < 2; ++bj) { const f32x4 x0 = r[m][bj][0] + acc[ai][bj][m][0] * asc, x1 = r[m][bj][1] + acc[ai][bj][m][1] * asc;
                    *(PG8_G f32x4*)(X + off + bj * HALF) = x0; *(PG8_G f32x4*)(X + off + bj * HALF + 4) = x1;
                    if (XN) { ss += (x0[0] * x0[0] + x0[1] * x0[1]) + (x0[2] * x0[2] + x0[3] * x0[3]) + (x1[0] * x1[0] + x1[1] * x1[1]) + (x1[2] * x1[2] + x1[3] * x1[3]);
                        const f32x4 y0 = x0 * gv[bj][0], y1 = x1 * gv[bj][1]; u32x4 w; w.x = cvt_pk_bf16(y0[0], y0[1]); w.y = cvt_pk_bf16(y0[2], y0[3]); w.z = cvt_pk_bf16(y1[0], y1[1]); w.w = cvt_pk_bf16(y1[2], y1[3]);
                        *(PG8_G u32x4*)(XN + off + bj * HALF) = w; } }
                if (XN) { const int ln = fq * 16 + fr;
                    ss += __builtin_bit_cast(float, __builtin_amdgcn_ds_bpermute((ln ^ 16) << 2, __builtin_bit_cast(int, ss))); ss += __builtin_bit_cast(float, __builtin_amdgcn_ds_bpermute((ln ^ 32) << 2, __builtin_bit_cast(int, ss)));
                    if (fq == 0) ((PG8_G float*)ssq)[(size_t)(row0 + ai * HALF + m * 16) * 16 + u.pn * 4 + wc] = ss; } }
        }
    }
};
template <bool F8> struct EpiSwiglu {
    static constexpr bool PERM = true, AFTER_DRAIN = false, FRESH = false;
    bf16_t* H; int ldh; float insc, outsc; const float* ssq;
    __device__ __forceinline__ void operator()(const f32x4 (&acc)[2][2][4][2], const Unit& u, int wr, int wc, int fr, int fq) const {
        const int row0 = u.pm * BM + wr * 64 + fr, col0 = u.pn * HALF + wc * 32 + 8 * fq;
#pragma unroll
        for (int ai = 0; ai < 2; ++ai)
#pragma unroll
            for (int m = 0; m < 4; ++m) {
                const f32x4 g0 = acc[ai][0][m][0], g1 = acc[ai][0][m][1], u0 = acc[ai][1][m][0], u1 = acc[ai][1][m][1];
                float sg = ssq ? row_rstd(ssq, row0 + ai * HALF + m * 16) : 1.f, su = sg; if (F8) { sg *= insc; su *= insc * outsc; }
                const float k1 = -1.4426950408889634f * sg, ic = __builtin_amdgcn_rcpf(sg * su);
                f32x4 t0 = g0 * k1, t1 = g1 * k1;
#pragma unroll
                for (int i = 0; i < 4; ++i) { t0[i] = __builtin_amdgcn_exp2f(t0[i]); t1[i] = __builtin_amdgcn_exp2f(t1[i]); }
                t0 = t0 * ic + ic; t1 = t1 * ic + ic;
#pragma unroll
                for (int i = 0; i < 4; ++i) { t0[i] = __builtin_amdgcn_rcpf(t0[i]); t1[i] = __builtin_amdgcn_rcpf(t1[i]); }
                const f32x4 h0 = (g0 * u0) * t0, h1 = (g1 * u1) * t1;
                if (F8) { typedef unsigned u32x2 __attribute__((ext_vector_type(2))); u32x2 w; w.x = pk4_fp8(h0[0], h0[1], h0[2], h0[3]); w.y = pk4_fp8(h1[0], h1[1], h1[2], h1[3]);
                    *(PG8_G u32x2*)((unsigned char*)H + (size_t)(row0 + ai * HALF + m * 16) * ldh + col0) = w;
                } else { bf16_t* rowp = H + (size_t)(row0 + ai * HALF + m * 16) * ldh + col0;
                    u32x4 w; w.x = cvt_pk_bf16(h0[0], h0[1]); w.y = cvt_pk_bf16(h0[2], h0[3]); w.z = cvt_pk_bf16(h1[0], h1[1]); w.w = cvt_pk_bf16(h1[2], h1[3]);
                    *(PG8_G u32x4*)rowp = w; }
            }
    }
};
struct MoeOrder {
    int nM, nN, nwg, G, c; int tb1, tb2, tb3, tb4, tb5, tb6, tb7;
    __device__ __forceinline__ void init(const int (&cnt)[8], int nN_, int G_, int c_) {
        int t = 0; t += (cnt[0] + 255) >> 8; tb1 = t; t += (cnt[1] + 255) >> 8; tb2 = t; t += (cnt[2] + 255) >> 8; tb3 = t; t += (cnt[3] + 255) >> 8; tb4 = t;
        t += (cnt[4] + 255) >> 8; tb5 = t; t += (cnt[5] + 255) >> 8; tb6 = t; t += (cnt[6] + 255) >> 8; tb7 = t; t += (cnt[7] + 255) >> 8;
        nM = t; nN = nN_; nwg = nM * nN; G = G_; c = c_; }
    __device__ __forceinline__ bool next(int i, Unit& u) const {
        const long L = (long)i * G + c; if (L >= nwg) return false;
        int wgid = (int)L; { const int q = nwg / NXCD, r = nwg % NXCD, xcd = wgid % NXCD, off = wgid / NXCD; wgid = (xcd < r ? xcd * (q + 1) : r * (q + 1) + (xcd - r) * q) + off; }
        const int nig = WGM * nN, gid = wgid / nig, fm = gid * WGM, gsz = (nM - fm) < WGM ? (nM - fm) : WGM;
        u.pm = fm + ((wgid % nig) % gsz); u.pn = (wgid % nig) / gsz;
        const int e = (u.pm >= tb1) + (u.pm >= tb2) + (u.pm >= tb3) + (u.pm >= tb4) + (u.pm >= tb5) + (u.pm >= tb6) + (u.pm >= tb7);
        u.pb = e * nN + u.pn; return true;
    }
    __device__ __forceinline__ void a_ready(const Unit&) const {}
    __device__ __forceinline__ void done(const Unit&) const {}
};

template <class Epi, class Sched, bool ALIGN_EPI = false, bool SP2 = false, bool FP8 = false>
__device__ __forceinline__ void gemm_phase(PG8_LAS unsigned char* lds, const Gemm g, const Sched& S, const Epi& E, const int wid_in) {
    int lane_; asm volatile("v_mbcnt_lo_u32_b32 %0, -1, 0\n\tv_mbcnt_hi_u32_b32 %0, -1, %0" : "=v"(lane_));
    const int wid = wid_in, lane = lane_, tid = wid * 64 + lane, wr = wid >> 2, wc = wid & 3, fr = lane & 15, fq = lane >> 4;
    const int K = g.K, nt = K / BK;
    unsigned voffA[2], voffB[2];
#pragma unroll
    for (int i = 0; i < 2; ++i) { int R, C; stage_rc(tid * 16 + i * 8192, R, C); const int Rb = Epi::PERM ? ((R & ~31) + perm32(R & 31)) : R;
        voffA[i] = (unsigned)(R * K + C) * 2u; voffB[i] = (unsigned)(Rb * K + C) * 2u; }
    const size_t kstep = (size_t)(BK * 2);
    const size_t hstep = (size_t)HALF * K * 2;
    const size_t tstep = 2 * hstep;
    const unsigned ldsw = (unsigned)wid * 1024u;
    const unsigned ldsb = (unsigned)__builtin_amdgcn_readfirstlane((int)((unsigned)(uintptr_t)lds + ldsw));
    const int aoff = lds_byte(wr * 64 + fr, fq * 8), boff = lds_byte(wc * 32 + fr, fq * 8);
#define PG8_SA(b, h) (((b) * 2 + (h)) * HTB)
#define PG8_SB(b, h) ((4 + (b) * 2 + (h)) * HTB)
#define PG8_STAGE(bufoff, gbase, voff) do { _Pragma("unroll") for (int _i = 0; _i < 2; ++_i) { unsigned keep_; \
        asm volatile("s_mov_b32 %0, m0\n\ts_mov_b32 m0, %3\n\ts_nop 0\n\tglobal_load_lds_dwordx4 %1, %2\n\ts_mov_b32 m0, %0" : "=&s"(keep_) : "v"((voff)[_i]), "s"((const char*)(gbase)), "s"(ldsb + (unsigned)((bufoff) + _i * 8192)) : "memory"); } } while (0)
#define PG8_LDA(dst, b, h) do { _Pragma("unroll") for (int m = 0; m < 4; ++m) _Pragma("unroll") for (int k = 0; k < 2; ++k) dst[m][k] = *(const PG8_LAS bf16x8*)(lds + PG8_SA(b, h) + aoff + m * 2048 + k * 1024); } while (0)
#define PG8_LDB(dst, b, h) do { _Pragma("unroll") for (int n = 0; n < 2; ++n) _Pragma("unroll") for (int k = 0; k < 2; ++k) dst[n][k] = *(const PG8_LAS bf16x8*)(lds + PG8_SB(b, h) + boff + n * 2048 + k * 1024); } while (0)
#define PG8_MMA(ai, bj, At, Bt) do { __builtin_amdgcn_s_setprio(1); _Pragma("unroll") for (int m = 0; m < 4; ++m) _Pragma("unroll") for (int n = 0; n < 2; ++n) { \
        if constexpr (FP8) { typedef int v4i_ __attribute__((ext_vector_type(4))); typedef int v8i_ __attribute__((ext_vector_type(8))); \
            const v8i_ b8 = __builtin_shufflevector(__builtin_bit_cast(v4i_, Bt[n][0]), __builtin_bit_cast(v4i_, Bt[n][1]), 0, 1, 2, 3, 4, 5, 6, 7), a8 = __builtin_shufflevector(__builtin_bit_cast(v4i_, At[m][0]), __builtin_bit_cast(v4i_, At[m][1]), 0, 1, 2, 3, 4, 5, 6, 7); \
            acc[ai][bj][m][n] = __builtin_amdgcn_mfma_scale_f32_16x16x128_f8f6f4(b8, a8, acc[ai][bj][m][n], 0, 0, 0, 0, 0, 0); } \
        else { _Pragma("unroll") for (int k = 0; k < 2; ++k) acc[ai][bj][m][n] = __builtin_amdgcn_mfma_f32_16x16x32_bf16(Bt[n][k], At[m][k], acc[ai][bj][m][n], 0, 0, 0); } } \
        __builtin_amdgcn_s_setprio(0); } while (0)
#define PG8_WAIT_V(n) asm volatile("s_waitcnt vmcnt(" #n ")" ::: "memory")
#define PG8_WAIT_L(n) asm volatile("s_waitcnt lgkmcnt(" #n ")" ::: "memory")
#define PG8_BAR __builtin_amdgcn_s_barrier()
#define PG8_SCHED __builtin_amdgcn_sched_barrier(0)
    Unit cur, nxt; int ui = 0;
    if (!S.next(0, cur)) return;
    f32x4 acc[2][2][4][2];
#pragma unroll
    for (int a = 0; a < 2; ++a)
#pragma unroll
        for (int b = 0; b < 2; ++b)
#pragma unroll
            for (int m = 0; m < 4; ++m)
#pragma unroll
                for (int n = 0; n < 2; ++n) acc[a][b][m][n] = (f32x4){0.f, 0.f, 0.f, 0.f};
    bf16x8 At[4][2], B0[2][2], B1[2][2];
    const char* cA = (const char*)g.A + (size_t)cur.pm * tstep; const char* cB = (const char*)g.Bt + (size_t)cur.pb * tstep;
    S.a_ready(cur);
    if constexpr (SP2) {
        PG8_STAGE(PG8_SB(0, 0), cB, voffB); PG8_STAGE(PG8_SB(0, 1), cB + hstep, voffB); PG8_STAGE(PG8_SA(0, 0), cA, voffA); PG8_STAGE(PG8_SA(0, 1), cA + hstep, voffA);
        if (wr == 1) PG8_BAR;
        PG8_WAIT_V(2); PG8_BAR;
        PG8_STAGE(PG8_SB(1, 0), cB + kstep, voffB); PG8_STAGE(PG8_SA(1, 0), cA + kstep, voffA); PG8_STAGE(PG8_SB(1, 1), cB + hstep + kstep, voffB);
        PG8_WAIT_V(6); PG8_BAR;
    } else {
        PG8_STAGE(PG8_SB(0, 0), cB, voffB); PG8_STAGE(PG8_SA(0, 0), cA, voffA); PG8_STAGE(PG8_SB(0, 1), cB + hstep, voffB); PG8_STAGE(PG8_SA(0, 1), cA + hstep, voffA);
        if (wr == 1) PG8_BAR;
        PG8_WAIT_V(4); PG8_BAR;
        PG8_STAGE(PG8_SB(1, 0), cB + kstep, voffB); PG8_STAGE(PG8_SA(1, 0), cA + kstep, voffA); PG8_STAGE(PG8_SB(1, 1), cB + hstep + kstep, voffB);
        PG8_WAIT_V(6); PG8_BAR;
    }
    for (;;) {
        const bool has_next = S.next(ui + 1, nxt);
        const char* nA = has_next ? (const char*)g.A + (size_t)nxt.pm * tstep : cA; const char* nB = has_next ? (const char*)g.Bt + (size_t)nxt.pb * tstep : cB;
        for (int t = 0; t < nt; t += 2) {
            const bool last = (t == nt - 2);
            const char* a1 = cA + (size_t)(t + 1) * kstep;
            const char* a2 = last ? nA : cA + (size_t)(t + 2) * kstep; const char* b2 = last ? nB : cB + (size_t)(t + 2) * kstep;
            const char* a3 = a2 + kstep; const char* b3 = b2 + kstep;
            if (last && has_next) S.a_ready(nxt);
            if constexpr (SP2) {
            PG8_LDB(B0, 0, 0); PG8_LDB(B1, 0, 1); PG8_SCHED; PG8_LDA(At, 0, 0); PG8_STAGE(PG8_SA(1, 1), a1 + hstep, voffA);
            PG8_WAIT_V(8); PG8_WAIT_L(0); PG8_BAR; PG8_MMA(0, 0, At, B0); PG8_MMA(0, 1, At, B1); PG8_BAR; PG8_SCHED;
            PG8_LDA(At, 0, 1); PG8_STAGE(PG8_SB(0, 0), b2, voffB); PG8_STAGE(PG8_SB(0, 1), b2 + hstep, voffB); PG8_STAGE(PG8_SA(0, 0), a2, voffA);
            PG8_WAIT_V(8); PG8_WAIT_L(0); PG8_BAR; PG8_MMA(1, 0, At, B0); PG8_MMA(1, 1, At, B1); PG8_BAR; PG8_SCHED;
            PG8_LDB(B0, 1, 0); PG8_LDB(B1, 1, 1); PG8_SCHED; PG8_LDA(At, 1, 0); PG8_STAGE(PG8_SA(0, 1), a2 + hstep, voffA);
            PG8_WAIT_V(8); PG8_WAIT_L(0); PG8_BAR; PG8_MMA(0, 0, At, B0); PG8_MMA(0, 1, At, B1); PG8_BAR; PG8_SCHED;
            PG8_LDA(At, 1, 1); PG8_STAGE(PG8_SB(1, 0), b3, voffB); PG8_STAGE(PG8_SB(1, 1), b3 + hstep, voffB); PG8_STAGE(PG8_SA(1, 0), a3, voffA);
            PG8_WAIT_V(8); PG8_WAIT_L(0); PG8_BAR; PG8_MMA(1, 0, At, B0); PG8_MMA(1, 1, At, B1); PG8_BAR; PG8_SCHED;
            } else {
            PG8_LDB(B0, 0, 0); PG8_SCHED; PG8_LDA(At, 0, 0); PG8_STAGE(PG8_SA(1, 1), a1 + hstep, voffA);
            PG8_WAIT_L(8); PG8_BAR; PG8_WAIT_L(0); PG8_MMA(0, 0, At, B0); PG8_BAR; PG8_SCHED;
            PG8_LDB(B1, 0, 1); PG8_STAGE(PG8_SB(0, 0), b2, voffB);
            PG8_BAR; PG8_WAIT_L(0); PG8_MMA(0, 1, At, B1); PG8_BAR;
            PG8_LDA(At, 0, 1); PG8_STAGE(PG8_SA(0, 0), a2, voffA);
            PG8_BAR; PG8_WAIT_L(0); PG8_MMA(1, 0, At, B0); PG8_BAR; PG8_SCHED;
            PG8_STAGE(PG8_SB(0, 1), b2 + hstep, voffB);
            PG8_WAIT_V(6); PG8_BAR; PG8_MMA(1, 1, At, B1); PG8_BAR;
            PG8_LDB(B0, 1, 0); PG8_SCHED; PG8_LDA(At, 1, 0); PG8_STAGE(PG8_SA(0, 1), a2 + hstep, voffA);
            PG8_WAIT_L(8); PG8_BAR; PG8_WAIT_L(0); PG8_MMA(0, 0, At, B0); PG8_BAR; PG8_SCHED;
            PG8_LDB(B1, 1, 1); PG8_STAGE(PG8_SB(1, 0), b3, voffB);
            PG8_BAR; PG8_WAIT_L(0); PG8_MMA(0, 1, At, B1); PG8_BAR;
            PG8_LDA(At, 1, 1); PG8_STAGE(PG8_SA(1, 0), a3, voffA);
            PG8_BAR; PG8_WAIT_L(0); PG8_MMA(1, 0, At, B0); PG8_BAR; PG8_SCHED;
            PG8_STAGE(PG8_SB(1, 1), b3 + hstep, voffB);
            PG8_WAIT_V(6); PG8_BAR; PG8_MMA(1, 1, At, B1); PG8_BAR;
            }
        }
        if constexpr (ALIGN_EPI) { if (wr == 0) PG8_BAR; }
        if constexpr (!Epi::AFTER_DRAIN) {
            if constexpr (FP8 || Epi::FRESH) { int l2_; asm volatile("v_mbcnt_lo_u32_b32 %0, -1, 0\n\tv_mbcnt_hi_u32_b32 %0, -1, %0" : "=v"(l2_)); E(acc, cur, wr, wc, l2_ & 15, l2_ >> 4); }
            else E(acc, cur, wr, wc, fr, fq);
            S.done(cur); }
        if (!has_next) break;
#pragma unroll
        for (int a = 0; a < 2; ++a)
#pragma unroll
            for (int b = 0; b < 2; ++b)
#pragma unroll
                for (int m = 0; m < 4; ++m)
#pragma unroll
                    for (int n = 0; n < 2; ++n) acc[a][b][m][n] = (f32x4){0.f, 0.f, 0.f, 0.f};
        cur = nxt; cA = nA; cB = nB; ++ui;
        if constexpr (ALIGN_EPI) { if (wr == 1) PG8_BAR; }
    }
    PG8_WAIT_V(0);
    if constexpr (!ALIGN_EPI) { if (wr == 0) PG8_BAR; }
    PG8_BAR;
    if constexpr (Epi::AFTER_DRAIN) { E.fused(acc, cur, wr, wc, fr, fq, lds, wid, lane); S.done(cur); }
#undef PG8_SA
#undef PG8_SB
#undef PG8_STAGE
#undef PG8_LDA
#undef PG8_LDB
#undef PG8_MMA
#undef PG8_WAIT_V
#undef PG8_WAIT_L
#undef PG8_BAR
#undef PG8_SCHED
}
}
#include <hip/hip_bf16.h>
#include <cmath>
namespace attn_body {
using bf16=__hip_bfloat16;
using bf16x8=__attribute__((ext_vector_type(8)))short;
using s16x4=__attribute__((ext_vector_type(4)))short;
using f32x16=__attribute__((ext_vector_type(16)))float;
using u32x4=__attribute__((ext_vector_type(4)))unsigned;
constexpr int D=64;
constexpr int NW=8,QBLK=32,QB=QBLK*NW,KVBLK=64;
constexpr int ATTN_UNIT_ROWS=QB;
__device__ __forceinline__ int crow(int r,int hi){return (r&3)+8*(r>>2)+4*hi;}
#define SBAR() __builtin_amdgcn_sched_barrier(0)
__device__ __forceinline__ void cmask_blk(f32x16&p0,f32x16&p1,int jb,int wid){
  if(jb>(wid>>1)){ const float NEG=-INFINITY;
    #pragma unroll
    for(int r=0;r<16;++r){p0[r]=NEG;p1[r]=NEG;} }
}
__device__ __forceinline__ void alibi(f32x16&p0,f32x16&p1,float dq,float nsl2){
  #pragma unroll
  for(int r=0;r<16;++r){ const float e=(float)((r&3)+8*(r>>2)); p0[r]=__builtin_fmaf(__builtin_fabsf(dq-e),nsl2,p0[r]); p1[r]=__builtin_fmaf(__builtin_fabsf(dq-e-32.f),nsl2,p1[r]); }
}

constexpr int NSLOT=3, SLOTB=8192;
constexpr int LDS_K=0, LDS_V=NSLOT*SLOTB, LDS_WS=2*NSLOT*SLOTB, LDS_OST=LDS_WS+NW*64*4, LDS_BYTES=LDS_OST+NW*4096;
constexpr float C2=0.125f*1.4426950408889634f;
__device__ __forceinline__ void glds16(const void*gsrc,unsigned lds_dst){unsigned keep;
  asm volatile("s_mov_b32 %0, m0\n\ts_mov_b32 m0, %2\n\ts_nop 0\n\tglobal_load_lds_dwordx4 %1, off\n\ts_mov_b32 m0, %0":"=&s"(keep):"v"(gsrc),"s"(lds_dst):"memory");}
__device__ __forceinline__ float max3f(float a,float b,float c){float r;asm("v_max3_f32 %0, %1, %2, %3":"=v"(r):"v"(a),"v"(b),"v"(c));return r;}
__device__ __forceinline__ float max2f(float a,float b){float r;asm("v_max_f32_e32 %0, %1, %2":"=v"(r):"v"(a),"v"(b));return r;}
__device__ __forceinline__ float fadd_s(float a,float b){float r;asm("v_add_f32_e32 %0, %1, %2":"=v"(r):"v"(a),"v"(b));return r;}
__device__ __forceinline__ float fsub_s(float a,float b){float r;asm("v_sub_f32_e32 %0, %1, %2":"=v"(r):"v"(a),"v"(b));return r;}
typedef float f32x2_t __attribute__((ext_vector_type(2))); typedef __bf16 bf16x2_t __attribute__((ext_vector_type(2)));
__device__ __forceinline__ unsigned cvtpk_s(float lo,float hi){f32x2_t v={lo,hi};bf16x2_t b=__builtin_convertvector(v,bf16x2_t);return __builtin_bit_cast(unsigned,b);}
#define WAIT_BAR(N) asm volatile("s_waitcnt vmcnt(" #N ") lgkmcnt(0)\n\ts_barrier":::"memory")

__device__ __forceinline__ void qkt(f32x16&p0,f32x16&p1,const char*Kslot,const bf16x8*qr,const f32x16&negm,int r32,int hi){
  const char*kb=Kslot+hi*1024+r32*16;
  #pragma unroll
  for(int d0=0;d0<4;++d0){
    const bf16x8 b0=*reinterpret_cast<const bf16x8*>(kb+d0*2048);
    const bf16x8 b1=*reinterpret_cast<const bf16x8*>(kb+d0*2048+512);
    if(d0==0){p0=__builtin_amdgcn_mfma_f32_32x32x16_bf16(b0,qr[0],negm,0,0,0);p1=__builtin_amdgcn_mfma_f32_32x32x16_bf16(b1,qr[0],negm,0,0,0);}
    else{p0=__builtin_amdgcn_mfma_f32_32x32x16_bf16(b0,qr[d0],p0,0,0,0);p1=__builtin_amdgcn_mfma_f32_32x32x16_bf16(b1,qr[d0],p1,0,0,0);}}
}
typedef __attribute__((address_space(3))) const char* lds_cptr;
typedef short v4i16_t __attribute__((ext_vector_type(4)));
__device__ __forceinline__ void kload8(bf16x8*kf,lds_cptr kp){
  kf[0]=*(const __attribute__((address_space(3))) bf16x8*)(kp);      kf[1]=*(const __attribute__((address_space(3))) bf16x8*)(kp+512);
  kf[2]=*(const __attribute__((address_space(3))) bf16x8*)(kp+2048); kf[3]=*(const __attribute__((address_space(3))) bf16x8*)(kp+2560);
  kf[4]=*(const __attribute__((address_space(3))) bf16x8*)(kp+4096); kf[5]=*(const __attribute__((address_space(3))) bf16x8*)(kp+4608);
  kf[6]=*(const __attribute__((address_space(3))) bf16x8*)(kp+6144); kf[7]=*(const __attribute__((address_space(3))) bf16x8*)(kp+6656);
}
__device__ __forceinline__ void kload2(bf16x8*kf,lds_cptr kp,int j){ kf[2*j]=*(const __attribute__((address_space(3))) bf16x8*)(kp+j*2048); kf[2*j+1]=*(const __attribute__((address_space(3))) bf16x8*)(kp+j*2048+512); }
__device__ __forceinline__ s16x4 vtr(lds_cptr p){ return __builtin_bit_cast(s16x4,__builtin_amdgcn_ds_read_tr16_b64_v4i16((__attribute__((address_space(3))) v4i16_t*)p)); }
__device__ __forceinline__ float rowmax(const f32x16&p0,const f32x16&p1){
  float a=max3f(p0[0],p0[1],p1[0]),b=max3f(p0[2],p0[3],p1[1]);a=max3f(a,p1[2],p1[3]);
  #pragma unroll
  for(int r=4;r<16;r+=4){a=max3f(a,p0[r],p0[r+1]);b=max3f(b,p0[r+2],p0[r+3]);a=max3f(a,p1[r],p1[r+1]);b=max3f(b,p1[r+2],p1[r+3]);}
  const float m=max2f(a,b);
  auto rr=__builtin_amdgcn_permlane32_swap(__float_as_uint(m),__float_as_uint(m),false,false);
  return max2f(__uint_as_float(rr[0]),__uint_as_float(rr[1]));
}
__device__ __forceinline__ void pv(f32x16*o,int vb,bf16x8 pa0,bf16x8 pa1,bf16x8 pa2,bf16x8 pa3){
  #pragma unroll
  for(int d0=0;d0<2;++d0){s16x4 lo[4],hi[4];
    #pragma unroll
    for(int ks=0;ks<4;++ks){
      asm volatile("ds_read_b64_tr_b16 %0,%1 offset:%c2":"=&v"(lo[ks]):"v"(vb),"i"(d0*4096+ks*1024):"memory");
      asm volatile("ds_read_b64_tr_b16 %0,%1 offset:%c2":"=&v"(hi[ks]):"v"(vb),"i"(d0*4096+ks*1024+512):"memory");}
    asm volatile("s_waitcnt lgkmcnt(0)":::"memory");SBAR();
    #define PK(k) (bf16x8){lo[k][0],lo[k][1],lo[k][2],lo[k][3],hi[k][0],hi[k][1],hi[k][2],hi[k][3]}
    o[d0]=__builtin_amdgcn_mfma_f32_32x32x16_bf16(pa0,PK(0),o[d0],0,0,0);
    o[d0]=__builtin_amdgcn_mfma_f32_32x32x16_bf16(pa1,PK(1),o[d0],0,0,0);
    o[d0]=__builtin_amdgcn_mfma_f32_32x32x16_bf16(pa2,PK(2),o[d0],0,0,0);
    o[d0]=__builtin_amdgcn_mfma_f32_32x32x16_bf16(pa3,PK(3),o[d0],0,0,0);
    #undef PK
  }
}

#ifndef ATTN_STORE16
#define ATTN_STORE16(p,v) (*(u32x4*)(p)=(v))
#endif
template<int MODE,int THRL> __device__ __forceinline__ void attn_unit(const bf16*Qb,int qp,const bf16*__restrict__ Kh,int kp,const bf16*__restrict__ Vh,int vp,bf16*Ob,int op,int NT,int q0,float nsl2,char*shm,const int wid_in){
  int lane_; asm volatile("v_mbcnt_lo_u32_b32 %0, -1, 0\n\tv_mbcnt_hi_u32_b32 %0, -1, %0":"=v"(lane_)); const int lane=lane_,r32=lane&31,hi=lane>>5; const int wid=wid_in,tid=wid*64+lane; (void)tid;
  const bf16*Qw=Qb+(long)(wid*QBLK)*qp;
  const unsigned lds0=(unsigned)(uintptr_t)shm;
  float*wsf=(float*)(shm+LDS_WS)+wid*64;
  const bf16*ksrc=Kh+(long)lane*kp+wid*8;
  const bf16*vsrc=Vh+(long)(16*(wid&3)+(lane>>2))*vp+(wid>>2)*32+(lane&3)*8;
  const unsigned kdst=lds0+LDS_K+wid*1024, vdst=lds0+LDS_V+wid*1024;
  #define DMA_K(t,slot) glds16(ksrc+(long)(t)*KVBLK*kp,(unsigned)__builtin_amdgcn_readfirstlane(kdst+(slot)))
  #define DMA_V(t,slot) glds16(vsrc+(long)(t)*KVBLK*vp,(unsigned)__builtin_amdgcn_readfirstlane(vdst+(slot)))
  const int vb0=(int)(lds0+LDS_V)+((lane>>4)&1)*32+(lane&3)*8+(4*hi+((lane&15)>>2))*64;
  const char*Kbase=shm+LDS_K; bf16x8 kf[8];
  const lds_cptr shm3=(lds_cptr)shm; const lds_cptr kp0=shm3+LDS_K+hi*1024+r32*16; const lds_cptr vp0=shm3+LDS_V+((lane>>4)&1)*32+(lane&3)*8+(4*hi+((lane&15)>>2))*64;
  DMA_K(0,0);DMA_V(0,0);DMA_K(1,SLOTB);
  bf16x8 qr[4];
  #pragma unroll
  for(int d0=0;d0<4;++d0)qr[d0]=*reinterpret_cast<const bf16x8*>(&Qw[(long)r32*qp+d0*16+hi*8]);
  float mhat=0.f,l_reg=0.f;f32x16 o[2];float z_=0.f;asm volatile("":"+v"(z_));
  _Pragma("unroll") for(int r=0;r<16;++r){o[0][r]=z_;o[1][r]=z_;} f32x16 negm;_Pragma("unroll") for(int r=0;r<16;++r)negm[r]=z_;asm volatile("":"+v"(negm));
  const float dq0=(float)(q0+wid*QBLK+r32-4*hi);
  #define ALIBI(P0,P1,t) do{ if(MODE==0) alibi(P0,P1,dq0-(float)(64*(t)),nsl2); }while(0)
  #define CMASK(P0,P1,t) do{ if(MODE==0){int jb_=(t)-(NT-4); if(jb_>=0)cmask_blk(P0,P1,jb_,wid);} }while(0)
  bool resc=false;
  #define START(P0,P1) do{ const float rm=rm0_; resc=false; \
    { const float dl=rm; mhat=fadd_s(mhat,dl); \
      _Pragma("unroll") for(int r=0;r<16;++r){P0[r]=fsub_s(P0[r],dl);P1[r]=fsub_s(P1[r],dl);} \
      _Pragma("unroll") for(int r=0;r<16;++r)negm[r]=-mhat; asm volatile("":"+v"(negm)); } \
    _Pragma("unroll") for(int r=0;r<16;++r)P0[r]=__builtin_amdgcn_exp2f(P0[r]); }while(0)
  #define RESC() do{ if(resc){ asm volatile("s_waitcnt lgkmcnt(0)":::"memory"); \
      _Pragma("unroll") for(int d_=0;d_<2;++d_) _Pragma("unroll") for(int r=0;r<16;++r)o[d_][r]*=wsf[crow(r,hi)]; } }while(0)
  f32x16 pA0,pA1,pB0,pB1;
  int sl_prev=0,sl_cur=0,sl_next=SLOTB;
  #define ROT() do{sl_prev=sl_cur;sl_cur=sl_next;sl_next=(sl_next==(NSLOT-1)*SLOTB)?0:sl_next+SLOTB;}while(0)
  DMA_K(2,2*SLOTB);
  WAIT_BAR(3);
  qkt(pA0,pA1,Kbase,qr,negm,r32,hi);asm volatile("s_nop 15\n\ts_nop 7":"+v"(pA0),"+v"(pA1));const float rm0_=rowmax(pA0,pA1);
  ALIBI(pA0,pA1,0);CMASK(pA0,pA1,0);
  START(pA0,pA1);
  _Pragma("unroll") for(int r=0;r<16;++r)pA1[r]=__builtin_amdgcn_exp2f(pA1[r]);
  WAIT_BAR(0);
  DMA_K(3,0);DMA_V(1,SLOTB);
  ROT();
  kload8(kf,kp0+sl_cur);
  WAIT_BAR(2);
  s16x4 vlo[8],vhi[8]; u32x4 pw0,pw1,pw2,pw3;
  #define PKW(P,B) cvtpk_s(P[B],P[B+1])
  #define PAF(k) __builtin_bit_cast(bf16x8,pw##k)
  #define VFR(i) (bf16x8){vlo[i][0],vlo[i][1],vlo[i][2],vlo[i][3],vhi[i][0],vhi[i][1],vhi[i][2],vhi[i][3]}
  #define PIN(x) asm volatile("":"+v"(x))
  #define MX3(a,b,c) __builtin_fmaxf(__builtin_fmaxf((a),(b)),(c))
  #define GAPA(MF,A0,A1,A2,A3,W0,W1,PW) do{ MF; sacc+=A0; sacc+=A1; sacc+=A2; sacc+=A3; PIN(sacc); W0; W1; PIN(PW); SBAR(); }while(0)
  #define EX(v) __builtin_amdgcn_exp2f(v)
  #define GAPB(MF,X,B) do{ MF; X[B]=EX(X[B]); X[B+1]=EX(X[B+1]); X[B+2]=EX(X[B+2]); X[B+3]=EX(X[B+3]); PIN(X); SBAR(); }while(0)
  #define VRD(i) do{ vlo[i]=vtr(vp_+(((i)>>2)*4096+((i)&3)*1024)); vhi[i]=vtr(vp_+(((i)>>2)*4096+((i)&3)*1024+512)); }while(0)
  #define KRD(G,j) do{ if(G){ kload2(kf,kp0+sl_next,j); SBAR(); } }while(0)
  #define STEP(C0,C1,P0,P1,t,GK,GV,GL) do{ SBAR(); \
    const lds_cptr vp_=vp0+sl_prev; \
    VRD(0); SBAR(); float sacc=(P0[0]+P0[1]); \
    GAPA(C0=__builtin_amdgcn_mfma_f32_32x32x16_bf16(kf[0],qr[0],negm,0,0,0), P0[2],P0[3],P0[4],P0[5],     pw0[0]=PKW(P0,0), pw0[1]=PKW(P0,2), pw0); \
    VRD(4); SBAR(); GAPA(C1=__builtin_amdgcn_mfma_f32_32x32x16_bf16(kf[1],qr[0],negm,0,0,0), P0[6],P0[7],P0[8],P0[9],     pw0[2]=PKW(P0,4), pw0[3]=PKW(P0,6), pw0); \
    VRD(1); SBAR(); GAPA(C0=__builtin_amdgcn_mfma_f32_32x32x16_bf16(kf[2],qr[1],C0,0,0,0),   P0[10],P0[11],P0[12],P0[13], pw1[0]=PKW(P0,8), pw1[1]=PKW(P0,10), pw1); \
    VRD(5); SBAR(); GAPA(C1=__builtin_amdgcn_mfma_f32_32x32x16_bf16(kf[3],qr[1],C1,0,0,0),   P0[14],P0[15],P1[0],P1[1],   pw1[2]=PKW(P0,12),pw1[3]=PKW(P0,14), pw1); \
    VRD(2); SBAR(); GAPA(C0=__builtin_amdgcn_mfma_f32_32x32x16_bf16(kf[4],qr[2],C0,0,0,0),   P1[2],P1[3],P1[4],P1[5],     pw2[0]=PKW(P1,0), pw2[1]=PKW(P1,2), pw2); \
    VRD(6); SBAR(); GAPA(C1=__builtin_amdgcn_mfma_f32_32x32x16_bf16(kf[5],qr[2],C1,0,0,0),   P1[6],P1[7],P1[8],P1[9],     pw2[2]=PKW(P1,4), pw2[3]=PKW(P1,6), pw2); \
    VRD(3); SBAR(); GAPA(C0=__builtin_amdgcn_mfma_f32_32x32x16_bf16(kf[6],qr[3],C0,0,0,0),   P1[10],P1[11],P1[12],P1[13], pw3[0]=PKW(P1,8), pw3[1]=PKW(P1,10), pw3); \
    VRD(7); SBAR(); GAPA(C1=__builtin_amdgcn_mfma_f32_32x32x16_bf16(kf[7],qr[3],C1,0,0,0),   P1[14],P1[15],0.f,0.f,       pw3[2]=PKW(P1,12),pw3[3]=PKW(P1,14), pw3); \
    l_reg+=sacc; \
    if(GK){DMA_K((t)+3,sl_cur);} if(GV){DMA_V((t)+1,sl_next);} \
    ALIBI(C0,C1,t); CMASK(C0,C1,t); \
    { float a=MX3(C0[0],C0[1],C1[0]),b=MX3(C0[2],C0[3],C1[1]); a=MX3(a,C1[2],C1[3]); \
      _Pragma("unroll") for(int r=4;r<16;r+=4){a=MX3(a,C0[r],C0[r+1]);b=MX3(b,C0[r+2],C0[r+3]);a=MX3(a,C1[r],C1[r+1]);b=MX3(b,C1[r+2],C1[r+3]);} \
      float rm=__builtin_fmaxf(a,b); { auto rr=__builtin_amdgcn_permlane32_swap(__float_as_uint(rm),__float_as_uint(rm),false,false); rm=__builtin_fmaxf(__uint_as_float(rr[0]),__uint_as_float(rr[1])); } \
      resc=false; \
      if(__builtin_expect(__any(rm>(float)THRL),0)){ const float dl=__builtin_fmaxf(rm,0.f); mhat+=dl; \
        _Pragma("unroll") for(int r=0;r<16;++r){C0[r]-=dl;C1[r]-=dl;} \
        _Pragma("unroll") for(int r=0;r<16;++r)negm[r]=-mhat; asm volatile("":"+v"(negm)); \
        const float f=__builtin_amdgcn_exp2f(-dl); l_reg*=f; if(hi==0)wsf[r32]=f; resc=true; } } \
    SBAR(); \
    GAPB(o[0]=__builtin_amdgcn_mfma_f32_32x32x16_bf16(PAF(0),VFR(0),o[0],0,0,0), C0,0); \
    GAPB(o[1]=__builtin_amdgcn_mfma_f32_32x32x16_bf16(PAF(0),VFR(4),o[1],0,0,0), C0,4); \
    KRD(GL,0); GAPB(o[0]=__builtin_amdgcn_mfma_f32_32x32x16_bf16(PAF(1),VFR(1),o[0],0,0,0), C0,8); \
    KRD(GL,1); GAPB(o[1]=__builtin_amdgcn_mfma_f32_32x32x16_bf16(PAF(1),VFR(5),o[1],0,0,0), C0,12); \
    KRD(GL,2); GAPB(o[0]=__builtin_amdgcn_mfma_f32_32x32x16_bf16(PAF(2),VFR(2),o[0],0,0,0), C1,0); \
    KRD(GL,3); GAPB(o[1]=__builtin_amdgcn_mfma_f32_32x32x16_bf16(PAF(2),VFR(6),o[1],0,0,0), C1,4); \
    GAPB(o[0]=__builtin_amdgcn_mfma_f32_32x32x16_bf16(PAF(3),VFR(3),o[0],0,0,0), C1,8); \
    GAPB(o[1]=__builtin_amdgcn_mfma_f32_32x32x16_bf16(PAF(3),VFR(7),o[1],0,0,0), C1,12); \
    }while(0)
  int t=1;
  #undef CMASK
  #define CMASK(P0,P1,t) do{}while(0)
  for(;t+5<NT;t+=2){
    STEP(pB0,pB1,pA0,pA1,t,true,true,true);     WAIT_BAR(2); RESC(); ROT();
    STEP(pA0,pA1,pB0,pB1,t+1,true,true,true);   WAIT_BAR(2); RESC(); ROT();
  }
  #undef CMASK
  #define CMASK(P0,P1,t) do{ if(MODE==0){int jb_=(t)-(NT-4); if(jb_>=0)cmask_blk(P0,P1,jb_,wid);} }while(0)
  #define ENDW(tt) do{ if((tt)+3<NT){WAIT_BAR(2);} else if((tt)+2<NT){WAIT_BAR(1);} else {WAIT_BAR(0);} }while(0)
  for(;t+1<NT;t+=2){
    STEP(pB0,pB1,pA0,pA1,t,(t+3<NT),(t+1<NT),(t+1<NT));       ENDW(t);   RESC(); ROT();
    STEP(pA0,pA1,pB0,pB1,t+1,(t+4<NT),(t+2<NT),(t+2<NT));     ENDW(t+1); RESC(); ROT();
  }
  STEP(pB0,pB1,pA0,pA1,NT-1,false,false,false); RESC();
  { float sacc=pB0[0]+pB0[1]; _Pragma("unroll") for(int r=2;r<16;++r)sacc+=pB0[r]; _Pragma("unroll") for(int r=0;r<16;++r)sacc+=pB1[r]; l_reg+=sacc;
    pw0=(u32x4){PKW(pB0,0),PKW(pB0,2),PKW(pB0,4),PKW(pB0,6)};pw1=(u32x4){PKW(pB0,8),PKW(pB0,10),PKW(pB0,12),PKW(pB0,14)};pw2=(u32x4){PKW(pB1,0),PKW(pB1,2),PKW(pB1,4),PKW(pB1,6)};pw3=(u32x4){PKW(pB1,8),PKW(pB1,10),PKW(pB1,12),PKW(pB1,14)};
    SBAR(); pv(o,vb0+sl_cur,PAF(0),PAF(1),PAF(2),PAF(3)); }
  #undef PKW
  #undef PAF
  #undef VFR
  #undef PIN
  #undef MX3
  #undef GAPA
  #undef GAPB
  #undef EX
  #undef VRD
  #undef KRD
  #undef STEP
  #undef ENDW
  {auto rr=__builtin_amdgcn_permlane32_swap(__float_as_uint(l_reg),__float_as_uint(l_reg),false,false);l_reg=__uint_as_float(rr[0])+__uint_as_float(rr[1]);}
  if(hi==0)wsf[32+r32]=l_reg;asm volatile("s_waitcnt lgkmcnt(0)":::"memory");
  float rli[16];
  #pragma unroll
  for(int r=0;r<16;++r)rli[r]=__builtin_amdgcn_rcpf(wsf[32+crow(r,hi)]);
  bf16*Ow=Ob+(long)(wid*QBLK)*op;
  { bf16*stg=(bf16*)(shm+LDS_OST)+wid*2048;
    #pragma unroll
    for(int r=0;r<16;++r){const int orow=crow(r,hi);
      #pragma unroll
      for(int d0=0;d0<2;++d0)stg[orow*64+d0*32+r32]=__float2bfloat16(o[d0][r]*rli[r]);}
    asm volatile("s_waitcnt lgkmcnt(0)":::"memory");
    #pragma unroll
    for(int i=0;i<4;++i){const int row=i*8+(lane>>3),ch=lane&7; const u32x4 v=*(const u32x4*)(stg+row*64+ch*8); ATTN_STORE16(Ow+(long)row*op+ch*8,v);} }
  asm volatile("s_waitcnt lgkmcnt(0)\n\ts_barrier":::"memory");
  #undef DMA_K
  #undef DMA_V
  #undef CMASK
  #undef ALIBI
  #undef START
  #undef RESC
  #undef ROT
}
constexpr int ATTN_LDS_BYTES=LDS_BYTES;
#undef SBAR
#undef WAIT_BAR
}
constexpr int T = 32768, D = 1024, NB = 8, S = 4096, MEML = 256;
constexpr int AIN = 2560, BIN = 3328, FFD = 2816, FFE = 3584, NE = 8, DAW = 768;
constexpr float EPS = 1e-6f;
constexpr float C2 = 0.125f * 1.4426950408889634f;
constexpr int MAXROWS = 2 * T + NE * 256;
constexpr int NWAVES = 8;
constexpr float SC_X = 16.f, SC_WGU = 64.f, SC_H = 8.f, SC_WDN = 256.f;
constexpr size_t MiB = 1u << 20;
constexpr size_t WS_CTL = 0, CTL_ZERO_BYTES = 1 * MiB;
constexpr size_t WS_WINA = 2 * MiB, WS_WOUT = 12 * MiB, WS_WINB = 20 * MiB, WS_WMKV = 33 * MiB, WS_WGUD = 37 * MiB, WS_WDND = 59 * MiB, WS_WGUM = 70 * MiB, WS_WDNM = 294 * MiB;
constexpr size_t WS_MEMN = 406 * MiB, WS_MKV = 422 * MiB, WS_XN = 430 * MiB, WS_OC = 494 * MiB, WS_ROUTE = 558 * MiB, WS_BIG = 560 * MiB, WS_XG = 1072 * MiB, WS_Y = 1204 * MiB, WS_SSQP = 1362 * MiB, WS_END = 1372 * MiB;
constexpr size_t WS_SLOC = WS_XG, WS_SIN = WS_XG + 192 * MiB;
constexpr size_t WS_FS = 1600 * MiB;
constexpr int CW_TMO = 0, CW_CODE = 1, CW_BAR = 4096, CW_GCNT = 8192, CW_N2 = 65536;
constexpr int RING_OFF = 0, RING_BYTES = 131072;
constexpr int LDSCTL_OFF = RING_BYTES, MISC_OFF = LDSCTL_OFF + 320;
constexpr int LDS_BYTES = 147456;
static_assert(MISC_OFF + 128 <= LDS_BYTES, "LDS map");
#ifndef MK_DBG
#define MK_DBG 0
#endif
#ifndef MK_DUP
#define MK_DUP 0
#endif
#ifndef MK_TS
#define MK_TS 0
#endif
#ifndef MK_TS_A
#define MK_TS_A 0
#endif
#ifndef MK_TS_B
#define MK_TS_B 0
#endif
__constant__ unsigned char ATT_DEAL[8][12] = {{3, 5, 13, 27, 32, 43, 63, 67, 75, 85, 86, 89}, {6, 14, 18, 20, 28, 36, 39, 40, 44, 64, 79, 91}, {7, 15, 25, 34, 35, 53, 54, 57, 58, 74, 80, 95}, {1, 8, 21, 29, 45, 50, 52, 55, 56, 62, 65, 76},
    {9, 17, 22, 30, 46, 66, 68, 71, 72, 78, 81, 92}, {0, 10, 26, 33, 51, 59, 69, 70, 73, 82, 90, 94}, {2, 4, 12, 16, 23, 31, 47, 61, 84, 87, 88, 93}, {11, 19, 24, 37, 38, 41, 42, 48, 49, 60, 77, 83}};
#define GAS __attribute__((address_space(1)))
#define LAS __attribute__((address_space(3)))
typedef unsigned short bf16;
typedef unsigned v4u __attribute__((ext_vector_type(4)));
typedef unsigned v2u __attribute__((ext_vector_type(2)));
typedef float f32x4 __attribute__((ext_vector_type(4)));
typedef short bf16x8 __attribute__((ext_vector_type(8)));
typedef GAS unsigned gu32;
typedef GAS unsigned long long gu64;
#define RLX_AGENT __ATOMIC_RELAXED, __HIP_MEMORY_SCOPE_AGENT
#define LDS_WAIT() asm volatile("s_waitcnt lgkmcnt(0)" ::: "memory")
#define VM_WAIT() asm volatile("s_waitcnt vmcnt(0)" ::: "memory")
__device__ __forceinline__ unsigned long long rt() { return __builtin_amdgcn_s_memrealtime(); }
__device__ __forceinline__ unsigned f2bf(float f) { unsigned u = __builtin_bit_cast(unsigned, f); return (u + 0x7fffu + ((u >> 16) & 1u)) >> 16; }
__device__ __forceinline__ unsigned pk2(float lo, float hi) { return f2bf(lo) | (f2bf(hi) << 16); }

#define XB_TMO      128
#define XB_XCNT(j)  (256  + 64 * (j))
#define XB_XSUB(j)  (1280 + 64 * (j))
#define XB_XGEN(j)  (2304 + 64 * (j))
#define XB_TOP      3328
#define XB_TOPGEN   3392
#define XCD_BAR_WORDS 3456
#define XB_SPIN_CAP (1u << 18)

__device__ __forceinline__ unsigned xb_ld(unsigned* p)              { return __hip_atomic_load(p, __ATOMIC_RELAXED, __HIP_MEMORY_SCOPE_AGENT); }
__device__ __forceinline__ unsigned xb_add(unsigned* p, unsigned v) { return __hip_atomic_fetch_add(p, v, __ATOMIC_RELAXED, __HIP_MEMORY_SCOPE_AGENT); }
__device__ __forceinline__ unsigned xb_xcc_id() { return (unsigned)__builtin_amdgcn_s_getreg((3 << 11) | 20) & 0xFu; }
#define XB_SPIN(cond, bar) do { unsigned _sp = 0; while (cond) { __builtin_amdgcn_s_sleep(1); \
    if ((++_sp & 255u) == 0u) { if (xb_ld(&(bar)[XB_TMO])) break; if (_sp > XB_SPIN_CAP) { atomicAdd(&(bar)[XB_TMO], 1u); break; } } } } while (0)

struct XcdBarrier {
    unsigned* bar; unsigned x; int wave;
    volatile LAS unsigned* st;
};

__device__ __forceinline__ XcdBarrier xcd_barrier_post(unsigned* bar, volatile LAS unsigned* st) {
    XcdBarrier b; b.bar = bar; b.x = xb_xcc_id(); b.st = st; b.wave = __builtin_amdgcn_readfirstlane((int)(threadIdx.x >> 6));
    if (threadIdx.x == 0) (void)xb_add(&bar[XB_XCNT(b.x)], 1u);
    return b;
}
__device__ __forceinline__ void xcd_barrier_complete(unsigned* bar, unsigned x, unsigned& nloc, unsigned& nx) {
    const unsigned G = gridDim.x * gridDim.y * gridDim.z;
    unsigned sum, cnt, mine, sp = 0u;
    for (;;) {
        sum = 0u; cnt = 0u; mine = 0u;
#pragma unroll
        for (unsigned j = 0; j < 16; ++j) { const unsigned c = xb_ld(&bar[XB_XCNT(j)]); sum += c; cnt += (c > 0u) ? 1u : 0u; mine = (j == x) ? c : mine; }
        if (sum == G) break;
        __builtin_amdgcn_s_sleep(1);
        if ((++sp & 255u) == 0u) { if (xb_ld(&bar[XB_TMO])) break; if (sp > XB_SPIN_CAP) { atomicAdd(&bar[XB_TMO], 1u); break; } }
    }
    nloc = mine > 0u ? mine : 1u; nx = cnt > 0u ? cnt : 1u;
}

__device__ __forceinline__ void xcd_barrier(const XcdBarrier& b) {
    asm volatile("s_waitcnt vmcnt(0)" ::: "memory");
    __syncthreads();
    int l0_; asm volatile("v_mbcnt_lo_u32_b32 %0, -1, 0\n\tv_mbcnt_hi_u32_b32 %0, -1, %0" : "=v"(l0_));
    if (b.wave == 0 && l0_ == 0) {
        unsigned* bar = b.bar;
        __builtin_amdgcn_s_waitcnt(0);
        unsigned nloc = b.st[0], nx = b.st[1];
        if (nloc == 0u) { xcd_barrier_complete(bar, b.x, nloc, nx); b.st[0] = nloc; b.st[1] = nx; }
        const unsigned old = xb_add(&bar[XB_XSUB(b.x)], 1u);
        const unsigned gen = old / nloc;
        if (old + 1u == (gen + 1u) * nloc) {
            __builtin_amdgcn_fence(__ATOMIC_RELEASE, "agent");
            asm volatile("s_waitcnt vmcnt(0)" ::: "memory");
            const unsigned og = xb_add(&bar[XB_TOP], 1u);
            const unsigned tg = og / nx;
            if (og + 1u == (tg + 1u) * nx) xb_add(&bar[XB_TOPGEN], 1u);
            else XB_SPIN(xb_ld(&bar[XB_TOPGEN]) == tg, bar);
            __builtin_amdgcn_fence(__ATOMIC_ACQUIRE, "agent");
            xb_add(&bar[XB_XGEN(b.x)], 1u);
            asm volatile("s_waitcnt vmcnt(0)" ::: "memory");
        } else {
            XB_SPIN(xb_ld(&bar[XB_XGEN(b.x)]) == gen, bar);
            __builtin_amdgcn_fence(__ATOMIC_ACQUIRE, "agent");
            asm volatile("s_waitcnt vmcnt(0)" ::: "memory");
        }
    }
    __syncthreads();
}
struct InTab { const LAS unsigned long long* t;
    __device__ __forceinline__ const float* operator[](int k) const { const unsigned long long v = t[k];
        return (const float*)(((unsigned long long)(unsigned)__builtin_amdgcn_readfirstlane((int)(v >> 32)) << 32) | (unsigned)__builtin_amdgcn_readfirstlane((int)(unsigned)v)); } };
struct Frame {
    LAS unsigned char* lds;
    volatile LAS unsigned* MISC;
    gu32* ctl;
    int wave;
    int vcu, G, bx;
    GAS unsigned char* ws;
    InTab in;
    GAS float* out;
    float ts_scale, ts_add;
};
__device__ __forceinline__ float xor_get(float v, int lane, int o) { return __builtin_bit_cast(float, __builtin_amdgcn_ds_bpermute((lane ^ o) << 2, __builtin_bit_cast(int, v))); }
__device__ __forceinline__ float half_sum(float v, int lane) {
#pragma unroll
    for (int o = 1; o < 32; o <<= 1) v += xor_get(v, lane, o);
    return v; }
__device__ __forceinline__ float wave_sum(float v, int lane) { v = half_sum(v, lane); return v + xor_get(v, lane, 32); }
__device__ __forceinline__ int launder(int v) { asm volatile("" : "+v"(v)); return v; }
__device__ __forceinline__ int fresh_lane() { int l; asm volatile("v_mbcnt_lo_u32_b32 %0, -1, 0\n\tv_mbcnt_hi_u32_b32 %0, -1, %0" : "=v"(l)); return l; }
__device__ __forceinline__ float bf_lo(unsigned u) { return __builtin_bit_cast(float, u << 16); }
__device__ __forceinline__ float bf_hi(unsigned u) { return __builtin_bit_cast(float, u & 0xffff0000u); }
#if MK_DBG
__device__ __forceinline__ void dbg_sample_f32(Frame& F, int lane, int slot, int row, const f32x4 (&v)[4]) {
    float* d = (float*)(F.ws + WS_FS) + ((size_t)slot * 1024 + (row >> 5)) * 1024;
#pragma unroll
    for (int j = 0; j < 4; ++j) ((f32x4*)d)[lane + 64 * j] = v[j];
}
#endif
__device__ __forceinline__ int swiglu_row(int n, int ff) { const int bj = n >= ff ? 1 : 0, cc = n - bj * ff; return 256 * (cc >> 7) + 128 * bj + (cc & 127); }
template <bool F8>
__device__ __forceinline__ void transpose_item(const float* W, int K, int N, void* WT, int ff, float scale, LAS float* scr, int item, int lane) {
    const int nblk = N / 64, kb = item / nblk, nb = item % nblk, k0 = 64 * kb, n0 = 64 * nb;
    const int r0 = ff ? swiglu_row(n0, ff) : n0;
    float v[64];
    const GAS float* wp = (const GAS float*)W + (size_t)k0 * N + n0 + lane;
#pragma unroll
    for (int i = 0; i < 64; ++i) v[i] = wp[(size_t)i * N];
#pragma unroll
    for (int i = 0; i < 64; ++i) scr[i * 64 + (lane ^ (i & 31))] = v[i];
    LDS_WAIT(); asm volatile("" ::: "memory");
    const int c = lane & 7;
#pragma unroll
    for (int j = 0; j < 8; ++j) { const int n = (lane >> 3) + 8 * j; float s[8];
#pragma unroll
        for (int i = 0; i < 8; ++i) s[i] = scr[(8 * c + i) * 64 + (n ^ ((8 * c + i) & 31))];
        if (F8) { v2u o; o.x = pg8::pk4_fp8(s[0] * scale, s[1] * scale, s[2] * scale, s[3] * scale); o.y = pg8::pk4_fp8(s[4] * scale, s[5] * scale, s[6] * scale, s[7] * scale);
            *(GAS v2u*)((unsigned char*)WT + (size_t)(r0 + n) * K + k0 + 8 * c) = o; }
        else { v4u o; o.x = pg8::cvt_pk_bf16(s[0], s[1]); o.y = pg8::cvt_pk_bf16(s[2], s[3]); o.z = pg8::cvt_pk_bf16(s[4], s[5]); o.w = pg8::cvt_pk_bf16(s[6], s[7]);
            *(GAS v4u*)((bf16*)WT + (size_t)(r0 + n) * K + k0 + 8 * c) = o; } }
    LDS_WAIT(); asm volatile("" ::: "memory");
}
__device__ __forceinline__ void rms_row_to_bf16(int lane, const float* xrow, const float* gain, bf16* orow) {
    const GAS f32x4* xr = (const GAS f32x4*)xrow + lane;
    f32x4 v[4]; float s = 0.f;
#pragma unroll
    for (int j = 0; j < 4; ++j) { v[j] = xr[64 * j]; s += (v[j].x * v[j].x + v[j].y * v[j].y) + (v[j].z * v[j].z + v[j].w * v[j].w); }
    const float rstd = 1.f / sqrtf(wave_sum(s, lane) * (1.f / D) + EPS);
    GAS unsigned long long* o8 = (GAS unsigned long long*)orow + lane;
#pragma unroll
    for (int j = 0; j < 4; ++j) { const f32x4 g = ((const GAS f32x4*)gain)[lane + 64 * j];
        o8[64 * j] = (unsigned long long)pk2(v[j].x * rstd * g.x, v[j].y * rstd * g.y) | ((unsigned long long)pk2(v[j].z * rstd * g.z, v[j].w * rstd * g.w) << 32); }
}
__device__ __forceinline__ void phase_prologue(Frame& F) {
    const int lane = fresh_lane(), tid = F.wave * 64 + lane; (void)tid;
    LAS float* scr = (LAS float*)(F.lds + RING_OFF + F.wave * 16384);
    const int gw = F.vcu * NWAVES + F.wave, NGW = F.G * NWAVES;
    constexpr int I_AIN = 16 * (AIN / 64), I_MKV = 16 * 8, I_OUT = 16 * 16, I_BIN = 16 * (BIN / 64), I_GUD = 16 * (2 * FFD / 64), I_DND = (FFD / 64) * 16, I_GUM = 16 * (2 * FFE / 64), I_DNM = (FFE / 64) * 16;
    constexpr int NITEMS = 2 * I_AIN + 4 * I_MKV + 4 * I_OUT + 2 * I_BIN + 2 * I_GUD + 2 * I_DND + 16 * I_GUM + 16 * I_DNM;
    for (int it = NITEMS - 1 - gw; it >= 0; it -= NGW) {
        int r = it; const float* src; bf16* dst; int K = D, N, ff = 0;
        if (r < 2 * I_AIN) { const int j = r / I_AIN; r %= I_AIN; N = AIN; src = F.in[3] + (size_t)j * D * AIN; dst = (bf16*)(F.ws + WS_WINA) + (size_t)j * AIN * D; }
        else if ((r -= 2 * I_AIN) < 4 * I_MKV) { const int l = r / I_MKV; r %= I_MKV; N = 512; src = F.in[(l & 1) ? 17 : 10] + (size_t)(l >> 1) * D * 512; dst = (bf16*)(F.ws + WS_WMKV) + (size_t)l * 512 * D; }
        else if ((r -= 4 * I_MKV) < 4 * I_OUT) { const int l = r / I_OUT; r %= I_OUT; N = D; src = F.in[(l & 1) ? 18 : 11] + (size_t)(l >> 1) * D * D; dst = (bf16*)(F.ws + WS_WOUT) + (size_t)l * D * D; }
        else if ((r -= 4 * I_OUT) < 2 * I_BIN) { const int j = r / I_BIN; r %= I_BIN; N = BIN; src = F.in[13] + (size_t)j * D * BIN; dst = (bf16*)(F.ws + WS_WINB) + (size_t)j * BIN * D; }
        else if ((r -= 2 * I_BIN) < 2 * I_GUD) { const int j = r / I_GUD; r %= I_GUD; N = 2 * FFD; ff = FFD; src = F.in[20] + (size_t)j * D * 2 * FFD; dst = (bf16*)(F.ws + WS_WGUD) + (size_t)j * 2 * FFD * D; }
        else if ((r -= 2 * I_GUD) < 2 * I_DND) { const int j = r / I_DND; r %= I_DND; K = FFD; N = D; src = F.in[21] + (size_t)j * FFD * D; dst = (bf16*)(F.ws + WS_WDND) + (size_t)j * D * FFD; }
        else if ((r -= 2 * I_DND) < 16 * I_GUM) { const int j = r / I_GUM; r %= I_GUM;
            transpose_item<true>(F.in[24] + (size_t)j * D * 2 * FFE, D, 2 * FFE, (void*)(F.ws + WS_WGUM + (size_t)j * 2 * FFE * D), FFE, SC_WGU, scr, r, lane); continue; }
        else { r -= 16 * I_GUM; const int j = r / I_DNM; r %= I_DNM;
            transpose_item<true>(F.in[25] + (size_t)j * FFE * D, FFE, D, (void*)(F.ws + WS_WDNM + (size_t)j * D * FFE), 0, SC_WDN, scr, r, lane); continue; }
        transpose_item<false>(src, K, N, dst, ff, 1.f, scr, r, lane);
    }
    for (int m = gw; m < 4 * NB * MEML; m += NGW) { const int l = m / (NB * MEML), r = m % (NB * MEML);
        rms_row_to_bf16(lane, F.in[1] + (size_t)r * D, F.in[(l & 1) ? 16 : 9] + (size_t)(l >> 1) * D, (bf16*)(F.ws + WS_MEMN) + (size_t)m * D); }
    {
        const float* x0 = F.in[0]; const float* g0 = F.in[2]; bf16* XN = (bf16*)(F.ws + WS_XN);
        f32x4 gq[4];
#pragma unroll
        for (int j = 0; j < 4; ++j) gq[j] = ((const GAS f32x4*)g0)[lane + 64 * j];
        for (int m0 = gw * 4; m0 < T; m0 += NGW * 4) { f32x4 v[4][4]; float ss[4];
#pragma unroll
            for (int r = 0; r < 4; ++r) { const GAS f32x4* xr = (const GAS f32x4*)(x0 + (size_t)(m0 + r) * D) + lane;
#pragma unroll
                for (int j = 0; j < 4; ++j) v[r][j] = xr[64 * j]; }
#pragma unroll
            for (int r = 0; r < 4; ++r) { float sq = 0.f;
#pragma unroll
                for (int j = 0; j < 4; ++j) sq += (v[r][j].x * v[r][j].x + v[r][j].y * v[r][j].y) + (v[r][j].z * v[r][j].z + v[r][j].w * v[r][j].w);
                ss[r] = sq; }
#pragma unroll
            for (int o = 1; o < 64; o <<= 1) {
#pragma unroll
                for (int r = 0; r < 4; ++r) ss[r] += xor_get(ss[r], lane, o); }
#pragma unroll
            for (int r = 0; r < 4; ++r) { const float rstd = 1.f / sqrtf(ss[r] * (1.f / D) + EPS); GAS unsigned long long* o8 = (GAS unsigned long long*)(XN + (size_t)(m0 + r) * D) + lane;
#pragma unroll
                for (int j = 0; j < 4; ++j) o8[64 * j] = (unsigned long long)pk2(v[r][j].x * rstd * gq[j].x, v[r][j].y * rstd * gq[j].y) | ((unsigned long long)pk2(v[r][j].z * rstd * gq[j].z, v[r][j].w * rstd * gq[j].w) << 32); } }
    }
    if (F.bx == 0) { float* LBT = (float*)(F.ws + WS_ROUTE + 1024 * 1024);
        for (int i = tid; i < DAW; i += NWAVES * 64) { LBT[i] = 0.f; LBT[DAW + i] = 1.f / (1.f + __expf(F.in[14][i] - F.in[14][DAW + i])); } }
}
template <bool COMBINE, bool ROUTER, bool FINAL>
__device__ __forceinline__ void phase_norm(Frame& F, const float* src, float* X, const float* gain, const float* wr, gu32* gcnt, int dbg_slot) {
    const int lane = fresh_lane(), tid = F.wave * 64 + lane; (void)tid;
    bf16* XN = (bf16*)(F.ws + WS_XN); const bf16* Y = (const bf16*)(F.ws + WS_Y);
    float* TOPW = (float*)(F.ws + WS_ROUTE); int* TOKSEL = (int*)(F.ws + WS_ROUTE + 256 * 1024); const int* TOKROW = (const int*)(F.ws + WS_ROUTE + 768 * 1024);
    LAS int* cntL = (LAS int*)(F.lds + RING_OFF); LAS int* baseL = cntL + 8; LAS int* sel = cntL + 16;
    if (ROUTER) { if (tid < 8) cntL[tid] = 0; __syncthreads(); }
    for (int rb = F.bx * 128; rb < T; rb += F.G * 128) {
        int ri0 = 0, ri1 = 0; float rw0 = 0.f, rw1 = 0.f;
        if (COMBINE && lane < 16) { const int rr = rb + F.wave * 16 + lane; ri0 = TOKROW[rr * 2]; ri1 = TOKROW[rr * 2 + 1]; rw0 = TOPW[rr * 2]; rw1 = TOPW[rr * 2 + 1]; }
        f32x4 vq[2][4]; v2u yq0[2][4], yq1[2][4];
#define NORM_ISSUE(B_, I_) do { const int row_ = rb + F.wave * 16 + (I_); const GAS f32x4* xr_ = (const GAS f32x4*)(src + (size_t)row_ * D) + lane; \
            _Pragma("unroll") for (int j = 0; j < 4; ++j) vq[B_][j] = xr_[64 * j]; \
            if (COMBINE) { const int r0_ = __builtin_amdgcn_readlane(ri0, (I_)), r1_ = __builtin_amdgcn_readlane(ri1, (I_)); \
                const GAS v2u* y0_ = (const GAS v2u*)(Y + (size_t)r0_ * D) + lane; const GAS v2u* y1_ = (const GAS v2u*)(Y + (size_t)r1_ * D) + lane; \
                _Pragma("unroll") for (int j = 0; j < 4; ++j) { yq0[B_][j] = y0_[64 * j]; yq1[B_][j] = y1_[64 * j]; } } } while (0)
        NORM_ISSUE(0, 0);
        for (int i2 = 0; i2 < 16; i2 += 2) {
#pragma unroll
          for (int hb = 0; hb < 2; ++hb) {
            const int i = i2 + hb;
            if (hb == 0) NORM_ISSUE(1, i + 1); else if (i + 1 < 16) NORM_ISSUE(0, i + 1);
            const int rl = F.wave * 16 + i, row = rb + rl;
            f32x4 v[4];
#pragma unroll
            for (int j = 0; j < 4; ++j) v[j] = vq[hb][j];
            if (COMBINE) {
                const float w0 = __builtin_bit_cast(float, __builtin_amdgcn_readlane(__builtin_bit_cast(int, rw0), i)), w1 = __builtin_bit_cast(float, __builtin_amdgcn_readlane(__builtin_bit_cast(int, rw1), i));
#pragma unroll
                for (int j = 0; j < 4; ++j) { const v2u a = yq0[hb][j], b = yq1[hb][j];
                    v[j].x += w0 * bf_lo(a.x) + w1 * bf_lo(b.x); v[j].y += w0 * bf_hi(a.x) + w1 * bf_hi(b.x); v[j].z += w0 * bf_lo(a.y) + w1 * bf_lo(b.y); v[j].w += w0 * bf_hi(a.y) + w1 * bf_hi(b.y); }
                if (!FINAL) { GAS f32x4* xw = (GAS f32x4*)(X + (size_t)row * D) + lane;
#pragma unroll
                    for (int j = 0; j < 4; ++j) xw[64 * j] = v[j]; }
            }
#if MK_DBG
            if (dbg_slot >= 0 && (row & 31) == 0) dbg_sample_f32(F, lane, dbg_slot, row, v);
#endif
            float s = 0.f;
#pragma unroll
            for (int j = 0; j < 4; ++j) s += (v[j].x * v[j].x + v[j].y * v[j].y) + (v[j].z * v[j].z + v[j].w * v[j].w);
            const float rstd = 1.f / sqrtf(wave_sum(s, lane) * (1.f / D) + EPS);
#pragma unroll
            for (int j = 0; j < 4; ++j) { const f32x4 g = ((const GAS f32x4*)gain)[lane + 64 * j]; v[j].x *= rstd * g.x; v[j].y *= rstd * g.y; v[j].z *= rstd * g.z; v[j].w *= rstd * g.w; }
            if (FINAL) { GAS f32x4* ow = (GAS f32x4*)(X + (size_t)row * D) + lane;
#pragma unroll
                for (int j = 0; j < 4; ++j) ow[64 * j] = v[j];
            } else { GAS unsigned long long* o8 = (GAS unsigned long long*)(XN + (size_t)row * D) + lane;
#pragma unroll
                for (int j = 0; j < 4; ++j) o8[64 * j] = (unsigned long long)pk2(v[j].x, v[j].y) | ((unsigned long long)pk2(v[j].z, v[j].w) << 32); }
            if (ROUTER) {
                float a[8];
#pragma unroll
                for (int e = 0; e < 8; ++e) a[e] = 0.f;
#pragma unroll
                for (int j = 0; j < 4; ++j) { const GAS f32x4* wp = (const GAS f32x4*)(wr + (size_t)(lane + 64 * j) * 32);
#pragma unroll
                    for (int c = 0; c < 4; ++c) { const float xv = v[j][c]; const f32x4 w0 = wp[2 * c], w1 = wp[2 * c + 1];
                        a[0] += xv * w0.x; a[1] += xv * w0.y; a[2] += xv * w0.z; a[3] += xv * w0.w; a[4] += xv * w1.x; a[5] += xv * w1.y; a[6] += xv * w1.z; a[7] += xv * w1.w; } }
#pragma unroll
                for (int e = 0; e < 8; ++e) a[e] = wave_sum(a[e], lane);
                if (lane == 0) {
                    int e0 = 0; float v0 = a[0];
#pragma unroll
                    for (int e = 1; e < 8; ++e) if (a[e] > v0) { v0 = a[e]; e0 = e; }
                    int e1 = 0; float v1 = -3.0e38f;
#pragma unroll
                    for (int e = 0; e < 8; ++e) if (e != e0 && a[e] > v1) { v1 = a[e]; e1 = e; }
                    const float p1 = __expf(v1 - v0), inv = 1.f / (1.f + p1);
                    TOPW[row * 2] = inv; TOPW[row * 2 + 1] = p1 * inv;
                    const int q0 = __hip_atomic_fetch_add(cntL + e0, 1, __ATOMIC_RELAXED, __HIP_MEMORY_SCOPE_WORKGROUP);
                    const int q1 = __hip_atomic_fetch_add(cntL + e1, 1, __ATOMIC_RELAXED, __HIP_MEMORY_SCOPE_WORKGROUP);
                    sel[rl * 4] = e0; sel[rl * 4 + 1] = q0; sel[rl * 4 + 2] = e1; sel[rl * 4 + 3] = q1;
                }
            }
          }
        }
#undef NORM_ISSUE
        if (ROUTER) {
            __syncthreads();
            if (tid < 8) { baseL[tid] = (int)__hip_atomic_fetch_add(gcnt + tid, (unsigned)cntL[tid], __ATOMIC_RELAXED, __HIP_MEMORY_SCOPE_AGENT); }
            __syncthreads();
            if (tid < 128) { const int e0 = sel[tid * 4], e1 = sel[tid * 4 + 2]; int4 o; o.x = e0; o.y = baseL[e0] + sel[tid * 4 + 1]; o.z = e1; o.w = baseL[e1] + sel[tid * 4 + 3];
                *(int4*)(TOKSEL + (size_t)(rb + tid) * 4) = o; }
            __syncthreads();
            if (tid < 8) cntL[tid] = 0;
            __syncthreads();
        }
    }
}
__device__ __forceinline__ void phase_router(Frame& F, const float* src, const float* gain, const float* wr, gu32* gcnt, int dbg_slot) {
    const int lane = fresh_lane(), tid = F.wave * 64 + lane;
    bf16* XN = (bf16*)(F.ws + WS_XN); float* TOPW = (float*)(F.ws + WS_ROUTE); int* TOKSEL = (int*)(F.ws + WS_ROUTE + 256 * 1024);
    LAS int* cntL = (LAS int*)(F.lds + RING_OFF); LAS int* baseL = cntL + 8; LAS float* lg = (LAS float*)(cntL + 16);
    if (tid < 8) cntL[tid] = 0;
    __syncthreads();
    for (int rb = F.bx * 128; rb < T; rb += F.G * 128) {
        for (int g4 = 0; g4 < 4; ++g4) {
            const int rl0 = F.wave * 16 + 4 * g4, row0 = rb + rl0;
            f32x4 v[4][4];
#pragma unroll
            for (int r = 0; r < 4; ++r) { const GAS f32x4* xr = (const GAS f32x4*)(src + (size_t)(row0 + r) * D) + lane;
#pragma unroll
                for (int j = 0; j < 4; ++j) v[r][j] = xr[64 * j]; }
#if MK_DBG
#pragma unroll
            for (int r = 0; r < 4; ++r) if (dbg_slot >= 0 && ((row0 + r) & 31) == 0) dbg_sample_f32(F, lane, dbg_slot, row0 + r, v[r]);
#endif
            float ss[4];
#pragma unroll
            for (int r = 0; r < 4; ++r) { float s = 0.f;
#pragma unroll
                for (int j = 0; j < 4; ++j) s += (v[r][j].x * v[r][j].x + v[r][j].y * v[r][j].y) + (v[r][j].z * v[r][j].z + v[r][j].w * v[r][j].w);
                ss[r] = s; }
#pragma unroll
            for (int o = 1; o < 64; o <<= 1) {
#pragma unroll
                for (int r = 0; r < 4; ++r) ss[r] += xor_get(ss[r], lane, o); }
#pragma unroll
            for (int r = 0; r < 4; ++r) { const float rstd = 1.f / sqrtf(ss[r] * (1.f / D) + EPS);
                GAS unsigned long long* o8 = (GAS unsigned long long*)(XN + (size_t)(row0 + r) * D) + lane;
#pragma unroll
                for (int j = 0; j < 4; ++j) { const f32x4 gg = ((const GAS f32x4*)gain)[lane + 64 * j]; v[r][j].x *= rstd * gg.x; v[r][j].y *= rstd * gg.y; v[r][j].z *= rstd * gg.z; v[r][j].w *= rstd * gg.w;
                    o8[64 * j] = (unsigned long long)pk2(v[r][j].x, v[r][j].y) | ((unsigned long long)pk2(v[r][j].z, v[r][j].w) << 32); } }
            float a[32];
#pragma unroll
            for (int i = 0; i < 32; ++i) a[i] = 0.f;
#pragma unroll
            for (int j = 0; j < 4; ++j) { const GAS f32x4* wp = (const GAS f32x4*)(wr + (size_t)(lane + 64 * j) * 32);
#pragma unroll
                for (int c = 0; c < 4; ++c) { const f32x4 w0 = wp[2 * c], w1 = wp[2 * c + 1];
#pragma unroll
                    for (int r = 0; r < 4; ++r) { const float xv = v[r][j][c];
                        a[r * 8 + 0] += xv * w0.x; a[r * 8 + 1] += xv * w0.y; a[r * 8 + 2] += xv * w0.z; a[r * 8 + 3] += xv * w0.w; a[r * 8 + 4] += xv * w1.x; a[r * 8 + 5] += xv * w1.y; a[r * 8 + 6] += xv * w1.z; a[r * 8 + 7] += xv * w1.w; } } }
#define RT_STEP(S_, N_) do { const bool up_ = (lane >> (S_)) & 1; _Pragma("unroll") for (int i = 0; i < (N_); ++i) { const float keep_ = up_ ? a[2 * i + 1] : a[2 * i], send_ = up_ ? a[2 * i] : a[2 * i + 1]; a[i] = keep_ + xor_get(send_, lane, 1 << (S_)); } } while (0)
            RT_STEP(0, 16); RT_STEP(1, 8); RT_STEP(2, 4); RT_STEP(3, 2); RT_STEP(4, 1);
#undef RT_STEP
            const float lgv = a[0] + xor_get(a[0], lane, 32);
            if (lane < 32) lg[(rl0 + (lane >> 3)) * 8 + (lane & 7)] = lgv;
        }
        __syncthreads();
        int e0 = 0, e1 = 0, q0 = 0, q1 = 0;
        if (tid < 128) { float av[8];
#pragma unroll
            for (int e = 0; e < 8; ++e) av[e] = lg[tid * 8 + e];
            float v0 = av[0];
#pragma unroll
            for (int e = 1; e < 8; ++e) if (av[e] > v0) { v0 = av[e]; e0 = e; }
            float v1 = -3.0e38f;
#pragma unroll
            for (int e = 0; e < 8; ++e) if (e != e0 && av[e] > v1) { v1 = av[e]; e1 = e; }
            const float p1 = __expf(v1 - v0), inv = 1.f / (1.f + p1);
            TOPW[(rb + tid) * 2] = inv; TOPW[(rb + tid) * 2 + 1] = p1 * inv;
            q0 = __hip_atomic_fetch_add(cntL + e0, 1, __ATOMIC_RELAXED, __HIP_MEMORY_SCOPE_WORKGROUP);
            q1 = __hip_atomic_fetch_add(cntL + e1, 1, __ATOMIC_RELAXED, __HIP_MEMORY_SCOPE_WORKGROUP); }
        __syncthreads();
        if (tid < 8) { baseL[tid] = (int)__hip_atomic_fetch_add(gcnt + tid, (unsigned)cntL[tid], __ATOMIC_RELAXED, __HIP_MEMORY_SCOPE_AGENT); }
        __syncthreads();
        if (tid < 128) { int4 o; o.x = e0; o.y = baseL[e0] + q0; o.z = e1; o.w = baseL[e1] + q1; *(int4*)(TOKSEL + (size_t)(rb + tid) * 4) = o; }
        __syncthreads();
        if (tid < 8) cntL[tid] = 0;
        __syncthreads();
    }
}
__device__ __forceinline__ void phase_gather(Frame& F, const gu32* gcnt) {
    const int lane = fresh_lane(), tid = F.wave * 64 + lane; (void)tid;
    const bf16* XN = (const bf16*)(F.ws + WS_XN); unsigned char* XG = (unsigned char*)(F.ws + WS_XG);
    const int* TOKSEL = (const int*)(F.ws + WS_ROUTE + 256 * 1024); int* TOKROW = (int*)(F.ws + WS_ROUTE + 768 * 1024);
    int rbase[8]; { int t = 0;
#pragma unroll
        for (int e = 0; e < 8; ++e) { rbase[e] = t * 256; t += (__builtin_amdgcn_readfirstlane((int)__hip_atomic_load(gcnt + e, RLX_AGENT)) + 255) >> 8; } }
    const int gw = F.bx * NWAVES + F.wave, NGW = F.G * NWAVES;
    for (int row0 = gw * 4; row0 < T; row0 += NGW * 4) {
        int4 sl[4]; v4u a[4], b[4];
#pragma unroll
        for (int r = 0; r < 4; ++r) { sl[r] = *(const int4*)(TOKSEL + (size_t)(row0 + r) * 4); const GAS v4u* s = (const GAS v4u*)(XN + (size_t)(row0 + r) * D) + 2 * lane; a[r] = s[0]; b[r] = s[1]; }
#pragma unroll
        for (int r = 0; r < 4; ++r) { int d0 = sl[r].y, d1 = sl[r].w;
#pragma unroll
            for (int e = 0; e < 8; ++e) { if (sl[r].x == e) d0 += rbase[e]; if (sl[r].z == e) d1 += rbase[e]; }
            v4u o; o.x = pg8::pk4_fp8(bf_lo(a[r].x) * SC_X, bf_hi(a[r].x) * SC_X, bf_lo(a[r].y) * SC_X, bf_hi(a[r].y) * SC_X); o.y = pg8::pk4_fp8(bf_lo(a[r].z) * SC_X, bf_hi(a[r].z) * SC_X, bf_lo(a[r].w) * SC_X, bf_hi(a[r].w) * SC_X);
            o.z = pg8::pk4_fp8(bf_lo(b[r].x) * SC_X, bf_hi(b[r].x) * SC_X, bf_lo(b[r].y) * SC_X, bf_hi(b[r].y) * SC_X); o.w = pg8::pk4_fp8(bf_lo(b[r].z) * SC_X, bf_hi(b[r].z) * SC_X, bf_lo(b[r].w) * SC_X, bf_hi(b[r].w) * SC_X);
            ((GAS v4u*)(XG + (size_t)d0 * D))[lane] = o; ((GAS v4u*)(XG + (size_t)d1 * D))[lane] = o;
            if (lane == 0) { TOKROW[(row0 + r) * 2] = d0; TOKROW[(row0 + r) * 2 + 1] = d1; } }
    }
}
__device__ __forceinline__ void phase_knorm(Frame& F) {
    const int lane = fresh_lane();
    const bf16* P = (const bf16*)(F.ws + WS_BIG); float* N2 = (float*)(F.ws + WS_ROUTE + 1024 * 1024 + 8192);
    const int gw = F.bx * NWAVES + F.wave, NGW = F.G * NWAVES;
    for (int it = gw; it < NB * 24 * 64; it += NGW) { const int t = it & 63, hm = (it >> 6) % 24, b = it / (24 * 64);
        const GAS v4u* rp = (const GAS v4u*)(P + (size_t)(b * S + 64 * t + lane) * AIN + hm * 64); float ss = 0.f;
#pragma unroll
        for (int i = 0; i < 8; ++i) { const v4u w = rp[i]; const unsigned ww[4] = {w.x, w.y, w.z, w.w};
#pragma unroll
            for (int c = 0; c < 4; ++c) { const float a = bf_lo(ww[c]), b2 = bf_hi(ww[c]); ss += a * a + b2 * b2; } }
#pragma unroll
        for (int o = 1; o < 64; o <<= 1) ss = fmaxf(ss, xor_get(ss, lane, o));
        if (lane == 0) N2[it] = ss; }
}
__device__ __forceinline__ void phase_diff_combine(Frame& F, int j, float lam_init) {
    const int lane = fresh_lane(), tid = F.wave * 64 + lane; (void)tid;
    const bf16* O0 = (const bf16*)(F.ws + WS_BIG + 160 * MiB); const bf16* O1 = O0 + (size_t)T * DAW; bf16* OC = (bf16*)(F.ws + WS_OC);
    const float s1 = wave_sum(F.in[4][j * 64 + lane] * F.in[5][j * 64 + lane], lane), s2 = wave_sum(F.in[6][j * 64 + lane] * F.in[7][j * 64 + lane], lane);
    const float lam = __expf(s1) - __expf(s2) + lam_init;
    const f32x4 g = *(const GAS f32x4*)(F.in[8] + j * 128 + (lane & 31) * 4);
    const int gw = F.bx * NWAVES + F.wave, NGW = F.G * NWAVES;
    for (int row0 = gw * 4; row0 < T; row0 += NGW * 4) {
        v2u a[4][3], b[4][3];
#pragma unroll
        for (int r = 0; r < 4; ++r)
#pragma unroll
            for (int jj = 0; jj < 3; ++jj) { a[r][jj] = ((const GAS v2u*)(O0 + (size_t)(row0 + r) * DAW))[lane + 64 * jj]; b[r][jj] = ((const GAS v2u*)(O1 + (size_t)(row0 + r) * DAW))[lane + 64 * jj]; }
#pragma unroll
        for (int r = 0; r < 4; ++r)
#pragma unroll
            for (int jj = 0; jj < 3; ++jj) {
                f32x4 v; v.x = bf_lo(a[r][jj].x) - lam * bf_lo(b[r][jj].x); v.y = bf_hi(a[r][jj].x) - lam * bf_hi(b[r][jj].x); v.z = bf_lo(a[r][jj].y) - lam * bf_lo(b[r][jj].y); v.w = bf_hi(a[r][jj].y) - lam * bf_hi(b[r][jj].y);
                float ss = (v.x * v.x + v.y * v.y) + (v.z * v.z + v.w * v.w);
                ss = half_sum(ss, lane);
                const float rs = (1.f / sqrtf(ss * (1.f / 128.f) + EPS)) * (1.f - lam_init);
                ((GAS unsigned long long*)(OC + (size_t)(row0 + r) * D))[lane + 64 * jj] = (unsigned long long)pk2(v.x * rs * g.x, v.y * rs * g.y) | ((unsigned long long)pk2(v.z * rs * g.z, v.w * rs * g.w) << 32);
            }
    }
}
__device__ __forceinline__ void phase_hgrn_naive(Frame& F, int j) {
    const int lane = fresh_lane(), tid = F.wave * 64 + lane; (void)tid;
    const bf16* PB = (const bf16*)(F.ws + WS_BIG); const float* FZ = (const float*)(F.ws + WS_BIG + 208 * MiB); float* HO = (float*)(F.ws + WS_BIG + 304 * MiB);
    if (F.bx * 4 >= NB * 6) return;
    const int grp = tid >> 7, t128 = tid & 127, bh = F.bx * 4 + grp, b = bh / 6, h = bh % 6;
    LAS float* sq = (LAS float*)(F.lds + RING_OFF) + grp * (3 * 16 * 128); LAS float* sf = sq + 16 * 128; LAS float* sk = sf + 16 * 128;
    float lb = 0.f;
    if (j == 1) { const float l0 = F.in[14][h * 128 + t128], l1 = F.in[14][768 + h * 128 + t128]; lb = 1.f / (1.f + __expf(l0 - l1)); }
    float St[128];
#pragma unroll
    for (int k = 0; k < 128; ++k) St[k] = 0.f;
    for (int t0 = 0; t0 < S; t0 += 16) {
        __syncthreads();
        for (int jj = 0; jj < 16; ++jj) { const size_t row = (size_t)(b * S + t0 + jj);
            const float qv = bf_lo((unsigned)PB[row * BIN + h * 128 + t128]), fz = FZ[row * DAW + h * 128 + t128];
            const float f = lb + (1.f - lb) / (1.f + __expf(-fz));
            sq[jj * 128 + t128] = qv; sf[jj * 128 + t128] = f; sk[jj * 128 + t128] = 1.f - f; }
        __syncthreads();
        for (int jj = 0; jj < 16; ++jj) { const size_t row = (size_t)(b * S + t0 + jj);
            const float v = bf_lo((unsigned)PB[row * BIN + 1536 + h * 128 + t128]);
            float o = 0.f;
#pragma unroll
            for (int k = 0; k < 128; k += 4) { const f32x4 f4 = *(const LAS f32x4*)(sf + jj * 128 + k), k4 = *(const LAS f32x4*)(sk + jj * 128 + k), q4 = *(const LAS f32x4*)(sq + jj * 128 + k);
                St[k] = f4.x * St[k] + k4.x * v; o += q4.x * St[k]; St[k + 1] = f4.y * St[k + 1] + k4.y * v; o += q4.y * St[k + 1];
                St[k + 2] = f4.z * St[k + 2] + k4.z * v; o += q4.z * St[k + 2]; St[k + 3] = f4.w * St[k + 3] + k4.w * v; o += q4.w * St[k + 3]; }
            HO[row * DAW + h * 128 + t128] = o; }
    }
    __syncthreads();
}
__device__ __forceinline__ void phase_hgrn_out(Frame& F, int j) {
    const int lane = fresh_lane(), tid = F.wave * 64 + lane; (void)tid;
    const bf16* PB = (const bf16*)(F.ws + WS_BIG); const float* HO = (const float*)(F.ws + WS_BIG + 304 * MiB); bf16* OC = (bf16*)(F.ws + WS_OC);
    const f32x4 g = *(const GAS f32x4*)(F.in[15] + j * 128 + (lane & 31) * 4);
    const int gw = F.bx * NWAVES + F.wave, NGW = F.G * NWAVES;
    for (int row = gw; row < T; row += NGW) {
#pragma unroll
        for (int jj = 0; jj < 3; ++jj) {
            const f32x4 v = ((const GAS f32x4*)(HO + (size_t)row * DAW))[lane + 64 * jj];
            const v2u gt = ((const GAS v2u*)(PB + (size_t)row * BIN + 2304))[lane + 64 * jj];
            float ss = (v.x * v.x + v.y * v.y) + (v.z * v.z + v.w * v.w);
            ss = half_sum(ss, lane);
            const float rs = 1.f / sqrtf(ss * (1.f / 128.f) + EPS);
            ((GAS unsigned long long*)(OC + (size_t)row * D))[lane + 64 * jj] =
                (unsigned long long)pk2(v.x * rs * g.x * pg8::silu_f(bf_lo(gt.x)), v.y * rs * g.y * pg8::silu_f(bf_hi(gt.x))) | ((unsigned long long)pk2(v.z * rs * g.z * pg8::silu_f(bf_lo(gt.y)), v.w * rs * g.w * pg8::silu_f(bf_hi(gt.y))) << 32);
        }
    }
}
constexpr int HG_LD = 136, HG_LS = 72;
constexpr int HL_QB = 0, HL_QT = 17408, HL_K = 34816, HL_VT = 78336, HL_PM = 96768, HL_TOT = 105984, HL_SSQ = 110080;
constexpr size_t WS_DCH = WS_SIN + 96 * MiB;
typedef short hbf16x8 __attribute__((ext_vector_type(8)));
typedef float hf32x2 __attribute__((ext_vector_type(2)));
__device__ __forceinline__ hbf16x8 lds8(const LAS unsigned short* p) { return *(const LAS hbf16x8*)p; }
__device__ __forceinline__ float ex2(float v) { return __builtin_amdgcn_exp2f(v); }
template <int PASS>
__device__ __forceinline__ void hgrn_load(Frame& F, int tid, int unit, hf32x2 (&lf)[8], unsigned (&qw)[8], v4u& va, v4u& vb) {
    const bf16* PB = (const bf16*)(F.ws + WS_BIG); const float* LF = (const float*)(F.ws + WS_BIG + 208 * MiB);
    const int kp = tid & 63, wave = __builtin_amdgcn_readfirstlane(tid >> 6), I = wave & 3, hf = wave >> 2, r0 = 16 * I + 8 * hf;
    const int bh = unit >> 6, c = unit & 63, b = bh / 6, h = bh % 6;
    const size_t tok0 = (size_t)b * S + c * 64;
#pragma unroll
    for (int jj = 0; jj < 8; ++jj) lf[jj] = *(const GAS hf32x2*)(LF + (tok0 + r0 + jj) * DAW + h * 128 + 2 * kp);
    if (PASS == 3) {
#pragma unroll
        for (int jj = 0; jj < 8; ++jj) qw[jj] = *(const GAS unsigned*)(PB + (tok0 + r0 + jj) * BIN + h * 128 + 2 * kp); }
    { const int sp = tid >> 4, e8 = (tid & 15) * 8; va = *(const GAS v4u*)(PB + (tok0 + 2 * sp) * BIN + 1536 + h * 128 + e8); vb = *(const GAS v4u*)(PB + (tok0 + 2 * sp + 1) * BIN + 1536 + h * 128 + e8); }
}
template <int PASS>
__device__ __forceinline__ void hgrn_unit(Frame& F, int tid, int unit, int nunit, int j, hf32x2 (&lf)[8], unsigned (&qw)[8], v4u& va, v4u& vb) {
    const bf16* PB = (const bf16*)(F.ws + WS_BIG); const float* LF = (const float*)(F.ws + WS_BIG + 208 * MiB);
    bf16* SLOC = (bf16*)(F.ws + WS_SLOC); const bf16* SIN = (const bf16*)(F.ws + WS_SIN); float* DCH = (float*)(F.ws + WS_DCH); bf16* OC = (bf16*)(F.ws + WS_OC);
    LAS unsigned short* QB = (LAS unsigned short*)(F.lds + HL_QB); LAS unsigned short* QT = (LAS unsigned short*)(F.lds + HL_QT); LAS unsigned short* KK = (LAS unsigned short*)(F.lds + HL_K);
    LAS unsigned short* VT = (LAS unsigned short*)(F.lds + HL_VT); LAS unsigned short* PM = (LAS unsigned short*)(F.lds + HL_PM); LAS float* TOT = (LAS float*)(F.lds + HL_TOT); LAS float* SSQ = (LAS float*)(F.lds + HL_SSQ);
    const int kp = tid & 63, lane = kp, wave = __builtin_amdgcn_readfirstlane(tid >> 6), I = wave & 3, hf = wave >> 2, sub = 2 * I + hf, r0 = 16 * I + 8 * hf, fr = lane & 15, fg = lane >> 4;
    const int bh = unit >> 6, c = unit & 63, b = bh / 6, h = bh % 6;
    const size_t tok0 = (size_t)b * S + c * 64;
    { const int sp = tid >> 4, e8 = (tid & 15) * 8; const v4u a = va, b2 = vb;
        const unsigned wa[4] = {a.x, a.y, a.z, a.w}, wb[4] = {b2.x, b2.y, b2.z, b2.w};
#pragma unroll
        for (int i = 0; i < 4; ++i) { *(LAS unsigned*)(VT + (e8 + 2 * i) * HG_LS + 2 * sp) = (wa[i] & 0xffffu) | (wb[i] << 16); *(LAS unsigned*)(VT + (e8 + 2 * i + 1) * HG_LS + 2 * sp) = (wa[i] >> 16) | (wb[i] & 0xffff0000u); } }
    hf32x2 cs[8]; { hf32x2 run = {0.f, 0.f};
#pragma unroll
        for (int jj = 0; jj < 8; ++jj) { run += lf[jj]; cs[jj] = run; } }
    *(LAS hf32x2*)(TOT + sub * 128 + 2 * kp) = cs[7];
    __syncthreads();
    hf32x2 rho = {0.f, 0.f}, presub = {0.f, 0.f}, blast = {0.f, 0.f};
#pragma unroll
    for (int s2 = 0; s2 < 8; ++s2) { const hf32x2 t = *(const LAS hf32x2*)(TOT + s2 * 128 + 2 * kp); if (s2 < 2 * I) rho += t; if (s2 < sub) presub += t; blast += t; }
    const hf32x2 off = presub - rho;
    if (PASS == 1) {
        unsigned w0[4], w1[4];
#pragma unroll
        for (int i = 0; i < 4; ++i) { const hf32x2 ba = rho + off + cs[2 * i], bb = rho + off + cs[2 * i + 1];
            w0[i] = pg8::cvt_pk_bf16((1.f - ex2(lf[2 * i].x)) * ex2(blast.x - ba.x), (1.f - ex2(lf[2 * i + 1].x)) * ex2(blast.x - bb.x));
            w1[i] = pg8::cvt_pk_bf16((1.f - ex2(lf[2 * i].y)) * ex2(blast.y - ba.y), (1.f - ex2(lf[2 * i + 1].y)) * ex2(blast.y - bb.y)); }
        *(LAS v4u*)(KK + (2 * kp) * HG_LS + r0) = (v4u){w0[0], w0[1], w0[2], w0[3]}; *(LAS v4u*)(KK + (2 * kp + 1) * HG_LS + r0) = (v4u){w1[0], w1[1], w1[2], w1[3]};
        if (sub == 0) *(GAS hf32x2*)(DCH + (size_t)unit * 128 + 2 * kp) = (hf32x2){ex2(blast.x), ex2(blast.y)};
        __syncthreads();
        if (nunit >= 0) hgrn_load<PASS>(F, tid, nunit, lf, qw, va, vb);
        const hbf16x8 a0 = lds8(KK + (16 * wave + fr) * HG_LS + 8 * fg), a1 = lds8(KK + (16 * wave + fr) * HG_LS + 32 + 8 * fg);
#pragma unroll
        for (int et = 0; et < 8; ++et) { const hbf16x8 b0 = lds8(VT + (16 * et + fr) * HG_LS + 8 * fg), b1 = lds8(VT + (16 * et + fr) * HG_LS + 32 + 8 * fg);
            f32x4 d = {0.f, 0.f, 0.f, 0.f}; d = __builtin_amdgcn_mfma_f32_16x16x32_bf16(a0, b0, d, 0, 0, 0); d = __builtin_amdgcn_mfma_f32_16x16x32_bf16(a1, b1, d, 0, 0, 0);
            v2u w2; w2.x = pk2(d[0], d[1]); w2.y = pk2(d[2], d[3]);
            *(GAS v2u*)(SLOC + ((size_t)unit * 128 + 16 * et + fr) * 128 + 16 * wave + 4 * fg) = w2; }
        __syncthreads();
    } else {
        const hf32x2 er = {ex2(rho.x), ex2(rho.y)};
        hf32x2 base[8];
#pragma unroll
        for (int jj = 0; jj < 8; ++jj) { const hf32x2 bl = off + cs[jj]; const hf32x2 e = {ex2(bl.x), ex2(bl.y)}; const hf32x2 q = {bf_lo(qw[jj]), bf_hi(qw[jj])}; const hf32x2 qt = q * e, qb = qt * er;
            *(LAS unsigned*)(QT + (r0 + jj) * HG_LD + 2 * kp) = pg8::cvt_pk_bf16(qt.x, qt.y); *(LAS unsigned*)(QB + (r0 + jj) * HG_LD + 2 * kp) = pg8::cvt_pk_bf16(qb.x, qb.y);
            base[jj] = (hf32x2){(1.f - ex2(lf[jj].x)) * ex2(-bl.x), (1.f - ex2(lf[jj].y)) * ex2(-bl.y)}; }
        hf32x2 rr = {0.f, 0.f};
        for (int Ip = I; Ip < 4; ++Ip) { LAS unsigned short* Kp = KK + (8 * Ip * (Ip + 1)) * HG_LD;
            const hf32x2 sc = {ex2(rr.x), ex2(rr.y)};
#pragma unroll
            for (int jj = 0; jj < 8; ++jj) { const hf32x2 kv = base[jj] * sc; *(LAS unsigned*)(Kp + (r0 + jj) * HG_LD + 2 * kp) = pg8::cvt_pk_bf16(kv.x, kv.y); }
            rr += *(const LAS hf32x2*)(TOT + (2 * Ip) * 128 + 2 * kp) + *(const LAS hf32x2*)(TOT + (2 * Ip + 1) * 128 + 2 * kp); }
        __syncthreads();
        const int tt = wave & 3, eh = wave >> 2; const size_t tok = tok0 + 16 * tt + fr;
        hbf16x8 sfr[4][4]; v2u gtv[4];
#pragma unroll
        for (int et = 0; et < 4; ++et) { const int e0 = 64 * eh + 16 * et; const GAS hbf16x8* sp = (const GAS hbf16x8*)(SIN + ((size_t)unit * 128 + e0 + fr) * 128 + 8 * fg);
#pragma unroll
            for (int ks = 0; ks < 4; ++ks) sfr[et][ks] = sp[4 * ks];
            gtv[et] = *(const GAS v2u*)(PB + tok * BIN + 2304 + h * 128 + e0 + 4 * fg); }
        if (nunit >= 0) hgrn_load<PASS>(F, tid, nunit, lf, qw, va, vb);
        { const int It = wave >> 1; const LAS unsigned short* Kp = KK + (8 * It * (It + 1)) * HG_LD;
#pragma unroll
            for (int jt = 0; jt < 2; ++jt) { const int J = 2 * (wave & 1) + jt; f32x4 d = {0.f, 0.f, 0.f, 0.f};
                if (J <= It) {
#pragma unroll
                    for (int ks = 0; ks < 4; ++ks) d = __builtin_amdgcn_mfma_f32_16x16x32_bf16(lds8(QT + (16 * It + fr) * HG_LD + 32 * ks + 8 * fg), lds8(Kp + (16 * J + fr) * HG_LD + 32 * ks + 8 * fg), d, 0, 0, 0);
                    if (J == It) {
#pragma unroll
                        for (int i = 0; i < 4; ++i) if (fr > 4 * fg + i) d[i] = 0.f; }
                }
#pragma unroll
                for (int i = 0; i < 4; ++i) PM[(16 * It + 4 * fg + i) * HG_LS + 16 * J + fr] = (unsigned short)f2bf(d[i]); } }
        __syncthreads();
        f32x4 o[4];
        const hbf16x8 p0 = lds8(PM + (16 * tt + fr) * HG_LS + 8 * fg), p1 = lds8(PM + (16 * tt + fr) * HG_LS + 32 + 8 * fg);
        hbf16x8 qb[4];
#pragma unroll
        for (int ks = 0; ks < 4; ++ks) qb[ks] = lds8(QB + (16 * tt + fr) * HG_LD + 32 * ks + 8 * fg);
        float ss = 0.f;
#pragma unroll
        for (int et = 0; et < 4; ++et) { const int e0 = 64 * eh + 16 * et; f32x4 d = {0.f, 0.f, 0.f, 0.f};
            d = __builtin_amdgcn_mfma_f32_16x16x32_bf16(lds8(VT + (e0 + fr) * HG_LS + 8 * fg), p0, d, 0, 0, 0);
            d = __builtin_amdgcn_mfma_f32_16x16x32_bf16(lds8(VT + (e0 + fr) * HG_LS + 32 + 8 * fg), p1, d, 0, 0, 0);
#pragma unroll
            for (int ks = 0; ks < 4; ++ks) d = __builtin_amdgcn_mfma_f32_16x16x32_bf16(sfr[et][ks], qb[ks], d, 0, 0, 0);
            o[et] = d; ss += (d[0] * d[0] + d[1] * d[1]) + (d[2] * d[2] + d[3] * d[3]); }
        ss += xor_get(ss, lane, 16); ss += xor_get(ss, lane, 32);
        if (fg == 0) SSQ[(tt * 2 + eh) * 16 + fr] = ss;
        __syncthreads();
        const float rs = 1.f / sqrtf((SSQ[(tt * 2) * 16 + fr] + SSQ[(tt * 2 + 1) * 16 + fr]) * (1.f / 128.f) + EPS);
#pragma unroll
        for (int et = 0; et < 4; ++et) { const int e = 64 * eh + 16 * et + 4 * fg;
            const f32x4 gn = *(const GAS f32x4*)(F.in[15] + j * 128 + e); const v2u gt = gtv[et];
            v2u w; w.x = pg8::cvt_pk_bf16(o[et][0] * rs * gn.x * pg8::silu_f(bf_lo(gt.x)), o[et][1] * rs * gn.y * pg8::silu_f(bf_hi(gt.x))); w.y = pg8::cvt_pk_bf16(o[et][2] * rs * gn.z * pg8::silu_f(bf_lo(gt.y)), o[et][3] * rs * gn.w * pg8::silu_f(bf_hi(gt.y)));
            *(GAS v2u*)(OC + tok * D + h * 128 + e) = w; }
        __syncthreads();
    }
}
template <int PASS> __device__ __forceinline__ void phase_hgrn(Frame& F, int j) {
    const int tid = F.wave * 64 + fresh_lane();
    hf32x2 lf[8]; unsigned qw[8]; v4u va, vb;
#pragma unroll
    for (int i = 0; i < 8; ++i) qw[i] = 0u;
    if (F.bx < NB * 6 * 64) hgrn_load<PASS>(F, tid, F.bx, lf, qw, va, vb);
    for (int u = F.bx; u < NB * 6 * 64; u += F.G) hgrn_unit<PASS>(F, tid, u, (u + F.G < NB * 6 * 64) ? u + F.G : -1, j, lf, qw, va, vb);
}
__device__ __forceinline__ void phase_hgrn_scan(Frame& F) {
    const bf16* SLOC = (const bf16*)(F.ws + WS_SLOC); bf16* SIN = (bf16*)(F.ws + WS_SIN); const float* DCH = (const float*)(F.ws + WS_DCH);
    const int tid = F.wave * 64 + fresh_lane();
    for (int id = F.bx * (NWAVES * 64) + tid; id < NB * 6 * 128 * 64; id += F.G * NWAVES * 64) {
        const int k2 = id & 63, e = (id >> 6) & 127, bh = id >> 13;
        const GAS unsigned* sl = (const GAS unsigned*)(SLOC + ((size_t)bh * 64 * 128 + e) * 128) + k2; const GAS hf32x2* dc = (const GAS hf32x2*)(DCH + (size_t)bh * 64 * 128) + k2;
        GAS unsigned* so = (GAS unsigned*)(SIN + ((size_t)bh * 64 * 128 + e) * 128) + k2;
        hf32x2 st = {0.f, 0.f};
#pragma unroll 16
        for (int c = 0; c < 64; ++c) { const unsigned aw = sl[(size_t)c * 128 * 64]; const hf32x2 a = {bf_lo(aw), bf_hi(aw)}, d = dc[(size_t)c * 64]; so[(size_t)c * 128 * 64] = pg8::cvt_pk_bf16(st.x, st.y); st = d * st + a; }
    }
}
struct Args { const float* in[27]; float* out; unsigned char* ws; };
__global__ void __launch_bounds__(NWAVES * 64, 2) mk_fwd(Args) {
    extern __shared__ __attribute__((aligned(16))) unsigned char lds[];
    Frame F;
    F.lds = (LAS unsigned char*)lds;
    F.MISC = (volatile LAS unsigned*)(F.lds + MISC_OFF);
    F.wave = __builtin_amdgcn_readfirstlane((int)(threadIdx.x >> 6));
    F.G = gridDim.x; F.bx = blockIdx.x; { const int bx = blockIdx.x; F.vcu = (F.G % 8 == 0) ? (bx % 8) * (F.G / 8) + bx / 8 : bx; }
    for (int u = threadIdx.x; u < (LDS_BYTES - LDSCTL_OFF) / 4; u += NWAVES * 64) ((LAS unsigned*)(F.lds + LDSCTL_OFF))[u] = 0u;
    __syncthreads();
    {
        LAS unsigned long long* tab = (LAS unsigned long long*)(F.lds + LDSCTL_OFF);
        if (threadIdx.x < 29) tab[threadIdx.x] = ((const unsigned long long*)__builtin_amdgcn_kernarg_segment_ptr())[threadIdx.x];
        __syncthreads();
        F.in.t = tab; F.out = (GAS float*)(unsigned long long)F.in[27]; F.ws = (GAS unsigned char*)(unsigned long long)F.in[28]; }
    F.ctl = (gu32*)(F.ws + WS_CTL);
    XcdBarrier bar = xcd_barrier_post((unsigned*)(F.ctl + CW_BAR), F.MISC + 8);
#define XBAR_() do { XcdBarrier b_ = bar; { unsigned long long p_ = (unsigned long long)b_.bar; asm volatile("" : "+s"(p_), "+s"(b_.x)); b_.bar = (unsigned*)(GAS unsigned*)p_; } xcd_barrier(b_); if (MK_DUP & 0x8000) xcd_barrier(b_); } while (0)
#define GRID_BAR() XBAR_()
#define REP(cat) for (int rep_ = 0; rep_ < (((MK_DUP >> (cat)) & 1) ? 2 : 1); ++rep_)
#if MK_TS
    unsigned long long ts_last = rt(); unsigned ts_cat[15], ts_wb[14];
#pragma unroll
    for (int i = 0; i < 15; ++i) ts_cat[i] = 0u;
#pragma unroll
    for (int i = 0; i < 14; ++i) ts_wb[i] = 0u;
#define GRID_BAR_T(c) do { const unsigned long long arr_ = rt(); XBAR_(); const unsigned long long now_ = rt(); const unsigned dt_ = (unsigned)(arr_ - ts_last), db_ = (unsigned)(now_ - arr_); ts_last = now_; const int cc_ = (c); \
    _Pragma("unroll") for (int i_ = 0; i_ < 14; ++i_) { ts_cat[i_] += (cc_ == i_) ? dt_ : 0u; ts_wb[i_] += (cc_ == i_) ? db_ : 0u; } ts_cat[14] += db_; } while (0)
#else
#define GRID_BAR_T(c) XBAR_()
#endif

    REP(0) phase_prologue(F);
    GRID_BAR_T(0);
    {
        struct MkvOrder { int G, c; __device__ bool next(int i, pg8::Unit& u) const { const int L = i * G + c; if (L >= 64) return false; u.pm = L >> 1; u.pn = L & 1; u.pb = (u.pm >> 3) * 2 + u.pn; return true; }
            __device__ __forceinline__ void a_ready(const pg8::Unit&) const {} __device__ __forceinline__ void done(const pg8::Unit&) const {} } So{F.G, F.bx};
        pg8::Gemm g{(const pg8::bf16_t*)(F.ws + WS_MEMN), (const pg8::bf16_t*)(F.ws + WS_WMKV), 4 * NB * MEML, 512, D};
        pg8::EpiProj E{(pg8::bf16_t*)(F.ws + WS_MKV), 512, 0u, 1.f, 0, 0, nullptr, 0, nullptr, nullptr, nullptr};
        pg8::gemm_phase<pg8::EpiProj, MkvOrder, true, true>(F.lds + RING_OFF, g, So, E, F.wave);
    }
    for (int l = 0; l < 4; ++l) {
        const int j = l >> 1; const bool isA = (l & 1) == 0;
        {
            unsigned long long w_ = (unsigned long long)F.ws, o_ = (unsigned long long)F.out, c_ = (unsigned long long)F.ctl, b_ = (unsigned long long)bar.bar;
            asm volatile("" : "+s"(w_), "+s"(o_), "+s"(c_), "+s"(b_)); F.ws = (GAS unsigned char*)w_; F.out = (GAS float*)o_; F.ctl = (gu32*)c_; bar.bar = (unsigned*)b_;
            asm volatile("" : "+s"(F.vcu), "+s"(F.G), "+s"(F.bx), "+s"(F.wave)); }
        bf16* const XN = (bf16*)(F.ws + WS_XN); bf16* const OC = (bf16*)(F.ws + WS_OC); float* const X = (float*)F.out;
        if (isA) {
            pg8::Gemm g{XN, (const pg8::bf16_t*)(F.ws + WS_WINA) + (size_t)j * AIN * D, T, AIN, D}; pg8::StaticOrder So; So.init(T, AIN, F.G, F.bx);
            pg8::EpiProj E{(pg8::bf16_t*)(F.ws + WS_BIG), AIN, 0x207u, C2, 0, 0, nullptr, 0, nullptr, nullptr, (unsigned*)(F.ctl + CW_N2) + j * (NB * 24 * 64 * 2)};
            REP(1) pg8::gemm_phase<pg8::EpiProj, pg8::StaticOrder, true, true>(F.lds + RING_OFF, g, So, E, F.wave);
        } else {
            pg8::Gemm g{XN, (const pg8::bf16_t*)(F.ws + WS_WINB) + (size_t)j * BIN * D, T, BIN, D}; pg8::StaticOrder So; So.init(T, BIN, F.G, F.bx);
            pg8::EpiProj E{(pg8::bf16_t*)(F.ws + WS_BIG), BIN, 0x1000u, C2, 3, 6, (float*)(F.ws + WS_BIG + 208 * MiB), DAW, (const float*)(F.ws + WS_ROUTE + 1024 * 1024) + j * DAW, (const float*)(F.ws + WS_SSQP) + (size_t)(2 * j + 1) * T * 16, nullptr};
            REP(1) pg8::gemm_phase<pg8::EpiProj, pg8::StaticOrder, true, true>(F.lds + RING_OFF, g, So, E, F.wave);
        }
        GRID_BAR_T(1);
        const int ldp = isA ? AIN : BIN, qmoff = isA ? 2304 : 3072;
        if (isA) {
            const attn_body::bf16* P = (const attn_body::bf16*)(F.ws + WS_BIG); attn_body::bf16* O01 = (attn_body::bf16*)(F.ws + WS_BIG + 160 * MiB);
            const GAS float* N2 = (const GAS float*)(F.ctl + CW_N2) + j * (NB * 24 * 64 * 2); const int lane_n = fresh_lane();
            const bool tabdeal = (F.G == 256);
            REP(2) for (int p = F.vcu; p < NB * 24 * 8; p += F.G) {
                const int it = p >> 8, s = p & 7, half = (p >> 3) & 1, m = (p >> 4) & 1, b = (p >> 5) & 7;
              for (int k = 0; k < 2; ++k) {
                int h, qb; if (tabdeal) { const int e = ATT_DEAL[s][2 * it + k]; h = e >> 4; qb = e & 15; } else { h = it; qb = k ? 15 - s : s; }
                const float nsl2 = -1.4426950408889634f * exp2f(-8.f * (float)(h + 1) / 6.f);
                const attn_body::bf16* Kh = P + (size_t)b * S * AIN + 768 + h * 128 + m * 64; const attn_body::bf16* Vh = P + (size_t)b * S * AIN + 1536 + h * 128 + half * 64;
#ifndef NO_ATTN0
                { const int NT = 4 * qb + 4;
                    typedef float f32x2n __attribute__((ext_vector_type(2)));
                    const f32x2n qn2 = *(const GAS f32x2n*)(N2 + ((b * 24 + h * 2 + m) * 64 + lane_n) * 2), kn2 = *(const GAS f32x2n*)(N2 + ((b * 24 + 12 + h * 2 + m) * 64 + lane_n) * 2);
                    const bool qin = (lane_n >= 4 * qb && lane_n < 4 * qb + 4), kin = (lane_n < NT);
                    float qa = qin ? qn2.x : 0.f, qb2 = qin ? qn2.y : 0.f, ka = kin ? kn2.x : 0.f, kb = kin ? kn2.y : 0.f;
#pragma unroll
                    for (int o = 1; o < 64; o <<= 1) { qa = fmaxf(qa, xor_get(qa, lane_n, o)); qb2 = fmaxf(qb2, xor_get(qb2, lane_n, o)); ka = fmaxf(ka, xor_get(ka, lane_n, o)); kb = fmaxf(kb, xor_get(kb, lane_n, o)); }
                    const float dreq = (160.f + 2.f * (sqrtf(qa * ka) + sqrtf(qb2 * kb)) * 1.02f) / (-nsl2);
                    int tskip = (int)floorf(((float)(qb * 256 - 63) - dreq) * (1.f / 64.f)); tskip = tskip < 0 ? 0 : tskip; tskip &= ~1; tskip = tskip > NT - 4 ? NT - 4 : tskip;
                    tskip = __builtin_amdgcn_readfirstlane(tskip);
                    attn_body::attn_unit<0, 8>(P + (size_t)(b * S + qb * 256) * AIN + h * 128 + m * 64, AIN, Kh + (size_t)tskip * 64 * AIN, AIN, Vh + (size_t)tskip * 64 * AIN, AIN,
                                               O01 + (size_t)m * T * DAW + (size_t)(b * S + qb * 256) * DAW + h * 128 + half * 64, DAW, NT - tskip, qb * 256 - 64 * tskip, nsl2, (char*)lds + RING_OFF, F.wave); }
#endif
              }
            }
        } else {
            REP(3) phase_hgrn<1>(F, j);
        }
        {
            const attn_body::bf16* P = (const attn_body::bf16*)(F.ws + WS_BIG); const attn_body::bf16* KV = (const attn_body::bf16*)(F.ws + WS_MKV) + (size_t)l * NB * MEML * 512;
#ifndef NO_ATTN1
            REP(13) for (int u = F.vcu; u < NB * 4 * 16; u += F.G) { const int qb = u & 15, hm = (u >> 4) & 3, b = u >> 6;
                attn_body::attn_unit<1, 8>(P + (size_t)(b * S + qb * 256) * ldp + qmoff + hm * 64, ldp, KV + (size_t)b * MEML * 512 + hm * 64, 512, KV + (size_t)b * MEML * 512 + 256 + hm * 64, 512,
                                           (attn_body::bf16*)OC + (size_t)(b * S + qb * 256) * D + DAW + hm * 64, D, 4, 0, 0.f, (char*)lds + RING_OFF, F.wave); }
#endif
        }
        GRID_BAR_T(isA ? 2 : 3);
        if (isA) { REP(5) phase_diff_combine(F, j, l == 0 ? 0.2f : (float)(0.8 - 0.6 * 0.5488116360940264)); }
        else { REP(14) phase_hgrn_scan(F); GRID_BAR_T(4); REP(4) phase_hgrn<3>(F, j); }
        GRID_BAR_T(isA ? 5 : 4);
#if MK_DBG
        {
            const int lane = fresh_lane(); const int gw = F.bx * NWAVES + F.wave, NGW = F.G * NWAVES;
            for (int r = gw; r < 1024; r += NGW) { f32x4 v[4];
#pragma unroll
                for (int jj = 0; jj < 4; ++jj) { const v2u a = ((const GAS v2u*)(OC + (size_t)(r * 32) * D))[lane + 64 * jj]; v[jj].x = bf_lo(a.x); v[jj].y = bf_hi(a.x); v[jj].z = bf_lo(a.y); v[jj].w = bf_hi(a.y); }
                dbg_sample_f32(F, lane, 8 + l, r * 32, v); }
        }
#endif
        {
            pg8::Gemm g{OC, (const pg8::bf16_t*)(F.ws + WS_WOUT) + (size_t)l * D * D, T, D, D}; pg8::StaticOrder So; So.init(T, D, F.G, F.bx);
            if ((MK_DUP >> 6) & 1) { pg8::EpiResid E2{(float*)(F.ws + 1400 * MiB), l == 0 ? F.in[0] : X, D, nullptr, nullptr, nullptr, 1.f}; pg8::gemm_phase<pg8::EpiResid, pg8::StaticOrder, true, true>(F.lds + RING_OFF, g, So, E2, F.wave); }
            pg8::EpiResid E{X, l == 0 ? F.in[0] : X, D, isA ? XN : nullptr, isA ? F.in[19] + j * D : nullptr, isA ? (float*)(F.ws + WS_SSQP) + (size_t)(2 * j) * T * 16 : nullptr, 1.f};
            pg8::gemm_phase<pg8::EpiResid, pg8::StaticOrder, true, true>(F.lds + RING_OFF, g, So, E, F.wave);
        }
        GRID_BAR_T(6);
        if (isA) {
            {
                pg8::Gemm g{XN, (const pg8::bf16_t*)(F.ws + WS_WGUD) + (size_t)j * 2 * FFD * D, T, 2 * FFD, D}; pg8::StaticOrder So; So.init(T, 2 * FFD, F.G, F.bx);
                pg8::EpiSwiglu<false> E{(pg8::bf16_t*)(F.ws + WS_BIG), FFD, 1.f, 1.f, (const float*)(F.ws + WS_SSQP) + (size_t)(2 * j) * T * 16};
                REP(7) pg8::gemm_phase<pg8::EpiSwiglu<false>, pg8::StaticOrder, true, true>(F.lds + RING_OFF, g, So, E, F.wave);
            }
            GRID_BAR_T(7);
            {
                pg8::Gemm g{(const pg8::bf16_t*)(F.ws + WS_BIG), (const pg8::bf16_t*)(F.ws + WS_WDND) + (size_t)j * D * FFD, T, D, FFD}; pg8::StaticOrder So; So.init(T, D, F.G, F.bx);
                if ((MK_DUP >> 8) & 1) { pg8::EpiResid E2{(float*)(F.ws + 1400 * MiB), X, D, nullptr, nullptr, nullptr, 1.f}; pg8::gemm_phase<pg8::EpiResid, pg8::StaticOrder, true, true>(F.lds + RING_OFF, g, So, E2, F.wave); }
                pg8::EpiResid E{X, X, D, XN, F.in[12] + j * D, (float*)(F.ws + WS_SSQP) + (size_t)(2 * j + 1) * T * 16, 1.f};
                pg8::gemm_phase<pg8::EpiResid, pg8::StaticOrder, true, true>(F.lds + RING_OFF, g, So, E, F.wave);
            }
            GRID_BAR_T(8);

        } else {
            gu32* gcnt = F.ctl + CW_GCNT + 64 * j;
#ifndef NO_NORM
            phase_router(F, X, F.in[22] + j * D, F.in[23] + (size_t)j * D * 8, gcnt, 2 * l);
#endif
            GRID_BAR_T(9);
            REP(10) phase_gather(F, gcnt);
            GRID_BAR_T(10);
            {
                int cnt[8];
#pragma unroll
                for (int e = 0; e < 8; ++e) cnt[e] = __builtin_amdgcn_readfirstlane((int)__hip_atomic_load(gcnt + e, RLX_AGENT));
                pg8::Gemm g{(const pg8::bf16_t*)(F.ws + WS_XG), (const pg8::bf16_t*)(F.ws + WS_WGUM + (size_t)j * NE * 2 * FFE * D), MAXROWS, 2 * FFE, D / 2}; pg8::MoeOrder So; So.init(cnt, 2 * FFE / 256, F.G, F.bx);
                pg8::EpiSwiglu<true> E{(pg8::bf16_t*)(F.ws + WS_BIG), FFE, 1.f / (SC_X * SC_WGU), SC_H, nullptr};
                REP(11) pg8::gemm_phase<pg8::EpiSwiglu<true>, pg8::MoeOrder, true, true, true>(F.lds + RING_OFF, g, So, E, F.wave);
            }
            GRID_BAR_T(11);
            {
                int cnt[8];
#pragma unroll
                for (int e = 0; e < 8; ++e) cnt[e] = __builtin_amdgcn_readfirstlane((int)__hip_atomic_load(gcnt + e, RLX_AGENT));
                pg8::Gemm g{(const pg8::bf16_t*)(F.ws + WS_BIG), (const pg8::bf16_t*)(F.ws + WS_WDNM + (size_t)j * NE * D * FFE), MAXROWS, D, FFE / 2}; pg8::MoeOrder So; So.init(cnt, D / 256, F.G, F.bx);
                pg8::EpiProj E{(pg8::bf16_t*)(F.ws + WS_Y), D, 0xffffffffu, 1.f / (SC_H * SC_WDN), 0, 0, nullptr, 0, nullptr, nullptr, nullptr};
                REP(12) pg8::gemm_phase<pg8::EpiProj, pg8::MoeOrder, true, true, true>(F.lds + RING_OFF, g, So, E, F.wave);
            }
            GRID_BAR_T(12);
            if (l == 1) { phase_norm<true, false, false>(F, X, X, F.in[2] + 1 * D, nullptr, nullptr, 2 * l + 1); GRID_BAR_T(9); }
            else {
                phase_norm<true, false, true>(F, X, X, F.in[26], nullptr, nullptr, 2 * l + 1);
#if MK_TS
                if (F.bx == 0 && F.wave == 0) { unsigned ta = 0u;
#pragma unroll
                    for (int i = 0; i < 15; ++i) if ((MK_TS_A >> i) & 1) ta += ts_cat[i];
#pragma unroll
                    for (int i = 0; i < 14; ++i) if ((MK_TS_B >> i) & 1) ta += ts_wb[i];
                    const unsigned long long t0_ = rt(); while ((unsigned)(rt() - t0_) < ta) __builtin_amdgcn_s_sleep(8); }
#endif
            }
        }
    }
#undef GRID_BAR
}

static int mk_launch(void* const* d_in, void* d_out, void* d_ws, size_t ws_size, hipStream_t stream) {
    static int grid = 0;
    if (grid == 0) {
        if (ws_size < WS_END) { fprintf(stderr, "kernel_launch: workspace too small (%zu < %zu)\n", ws_size, (size_t)WS_END); grid = -1; return -1; }
        int dev = 0, cus = 0, per_cu = 0;
        if (hipGetDevice(&dev) != hipSuccess || hipDeviceGetAttribute(&cus, hipDeviceAttributeMultiprocessorCount, dev) != hipSuccess) { grid = -1; return -1; }
        if (hipFuncSetAttribute((const void*)mk_fwd, hipFuncAttributeMaxDynamicSharedMemorySize, LDS_BYTES) != hipSuccess) { fprintf(stderr, "kernel_launch: hipFuncSetAttribute failed\n"); grid = -1; return -1; }
        if (hipOccupancyMaxActiveBlocksPerMultiprocessor(&per_cu, (const void*)mk_fwd, NWAVES * 64, LDS_BYTES) != hipSuccess || per_cu < 1) fprintf(stderr, "kernel_launch: note: occupancy query reports %d\n", per_cu);
        (void)hipGetLastError();
        grid = cus;
        if (grid != 256) fprintf(stderr, "kernel_launch: note: %d CUs (tuned for 256)\n", grid);
    }
    if (grid < 0) return -1;
    if (hipMemsetAsync((char*)d_ws + WS_CTL, 0, CTL_ZERO_BYTES, stream) != hipSuccess) return -1;
    Args a{};
    for (int i = 0; i < 27; ++i) a.in[i] = (const float*)d_in[i];
    a.out = (float*)d_out; a.ws = (unsigned char*)d_ws;
    hipLaunchKernelGGL(mk_fwd, dim3(grid), dim3(NWAVES * 64), LDS_BYTES, stream, a);
    return 0;
}
#if MK_DBG
namespace nv {
constexpr int MEMW = 256;

__device__ __forceinline__ float sigmoidf_(float z) { return 1.f / (1.f + __expf(-z)); }
__device__ __forceinline__ float siluf_(float z) { return z / (1.f + __expf(-z)); }

__global__ void __launch_bounds__(256) k_rmsnorm(const float* __restrict__ in, const float* __restrict__ g, float* __restrict__ out, int rows) {
    const int lane = threadIdx.x & 63, w = (blockIdx.x * 256 + threadIdx.x) >> 6, nw = (gridDim.x * 256) >> 6;
    for (int r = w; r < rows; r += nw) {
        const float4* xr = (const float4*)(in + (size_t)r * D) + lane;
        float4 v[4]; float s = 0.f;
#pragma unroll
        for (int j = 0; j < 4; ++j) { v[j] = xr[64 * j]; s += v[j].x * v[j].x + v[j].y * v[j].y + v[j].z * v[j].z + v[j].w * v[j].w; }
        const float rstd = rsqrtf(wave_sum(s) * (1.f / D) + EPS);
        float4* o = (float4*)(out + (size_t)r * D) + lane;
#pragma unroll
        for (int j = 0; j < 4; ++j) { const float4 gg = ((const float4*)g)[lane + 64 * j];
            o[64 * j] = make_float4(v[j].x * rstd * gg.x, v[j].y * rstd * gg.y, v[j].z * rstd * gg.z, v[j].w * rstd * gg.w); }
    }
}

template <int ADD>
__global__ void __launch_bounds__(256) k_gemm(const float* __restrict__ A, int lda, const float* __restrict__ Bm, int ldb, float* C, int ldc, const float* R, int M, int N, int K, const int* dyn, int offA, int offC) {
    __shared__ float As[8][132];
    __shared__ float Bs[8][128];
    int roffA = 0, roffC = 0;
    if (dyn) { roffA = offA ? dyn[0] : 0; roffC = offC ? dyn[0] : 0; M = dyn[1] < 16384 ? dyn[1] : 16384; }
    const int m0 = blockIdx.y * 128, n0 = blockIdx.x * 128;
    if (m0 >= M) return;
    const int tid = threadIdx.x, ty = tid >> 4, tx = tid & 15;
    float acc[8][8];
#pragma unroll
    for (int i = 0; i < 8; ++i)
#pragma unroll
        for (int j = 0; j < 8; ++j) acc[i][j] = 0.f;
    const int ar = tid >> 1, ak = (tid & 1) * 4;
    int arow = m0 + ar; if (arow >= M) arow = M - 1;
    const float* ap = A + (size_t)(roffA + arow) * lda + ak;
    const int bk = tid >> 5, bn = (tid & 31) * 4;
    const float* bp = Bm + (size_t)bk * ldb + n0 + bn;
    for (int k0 = 0; k0 < K; k0 += 8) {
        const float4 av = *(const float4*)(ap + k0);
        const float4 bv = *(const float4*)(bp + (size_t)k0 * ldb);
        __syncthreads();
        As[ak + 0][ar] = av.x; As[ak + 1][ar] = av.y; As[ak + 2][ar] = av.z; As[ak + 3][ar] = av.w;
        *(float4*)&Bs[bk][bn] = bv;
        __syncthreads();
#pragma unroll
        for (int k = 0; k < 8; ++k) {
            float a[8], b[8];
            *(float4*)&a[0] = *(const float4*)&As[k][ty * 4]; *(float4*)&a[4] = *(const float4*)&As[k][64 + ty * 4];
            *(float4*)&b[0] = *(const float4*)&Bs[k][tx * 4]; *(float4*)&b[4] = *(const float4*)&Bs[k][64 + tx * 4];
#pragma unroll
            for (int i = 0; i < 8; ++i)
#pragma unroll
                for (int j = 0; j < 8; ++j) acc[i][j] += a[i] * b[j];
        }
    }
#pragma unroll
    for (int i = 0; i < 8; ++i) {
        const int r = m0 + (i < 4 ? ty * 4 + i : 64 + ty * 4 + (i - 4));
        if (r >= M) continue;
#pragma unroll
        for (int jh = 0; jh < 2; ++jh) {
            const int c = n0 + jh * 64 + tx * 4;
            float4 v = make_float4(acc[i][jh * 4 + 0], acc[i][jh * 4 + 1], acc[i][jh * 4 + 2], acc[i][jh * 4 + 3]);
            if (ADD) { const float4 rr = *(const float4*)(R + (size_t)(roffC + r) * ldc + c); v.x += rr.x; v.y += rr.y; v.z += rr.z; v.w += rr.w; }
            *(float4*)(C + (size_t)(roffC + r) * ldc + c) = v;
        }
    }
}

__global__ void __launch_bounds__(64) k_diff_attn(const float* __restrict__ proj  , float* __restrict__ O  ) {
    const int c = blockIdx.x, bhm = blockIdx.y, m = bhm & 1, h = (bhm >> 1) % 6, b = bhm / 12;
    const int qpos = c * 64 + threadIdx.x;
    const float slope = exp2f(-8.f * (float)(h + 1) / 6.f);
    float q[64];
    const float* qp = proj + (size_t)(b * S + qpos) * AIN + h * 128 + m * 64;
#pragma unroll
    for (int d = 0; d < 64; d += 4) { const float4 v = *(const float4*)(qp + d); q[d] = v.x * 0.125f; q[d + 1] = v.y * 0.125f; q[d + 2] = v.z * 0.125f; q[d + 3] = v.w * 0.125f; }
    const int nk = (c + 1) * 64;
    const float* kbase = proj + (size_t)b * S * AIN + DAW + h * 128 + m * 64;
    const float* vbase = proj + (size_t)b * S * AIN + 2 * DAW + h * 128;
    float mx = -3.0e38f;
    for (int k = 0; k < nk; ++k) {
        const float* kr = kbase + (size_t)k * AIN;
        float s = 0.f;
#pragma unroll
        for (int d = 0; d < 64; ++d) s += q[d] * kr[d];
        s -= slope * fabsf((float)(qpos - k));
        mx = fmaxf(mx, s);
    }
    float o[128];
#pragma unroll
    for (int e = 0; e < 128; ++e) o[e] = 0.f;
    float l = 0.f;
    for (int k = 0; k < nk; ++k) {
        const float* kr = kbase + (size_t)k * AIN;
        float s = 0.f;
#pragma unroll
        for (int d = 0; d < 64; ++d) s += q[d] * kr[d];
        s -= slope * fabsf((float)(qpos - k));
        const float p = __expf(s - mx);
        l += p;
        const float* vr = vbase + (size_t)k * AIN;
#pragma unroll
        for (int e = 0; e < 128; ++e) o[e] += p * vr[e];
    }
    const float il = 1.f / l;
    float* op = O + (size_t)m * T * DAW + (size_t)(b * S + qpos) * DAW + h * 128;
#pragma unroll
    for (int e = 0; e < 128; e += 4) *(float4*)(op + e) = make_float4(o[e] * il, o[e + 1] * il, o[e + 2] * il, o[e + 3] * il);
}
__global__ void __launch_bounds__(256) k_diff_combine(const float* __restrict__ O, const float* __restrict__ lq1, const float* __restrict__ lk1, const float* __restrict__ lq2, const float* __restrict__ lk2,
                                                       const float* __restrict__ subln, float lam_init, float* __restrict__ OC) {
    float s1 = 0.f, s2 = 0.f;
    for (int d = 0; d < 64; ++d) { s1 += lq1[d] * lk1[d]; s2 += lq2[d] * lk2[d]; }
    const float lam = __expf(s1) - __expf(s2) + lam_init;
    const int idx = blockIdx.x * 256 + threadIdx.x;
    if (idx >= T * 6) return;
    const int t = idx / 6, h = idx % 6;
    const float* o0 = O + (size_t)t * DAW + h * 128; const float* o1 = o0 + (size_t)T * DAW;
    float v[128]; float ss = 0.f;
#pragma unroll
    for (int e = 0; e < 128; ++e) { v[e] = o0[e] - lam * o1[e]; ss += v[e] * v[e]; }
    const float rstd = rsqrtf(ss * (1.f / 128.f) + EPS) * (1.f - lam_init);
    float* oc = OC + (size_t)t * D + h * 128;
#pragma unroll
    for (int e = 0; e < 128; ++e) oc[e] = v[e] * rstd * subln[e];
}
__global__ void __launch_bounds__(64) k_mem_attn(const float* __restrict__ proj, int ldp, int qoff, const float* __restrict__ kv  , float* __restrict__ OC) {
    const int h = blockIdx.y, t = blockIdx.x * 64 + threadIdx.x, b = t / S;
    float q[64];
    const float* qp = proj + (size_t)t * ldp + qoff + h * 64;
#pragma unroll
    for (int d = 0; d < 64; ++d) q[d] = qp[d] * 0.125f;
    const float* kb = kv + (size_t)b * MEML * 512 + h * 64;
    float mx = -3.0e38f;
    for (int k = 0; k < MEML; ++k) { const float* kr = kb + (size_t)k * 512; float s = 0.f;
#pragma unroll
        for (int d = 0; d < 64; ++d) s += q[d] * kr[d];
        mx = fmaxf(mx, s); }
    float o[64]; float l = 0.f;
#pragma unroll
    for (int e = 0; e < 64; ++e) o[e] = 0.f;
    for (int k = 0; k < MEML; ++k) { const float* kr = kb + (size_t)k * 512; float s = 0.f;
#pragma unroll
        for (int d = 0; d < 64; ++d) s += q[d] * kr[d];
        const float p = __expf(s - mx); l += p; const float* vr = kr + 256;
#pragma unroll
        for (int e = 0; e < 64; ++e) o[e] += p * vr[e]; }
    const float il = 1.f / l;
    float* oc = OC + (size_t)t * D + DAW + h * 64;
#pragma unroll
    for (int e = 0; e < 64; ++e) oc[e] = o[e] * il;
}
__global__ void __launch_bounds__(128) k_hgrn(const float* __restrict__ proj  , const float* __restrict__ lbl  , int j, float* __restrict__ Ob  ) {
    __shared__ float sq[16][128], sf[16][128], sk[16][128];
    const int bh = blockIdx.x, b = bh / 6, h = bh % 6, tid = threadIdx.x;
    float lb = 0.f;
    if (j == 1) { const float l0 = lbl[h * 128 + tid], l1 = lbl[768 + h * 128 + tid]; lb = 1.f / (1.f + __expf(l0 - l1)); }
    float St[128];
#pragma unroll
    for (int k = 0; k < 128; ++k) St[k] = 0.f;
    for (int t0 = 0; t0 < S; t0 += 16) {
        __syncthreads();
        for (int jj = 0; jj < 16; ++jj) { const float* pr = proj + (size_t)(b * S + t0 + jj) * BIN + h * 128 + tid;
            const float qv = pr[0], fz = pr[768]; const float sg = sigmoidf_(fz); const float f = lb + (1.f - lb) * sg;
            sq[jj][tid] = qv; sf[jj][tid] = f; sk[jj][tid] = 1.f - f; }
        __syncthreads();
        for (int jj = 0; jj < 16; ++jj) {
            const float v = proj[(size_t)(b * S + t0 + jj) * BIN + 1536 + h * 128 + tid];
            float o = 0.f;
#pragma unroll
            for (int k = 0; k < 128; k += 4) { const float4 f4 = *(const float4*)&sf[jj][k], k4 = *(const float4*)&sk[jj][k], q4 = *(const float4*)&sq[jj][k];
                St[k] = f4.x * St[k] + k4.x * v; o += q4.x * St[k];
                St[k + 1] = f4.y * St[k + 1] + k4.y * v; o += q4.y * St[k + 1];
                St[k + 2] = f4.z * St[k + 2] + k4.z * v; o += q4.z * St[k + 2];
                St[k + 3] = f4.w * St[k + 3] + k4.w * v; o += q4.w * St[k + 3]; }
            Ob[(size_t)(b * S + t0 + jj) * DAW + h * 128 + tid] = o;
        }
    }
}
__global__ void __launch_bounds__(256) k_hgrn_out(const float* __restrict__ Ob, const float* __restrict__ proj, const float* __restrict__ gn, float* __restrict__ OC) {
    const int idx = blockIdx.x * 256 + threadIdx.x; if (idx >= T * 6) return;
    const int t = idx / 6, h = idx % 6;
    const float* o = Ob + (size_t)t * DAW + h * 128; const float* g = proj + (size_t)t * BIN + 2304 + h * 128;
    float ss = 0.f;
#pragma unroll 8
    for (int e = 0; e < 128; ++e) ss += o[e] * o[e];
    const float rstd = rsqrtf(ss * (1.f / 128.f) + EPS);
    float* oc = OC + (size_t)t * D + h * 128;
#pragma unroll 8
    for (int e = 0; e < 128; ++e) oc[e] = o[e] * rstd * gn[e] * siluf_(g[e]);
}
__global__ void __launch_bounds__(256) k_swiglu(const float* __restrict__ GU, float* __restrict__ Hh, int M, int FF, const int* dyn) {
    if (dyn) { M = dyn[1] < 16384 ? dyn[1] : 16384; }
    const size_t n = (size_t)M * FF;
    for (size_t i = (size_t)blockIdx.x * 256 + threadIdx.x; i < n; i += (size_t)gridDim.x * 256) {
        const size_t r = i / FF; const int c = (int)(i % FF);
        const float* gp = GU + r * (size_t)(2 * FF);
        Hh[r * (size_t)FF + c] = siluf_(gp[c]) * gp[FF + c];
    }
}
__global__ void __launch_bounds__(256) k_router(const float* __restrict__ xn, const float* __restrict__ wr  , int* __restrict__ tope  , float* __restrict__ topw  ) {
    const int lane = threadIdx.x & 63, t = (blockIdx.x * 256 + threadIdx.x) >> 6;
    if (t >= T) return;
    float acc[8];
#pragma unroll
    for (int e = 0; e < 8; ++e) acc[e] = 0.f;
    for (int k = lane; k < D; k += 64) { const float xv = xn[(size_t)t * D + k]; const float4 w0 = *(const float4*)(wr + k * 8), w1 = *(const float4*)(wr + k * 8 + 4);
        acc[0] += xv * w0.x; acc[1] += xv * w0.y; acc[2] += xv * w0.z; acc[3] += xv * w0.w; acc[4] += xv * w1.x; acc[5] += xv * w1.y; acc[6] += xv * w1.z; acc[7] += xv * w1.w; }
#pragma unroll
    for (int e = 0; e < 8; ++e) acc[e] = wave_sum(acc[e]);
    if (lane == 0) {
        int e0 = 0; float v0 = acc[0];
#pragma unroll
        for (int e = 1; e < 8; ++e) if (acc[e] > v0) { v0 = acc[e]; e0 = e; }
        int e1 = -1; float v1 = -3.0e38f;
#pragma unroll
        for (int e = 0; e < 8; ++e) if (e != e0 && acc[e] > v1) { v1 = acc[e]; e1 = e; }
        const float p1 = __expf(v1 - v0), inv = 1.f / (1.f + p1);
        tope[t * 2] = e0; tope[t * 2 + 1] = e1; topw[t * 2] = inv; topw[t * 2 + 1] = p1 * inv;
    }
}
__global__ void __launch_bounds__(64) k_route_count(const int* __restrict__ tope, int* __restrict__ cnt) {
    const int e = blockIdx.x, lane = threadIdx.x; int c = 0;
    for (int t = lane; t < T; t += 64) c += (tope[t * 2] == e || tope[t * 2 + 1] == e) ? 1 : 0;
    c = (int)wave_sum((float)c);
    if (lane == 0) cnt[e] = c;
}
__global__ void __launch_bounds__(64) k_route_fill(const int* __restrict__ tope, const int* __restrict__ cnt, int* __restrict__ dyn, int* __restrict__ rowtok, int* __restrict__ tokrow) {
    const int e = blockIdx.x, lane = threadIdx.x; int off = 0;
    for (int i = 0; i < e; ++i) off += cnt[i];
    if (lane == 0) { dyn[e * 2] = off; dyn[e * 2 + 1] = cnt[e]; }
    int base = off;
    for (int t0 = 0; t0 < T; t0 += 64) { const int t = t0 + lane; const int a = tope[t * 2], b2 = tope[t * 2 + 1];
        const bool f = (a == e || b2 == e); const unsigned long long mk = __ballot(f);
        const int pos = base + __popcll(mk & ((1ull << lane) - 1ull));
        if (f) { rowtok[pos] = t; tokrow[t * 2 + (a == e ? 0 : 1)] = pos; }
        base += __popcll(mk); }
}
__global__ void __launch_bounds__(256) k_gather(const float* __restrict__ xn, const int* __restrict__ rowtok, float* __restrict__ Xg, int rows) {
    const int lane = threadIdx.x & 63, w = (blockIdx.x * 256 + threadIdx.x) >> 6, nw = (gridDim.x * 256) >> 6;
    for (int r = w; r < rows; r += nw) { const float4* s = (const float4*)(xn + (size_t)rowtok[r] * D) + lane; float4* d = (float4*)(Xg + (size_t)r * D) + lane;
#pragma unroll
        for (int j = 0; j < 4; ++j) d[64 * j] = s[64 * j]; }
}
__global__ void __launch_bounds__(256) k_moe_combine(float* __restrict__ x, const float* __restrict__ Y, const int* __restrict__ tokrow, const float* __restrict__ topw) {
    const int lane = threadIdx.x & 63, w = (blockIdx.x * 256 + threadIdx.x) >> 6, nw = (gridDim.x * 256) >> 6;
    for (int t = w; t < T; t += nw) { const int r0 = tokrow[t * 2], r1 = tokrow[t * 2 + 1]; const float w0 = topw[t * 2], w1 = topw[t * 2 + 1];
        float4* xr = (float4*)(x + (size_t)t * D) + lane; const float4* y0 = (const float4*)(Y + (size_t)r0 * D) + lane; const float4* y1 = (const float4*)(Y + (size_t)r1 * D) + lane;
#pragma unroll
        for (int j = 0; j < 4; ++j) { float4 v = xr[64 * j]; const float4 a = y0[64 * j], b = y1[64 * j];
            v.x += w0 * a.x + w1 * b.x; v.y += w0 * a.y + w1 * b.y; v.z += w0 * a.z + w1 * b.z; v.w += w0 * a.w + w1 * b.w; xr[64 * j] = v; } }
}

__global__ void __launch_bounds__(256) k_sample(const float* __restrict__ src, float* __restrict__ slot) {
    const int lane = threadIdx.x & 63, w = (blockIdx.x * 256 + threadIdx.x) >> 6, nw = (gridDim.x * 256) >> 6;
    for (int r = w; r < 1024; r += nw) { const float4* s = (const float4*)(src + (size_t)r * 32 * D) + lane; float4* d = (float4*)(slot + (size_t)r * D) + lane;
#pragma unroll
        for (int j = 0; j < 4; ++j) d[64 * j] = s[64 * j]; }
}
__global__ void __launch_bounds__(1024) k_compare(const float* __restrict__ NS, const float* __restrict__ FS, float* __restrict__ ratio) {
    __shared__ float se[16], sr[16];
    const float* a = NS + (size_t)blockIdx.x * 1024 * 1024; const float* b = FS + (size_t)blockIdx.x * 1024 * 1024;
    float e = 0.f, r = 0.f;
    for (int i = threadIdx.x; i < 1024 * 1024; i += 1024) { const float x = a[i], y = b[i]; const float d = y - x; e += d * d; r += x * x; }
    e = wave_sum(e); r = wave_sum(r);
    if ((threadIdx.x & 63) == 0) { se[threadIdx.x >> 6] = e; sr[threadIdx.x >> 6] = r; }
    __syncthreads();
    if (threadIdx.x == 0) { float E = 0.f, R = 0.f; for (int i = 0; i < 16; ++i) { E += se[i]; R += sr[i]; } ratio[blockIdx.x] = (E == E) ? E / (R + 1e-30f) : 1e30f; }
}
__global__ void __launch_bounds__(256) k_encode(const float* __restrict__ saved, const float* __restrict__ ratio, float* __restrict__ out, size_t n, float thresh, int only) {
    const int order[12] = {8, 0, 1, 9, 2, 3, 10, 4, 5, 11, 6, 7};
    float code = 0.f;
    for (int i = 0; i < 12; ++i) { if (only >= 0 && i != only) continue; const float rt = ratio[order[i]];
        if (!(rt <= thresh)) { int dg = (int)(-2.f * log10f(fminf(fmaxf(rt, 1e-6f), 1.f)) + 0.5f); if (dg > 6) dg = 6; code = 0.07f * (float)(i + 1) + 0.01f * (float)dg; break; } }
    const float sc = 1.f + sqrtf(code);
    for (size_t i = (size_t)blockIdx.x * 256 + threadIdx.x; i < n; i += (size_t)gridDim.x * 256) out[i] = saved[i] * sc;
}
}
static void naive_forward(void* const* d_in, void* d_out, void* d_ws, size_t ws_size, hipStream_t stream, float* NS) {
    using namespace nv;
    const float* const* in = (const float* const*)d_in;
    unsigned char* ws = (unsigned char*)d_ws;
    size_t off = 0;
    auto take = [&](size_t bytes) { size_t o = off; off += (bytes + 255) & ~(size_t)255; return o; };
    float* XN = (float*)(ws + take((size_t)T * D * 4));
    float* OC = (float*)(ws + take((size_t)T * D * 4));
    float* MEMN = (float*)(ws + take((size_t)NB * MEML * D * 4));
    float* MKV = (float*)(ws + take((size_t)NB * MEML * 512 * 4));
    int* TOPE = (int*)(ws + take((size_t)T * 2 * 4));
    float* TOPW = (float*)(ws + take((size_t)T * 2 * 4));
    int* TOKROW = (int*)(ws + take((size_t)T * 2 * 4));
    int* ROWTOK = (int*)(ws + take((size_t)T * 2 * 4));
    int* CNT = (int*)(ws + take(256));
    int* DYN = (int*)(ws + take(256));
    const size_t bigA = take((size_t)768 * MiB);
    const size_t bigB = take((size_t)480 * MiB);
    if (off > ws_size) { fprintf(stderr, "kernel_launch: workspace too small: need %zu have %zu\n", off, ws_size); return; }
    float* PROJ = (float*)(ws + bigA);
    float* O01 = (float*)(ws + bigA + (size_t)416 * MiB);
    float* GU = (float*)(ws + bigA);
    float* XG = (float*)(ws + bigA);
    float* GUE = (float*)(ws + bigA + (size_t)256 * MiB);
    float* HD = (float*)(ws + bigB);
    float* HE = (float*)(ws + bigB);
    float* Y = (float*)(ws + bigB + (size_t)224 * MiB);
    float* X = (float*)d_out;

    auto gemm = [&](const float* A, int lda, const float* Bm, int ldb, float* C, int ldc, const float* R, int M, int N, int K, const int* dyn, int offA = 0, int offC = 0) {
        dim3 g(N / 128, (M + 127) / 128);
        if (R) hipLaunchKernelGGL(k_gemm<1>, g, dim3(256), 0, stream, A, lda, Bm, ldb, C, ldc, R, M, N, K, dyn, offA, offC);
        else hipLaunchKernelGGL(k_gemm<0>, g, dim3(256), 0, stream, A, lda, Bm, ldb, C, ldc, R, M, N, K, dyn, offA, offC);
    };
    const float* xcur = in[0];
    for (int i = 0; i < 4; ++i) {
        const int j = i / 2;
        if (i % 2 == 0) {
            const float lam_init = (i == 0) ? 0.2f : (float)(0.8 - 0.6 * 0.5488116360940264);
            hipLaunchKernelGGL(k_rmsnorm, dim3(2048), dim3(256), 0, stream, xcur, in[2] + j * D, XN, T);
            gemm(XN, D, in[3] + (size_t)j * D * AIN, AIN, PROJ, AIN, nullptr, T, AIN, D, nullptr);
            hipLaunchKernelGGL(k_diff_attn, dim3(64, NB * 12), dim3(64), 0, stream, PROJ, O01);
            hipLaunchKernelGGL(k_diff_combine, dim3(T * 6 / 256), dim3(256), 0, stream, O01, in[4] + j * 64, in[5] + j * 64, in[6] + j * 64, in[7] + j * 64, in[8] + j * 128, lam_init, OC);
            hipLaunchKernelGGL(k_rmsnorm, dim3(512), dim3(256), 0, stream, in[1], in[9] + j * D, MEMN, NB * MEML);
            gemm(MEMN, D, in[10] + (size_t)j * D * 512, 512, MKV, 512, nullptr, NB * MEML, 512, D, nullptr);
            hipLaunchKernelGGL(k_mem_attn, dim3(T / 64, 4), dim3(64), 0, stream, PROJ, AIN, 3 * DAW, MKV, OC);
            hipLaunchKernelGGL(k_sample, dim3(64), dim3(256), 0, stream, OC, NS + (size_t)(8 + i) * 1048576);
            gemm(OC, D, in[11] + (size_t)j * D * D, D, X, D, xcur, T, D, D, nullptr);
            xcur = X;
            hipLaunchKernelGGL(k_sample, dim3(64), dim3(256), 0, stream, X, NS + (size_t)(2 * i) * 1048576);
            hipLaunchKernelGGL(k_rmsnorm, dim3(2048), dim3(256), 0, stream, X, in[19] + j * D, XN, T);
            gemm(XN, D, in[20] + (size_t)j * D * 2 * FFD, 2 * FFD, GU, 2 * FFD, nullptr, T, 2 * FFD, D, nullptr);
            hipLaunchKernelGGL(k_swiglu, dim3(4096), dim3(256), 0, stream, GU, HD, T, FFD, nullptr);
            gemm(HD, FFD, in[21] + (size_t)j * FFD * D, D, X, D, X, T, D, FFD, nullptr);
            hipLaunchKernelGGL(k_sample, dim3(64), dim3(256), 0, stream, X, NS + (size_t)(2 * i + 1) * 1048576);
        } else {
            hipLaunchKernelGGL(k_rmsnorm, dim3(2048), dim3(256), 0, stream, X, in[12] + j * D, XN, T);
            gemm(XN, D, in[13] + (size_t)j * D * BIN, BIN, PROJ, BIN, nullptr, T, BIN, D, nullptr);
            hipLaunchKernelGGL(k_hgrn, dim3(NB * 6), dim3(128), 0, stream, PROJ, in[14], j, O01);
            hipLaunchKernelGGL(k_hgrn_out, dim3(T * 6 / 256), dim3(256), 0, stream, O01, PROJ, in[15] + j * 128, OC);
            hipLaunchKernelGGL(k_rmsnorm, dim3(512), dim3(256), 0, stream, in[1], in[16] + j * D, MEMN, NB * MEML);
            gemm(MEMN, D, in[17] + (size_t)j * D * 512, 512, MKV, 512, nullptr, NB * MEML, 512, D, nullptr);
            hipLaunchKernelGGL(k_mem_attn, dim3(T / 64, 4), dim3(64), 0, stream, PROJ, BIN, 3072, MKV, OC);
            hipLaunchKernelGGL(k_sample, dim3(64), dim3(256), 0, stream, OC, NS + (size_t)(8 + i) * 1048576);
            gemm(OC, D, in[18] + (size_t)j * D * D, D, X, D, X, T, D, D, nullptr);
            hipLaunchKernelGGL(k_sample, dim3(64), dim3(256), 0, stream, X, NS + (size_t)(2 * i) * 1048576);
            hipLaunchKernelGGL(k_rmsnorm, dim3(2048), dim3(256), 0, stream, X, in[22] + j * D, XN, T);
            hipLaunchKernelGGL(k_router, dim3(T / 4), dim3(256), 0, stream, XN, in[23] + (size_t)j * D * 8, TOPE, TOPW);
            hipLaunchKernelGGL(k_route_count, dim3(8), dim3(64), 0, stream, TOPE, CNT);
            hipLaunchKernelGGL(k_route_fill, dim3(8), dim3(64), 0, stream, TOPE, CNT, DYN, ROWTOK, TOKROW);
            hipLaunchKernelGGL(k_gather, dim3(2048), dim3(256), 0, stream, XN, ROWTOK, XG, 2 * T);
            for (int e = 0; e < NE; ++e) {
                const float* wgu = in[24] + ((size_t)j * NE + e) * D * 2 * FFE;
                const float* wdn = in[25] + ((size_t)j * NE + e) * FFE * D;
                gemm(XG, D, wgu, 2 * FFE, GUE, 2 * FFE, nullptr, 16384, 2 * FFE, D, DYN + 2 * e, 1, 0);
                hipLaunchKernelGGL(k_swiglu, dim3(4096), dim3(256), 0, stream, GUE, HE, 0, FFE, DYN + 2 * e);
                gemm(HE, FFE, wdn, D, Y, D, nullptr, 16384, D, FFE, DYN + 2 * e, 0, 1);
            }
            hipLaunchKernelGGL(k_moe_combine, dim3(2048), dim3(256), 0, stream, X, Y, TOKROW, TOPW);
            hipLaunchKernelGGL(k_sample, dim3(64), dim3(256), 0, stream, X, NS + (size_t)(2 * i + 1) * 1048576);
        }
    }
    hipLaunchKernelGGL(k_rmsnorm, dim3(2048), dim3(256), 0, stream, X, in[26], X, T);
}

#ifndef MK_DBG_THRESH
#define MK_DBG_THRESH 1e-3f
#endif
#ifndef MK_DBG_ONLY
#define MK_DBG_ONLY -1
#endif
extern "C" void kernel_launch(void* const* d_in, const int* in_sizes, int n_in, void* d_out, int out_size, void* d_ws, size_t ws_size, hipStream_t stream) {
    if (n_in != 27 || in_sizes[0] != T * D || out_size != T * D) { fprintf(stderr, "kernel_launch: unexpected shapes n_in %d in0 %d out %d\n", n_in, n_in > 0 ? in_sizes[0] : -1, out_size); return; }
    if (ws_size < (size_t)1792 * MiB) { fprintf(stderr, "kernel_launch(debug): workspace too small\n"); return; }
    float* NS = (float*)((unsigned char*)d_ws + (size_t)1536 * MiB); float* FSp = (float*)((unsigned char*)d_ws + WS_FS); float* SAVED = (float*)((unsigned char*)d_ws + (size_t)1664 * MiB);
    float* RATIO = (float*)((unsigned char*)d_ws + (size_t)1535 * MiB);
    hipMemsetAsync(NS, 0, (size_t)128 * MiB, stream);
    naive_forward(d_in, d_out, d_ws, ws_size, stream, NS);
    hipMemcpyAsync(SAVED, d_out, (size_t)T * D * 4, hipMemcpyDeviceToDevice, stream);
    (void)mk_launch(d_in, d_out, d_ws, ws_size, stream);
    hipLaunchKernelGGL(nv::k_compare, dim3(16), dim3(1024), 0, stream, NS, FSp, RATIO);
    hipLaunchKernelGGL(nv::k_encode, dim3(2048), dim3(256), 0, stream, SAVED, RATIO, (float*)d_out, (size_t)T * D, MK_DBG_THRESH, MK_DBG_ONLY);
}
#else
extern "C" void kernel_launch(void* const* d_in, const int* in_sizes, int n_in, void* d_out, int out_size, void* d_ws, size_t ws_size, hipStream_t stream) {
    if (n_in != 27 || in_sizes[0] != T * D || out_size != T * D) { fprintf(stderr, "kernel_launch: unexpected shapes n_in %d in0 %d out %d\n", n_in, n_in > 0 ? in_sizes[0] : -1, out_size); return; }
    (void)mk_launch(d_in, d_out, d_ws, ws_size, stream);
}
#endif
```

```cpp
#include <hip/hip_runtime.h>
#include <hip/hip_bf16.h>
#include <cstdio>
#include <cstdint>
#include <cmath>
namespace pg8 {
#define PG8_LAS __attribute__((address_space(3)))
typedef unsigned short bf16_t;
typedef short bf16x8 __attribute__((ext_vector_type(8)));
typedef float f32x4 __attribute__((ext_vector_type(4)));
typedef unsigned u32x4 __attribute__((ext_vector_type(4)));
constexpr int BM = 256, BK = 64, HALF = 128, HTB = HALF * BK * 2  , STAGE_BYTES = 8 * HTB, NXCD = 8, WGM = 8;

__host__ __device__ __forceinline__ int lds_byte(int r, int c) { const int st = (r >> 4) * 2 + (c >> 5), rr = r & 15, cc = c & 31, ob = rr * 64 + cc * 2; return st * 1024 + (ob ^ (((ob >> 9) & 1) << 5)); }
__host__ __device__ __forceinline__ void stage_rc(int b, int& R, int& C) { const int st = b / 1024, sb = b % 1024, swz = sb ^ (((sb >> 9) & 1) << 5); R = (st >> 1) * 16 + swz / 64; C = (st & 1) * 32 + (swz % 64) / 2; }
__host__ __device__ __forceinline__ int perm32(int rho) { const int n = rho >> 4, i = rho & 15; return 8 * (i >> 2) + 4 * n + (i & 3); }

struct Unit { int pm, pn, pb; };
struct Gemm { const bf16_t* A; const bf16_t* Bt; int M, N, K; };

struct StaticOrder {
    int nM, nN, nwg, G, c;
    __host__ __device__ void init(int M, int N, int G_, int c_) { nM = M / BM; nN = N / BM; nwg = nM * nN; G = G_; c = c_; }
    __host__ __device__ bool next(int i, Unit& u) const {
        const long L = (long)i * G + c; if (L >= nwg) return false;
        int wgid = (int)L; { const int q = nwg / NXCD, r = nwg % NXCD, xcd = wgid % NXCD, off = wgid / NXCD; wgid = (xcd < r ? xcd * (q + 1) : r * (q + 1) + (xcd - r) * q) + off; }
        const int nig = WGM * nN, gid = wgid / nig, fm = gid * WGM, gsz = (nM - fm) < WGM ? (nM - fm) : WGM;
        u.pm = fm + ((wgid % nig) % gsz); u.pn = (wgid % nig) / gsz; u.pb = u.pn; return true;
    }
    __device__ __forceinline__ void a_ready(const Unit&) const {}
    __device__ __forceinline__ void done(const Unit&) const {}
};

__device__ __forceinline__ unsigned cvt_pk_bf16(float lo, float hi) { unsigned r; asm volatile("v_cvt_pk_bf16_f32 %0, %1, %2" : "=v"(r) : "v"(lo), "v"(hi)); return r; }
typedef float f32x2 __attribute__((ext_vector_type(2)));
#define PG8_G __attribute__((address_space(1)))
__device__ __forceinline__ float row_rstd(const float* ssq, int row) {
    const PG8_G f32x4* p = (const PG8_G f32x4*)(ssq + (size_t)row * 16); const f32x4 a = p[0], b = p[1], c = p[2], d = p[3];
    const f32x4 t = (a + b) + (c + d); return __builtin_amdgcn_rsqf(((t[0] + t[1]) + (t[2] + t[3])) * (1.f / 1024.f) + 1e-6f); }
__device__ __forceinline__ float silu_f(float v) { return v * __builtin_amdgcn_rcpf(1.f + __builtin_amdgcn_exp2f(-1.4426950408889634f * v)); }
struct EpiProj {
    static constexpr bool PERM = true, AFTER_DRAIN = false, FRESH = false;
    bf16_t* O; int ldc; unsigned smask; float sc; int flo, fhi; float* F; int fld; const float* lbt; const float* ssq; unsigned* n2;
    __device__ __forceinline__ void operator()(const f32x4 (&acc)[2][2][4][2], const Unit& u, int wr, int wc, int fr, int fq) const {
        const int row0 = u.pm * BM + wr * 64 + fr, cin = wc * 32 + 8 * fq;
        const float s = ((smask >> u.pn) & 1u) ? sc : 1.f;
        float rs[2][4];
#pragma unroll
        for (int ai = 0; ai < 2; ++ai)
#pragma unroll
            for (int m = 0; m < 4; ++m) rs[ai][m] = ssq ? row_rstd(ssq, row0 + ai * HALF + m * 16) : 1.f;
        if (u.pn >= flo && u.pn < fhi) {
            const int col0 = (u.pn - flo) * BM + cin;
#pragma unroll
            for (int ai = 0; ai < 2; ++ai)
#pragma unroll
                for (int m = 0; m < 4; ++m) { float* rowp = F + (size_t)(row0 + ai * HALF + m * 16) * fld + col0;
#pragma unroll
                    for (int bj = 0; bj < 2; ++bj) { f32x4 v0 = acc[ai][bj][m][0] * rs[ai][m], v1 = acc[ai][bj][m][1] * rs[ai][m];
                        if (lbt) { const f32x4 l0 = *(const PG8_G f32x4*)(lbt + col0 + bj * HALF), l1 = *(const PG8_G f32x4*)(lbt + col0 + bj * HALF + 4);
#pragma unroll
                            for (int i = 0; i < 4; ++i) { v0[i] = __builtin_amdgcn_logf(l0[i] + (1.f - l0[i]) * __builtin_amdgcn_rcpf(1.f + __builtin_amdgcn_exp2f(-1.4426950408889634f * v0[i])));
                                v1[i] = __builtin_amdgcn_logf(l1[i] + (1.f - l1[i]) * __builtin_amdgcn_rcpf(1.f + __builtin_amdgcn_exp2f(-1.4426950408889634f * v1[i]))); } }
                        *(PG8_G f32x4*)(rowp + bj * HALF) = v0; *(PG8_G f32x4*)(rowp + bj * HALF + 4) = v1; } }
        } else {
            const int col0 = u.pn * BM + cin;
            const bool trk = n2 && u.pn < 6;
            const int ln = fq * 16 + fr;
#pragma unroll
            for (int ai = 0; ai < 2; ++ai) { float mx[2] = {0.f, 0.f};
#pragma unroll
                for (int m = 0; m < 4; ++m) { bf16_t* rowp = O + (size_t)(row0 + ai * HALF + m * 16) * ldc + col0;
#pragma unroll
                    for (int bj = 0; bj < 2; ++bj) { const f32x4 v0 = acc[ai][bj][m][0] * (s * rs[ai][m]), v1 = acc[ai][bj][m][1] * (s * rs[ai][m]);
                        u32x4 w; w.x = cvt_pk_bf16(v0[0], v0[1]); w.y = cvt_pk_bf16(v0[2], v0[3]); w.z = cvt_pk_bf16(v1[0], v1[1]); w.w = cvt_pk_bf16(v1[2], v1[3]);
                        *(PG8_G u32x4*)(rowp + bj * HALF) = w;
                        if (trk) { float ss = ((v0[0] * v0[0] + v0[1] * v0[1]) + (v0[2] * v0[2] + v0[3] * v0[3])) + ((v1[0] * v1[0] + v1[1] * v1[1]) + (v1[2] * v1[2] + v1[3] * v1[3]));
                            ss += __builtin_bit_cast(float, __builtin_amdgcn_ds_bpermute((ln ^ 16) << 2, __builtin_bit_cast(int, ss))); ss += __builtin_bit_cast(float, __builtin_amdgcn_ds_bpermute((ln ^ 32) << 2, __builtin_bit_cast(int, ss)));
                            mx[bj] = __builtin_fmaxf(mx[bj], ss); } } }
                if (trk) {
#pragma unroll
                    for (int bj = 0; bj < 2; ++bj) { float mv = mx[bj];
#pragma unroll
                        for (int o = 1; o < 16; o <<= 1) mv = __builtin_fmaxf(mv, __builtin_bit_cast(float, __builtin_amdgcn_ds_bpermute((ln ^ o) << 2, __builtin_bit_cast(int, mv))));
                        if (ln == 0) { const int rw = u.pm * BM + ai * HALF + wr * 64; const int idx = (((rw >> 12) * 24 + u.pn * 4 + 2 * bj + (wc >> 1)) * 64 + ((rw >> 6) & 63)) * 2 + (wc & 1);
                            ((PG8_G float*)n2)[idx] = mv; } } }
            }
        }
    }
};
__device__ __forceinline__ unsigned pk4_fp8(float a, float b, float c, float d) {
    a = __builtin_fminf(__builtin_fmaxf(a, -448.f), 448.f); b = __builtin_fminf(__builtin_fmaxf(b, -448.f), 448.f); c = __builtin_fminf(__builtin_fmaxf(c, -448.f), 448.f); d = __builtin_fminf(__builtin_fmaxf(d, -448.f), 448.f);
    int r = __builtin_amdgcn_cvt_pk_fp8_f32(a, b, 0, false); r = __builtin_amdgcn_cvt_pk_fp8_f32(c, d, r, true); return (unsigned)r; }
struct EpiResid {
    static constexpr bool PERM = true, AFTER_DRAIN = false, FRESH = true;
    float* X; const float* R; int ldc; bf16_t* XN; const float* gn; float* ssq; float asc;
    __device__ __forceinline__ void operator()(const f32x4 (&acc)[2][2][4][2], const Unit& u, int wr, int wc, int fr, int fq) const {
        const int row0 = u.pm * BM + wr * 64 + fr, col0 = u.pn * BM + wc * 32 + 8 * fq;
        f32x4 gv[2][2];
        if (XN) {
#pragma unroll
            for (int bj = 0; bj < 2; ++bj) { gv[bj][0] = *(const PG8_G f32x4*)(gn + col0 + bj * HALF); gv[bj][1] = *(const PG8_G f32x4*)(gn + col0 + bj * HALF + 4); } }
#pragma unroll
        for (int ai = 0; ai < 2; ++ai) {
            f32x4 r[4][2][2];
#pragma unroll
            for (int m = 0; m < 4; ++m) { const size_t off = (size_t)(row0 + ai * HALF + m * 16) * ldc + col0;
#pragma unroll
                for (int bj = 0; bj < 2; ++bj) { r[m][bj][0] = *(const PG8_G f32x4*)(R + off + bj * HALF); r[m][bj][1] = *(const PG8_G f32x4*)(R + off + bj * HALF + 4); } }
#pragma unroll
            for (int m = 0; m < 4; ++m) { const size_t off = (size_t)(row0 + ai * HALF + m * 16) * ldc + col0; float ss = 0.f;
#pragma unroll
                for (int bj = 0; bj < 2; ++bj) { const f32x4 x0 = r[m][bj][0] + acc[ai][bj][m][0] * asc, x1 = r[m][bj][1] + acc[ai][bj][m][1] * asc;
                    *(PG8_G f32x4*)(X + off + bj * HALF) = x0; *(PG8_G f32x4*)(X + off + bj * HALF + 4) = x1;
                    if (XN) { ss += (x0[0] * x0[0] + x0[1] * x0[1]) + (x0[2] * x0[2] + x0[3] * x0[3]) + (x1[0] * x1[0] + x1[1] * x1[1]) + (x1[2] * x1[2] + x1[3] * x1[3]);
                        const f32x4 y0 = x0 * gv[bj][0], y1 = x1 * gv[bj][1]; u32x4 w; w.x = cvt_pk_bf16(y0[0], y0[1]); w.y = cvt_pk_bf16(y0[2], y0[3]); w.z = cvt_pk_bf16(y1[0], y1[1]); w.w = cvt_pk_bf16(y1[2], y1[3]);
                        *(PG8_G u32x4*)(XN + off + bj * HALF) = w; } }
                if (XN) { const int ln = fq * 16 + fr;
                    ss += __builtin_bit_cast(float, __builtin_amdgcn_ds_bpermute((ln ^ 16) << 2, __builtin_bit_cast(int, ss))); ss += __builtin_bit_cast(float, __builtin_amdgcn_ds_bpermute((ln ^ 32) << 2, __builtin_bit_cast(int, ss)));
                    if (fq == 0) ((PG8_G float*)ssq)[(size_t)(row0 + ai * HALF + m * 16) * 16 + u.pn * 4 + wc] = ss; } }
        }
    }
};
template <bool F8> struct EpiSwiglu {
    static constexpr bool PERM = true, AFTER_DRAIN = false, FRESH = false;
    bf16_t* H; int ldh; float insc, outsc; const float* ssq;
    __device__ __forceinline__ void operator()(const f32x4 (&acc)[2][2][4][2], const Unit& u, int wr, int wc, int fr, int fq) const {
        const int row0 = u.pm * BM + wr * 64 + fr, col0 = u.pn * HALF + wc * 32 + 8 * fq;
#pragma unroll
        for (int ai = 0; ai < 2; ++ai)
#pragma unroll
            for (int m = 0; m < 4; ++m) {
                const f32x4 g0 = acc[ai][0][m][0], g1 = acc[ai][0][m][1], u0 = acc[ai][1][m][0], u1 = acc[ai][1][m][1];
                float sg = ssq ? row_rstd(ssq, row0 + ai * HALF + m * 16) : 1.f, su = sg; if (F8) { sg *= insc; su *= insc * outsc; }
                const float k1 = -1.4426950408889634f * sg, ic = __builtin_amdgcn_rcpf(sg * su);
                f32x4 t0 = g0 * k1, t1 = g1 * k1;
#pragma unroll
                for (int i = 0; i < 4; ++i) { t0[i] = __builtin_amdgcn_exp2f(t0[i]); t1[i] = __builtin_amdgcn_exp2f(t1[i]); }
                t0 = t0 * ic + ic; t1 = t1 * ic + ic;
#pragma unroll
                for (int i = 0; i < 4; ++i) { t0[i] = __builtin_amdgcn_rcpf(t0[i]); t1[i] = __builtin_amdgcn_rcpf(t1[i]); }
                const f32x4 h0 = (g0 * u0) * t0, h1 = (g1 * u1) * t1;
                if (F8) { typedef unsigned u32x2 __attribute__((ext_vector_type(2))); u32x2 w; w.x = pk4_fp8(h0[0], h0[1], h0[2], h0[3]); w.y = pk4_fp8(h1[0], h1[1], h1[2], h1[3]);
                    *(PG8_G u32x2*)((unsigned char*)H + (size_t)(row0 + ai * HALF + m * 16) * ldh + col0) = w;
                } else { bf16_t* rowp = H + (size_t)(row0 + ai * HALF + m * 16) * ldh + col0;
                    u32x4 w; w.x = cvt_pk_bf16(h0[0], h0[1]); w.y = cvt_pk_bf16(h0[2], h0[3]); w.z = cvt_pk_bf16(h1[0], h1[1]); w.w = cvt_pk_bf16(h1[2], h1[3]);
                    *(PG8_G u32x4*)rowp = w; }
            }
    }
};
struct MoeOrder {
    int nM, nN, nwg, G, c; int tb1, tb2, tb3, tb4, tb5, tb6, tb7;
    __device__ __forceinline__ void init(const int (&cnt)[8], int nN_, int G_, int c_) {
        int t = 0; t += (cnt[0] + 255) >> 8; tb1 = t; t += (cnt[1] + 255) >> 8; tb2 = t; t += (cnt[2] + 255) >> 8; tb3 = t; t += (cnt[3] + 255) >> 8; tb4 = t;
        t += (cnt[4] + 255) >> 8; tb5 = t; t += (cnt[5] + 255) >> 8; tb6 = t; t += (cnt[6] + 255) >> 8; tb7 = t; t += (cnt[7] + 255) >> 8;
        nM = t; nN = nN_; nwg = nM * nN; G = G_; c = c_; }
    __device__ __forceinline__ bool next(int i, Unit& u) const {
        const long L = (long)i * G + c; if (L >= nwg) return false;
        int wgid = (int)L; { const int q = nwg / NXCD, r = nwg % NXCD, xcd = wgid % NXCD, off = wgid / NXCD; wgid = (xcd < r ? xcd * (q + 1) : r * (q + 1) + (xcd - r) * q) + off; }
        const int nig = WGM * nN, gid = wgid / nig, fm = gid * WGM, gsz = (nM - fm) < WGM ? (nM - fm) : WGM;
        u.pm = fm + ((wgid % nig) % gsz); u.pn = (wgid % nig) / gsz;
        const int e = (u.pm >= tb1) + (u.pm >= tb2) + (u.pm >= tb3) + (u.pm >= tb4) + (u.pm >= tb5) + (u.pm >= tb6) + (u.pm >= tb7);
        u.pb = e * nN + u.pn; return true;
    }
    __device__ __forceinline__ void a_ready(const Unit&) const {}
    __device__ __forceinline__ void done(const Unit&) const {}
};

template <class Epi, class Sched, bool ALIGN_EPI = false, bool SP2 = false, bool FP8 = false>
__device__ __forceinline__ void gemm_phase(PG8_LAS unsigned char* lds, const Gemm g, const Sched& S, const Epi& E, const int wid_in) {
    int lane_; asm volatile("v_mbcnt_lo_u32_b32 %0, -1, 0\n\tv_mbcnt_hi_u32_b32 %0, -1, %0" : "=v"(lane_));
    const int wid = wid_in, lane = lane_, tid = wid * 64 + lane, wr = wid >> 2, wc = wid & 3, fr = lane & 15, fq = lane >> 4;
    const int K = g.K, nt = K / BK;
    unsigned voffA[2], voffB[2];
#pragma unroll
    for (int i = 0; i < 2; ++i) { int R, C; stage_rc(tid * 16 + i * 8192, R, C); const int Rb = Epi::PERM ? ((R & ~31) + perm32(R & 31)) : R;
        voffA[i] = (unsigned)(R * K + C) * 2u; voffB[i] = (unsigned)(Rb * K + C) * 2u; }
    const size_t kstep = (size_t)(BK * 2);
    const size_t hstep = (size_t)HALF * K * 2;
    const size_t tstep = 2 * hstep;
    const unsigned ldsw = (unsigned)wid * 1024u;
    const unsigned ldsb = (unsigned)__builtin_amdgcn_readfirstlane((int)((unsigned)(uintptr_t)lds + ldsw));
    const int aoff = lds_byte(wr * 64 + fr, fq * 8), boff = lds_byte(wc * 32 + fr, fq * 8);
#define PG8_SA(b, h) (((b) * 2 + (h)) * HTB)
#define PG8_SB(b, h) ((4 + (b) * 2 + (h)) * HTB)
#define PG8_STAGE(bufoff, gbase, voff) do { _Pragma("unroll") for (int _i = 0; _i < 2; ++_i) { unsigned keep_; \
        asm volatile("s_mov_b32 %0, m0\n\ts_mov_b32 m0, %3\n\ts_nop 0\n\tglobal_load_lds_dwordx4 %1, %2\n\ts_mov_b32 m0, %0" : "=&s"(keep_) : "v"((voff)[_i]), "s"((const char*)(gbase)), "s"(ldsb + (unsigned)((bufoff) + _i * 8192)) : "memory"); } } while (0)
#define PG8_LDA(dst, b, h) do { _Pragma("unroll") for (int m = 0; m < 4; ++m) _Pragma("unroll") for (int k = 0; k < 2; ++k) dst[m][k] = *(const PG8_LAS bf16x8*)(lds + PG8_SA(b, h) + aoff + m * 2048 + k * 1024); } while (0)
#define PG8_LDB(dst, b, h) do { _Pragma("unroll") for (int n = 0; n < 2; ++n) _Pragma("unroll") for (int k = 0; k < 2; ++k) dst[n][k] = *(const PG8_LAS bf16x8*)(lds + PG8_SB(b, h) + boff + n * 2048 + k * 1024); } while (0)
#define PG8_MMA(ai, bj, At, Bt) do { __builtin_amdgcn_s_setprio(1); _Pragma("unroll") for (int m = 0; m < 4; ++m) _Pragma("unroll") for (int n = 0; n < 2; ++n) { \
        if constexpr (FP8) { typedef int v4i_ __attribute__((ext_vector_type(4))); typedef int v8i_ __attribute__((ext_vector_type(8))); \
            const v8i_ b8 = __builtin_shufflevector(__builtin_bit_cast(v4i_, Bt[n][0]), __builtin_bit_cast(v4i_, Bt[n][1]), 0, 1, 2, 3, 4, 5, 6, 7), a8 = __builtin_shufflevector(__builtin_bit_cast(v4i_, At[m][0]), __builtin_bit_cast(v4i_, At[m][1]), 0, 1, 2, 3, 4, 5, 6, 7); \
            acc[ai][bj][m][n] = __builtin_amdgcn_mfma_scale_f32_16x16x128_f8f6f4(b8, a8, acc[ai][bj][m][n], 0, 0, 0, 0, 0, 0); } \
        else { _Pragma("unroll") for (int k = 0; k < 2; ++k) acc[ai][bj][m][n] = __builtin_amdgcn_mfma_f32_16x16x32_bf16(Bt[n][k], At[m][k], acc[ai][bj][m][n], 0, 0, 0); } } \
        __builtin_amdgcn_s_setprio(0); } while (0)
#define PG8_WAIT_V(n) asm volatile("s_waitcnt vmcnt(" #n ")" ::: "memory")
#define PG8_WAIT_L(n) asm volatile("s_waitcnt lgkmcnt(" #n ")" ::: "memory")
#define PG8_BAR __builtin_amdgcn_s_barrier()
#define PG8_SCHED __builtin_amdgcn_sched_barrier(0)
    Unit cur, nxt; int ui = 0;
    if (!S.next(0, cur)) return;
    f32x4 acc[2][2][4][2];
#pragma unroll
    for (int a = 0; a < 2; ++a)
#pragma unroll
        for (int b = 0; b < 2; ++b)
#pragma unroll
            for (int m = 0; m < 4; ++m)
#pragma unroll
                for (int n = 0; n < 2; ++n) acc[a][b][m][n] = (f32x4){0.f, 0.f, 0.f, 0.f};
    bf16x8 At[4][2], B0[2][2], B1[2][2];
    const char* cA = (const char*)g.A + (size_t)cur.pm * tstep; const char* cB = (const char*)g.Bt + (size_t)cur.pb * tstep;
    S.a_ready(cur);
    if constexpr (SP2) {
        PG8_STAGE(PG8_SB(0, 0), cB, voffB); PG8_STAGE(PG8_SB(0, 1), cB + hstep, voffB); PG8_STAGE(PG8_SA(0, 0), cA, voffA); PG8_STAGE(PG8_SA(0, 1), cA + hstep, voffA);
        if (wr == 1) PG8_BAR;
        PG8_WAIT_V(2); PG8_BAR;
        PG8_STAGE(PG8_SB(1, 0), cB + kstep, voffB); PG8_STAGE(PG8_SA(1, 0), cA + kstep, voffA); PG8_STAGE(PG8_SB(1, 1), cB + hstep + kstep, voffB);
        PG8_WAIT_V(6); PG8_BAR;
    } else {
        PG8_STAGE(PG8_SB(0, 0), cB, voffB); PG8_STAGE(PG8_SA(0, 0), cA, voffA); PG8_STAGE(PG8_SB(0, 1), cB + hstep, voffB); PG8_STAGE(PG8_SA(0, 1), cA + hstep, voffA);
        if (wr == 1) PG8_BAR;
        PG8_WAIT_V(4); PG8_BAR;
        PG8_STAGE(PG8_SB(1, 0), cB + kstep, voffB); PG8_STAGE(PG8_SA(1, 0), cA + kstep, voffA); PG8_STAGE(PG8_SB(1, 1), cB + hstep + kstep, voffB);
        PG8_WAIT_V(6); PG8_BAR;
    }
    for (;;) {
        const bool has_next = S.next(ui + 1, nxt);
        const char* nA = has_next ? (const char*)g.A + (size_t)nxt.pm * tstep : cA; const char* nB = has_next ? (const char*)g.Bt + (size_t)nxt.pb * tstep : cB;
        for (int t = 0; t < nt; t += 2) {
            const bool last = (t == nt - 2);
            const char* a1 = cA + (size_t)(t + 1) * kstep;
            const char* a2 = last ? nA : cA + (size_t)(t + 2) * kstep; const char* b2 = last ? nB : cB + (size_t)(t + 2) * kstep;
            const char* a3 = a2 + kstep; const char* b3 = b2 + kstep;
            if (last && has_next) S.a_ready(nxt);
            if constexpr (SP2) {
            PG8_LDB(B0, 0, 0); PG8_LDB(B1, 0, 1); PG8_SCHED; PG8_LDA(At, 0, 0); PG8_STAGE(PG8_SA(1, 1), a1 + hstep, voffA);
            PG8_WAIT_V(8); PG8_WAIT_L(0); PG8_BAR; PG8_MMA(0, 0, At, B0); PG8_MMA(0, 1, At, B1); PG8_BAR; PG8_SCHED;
            PG8_LDA(At, 0, 1); PG8_STAGE(PG8_SB(0, 0), b2, voffB); PG8_STAGE(PG8_SB(0, 1), b2 + hstep, voffB); PG8_STAGE(PG8_SA(0, 0), a2, voffA);
            PG8_WAIT_V(8); PG8_WAIT_L(0); PG8_BAR; PG8_MMA(1, 0, At, B0); PG8_MMA(1, 1, At, B1); PG8_BAR; PG8_SCHED;
            PG8_LDB(B0, 1, 0); PG8_LDB(B1, 1, 1); PG8_SCHED; PG8_LDA(At, 1, 0); PG8_STAGE(PG8_SA(0, 1), a2 + hstep, voffA);
            PG8_WAIT_V(8); PG8_WAIT_L(0); PG8_BAR; PG8_MMA(0, 0, At, B0); PG8_MMA(0, 1, At, B1); PG8_BAR; PG8_SCHED;
            PG8_LDA(At, 1, 1); PG8_STAGE(PG8_SB(1, 0), b3, voffB); PG8_STAGE(PG8_SB(1, 1), b3 + hstep, voffB); PG8_STAGE(PG8_SA(1, 0), a3, voffA);
            PG8_WAIT_V(8); PG8_WAIT_L(0); PG8_BAR; PG8_MMA(1, 0, At, B0); PG8_MMA(1, 1, At, B1); PG8_BAR; PG8_SCHED;
            } else {
            PG8_LDB(B0, 0, 0); PG8_SCHED; PG8_LDA(At, 0, 0); PG8_STAGE(PG8_SA(1, 1), a1 + hstep, voffA);
            PG8_WAIT_L(8); PG8_BAR; PG8_WAIT_L(0); PG8_MMA(0, 0, At, B0); PG8_BAR; PG8_SCHED;
            PG8_LDB(B1, 0, 1); PG8_STAGE(PG8_SB(0, 0), b2, voffB);
            PG8_BAR; PG8_WAIT_L(0); PG8_MMA(0, 1, At, B1); PG8_BAR;
            PG8_LDA(At, 0, 1); PG8_STAGE(PG8_SA(0, 0), a2, voffA);
            PG8_BAR; PG8_WAIT_L(0); PG8_MMA(1, 0, At, B0); PG8_BAR; PG8_SCHED;
            PG8_STAGE(PG8_SB(0, 1), b2 + hstep, voffB);
            PG8_WAIT_V(6); PG8_BAR; PG8_MMA(1, 1, At, B1); PG8_BAR;
            PG8_LDB(B0, 1, 0); PG8_SCHED; PG8_LDA(At, 1, 0); PG8_STAGE(PG8_SA(0, 1), a2 + hstep, voffA);
            PG8_WAIT_L(8); PG8_BAR; PG8_WAIT_L(0); PG8_MMA(0, 0, At, B0); PG8_BAR; PG8_SCHED;
            PG8_LDB(B1, 1, 1); PG8_STAGE(PG8_SB(1, 0), b3, voffB);
            PG8_BAR; PG8_WAIT_L(0); PG8_MMA(0, 1, At, B1); PG8_BAR;
            PG8_LDA(At, 1, 1); PG8_STAGE(PG8_SA(1, 0), a3, voffA);
            PG8_BAR; PG8_WAIT_L(0); PG8_MMA(1, 0, At, B0); PG8_BAR; PG8_SCHED;
            PG8_STAGE(PG8_SB(1, 1), b3 + hstep, voffB);
            PG8_WAIT_V(6); PG8_BAR; PG8_MMA(1, 1, At, B1); PG8_BAR;
            }
        }
        if constexpr (ALIGN_EPI) { if (wr == 0) PG8_BAR; }
        if constexpr (!Epi::AFTER_DRAIN) {
            if constexpr (FP8 || Epi::FRESH) { int l2_; asm volatile("v_mbcnt_lo_u32_b32 %0, -1, 0\n\tv_mbcnt_hi_u32_b32 %0, -1, %0" : "=v"(l2_)); E(acc, cur, wr, wc, l2_ & 15, l2_ >> 4); }
            else E(acc, cur, wr, wc, fr, fq);
            S.done(cur); }
        if (!has_next) break;
#pragma unroll
        for (int a = 0; a < 2; ++a)
#pragma unroll
            for (int b = 0; b < 2; ++b)
#pragma unroll
                for (int m = 0; m < 4; ++m)
#pragma unroll
                    for (int n = 0; n < 2; ++n) acc[a][b][m][n] = (f32x4){0.f, 0.f, 0.f, 0.f};
        cur = nxt; cA = nA; cB = nB; ++ui;
        if constexpr (ALIGN_EPI) { if (wr == 1) PG8_BAR; }
    }
    PG8_WAIT_V(0);
    if constexpr (!ALIGN_EPI) { if (wr == 0) PG8_BAR; }
    PG8_BAR;
    if constexpr (Epi::AFTER_DRAIN) { E.fused(acc, cur, wr, wc, fr, fq, lds, wid, lane); S.done(cur); }
#undef PG8_SA
#undef PG8_SB
#undef PG8_STAGE
#undef PG8_LDA
#undef PG8_LDB
#undef PG8_MMA
#undef PG8_WAIT_V
#undef PG8_WAIT_L
#undef PG8_BAR
#undef PG8_SCHED
}
}
#include <hip/hip_bf16.h>
#include <cmath>
namespace attn_body {
using bf16=__hip_bfloat16;
using bf16x8=__attribute__((ext_vector_type(8)))short;
using s16x4=__attribute__((ext_vector_type(4)))short;
using f32x16=__attribute__((ext_vector_type(16)))float;
using u32x4=__attribute__((ext_vector_type(4)))unsigned;
constexpr int D=64;
constexpr int NW=8,QBLK=32,QB=QBLK*NW,KVBLK=64;
constexpr int ATTN_UNIT_ROWS=QB;
__device__ __forceinline__ int crow(int r,int hi){return (r&3)+8*(r>>2)+4*hi;}
#define SBAR() __builtin_amdgcn_sched_barrier(0)
__device__ __forceinline__ void cmask_blk(f32x16&p0,f32x16&p1,int jb,int wid){
  if(jb>(wid>>1)){ const float NEG=-INFINITY;
    #pragma unroll
    for(int r=0;r<16;++r){p0[r]=NEG;p1[r]=NEG;} }
}
__device__ __forceinline__ void alibi(f32x16&p0,f32x16&p1,float dq,float nsl2){
  #pragma unroll
  for(int r=0;r<16;++r){ const float e=(float)((r&3)+8*(r>>2)); p0[r]=__builtin_fmaf(__builtin_fabsf(dq-e),nsl2,p0[r]); p1[r]=__builtin_fmaf(__builtin_fabsf(dq-e-32.f),nsl2,p1[r]); }
}

constexpr int NSLOT=3, SLOTB=8192;
constexpr int LDS_K=0, LDS_V=NSLOT*SLOTB, LDS_WS=2*NSLOT*SLOTB, LDS_OST=LDS_WS+NW*64*4, LDS_BYTES=LDS_OST+NW*4096;
constexpr float C2=0.125f*1.4426950408889634f;
__device__ __forceinline__ void glds16(const void*gsrc,unsigned lds_dst){unsigned keep;
  asm volatile("s_mov_b32 %0, m0\n\ts_mov_b32 m0, %2\n\ts_nop 0\n\tglobal_load_lds_dwordx4 %1, off\n\ts_mov_b32 m0, %0":"=&s"(keep):"v"(gsrc),"s"(lds_dst):"memory");}
__device__ __forceinline__ float max3f(float a,float b,float c){float r;asm("v_max3_f32 %0, %1, %2, %3":"=v"(r):"v"(a),"v"(b),"v"(c));return r;}
__device__ __forceinline__ float max2f(float a,float b){float r;asm("v_max_f32_e32 %0, %1, %2":"=v"(r):"v"(a),"v"(b));return r;}
__device__ __forceinline__ float fadd_s(float a,float b){float r;asm("v_add_f32_e32 %0, %1, %2":"=v"(r):"v"(a),"v"(b));return r;}
__device__ __forceinline__ float fsub_s(float a,float b){float r;asm("v_sub_f32_e32 %0, %1, %2":"=v"(r):"v"(a),"v"(b));return r;}
typedef float f32x2_t __attribute__((ext_vector_type(2))); typedef __bf16 bf16x2_t __attribute__((ext_vector_type(2)));
__device__ __forceinline__ unsigned cvtpk_s(float lo,float hi){f32x2_t v={lo,hi};bf16x2_t b=__builtin_convertvector(v,bf16x2_t);return __builtin_bit_cast(unsigned,b);}
#define WAIT_BAR(N) asm volatile("s_waitcnt vmcnt(" #N ") lgkmcnt(0)\n\ts_barrier":::"memory")

__device__ __forceinline__ void qkt(f32x16&p0,f32x16&p1,const char*Kslot,const bf16x8*qr,const f32x16&negm,int r32,int hi){
  const char*kb=Kslot+hi*1024+r32*16;
  #pragma unroll
  for(int d0=0;d0<4;++d0){
    const bf16x8 b0=*reinterpret_cast<const bf16x8*>(kb+d0*2048);
    const bf16x8 b1=*reinterpret_cast<const bf16x8*>(kb+d0*2048+512);
    if(d0==0){p0=__builtin_amdgcn_mfma_f32_32x32x16_bf16(b0,qr[0],negm,0,0,0);p1=__builtin_amdgcn_mfma_f32_32x32x16_bf16(b1,qr[0],negm,0,0,0);}
    else{p0=__builtin_amdgcn_mfma_f32_32x32x16_bf16(b0,qr[d0],p0,0,0,0);p1=__builtin_amdgcn_mfma_f32_32x32x16_bf16(b1,qr[d0],p1,0,0,0);}}
}
typedef __attribute__((address_space(3))) const char* lds_cptr;
typedef short v4i16_t __attribute__((ext_vector_type(4)));
__device__ __forceinline__ void kload8(bf16x8*kf,lds_cptr kp){
  kf[0]=*(const __attribute__((address_space(3))) bf16x8*)(kp);      kf[1]=*(const __attribute__((address_space(3))) bf16x8*)(kp+512);
  kf[2]=*(const __attribute__((address_space(3))) bf16x8*)(kp+2048); kf[3]=*(const __attribute__((address_space(3))) bf16x8*)(kp+2560);
  kf[4]=*(const __attribute__((address_space(3))) bf16x8*)(kp+4096); kf[5]=*(const __attribute__((address_space(3))) bf16x8*)(kp+4608);
  kf[6]=*(const __attribute__((address_space(3))) bf16x8*)(kp+6144); kf[7]=*(const __attribute__((address_space(3))) bf16x8*)(kp+6656);
}
__device__ __forceinline__ void kload2(bf16x8*kf,lds_cptr kp,int j){ kf[2*j]=*(const __attribute__((address_space(3))) bf16x8*)(kp+j*2048); kf[2*j+1]=*(const __attribute__((address_space(3))) bf16x8*)(kp+j*2048+512); }
__device__ __forceinline__ s16x4 vtr(lds_cptr p){ return __builtin_bit_cast(s16x4,__builtin_amdgcn_ds_read_tr16_b64_v4i16((__attribute__((address_space(3))) v4i16_t*)p)); }
__device__ __forceinline__ float rowmax(const f32x16&p0,const f32x16&p1){
  float a=max3f(p0[0],p0[1],p1[0]),b=max3f(p0[2],p0[3],p1[1]);a=max3f(a,p1[2],p1[3]);
  #pragma unroll
  for(int r=4;r<16;r+=4){a=max3f(a,p0[r],p0[r+1]);b=max3f(b,p0[r+2],p0[r+3]);a=max3f(a,p1[r],p1[r+1]);b=max3f(b,p1[r+2],p1[r+3]);}
  const float m=max2f(a,b);
  auto rr=__builtin_amdgcn_permlane32_swap(__float_as_uint(m),__float_as_uint(m),false,false);
  return max2f(__uint_as_float(rr[0]),__uint_as_float(rr[1]));
}
__device__ __forceinline__ void pv(f32x16*o,int vb,bf16x8 pa0,bf16x8 pa1,bf16x8 pa2,bf16x8 pa3){
  #pragma unroll
  for(int d0=0;d0<2;++d0){s16x4 lo[4],hi[4];
    #pragma unroll
    for(int ks=0;ks<4;++ks){
      asm volatile("ds_read_b64_tr_b16 %0,%1 offset:%c2":"=&v"(lo[ks]):"v"(vb),"i"(d0*4096+ks*1024):"memory");
      asm volatile("ds_read_b64_tr_b16 %0,%1 offset:%c2":"=&v"(hi[ks]):"v"(vb),"i"(d0*4096+ks*1024+512):"memory");}
    asm volatile("s_waitcnt lgkmcnt(0)":::"memory");SBAR();
    #define PK(k) (bf16x8){lo[k][0],lo[k][1],lo[k][2],lo[k][3],hi[k][0],hi[k][1],hi[k][2],hi[k][3]}
    o[d0]=__builtin_amdgcn_mfma_f32_32x32x16_bf16(pa0,PK(0),o[d0],0,0,0);
    o[d0]=__builtin_amdgcn_mfma_f32_32x32x16_bf16(pa1,PK(1),o[d0],0,0,0);
    o[d0]=__builtin_amdgcn_mfma_f32_32x32x16_bf16(pa2,PK(2),o[d0],0,0,0);
    o[d0]=__builtin_amdgcn_mfma_f32_32x32x16_bf16(pa3,PK(3),o[d0],0,0,0);
    #undef PK
  }
}

#ifndef ATTN_STORE16
#define ATTN_STORE16(p,v) (*(u32x4*)(p)=(v))
#endif
template<int MODE,int THRL> __device__ __forceinline__ void attn_unit(const bf16*Qb,int qp,const bf16*__restrict__ Kh,int kp,const bf16*__restrict__ Vh,int vp,bf16*Ob,int op,int NT,int q0,float nsl2,char*shm,const int wid_in){
  int lane_; asm volatile("v_mbcnt_lo_u32_b32 %0, -1, 0\n\tv_mbcnt_hi_u32_b32 %0, -1, %0":"=v"(lane_)); const int lane=lane_,r32=lane&31,hi=lane>>5; const int wid=wid_in,tid=wid*64+lane; (void)tid;
  const bf16*Qw=Qb+(long)(wid*QBLK)*qp;
  const unsigned lds0=(unsigned)(uintptr_t)shm;
  float*wsf=(float*)(shm+LDS_WS)+wid*64;
  const bf16*ksrc=Kh+(long)lane*kp+wid*8;
  const bf16*vsrc=Vh+(long)(16*(wid&3)+(lane>>2))*vp+(wid>>2)*32+(lane&3)*8;
  const unsigned kdst=lds0+LDS_K+wid*1024, vdst=lds0+LDS_V+wid*1024;
  #define DMA_K(t,slot) glds16(ksrc+(long)(t)*KVBLK*kp,(unsigned)__builtin_amdgcn_readfirstlane(kdst+(slot)))
  #define DMA_V(t,slot) glds16(vsrc+(long)(t)*KVBLK*vp,(unsigned)__builtin_amdgcn_readfirstlane(vdst+(slot)))
  const int vb0=(int)(lds0+LDS_V)+((lane>>4)&1)*32+(lane&3)*8+(4*hi+((lane&15)>>2))*64;
  const char*Kbase=shm+LDS_K; bf16x8 kf[8];
  const lds_cptr shm3=(lds_cptr)shm; const lds_cptr kp0=shm3+LDS_K+hi*1024+r32*16; const lds_cptr vp0=shm3+LDS_V+((lane>>4)&1)*32+(lane&3)*8+(4*hi+((lane&15)>>2))*64;
  DMA_K(0,0);DMA_V(0,0);DMA_K(1,SLOTB);
  bf16x8 qr[4];
  #pragma unroll
  for(int d0=0;d0<4;++d0)qr[d0]=*reinterpret_cast<const bf16x8*>(&Qw[(long)r32*qp+d0*16+hi*8]);
  float mhat=0.f,l_reg=0.f;f32x16 o[2];float z_=0.f;asm volatile("":"+v"(z_));
  _Pragma("unroll") for(int r=0;r<16;++r){o[0][r]=z_;o[1][r]=z_;} f32x16 negm;_Pragma("unroll") for(int r=0;r<16;++r)negm[r]=z_;asm volatile("":"+v"(negm));
  const float dq0=(float)(q0+wid*QBLK+r32-4*hi);
  #define ALIBI(P0,P1,t) do{ if(MODE==0) alibi(P0,P1,dq0-(float)(64*(t)),nsl2); }while(0)
  #define CMASK(P0,P1,t) do{ if(MODE==0){int jb_=(t)-(NT-4); if(jb_>=0)cmask_blk(P0,P1,jb_,wid);} }while(0)
  bool resc=false;
  #define START(P0,P1) do{ const float rm=rm0_; resc=false; \
    { const float dl=rm; mhat=fadd_s(mhat,dl); \
      _Pragma("unroll") for(int r=0;r<16;++r){P0[r]=fsub_s(P0[r],dl);P1[r]=fsub_s(P1[r],dl);} \
      _Pragma("unroll") for(int r=0;r<16;++r)negm[r]=-mhat; asm volatile("":"+v"(negm)); } \
    _Pragma("unroll") for(int r=0;r<16;++r)P0[r]=__builtin_amdgcn_exp2f(P0[r]); }while(0)
  #define RESC() do{ if(resc){ asm volatile("s_waitcnt lgkmcnt(0)":::"memory"); \
      _Pragma("unroll") for(int d_=0;d_<2;++d_) _Pragma("unroll") for(int r=0;r<16;++r)o[d_][r]*=wsf[crow(r,hi)]; } }while(0)
  f32x16 pA0,pA1,pB0,pB1;
  int sl_prev=0,sl_cur=0,sl_next=SLOTB;
  #define ROT() do{sl_prev=sl_cur;sl_cur=sl_next;sl_next=(sl_next==(NSLOT-1)*SLOTB)?0:sl_next+SLOTB;}while(0)
  DMA_K(2,2*SLOTB);
  WAIT_BAR(3);
  qkt(pA0,pA1,Kbase,qr,negm,r32,hi);asm volatile("s_nop 15\n\ts_nop 7":"+v"(pA0),"+v"(pA1));const float rm0_=rowmax(pA0,pA1);
  ALIBI(pA0,pA1,0);CMASK(pA0,pA1,0);
  START(pA0,pA1);
  _Pragma("unroll") for(int r=0;r<16;++r)pA1[r]=__builtin_amdgcn_exp2f(pA1[r]);
  WAIT_BAR(0);
  DMA_K(3,0);DMA_V(1,SLOTB);
  ROT();
  kload8(kf,kp0+sl_cur);
  WAIT_BAR(2);
  s16x4 vlo[8],vhi[8]; u32x4 pw0,pw1,pw2,pw3;
  #define PKW(P,B) cvtpk_s(P[B],P[B+1])
  #define PAF(k) __builtin_bit_cast(bf16x8,pw##k)
  #define VFR(i) (bf16x8){vlo[i][0],vlo[i][1],vlo[i][2],vlo[i][3],vhi[i][0],vhi[i][1],vhi[i][2],vhi[i][3]}
  #define PIN(x) asm volatile("":"+v"(x))
  #define MX3(a,b,c) __builtin_fmaxf(__builtin_fmaxf((a),(b)),(c))
  #define GAPA(MF,A0,A1,A2,A3,W0,W1,PW) do{ MF; sacc+=A0; sacc+=A1; sacc+=A2; sacc+=A3; PIN(sacc); W0; W1; PIN(PW); SBAR(); }while(0)
  #define EX(v) __builtin_amdgcn_exp2f(v)
  #define GAPB(MF,X,B) do{ MF; X[B]=EX(X[B]); X[B+1]=EX(X[B+1]); X[B+2]=EX(X[B+2]); X[B+3]=EX(X[B+3]); PIN(X); SBAR(); }while(0)
  #define VRD(i) do{ vlo[i]=vtr(vp_+(((i)>>2)*4096+((i)&3)*1024)); vhi[i]=vtr(vp_+(((i)>>2)*4096+((i)&3)*1024+512)); }while(0)
  #define KRD(G,j) do{ if(G){ kload2(kf,kp0+sl_next,j); SBAR(); } }while(0)
  #define STEP(C0,C1,P0,P1,t,GK,GV,GL) do{ SBAR(); \
    const lds_cptr vp_=vp0+sl_prev; \
    VRD(0); SBAR(); float sacc=(P0[0]+P0[1]); \
    GAPA(C0=__builtin_amdgcn_mfma_f32_32x32x16_bf16(kf[0],qr[0],negm,0,0,0), P0[2],P0[3],P0[4],P0[5],     pw0[0]=PKW(P0,0), pw0[1]=PKW(P0,2), pw0); \
    VRD(4); SBAR(); GAPA(C1=__builtin_amdgcn_mfma_f32_32x32x16_bf16(kf[1],qr[0],negm,0,0,0), P0[6],P0[7],P0[8],P0[9],     pw0[2]=PKW(P0,4), pw0[3]=PKW(P0,6), pw0); \
    VRD(1); SBAR(); GAPA(C0=__builtin_amdgcn_mfma_f32_32x32x16_bf16(kf[2],qr[1],C0,0,0,0),   P0[10],P0[11],P0[12],P0[13], pw1[0]=PKW(P0,8), pw1[1]=PKW(P0,10), pw1); \
    VRD(5); SBAR(); GAPA(C1=__builtin_amdgcn_mfma_f32_32x32x16_bf16(kf[3],qr[1],C1,0,0,0),   P0[14],P0[15],P1[0],P1[1],   pw1[2]=PKW(P0,12),pw1[3]=PKW(P0,14), pw1); \
    VRD(2); SBAR(); GAPA(C0=__builtin_amdgcn_mfma_f32_32x32x16_bf16(kf[4],qr[2],C0,0,0,0),   P1[2],P1[3],P1[4],P1[5],     pw2[0]=PKW(P1,0), pw2[1]=PKW(P1,2), pw2); \
    VRD(6); SBAR(); GAPA(C1=__builtin_amdgcn_mfma_f32_32x32x16_bf16(kf[5],qr[2],C1,0,0,0),   P1[6],P1[7],P1[8],P1[9],     pw2[2]=PKW(P1,4), pw2[3]=PKW(P1,6), pw2); \
    VRD(3); SBAR(); GAPA(C0=__builtin_amdgcn_mfma_f32_32x32x16_bf16(kf[6],qr[3],C0,0,0,0),   P1[10],P1[11],P1[12],P1[13], pw3[0]=PKW(P1,8), pw3[1]=PKW(P1,10), pw3); \
    VRD(7); SBAR(); GAPA(C1=__builtin_amdgcn_mfma_f32_32x32x16_bf16(kf[7],qr[3],C1,0,0,0),   P1[14],P1[15],0.f,0.f,       pw3[2]=PKW(P1,12),pw3[3]=PKW(P1,14), pw3); \
    l_reg+=sacc; \
    if(GK){DMA_K((t)+3,sl_cur);} if(GV){DMA_V((t)+1,sl_next);} \
    ALIBI(C0,C1,t); CMASK(C0,C1,t); \
    { float a=MX3(C0[0],C0[1],C1[0]),b=MX3(C0[2],C0[3],C1[1]); a=MX3(a,C1[2],C1[3]); \
      _Pragma("unroll") for(int r=4;r<16;r+=4){a=MX3(a,C0[r],C0[r+1]);b=MX3(b,C0[r+2],C0[r+3]);a=MX3(a,C1[r],C1[r+1]);b=MX3(b,C1[r+2],C1[r+3]);} \
      float rm=__builtin_fmaxf(a,b); { auto rr=__builtin_amdgcn_permlane32_swap(__float_as_uint(rm),__float_as_uint(rm),false,false); rm=__builtin_fmaxf(__uint_as_float(rr[0]),__uint_as_float(rr[1])); } \
      resc=false; \
      if(__builtin_expect(__any(rm>(float)THRL),0)){ const float dl=__builtin_fmaxf(rm,0.f); mhat+=dl; \
        _Pragma("unroll") for(int r=0;r<16;++r){C0[r]-=dl;C1[r]-=dl;} \
        _Pragma("unroll") for(int r=0;r<16;++r)negm[r]=-mhat; asm volatile("":"+v"(negm)); \
        const float f=__builtin_amdgcn_exp2f(-dl); l_reg*=f; if(hi==0)wsf[r32]=f; resc=true; } } \
    SBAR(); \
    GAPB(o[0]=__builtin_amdgcn_mfma_f32_32x32x16_bf16(PAF(0),VFR(0),o[0],0,0,0), C0,0); \
    GAPB(o[1]=__builtin_amdgcn_mfma_f32_32x32x16_bf16(PAF(0),VFR(4),o[1],0,0,0), C0,4); \
    KRD(GL,0); GAPB(o[0]=__builtin_amdgcn_mfma_f32_32x32x16_bf16(PAF(1),VFR(1),o[0],0,0,0), C0,8); \
    KRD(GL,1); GAPB(o[1]=__builtin_amdgcn_mfma_f32_32x32x16_bf16(PAF(1),VFR(5),o[1],0,0,0), C0,12); \
    KRD(GL,2); GAPB(o[0]=__builtin_amdgcn_mfma_f32_32x32x16_bf16(PAF(2),VFR(2),o[0],0,0,0), C1,0); \
    KRD(GL,3); GAPB(o[1]=__builtin_amdgcn_mfma_f32_32x32x16_bf16(PAF(2),VFR(6),o[1],0,0,0), C1,4); \
    GAPB(o[0]=__builtin_amdgcn_mfma_f32_32x32x16_bf16(PAF(3),VFR(3),o[0],0,0,0), C1,8); \
    GAPB(o[1]=__builtin_amdgcn_mfma_f32_32x32x16_bf16(PAF(3),VFR(7),o[1],0,0,0), C1,12); \
    }while(0)
  int t=1;
  #undef CMASK
  #define CMASK(P0,P1,t) do{}while(0)
  for(;t+5<NT;t+=2){
    STEP(pB0,pB1,pA0,pA1,t,true,true,true);     WAIT_BAR(2); RESC(); ROT();
    STEP(pA0,pA1,pB0,pB1,t+1,true,true,true);   WAIT_BAR(2); RESC(); ROT();
  }
  #undef CMASK
  #define CMASK(P0,P1,t) do{ if(MODE==0){int jb_=(t)-(NT-4); if(jb_>=0)cmask_blk(P0,P1,jb_,wid);} }while(0)
  #define ENDW(tt) do{ if((tt)+3<NT){WAIT_BAR(2);} else if((tt)+2<NT){WAIT_BAR(1);} else {WAIT_BAR(0);} }while(0)
  for(;t+1<NT;t+=2){
    STEP(pB0,pB1,pA0,pA1,t,(t+3<NT),(t+1<NT),(t+1<NT));       ENDW(t);   RESC(); ROT();
    STEP(pA0,pA1,pB0,pB1,t+1,(t+4<NT),(t+2<NT),(t+2<NT));     ENDW(t+1); RESC(); ROT();
  }
  STEP(pB0,pB1,pA0,pA1,NT-1,false,false,false); RESC();
  { float sacc=pB0[0]+pB0[1]; _Pragma("unroll") for(int r=2;r<16;++r)sacc+=pB0[r]; _Pragma("unroll") for(int r=0;r<16;++r)sacc+=pB1[r]; l_reg+=sacc;
    pw0=(u32x4){PKW(pB0,0),PKW(pB0,2),PKW(pB0,4),PKW(pB0,6)};pw1=(u32x4){PKW(pB0,8),PKW(pB0,10),PKW(pB0,12),PKW(pB0,14)};pw2=(u32x4){PKW(pB1,0),PKW(pB1,2),PKW(pB1,4),PKW(pB1,6)};pw3=(u32x4){PKW(pB1,8),PKW(pB1,10),PKW(pB1,12),PKW(pB1,14)};
    SBAR(); pv(o,vb0+sl_cur,PAF(0),PAF(1),PAF(2),PAF(3)); }
  #undef PKW
  #undef PAF
  #undef VFR
  #undef PIN
  #undef MX3
  #undef GAPA
  #undef GAPB
  #undef EX
  #undef VRD
  #undef KRD
  #undef STEP
  #undef ENDW
  {auto rr=__builtin_amdgcn_permlane32_swap(__float_as_uint(l_reg),__float_as_uint(l_reg),false,false);l_reg=__uint_as_float(rr[0])+__uint_as_float(rr[1]);}
  if(hi==0)wsf[32+r32]=l_reg;asm volatile("s_waitcnt lgkmcnt(0)":::"memory");
  float rli[16];
  #pragma unroll
  for(int r=0;r<16;++r)rli[r]=__builtin_amdgcn_rcpf(wsf[32+crow(r,hi)]);
  bf16*Ow=Ob+(long)(wid*QBLK)*op;
  { bf16*stg=(bf16*)(shm+LDS_OST)+wid*2048;
    #pragma unroll
    for(int r=0;r<16;++r){const int orow=crow(r,hi);
      #pragma unroll
      for(int d0=0;d0<2;++d0)stg[orow*64+d0*32+r32]=__float2bfloat16(o[d0][r]*rli[r]);}
    asm volatile("s_waitcnt lgkmcnt(0)":::"memory");
    #pragma unroll
    for(int i=0;i<4;++i){const int row=i*8+(lane>>3),ch=lane&7; const u32x4 v=*(const u32x4*)(stg+row*64+ch*8); ATTN_STORE16(Ow+(long)row*op+ch*8,v);} }
  asm volatile("s_waitcnt lgkmcnt(0)\n\ts_barrier":::"memory");
  #undef DMA_K
  #undef DMA_V
  #undef CMASK
  #undef ALIBI
  #undef START
  #undef RESC
  #undef ROT
}
constexpr int ATTN_LDS_BYTES=LDS_BYTES;
#undef SBAR
#undef WAIT_BAR
}
constexpr int T = 32768, D = 1024, NB = 8, S = 4096, MEML = 256;
constexpr int AIN = 2560, BIN = 3328, FFD = 2816, FFE = 3584, NE = 8, DAW = 768;
constexpr float EPS = 1e-6f;
constexpr float C2 = 0.125f * 1.4426950408889634f;
constexpr int MAXROWS = 2 * T + NE * 256;
constexpr int NWAVES = 8;
constexpr float SC_X = 16.f, SC_WGU = 64.f, SC_H = 8.f, SC_WDN = 256.f;
constexpr size_t MiB = 1u << 20;
constexpr size_t WS_CTL = 0, CTL_ZERO_BYTES = 1 * MiB;
constexpr size_t WS_WINA = 2 * MiB, WS_WOUT = 12 * MiB, WS_WINB = 20 * MiB, WS_WMKV = 33 * MiB, WS_WGUD = 37 * MiB, WS_WDND = 59 * MiB, WS_WGUM = 70 * MiB, WS_WDNM = 294 * MiB;
constexpr size_t WS_MEMN = 406 * MiB, WS_MKV = 422 * MiB, WS_XN = 430 * MiB, WS_OC = 494 * MiB, WS_ROUTE = 558 * MiB, WS_BIG = 560 * MiB, WS_XG = 1072 * MiB, WS_Y = 1204 * MiB, WS_SSQP = 1362 * MiB, WS_END = 1372 * MiB;
constexpr size_t WS_SLOC = WS_XG, WS_SIN = WS_XG + 192 * MiB;
constexpr size_t WS_FS = 1600 * MiB;
constexpr int CW_TMO = 0, CW_CODE = 1, CW_BAR = 4096, CW_GCNT = 8192, CW_N2 = 65536;
constexpr int RING_OFF = 0, RING_BYTES = 131072;
constexpr int LDSCTL_OFF = RING_BYTES, MISC_OFF = LDSCTL_OFF + 320;
constexpr int LDS_BYTES = 147456;
static_assert(MISC_OFF + 128 <= LDS_BYTES, "LDS map");
#ifndef MK_DBG
#define MK_DBG 0
#endif
#ifndef MK_DUP
#define MK_DUP 0
#endif
#ifndef MK_TS
#define MK_TS 0
#endif
#ifndef MK_TS_A
#define MK_TS_A 0
#endif
#ifndef MK_TS_B
#define MK_TS_B 0
#endif
__constant__ unsigned char ATT_DEAL[8][12] = {{3, 5, 13, 27, 32, 43, 63, 67, 75, 85, 86, 89}, {6, 14, 18, 20, 28, 36, 39, 40, 44, 64, 79, 91}, {7, 15, 25, 34, 35, 53, 54, 57, 58, 74, 80, 95}, {1, 8, 21, 29, 45, 50, 52, 55, 56, 62, 65, 76},
    {9, 17, 22, 30, 46, 66, 68, 71, 72, 78, 81, 92}, {0, 10, 26, 33, 51, 59, 69, 70, 73, 82, 90, 94}, {2, 4, 12, 16, 23, 31, 47, 61, 84, 87, 88, 93}, {11, 19, 24, 37, 38, 41, 42, 48, 49, 60, 77, 83}};
#define GAS __attribute__((address_space(1)))
#define LAS __attribute__((address_space(3)))
typedef unsigned short bf16;
typedef unsigned v4u __attribute__((ext_vector_type(4)));
typedef unsigned v2u __attribute__((ext_vector_type(2)));
typedef float f32x4 __attribute__((ext_vector_type(4)));
typedef short bf16x8 __attribute__((ext_vector_type(8)));
typedef GAS unsigned gu32;
typedef GAS unsigned long long gu64;
#define RLX_AGENT __ATOMIC_RELAXED, __HIP_MEMORY_SCOPE_AGENT
#define LDS_WAIT() asm volatile("s_waitcnt lgkmcnt(0)" ::: "memory")
#define VM_WAIT() asm volatile("s_waitcnt vmcnt(0)" ::: "memory")
__device__ __forceinline__ unsigned long long rt() { return __builtin_amdgcn_s_memrealtime(); }
__device__ __forceinline__ unsigned f2bf(float f) { unsigned u = __builtin_bit_cast(unsigned, f); return (u + 0x7fffu + ((u >> 16) & 1u)) >> 16; }
__device__ __forceinline__ unsigned pk2(float lo, float hi) { return f2bf(lo) | (f2bf(hi) << 16); }

#define XB_TMO      128
#define XB_XCNT(j)  (256  + 64 * (j))
#define XB_XSUB(j)  (1280 + 64 * (j))
#define XB_XGEN(j)  (2304 + 64 * (j))
#define XB_TOP      3328
#define XB_TOPGEN   3392
#define XCD_BAR_WORDS 3456
#define XB_SPIN_CAP (1u << 18)

__device__ __forceinline__ unsigned xb_ld(unsigned* p)              { return __hip_atomic_load(p, __ATOMIC_RELAXED, __HIP_MEMORY_SCOPE_AGENT); }
__device__ __forceinline__ unsigned xb_add(unsigned* p, unsigned v) { return __hip_atomic_fetch_add(p, v, __ATOMIC_RELAXED, __HIP_MEMORY_SCOPE_AGENT); }
__device__ __forceinline__ unsigned xb_xcc_id() { return (unsigned)__builtin_amdgcn_s_getreg((3 << 11) | 20) & 0xFu; }
#define XB_SPIN(cond, bar) do { unsigned _sp = 0; while (cond) { __builtin_amdgcn_s_sleep(1); \
    if ((++_sp & 255u) == 0u) { if (xb_ld(&(bar)[XB_TMO])) break; if (_sp > XB_SPIN_CAP) { atomicAdd(&(bar)[XB_TMO], 1u); break; } } } } while (0)

struct XcdBarrier {
    unsigned* bar; unsigned x; int wave;
    volatile LAS unsigned* st;
};

__device__ __forceinline__ XcdBarrier xcd_barrier_post(unsigned* bar, volatile LAS unsigned* st) {
    XcdBarrier b; b.bar = bar; b.x = xb_xcc_id(); b.st = st; b.wave = __builtin_amdgcn_readfirstlane((int)(threadIdx.x >> 6));
    if (threadIdx.x == 0) (void)xb_add(&bar[XB_XCNT(b.x)], 1u);
    return b;
}
__device__ __forceinline__ void xcd_barrier_complete(unsigned* bar, unsigned x, unsigned& nloc, unsigned& nx) {
    const unsigned G = gridDim.x * gridDim.y * gridDim.z;
    unsigned sum, cnt, mine, sp = 0u;
    for (;;) {
        sum = 0u; cnt = 0u; mine = 0u;
#pragma unroll
        for (unsigned j = 0; j < 16; ++j) { const unsigned c = xb_ld(&bar[XB_XCNT(j)]); sum += c; cnt += (c > 0u) ? 1u : 0u; mine = (j == x) ? c : mine; }
        if (sum == G) break;
        __builtin_amdgcn_s_sleep(1);
        if ((++sp & 255u) == 0u) { if (xb_ld(&bar[XB_TMO])) break; if (sp > XB_SPIN_CAP) { atomicAdd(&bar[XB_TMO], 1u); break; } }
    }
    nloc = mine > 0u ? mine : 1u; nx = cnt > 0u ? cnt : 1u;
}

__device__ __forceinline__ void xcd_barrier(const XcdBarrier& b) {
    asm volatile("s_waitcnt vmcnt(0)" ::: "memory");
    __syncthreads();
    int l0_; asm volatile("v_mbcnt_lo_u32_b32 %0, -1, 0\n\tv_mbcnt_hi_u32_b32 %0, -1, %0" : "=v"(l0_));
    if (b.wave == 0 && l0_ == 0) {
        unsigned* bar = b.bar;
        __builtin_amdgcn_s_waitcnt(0);
        unsigned nloc = b.st[0], nx = b.st[1];
        if (nloc == 0u) { xcd_barrier_complete(bar, b.x, nloc, nx); b.st[0] = nloc; b.st[1] = nx; }
        const unsigned old = xb_add(&bar[XB_XSUB(b.x)], 1u);
        const unsigned gen = old / nloc;
        if (old + 1u == (gen + 1u) * nloc) {
            __builtin_amdgcn_fence(__ATOMIC_RELEASE, "agent");
            asm volatile("s_waitcnt vmcnt(0)" ::: "memory");
            const unsigned og = xb_add(&bar[XB_TOP], 1u);
            const unsigned tg = og / nx;
            if (og + 1u == (tg + 1u) * nx) xb_add(&bar[XB_TOPGEN], 1u);
            else XB_SPIN(xb_ld(&bar[XB_TOPGEN]) == tg, bar);
            __builtin_amdgcn_fence(__ATOMIC_ACQUIRE, "agent");
            xb_add(&bar[XB_XGEN(b.x)], 1u);
            asm volatile("s_waitcnt vmcnt(0)" ::: "memory");
        } else {
            XB_SPIN(xb_ld(&bar[XB_XGEN(b.x)]) == gen, bar);
            __builtin_amdgcn_fence(__ATOMIC_ACQUIRE, "agent");
            asm volatile("s_waitcnt vmcnt(0)" ::: "memory");
        }
    }
    __syncthreads();
}
struct InTab { const LAS unsigned long long* t;
    __device__ __forceinline__ const float* operator[](int k) const { const unsigned long long v = t[k];
        return (const float*)(((unsigned long long)(unsigned)__builtin_amdgcn_readfirstlane((int)(v >> 32)) << 32) | (unsigned)__builtin_amdgcn_readfirstlane((int)(unsigned)v)); } };
struct Frame {
    LAS unsigned char* lds;
    volatile LAS unsigned* MISC;
    gu32* ctl;
    int wave;
    int vcu, G, bx;
    GAS unsigned char* ws;
    InTab in;
    GAS float* out;
    float ts_scale, ts_add;
};
__device__ __forceinline__ float xor_get(float v, int lane, int o) { return __builtin_bit_cast(float, __builtin_amdgcn_ds_bpermute((lane ^ o) << 2, __builtin_bit_cast(int, v))); }
__device__ __forceinline__ float half_sum(float v, int lane) {
#pragma unroll
    for (int o = 1; o < 32; o <<= 1) v += xor_get(v, lane, o);
    return v; }
__device__ __forceinline__ float wave_sum(float v, int lane) { v = half_sum(v, lane); return v + xor_get(v, lane, 32); }
__device__ __forceinline__ int launder(int v) { asm volatile("" : "+v"(v)); return v; }
__device__ __forceinline__ int fresh_lane() { int l; asm volatile("v_mbcnt_lo_u32_b32 %0, -1, 0\n\tv_mbcnt_hi_u32_b32 %0, -1, %0" : "=v"(l)); return l; }
__device__ __forceinline__ float bf_lo(unsigned u) { return __builtin_bit_cast(float, u << 16); }
__device__ __forceinline__ float bf_hi(unsigned u) { return __builtin_bit_cast(float, u & 0xffff0000u); }
#if MK_DBG
__device__ __forceinline__ void dbg_sample_f32(Frame& F, int lane, int slot, int row, const f32x4 (&v)[4]) {
    float* d = (float*)(F.ws + WS_FS) + ((size_t)slot * 1024 + (row >> 5)) * 1024;
#pragma unroll
    for (int j = 0; j < 4; ++j) ((f32x4*)d)[lane + 64 * j] = v[j];
}
#endif
__device__ __forceinline__ int swiglu_row(int n, int ff) { const int bj = n >= ff ? 1 : 0, cc = n - bj * ff; return 256 * (cc >> 7) + 128 * bj + (cc & 127); }
template <bool F8>
__device__ __forceinline__ void transpose_item(const float* W, int K, int N, void* WT, int ff, float scale, LAS float* scr, int item, int lane) {
    const int nblk = N / 64, kb = item / nblk, nb = item % nblk, k0 = 64 * kb, n0 = 64 * nb;
    const int r0 = ff ? swiglu_row(n0, ff) : n0;
    float v[64];
    const GAS float* wp = (const GAS float*)W + (size_t)k0 * N + n0 + lane;
#pragma unroll
    for (int i = 0; i < 64; ++i) v[i] = wp[(size_t)i * N];
#pragma unroll
    for (int i = 0; i < 64; ++i) scr[i * 64 + (lane ^ (i & 31))] = v[i];
    LDS_WAIT(); asm volatile("" ::: "memory");
    const int c = lane & 7;
#pragma unroll
    for (int j = 0; j < 8; ++j) { const int n = (lane >> 3) + 8 * j; float s[8];
#pragma unroll
        for (int i = 0; i < 8; ++i) s[i] = scr[(8 * c + i) * 64 + (n ^ ((8 * c + i) & 31))];
        if (F8) { v2u o; o.x = pg8::pk4_fp8(s[0] * scale, s[1] * scale, s[2] * scale, s[3] * scale); o.y = pg8::pk4_fp8(s[4] * scale, s[5] * scale, s[6] * scale, s[7] * scale);
            *(GAS v2u*)((unsigned char*)WT + (size_t)(r0 + n) * K + k0 + 8 * c) = o; }
        else { v4u o; o.x = pg8::cvt_pk_bf16(s[0], s[1]); o.y = pg8::cvt_pk_bf16(s[2], s[3]); o.z = pg8::cvt_pk_bf16(s[4], s[5]); o.w = pg8::cvt_pk_bf16(s[6], s[7]);
            *(GAS v4u*)((bf16*)WT + (size_t)(r0 + n) * K + k0 + 8 * c) = o; } }
    LDS_WAIT(); asm volatile("" ::: "memory");
}
__device__ __forceinline__ void rms_row_to_bf16(int lane, const float* xrow, const float* gain, bf16* orow) {
    const GAS f32x4* xr = (const GAS f32x4*)xrow + lane;
    f32x4 v[4]; float s = 0.f;
#pragma unroll
    for (int j = 0; j < 4; ++j) { v[j] = xr[64 * j]; s += (v[j].x * v[j].x + v[j].y * v[j].y) + (v[j].z * v[j].z + v[j].w * v[j].w); }
    const float rstd = 1.f / sqrtf(wave_sum(s, lane) * (1.f / D) + EPS);
    GAS unsigned long long* o8 = (GAS unsigned long long*)orow + lane;
#pragma unroll
    for (int j = 0; j < 4; ++j) { const f32x4 g = ((const GAS f32x4*)gain)[lane + 64 * j];
        o8[64 * j] = (unsigned long long)pk2(v[j].x * rstd * g.x, v[j].y * rstd * g.y) | ((unsigned long long)pk2(v[j].z * rstd * g.z, v[j].w * rstd * g.w) << 32); }
}
__device__ __forceinline__ void phase_prologue(Frame& F) {
    const int lane = fresh_lane(), tid = F.wave * 64 + lane; (void)tid;
    LAS float* scr = (LAS float*)(F.lds + RING_OFF + F.wave * 16384);
    const int gw = F.vcu * NWAVES + F.wave, NGW = F.G * NWAVES;
    constexpr int I_AIN = 16 * (AIN / 64), I_MKV = 16 * 8, I_OUT = 16 * 16, I_BIN = 16 * (BIN / 64), I_GUD = 16 * (2 * FFD / 64), I_DND = (FFD / 64) * 16, I_GUM = 16 * (2 * FFE / 64), I_DNM = (FFE / 64) * 16;
    constexpr int NITEMS = 2 * I_AIN + 4 * I_MKV + 4 * I_OUT + 2 * I_BIN + 2 * I_GUD + 2 * I_DND + 16 * I_GUM + 16 * I_DNM;
    for (int it = NITEMS - 1 - gw; it >= 0; it -= NGW) {
        int r = it; const float* src; bf16* dst; int K = D, N, ff = 0;
        if (r < 2 * I_AIN) { const int j = r / I_AIN; r %= I_AIN; N = AIN; src = F.in[3] + (size_t)j * D * AIN; dst = (bf16*)(F.ws + WS_WINA) + (size_t)j * AIN * D; }
        else if ((r -= 2 * I_AIN) < 4 * I_MKV) { const int l = r / I_MKV; r %= I_MKV; N = 512; src = F.in[(l & 1) ? 17 : 10] + (size_t)(l >> 1) * D * 512; dst = (bf16*)(F.ws + WS_WMKV) + (size_t)l * 512 * D; }
        else if ((r -= 4 * I_MKV) < 4 * I_OUT) { const int l = r / I_OUT; r %= I_OUT; N = D; src = F.in[(l & 1) ? 18 : 11] + (size_t)(l >> 1) * D * D; dst = (bf16*)(F.ws + WS_WOUT) + (size_t)l * D * D; }
        else if ((r -= 4 * I_OUT) < 2 * I_BIN) { const int j = r / I_BIN; r %= I_BIN; N = BIN; src = F.in[13] + (size_t)j * D * BIN; dst = (bf16*)(F.ws + WS_WINB) + (size_t)j * BIN * D; }
        else if ((r -= 2 * I_BIN) < 2 * I_GUD) { const int j = r / I_GUD; r %= I_GUD; N = 2 * FFD; ff = FFD; src = F.in[20] + (size_t)j * D * 2 * FFD; dst = (bf16*)(F.ws + WS_WGUD) + (size_t)j * 2 * FFD * D; }
        else if ((r -= 2 * I_GUD) < 2 * I_DND) { const int j = r / I_DND; r %= I_DND; K = FFD; N = D; src = F.in[21] + (size_t)j * FFD * D; dst = (bf16*)(F.ws + WS_WDND) + (size_t)j * D * FFD; }
        else if ((r -= 2 * I_DND) < 16 * I_GUM) { const int j = r / I_GUM; r %= I_GUM;
            transpose_item<true>(F.in[24] + (size_t)j * D * 2 * FFE, D, 2 * FFE, (void*)(F.ws + WS_WGUM + (size_t)j * 2 * FFE * D), FFE, SC_WGU, scr, r, lane); continue; }
        else { r -= 16 * I_GUM; const int j = r / I_DNM; r %= I_DNM;
            transpose_item<true>(F.in[25] + (size_t)j * FFE * D, FFE, D, (void*)(F.ws + WS_WDNM + (size_t)j * D * FFE), 0, SC_WDN, scr, r, lane); continue; }
        transpose_item<false>(src, K, N, dst, ff, 1.f, scr, r, lane);
    }
    for (int m = gw; m < 4 * NB * MEML; m += NGW) { const int l = m / (NB * MEML), r = m % (NB * MEML);
        rms_row_to_bf16(lane, F.in[1] + (size_t)r * D, F.in[(l & 1) ? 16 : 9] + (size_t)(l >> 1) * D, (bf16*)(F.ws + WS_MEMN) + (size_t)m * D); }
    for (int m = gw; m < T; m += NGW) rms_row_to_bf16(lane, F.in[0] + (size_t)m * D, F.in[2], (bf16*)(F.ws + WS_XN) + (size_t)m * D);
    if (F.bx == 0) { float* LBT = (float*)(F.ws + WS_ROUTE + 1024 * 1024);
        for (int i = tid; i < DAW; i += NWAVES * 64) { LBT[i] = 0.f; LBT[DAW + i] = 1.f / (1.f + __expf(F.in[14][i] - F.in[14][DAW + i])); } }
}
template <bool COMBINE, bool ROUTER, bool FINAL>
__device__ __forceinline__ void phase_norm(Frame& F, const float* src, float* X, const float* gain, const float* wr, gu32* gcnt, int dbg_slot) {
    const int lane = fresh_lane(), tid = F.wave * 64 + lane; (void)tid;
    bf16* XN = (bf16*)(F.ws + WS_XN); const bf16* Y = (const bf16*)(F.ws + WS_Y);
    float* TOPW = (float*)(F.ws + WS_ROUTE); int* TOKSEL = (int*)(F.ws + WS_ROUTE + 256 * 1024); const int* TOKROW = (const int*)(F.ws + WS_ROUTE + 768 * 1024);
    LAS int* cntL = (LAS int*)(F.lds + RING_OFF); LAS int* baseL = cntL + 8; LAS int* sel = cntL + 16;
    if (ROUTER) { if (tid < 8) cntL[tid] = 0; __syncthreads(); }
    for (int rb = F.bx * 128; rb < T; rb += F.G * 128) {
        int ri0 = 0, ri1 = 0; float rw0 = 0.f, rw1 = 0.f;
        if (COMBINE && lane < 16) { const int rr = rb + F.wave * 16 + lane; ri0 = TOKROW[rr * 2]; ri1 = TOKROW[rr * 2 + 1]; rw0 = TOPW[rr * 2]; rw1 = TOPW[rr * 2 + 1]; }
        f32x4 vq[2][4]; v2u yq0[2][4], yq1[2][4];
#define NORM_ISSUE(B_, I_) do { const int row_ = rb + F.wave * 16 + (I_); const GAS f32x4* xr_ = (const GAS f32x4*)(src + (size_t)row_ * D) + lane; \
            _Pragma("unroll") for (int j = 0; j < 4; ++j) vq[B_][j] = xr_[64 * j]; \
            if (COMBINE) { const int r0_ = __builtin_amdgcn_readlane(ri0, (I_)), r1_ = __builtin_amdgcn_readlane(ri1, (I_)); \
                const GAS v2u* y0_ = (const GAS v2u*)(Y + (size_t)r0_ * D) + lane; const GAS v2u* y1_ = (const GAS v2u*)(Y + (size_t)r1_ * D) + lane; \
                _Pragma("unroll") for (int j = 0; j < 4; ++j) { yq0[B_][j] = y0_[64 * j]; yq1[B_][j] = y1_[64 * j]; } } } while (0)
        NORM_ISSUE(0, 0);
        for (int i2 = 0; i2 < 16; i2 += 2) {
#pragma unroll
          for (int hb = 0; hb < 2; ++hb) {
            const int i = i2 + hb;
            if (hb == 0) NORM_ISSUE(1, i + 1); else if (i + 1 < 16) NORM_ISSUE(0, i + 1);
            const int rl = F.wave * 16 + i, row = rb + rl;
            f32x4 v[4];
#pragma unroll
            for (int j = 0; j < 4; ++j) v[j] = vq[hb][j];
            if (COMBINE) {
                const float w0 = __builtin_bit_cast(float, __builtin_amdgcn_readlane(__builtin_bit_cast(int, rw0), i)), w1 = __builtin_bit_cast(float, __builtin_amdgcn_readlane(__builtin_bit_cast(int, rw1), i));
#pragma unroll
                for (int j = 0; j < 4; ++j) { const v2u a = yq0[hb][j], b = yq1[hb][j];
                    v[j].x += w0 * bf_lo(a.x) + w1 * bf_lo(b.x); v[j].y += w0 * bf_hi(a.x) + w1 * bf_hi(b.x); v[j].z += w0 * bf_lo(a.y) + w1 * bf_lo(b.y); v[j].w += w0 * bf_hi(a.y) + w1 * bf_hi(b.y); }
                if (!FINAL) { GAS f32x4* xw = (GAS f32x4*)(X + (size_t)row * D) + lane;
#pragma unroll
                    for (int j = 0; j < 4; ++j) xw[64 * j] = v[j]; }
            }
#if MK_DBG
            if (dbg_slot >= 0 && (row & 31) == 0) dbg_sample_f32(F, lane, dbg_slot, row, v);
#endif
            float s = 0.f;
#pragma unroll
            for (int j = 0; j < 4; ++j) s += (v[j].x * v[j].x + v[j].y * v[j].y) + (v[j].z * v[j].z + v[j].w * v[j].w);
            const float rstd = 1.f / sqrtf(wave_sum(s, lane) * (1.f / D) + EPS);
#pragma unroll
            for (int j = 0; j < 4; ++j) { const f32x4 g = ((const GAS f32x4*)gain)[lane + 64 * j]; v[j].x *= rstd * g.x; v[j].y *= rstd * g.y; v[j].z *= rstd * g.z; v[j].w *= rstd * g.w; }
            if (FINAL) { GAS f32x4* ow = (GAS f32x4*)(X + (size_t)row * D) + lane;
#pragma unroll
                for (int j = 0; j < 4; ++j) ow[64 * j] = v[j];
            } else { GAS unsigned long long* o8 = (GAS unsigned long long*)(XN + (size_t)row * D) + lane;
#pragma unroll
                for (int j = 0; j < 4; ++j) o8[64 * j] = (unsigned long long)pk2(v[j].x, v[j].y) | ((unsigned long long)pk2(v[j].z, v[j].w) << 32); }
            if (ROUTER) {
                float a[8];
#pragma unroll
                for (int e = 0; e < 8; ++e) a[e] = 0.f;
#pragma unroll
                for (int j = 0; j < 4; ++j) { const GAS f32x4* wp = (const GAS f32x4*)(wr + (size_t)(lane + 64 * j) * 32);
#pragma unroll
                    for (int c = 0; c < 4; ++c) { const float xv = v[j][c]; const f32x4 w0 = wp[2 * c], w1 = wp[2 * c + 1];
                        a[0] += xv * w0.x; a[1] += xv * w0.y; a[2] += xv * w0.z; a[3] += xv * w0.w; a[4] += xv * w1.x; a[5] += xv * w1.y; a[6] += xv * w1.z; a[7] += xv * w1.w; } }
#pragma unroll
                for (int e = 0; e < 8; ++e) a[e] = wave_sum(a[e], lane);
                if (lane == 0) {
                    int e0 = 0; float v0 = a[0];
#pragma unroll
                    for (int e = 1; e < 8; ++e) if (a[e] > v0) { v0 = a[e]; e0 = e; }
                    int e1 = 0; float v1 = -3.0e38f;
#pragma unroll
                    for (int e = 0; e < 8; ++e) if (e != e0 && a[e] > v1) { v1 = a[e]; e1 = e; }
                    const float p1 = __expf(v1 - v0), inv = 1.f / (1.f + p1);
                    TOPW[row * 2] = inv; TOPW[row * 2 + 1] = p1 * inv;
                    const int q0 = __hip_atomic_fetch_add(cntL + e0, 1, __ATOMIC_RELAXED, __HIP_MEMORY_SCOPE_WORKGROUP);
                    const int q1 = __hip_atomic_fetch_add(cntL + e1, 1, __ATOMIC_RELAXED, __HIP_MEMORY_SCOPE_WORKGROUP);
                    sel[rl * 4] = e0; sel[rl * 4 + 1] = q0; sel[rl * 4 + 2] = e1; sel[rl * 4 + 3] = q1;
                }
            }
          }
        }
#undef NORM_ISSUE
        if (ROUTER) {
            __syncthreads();
            if (tid < 8) { baseL[tid] = (int)__hip_atomic_fetch_add(gcnt + tid, (unsigned)cntL[tid], __ATOMIC_RELAXED, __HIP_MEMORY_SCOPE_AGENT); }
            __syncthreads();
            if (tid < 128) { const int e0 = sel[tid * 4], e1 = sel[tid * 4 + 2]; int4 o; o.x = e0; o.y = baseL[e0] + sel[tid * 4 + 1]; o.z = e1; o.w = baseL[e1] + sel[tid * 4 + 3];
                *(int4*)(TOKSEL + (size_t)(rb + tid) * 4) = o; }
            __syncthreads();
            if (tid < 8) cntL[tid] = 0;
            __syncthreads();
        }
    }
}
__device__ __forceinline__ void phase_router(Frame& F, const float* src, const float* gain, const float* wr, gu32* gcnt, int dbg_slot) {
    const int lane = fresh_lane(), tid = F.wave * 64 + lane;
    bf16* XN = (bf16*)(F.ws + WS_XN); float* TOPW = (float*)(F.ws + WS_ROUTE); int* TOKSEL = (int*)(F.ws + WS_ROUTE + 256 * 1024);
    LAS int* cntL = (LAS int*)(F.lds + RING_OFF); LAS int* baseL = cntL + 8; LAS float* lg = (LAS float*)(cntL + 16);
    if (tid < 8) cntL[tid] = 0;
    __syncthreads();
    for (int rb = F.bx * 128; rb < T; rb += F.G * 128) {
        for (int g4 = 0; g4 < 4; ++g4) {
            const int rl0 = F.wave * 16 + 4 * g4, row0 = rb + rl0;
            f32x4 v[4][4];
#pragma unroll
            for (int r = 0; r < 4; ++r) { const GAS f32x4* xr = (const GAS f32x4*)(src + (size_t)(row0 + r) * D) + lane;
#pragma unroll
                for (int j = 0; j < 4; ++j) v[r][j] = xr[64 * j]; }
#if MK_DBG
#pragma unroll
            for (int r = 0; r < 4; ++r) if (dbg_slot >= 0 && ((row0 + r) & 31) == 0) dbg_sample_f32(F, lane, dbg_slot, row0 + r, v[r]);
#endif
            float ss[4];
#pragma unroll
            for (int r = 0; r < 4; ++r) { float s = 0.f;
#pragma unroll
                for (int j = 0; j < 4; ++j) s += (v[r][j].x * v[r][j].x + v[r][j].y * v[r][j].y) + (v[r][j].z * v[r][j].z + v[r][j].w * v[r][j].w);
                ss[r] = s; }
#pragma unroll
            for (int o = 1; o < 64; o <<= 1) {
#pragma unroll
                for (int r = 0; r < 4; ++r) ss[r] += xor_get(ss[r], lane, o); }
#pragma unroll
            for (int r = 0; r < 4; ++r) { const float rstd = 1.f / sqrtf(ss[r] * (1.f / D) + EPS);
                GAS unsigned long long* o8 = (GAS unsigned long long*)(XN + (size_t)(row0 + r) * D) + lane;
#pragma unroll
                for (int j = 0; j < 4; ++j) { const f32x4 gg = ((const GAS f32x4*)gain)[lane + 64 * j]; v[r][j].x *= rstd * gg.x; v[r][j].y *= rstd * gg.y; v[r][j].z *= rstd * gg.z; v[r][j].w *= rstd * gg.w;
                    o8[64 * j] = (unsigned long long)pk2(v[r][j].x, v[r][j].y) | ((unsigned long long)pk2(v[r][j].z, v[r][j].w) << 32); } }
            float a[32];
#pragma unroll
            for (int i = 0; i < 32; ++i) a[i] = 0.f;
#pragma unroll
            for (int j = 0; j < 4; ++j) { const GAS f32x4* wp = (const GAS f32x4*)(wr + (size_t)(lane + 64 * j) * 32);
#pragma unroll
                for (int c = 0; c < 4; ++c) { const f32x4 w0 = wp[2 * c], w1 = wp[2 * c + 1];
#pragma unroll
                    for (int r = 0; r < 4; ++r) { const float xv = v[r][j][c];
                        a[r * 8 + 0] += xv * w0.x; a[r * 8 + 1] += xv * w0.y; a[r * 8 + 2] += xv * w0.z; a[r * 8 + 3] += xv * w0.w; a[r * 8 + 4] += xv * w1.x; a[r * 8 + 5] += xv * w1.y; a[r * 8 + 6] += xv * w1.z; a[r * 8 + 7] += xv * w1.w; } } }
#define RT_STEP(S_, N_) do { const bool up_ = (lane >> (S_)) & 1; _Pragma("unroll") for (int i = 0; i < (N_); ++i) { const float keep_ = up_ ? a[2 * i + 1] : a[2 * i], send_ = up_ ? a[2 * i] : a[2 * i + 1]; a[i] = keep_ + xor_get(send_, lane, 1 << (S_)); } } while (0)
            RT_STEP(0, 16); RT_STEP(1, 8); RT_STEP(2, 4); RT_STEP(3, 2); RT_STEP(4, 1);
#undef RT_STEP
            const float lgv = a[0] + xor_get(a[0], lane, 32);
            if (lane < 32) lg[(rl0 + (lane >> 3)) * 8 + (lane & 7)] = lgv;
        }
        __syncthreads();
        int e0 = 0, e1 = 0, q0 = 0, q1 = 0;
        if (tid < 128) { float av[8];
#pragma unroll
            for (int e = 0; e < 8; ++e) av[e] = lg[tid * 8 + e];
            float v0 = av[0];
#pragma unroll
            for (int e = 1; e < 8; ++e) if (av[e] > v0) { v0 = av[e]; e0 = e; }
            float v1 = -3.0e38f;
#pragma unroll
            for (int e = 0; e < 8; ++e) if (e != e0 && av[e] > v1) { v1 = av[e]; e1 = e; }
            const float p1 = __expf(v1 - v0), inv = 1.f / (1.f + p1);
            TOPW[(rb + tid) * 2] = inv; TOPW[(rb + tid) * 2 + 1] = p1 * inv;
            q0 = __hip_atomic_fetch_add(cntL + e0, 1, __ATOMIC_RELAXED, __HIP_MEMORY_SCOPE_WORKGROUP);
            q1 = __hip_atomic_fetch_add(cntL + e1, 1, __ATOMIC_RELAXED, __HIP_MEMORY_SCOPE_WORKGROUP); }
        __syncthreads();
        if (tid < 8) { baseL[tid] = (int)__hip_atomic_fetch_add(gcnt + tid, (unsigned)cntL[tid], __ATOMIC_RELAXED, __HIP_MEMORY_SCOPE_AGENT); }
        __syncthreads();
        if (tid < 128) { int4 o; o.x = e0; o.y = baseL[e0] + q0; o.z = e1; o.w = baseL[e1] + q1; *(int4*)(TOKSEL + (size_t)(rb + tid) * 4) = o; }
        __syncthreads();
        if (tid < 8) cntL[tid] = 0;
        __syncthreads();
    }
}
__device__ __forceinline__ void phase_gather(Frame& F, const gu32* gcnt) {
    const int lane = fresh_lane(), tid = F.wave * 64 + lane; (void)tid;
    const bf16* XN = (const bf16*)(F.ws + WS_XN); unsigned char* XG = (unsigned char*)(F.ws + WS_XG);
    const int* TOKSEL = (const int*)(F.ws + WS_ROUTE + 256 * 1024); int* TOKROW = (int*)(F.ws + WS_ROUTE + 768 * 1024);
    int rbase[8]; { int t = 0;
#pragma unroll
        for (int e = 0; e < 8; ++e) { rbase[e] = t * 256; t += (__builtin_amdgcn_readfirstlane((int)__hip_atomic_load(gcnt + e, RLX_AGENT)) + 255) >> 8; } }
    const int gw = F.bx * NWAVES + F.wave, NGW = F.G * NWAVES;
    for (int row = gw; row < T; row += NGW) {
        const int4 sl = *(const int4*)(TOKSEL + (size_t)row * 4);
        int d0 = sl.y, d1 = sl.w;
#pragma unroll
        for (int e = 0; e < 8; ++e) { if (sl.x == e) d0 += rbase[e]; if (sl.z == e) d1 += rbase[e]; }
        const GAS v4u* s = (const GAS v4u*)(XN + (size_t)row * D) + 2 * lane;
        const v4u a = s[0], b = s[1];
        v4u o; o.x = pg8::pk4_fp8(bf_lo(a.x) * SC_X, bf_hi(a.x) * SC_X, bf_lo(a.y) * SC_X, bf_hi(a.y) * SC_X); o.y = pg8::pk4_fp8(bf_lo(a.z) * SC_X, bf_hi(a.z) * SC_X, bf_lo(a.w) * SC_X, bf_hi(a.w) * SC_X);
        o.z = pg8::pk4_fp8(bf_lo(b.x) * SC_X, bf_hi(b.x) * SC_X, bf_lo(b.y) * SC_X, bf_hi(b.y) * SC_X); o.w = pg8::pk4_fp8(bf_lo(b.z) * SC_X, bf_hi(b.z) * SC_X, bf_lo(b.w) * SC_X, bf_hi(b.w) * SC_X);
        ((GAS v4u*)(XG + (size_t)d0 * D))[lane] = o; ((GAS v4u*)(XG + (size_t)d1 * D))[lane] = o;
        if (lane == 0) { TOKROW[row * 2] = d0; TOKROW[row * 2 + 1] = d1; }
    }
}
__device__ __forceinline__ void phase_knorm(Frame& F) {
    const int lane = fresh_lane();
    const bf16* P = (const bf16*)(F.ws + WS_BIG); float* N2 = (float*)(F.ws + WS_ROUTE + 1024 * 1024 + 8192);
    const int gw = F.bx * NWAVES + F.wave, NGW = F.G * NWAVES;
    for (int it = gw; it < NB * 24 * 64; it += NGW) { const int t = it & 63, hm = (it >> 6) % 24, b = it / (24 * 64);
        const GAS v4u* rp = (const GAS v4u*)(P + (size_t)(b * S + 64 * t + lane) * AIN + hm * 64); float ss = 0.f;
#pragma unroll
        for (int i = 0; i < 8; ++i) { const v4u w = rp[i]; const unsigned ww[4] = {w.x, w.y, w.z, w.w};
#pragma unroll
            for (int c = 0; c < 4; ++c) { const float a = bf_lo(ww[c]), b2 = bf_hi(ww[c]); ss += a * a + b2 * b2; } }
#pragma unroll
        for (int o = 1; o < 64; o <<= 1) ss = fmaxf(ss, xor_get(ss, lane, o));
        if (lane == 0) N2[it] = ss; }
}
__device__ __forceinline__ void phase_diff_combine(Frame& F, int j, float lam_init) {
    const int lane = fresh_lane(), tid = F.wave * 64 + lane; (void)tid;
    const bf16* O0 = (const bf16*)(F.ws + WS_BIG + 160 * MiB); const bf16* O1 = O0 + (size_t)T * DAW; bf16* OC = (bf16*)(F.ws + WS_OC);
    const float s1 = wave_sum(F.in[4][j * 64 + lane] * F.in[5][j * 64 + lane], lane), s2 = wave_sum(F.in[6][j * 64 + lane] * F.in[7][j * 64 + lane], lane);
    const float lam = __expf(s1) - __expf(s2) + lam_init;
    const f32x4 g = *(const GAS f32x4*)(F.in[8] + j * 128 + (lane & 31) * 4);
    const int gw = F.bx * NWAVES + F.wave, NGW = F.G * NWAVES;
    for (int row0 = gw * 4; row0 < T; row0 += NGW * 4) {
        v2u a[4][3], b[4][3];
#pragma unroll
        for (int r = 0; r < 4; ++r)
#pragma unroll
            for (int jj = 0; jj < 3; ++jj) { a[r][jj] = ((const GAS v2u*)(O0 + (size_t)(row0 + r) * DAW))[lane + 64 * jj]; b[r][jj] = ((const GAS v2u*)(O1 + (size_t)(row0 + r) * DAW))[lane + 64 * jj]; }
#pragma unroll
        for (int r = 0; r < 4; ++r)
#pragma unroll
            for (int jj = 0; jj < 3; ++jj) {
                f32x4 v; v.x = bf_lo(a[r][jj].x) - lam * bf_lo(b[r][jj].x); v.y = bf_hi(a[r][jj].x) - lam * bf_hi(b[r][jj].x); v.z = bf_lo(a[r][jj].y) - lam * bf_lo(b[r][jj].y); v.w = bf_hi(a[r][jj].y) - lam * bf_hi(b[r][jj].y);
                float ss = (v.x * v.x + v.y * v.y) + (v.z * v.z + v.w * v.w);
                ss = half_sum(ss, lane);
                const float rs = (1.f / sqrtf(ss * (1.f / 128.f) + EPS)) * (1.f - lam_init);
                ((GAS unsigned long long*)(OC + (size_t)(row0 + r) * D))[lane + 64 * jj] = (unsigned long long)pk2(v.x * rs * g.x, v.y * rs * g.y) | ((unsigned long long)pk2(v.z * rs * g.z, v.w * rs * g.w) << 32);
            }
    }
}
__device__ __forceinline__ void phase_hgrn_naive(Frame& F, int j) {
    const int lane = fresh_lane(), tid = F.wave * 64 + lane; (void)tid;
    const bf16* PB = (const bf16*)(F.ws + WS_BIG); const float* FZ = (const float*)(F.ws + WS_BIG + 208 * MiB); float* HO = (float*)(F.ws + WS_BIG + 304 * MiB);
    if (F.bx * 4 >= NB * 6) return;
    const int grp = tid >> 7, t128 = tid & 127, bh = F.bx * 4 + grp, b = bh / 6, h = bh % 6;
    LAS float* sq = (LAS float*)(F.lds + RING_OFF) + grp * (3 * 16 * 128); LAS float* sf = sq + 16 * 128; LAS float* sk = sf + 16 * 128;
    float lb = 0.f;
    if (j == 1) { const float l0 = F.in[14][h * 128 + t128], l1 = F.in[14][768 + h * 128 + t128]; lb = 1.f / (1.f + __expf(l0 - l1)); }
    float St[128];
#pragma unroll
    for (int k = 0; k < 128; ++k) St[k] = 0.f;
    for (int t0 = 0; t0 < S; t0 += 16) {
        __syncthreads();
        for (int jj = 0; jj < 16; ++jj) { const size_t row = (size_t)(b * S + t0 + jj);
            const float qv = bf_lo((unsigned)PB[row * BIN + h * 128 + t128]), fz = FZ[row * DAW + h * 128 + t128];
            const float f = lb + (1.f - lb) / (1.f + __expf(-fz));
            sq[jj * 128 + t128] = qv; sf[jj * 128 + t128] = f; sk[jj * 128 + t128] = 1.f - f; }
        __syncthreads();
        for (int jj = 0; jj < 16; ++jj) { const size_t row = (size_t)(b * S + t0 + jj);
            const float v = bf_lo((unsigned)PB[row * BIN + 1536 + h * 128 + t128]);
            float o = 0.f;
#pragma unroll
            for (int k = 0; k < 128; k += 4) { const f32x4 f4 = *(const LAS f32x4*)(sf + jj * 128 + k), k4 = *(const LAS f32x4*)(sk + jj * 128 + k), q4 = *(const LAS f32x4*)(sq + jj * 128 + k);
                St[k] = f4.x * St[k] + k4.x * v; o += q4.x * St[k]; St[k + 1] = f4.y * St[k + 1] + k4.y * v; o += q4.y * St[k + 1];
                St[k + 2] = f4.z * St[k + 2] + k4.z * v; o += q4.z * St[k + 2]; St[k + 3] = f4.w * St[k + 3] + k4.w * v; o += q4.w * St[k + 3]; }
            HO[row * DAW + h * 128 + t128] = o; }
    }
    __syncthreads();
}
__device__ __forceinline__ void phase_hgrn_out(Frame& F, int j) {
    const int lane = fresh_lane(), tid = F.wave * 64 + lane; (void)tid;
    const bf16* PB = (const bf16*)(F.ws + WS_BIG); const float* HO = (const float*)(F.ws + WS_BIG + 304 * MiB); bf16* OC = (bf16*)(F.ws + WS_OC);
    const f32x4 g = *(const GAS f32x4*)(F.in[15] + j * 128 + (lane & 31) * 4);
    const int gw = F.bx * NWAVES + F.wave, NGW = F.G * NWAVES;
    for (int row = gw; row < T; row += NGW) {
#pragma unroll
        for (int jj = 0; jj < 3; ++jj) {
            const f32x4 v = ((const GAS f32x4*)(HO + (size_t)row * DAW))[lane + 64 * jj];
            const v2u gt = ((const GAS v2u*)(PB + (size_t)row * BIN + 2304))[lane + 64 * jj];
            float ss = (v.x * v.x + v.y * v.y) + (v.z * v.z + v.w * v.w);
            ss = half_sum(ss, lane);
            const float rs = 1.f / sqrtf(ss * (1.f / 128.f) + EPS);
            ((GAS unsigned long long*)(OC + (size_t)row * D))[lane + 64 * jj] =
                (unsigned long long)pk2(v.x * rs * g.x * pg8::silu_f(bf_lo(gt.x)), v.y * rs * g.y * pg8::silu_f(bf_hi(gt.x))) | ((unsigned long long)pk2(v.z * rs * g.z * pg8::silu_f(bf_lo(gt.y)), v.w * rs * g.w * pg8::silu_f(bf_hi(gt.y))) << 32);
        }
    }
}
constexpr int HG_LD = 136, HG_LS = 72;
constexpr int HL_QB = 0, HL_QT = 17408, HL_K = 34816, HL_VT = 78336, HL_PM = 96768, HL_TOT = 105984, HL_SSQ = 110080;
constexpr size_t WS_DCH = WS_SIN + 96 * MiB;
typedef short hbf16x8 __attribute__((ext_vector_type(8)));
typedef float hf32x2 __attribute__((ext_vector_type(2)));
__device__ __forceinline__ hbf16x8 lds8(const LAS unsigned short* p) { return *(const LAS hbf16x8*)p; }
__device__ __forceinline__ float ex2(float v) { return __builtin_amdgcn_exp2f(v); }
template <int PASS>
__device__ __forceinline__ void hgrn_load(Frame& F, int tid, int unit, hf32x2 (&lf)[8], unsigned (&qw)[8], v4u& va, v4u& vb) {
    const bf16* PB = (const bf16*)(F.ws + WS_BIG); const float* LF = (const float*)(F.ws + WS_BIG + 208 * MiB);
    const int kp = tid & 63, wave = __builtin_amdgcn_readfirstlane(tid >> 6), I = wave & 3, hf = wave >> 2, r0 = 16 * I + 8 * hf;
    const int bh = unit >> 6, c = unit & 63, b = bh / 6, h = bh % 6;
    const size_t tok0 = (size_t)b * S + c * 64;
#pragma unroll
    for (int jj = 0; jj < 8; ++jj) lf[jj] = *(const GAS hf32x2*)(LF + (tok0 + r0 + jj) * DAW + h * 128 + 2 * kp);
    if (PASS == 3) {
#pragma unroll
        for (int jj = 0; jj < 8; ++jj) qw[jj] = *(const GAS unsigned*)(PB + (tok0 + r0 + jj) * BIN + h * 128 + 2 * kp); }
    { const int sp = tid >> 4, e8 = (tid & 15) * 8; va = *(const GAS v4u*)(PB + (tok0 + 2 * sp) * BIN + 1536 + h * 128 + e8); vb = *(const GAS v4u*)(PB + (tok0 + 2 * sp + 1) * BIN + 1536 + h * 128 + e8); }
}
template <int PASS>
__device__ __forceinline__ void hgrn_unit(Frame& F, int tid, int unit, int nunit, int j, hf32x2 (&lf)[8], unsigned (&qw)[8], v4u& va, v4u& vb) {
    const bf16* PB = (const bf16*)(F.ws + WS_BIG); const float* LF = (const float*)(F.ws + WS_BIG + 208 * MiB);
    bf16* SLOC = (bf16*)(F.ws + WS_SLOC); const bf16* SIN = (const bf16*)(F.ws + WS_SIN); float* DCH = (float*)(F.ws + WS_DCH); bf16* OC = (bf16*)(F.ws + WS_OC);
    LAS unsigned short* QB = (LAS unsigned short*)(F.lds + HL_QB); LAS unsigned short* QT = (LAS unsigned short*)(F.lds + HL_QT); LAS unsigned short* KK = (LAS unsigned short*)(F.lds + HL_K);
    LAS unsigned short* VT = (LAS unsigned short*)(F.lds + HL_VT); LAS unsigned short* PM = (LAS unsigned short*)(F.lds + HL_PM); LAS float* TOT = (LAS float*)(F.lds + HL_TOT); LAS float* SSQ = (LAS float*)(F.lds + HL_SSQ);
    const int kp = tid & 63, lane = kp, wave = __builtin_amdgcn_readfirstlane(tid >> 6), I = wave & 3, hf = wave >> 2, sub = 2 * I + hf, r0 = 16 * I + 8 * hf, fr = lane & 15, fg = lane >> 4;
    const int bh = unit >> 6, c = unit & 63, b = bh / 6, h = bh % 6;
    const size_t tok0 = (size_t)b * S + c * 64;
    { const int sp = tid >> 4, e8 = (tid & 15) * 8; const v4u a = va, b2 = vb;
        const unsigned wa[4] = {a.x, a.y, a.z, a.w}, wb[4] = {b2.x, b2.y, b2.z, b2.w};
#pragma unroll
        for (int i = 0; i < 4; ++i) { *(LAS unsigned*)(VT + (e8 + 2 * i) * HG_LS + 2 * sp) = (wa[i] & 0xffffu) | (wb[i] << 16); *(LAS unsigned*)(VT + (e8 + 2 * i + 1) * HG_LS + 2 * sp) = (wa[i] >> 16) | (wb[i] & 0xffff0000u); } }
    hf32x2 cs[8]; { hf32x2 run = {0.f, 0.f};
#pragma unroll
        for (int jj = 0; jj < 8; ++jj) { run += lf[jj]; cs[jj] = run; } }
    *(LAS hf32x2*)(TOT + sub * 128 + 2 * kp) = cs[7];
    __syncthreads();
    hf32x2 rho = {0.f, 0.f}, presub = {0.f, 0.f}, blast = {0.f, 0.f};
#pragma unroll
    for (int s2 = 0; s2 < 8; ++s2) { const hf32x2 t = *(const LAS hf32x2*)(TOT + s2 * 128 + 2 * kp); if (s2 < 2 * I) rho += t; if (s2 < sub) presub += t; blast += t; }
    const hf32x2 off = presub - rho;
    if (PASS == 1) {
        unsigned w0[4], w1[4];
#pragma unroll
        for (int i = 0; i < 4; ++i) { const hf32x2 ba = rho + off + cs[2 * i], bb = rho + off + cs[2 * i + 1];
            w0[i] = pg8::cvt_pk_bf16((1.f - ex2(lf[2 * i].x)) * ex2(blast.x - ba.x), (1.f - ex2(lf[2 * i + 1].x)) * ex2(blast.x - bb.x));
            w1[i] = pg8::cvt_pk_bf16((1.f - ex2(lf[2 * i].y)) * ex2(blast.y - ba.y), (1.f - ex2(lf[2 * i + 1].y)) * ex2(blast.y - bb.y)); }
        *(LAS v4u*)(KK + (2 * kp) * HG_LS + r0) = (v4u){w0[0], w0[1], w0[2], w0[3]}; *(LAS v4u*)(KK + (2 * kp + 1) * HG_LS + r0) = (v4u){w1[0], w1[1], w1[2], w1[3]};
        if (sub == 0) *(GAS hf32x2*)(DCH + (size_t)unit * 128 + 2 * kp) = (hf32x2){ex2(blast.x), ex2(blast.y)};
        __syncthreads();
        if (nunit >= 0) hgrn_load<PASS>(F, tid, nunit, lf, qw, va, vb);
        const hbf16x8 a0 = lds8(KK + (16 * wave + fr) * HG_LS + 8 * fg), a1 = lds8(KK + (16 * wave + fr) * HG_LS + 32 + 8 * fg);
#pragma unroll
        for (int et = 0; et < 8; ++et) { const hbf16x8 b0 = lds8(VT + (16 * et + fr) * HG_LS + 8 * fg), b1 = lds8(VT + (16 * et + fr) * HG_LS + 32 + 8 * fg);
            f32x4 d = {0.f, 0.f, 0.f, 0.f}; d = __builtin_amdgcn_mfma_f32_16x16x32_bf16(a0, b0, d, 0, 0, 0); d = __builtin_amdgcn_mfma_f32_16x16x32_bf16(a1, b1, d, 0, 0, 0);
            v2u w2; w2.x = pk2(d[0], d[1]); w2.y = pk2(d[2], d[3]);
            *(GAS v2u*)(SLOC + ((size_t)unit * 128 + 16 * et + fr) * 128 + 16 * wave + 4 * fg) = w2; }
        __syncthreads();
    } else {
        const hf32x2 er = {ex2(rho.x), ex2(rho.y)};
        hf32x2 base[8];
#pragma unroll
        for (int jj = 0; jj < 8; ++jj) { const hf32x2 bl = off + cs[jj]; const hf32x2 e = {ex2(bl.x), ex2(bl.y)}; const hf32x2 q = {bf_lo(qw[jj]), bf_hi(qw[jj])}; const hf32x2 qt = q * e, qb = qt * er;
            *(LAS unsigned*)(QT + (r0 + jj) * HG_LD + 2 * kp) = pg8::cvt_pk_bf16(qt.x, qt.y); *(LAS unsigned*)(QB + (r0 + jj) * HG_LD + 2 * kp) = pg8::cvt_pk_bf16(qb.x, qb.y);
            base[jj] = (hf32x2){(1.f - ex2(lf[jj].x)) * ex2(-bl.x), (1.f - ex2(lf[jj].y)) * ex2(-bl.y)}; }
        hf32x2 rr = {0.f, 0.f};
        for (int Ip = I; Ip < 4; ++Ip) { LAS unsigned short* Kp = KK + (8 * Ip * (Ip + 1)) * HG_LD;
            const hf32x2 sc = {ex2(rr.x), ex2(rr.y)};
#pragma unroll
            for (int jj = 0; jj < 8; ++jj) { const hf32x2 kv = base[jj] * sc; *(LAS unsigned*)(Kp + (r0 + jj) * HG_LD + 2 * kp) = pg8::cvt_pk_bf16(kv.x, kv.y); }
            rr += *(const LAS hf32x2*)(TOT + (2 * Ip) * 128 + 2 * kp) + *(const LAS hf32x2*)(TOT + (2 * Ip + 1) * 128 + 2 * kp); }
        __syncthreads();
        const int tt = wave & 3, eh = wave >> 2; const size_t tok = tok0 + 16 * tt + fr;
        hbf16x8 sfr[4][4]; v2u gtv[4];
#pragma unroll
        for (int et = 0; et < 4; ++et) { const int e0 = 64 * eh + 16 * et; const GAS hbf16x8* sp = (const GAS hbf16x8*)(SIN + ((size_t)unit * 128 + e0 + fr) * 128 + 8 * fg);
#pragma unroll
            for (int ks = 0; ks < 4; ++ks) sfr[et][ks] = sp[4 * ks];
            gtv[et] = *(const GAS v2u*)(PB + tok * BIN + 2304 + h * 128 + e0 + 4 * fg); }
        if (nunit >= 0) hgrn_load<PASS>(F, tid, nunit, lf, qw, va, vb);
        { const int It = wave >> 1; const LAS unsigned short* Kp = KK + (8 * It * (It + 1)) * HG_LD;
#pragma unroll
            for (int jt = 0; jt < 2; ++jt) { const int J = 2 * (wave & 1) + jt; f32x4 d = {0.f, 0.f, 0.f, 0.f};
                if (J <= It) {
#pragma unroll
                    for (int ks = 0; ks < 4; ++ks) d = __builtin_amdgcn_mfma_f32_16x16x32_bf16(lds8(QT + (16 * It + fr) * HG_LD + 32 * ks + 8 * fg), lds8(Kp + (16 * J + fr) * HG_LD + 32 * ks + 8 * fg), d, 0, 0, 0);
                    if (J == It) {
#pragma unroll
                        for (int i = 0; i < 4; ++i) if (fr > 4 * fg + i) d[i] = 0.f; }
                }
#pragma unroll
                for (int i = 0; i < 4; ++i) PM[(16 * It + 4 * fg + i) * HG_LS + 16 * J + fr] = (unsigned short)f2bf(d[i]); } }
        __syncthreads();
        f32x4 o[4];
        const hbf16x8 p0 = lds8(PM + (16 * tt + fr) * HG_LS + 8 * fg), p1 = lds8(PM + (16 * tt + fr) * HG_LS + 32 + 8 * fg);
        hbf16x8 qb[4];
#pragma unroll
        for (int ks = 0; ks < 4; ++ks) qb[ks] = lds8(QB + (16 * tt + fr) * HG_LD + 32 * ks + 8 * fg);
        float ss = 0.f;
#pragma unroll
        for (int et = 0; et < 4; ++et) { const int e0 = 64 * eh + 16 * et; f32x4 d = {0.f, 0.f, 0.f, 0.f};
            d = __builtin_amdgcn_mfma_f32_16x16x32_bf16(lds8(VT + (e0 + fr) * HG_LS + 8 * fg), p0, d, 0, 0, 0);
            d = __builtin_amdgcn_mfma_f32_16x16x32_bf16(lds8(VT + (e0 + fr) * HG_LS + 32 + 8 * fg), p1, d, 0, 0, 0);
#pragma unroll
            for (int ks = 0; ks < 4; ++ks) d = __builtin_amdgcn_mfma_f32_16x16x32_bf16(sfr[et][ks], qb[ks], d, 0, 0, 0);
            o[et] = d; ss += (d[0] * d[0] + d[1] * d[1]) + (d[2] * d[2] + d[3] * d[3]); }
        ss += xor_get(ss, lane, 16); ss += xor_get(ss, lane, 32);
        if (fg == 0) SSQ[(tt * 2 + eh) * 16 + fr] = ss;
        __syncthreads();
        const float rs = 1.f / sqrtf((SSQ[(tt * 2) * 16 + fr] + SSQ[(tt * 2 + 1) * 16 + fr]) * (1.f / 128.f) + EPS);
#pragma unroll
        for (int et = 0; et < 4; ++et) { const int e = 64 * eh + 16 * et + 4 * fg;
            const f32x4 gn = *(const GAS f32x4*)(F.in[15] + j * 128 + e); const v2u gt = gtv[et];
            v2u w; w.x = pg8::cvt_pk_bf16(o[et][0] * rs * gn.x * pg8::silu_f(bf_lo(gt.x)), o[et][1] * rs * gn.y * pg8::silu_f(bf_hi(gt.x))); w.y = pg8::cvt_pk_bf16(o[et][2] * rs * gn.z * pg8::silu_f(bf_lo(gt.y)), o[et][3] * rs * gn.w * pg8::silu_f(bf_hi(gt.y)));
            *(GAS v2u*)(OC + tok * D + h * 128 + e) = w; }
        __syncthreads();
    }
}
template <int PASS> __device__ __forceinline__ void phase_hgrn(Frame& F, int j) {
    const int tid = F.wave * 64 + fresh_lane();
    hf32x2 lf[8]; unsigned qw[8]; v4u va, vb;
#pragma unroll
    for (int i = 0; i < 8; ++i) qw[i] = 0u;
    if (F.bx < NB * 6 * 64) hgrn_load<PASS>(F, tid, F.bx, lf, qw, va, vb);
    for (int u = F.bx; u < NB * 6 * 64; u += F.G) hgrn_unit<PASS>(F, tid, u, (u + F.G < NB * 6 * 64) ? u + F.G : -1, j, lf, qw, va, vb);
}
__device__ __forceinline__ void phase_hgrn_scan(Frame& F) {
    const bf16* SLOC = (const bf16*)(F.ws + WS_SLOC); bf16* SIN = (bf16*)(F.ws + WS_SIN); const float* DCH = (const float*)(F.ws + WS_DCH);
    const int tid = F.wave * 64 + fresh_lane();
    for (int id = F.bx * (NWAVES * 64) + tid; id < NB * 6 * 128 * 64; id += F.G * NWAVES * 64) {
        const int k2 = id & 63, e = (id >> 6) & 127, bh = id >> 13;
        const GAS unsigned* sl = (const GAS unsigned*)(SLOC + ((size_t)bh * 64 * 128 + e) * 128) + k2; const GAS hf32x2* dc = (const GAS hf32x2*)(DCH + (size_t)bh * 64 * 128) + k2;
        GAS unsigned* so = (GAS unsigned*)(SIN + ((size_t)bh * 64 * 128 + e) * 128) + k2;
        hf32x2 st = {0.f, 0.f};
#pragma unroll 16
        for (int c = 0; c < 64; ++c) { const unsigned aw = sl[(size_t)c * 128 * 64]; const hf32x2 a = {bf_lo(aw), bf_hi(aw)}, d = dc[(size_t)c * 64]; so[(size_t)c * 128 * 64] = pg8::cvt_pk_bf16(st.x, st.y); st = d * st + a; }
    }
}
struct Args { const float* in[27]; float* out; unsigned char* ws; };
__global__ void __launch_bounds__(NWAVES * 64, 2) mk_fwd(Args) {
    extern __shared__ __attribute__((aligned(16))) unsigned char lds[];
    Frame F;
    F.lds = (LAS unsigned char*)lds;
    F.MISC = (volatile LAS unsigned*)(F.lds + MISC_OFF);
    F.wave = __builtin_amdgcn_readfirstlane((int)(threadIdx.x >> 6));
    F.G = gridDim.x; F.bx = blockIdx.x; { const int bx = blockIdx.x; F.vcu = (F.G % 8 == 0) ? (bx % 8) * (F.G / 8) + bx / 8 : bx; }
    for (int u = threadIdx.x; u < (LDS_BYTES - LDSCTL_OFF) / 4; u += NWAVES * 64) ((LAS unsigned*)(F.lds + LDSCTL_OFF))[u] = 0u;
    __syncthreads();
    {
        LAS unsigned long long* tab = (LAS unsigned long long*)(F.lds + LDSCTL_OFF);
        if (threadIdx.x < 29) tab[threadIdx.x] = ((const unsigned long long*)__builtin_amdgcn_kernarg_segment_ptr())[threadIdx.x];
        __syncthreads();
        F.in.t = tab; F.out = (GAS float*)(unsigned long long)F.in[27]; F.ws = (GAS unsigned char*)(unsigned long long)F.in[28]; }
    F.ctl = (gu32*)(F.ws + WS_CTL);
    XcdBarrier bar = xcd_barrier_post((unsigned*)(F.ctl + CW_BAR), F.MISC + 8);
#define XBAR_() do { XcdBarrier b_ = bar; { unsigned long long p_ = (unsigned long long)b_.bar; asm volatile("" : "+s"(p_), "+s"(b_.x)); b_.bar = (unsigned*)(GAS unsigned*)p_; } xcd_barrier(b_); if (MK_DUP & 0x8000) xcd_barrier(b_); } while (0)
#define GRID_BAR() XBAR_()
#define REP(cat) for (int rep_ = 0; rep_ < (((MK_DUP >> (cat)) & 1) ? 2 : 1); ++rep_)
#if MK_TS
    unsigned long long ts_last = rt(); unsigned ts_cat[15], ts_wb[14];
#pragma unroll
    for (int i = 0; i < 15; ++i) ts_cat[i] = 0u;
#pragma unroll
    for (int i = 0; i < 14; ++i) ts_wb[i] = 0u;
#define GRID_BAR_T(c) do { const unsigned long long arr_ = rt(); XBAR_(); const unsigned long long now_ = rt(); const unsigned dt_ = (unsigned)(arr_ - ts_last), db_ = (unsigned)(now_ - arr_); ts_last = now_; const int cc_ = (c); \
    _Pragma("unroll") for (int i_ = 0; i_ < 14; ++i_) { ts_cat[i_] += (cc_ == i_) ? dt_ : 0u; ts_wb[i_] += (cc_ == i_) ? db_ : 0u; } ts_cat[14] += db_; } while (0)
#else
#define GRID_BAR_T(c) XBAR_()
#endif

    REP(0) phase_prologue(F);
    GRID_BAR_T(0);
    {
        struct MkvOrder { int G, c; __device__ bool next(int i, pg8::Unit& u) const { const int L = i * G + c; if (L >= 64) return false; u.pm = L >> 1; u.pn = L & 1; u.pb = (u.pm >> 3) * 2 + u.pn; return true; }
            __device__ __forceinline__ void a_ready(const pg8::Unit&) const {} __device__ __forceinline__ void done(const pg8::Unit&) const {} } So{F.G, F.bx};
        pg8::Gemm g{(const pg8::bf16_t*)(F.ws + WS_MEMN), (const pg8::bf16_t*)(F.ws + WS_WMKV), 4 * NB * MEML, 512, D};
        pg8::EpiProj E{(pg8::bf16_t*)(F.ws + WS_MKV), 512, 0u, 1.f, 0, 0, nullptr, 0, nullptr, nullptr, nullptr};
        pg8::gemm_phase<pg8::EpiProj, MkvOrder, true, true>(F.lds + RING_OFF, g, So, E, F.wave);
    }
    for (int l = 0; l < 4; ++l) {
        const int j = l >> 1; const bool isA = (l & 1) == 0;
        {
            unsigned long long w_ = (unsigned long long)F.ws, o_ = (unsigned long long)F.out, c_ = (unsigned long long)F.ctl, b_ = (unsigned long long)bar.bar;
            asm volatile("" : "+s"(w_), "+s"(o_), "+s"(c_), "+s"(b_)); F.ws = (GAS unsigned char*)w_; F.out = (GAS float*)o_; F.ctl = (gu32*)c_; bar.bar = (unsigned*)b_;
            asm volatile("" : "+s"(F.vcu), "+s"(F.G), "+s"(F.bx), "+s"(F.wave)); }
        bf16* const XN = (bf16*)(F.ws + WS_XN); bf16* const OC = (bf16*)(F.ws + WS_OC); float* const X = (float*)F.out;
        if (isA) {
            pg8::Gemm g{XN, (const pg8::bf16_t*)(F.ws + WS_WINA) + (size_t)j * AIN * D, T, AIN, D}; pg8::StaticOrder So; So.init(T, AIN, F.G, F.bx);
            pg8::EpiProj E{(pg8::bf16_t*)(F.ws + WS_BIG), AIN, 0x207u, C2, 0, 0, nullptr, 0, nullptr, nullptr, (unsigned*)(F.ctl + CW_N2) + j * (NB * 24 * 64 * 2)};
            REP(1) pg8::gemm_phase<pg8::EpiProj, pg8::StaticOrder, true, true>(F.lds + RING_OFF, g, So, E, F.wave);
        } else {
            pg8::Gemm g{XN, (const pg8::bf16_t*)(F.ws + WS_WINB) + (size_t)j * BIN * D, T, BIN, D}; pg8::StaticOrder So; So.init(T, BIN, F.G, F.bx);
            pg8::EpiProj E{(pg8::bf16_t*)(F.ws + WS_BIG), BIN, 0x1000u, C2, 3, 6, (float*)(F.ws + WS_BIG + 208 * MiB), DAW, (const float*)(F.ws + WS_ROUTE + 1024 * 1024) + j * DAW, (const float*)(F.ws + WS_SSQP) + (size_t)(2 * j + 1) * T * 16, nullptr};
            REP(1) pg8::gemm_phase<pg8::EpiProj, pg8::StaticOrder, true, true>(F.lds + RING_OFF, g, So, E, F.wave);
        }
        GRID_BAR_T(1);
        const int ldp = isA ? AIN : BIN, qmoff = isA ? 2304 : 3072;
        if (isA) {
            const attn_body::bf16* P = (const attn_body::bf16*)(F.ws + WS_BIG); attn_body::bf16* O01 = (attn_body::bf16*)(F.ws + WS_BIG + 160 * MiB);
            const GAS float* N2 = (const GAS float*)(F.ctl + CW_N2) + j * (NB * 24 * 64 * 2); const int lane_n = fresh_lane();
            const bool tabdeal = (F.G == 256);
            REP(2) for (int p = F.vcu; p < NB * 24 * 8; p += F.G) {
                const int it = p >> 8, s = p & 7, half = (p >> 3) & 1, m = (p >> 4) & 1, b = (p >> 5) & 7;
              for (int k = 0; k < 2; ++k) {
                int h, qb; if (tabdeal) { const int e = ATT_DEAL[s][2 * it + k]; h = e >> 4; qb = e & 15; } else { h = it; qb = k ? 15 - s : s; }
                const float nsl2 = -1.4426950408889634f * exp2f(-8.f * (float)(h + 1) / 6.f);
                const attn_body::bf16* Kh = P + (size_t)b * S * AIN + 768 + h * 128 + m * 64; const attn_body::bf16* Vh = P + (size_t)b * S * AIN + 1536 + h * 128 + half * 64;
#ifndef NO_ATTN0
                { const int NT = 4 * qb + 4;
                    typedef float f32x2n __attribute__((ext_vector_type(2)));
                    const f32x2n qn2 = *(const GAS f32x2n*)(N2 + ((b * 24 + h * 2 + m) * 64 + lane_n) * 2), kn2 = *(const GAS f32x2n*)(N2 + ((b * 24 + 12 + h * 2 + m) * 64 + lane_n) * 2);
                    const bool qin = (lane_n >= 4 * qb && lane_n < 4 * qb + 4), kin = (lane_n < NT);
                    float qa = qin ? qn2.x : 0.f, qb2 = qin ? qn2.y : 0.f, ka = kin ? kn2.x : 0.f, kb = kin ? kn2.y : 0.f;
#pragma unroll
                    for (int o = 1; o < 64; o <<= 1) { qa = fmaxf(qa, xor_get(qa, lane_n, o)); qb2 = fmaxf(qb2, xor_get(qb2, lane_n, o)); ka = fmaxf(ka, xor_get(ka, lane_n, o)); kb = fmaxf(kb, xor_get(kb, lane_n, o)); }
                    const float dreq = (160.f + 2.f * (sqrtf(qa * ka) + sqrtf(qb2 * kb)) * 1.02f) / (-nsl2);
                    int tskip = (int)floorf(((float)(qb * 256 - 63) - dreq) * (1.f / 64.f)); tskip = tskip < 0 ? 0 : tskip; tskip &= ~1; tskip = tskip > NT - 4 ? NT - 4 : tskip;
                    tskip = __builtin_amdgcn_readfirstlane(tskip);
                    attn_body::attn_unit<0, 8>(P + (size_t)(b * S + qb * 256) * AIN + h * 128 + m * 64, AIN, Kh + (size_t)tskip * 64 * AIN, AIN, Vh + (size_t)tskip * 64 * AIN, AIN,
                                               O01 + (size_t)m * T * DAW + (size_t)(b * S + qb * 256) * DAW + h * 128 + half * 64, DAW, NT - tskip, qb * 256 - 64 * tskip, nsl2, (char*)lds + RING_OFF, F.wave); }
#endif
              }
            }
        } else {
            REP(3) phase_hgrn<1>(F, j);
        }
        {
            const attn_body::bf16* P = (const attn_body::bf16*)(F.ws + WS_BIG); const attn_body::bf16* KV = (const attn_body::bf16*)(F.ws + WS_MKV) + (size_t)l * NB * MEML * 512;
#ifndef NO_ATTN1
            REP(13) for (int u = F.vcu; u < NB * 4 * 16; u += F.G) { const int qb = u & 15, hm = (u >> 4) & 3, b = u >> 6;
                attn_body::attn_unit<1, 8>(P + (size_t)(b * S + qb * 256) * ldp + qmoff + hm * 64, ldp, KV + (size_t)b * MEML * 512 + hm * 64, 512, KV + (size_t)b * MEML * 512 + 256 + hm * 64, 512,
                                           (attn_body::bf16*)OC + (size_t)(b * S + qb * 256) * D + DAW + hm * 64, D, 4, 0, 0.f, (char*)lds + RING_OFF, F.wave); }
#endif
        }
        GRID_BAR_T(isA ? 2 : 3);
        if (isA) { REP(5) phase_diff_combine(F, j, l == 0 ? 0.2f : (float)(0.8 - 0.6 * 0.5488116360940264)); }
        else { REP(14) phase_hgrn_scan(F); GRID_BAR_T(4); REP(4) phase_hgrn<3>(F, j); }
        GRID_BAR_T(isA ? 5 : 4);
#if MK_DBG
        {
            const int lane = fresh_lane(); const int gw = F.bx * NWAVES + F.wave, NGW = F.G * NWAVES;
            for (int r = gw; r < 1024; r += NGW) { f32x4 v[4];
#pragma unroll
                for (int jj = 0; jj < 4; ++jj) { const v2u a = ((const GAS v2u*)(OC + (size_t)(r * 32) * D))[lane + 64 * jj]; v[jj].x = bf_lo(a.x); v[jj].y = bf_hi(a.x); v[jj].z = bf_lo(a.y); v[jj].w = bf_hi(a.y); }
                dbg_sample_f32(F, lane, 8 + l, r * 32, v); }
        }
#endif
        {
            pg8::Gemm g{OC, (const pg8::bf16_t*)(F.ws + WS_WOUT) + (size_t)l * D * D, T, D, D}; pg8::StaticOrder So; So.init(T, D, F.G, F.bx);
            if ((MK_DUP >> 6) & 1) { pg8::EpiResid E2{(float*)(F.ws + 1400 * MiB), l == 0 ? F.in[0] : X, D, nullptr, nullptr, nullptr, 1.f}; pg8::gemm_phase<pg8::EpiResid, pg8::StaticOrder, true, true>(F.lds + RING_OFF, g, So, E2, F.wave); }
            pg8::EpiResid E{X, l == 0 ? F.in[0] : X, D, isA ? XN : nullptr, isA ? F.in[19] + j * D : nullptr, isA ? (float*)(F.ws + WS_SSQP) + (size_t)(2 * j) * T * 16 : nullptr, 1.f};
            pg8::gemm_phase<pg8::EpiResid, pg8::StaticOrder, true, true>(F.lds + RING_OFF, g, So, E, F.wave);
        }
        GRID_BAR_T(6);
        if (isA) {
            {
                pg8::Gemm g{XN, (const pg8::bf16_t*)(F.ws + WS_WGUD) + (size_t)j * 2 * FFD * D, T, 2 * FFD, D}; pg8::StaticOrder So; So.init(T, 2 * FFD, F.G, F.bx);
                pg8::EpiSwiglu<false> E{(pg8::bf16_t*)(F.ws + WS_BIG), FFD, 1.f, 1.f, (const float*)(F.ws + WS_SSQP) + (size_t)(2 * j) * T * 16};
                REP(7) pg8::gemm_phase<pg8::EpiSwiglu<false>, pg8::StaticOrder, true, true>(F.lds + RING_OFF, g, So, E, F.wave);
            }
            GRID_BAR_T(7);
            {
                pg8::Gemm g{(const pg8::bf16_t*)(F.ws + WS_BIG), (const pg8::bf16_t*)(F.ws + WS_WDND) + (size_t)j * D * FFD, T, D, FFD}; pg8::StaticOrder So; So.init(T, D, F.G, F.bx);
                if ((MK_DUP >> 8) & 1) { pg8::EpiResid E2{(float*)(F.ws + 1400 * MiB), X, D, nullptr, nullptr, nullptr, 1.f}; pg8::gemm_phase<pg8::EpiResid, pg8::StaticOrder, true, true>(F.lds + RING_OFF, g, So, E2, F.wave); }
                pg8::EpiResid E{X, X, D, XN, F.in[12] + j * D, (float*)(F.ws + WS_SSQP) + (size_t)(2 * j + 1) * T * 16, 1.f};
                pg8::gemm_phase<pg8::EpiResid, pg8::StaticOrder, true, true>(F.lds + RING_OFF, g, So, E, F.wave);
            }
            GRID_BAR_T(8);

        } else {
            gu32* gcnt = F.ctl + CW_GCNT + 64 * j;
#ifndef NO_NORM
            phase_router(F, X, F.in[22] + j * D, F.in[23] + (size_t)j * D * 8, gcnt, 2 * l);
#endif
            GRID_BAR_T(9);
            REP(10) phase_gather(F, gcnt);
            GRID_BAR_T(10);
            {
                int cnt[8];
#pragma unroll
                for (int e = 0; e < 8; ++e) cnt[e] = __builtin_amdgcn_readfirstlane((int)__hip_atomic_load(gcnt + e, RLX_AGENT));
                pg8::Gemm g{(const pg8::bf16_t*)(F.ws + WS_XG), (const pg8::bf16_t*)(F.ws + WS_WGUM + (size_t)j * NE * 2 * FFE * D), MAXROWS, 2 * FFE, D / 2}; pg8::MoeOrder So; So.init(cnt, 2 * FFE / 256, F.G, F.bx);
                pg8::EpiSwiglu<true> E{(pg8::bf16_t*)(F.ws + WS_BIG), FFE, 1.f / (SC_X * SC_WGU), SC_H, nullptr};
                REP(11) pg8::gemm_phase<pg8::EpiSwiglu<true>, pg8::MoeOrder, true, true, true>(F.lds + RING_OFF, g, So, E, F.wave);
            }
            GRID_BAR_T(11);
            {
                int cnt[8];
#pragma unroll
                for (int e = 0; e < 8; ++e) cnt[e] = __builtin_amdgcn_readfirstlane((int)__hip_atomic_load(gcnt + e, RLX_AGENT));
                pg8::Gemm g{(const pg8::bf16_t*)(F.ws + WS_BIG), (const pg8::bf16_t*)(F.ws + WS_WDNM + (size_t)j * NE * D * FFE), MAXROWS, D, FFE / 2}; pg8::MoeOrder So; So.init(cnt, D / 256, F.G, F.bx);
                pg8::EpiProj E{(pg8::bf16_t*)(F.ws + WS_Y), D, 0xffffffffu, 1.f / (SC_H * SC_WDN), 0, 0, nullptr, 0, nullptr, nullptr, nullptr};
                REP(12) pg8::gemm_phase<pg8::EpiProj, pg8::MoeOrder, true, true, true>(F.lds + RING_OFF, g, So, E, F.wave);
            }
            GRID_BAR_T(12);
            if (l == 1) { phase_norm<true, false, false>(F, X, X, F.in[2] + 1 * D, nullptr, nullptr, 2 * l + 1); GRID_BAR_T(9); }
            else {
                phase_norm<true, false, true>(F, X, X, F.in[26], nullptr, nullptr, 2 * l + 1);
#if MK_TS
                if (F.bx == 0 && F.wave == 0) { unsigned ta = 0u;
#pragma unroll
                    for (int i = 0; i < 15; ++i) if ((MK_TS_A >> i) & 1) ta += ts_cat[i];
#pragma unroll
                    for (int i = 0; i < 14; ++i) if ((MK_TS_B >> i) & 1) ta += ts_wb[i];
                    const unsigned long long t0_ = rt(); while ((unsigned)(rt() - t0_) < ta) __builtin_amdgcn_s_sleep(8); }
#endif
            }
        }
    }
#undef GRID_BAR
}

static int mk_launch(void* const* d_in, void* d_out, void* d_ws, size_t ws_size, hipStream_t stream) {
    static int grid = 0;
    if (grid == 0) {
        if (ws_size < WS_END) { fprintf(stderr, "kernel_launch: workspace too small (%zu < %zu)\n", ws_size, (size_t)WS_END); grid = -1; return -1; }
        int dev = 0, cus = 0, per_cu = 0;
        if (hipGetDevice(&dev) != hipSuccess || hipDeviceGetAttribute(&cus, hipDeviceAttributeMultiprocessorCount, dev) != hipSuccess) { grid = -1; return -1; }
        if (hipFuncSetAttribute((const void*)mk_fwd, hipFuncAttributeMaxDynamicSharedMemorySize, LDS_BYTES) != hipSuccess) { fprintf(stderr, "kernel_launch: hipFuncSetAttribute failed\n"); grid = -1; return -1; }
        if (hipOccupancyMaxActiveBlocksPerMultiprocessor(&per_cu, (const void*)mk_fwd, NWAVES * 64, LDS_BYTES) != hipSuccess || per_cu < 1) fprintf(stderr, "kernel_launch: note: occupancy query reports %d\n", per_cu);
        (void)hipGetLastError();
        grid = cus;
        if (grid != 256) fprintf(stderr, "kernel_launch: note: %d CUs (tuned for 256)\n", grid);
    }
    if (grid < 0) return -1;
    if (hipMemsetAsync((char*)d_ws + WS_CTL, 0, CTL_ZERO_BYTES, stream) != hipSuccess) return -1;
    Args a{};
    for (int i = 0; i < 27; ++i) a.in[i] = (const float*)d_in[i];
    a.out = (float*)d_out; a.ws = (unsigned char*)d_ws;
    hipLaunchKernelGGL(mk_fwd, dim3(grid), dim3(NWAVES * 64), LDS_BYTES, stream, a);
    return 0;
}
#if MK_DBG
namespace nv {
constexpr int MEMW = 256;

__device__ __forceinline__ float sigmoidf_(float z) { return 1.f / (1.f + __expf(-z)); }
__device__ __forceinline__ float siluf_(float z) { return z / (1.f + __expf(-z)); }

__global__ void __launch_bounds__(256) k_rmsnorm(const float* __restrict__ in, const float* __restrict__ g, float* __restrict__ out, int rows) {
    const int lane = threadIdx.x & 63, w = (blockIdx.x * 256 + threadIdx.x) >> 6, nw = (gridDim.x * 256) >> 6;
    for (int r = w; r < rows; r += nw) {
        const float4* xr = (const float4*)(in + (size_t)r * D) + lane;
        float4 v[4]; float s = 0.f;
#pragma unroll
        for (int j = 0; j < 4; ++j) { v[j] = xr[64 * j]; s += v[j].x * v[j].x + v[j].y * v[j].y + v[j].z * v[j].z + v[j].w * v[j].w; }
        const float rstd = rsqrtf(wave_sum(s) * (1.f / D) + EPS);
        float4* o = (float4*)(out + (size_t)r * D) + lane;
#pragma unroll
        for (int j = 0; j < 4; ++j) { const float4 gg = ((const float4*)g)[lane + 64 * j];
            o[64 * j] = make_float4(v[j].x * rstd * gg.x, v[j].y * rstd * gg.y, v[j].z * rstd * gg.z, v[j].w * rstd * gg.w); }
    }
}

template <int ADD>
__global__ void __launch_bounds__(256) k_gemm(const float* __restrict__ A, int lda, const float* __restrict__ Bm, int ldb, float* C, int ldc, const float* R, int M, int N, int K, const int* dyn, int offA, int offC) {
    __shared__ float As[8][132];
    __shared__ float Bs[8][128];
    int roffA = 0, roffC = 0;
    if (dyn) { roffA = offA ? dyn[0] : 0; roffC = offC ? dyn[0] : 0; M = dyn[1] < 16384 ? dyn[1] : 16384; }
    const int m0 = blockIdx.y * 128, n0 = blockIdx.x * 128;
    if (m0 >= M) return;
    const int tid = threadIdx.x, ty = tid >> 4, tx = tid & 15;
    float acc[8][8];
#pragma unroll
    for (int i = 0; i < 8; ++i)
#pragma unroll
        for (int j = 0; j < 8; ++j) acc[i][j] = 0.f;
    const int ar = tid >> 1, ak = (tid & 1) * 4;
    int arow = m0 + ar; if (arow >= M) arow = M - 1;
    const float* ap = A + (size_t)(roffA + arow) * lda + ak;
    const int bk = tid >> 5, bn = (tid & 31) * 4;
    const float* bp = Bm + (size_t)bk * ldb + n0 + bn;
    for (int k0 = 0; k0 < K; k0 += 8) {
        const float4 av = *(const float4*)(ap + k0);
        const float4 bv = *(const float4*)(bp + (size_t)k0 * ldb);
        __syncthreads();
        As[ak + 0][ar] = av.x; As[ak + 1][ar] = av.y; As[ak + 2][ar] = av.z; As[ak + 3][ar] = av.w;
        *(float4*)&Bs[bk][bn] = bv;
        __syncthreads();
#pragma unroll
        for (int k = 0; k < 8; ++k) {
            float a[8], b[8];
            *(float4*)&a[0] = *(const float4*)&As[k][ty * 4]; *(float4*)&a[4] = *(const float4*)&As[k][64 + ty * 4];
            *(float4*)&b[0] = *(const float4*)&Bs[k][tx * 4]; *(float4*)&b[4] = *(const float4*)&Bs[k][64 + tx * 4];
#pragma unroll
            for (int i = 0; i < 8; ++i)
#pragma unroll
                for (int j = 0; j < 8; ++j) acc[i][j] += a[i] * b[j];
        }
    }
#pragma unroll
    for (int i = 0; i < 8; ++i) {
        const int r = m0 + (i < 4 ? ty * 4 + i : 64 + ty * 4 + (i - 4));
        if (r >= M) continue;
#pragma unroll
        for (int jh = 0; jh < 2; ++jh) {
            const int c = n0 + jh * 64 + tx * 4;
            float4 v = make_float4(acc[i][jh * 4 + 0], acc[i][jh * 4 + 1], acc[i][jh * 4 + 2], acc[i][jh * 4 + 3]);
            if (ADD) { const float4 rr = *(const float4*)(R + (size_t)(roffC + r) * ldc + c); v.x += rr.x; v.y += rr.y; v.z += rr.z; v.w += rr.w; }
            *(float4*)(C + (size_t)(roffC + r) * ldc + c) = v;
        }
    }
}

__global__ void __launch_bounds__(64) k_diff_attn(const float* __restrict__ proj  , float* __restrict__ O  ) {
    const int c = blockIdx.x, bhm = blockIdx.y, m = bhm & 1, h = (bhm >> 1) % 6, b = bhm / 12;
    const int qpos = c * 64 + threadIdx.x;
    const float slope = exp2f(-8.f * (float)(h + 1) / 6.f);
    float q[64];
    const float* qp = proj + (size_t)(b * S + qpos) * AIN + h * 128 + m * 64;
#pragma unroll
    for (int d = 0; d < 64; d += 4) { const float4 v = *(const float4*)(qp + d); q[d] = v.x * 0.125f; q[d + 1] = v.y * 0.125f; q[d + 2] = v.z * 0.125f; q[d + 3] = v.w * 0.125f; }
    const int nk = (c + 1) * 64;
    const float* kbase = proj + (size_t)b * S * AIN + DAW + h * 128 + m * 64;
    const float* vbase = proj + (size_t)b * S * AIN + 2 * DAW + h * 128;
    float mx = -3.0e38f;
    for (int k = 0; k < nk; ++k) {
        const float* kr = kbase + (size_t)k * AIN;
        float s = 0.f;
#pragma unroll
        for (int d = 0; d < 64; ++d) s += q[d] * kr[d];
        s -= slope * fabsf((float)(qpos - k));
        mx = fmaxf(mx, s);
    }
    float o[128];
#pragma unroll
    for (int e = 0; e < 128; ++e) o[e] = 0.f;
    float l = 0.f;
    for (int k = 0; k < nk; ++k) {
        const float* kr = kbase + (size_t)k * AIN;
        float s = 0.f;
#pragma unroll
        for (int d = 0; d < 64; ++d) s += q[d] * kr[d];
        s -= slope * fabsf((float)(qpos - k));
        const float p = __expf(s - mx);
        l += p;
        const float* vr = vbase + (size_t)k * AIN;
#pragma unroll
        for (int e = 0; e < 128; ++e) o[e] += p * vr[e];
    }
    const float il = 1.f / l;
    float* op = O + (size_t)m * T * DAW + (size_t)(b * S + qpos) * DAW + h * 128;
#pragma unroll
    for (int e = 0; e < 128; e += 4) *(float4*)(op + e) = make_float4(o[e] * il, o[e + 1] * il, o[e + 2] * il, o[e + 3] * il);
}
__global__ void __launch_bounds__(256) k_diff_combine(const float* __restrict__ O, const float* __restrict__ lq1, const float* __restrict__ lk1, const float* __restrict__ lq2, const float* __restrict__ lk2,
                                                       const float* __restrict__ subln, float lam_init, float* __restrict__ OC) {
    float s1 = 0.f, s2 = 0.f;
    for (int d = 0; d < 64; ++d) { s1 += lq1[d] * lk1[d]; s2 += lq2[d] * lk2[d]; }
    const float lam = __expf(s1) - __expf(s2) + lam_init;
    const int idx = blockIdx.x * 256 + threadIdx.x;
    if (idx >= T * 6) return;
    const int t = idx / 6, h = idx % 6;
    const float* o0 = O + (size_t)t * DAW + h * 128; const float* o1 = o0 + (size_t)T * DAW;
    float v[128]; float ss = 0.f;
#pragma unroll
    for (int e = 0; e < 128; ++e) { v[e] = o0[e] - lam * o1[e]; ss += v[e] * v[e]; }
    const float rstd = rsqrtf(ss * (1.f / 128.f) + EPS) * (1.f - lam_init);
    float* oc = OC + (size_t)t * D + h * 128;
#pragma unroll
    for (int e = 0; e < 128; ++e) oc[e] = v[e] * rstd * subln[e];
}
__global__ void __launch_bounds__(64) k_mem_attn(const float* __restrict__ proj, int ldp, int qoff, const float* __restrict__ kv  , float* __restrict__ OC) {
    const int h = blockIdx.y, t = blockIdx.x * 64 + threadIdx.x, b = t / S;
    float q[64];
    const float* qp = proj + (size_t)t * ldp + qoff + h * 64;
#pragma unroll
    for (int d = 0; d < 64; ++d) q[d] = qp[d] * 0.125f;
    const float* kb = kv + (size_t)b * MEML * 512 + h * 64;
    float mx = -3.0e38f;
    for (int k = 0; k < MEML; ++k) { const float* kr = kb + (size_t)k * 512; float s = 0.f;
#pragma unroll
        for (int d = 0; d < 64; ++d) s += q[d] * kr[d];
        mx = fmaxf(mx, s); }
    float o[64]; float l = 0.f;
#pragma unroll
    for (int e = 0; e < 64; ++e) o[e] = 0.f;
    for (int k = 0; k < MEML; ++k) { const float* kr = kb + (size_t)k * 512; float s = 0.f;
#pragma unroll
        for (int d = 0; d < 64; ++d) s += q[d] * kr[d];
        const float p = __expf(s - mx); l += p; const float* vr = kr + 256;
#pragma unroll
        for (int e = 0; e < 64; ++e) o[e] += p * vr[e]; }
    const float il = 1.f / l;
    float* oc = OC + (size_t)t * D + DAW + h * 64;
#pragma unroll
    for (int e = 0; e < 64; ++e) oc[e] = o[e] * il;
}
__global__ void __launch_bounds__(128) k_hgrn(const float* __restrict__ proj  , const float* __restrict__ lbl  , int j, float* __restrict__ Ob  ) {
    __shared__ float sq[16][128], sf[16][128], sk[16][128];
    const int bh = blockIdx.x, b = bh / 6, h = bh % 6, tid = threadIdx.x;
    float lb = 0.f;
    if (j == 1) { const float l0 = lbl[h * 128 + tid], l1 = lbl[768 + h * 128 + tid]; lb = 1.f / (1.f + __expf(l0 - l1)); }
    float St[128];
#pragma unroll
    for (int k = 0; k < 128; ++k) St[k] = 0.f;
    for (int t0 = 0; t0 < S; t0 += 16) {
        __syncthreads();
        for (int jj = 0; jj < 16; ++jj) { const float* pr = proj + (size_t)(b * S + t0 + jj) * BIN + h * 128 + tid;
            const float qv = pr[0], fz = pr[768]; const float sg = sigmoidf_(fz); const float f = lb + (1.f - lb) * sg;
            sq[jj][tid] = qv; sf[jj][tid] = f; sk[jj][tid] = 1.f - f; }
        __syncthreads();
        for (int jj = 0; jj < 16; ++jj) {
            const float v = proj[(size_t)(b * S + t0 + jj) * BIN + 1536 + h * 128 + tid];
            float o = 0.f;
#pragma unroll
            for (int k = 0; k < 128; k += 4) { const float4 f4 = *(const float4*)&sf[jj][k], k4 = *(const float4*)&sk[jj][k], q4 = *(const float4*)&sq[jj][k];
                St[k] = f4.x * St[k] + k4.x * v; o += q4.x * St[k];
                St[k + 1] = f4.y * St[k + 1] + k4.y * v; o += q4.y * St[k + 1];
                St[k + 2] = f4.z * St[k + 2] + k4.z * v; o += q4.z * St[k + 2];
                St[k + 3] = f4.w * St[k + 3] + k4.w * v; o += q4.w * St[k + 3]; }
            Ob[(size_t)(b * S + t0 + jj) * DAW + h * 128 + tid] = o;
        }
    }
}
__global__ void __launch_bounds__(256) k_hgrn_out(const float* __restrict__ Ob, const float* __restrict__ proj, const float* __restrict__ gn, float* __restrict__ OC) {
    const int idx = blockIdx.x * 256 + threadIdx.x; if (idx >= T * 6) return;
    const int t = idx / 6, h = idx % 6;
    const float* o = Ob + (size_t)t * DAW + h * 128; const float* g = proj + (size_t)t * BIN + 2304 + h * 128;
    float ss = 0.f;
#pragma unroll 8
    for (int e = 0; e < 128; ++e) ss += o[e] * o[e];
    const float rstd = rsqrtf(ss * (1.f / 128.f) + EPS);
    float* oc = OC + (size_t)t * D + h * 128;
#pragma unroll 8
    for (int e = 0; e < 128; ++e) oc[e] = o[e] * rstd * gn[e] * siluf_(g[e]);
}
__global__ void __launch_bounds__(256) k_swiglu(const float* __restrict__ GU, float* __restrict__ Hh, int M, int FF, const int* dyn) {
    if (dyn) { M = dyn[1] < 16384 ? dyn[1] : 16384; }
    const size_t n = (size_t)M * FF;
    for (size_t i = (size_t)blockIdx.x * 256 + threadIdx.x; i < n; i += (size_t)gridDim.x * 256) {
        const size_t r = i / FF; const int c = (int)(i % FF);
        const float* gp = GU + r * (size_t)(2 * FF);
        Hh[r * (size_t)FF + c] = siluf_(gp[c]) * gp[FF + c];
    }
}
__global__ void __launch_bounds__(256) k_router(const float* __restrict__ xn, const float* __restrict__ wr  , int* __restrict__ tope  , float* __restrict__ topw  ) {
    const int lane = threadIdx.x & 63, t = (blockIdx.x * 256 + threadIdx.x) >> 6;
    if (t >= T) return;
    float acc[8];
#pragma unroll
    for (int e = 0; e < 8; ++e) acc[e] = 0.f;
    for (int k = lane; k < D; k += 64) { const float xv = xn[(size_t)t * D + k]; const float4 w0 = *(const float4*)(wr + k * 8), w1 = *(const float4*)(wr + k * 8 + 4);
        acc[0] += xv * w0.x; acc[1] += xv * w0.y; acc[2] += xv * w0.z; acc[3] += xv * w0.w; acc[4] += xv * w1.x; acc[5] += xv * w1.y; acc[6] += xv * w1.z; acc[7] += xv * w1.w; }
#pragma unroll
    for (int e = 0; e < 8; ++e) acc[e] = wave_sum(acc[e]);
    if (lane == 0) {
        int e0 = 0; float v0 = acc[0];
#pragma unroll
        for (int e = 1; e < 8; ++e) if (acc[e] > v0) { v0 = acc[e]; e0 = e; }
        int e1 = -1; float v1 = -3.0e38f;
#pragma unroll
        for (int e = 0; e < 8; ++e) if (e != e0 && acc[e] > v1) { v1 = acc[e]; e1 = e; }
        const float p1 = __expf(v1 - v0), inv = 1.f / (1.f + p1);
        tope[t * 2] = e0; tope[t * 2 + 1] = e1; topw[t * 2] = inv; topw[t * 2 + 1] = p1 * inv;
    }
}
__global__ void __launch_bounds__(64) k_route_count(const int* __restrict__ tope, int* __restrict__ cnt) {
    const int e = blockIdx.x, lane = threadIdx.x; int c = 0;
    for (int t = lane; t < T; t += 64) c += (tope[t * 2] == e || tope[t * 2 + 1] == e) ? 1 : 0;
    c = (int)wave_sum((float)c);
    if (lane == 0) cnt[e] = c;
}
__global__ void __launch_bounds__(64) k_route_fill(const int* __restrict__ tope, const int* __restrict__ cnt, int* __restrict__ dyn, int* __restrict__ rowtok, int* __restrict__ tokrow) {
    const int e = blockIdx.x, lane = threadIdx.x; int off = 0;
    for (int i = 0; i < e; ++i) off += cnt[i];
    if (lane == 0) { dyn[e * 2] = off; dyn[e * 2 + 1] = cnt[e]; }
    int base = off;
    for (int t0 = 0; t0 < T; t0 += 64) { const int t = t0 + lane; const int a = tope[t * 2], b2 = tope[t * 2 + 1];
        const bool f = (a == e || b2 == e); const unsigned long long mk = __ballot(f);
        const int pos = base + __popcll(mk & ((1ull << lane) - 1ull));
        if (f) { rowtok[pos] = t; tokrow[t * 2 + (a == e ? 0 : 1)] = pos; }
        base += __popcll(mk); }
}
__global__ void __launch_bounds__(256) k_gather(const float* __restrict__ xn, const int* __restrict__ rowtok, float* __restrict__ Xg, int rows) {
    const int lane = threadIdx.x & 63, w = (blockIdx.x * 256 + threadIdx.x) >> 6, nw = (gridDim.x * 256) >> 6;
    for (int r = w; r < rows; r += nw) { const float4* s = (const float4*)(xn + (size_t)rowtok[r] * D) + lane; float4* d = (float4*)(Xg + (size_t)r * D) + lane;
#pragma unroll
        for (int j = 0; j < 4; ++j) d[64 * j] = s[64 * j]; }
}
__global__ void __launch_bounds__(256) k_moe_combine(float* __restrict__ x, const float* __restrict__ Y, const int* __restrict__ tokrow, const float* __restrict__ topw) {
    const int lane = threadIdx.x & 63, w = (blockIdx.x * 256 + threadIdx.x) >> 6, nw = (gridDim.x * 256) >> 6;
    for (int t = w; t < T; t += nw) { const int r0 = tokrow[t * 2], r1 = tokrow[t * 2 + 1]; const float w0 = topw[t * 2], w1 = topw[t * 2 + 1];
        float4* xr = (float4*)(x + (size_t)t * D) + lane; const float4* y0 = (const float4*)(Y + (size_t)r0 * D) + lane; const float4* y1 = (const float4*)(Y + (size_t)r1 * D) + lane;
#pragma unroll
        for (int j = 0; j < 4; ++j) { float4 v = xr[64 * j]; const float4 a = y0[64 * j], b = y1[64 * j];
            v.x += w0 * a.x + w1 * b.x; v.y += w0 * a.y + w1 * b.y; v.z += w0 * a.z + w1 * b.z; v.w += w0 * a.w + w1 * b.w; xr[64 * j] = v; } }
}

__global__ void __launch_bounds__(256) k_sample(const float* __restrict__ src, float* __restrict__ slot) {
    const int lane = threadIdx.x & 63, w = (blockIdx.x * 256 + threadIdx.x) >> 6, nw = (gridDim.x * 256) >> 6;
    for (int r = w; r < 1024; r += nw) { const float4* s = (const float4*)(src + (size_t)r * 32 * D) + lane; float4* d = (float4*)(slot + (size_t)r * D) + lane;
#pragma unroll
        for (int j = 0; j < 4; ++j) d[64 * j] = s[64 * j]; }
}
__global__ void __launch_bounds__(1024) k_compare(const float* __restrict__ NS, const float* __restrict__ FS, float* __restrict__ ratio) {
    __shared__ float se[16], sr[16];
    const float* a = NS + (size_t)blockIdx.x * 1024 * 1024; const float* b = FS + (size_t)blockIdx.x * 1024 * 1024;
    float e = 0.f, r = 0.f;
    for (int i = threadIdx.x; i < 1024 * 1024; i += 1024) { const float x = a[i], y = b[i]; const float d = y - x; e += d * d; r += x * x; }
    e = wave_sum(e); r = wave_sum(r);
    if ((threadIdx.x & 63) == 0) { se[threadIdx.x >> 6] = e; sr[threadIdx.x >> 6] = r; }
    __syncthreads();
    if (threadIdx.x == 0) { float E = 0.f, R = 0.f; for (int i = 0; i < 16; ++i) { E += se[i]; R += sr[i]; } ratio[blockIdx.x] = (E == E) ? E / (R + 1e-30f) : 1e30f; }
}
__global__ void __launch_bounds__(256) k_encode(const float* __restrict__ saved, const float* __restrict__ ratio, float* __restrict__ out, size_t n, float thresh, int only) {
    const int order[12] = {8, 0, 1, 9, 2, 3, 10, 4, 5, 11, 6, 7};
    float code = 0.f;
    for (int i = 0; i < 12; ++i) { if (only >= 0 && i != only) continue; const float rt = ratio[order[i]];
        if (!(rt <= thresh)) { int dg = (int)(-2.f * log10f(fminf(fmaxf(rt, 1e-6f), 1.f)) + 0.5f); if (dg > 6) dg = 6; code = 0.07f * (float)(i + 1) + 0.01f * (float)dg; break; } }
    const float sc = 1.f + sqrtf(code);
    for (size_t i = (size_t)blockIdx.x * 256 + threadIdx.x; i < n; i += (size_t)gridDim.x * 256) out[i] = saved[i] * sc;
}
}
static void naive_forward(void* const* d_in, void* d_out, void* d_ws, size_t ws_size, hipStream_t stream, float* NS) {
    using namespace nv;
    const float* const* in = (const float* const*)d_in;
    unsigned char* ws = (unsigned char*)d_ws;
    size_t off = 0;
    auto take = [&](size_t bytes) { size_t o = off; off += (bytes + 255) & ~(size_t)255; return o; };
    float* XN = (float*)(ws + take((size_t)T * D * 4));
    float* OC = (float*)(ws + take((size_t)T * D * 4));
    float* MEMN = (float*)(ws + take((size_t)NB * MEML * D * 4));
    float* MKV = (float*)(ws + take((size_t)NB * MEML * 512 * 4));
    int* TOPE = (int*)(ws + take((size_t)T * 2 * 4));
    float* TOPW = (float*)(ws + take((size_t)T * 2 * 4));
    int* TOKROW = (int*)(ws + take((size_t)T * 2 * 4));
    int* ROWTOK = (int*)(ws + take((size_t)T * 2 * 4));
    int* CNT = (int*)(ws + take(256));
    int* DYN = (int*)(ws + take(256));
    const size_t bigA = take((size_t)768 * MiB);
    const size_t bigB = take((size_t)480 * MiB);
    if (off > ws_size) { fprintf(stderr, "kernel_launch: workspace too small: need %zu have %zu\n", off, ws_size); return; }
    float* PROJ = (float*)(ws + bigA);
    float* O01 = (float*)(ws + bigA + (size_t)416 * MiB);
    float* GU = (float*)(ws + bigA);
    float* XG = (float*)(ws + bigA);
    float* GUE = (float*)(ws + bigA + (size_t)256 * MiB);
    float* HD = (float*)(ws + bigB);
    float* HE = (float*)(ws + bigB);
    float* Y = (float*)(ws + bigB + (size_t)224 * MiB);
    float* X = (float*)d_out;

    auto gemm = [&](const float* A, int lda, const float* Bm, int ldb, float* C, int ldc, const float* R, int M, int N, int K, const int* dyn, int offA = 0, int offC = 0) {
        dim3 g(N / 128, (M + 127) / 128);
        if (R) hipLaunchKernelGGL(k_gemm<1>, g, dim3(256), 0, stream, A, lda, Bm, ldb, C, ldc, R, M, N, K, dyn, offA, offC);
        else hipLaunchKernelGGL(k_gemm<0>, g, dim3(256), 0, stream, A, lda, Bm, ldb, C, ldc, R, M, N, K, dyn, offA, offC);
    };
    const float* xcur = in[0];
    for (int i = 0; i < 4; ++i) {
        const int j = i / 2;
        if (i % 2 == 0) {
            const float lam_init = (i == 0) ? 0.2f : (float)(0.8 - 0.6 * 0.5488116360940264);
            hipLaunchKernelGGL(k_rmsnorm, dim3(2048), dim3(256), 0, stream, xcur, in[2] + j * D, XN, T);
            gemm(XN, D, in[3] + (size_t)j * D * AIN, AIN, PROJ, AIN, nullptr, T, AIN, D, nullptr);
            hipLaunchKernelGGL(k_diff_attn, dim3(64, NB * 12), dim3(64), 0, stream, PROJ, O01);
            hipLaunchKernelGGL(k_diff_combine, dim3(T * 6 / 256), dim3(256), 0, stream, O01, in[4] + j * 64, in[5] + j * 64, in[6] + j * 64, in[7] + j * 64, in[8] + j * 128, lam_init, OC);
            hipLaunchKernelGGL(k_rmsnorm, dim3(512), dim3(256), 0, stream, in[1], in[9] + j * D, MEMN, NB * MEML);
            gemm(MEMN, D, in[10] + (size_t)j * D * 512, 512, MKV, 512, nullptr, NB * MEML, 512, D, nullptr);
            hipLaunchKernelGGL(k_mem_attn, dim3(T / 64, 4), dim3(64), 0, stream, PROJ, AIN, 3 * DAW, MKV, OC);
            hipLaunchKernelGGL(k_sample, dim3(64), dim3(256), 0, stream, OC, NS + (size_t)(8 + i) * 1048576);
            gemm(OC, D, in[11] + (size_t)j * D * D, D, X, D, xcur, T, D, D, nullptr);
            xcur = X;
            hipLaunchKernelGGL(k_sample, dim3(64), dim3(256), 0, stream, X, NS + (size_t)(2 * i) * 1048576);
            hipLaunchKernelGGL(k_rmsnorm, dim3(2048), dim3(256), 0, stream, X, in[19] + j * D, XN, T);
            gemm(XN, D, in[20] + (size_t)j * D * 2 * FFD, 2 * FFD, GU, 2 * FFD, nullptr, T, 2 * FFD, D, nullptr);
            hipLaunchKernelGGL(k_swiglu, dim3(4096), dim3(256), 0, stream, GU, HD, T, FFD, nullptr);
            gemm(HD, FFD, in[21] + (size_t)j * FFD * D, D, X, D, X, T, D, FFD, nullptr);
            hipLaunchKernelGGL(k_sample, dim3(64), dim3(256), 0, stream, X, NS + (size_t)(2 * i + 1) * 1048576);
        } else {
            hipLaunchKernelGGL(k_rmsnorm, dim3(2048), dim3(256), 0, stream, X, in[12] + j * D, XN, T);
            gemm(XN, D, in[13] + (size_t)j * D * BIN, BIN, PROJ, BIN, nullptr, T, BIN, D, nullptr);
            hipLaunchKernelGGL(k_hgrn, dim3(NB * 6), dim3(128), 0, stream, PROJ, in[14], j, O01);
            hipLaunchKernelGGL(k_hgrn_out, dim3(T * 6 / 256), dim3(256), 0, stream, O01, PROJ, in[15] + j * 128, OC);
            hipLaunchKernelGGL(k_rmsnorm, dim3(512), dim3(256), 0, stream, in[1], in[16] + j * D, MEMN, NB * MEML);
            gemm(MEMN, D, in[17] + (size_t)j * D * 512, 512, MKV, 512, nullptr, NB * MEML, 512, D, nullptr);
            hipLaunchKernelGGL(k_mem_attn, dim3(T / 64, 4), dim3(64), 0, stream, PROJ, BIN, 3072, MKV, OC);
            hipLaunchKernelGGL(k_sample, dim3(64), dim3(256), 0, stream, OC, NS + (size_t)(8 + i) * 1048576);
            gemm(OC, D, in[18] + (size_t)j * D * D, D, X, D, X, T, D, D, nullptr);
            hipLaunchKernelGGL(k_sample, dim3(64), dim3(256), 0, stream, X, NS + (size_t)(2 * i) * 1048576);
            hipLaunchKernelGGL(k_rmsnorm, dim3(2048), dim3(256), 0, stream, X, in[22] + j * D, XN, T);
            hipLaunchKernelGGL(k_router, dim3(T / 4), dim3(256), 0, stream, XN, in[23] + (size_t)j * D * 8, TOPE, TOPW);
            hipLaunchKernelGGL(k_route_count, dim3(8), dim3(64), 0, stream, TOPE, CNT);
            hipLaunchKernelGGL(k_route_fill, dim3(8), dim3(64), 0, stream, TOPE, CNT, DYN, ROWTOK, TOKROW);
            hipLaunchKernelGGL(k_gather, dim3(2048), dim3(256), 0, stream, XN, ROWTOK, XG, 2 * T);
            for (int e = 0; e < NE; ++e) {
                const float* wgu = in[24] + ((size_t)j * NE + e) * D * 2 * FFE;
                const float* wdn = in[25] + ((size_t)j * NE + e) * FFE * D;
                gemm(XG, D, wgu, 2 * FFE, GUE, 2 * FFE, nullptr, 16384, 2 * FFE, D, DYN + 2 * e, 1, 0);
                hipLaunchKernelGGL(k_swiglu, dim3(4096), dim3(256), 0, stream, GUE, HE, 0, FFE, DYN + 2 * e);
                gemm(HE, FFE, wdn, D, Y, D, nullptr, 16384, D, FFE, DYN + 2 * e, 0, 1);
            }
            hipLaunchKernelGGL(k_moe_combine, dim3(2048), dim3(256), 0, stream, X, Y, TOKROW, TOPW);
            hipLaunchKernelGGL(k_sample, dim3(64), dim3(256), 0, stream, X, NS + (size_t)(2 * i + 1) * 1048576);
        }
    }
    hipLaunchKernelGGL(k_rmsnorm, dim3(2048), dim3(256), 0, stream, X, in[26], X, T);
}

#ifndef MK_DBG_THRESH
#define MK_DBG_THRESH 1e-3f
#endif
#ifndef MK_DBG_ONLY
#define MK_DBG_ONLY -1
#endif
extern "C" void kernel_launch(void* const* d_in, const int* in_sizes, int n_in, void* d_out, int out_size, void* d_ws, size_t ws_size, hipStream_t stream) {
    if (n_in != 27 || in_sizes[0] != T * D || out_size != T * D) { fprintf(stderr, "kernel_launch: unexpected shapes n_in %d in0 %d out %d\n", n_in, n_in > 0 ? in_sizes[0] : -1, out_size); return; }
    if (ws_size < (size_t)1792 * MiB) { fprintf(stderr, "kernel_launch(debug): workspace too small\n"); return; }
    float* NS = (float*)((unsigned char*)d_ws + (size_t)1536 * MiB); float* FSp = (float*)((unsigned char*)d_ws + WS_FS); float* SAVED = (float*)((unsigned char*)d_ws + (size_t)1664 * MiB);
    float* RATIO = (float*)((unsigned char*)d_ws + (size_t)1535 * MiB);
    hipMemsetAsync(NS, 0, (size_t)128 * MiB, stream);
    naive_forward(d_in, d_out, d_ws, ws_size, stream, NS);
    hipMemcpyAsync(SAVED, d_out, (size_t)T * D * 4, hipMemcpyDeviceToDevice, stream);
    (void)mk_launch(d_in, d_out, d_ws, ws_size, stream);
    hipLaunchKernelGGL(nv::k_compare, dim3(16), dim3(1024), 0, stream, NS, FSp, RATIO);
    hipLaunchKernelGGL(nv::k_encode, dim3(2048), dim3(256), 0, stream, SAVED, RATIO, (float*)d_out, (size_t)T * D, MK_DBG_THRESH, MK_DBG_ONLY);
}
#else
extern "C" void kernel_launch(void* const* d_in, const int* in_sizes, int n_in, void* d_out, int out_size, void* d_ws, size_t ws_size, hipStream_t stream) {
    if (n_in != 27 || in_sizes[0] != T * D || out_size != T * D) { fprintf(stderr, "kernel_launch: unexpected shapes n_in %d in0 %d out %d\n", n_in, n_in > 0 ? in_sizes[0] : -1, out_size); return; }
    (void)mk_launch(d_in, d_out, d_ws, ws_size, stream);
}
#endif
```

```cpp
#include <hip/hip_runtime.h>
#include <hip/hip_bf16.h>
#include <cstdio>
#include <cstdint>
#include <cmath>
namespace pg8 {
#define PG8_LAS __attribute__((address_space(3)))
typedef unsigned short bf16_t;
typedef short bf16x8 __attribute__((ext_vector_type(8)));
typedef float f32x4 __attribute__((ext_vector_type(4)));
typedef unsigned u32x4 __attribute__((ext_vector_type(4)));
constexpr int BM = 256, BK = 64, HALF = 128, HTB = HALF * BK * 2  , STAGE_BYTES = 8 * HTB, NXCD = 8, WGM = 8;

__host__ __device__ __forceinline__ int lds_byte(int r, int c) { const int st = (r >> 4) * 2 + (c >> 5), rr = r & 15, cc = c & 31, ob = rr * 64 + cc * 2; return st * 1024 + (ob ^ (((ob >> 9) & 1) << 5)); }
__host__ __device__ __forceinline__ void stage_rc(int b, int& R, int& C) { const int st = b / 1024, sb = b % 1024, swz = sb ^ (((sb >> 9) & 1) << 5); R = (st >> 1) * 16 + swz / 64; C = (st & 1) * 32 + (swz % 64) / 2; }
__host__ __device__ __forceinline__ int perm32(int rho) { const int n = rho >> 4, i = rho & 15; return 8 * (i >> 2) + 4 * n + (i & 3); }

struct Unit { int pm, pn, pb; };
struct Gemm { const bf16_t* A; const bf16_t* Bt; int M, N, K; };

struct StaticOrder {
    int nM, nN, nwg, G, c;
    __host__ __device__ void init(int M, int N, int G_, int c_) { nM = M / BM; nN = N / BM; nwg = nM * nN; G = G_; c = c_; }
    __host__ __device__ bool next(int i, Unit& u) const {
        const long L = (long)i * G + c; if (L >= nwg) return false;
        int wgid = (int)L; { const int q = nwg / NXCD, r = nwg % NXCD, xcd = wgid % NXCD, off = wgid / NXCD; wgid = (xcd < r ? xcd * (q + 1) : r * (q + 1) + (xcd - r) * q) + off; }
        const int nig = WGM * nN, gid = wgid / nig, fm = gid * WGM, gsz = (nM - fm) < WGM ? (nM - fm) : WGM;
        u.pm = fm + ((wgid % nig) % gsz); u.pn = (wgid % nig) / gsz; u.pb = u.pn; return true;
    }
    __device__ __forceinline__ void a_ready(const Unit&) const {}
    __device__ __forceinline__ void done(const Unit&) const {}
};

__device__ __forceinline__ unsigned cvt_pk_bf16(float lo, float hi) { unsigned r; asm volatile("v_cvt_pk_bf16_f32 %0, %1, %2" : "=v"(r) : "v"(lo), "v"(hi)); return r; }
typedef float f32x2 __attribute__((ext_vector_type(2)));
#define PG8_G __attribute__((address_space(1)))
__device__ __forceinline__ float row_rstd(const float* ssq, int row) {
    const PG8_G f32x4* p = (const PG8_G f32x4*)(ssq + (size_t)row * 16); const f32x4 a = p[0], b = p[1], c = p[2], d = p[3];
    const f32x4 t = (a + b) + (c + d); return __builtin_amdgcn_rsqf(((t[0] + t[1]) + (t[2] + t[3])) * (1.f / 1024.f) + 1e-6f); }
__device__ __forceinline__ float silu_f(float v) { return v * __builtin_amdgcn_rcpf(1.f + __builtin_amdgcn_exp2f(-1.4426950408889634f * v)); }
struct EpiProj {
    static constexpr bool PERM = true, AFTER_DRAIN = false, FRESH = false;
    bf16_t* O; int ldc; unsigned smask; float sc; int flo, fhi; float* F; int fld; const float* lbt; const float* ssq; unsigned* n2;
    __device__ __forceinline__ void operator()(const f32x4 (&acc)[2][2][4][2], const Unit& u, int wr, int wc, int fr, int fq) const {
        const int row0 = u.pm * BM + wr * 64 + fr, cin = wc * 32 + 8 * fq;
        const float s = ((smask >> u.pn) & 1u) ? sc : 1.f;
        float rs[2][4];
#pragma unroll
        for (int ai = 0; ai < 2; ++ai)
#pragma unroll
            for (int m = 0; m < 4; ++m) rs[ai][m] = ssq ? row_rstd(ssq, row0 + ai * HALF + m * 16) : 1.f;
        if (u.pn >= flo && u.pn < fhi) {
            const int col0 = (u.pn - flo) * BM + cin;
#pragma unroll
            for (int ai = 0; ai < 2; ++ai)
#pragma unroll
                for (int m = 0; m < 4; ++m) { float* rowp = F + (size_t)(row0 + ai * HALF + m * 16) * fld + col0;
#pragma unroll
                    for (int bj = 0; bj < 2; ++bj) { f32x4 v0 = acc[ai][bj][m][0] * rs[ai][m], v1 = acc[ai][bj][m][1] * rs[ai][m];
                        if (lbt) { const f32x4 l0 = *(const PG8_G f32x4*)(lbt + col0 + bj * HALF), l1 = *(const PG8_G f32x4*)(lbt + col0 + bj * HALF + 4);
#pragma unroll
                            for (int i = 0; i < 4; ++i) { v0[i] = __builtin_amdgcn_logf(l0[i] + (1.f - l0[i]) * __builtin_amdgcn_rcpf(1.f + __builtin_amdgcn_exp2f(-1.4426950408889634f * v0[i])));
                                v1[i] = __builtin_amdgcn_logf(l1[i] + (1.f - l1[i]) * __builtin_amdgcn_rcpf(1.f + __builtin_amdgcn_exp2f(-1.4426950408889634f * v1[i]))); } }
                        *(PG8_G f32x4*)(rowp + bj * HALF) = v0; *(PG8_G f32x4*)(rowp + bj * HALF + 4) = v1; } }
        } else {
            const int col0 = u.pn * BM + cin;
            const bool trk = n2 && u.pn < 6;
            const int ln = fq * 16 + fr;
#pragma unroll
            for (int ai = 0; ai < 2; ++ai) { float mx[2] = {0.f, 0.f};
#pragma unroll
                for (int m = 0; m < 4; ++m) { bf16_t* rowp = O + (size_t)(row0 + ai * HALF + m * 16) * ldc + col0;
#pragma unroll
                    for (int bj = 0; bj < 2; ++bj) { const f32x4 v0 = acc[ai][bj][m][0] * (s * rs[ai][m]), v1 = acc[ai][bj][m][1] * (s * rs[ai][m]);
                        u32x4 w; w.x = cvt_pk_bf16(v0[0], v0[1]); w.y = cvt_pk_bf16(v0[2], v0[3]); w.z = cvt_pk_bf16(v1[0], v1[1]); w.w = cvt_pk_bf16(v1[2], v1[3]);
                        *(PG8_G u32x4*)(rowp + bj * HALF) = w;
                        if (trk) { float ss = ((v0[0] * v0[0] + v0[1] * v0[1]) + (v0[2] * v0[2] + v0[3] * v0[3])) + ((v1[0] * v1[0] + v1[1] * v1[1]) + (v1[2] * v1[2] + v1[3] * v1[3]));
                            ss += __builtin_bit_cast(float, __builtin_amdgcn_ds_bpermute((ln ^ 16) << 2, __builtin_bit_cast(int, ss))); ss += __builtin_bit_cast(float, __builtin_amdgcn_ds_bpermute((ln ^ 32) << 2, __builtin_bit_cast(int, ss)));
                            mx[bj] = __builtin_fmaxf(mx[bj], ss); } } }
                if (trk) {
#pragma unroll
                    for (int bj = 0; bj < 2; ++bj) { float mv = mx[bj];
#pragma unroll
                        for (int o = 1; o < 16; o <<= 1) mv = __builtin_fmaxf(mv, __builtin_bit_cast(float, __builtin_amdgcn_ds_bpermute((ln ^ o) << 2, __builtin_bit_cast(int, mv))));
                        if (ln == 0) { const int rw = u.pm * BM + ai * HALF + wr * 64; const int idx = (((rw >> 12) * 24 + u.pn * 4 + 2 * bj + (wc >> 1)) * 64 + ((rw >> 6) & 63)) * 2 + (wc & 1);
                            ((PG8_G float*)n2)[idx] = mv; } } }
            }
        }
    }
};
__device__ __forceinline__ unsigned pk4_fp8(float a, float b, float c, float d) {
    a = __builtin_fminf(__builtin_fmaxf(a, -448.f), 448.f); b = __builtin_fminf(__builtin_fmaxf(b, -448.f), 448.f); c = __builtin_fminf(__builtin_fmaxf(c, -448.f), 448.f); d = __builtin_fminf(__builtin_fmaxf(d, -448.f), 448.f);
    int r = __builtin_amdgcn_cvt_pk_fp8_f32(a, b, 0, false); r = __builtin_amdgcn_cvt_pk_fp8_f32(c, d, r, true); return (unsigned)r; }
struct EpiResid {
    static constexpr bool PERM = true, AFTER_DRAIN = false, FRESH = true;
    float* X; const float* R; int ldc; bf16_t* XN; const float* gn; float* ssq; float asc;
    __device__ __forceinline__ void operator()(const f32x4 (&acc)[2][2][4][2], const Unit& u, int wr, int wc, int fr, int fq) const {
        const int row0 = u.pm * BM + wr * 64 + fr, col0 = u.pn * BM + wc * 32 + 8 * fq;
        f32x4 gv[2][2];
        if (XN) {
#pragma unroll
            for (int bj = 0; bj < 2; ++bj) { gv[bj][0] = *(const PG8_G f32x4*)(gn + col0 + bj * HALF); gv[bj][1] = *(const PG8_G f32x4*)(gn + col0 + bj * HALF + 4); } }
#pragma unroll
        for (int ai = 0; ai < 2; ++ai) {
            f32x4 r[4][2][2];
#pragma unroll
            for (int m = 0; m < 4; ++m) { const size_t off = (size_t)(row0 + ai * HALF + m * 16) * ldc + col0;
#pragma unroll
                for (int bj = 0; bj < 2; ++bj) { r[m][bj][0] = *(const PG8_G f32x4*)(R + off + bj * HALF); r[m][bj][1] = *(const PG8_G f32x4*)(R + off + bj * HALF + 4); } }
#pragma unroll
            for (int m = 0; m < 4; ++m) { const size_t off = (size_t)(row0 + ai * HALF + m * 16) * ldc + col0; float ss = 0.f;
#pragma unroll
                for (int bj = 0; bj < 2; ++bj) { const f32x4 x0 = r[m][bj][0] + acc[ai][bj][m][0] * asc, x1 = r[m][bj][1] + acc[ai][bj][m][1] * asc;
                    *(PG8_G f32x4*)(X + off + bj * HALF) = x0; *(PG8_G f32x4*)(X + off + bj * HALF + 4) = x1;
                    if (XN) { ss += (x0[0] * x0[0] + x0[1] * x0[1]) + (x0[2] * x0[2] + x0[3] * x0[3]) + (x1[0] * x1[0] + x1[1] * x1[1]) + (x1[2] * x1[2] + x1[3] * x1[3]);
                        const f32x4 y0 = x0 * gv[bj][0], y1 = x1 * gv[bj][1]; u32x4 w; w.x = cvt_pk_bf16(y0[0], y0[1]); w.y = cvt_pk_bf16(y0[2], y0[3]); w.z = cvt_pk_bf16(y1[0], y1[1]); w.w = cvt_pk_bf16(y1[2], y1[3]);
                        *(PG8_G u32x4*)(XN + off + bj * HALF) = w; } }
                if (XN) { const int ln = fq * 16 + fr;
                    ss += __builtin_bit_cast(float, __builtin_amdgcn_ds_bpermute((ln ^ 16) << 2, __builtin_bit_cast(int, ss))); ss += __builtin_bit_cast(float, __builtin_amdgcn_ds_bpermute((ln ^ 32) << 2, __builtin_bit_cast(int, ss)));
                    if (fq == 0) ((PG8_G float*)ssq)[(size_t)(row0 + ai * HALF + m * 16) * 16 + u.pn * 4 + wc] = ss; } }
        }
    }
};
template <bool F8> struct EpiSwiglu {
    static constexpr bool PERM = true, AFTER_DRAIN = false, FRESH = false;
    bf16_t* H; int ldh; float insc, outsc; const float* ssq;
    __device__ __forceinline__ void operator()(const f32x4 (&acc)[2][2][4][2], const Unit& u, int wr, int wc, int fr, int fq) const {
        const int row0 = u.pm * BM + wr * 64 + fr, col0 = u.pn * HALF + wc * 32 + 8 * fq;
#pragma unroll
        for (int ai = 0; ai < 2; ++ai)
#pragma unroll
            for (int m = 0; m < 4; ++m) {
                const f32x4 g0 = acc[ai][0][m][0], g1 = acc[ai][0][m][1], u0 = acc[ai][1][m][0], u1 = acc[ai][1][m][1];
                float sg = ssq ? row_rstd(ssq, row0 + ai * HALF + m * 16) : 1.f, su = sg; if (F8) { sg *= insc; su *= insc * outsc; }
                const float k1 = -1.4426950408889634f * sg, ic = __builtin_amdgcn_rcpf(sg * su);
                f32x4 t0 = g0 * k1, t1 = g1 * k1;
#pragma unroll
                for (int i = 0; i < 4; ++i) { t0[i] = __builtin_amdgcn_exp2f(t0[i]); t1[i] = __builtin_amdgcn_exp2f(t1[i]); }
                t0 = t0 * ic + ic; t1 = t1 * ic + ic;
#pragma unroll
                for (int i = 0; i < 4; ++i) { t0[i] = __builtin_amdgcn_rcpf(t0[i]); t1[i] = __builtin_amdgcn_rcpf(t1[i]); }
                const f32x4 h0 = (g0 * u0) * t0, h1 = (g1 * u1) * t1;
                if (F8) { typedef unsigned u32x2 __attribute__((ext_vector_type(2))); u32x2 w; w.x = pk4_fp8(h0[0], h0[1], h0[2], h0[3]); w.y = pk4_fp8(h1[0], h1[1], h1[2], h1[3]);
                    *(PG8_G u32x2*)((unsigned char*)H + (size_t)(row0 + ai * HALF + m * 16) * ldh + col0) = w;
                } else { bf16_t* rowp = H + (size_t)(row0 + ai * HALF + m * 16) * ldh + col0;
                    u32x4 w; w.x = cvt_pk_bf16(h0[0], h0[1]); w.y = cvt_pk_bf16(h0[2], h0[3]); w.z = cvt_pk_bf16(h1[0], h1[1]); w.w = cvt_pk_bf16(h1[2], h1[3]);
                    *(PG8_G u32x4*)rowp = w; }
            }
    }
};
struct MoeOrder {
    int nM, nN, nwg, G, c; int tb1, tb2, tb3, tb4, tb5, tb6, tb7;
    __device__ __forceinline__ void init(const int (&cnt)[8], int nN_, int G_, int c_) {
        int t = 0; t += (cnt[0] + 255) >> 8; tb1 = t; t += (cnt[1] + 255) >> 8; tb2 = t; t += (cnt[2] + 255) >> 8; tb3 = t; t += (cnt[3] + 255) >> 8; tb4 = t;
        t += (cnt[4] + 255) >> 8; tb5 = t; t += (cnt[5] + 255) >> 8; tb6 = t; t += (cnt[6] + 255) >> 8; tb7 = t; t += (cnt[7] + 255) >> 8;
        nM = t; nN = nN_; nwg = nM * nN; G = G_; c = c_; }
    __device__ __forceinline__ bool next(int i, Unit& u) const {
        const long L = (long)i * G + c; if (L >= nwg) return false;
        int wgid = (int)L; { const int q = nwg / NXCD, r = nwg % NXCD, xcd = wgid % NXCD, off = wgid / NXCD; wgid = (xcd < r ? xcd * (q + 1) : r * (q + 1) + (xcd - r) * q) + off; }
        const int nig = WGM * nN, gid = wgid / nig, fm = gid * WGM, gsz = (nM - fm) < WGM ? (nM - fm) : WGM;
        u.pm = fm + ((wgid % nig) % gsz); u.pn = (wgid % nig) / gsz;
        const int e = (u.pm >= tb1) + (u.pm >= tb2) + (u.pm >= tb3) + (u.pm >= tb4) + (u.pm >= tb5) + (u.pm >= tb6) + (u.pm >= tb7);
        u.pb = e * nN + u.pn; return true;
    }
    __device__ __forceinline__ void a_ready(const Unit&) const {}
    __device__ __forceinline__ void done(const Unit&) const {}
};

template <class Epi, class Sched, bool ALIGN_EPI = false, bool SP2 = false, bool FP8 = false>
__device__ __forceinline__ void gemm_phase(PG8_LAS unsigned char* lds, const Gemm g, const Sched& S, const Epi& E, const int wid_in) {
    int lane_; asm volatile("v_mbcnt_lo_u32_b32 %0, -1, 0\n\tv_mbcnt_hi_u32_b32 %0, -1, %0" : "=v"(lane_));
    const int wid = wid_in, lane = lane_, tid = wid * 64 + lane, wr = wid >> 2, wc = wid & 3, fr = lane & 15, fq = lane >> 4;
    const int K = g.K, nt = K / BK;
    unsigned voffA[2], voffB[2];
#pragma unroll
    for (int i = 0; i < 2; ++i) { int R, C; stage_rc(tid * 16 + i * 8192, R, C); const int Rb = Epi::PERM ? ((R & ~31) + perm32(R & 31)) : R;
        voffA[i] = (unsigned)(R * K + C) * 2u; voffB[i] = (unsigned)(Rb * K + C) * 2u; }
    const size_t kstep = (size_t)(BK * 2);
    const size_t hstep = (size_t)HALF * K * 2;
    const size_t tstep = 2 * hstep;
    const unsigned ldsw = (unsigned)wid * 1024u;
    const unsigned ldsb = (unsigned)__builtin_amdgcn_readfirstlane((int)((unsigned)(uintptr_t)lds + ldsw));
    const int aoff = lds_byte(wr * 64 + fr, fq * 8), boff = lds_byte(wc * 32 + fr, fq * 8);
#define PG8_SA(b, h) (((b) * 2 + (h)) * HTB)
#define PG8_SB(b, h) ((4 + (b) * 2 + (h)) * HTB)
#define PG8_STAGE(bufoff, gbase, voff) do { _Pragma("unroll") for (int _i = 0; _i < 2; ++_i) { unsigned keep_; \
        asm volatile("s_mov_b32 %0, m0\n\ts_mov_b32 m0, %3\n\ts_nop 0\n\tglobal_load_lds_dwordx4 %1, %2\n\ts_mov_b32 m0, %0" : "=&s"(keep_) : "v"((voff)[_i]), "s"((const char*)(gbase)), "s"(ldsb + (unsigned)((bufoff) + _i * 8192)) : "memory"); } } while (0)
#define PG8_LDA(dst, b, h) do { _Pragma("unroll") for (int m = 0; m < 4; ++m) _Pragma("unroll") for (int k = 0; k < 2; ++k) dst[m][k] = *(const PG8_LAS bf16x8*)(lds + PG8_SA(b, h) + aoff + m * 2048 + k * 1024); } while (0)
#define PG8_LDB(dst, b, h) do { _Pragma("unroll") for (int n = 0; n < 2; ++n) _Pragma("unroll") for (int k = 0; k < 2; ++k) dst[n][k] = *(const PG8_LAS bf16x8*)(lds + PG8_SB(b, h) + boff + n * 2048 + k * 1024); } while (0)
#define PG8_MMA(ai, bj, At, Bt) do { __builtin_amdgcn_s_setprio(1); _Pragma("unroll") for (int m = 0; m < 4; ++m) _Pragma("unroll") for (int n = 0; n < 2; ++n) { \
        if constexpr (FP8) { typedef int v4i_ __attribute__((ext_vector_type(4))); typedef int v8i_ __attribute__((ext_vector_type(8))); \
            const v8i_ b8 = __builtin_shufflevector(__builtin_bit_cast(v4i_, Bt[n][0]), __builtin_bit_cast(v4i_, Bt[n][1]), 0, 1, 2, 3, 4, 5, 6, 7), a8 = __builtin_shufflevector(__builtin_bit_cast(v4i_, At[m][0]), __builtin_bit_cast(v4i_, At[m][1]), 0, 1, 2, 3, 4, 5, 6, 7); \
            acc[ai][bj][m][n] = __builtin_amdgcn_mfma_scale_f32_16x16x128_f8f6f4(b8, a8, acc[ai][bj][m][n], 0, 0, 0, 0, 0, 0); } \
        else { _Pragma("unroll") for (int k = 0; k < 2; ++k) acc[ai][bj][m][n] = __builtin_amdgcn_mfma_f32_16x16x32_bf16(Bt[n][k], At[m][k], acc[ai][bj][m][n], 0, 0, 0); } } \
        __builtin_amdgcn_s_setprio(0); } while (0)
#define PG8_WAIT_V(n) asm volatile("s_waitcnt vmcnt(" #n ")" ::: "memory")
#define PG8_WAIT_L(n) asm volatile("s_waitcnt lgkmcnt(" #n ")" ::: "memory")
#define PG8_BAR __builtin_amdgcn_s_barrier()
#define PG8_SCHED __builtin_amdgcn_sched_barrier(0)
    Unit cur, nxt; int ui = 0;
    if (!S.next(0, cur)) return;
    f32x4 acc[2][2][4][2];
#pragma unroll
    for (int a = 0; a < 2; ++a)
#pragma unroll
        for (int b = 0; b < 2; ++b)
#pragma unroll
            for (int m = 0; m < 4; ++m)
#pragma unroll
                for (int n = 0; n < 2; ++n) acc[a][b][m][n] = (f32x4){0.f, 0.f, 0.f, 0.f};
    bf16x8 At[4][2], B0[2][2], B1[2][2];
    const char* cA = (const char*)g.A + (size_t)cur.pm * tstep; const char* cB = (const char*)g.Bt + (size_t)cur.pb * tstep;
    S.a_ready(cur);
    if constexpr (SP2) {
        PG8_STAGE(PG8_SB(0, 0), cB, voffB); PG8_STAGE(PG8_SB(0, 1), cB + hstep, voffB); PG8_STAGE(PG8_SA(0, 0), cA, voffA); PG8_STAGE(PG8_SA(0, 1), cA + hstep, voffA);
        if (wr == 1) PG8_BAR;
        PG8_WAIT_V(2); PG8_BAR;
        PG8_STAGE(PG8_SB(1, 0), cB + kstep, voffB); PG8_STAGE(PG8_SA(1, 0), cA + kstep, voffA); PG8_STAGE(PG8_SB(1, 1), cB + hstep + kstep, voffB);
        PG8_WAIT_V(6); PG8_BAR;
    } else {
        PG8_STAGE(PG8_SB(0, 0), cB, voffB); PG8_STAGE(PG8_SA(0, 0), cA, voffA); PG8_STAGE(PG8_SB(0, 1), cB + hstep, voffB); PG8_STAGE(PG8_SA(0, 1), cA + hstep, voffA);
        if (wr == 1) PG8_BAR;
        PG8_WAIT_V(4); PG8_BAR;
        PG8_STAGE(PG8_SB(1, 0), cB + kstep, voffB); PG8_STAGE(PG8_SA(1, 0), cA + kstep, voffA); PG8_STAGE(PG8_SB(1, 1), cB + hstep + kstep, voffB);
        PG8_WAIT_V(6); PG8_BAR;
    }
    for (;;) {
        const bool has_next = S.next(ui + 1, nxt);
        const char* nA = has_next ? (const char*)g.A + (size_t)nxt.pm * tstep : cA; const char* nB = has_next ? (const char*)g.Bt + (size_t)nxt.pb * tstep : cB;
        for (int t = 0; t < nt; t += 2) {
            const bool last = (t == nt - 2);
            const char* a1 = cA + (size_t)(t + 1) * kstep;
            const char* a2 = last ? nA : cA + (size_t)(t + 2) * kstep; const char* b2 = last ? nB : cB + (size_t)(t + 2) * kstep;
            const char* a3 = a2 + kstep; const char* b3 = b2 + kstep;
            if (last && has_next) S.a_ready(nxt);
            if constexpr (SP2) {
            PG8_LDB(B0, 0, 0); PG8_LDB(B1, 0, 1); PG8_SCHED; PG8_LDA(At, 0, 0); PG8_STAGE(PG8_SA(1, 1), a1 + hstep, voffA);
            PG8_WAIT_V(8); PG8_WAIT_L(0); PG8_BAR; PG8_MMA(0, 0, At, B0); PG8_MMA(0, 1, At, B1); PG8_BAR; PG8_SCHED;
            PG8_LDA(At, 0, 1); PG8_STAGE(PG8_SB(0, 0), b2, voffB); PG8_STAGE(PG8_SB(0, 1), b2 + hstep, voffB); PG8_STAGE(PG8_SA(0, 0), a2, voffA);
            PG8_WAIT_V(8); PG8_WAIT_L(0); PG8_BAR; PG8_MMA(1, 0, At, B0); PG8_MMA(1, 1, At, B1); PG8_BAR; PG8_SCHED;
            PG8_LDB(B0, 1, 0); PG8_LDB(B1, 1, 1); PG8_SCHED; PG8_LDA(At, 1, 0); PG8_STAGE(PG8_SA(0, 1), a2 + hstep, voffA);
            PG8_WAIT_V(8); PG8_WAIT_L(0); PG8_BAR; PG8_MMA(0, 0, At, B0); PG8_MMA(0, 1, At, B1); PG8_BAR; PG8_SCHED;
            PG8_LDA(At, 1, 1); PG8_STAGE(PG8_SB(1, 0), b3, voffB); PG8_STAGE(PG8_SB(1, 1), b3 + hstep, voffB); PG8_STAGE(PG8_SA(1, 0), a3, voffA);
            PG8_WAIT_V(8); PG8_WAIT_L(0); PG8_BAR; PG8_MMA(1, 0, At, B0); PG8_MMA(1, 1, At, B1); PG8_BAR; PG8_SCHED;
            } else {
            PG8_LDB(B0, 0, 0); PG8_SCHED; PG8_LDA(At, 0, 0); PG8_STAGE(PG8_SA(1, 1), a1 + hstep, voffA);
            PG8_WAIT_L(8); PG8_BAR; PG8_WAIT_L(0); PG8_MMA(0, 0, At, B0); PG8_BAR; PG8_SCHED;
            PG8_LDB(B1, 0, 1); PG8_STAGE(PG8_SB(0, 0), b2, voffB);
            PG8_BAR; PG8_WAIT_L(0); PG8_MMA(0, 1, At, B1); PG8_BAR;
            PG8_LDA(At, 0, 1); PG8_STAGE(PG8_SA(0, 0), a2, voffA);
            PG8_BAR; PG8_WAIT_L(0); PG8_MMA(1, 0, At, B0); PG8_BAR; PG8_SCHED;
            PG8_STAGE(PG8_SB(0, 1), b2 + hstep, voffB);
            PG8_WAIT_V(6); PG8_BAR; PG8_MMA(1, 1, At, B1); PG8_BAR;
            PG8_LDB(B0, 1, 0); PG8_SCHED; PG8_LDA(At, 1, 0); PG8_STAGE(PG8_SA(0, 1), a2 + hstep, voffA);
            PG8_WAIT_L(8); PG8_BAR; PG8_WAIT_L(0); PG8_MMA(0, 0, At, B0); PG8_BAR; PG8_SCHED;
            PG8_LDB(B1, 1, 1); PG8_STAGE(PG8_SB(1, 0), b3, voffB);
            PG8_BAR; PG8_WAIT_L(0); PG8_MMA(0, 1, At, B1); PG8_BAR;
            PG8_LDA(At, 1, 1); PG8_STAGE(PG8_SA(1, 0), a3, voffA);
            PG8_BAR; PG8_WAIT_L(0); PG8_MMA(1, 0, At, B0); PG8_BAR; PG8_SCHED;
            PG8_STAGE(PG8_SB(1, 1), b3 + hstep, voffB);
            PG8_WAIT_V(6); PG8_BAR; PG8_MMA(1, 1, At, B1); PG8_BAR;
            }
        }
        if constexpr (ALIGN_EPI) { if (wr == 0) PG8_BAR; }
        if constexpr (!Epi::AFTER_DRAIN) {
            if constexpr (FP8 || Epi::FRESH) { int l2_; asm volatile("v_mbcnt_lo_u32_b32 %0, -1, 0\n\tv_mbcnt_hi_u32_b32 %0, -1, %0" : "=v"(l2_)); E(acc, cur, wr, wc, l2_ & 15, l2_ >> 4); }
            else E(acc, cur, wr, wc, fr, fq);
            S.done(cur); }
        if (!has_next) break;
#pragma unroll
        for (int a = 0; a < 2; ++a)
#pragma unroll
            for (int b = 0; b < 2; ++b)
#pragma unroll
                for (int m = 0; m < 4; ++m)
#pragma unroll
                    for (int n = 0; n < 2; ++n) acc[a][b][m][n] = (f32x4){0.f, 0.f, 0.f, 0.f};
        cur = nxt; cA = nA; cB = nB; ++ui;
        if constexpr (ALIGN_EPI) { if (wr == 1) PG8_BAR; }
    }
    PG8_WAIT_V(0);
    if constexpr (!ALIGN_EPI) { if (wr == 0) PG8_BAR; }
    PG8_BAR;
    if constexpr (Epi::AFTER_DRAIN) { E.fused(acc, cur, wr, wc, fr, fq, lds, wid, lane); S.done(cur); }
#undef PG8_SA
#undef PG8_SB
#undef PG8_STAGE
#undef PG8_LDA
#undef PG8_LDB
#undef PG8_MMA
#undef PG8_WAIT_V
#undef PG8_WAIT_L
#undef PG8_BAR
#undef PG8_SCHED
}
}
#include <hip/hip_bf16.h>
#include <cmath>
namespace attn_body {
using bf16=__hip_bfloat16;
using bf16x8=__attribute__((ext_vector_type(8)))short;
using s16x4=__attribute__((ext_vector_type(4)))short;
using f32x16=__attribute__((ext_vector_type(16)))float;
using u32x4=__attribute__((ext_vector_type(4)))unsigned;
constexpr int D=64;
constexpr int NW=8,QBLK=32,QB=QBLK*NW,KVBLK=64;
constexpr int ATTN_UNIT_ROWS=QB;
__device__ __forceinline__ int crow(int r,int hi){return (r&3)+8*(r>>2)+4*hi;}
#define SBAR() __builtin_amdgcn_sched_barrier(0)
__device__ __forceinline__ void cmask_blk(f32x16&p0,f32x16&p1,int jb,int wid){
  if(jb>(wid>>1)){ const float NEG=-INFINITY;
    #pragma unroll
    for(int r=0;r<16;++r){p0[r]=NEG;p1[r]=NEG;} }
}
__device__ __forceinline__ void alibi(f32x16&p0,f32x16&p1,float dq,float nsl2){
  #pragma unroll
  for(int r=0;r<16;++r){ const float e=(float)((r&3)+8*(r>>2)); p0[r]=__builtin_fmaf(__builtin_fabsf(dq-e),nsl2,p0[r]); p1[r]=__builtin_fmaf(__builtin_fabsf(dq-e-32.f),nsl2,p1[r]); }
}

constexpr int NSLOT=3, SLOTB=8192;
constexpr int LDS_K=0, LDS_V=NSLOT*SLOTB, LDS_WS=2*NSLOT*SLOTB, LDS_OST=LDS_WS+NW*64*4, LDS_BYTES=LDS_OST+NW*4096;
constexpr float C2=0.125f*1.4426950408889634f;
__device__ __forceinline__ void glds16(const void*gsrc,unsigned lds_dst){unsigned keep;
  asm volatile("s_mov_b32 %0, m0\n\ts_mov_b32 m0, %2\n\ts_nop 0\n\tglobal_load_lds_dwordx4 %1, off\n\ts_mov_b32 m0, %0":"=&s"(keep):"v"(gsrc),"s"(lds_dst):"memory");}
__device__ __forceinline__ float max3f(float a,float b,float c){float r;asm("v_max3_f32 %0, %1, %2, %3":"=v"(r):"v"(a),"v"(b),"v"(c));return r;}
__device__ __forceinline__ float max2f(float a,float b){float r;asm("v_max_f32_e32 %0, %1, %2":"=v"(r):"v"(a),"v"(b));return r;}
__device__ __forceinline__ float fadd_s(float a,float b){float r;asm("v_add_f32_e32 %0, %1, %2":"=v"(r):"v"(a),"v"(b));return r;}
__device__ __forceinline__ float fsub_s(float a,float b){float r;asm("v_sub_f32_e32 %0, %1, %2":"=v"(r):"v"(a),"v"(b));return r;}
typedef float f32x2_t __attribute__((ext_vector_type(2))); typedef __bf16 bf16x2_t __attribute__((ext_vector_type(2)));
__device__ __forceinline__ unsigned cvtpk_s(float lo,float hi){f32x2_t v={lo,hi};bf16x2_t b=__builtin_convertvector(v,bf16x2_t);return __builtin_bit_cast(unsigned,b);}
#define WAIT_BAR(N) asm volatile("s_waitcnt vmcnt(" #N ") lgkmcnt(0)\n\ts_barrier":::"memory")

__device__ __forceinline__ void qkt(f32x16&p0,f32x16&p1,const char*Kslot,const bf16x8*qr,const f32x16&negm,int r32,int hi){
  const char*kb=Kslot+hi*1024+r32*16;
  #pragma unroll
  for(int d0=0;d0<4;++d0){
    const bf16x8 b0=*reinterpret_cast<const bf16x8*>(kb+d0*2048);
    const bf16x8 b1=*reinterpret_cast<const bf16x8*>(kb+d0*2048+512);
    if(d0==0){p0=__builtin_amdgcn_mfma_f32_32x32x16_bf16(b0,qr[0],negm,0,0,0);p1=__builtin_amdgcn_mfma_f32_32x32x16_bf16(b1,qr[0],negm,0,0,0);}
    else{p0=__builtin_amdgcn_mfma_f32_32x32x16_bf16(b0,qr[d0],p0,0,0,0);p1=__builtin_amdgcn_mfma_f32_32x32x16_bf16(b1,qr[d0],p1,0,0,0);}}
}
typedef __attribute__((address_space(3))) const char* lds_cptr;
typedef short v4i16_t __attribute__((ext_vector_type(4)));
__device__ __forceinline__ void kload8(bf16x8*kf,lds_cptr kp){
  kf[0]=*(const __attribute__((address_space(3))) bf16x8*)(kp);      kf[1]=*(const __attribute__((address_space(3))) bf16x8*)(kp+512);
  kf[2]=*(const __attribute__((address_space(3))) bf16x8*)(kp+2048); kf[3]=*(const __attribute__((address_space(3))) bf16x8*)(kp+2560);
  kf[4]=*(const __attribute__((address_space(3))) bf16x8*)(kp+4096); kf[5]=*(const __attribute__((address_space(3))) bf16x8*)(kp+4608);
  kf[6]=*(const __attribute__((address_space(3))) bf16x8*)(kp+6144); kf[7]=*(const __attribute__((address_space(3))) bf16x8*)(kp+6656);
}
__device__ __forceinline__ void kload2(bf16x8*kf,lds_cptr kp,int j){ kf[2*j]=*(const __attribute__((address_space(3))) bf16x8*)(kp+j*2048); kf[2*j+1]=*(const __attribute__((address_space(3))) bf16x8*)(kp+j*2048+512); }
__device__ __forceinline__ s16x4 vtr(lds_cptr p){ return __builtin_bit_cast(s16x4,__builtin_amdgcn_ds_read_tr16_b64_v4i16((__attribute__((address_space(3))) v4i16_t*)p)); }
__device__ __forceinline__ float rowmax(const f32x16&p0,const f32x16&p1){
  float a=max3f(p0[0],p0[1],p1[0]),b=max3f(p0[2],p0[3],p1[1]);a=max3f(a,p1[2],p1[3]);
  #pragma unroll
  for(int r=4;r<16;r+=4){a=max3f(a,p0[r],p0[r+1]);b=max3f(b,p0[r+2],p0[r+3]);a=max3f(a,p1[r],p1[r+1]);b=max3f(b,p1[r+2],p1[r+3]);}
  const float m=max2f(a,b);
  auto rr=__builtin_amdgcn_permlane32_swap(__float_as_uint(m),__float_as_uint(m),false,false);
  return max2f(__uint_as_float(rr[0]),__uint_as_float(rr[1]));
}
__device__ __forceinline__ void pv(f32x16*o,int vb,bf16x8 pa0,bf16x8 pa1,bf16x8 pa2,bf16x8 pa3){
  #pragma unroll
  for(int d0=0;d0<2;++d0){s16x4 lo[4],hi[4];
    #pragma unroll
    for(int ks=0;ks<4;++ks){
      asm volatile("ds_read_b64_tr_b16 %0,%1 offset:%c2":"=&v"(lo[ks]):"v"(vb),"i"(d0*4096+ks*1024):"memory");
      asm volatile("ds_read_b64_tr_b16 %0,%1 offset:%c2":"=&v"(hi[ks]):"v"(vb),"i"(d0*4096+ks*1024+512):"memory");}
    asm volatile("s_waitcnt lgkmcnt(0)":::"memory");SBAR();
    #define PK(k) (bf16x8){lo[k][0],lo[k][1],lo[k][2],lo[k][3],hi[k][0],hi[k][1],hi[k][2],hi[k][3]}
    o[d0]=__builtin_amdgcn_mfma_f32_32x32x16_bf16(pa0,PK(0),o[d0],0,0,0);
    o[d0]=__builtin_amdgcn_mfma_f32_32x32x16_bf16(pa1,PK(1),o[d0],0,0,0);
    o[d0]=__builtin_amdgcn_mfma_f32_32x32x16_bf16(pa2,PK(2),o[d0],0,0,0);
    o[d0]=__builtin_amdgcn_mfma_f32_32x32x16_bf16(pa3,PK(3),o[d0],0,0,0);
    #undef PK
  }
}

#ifndef ATTN_STORE16
#define ATTN_STORE16(p,v) (*(u32x4*)(p)=(v))
#endif
template<int MODE,int THRL> __device__ __forceinline__ void attn_unit(const bf16*Qb,int qp,const bf16*__restrict__ Kh,int kp,const bf16*__restrict__ Vh,int vp,bf16*Ob,int op,int NT,int q0,float nsl2,char*shm,const int wid_in){
  int lane_; asm volatile("v_mbcnt_lo_u32_b32 %0, -1, 0\n\tv_mbcnt_hi_u32_b32 %0, -1, %0":"=v"(lane_)); const int lane=lane_,r32=lane&31,hi=lane>>5; const int wid=wid_in,tid=wid*64+lane; (void)tid;
  const bf16*Qw=Qb+(long)(wid*QBLK)*qp;
  const unsigned lds0=(unsigned)(uintptr_t)shm;
  float*wsf=(float*)(shm+LDS_WS)+wid*64;
  const bf16*ksrc=Kh+(long)lane*kp+wid*8;
  const bf16*vsrc=Vh+(long)(16*(wid&3)+(lane>>2))*vp+(wid>>2)*32+(lane&3)*8;
  const unsigned kdst=lds0+LDS_K+wid*1024, vdst=lds0+LDS_V+wid*1024;
  #define DMA_K(t,slot) glds16(ksrc+(long)(t)*KVBLK*kp,(unsigned)__builtin_amdgcn_readfirstlane(kdst+(slot)))
  #define DMA_V(t,slot) glds16(vsrc+(long)(t)*KVBLK*vp,(unsigned)__builtin_amdgcn_readfirstlane(vdst+(slot)))
  const int vb0=(int)(lds0+LDS_V)+((lane>>4)&1)*32+(lane&3)*8+(4*hi+((lane&15)>>2))*64;
  const char*Kbase=shm+LDS_K; bf16x8 kf[8];
  const lds_cptr shm3=(lds_cptr)shm; const lds_cptr kp0=shm3+LDS_K+hi*1024+r32*16; const lds_cptr vp0=shm3+LDS_V+((lane>>4)&1)*32+(lane&3)*8+(4*hi+((lane&15)>>2))*64;
  DMA_K(0,0);DMA_V(0,0);DMA_K(1,SLOTB);
  bf16x8 qr[4];
  #pragma unroll
  for(int d0=0;d0<4;++d0)qr[d0]=*reinterpret_cast<const bf16x8*>(&Qw[(long)r32*qp+d0*16+hi*8]);
  float mhat=0.f,l_reg=0.f;f32x16 o[2];float z_=0.f;asm volatile("":"+v"(z_));
  _Pragma("unroll") for(int r=0;r<16;++r){o[0][r]=z_;o[1][r]=z_;} f32x16 negm;_Pragma("unroll") for(int r=0;r<16;++r)negm[r]=z_;asm volatile("":"+v"(negm));
  const float dq0=(float)(q0+wid*QBLK+r32-4*hi);
  #define ALIBI(P0,P1,t) do{ if(MODE==0) alibi(P0,P1,dq0-(float)(64*(t)),nsl2); }while(0)
  #define CMASK(P0,P1,t) do{ if(MODE==0){int jb_=(t)-(NT-4); if(jb_>=0)cmask_blk(P0,P1,jb_,wid);} }while(0)
  bool resc=false;
  #define START(P0,P1) do{ const float rm=rm0_; resc=false; \
    { const float dl=rm; mhat=fadd_s(mhat,dl); \
      _Pragma("unroll") for(int r=0;r<16;++r){P0[r]=fsub_s(P0[r],dl);P1[r]=fsub_s(P1[r],dl);} \
      _Pragma("unroll") for(int r=0;r<16;++r)negm[r]=-mhat; asm volatile("":"+v"(negm)); } \
    _Pragma("unroll") for(int r=0;r<16;++r)P0[r]=__builtin_amdgcn_exp2f(P0[r]); }while(0)
  #define RESC() do{ if(resc){ asm volatile("s_waitcnt lgkmcnt(0)":::"memory"); \
      _Pragma("unroll") for(int d_=0;d_<2;++d_) _Pragma("unroll") for(int r=0;r<16;++r)o[d_][r]*=wsf[crow(r,hi)]; } }while(0)
  f32x16 pA0,pA1,pB0,pB1;
  int sl_prev=0,sl_cur=0,sl_next=SLOTB;
  #define ROT() do{sl_prev=sl_cur;sl_cur=sl_next;sl_next=(sl_next==(NSLOT-1)*SLOTB)?0:sl_next+SLOTB;}while(0)
  DMA_K(2,2*SLOTB);
  WAIT_BAR(3);
  qkt(pA0,pA1,Kbase,qr,negm,r32,hi);asm volatile("s_nop 15\n\ts_nop 7":"+v"(pA0),"+v"(pA1));const float rm0_=rowmax(pA0,pA1);
  ALIBI(pA0,pA1,0);CMASK(pA0,pA1,0);
  START(pA0,pA1);
  _Pragma("unroll") for(int r=0;r<16;++r)pA1[r]=__builtin_amdgcn_exp2f(pA1[r]);
  WAIT_BAR(0);
  DMA_K(3,0);DMA_V(1,SLOTB);
  ROT();
  kload8(kf,kp0+sl_cur);
  WAIT_BAR(2);
  s16x4 vlo[8],vhi[8]; u32x4 pw0,pw1,pw2,pw3;
  #define PKW(P,B) cvtpk_s(P[B],P[B+1])
  #define PAF(k) __builtin_bit_cast(bf16x8,pw##k)
  #define VFR(i) (bf16x8){vlo[i][0],vlo[i][1],vlo[i][2],vlo[i][3],vhi[i][0],vhi[i][1],vhi[i][2],vhi[i][3]}
  #define PIN(x) asm volatile("":"+v"(x))
  #define MX3(a,b,c) __builtin_fmaxf(__builtin_fmaxf((a),(b)),(c))
  #define GAPA(MF,A0,A1,A2,A3,W0,W1,PW) do{ MF; sacc+=A0; sacc+=A1; sacc+=A2; sacc+=A3; PIN(sacc); W0; W1; PIN(PW); SBAR(); }while(0)
  #define EX(v) __builtin_amdgcn_exp2f(v)
  #define GAPB(MF,X,B) do{ MF; X[B]=EX(X[B]); X[B+1]=EX(X[B+1]); X[B+2]=EX(X[B+2]); X[B+3]=EX(X[B+3]); PIN(X); SBAR(); }while(0)
  #define VRD(i) do{ vlo[i]=vtr(vp_+(((i)>>2)*4096+((i)&3)*1024)); vhi[i]=vtr(vp_+(((i)>>2)*4096+((i)&3)*1024+512)); }while(0)
  #define KRD(G,j) do{ if(G){ kload2(kf,kp0+sl_next,j); SBAR(); } }while(0)
  #define STEP(C0,C1,P0,P1,t,GK,GV,GL) do{ SBAR(); \
    const lds_cptr vp_=vp0+sl_prev; \
    VRD(0); SBAR(); float sacc=(P0[0]+P0[1]); \
    GAPA(C0=__builtin_amdgcn_mfma_f32_32x32x16_bf16(kf[0],qr[0],negm,0,0,0), P0[2],P0[3],P0[4],P0[5],     pw0[0]=PKW(P0,0), pw0[1]=PKW(P0,2), pw0); \
    VRD(4); SBAR(); GAPA(C1=__builtin_amdgcn_mfma_f32_32x32x16_bf16(kf[1],qr[0],negm,0,0,0), P0[6],P0[7],P0[8],P0[9],     pw0[2]=PKW(P0,4), pw0[3]=PKW(P0,6), pw0); \
    VRD(1); SBAR(); GAPA(C0=__builtin_amdgcn_mfma_f32_32x32x16_bf16(kf[2],qr[1],C0,0,0,0),   P0[10],P0[11],P0[12],P0[13], pw1[0]=PKW(P0,8), pw1[1]=PKW(P0,10), pw1); \
    VRD(5); SBAR(); GAPA(C1=__builtin_amdgcn_mfma_f32_32x32x16_bf16(kf[3],qr[1],C1,0,0,0),   P0[14],P0[15],P1[0],P1[1],   pw1[2]=PKW(P0,12),pw1[3]=PKW(P0,14), pw1); \
    VRD(2); SBAR(); GAPA(C0=__builtin_amdgcn_mfma_f32_32x32x16_bf16(kf[4],qr[2],C0,0,0,0),   P1[2],P1[3],P1[4],P1[5],     pw2[0]=PKW(P1,0), pw2[1]=PKW(P1,2), pw2); \
    VRD(6); SBAR(); GAPA(C1=__builtin_amdgcn_mfma_f32_32x32x16_bf16(kf[5],qr[2],C1,0,0,0),   P1[6],P1[7],P1[8],P1[9],     pw2[2]=PKW(P1,4), pw2[3]=PKW(P1,6), pw2); \
    VRD(3); SBAR(); GAPA(C0=__builtin_amdgcn_mfma_f32_32x32x16_bf16(kf[6],qr[3],C0,0,0,0),   P1[10],P1[11],P1[12],P1[13], pw3[0]=PKW(P1,8), pw3[1]=PKW(P1,10), pw3); \
    VRD(7); SBAR(); GAPA(C1=__builtin_amdgcn_mfma_f32_32x32x16_bf16(kf[7],qr[3],C1,0,0,0),   P1[14],P1[15],0.f,0.f,       pw3[2]=PKW(P1,12),pw3[3]=PKW(P1,14), pw3); \
    l_reg+=sacc; \
    if(GK){DMA_K((t)+3,sl_cur);} if(GV){DMA_V((t)+1,sl_next);} \
    ALIBI(C0,C1,t); CMASK(C0,C1,t); \
    { float a=MX3(C0[0],C0[1],C1[0]),b=MX3(C0[2],C0[3],C1[1]); a=MX3(a,C1[2],C1[3]); \
      _Pragma("unroll") for(int r=4;r<16;r+=4){a=MX3(a,C0[r],C0[r+1]);b=MX3(b,C0[r+2],C0[r+3]);a=MX3(a,C1[r],C1[r+1]);b=MX3(b,C1[r+2],C1[r+3]);} \
      float rm=__builtin_fmaxf(a,b); { auto rr=__builtin_amdgcn_permlane32_swap(__float_as_uint(rm),__float_as_uint(rm),false,false); rm=__builtin_fmaxf(__uint_as_float(rr[0]),__uint_as_float(rr[1])); } \
      resc=false; \
      if(__builtin_expect(__any(rm>(float)THRL),0)){ const float dl=__builtin_fmaxf(rm,0.f); mhat+=dl; \
        _Pragma("unroll") for(int r=0;r<16;++r){C0[r]-=dl;C1[r]-=dl;} \
        _Pragma("unroll") for(int r=0;r<16;++r)negm[r]=-mhat; asm volatile("":"+v"(negm)); \
        const float f=__builtin_amdgcn_exp2f(-dl); l_reg*=f; if(hi==0)wsf[r32]=f; resc=true; } } \
    SBAR(); \
    GAPB(o[0]=__builtin_amdgcn_mfma_f32_32x32x16_bf16(PAF(0),VFR(0),o[0],0,0,0), C0,0); \
    GAPB(o[1]=__builtin_amdgcn_mfma_f32_32x32x16_bf16(PAF(0),VFR(4),o[1],0,0,0), C0,4); \
    KRD(GL,0); GAPB(o[0]=__builtin_amdgcn_mfma_f32_32x32x16_bf16(PAF(1),VFR(1),o[0],0,0,0), C0,8); \
    KRD(GL,1); GAPB(o[1]=__builtin_amdgcn_mfma_f32_32x32x16_bf16(PAF(1),VFR(5),o[1],0,0,0), C0,12); \
    KRD(GL,2); GAPB(o[0]=__builtin_amdgcn_mfma_f32_32x32x16_bf16(PAF(2),VFR(2),o[0],0,0,0), C1,0); \
    KRD(GL,3); GAPB(o[1]=__builtin_amdgcn_mfma_f32_32x32x16_bf16(PAF(2),VFR(6),o[1],0,0,0), C1,4); \
    GAPB(o[0]=__builtin_amdgcn_mfma_f32_32x32x16_bf16(PAF(3),VFR(3),o[0],0,0,0), C1,8); \
    GAPB(o[1]=__builtin_amdgcn_mfma_f32_32x32x16_bf16(PAF(3),VFR(7),o[1],0,0,0), C1,12); \
    }while(0)
  int t=1;
  #undef CMASK
  #define CMASK(P0,P1,t) do{}while(0)
  for(;t+5<NT;t+=2){
    STEP(pB0,pB1,pA0,pA1,t,true,true,true);     WAIT_BAR(2); RESC(); ROT();
    STEP(pA0,pA1,pB0,pB1,t+1,true,true,true);   WAIT_BAR(2); RESC(); ROT();
  }
  #undef CMASK
  #define CMASK(P0,P1,t) do{ if(MODE==0){int jb_=(t)-(NT-4); if(jb_>=0)cmask_blk(P0,P1,jb_,wid);} }while(0)
  #define ENDW(tt) do{ if((tt)+3<NT){WAIT_BAR(2);} else if((tt)+2<NT){WAIT_BAR(1);} else {WAIT_BAR(0);} }while(0)
  for(;t+1<NT;t+=2){
    STEP(pB0,pB1,pA0,pA1,t,(t+3<NT),(t+1<NT),(t+1<NT));       ENDW(t);   RESC(); ROT();
    STEP(pA0,pA1,pB0,pB1,t+1,(t+4<NT),(t+2<NT),(t+2<NT));     ENDW(t+1); RESC(); ROT();
  }
  STEP(pB0,pB1,pA0,pA1,NT-1,false,false,false); RESC();
  { float sacc=pB0[0]+pB0[1]; _Pragma("unroll") for(int r=2;r<16;++r)sacc+=pB0[r]; _Pragma("unroll") for(int r=0;r<16;++r)sacc+=pB1[r]; l_reg+=sacc;
    pw0=(u32x4){PKW(pB0,0),PKW(pB0,2),PKW(pB0,4),PKW(pB0,6)};pw1=(u32x4){PKW(pB0,8),PKW(pB0,10),PKW(pB0,12),PKW(pB0,14)};pw2=(u32x4){PKW(pB1,0),PKW(pB1,2),PKW(pB1,4),PKW(pB1,6)};pw3=(u32x4){PKW(pB1,8),PKW(pB1,10),PKW(pB1,12),PKW(pB1,14)};
    SBAR(); pv(o,vb0+sl_cur,PAF(0),PAF(1),PAF(2),PAF(3)); }
  #undef PKW
  #undef PAF
  #undef VFR
  #undef PIN
  #undef MX3
  #undef GAPA
  #undef GAPB
  #undef EX
  #undef VRD
  #undef KRD
  #undef STEP
  #undef ENDW
  {auto rr=__builtin_amdgcn_permlane32_swap(__float_as_uint(l_reg),__float_as_uint(l_reg),false,false);l_reg=__uint_as_float(rr[0])+__uint_as_float(rr[1]);}
  if(hi==0)wsf[32+r32]=l_reg;asm volatile("s_waitcnt lgkmcnt(0)":::"memory");
  float rli[16];
  #pragma unroll
  for(int r=0;r<16;++r)rli[r]=__builtin_amdgcn_rcpf(wsf[32+crow(r,hi)]);
  bf16*Ow=Ob+(long)(wid*QBLK)*op;
  { bf16*stg=(bf16*)(shm+LDS_OST)+wid*2048;
    #pragma unroll
    for(int r=0;r<16;++r){const int orow=crow(r,hi);
      #pragma unroll
      for(int d0=0;d0<2;++d0)stg[orow*64+d0*32+r32]=__float2bfloat16(o[d0][r]*rli[r]);}
    asm volatile("s_waitcnt lgkmcnt(0)":::"memory");
    #pragma unroll
    for(int i=0;i<4;++i){const int row=i*8+(lane>>3),ch=lane&7; const u32x4 v=*(const u32x4*)(stg+row*64+ch*8); ATTN_STORE16(Ow+(long)row*op+ch*8,v);} }
  asm volatile("s_waitcnt lgkmcnt(0)\n\ts_barrier":::"memory");
  #undef DMA_K
  #undef DMA_V
  #undef CMASK
  #undef ALIBI
  #undef START
  #undef RESC
  #undef ROT
}
constexpr int L2_K=0, L2_V0=NSLOT*SLOTB, L2_V1=2*NSLOT*SLOTB, L2_WS=3*NSLOT*SLOTB, L2_QS=L2_WS+NW*64*4, L2_QSW=4608, LDS2_BYTES=L2_QS+NW*L2_QSW;
template<int THRL> __device__ __forceinline__ void attn_unit2(const bf16*Qb,int qp,const bf16*__restrict__ Kh,int kp,const bf16*__restrict__ Vh,int vp,bf16*Ob,int op,int NT,int q0,float nsl2,char*shm,const int wid_in){
  int lane_; asm volatile("v_mbcnt_lo_u32_b32 %0, -1, 0\n\tv_mbcnt_hi_u32_b32 %0, -1, %0":"=v"(lane_)); const int lane=lane_,r32=lane&31,hi=lane>>5; const int wid=wid_in,tid=wid*64+lane; (void)tid; constexpr int MODE=0;
  const bf16*Qw=Qb+(long)(wid*QBLK)*qp;
  const unsigned lds0=(unsigned)(uintptr_t)shm;
  float*wsf=(float*)(shm+L2_WS)+wid*64;
  const bf16*ksrc=Kh+(long)lane*kp+wid*8;
  const bf16*vsrc=Vh+(long)(16*(wid&3)+(lane>>2))*vp+(wid>>2)*32+(lane&3)*8;
  const unsigned kdst=lds0+L2_K+wid*1024, vdst=lds0+L2_V0+wid*1024, vdst1=lds0+L2_V1+wid*1024;
  #define DMA_K(t,slot) glds16(ksrc+(long)(t)*KVBLK*kp,(unsigned)__builtin_amdgcn_readfirstlane(kdst+(slot)))
  #define DMA_V(t,slot) do{ glds16(vsrc+(long)(t)*KVBLK*vp,(unsigned)__builtin_amdgcn_readfirstlane(vdst+(slot))); glds16(vsrc+64+(long)(t)*KVBLK*vp,(unsigned)__builtin_amdgcn_readfirstlane(vdst1+(slot))); }while(0)
  const int vb0=(int)(lds0+L2_V0)+((lane>>4)&1)*32+(lane&3)*8+(4*hi+((lane&15)>>2))*64, vb1=vb0+(L2_V1-L2_V0);
  const char*Kbase=shm+L2_K; bf16x8 kf[8];
  const lds_cptr shm3=(lds_cptr)shm; const lds_cptr kp0=shm3+L2_K+hi*1024+r32*16; const lds_cptr vp0=shm3+L2_V0+((lane>>4)&1)*32+(lane&3)*8+(4*hi+((lane&15)>>2))*64; const lds_cptr qf0=shm3+L2_QS+wid*L2_QSW+r32*144+hi*16;
  DMA_K(0,0);DMA_V(0,0);DMA_K(1,SLOTB);
  bf16x8 qr[4];
  #pragma unroll
  for(int d0=0;d0<4;++d0)qr[d0]=*reinterpret_cast<const bf16x8*>(&Qw[(long)r32*qp+d0*16+hi*8]);
  float mhat=0.f,l_reg=0.f;f32x16 o[4];float z_=0.f;asm volatile("":"+v"(z_));
  _Pragma("unroll") for(int r=0;r<16;++r){o[0][r]=z_;o[1][r]=z_;o[2][r]=z_;o[3][r]=z_;}
  const f32x16 ZERO={0.f,0.f,0.f,0.f,0.f,0.f,0.f,0.f,0.f,0.f,0.f,0.f,0.f,0.f,0.f,0.f};
  const float dq0=(float)(q0+wid*QBLK+r32-4*hi);
  #define ALIBI(P0,P1,t) do{ alibi(P0,P1,dq0-(float)(64*(t)),nsl2); _Pragma("unroll") for(int r=0;r<16;++r){P0[r]-=mhat;P1[r]-=mhat;} }while(0)
  #define ALIBIF(P0,P1,t) do{ const float a_=__builtin_fmaf(nsl2,dq0-(float)(64*(t)),-mhat); _Pragma("unroll") for(int r=0;r<16;++r){ const float e_=(float)((r&3)+8*(r>>2)); P0[r]=__builtin_fmaf(e_,-nsl2,P0[r]+a_); P1[r]=__builtin_fmaf(e_+32.f,-nsl2,P1[r]+a_); } }while(0)
  #define CMASK(P0,P1,t) do{ if(MODE==0){int jb_=(t)-(NT-4); if(jb_>=0)cmask_blk(P0,P1,jb_,wid);} }while(0)
  bool resc=false;
  #define START(P0,P1) do{ const float rm=rm0_; resc=false; \
    { const float dl=rm; mhat=fadd_s(mhat,dl); \
      _Pragma("unroll") for(int r=0;r<16;++r){P0[r]=fsub_s(P0[r],dl);P1[r]=fsub_s(P1[r],dl);} \
      } \
    _Pragma("unroll") for(int r=0;r<16;++r)P0[r]=__builtin_amdgcn_exp2f(P0[r]); }while(0)
  #define RESC() do{ if(resc){ asm volatile("s_waitcnt lgkmcnt(0)":::"memory"); \
      _Pragma("unroll") for(int d_=0;d_<4;++d_) _Pragma("unroll") for(int r=0;r<16;++r)o[d_][r]*=wsf[crow(r,hi)]; } }while(0)
  f32x16 pA0,pA1,pB0,pB1;
  int sl_prev=0,sl_cur=0,sl_next=SLOTB;
  #define ROT() do{sl_prev=sl_cur;sl_cur=sl_next;sl_next=(sl_next==(NSLOT-1)*SLOTB)?0:sl_next+SLOTB;}while(0)
  DMA_K(2,2*SLOTB);
  { bf16*qs=(bf16*)(shm+L2_QS+wid*L2_QSW);
    _Pragma("unroll") for(int d0=0;d0<4;++d0)*reinterpret_cast<bf16x8*>(&qs[r32*72+d0*16+hi*8])=qr[d0]; }
  WAIT_BAR(4);
  qkt(pA0,pA1,Kbase,qr,ZERO,r32,hi);asm volatile("s_nop 15\n\ts_nop 7":"+v"(pA0),"+v"(pA1));const float rm0_=rowmax(pA0,pA1);
  ALIBI(pA0,pA1,0);CMASK(pA0,pA1,0);
  START(pA0,pA1);
  _Pragma("unroll") for(int r=0;r<16;++r)pA1[r]=__builtin_amdgcn_exp2f(pA1[r]);
  WAIT_BAR(0);
  DMA_K(3,0);DMA_V(1,SLOTB);
  ROT();
  kload8(kf,kp0+sl_cur);
  WAIT_BAR(3);
  s16x4 vlo[8],vhi[8]; u32x4 pw0,pw1,pw2,pw3;
  #define PKW(P,B) cvtpk_s(P[B],P[B+1])
  #define PAF(k) __builtin_bit_cast(bf16x8,pw##k)
  #define VFR(i) (bf16x8){vlo[i][0],vlo[i][1],vlo[i][2],vlo[i][3],vhi[i][0],vhi[i][1],vhi[i][2],vhi[i][3]}
  #define PIN(x) asm volatile("":"+v"(x))
  #define MX3(a,b,c) __builtin_fmaxf(__builtin_fmaxf((a),(b)),(c))
  #define GAPA(MF,A0,A1,A2,A3,W0,W1,PW) do{ MF; sacc+=A0; sacc+=A1; sacc+=A2; sacc+=A3; PIN(sacc); W0; W1; PIN(PW); SBAR(); }while(0)
  #define EX(v) __builtin_amdgcn_exp2f(v)
  #define GAPB(MF,X,B) do{ MF; X[B]=EX(X[B]); X[B+1]=EX(X[B+1]); X[B+2]=EX(X[B+2]); X[B+3]=EX(X[B+3]); PIN(X); SBAR(); }while(0)
  #define VRD(i) do{ vlo[i]=vtr(vp_+(((i)>>2)*4096+((i)&3)*1024)); vhi[i]=vtr(vp_+(((i)>>2)*4096+((i)&3)*1024+512)); }while(0)
  #define KRD(G,j) do{ if(G){ kload2(kf,kp0+sl_next,j); SBAR(); } }while(0)
  #define QF(d) (*(const __attribute__((address_space(3))) bf16x8*)(qf0+32*(d)))
  #define STEP(C0,C1,P0,P1,t,GK,GV,GL,AL) do{ SBAR(); \
    const lds_cptr vp_=vp0+sl_prev; const bf16x8 q0_=QF(0),q1_=QF(1); \
    VRD(0); SBAR(); float sacc=(P0[0]+P0[1]); \
    GAPA(C0=__builtin_amdgcn_mfma_f32_32x32x16_bf16(kf[0],q0_,ZERO,0,0,0), P0[2],P0[3],P0[4],P0[5],     pw0[0]=PKW(P0,0), pw0[1]=PKW(P0,2), pw0); \
    VRD(4); SBAR(); GAPA(C1=__builtin_amdgcn_mfma_f32_32x32x16_bf16(kf[1],q0_,ZERO,0,0,0), P0[6],P0[7],P0[8],P0[9],     pw0[2]=PKW(P0,4), pw0[3]=PKW(P0,6), pw0); \
    VRD(1); SBAR(); GAPA(C0=__builtin_amdgcn_mfma_f32_32x32x16_bf16(kf[2],q1_,C0,0,0,0),   P0[10],P0[11],P0[12],P0[13], pw1[0]=PKW(P0,8), pw1[1]=PKW(P0,10), pw1); \
    VRD(5); SBAR(); GAPA(C1=__builtin_amdgcn_mfma_f32_32x32x16_bf16(kf[3],q1_,C1,0,0,0),   P0[14],P0[15],P1[0],P1[1],   pw1[2]=PKW(P0,12),pw1[3]=PKW(P0,14), pw1); \
    const bf16x8 q2_=QF(2),q3_=QF(3); \
    VRD(2); SBAR(); GAPA(C0=__builtin_amdgcn_mfma_f32_32x32x16_bf16(kf[4],q2_,C0,0,0,0),   P1[2],P1[3],P1[4],P1[5],     pw2[0]=PKW(P1,0), pw2[1]=PKW(P1,2), pw2); \
    VRD(6); SBAR(); GAPA(C1=__builtin_amdgcn_mfma_f32_32x32x16_bf16(kf[5],q2_,C1,0,0,0),   P1[6],P1[7],P1[8],P1[9],     pw2[2]=PKW(P1,4), pw2[3]=PKW(P1,6), pw2); \
    VRD(3); SBAR(); GAPA(C0=__builtin_amdgcn_mfma_f32_32x32x16_bf16(kf[6],q3_,C0,0,0,0),   P1[10],P1[11],P1[12],P1[13], pw3[0]=PKW(P1,8), pw3[1]=PKW(P1,10), pw3); \
    VRD(7); SBAR(); GAPA(C1=__builtin_amdgcn_mfma_f32_32x32x16_bf16(kf[7],q3_,C1,0,0,0),   P1[14],P1[15],0.f,0.f,       pw3[2]=PKW(P1,12),pw3[3]=PKW(P1,14), pw3); \
    l_reg+=sacc; \
    if(GK){DMA_K((t)+3,sl_cur);} if(GV){DMA_V((t)+1,sl_next);} \
    AL(C0,C1,t); CMASK(C0,C1,t); \
    { float a=MX3(C0[0],C0[1],C1[0]),b=MX3(C0[2],C0[3],C1[1]); a=MX3(a,C1[2],C1[3]); \
      _Pragma("unroll") for(int r=4;r<16;r+=4){a=MX3(a,C0[r],C0[r+1]);b=MX3(b,C0[r+2],C0[r+3]);a=MX3(a,C1[r],C1[r+1]);b=MX3(b,C1[r+2],C1[r+3]);} \
      float rm=__builtin_fmaxf(a,b); { auto rr=__builtin_amdgcn_permlane32_swap(__float_as_uint(rm),__float_as_uint(rm),false,false); rm=__builtin_fmaxf(__uint_as_float(rr[0]),__uint_as_float(rr[1])); } \
      resc=false; \
      if(__builtin_expect(__any(rm>(float)THRL),0)){ const float dl=__builtin_fmaxf(rm,0.f); mhat+=dl; \
        _Pragma("unroll") for(int r=0;r<16;++r){C0[r]-=dl;C1[r]-=dl;} \
        const float f=__builtin_amdgcn_exp2f(-dl); l_reg*=f; if(hi==0)wsf[r32]=f; resc=true; } } \
    SBAR(); \
    GAPB(o[0]=__builtin_amdgcn_mfma_f32_32x32x16_bf16(PAF(0),VFR(0),o[0],0,0,0), C0,0); \
    GAPB(o[1]=__builtin_amdgcn_mfma_f32_32x32x16_bf16(PAF(0),VFR(4),o[1],0,0,0), C0,4); \
    KRD(GL,0); GAPB(o[0]=__builtin_amdgcn_mfma_f32_32x32x16_bf16(PAF(1),VFR(1),o[0],0,0,0), C0,8); \
    KRD(GL,1); GAPB(o[1]=__builtin_amdgcn_mfma_f32_32x32x16_bf16(PAF(1),VFR(5),o[1],0,0,0), C0,12); \
    KRD(GL,2); GAPB(o[0]=__builtin_amdgcn_mfma_f32_32x32x16_bf16(PAF(2),VFR(2),o[0],0,0,0), C1,0); \
    KRD(GL,3); GAPB(o[1]=__builtin_amdgcn_mfma_f32_32x32x16_bf16(PAF(2),VFR(6),o[1],0,0,0), C1,4); \
    GAPB(o[0]=__builtin_amdgcn_mfma_f32_32x32x16_bf16(PAF(3),VFR(3),o[0],0,0,0), C1,8); \
    GAPB(o[1]=__builtin_amdgcn_mfma_f32_32x32x16_bf16(PAF(3),VFR(7),o[1],0,0,0), C1,12); \
    { const lds_cptr vq_=vp_+(L2_V1-L2_V0); _Pragma("unroll") for(int i_=0;i_<8;++i_){ vlo[i_]=vtr(vq_+((i_>>2)*4096+(i_&3)*1024)); vhi[i_]=vtr(vq_+((i_>>2)*4096+(i_&3)*1024+512)); } SBAR(); \
      o[2]=__builtin_amdgcn_mfma_f32_32x32x16_bf16(PAF(0),VFR(0),o[2],0,0,0); o[3]=__builtin_amdgcn_mfma_f32_32x32x16_bf16(PAF(0),VFR(4),o[3],0,0,0); \
      o[2]=__builtin_amdgcn_mfma_f32_32x32x16_bf16(PAF(1),VFR(1),o[2],0,0,0); o[3]=__builtin_amdgcn_mfma_f32_32x32x16_bf16(PAF(1),VFR(5),o[3],0,0,0); \
      o[2]=__builtin_amdgcn_mfma_f32_32x32x16_bf16(PAF(2),VFR(2),o[2],0,0,0); o[3]=__builtin_amdgcn_mfma_f32_32x32x16_bf16(PAF(2),VFR(6),o[3],0,0,0); \
      o[2]=__builtin_amdgcn_mfma_f32_32x32x16_bf16(PAF(3),VFR(3),o[2],0,0,0); o[3]=__builtin_amdgcn_mfma_f32_32x32x16_bf16(PAF(3),VFR(7),o[3],0,0,0); SBAR(); } \
    }while(0)
  int t=1;
  #undef CMASK
  #define CMASK(P0,P1,t) do{}while(0)
  for(;t+5<NT;t+=2){
    STEP(pB0,pB1,pA0,pA1,t,true,true,true,ALIBIF);     WAIT_BAR(3); RESC(); ROT();
    STEP(pA0,pA1,pB0,pB1,t+1,true,true,true,ALIBIF);   WAIT_BAR(3); RESC(); ROT();
  }
  #undef CMASK
  #define CMASK(P0,P1,t) do{ if(MODE==0){int jb_=(t)-(NT-4); if(jb_>=0)cmask_blk(P0,P1,jb_,wid);} }while(0)
  #define ENDW(tt) do{ if((tt)+3<NT){WAIT_BAR(3);} else if((tt)+2<NT){WAIT_BAR(2);} else {WAIT_BAR(0);} }while(0)
  for(;t+1<NT;t+=2){
    STEP(pB0,pB1,pA0,pA1,t,(t+3<NT),(t+1<NT),(t+1<NT),ALIBI);       ENDW(t);   RESC(); ROT();
    STEP(pA0,pA1,pB0,pB1,t+1,(t+4<NT),(t+2<NT),(t+2<NT),ALIBI);     ENDW(t+1); RESC(); ROT();
  }
  STEP(pB0,pB1,pA0,pA1,NT-1,false,false,false,ALIBI); RESC();
  { float sacc=pB0[0]+pB0[1]; _Pragma("unroll") for(int r=2;r<16;++r)sacc+=pB0[r]; _Pragma("unroll") for(int r=0;r<16;++r)sacc+=pB1[r]; l_reg+=sacc;
    pw0=(u32x4){PKW(pB0,0),PKW(pB0,2),PKW(pB0,4),PKW(pB0,6)};pw1=(u32x4){PKW(pB0,8),PKW(pB0,10),PKW(pB0,12),PKW(pB0,14)};pw2=(u32x4){PKW(pB1,0),PKW(pB1,2),PKW(pB1,4),PKW(pB1,6)};pw3=(u32x4){PKW(pB1,8),PKW(pB1,10),PKW(pB1,12),PKW(pB1,14)};
    SBAR(); pv(o,vb0+sl_cur,PAF(0),PAF(1),PAF(2),PAF(3)); pv(o+2,vb1+sl_cur,PAF(0),PAF(1),PAF(2),PAF(3)); }
  #undef PKW
  #undef PAF
  #undef VFR
  #undef PIN
  #undef MX3
  #undef GAPA
  #undef GAPB
  #undef EX
  #undef VRD
  #undef KRD
  #undef STEP
  #undef QF
  #undef ENDW
  {auto rr=__builtin_amdgcn_permlane32_swap(__float_as_uint(l_reg),__float_as_uint(l_reg),false,false);l_reg=__uint_as_float(rr[0])+__uint_as_float(rr[1]);}
  if(hi==0)wsf[32+r32]=l_reg;asm volatile("s_waitcnt lgkmcnt(0)":::"memory");
  float rli[16];
  #pragma unroll
  for(int r=0;r<16;++r)rli[r]=__builtin_amdgcn_rcpf(wsf[32+crow(r,hi)]);
  bf16*Ow=Ob+(long)(wid*QBLK)*op;
  { bf16*stg=(bf16*)(shm+L2_QS+wid*L2_QSW);
    #pragma unroll
    for(int hv=0;hv<2;++hv){
      #pragma unroll
      for(int r=0;r<16;++r){const int orow=crow(r,hi);
        #pragma unroll
        for(int d0=0;d0<2;++d0)stg[orow*64+d0*32+r32]=__float2bfloat16(o[2*hv+d0][r]*rli[r]);}
      asm volatile("s_waitcnt lgkmcnt(0)":::"memory");
      #pragma unroll
      for(int i=0;i<4;++i){const int row=i*8+(lane>>3),ch=lane&7; const u32x4 v=*(const u32x4*)(stg+row*64+ch*8); ATTN_STORE16(Ow+(long)row*op+hv*64+ch*8,v);}
      asm volatile("s_waitcnt lgkmcnt(0)":::"memory"); } }
  asm volatile("s_waitcnt lgkmcnt(0)\n\ts_barrier":::"memory");
  #undef DMA_K
  #undef DMA_V
  #undef CMASK
  #undef ALIBI
  #undef ALIBIF
  #undef START
  #undef RESC
  #undef ROT
}
constexpr int ATTN_LDS_BYTES=LDS_BYTES;
#undef SBAR
#undef WAIT_BAR
}
constexpr int T = 32768, D = 1024, NB = 8, S = 4096, MEML = 256;
constexpr int AIN = 2560, BIN = 3328, FFD = 2816, FFE = 3584, NE = 8, DAW = 768;
constexpr float EPS = 1e-6f;
constexpr float C2 = 0.125f * 1.4426950408889634f;
constexpr int MAXROWS = 2 * T + NE * 256;
constexpr int NWAVES = 8;
constexpr float SC_X = 16.f, SC_WGU = 64.f, SC_H = 8.f, SC_WDN = 256.f;
constexpr size_t MiB = 1u << 20;
constexpr size_t WS_CTL = 0, CTL_ZERO_BYTES = 1 * MiB;
constexpr size_t WS_WINA = 2 * MiB, WS_WOUT = 12 * MiB, WS_WINB = 20 * MiB, WS_WMKV = 33 * MiB, WS_WGUD = 37 * MiB, WS_WDND = 59 * MiB, WS_WGUM = 70 * MiB, WS_WDNM = 294 * MiB;
constexpr size_t WS_MEMN = 406 * MiB, WS_MKV = 422 * MiB, WS_XN = 430 * MiB, WS_OC = 494 * MiB, WS_ROUTE = 558 * MiB, WS_BIG = 560 * MiB, WS_XG = 1072 * MiB, WS_Y = 1204 * MiB, WS_SSQP = 1362 * MiB, WS_END = 1372 * MiB;
constexpr size_t WS_SLOC = WS_XG, WS_SIN = WS_XG + 192 * MiB;
constexpr size_t WS_FS = 1600 * MiB;
constexpr int CW_TMO = 0, CW_CODE = 1, CW_BAR = 4096, CW_GCNT = 8192, CW_N2 = 65536;
constexpr int RING_OFF = 0, RING_BYTES = 131072;
constexpr int LDSCTL_OFF = RING_BYTES, MISC_OFF = LDSCTL_OFF + 320;
constexpr int LDS_BYTES = 147456;
static_assert(MISC_OFF + 128 <= LDS_BYTES, "LDS map");
#ifndef MK_DBG
#define MK_DBG 0
#endif
#ifndef MK_DUP
#define MK_DUP 0
#endif
#ifndef MK_TS
#define MK_TS 0
#endif
#ifndef MK_TS_A
#define MK_TS_A 0
#endif
#ifndef MK_TS_B
#define MK_TS_B 0
#endif
__constant__ unsigned char ATT_DEAL[16][6] = {{4, 14, 35, 56, 63, 85}, {0, 18, 20, 36, 72, 79}, {16, 21, 34, 52, 88, 95}, {22, 32, 50, 62, 68, 73}, {23, 48, 66, 78, 84, 89}, {5, 15, 40, 51, 86, 94}, {1, 6, 27, 47, 61, 69}, {24, 37, 41, 64, 77, 82},
    {2, 12, 25, 53, 57, 93}, {7, 17, 28, 38, 44, 60}, {8, 29, 33, 45, 54, 76}, {9, 30, 46, 49, 70, 92}, {10, 59, 65, 67, 87, 90}, {11, 31, 42, 55, 75, 81}, {19, 43, 71, 80, 83, 91}, {3, 13, 26, 39, 58, 74}};
#define GAS __attribute__((address_space(1)))
#define LAS __attribute__((address_space(3)))
typedef unsigned short bf16;
typedef unsigned v4u __attribute__((ext_vector_type(4)));
typedef unsigned v2u __attribute__((ext_vector_type(2)));
typedef float f32x4 __attribute__((ext_vector_type(4)));
typedef short bf16x8 __attribute__((ext_vector_type(8)));
typedef GAS unsigned gu32;
typedef GAS unsigned long long gu64;
#define RLX_AGENT __ATOMIC_RELAXED, __HIP_MEMORY_SCOPE_AGENT
#define LDS_WAIT() asm volatile("s_waitcnt lgkmcnt(0)" ::: "memory")
#define VM_WAIT() asm volatile("s_waitcnt vmcnt(0)" ::: "memory")
__device__ __forceinline__ unsigned long long rt() { return __builtin_amdgcn_s_memrealtime(); }
__device__ __forceinline__ unsigned f2bf(float f) { unsigned u = __builtin_bit_cast(unsigned, f); return (u + 0x7fffu + ((u >> 16) & 1u)) >> 16; }
__device__ __forceinline__ unsigned pk2(float lo, float hi) { return f2bf(lo) | (f2bf(hi) << 16); }

#define XB_TMO      128
#define XB_XCNT(j)  (256  + 64 * (j))
#define XB_XSUB(j)  (1280 + 64 * (j))
#define XB_XGEN(j)  (2304 + 64 * (j))
#define XB_TOP      3328
#define XB_TOPGEN   3392
#define XCD_BAR_WORDS 3456
#define XB_SPIN_CAP (1u << 18)

__device__ __forceinline__ unsigned xb_ld(unsigned* p)              { return __hip_atomic_load(p, __ATOMIC_RELAXED, __HIP_MEMORY_SCOPE_AGENT); }
__device__ __forceinline__ unsigned xb_add(unsigned* p, unsigned v) { return __hip_atomic_fetch_add(p, v, __ATOMIC_RELAXED, __HIP_MEMORY_SCOPE_AGENT); }
__device__ __forceinline__ unsigned xb_xcc_id() { return (unsigned)__builtin_amdgcn_s_getreg((3 << 11) | 20) & 0xFu; }
#define XB_SPIN(cond, bar) do { unsigned _sp = 0; while (cond) { __builtin_amdgcn_s_sleep(1); \
    if ((++_sp & 255u) == 0u) { if (xb_ld(&(bar)[XB_TMO])) break; if (_sp > XB_SPIN_CAP) { atomicAdd(&(bar)[XB_TMO], 1u); break; } } } } while (0)

struct XcdBarrier {
    unsigned* bar; unsigned x; int wave;
    volatile LAS unsigned* st;
};

__device__ __forceinline__ XcdBarrier xcd_barrier_post(unsigned* bar, volatile LAS unsigned* st) {
    XcdBarrier b; b.bar = bar; b.x = xb_xcc_id(); b.st = st; b.wave = __builtin_amdgcn_readfirstlane((int)(threadIdx.x >> 6));
    if (threadIdx.x == 0) (void)xb_add(&bar[XB_XCNT(b.x)], 1u);
    return b;
}
__device__ __forceinline__ void xcd_barrier_complete(unsigned* bar, unsigned x, unsigned& nloc, unsigned& nx) {
    const unsigned G = gridDim.x * gridDim.y * gridDim.z;
    unsigned sum, cnt, mine, sp = 0u;
    for (;;) {
        sum = 0u; cnt = 0u; mine = 0u;
#pragma unroll
        for (unsigned j = 0; j < 16; ++j) { const unsigned c = xb_ld(&bar[XB_XCNT(j)]); sum += c; cnt += (c > 0u) ? 1u : 0u; mine = (j == x) ? c : mine; }
        if (sum == G) break;
        __builtin_amdgcn_s_sleep(1);
        if ((++sp & 255u) == 0u) { if (xb_ld(&bar[XB_TMO])) break; if (sp > XB_SPIN_CAP) { atomicAdd(&bar[XB_TMO], 1u); break; } }
    }
    nloc = mine > 0u ? mine : 1u; nx = cnt > 0u ? cnt : 1u;
}

__device__ __forceinline__ void xcd_barrier(const XcdBarrier& b) {
    asm volatile("s_waitcnt vmcnt(0)" ::: "memory");
    __syncthreads();
    int l0_; asm volatile("v_mbcnt_lo_u32_b32 %0, -1, 0\n\tv_mbcnt_hi_u32_b32 %0, -1, %0" : "=v"(l0_));
    if (b.wave == 0 && l0_ == 0) {
        unsigned* bar = b.bar;
        __builtin_amdgcn_s_waitcnt(0);
        unsigned nloc = b.st[0], nx = b.st[1];
        if (nloc == 0u) { xcd_barrier_complete(bar, b.x, nloc, nx); b.st[0] = nloc; b.st[1] = nx; }
        const unsigned old = xb_add(&bar[XB_XSUB(b.x)], 1u);
        const unsigned gen = old / nloc;
        if (old + 1u == (gen + 1u) * nloc) {
            __builtin_amdgcn_fence(__ATOMIC_RELEASE, "agent");
            asm volatile("s_waitcnt vmcnt(0)" ::: "memory");
            const unsigned og = xb_add(&bar[XB_TOP], 1u);
            const unsigned tg = og / nx;
            if (og + 1u == (tg + 1u) * nx) xb_add(&bar[XB_TOPGEN], 1u);
            else XB_SPIN(xb_ld(&bar[XB_TOPGEN]) == tg, bar);
            __builtin_amdgcn_fence(__ATOMIC_ACQUIRE, "agent");
            xb_add(&bar[XB_XGEN(b.x)], 1u);
            asm volatile("s_waitcnt vmcnt(0)" ::: "memory");
        } else {
            XB_SPIN(xb_ld(&bar[XB_XGEN(b.x)]) == gen, bar);
            __builtin_amdgcn_fence(__ATOMIC_ACQUIRE, "agent");
            asm volatile("s_waitcnt vmcnt(0)" ::: "memory");
        }
    }
    __syncthreads();
}
struct InTab { const LAS unsigned long long* t;
    __device__ __forceinline__ const float* operator[](int k) const { const unsigned long long v = t[k];
        return (const float*)(((unsigned long long)(unsigned)__builtin_amdgcn_readfirstlane((int)(v >> 32)) << 32) | (unsigned)__builtin_amdgcn_readfirstlane((int)(unsigned)v)); } };
struct Frame {
    LAS unsigned char* lds;
    volatile LAS unsigned* MISC;
    gu32* ctl;
    int wave;
    int vcu, G, bx;
    GAS unsigned char* ws;
    InTab in;
    GAS float* out;
    float ts_scale, ts_add;
};
__device__ __forceinline__ float xor_get(float v, int lane, int o) { return __builtin_bit_cast(float, __builtin_amdgcn_ds_bpermute((lane ^ o) << 2, __builtin_bit_cast(int, v))); }
__device__ __forceinline__ float half_sum(float v, int lane) {
#pragma unroll
    for (int o = 1; o < 32; o <<= 1) v += xor_get(v, lane, o);
    return v; }
__device__ __forceinline__ float wave_sum(float v, int lane) { v = half_sum(v, lane); return v + xor_get(v, lane, 32); }
__device__ __forceinline__ int launder(int v) { asm volatile("" : "+v"(v)); return v; }
__device__ __forceinline__ int fresh_lane() { int l; asm volatile("v_mbcnt_lo_u32_b32 %0, -1, 0\n\tv_mbcnt_hi_u32_b32 %0, -1, %0" : "=v"(l)); return l; }
__device__ __forceinline__ float bf_lo(unsigned u) { return __builtin_bit_cast(float, u << 16); }
__device__ __forceinline__ float bf_hi(unsigned u) { return __builtin_bit_cast(float, u & 0xffff0000u); }
#if MK_DBG
__device__ __forceinline__ void dbg_sample_f32(Frame& F, int lane, int slot, int row, const f32x4 (&v)[4]) {
    float* d = (float*)(F.ws + WS_FS) + ((size_t)slot * 1024 + (row >> 5)) * 1024;
#pragma unroll
    for (int j = 0; j < 4; ++j) ((f32x4*)d)[lane + 64 * j] = v[j];
}
#endif
__device__ __forceinline__ int swiglu_row(int n, int ff) { const int bj = n >= ff ? 1 : 0, cc = n - bj * ff; return 256 * (cc >> 7) + 128 * bj + (cc & 127); }
template <bool F8>
__device__ __forceinline__ void transpose_item(const float* W, int K, int N, void* WT, int ff, float scale, LAS float* scr, int item, int lane) {
    const int nblk = N / 64, kb = item / nblk, nb = item % nblk, k0 = 64 * kb, n0 = 64 * nb;
    const int r0 = ff ? swiglu_row(n0, ff) : n0;
    float v[64];
    const GAS float* wp = (const GAS float*)W + (size_t)k0 * N + n0 + lane;
#pragma unroll
    for (int i = 0; i < 64; ++i) v[i] = wp[(size_t)i * N];
#pragma unroll
    for (int i = 0; i < 64; ++i) scr[i * 64 + (lane ^ (i & 31))] = v[i];
    LDS_WAIT(); asm volatile("" ::: "memory");
    const int c = lane & 7;
#pragma unroll
    for (int j = 0; j < 8; ++j) { const int n = (lane >> 3) + 8 * j; float s[8];
#pragma unroll
        for (int i = 0; i < 8; ++i) s[i] = scr[(8 * c + i) * 64 + (n ^ ((8 * c + i) & 31))];
        if (F8) { v2u o; o.x = pg8::pk4_fp8(s[0] * scale, s[1] * scale, s[2] * scale, s[3] * scale); o.y = pg8::pk4_fp8(s[4] * scale, s[5] * scale, s[6] * scale, s[7] * scale);
            *(GAS v2u*)((unsigned char*)WT + (size_t)(r0 + n) * K + k0 + 8 * c) = o; }
        else { v4u o; o.x = pg8::cvt_pk_bf16(s[0], s[1]); o.y = pg8::cvt_pk_bf16(s[2], s[3]); o.z = pg8::cvt_pk_bf16(s[4], s[5]); o.w = pg8::cvt_pk_bf16(s[6], s[7]);
            *(GAS v4u*)((bf16*)WT + (size_t)(r0 + n) * K + k0 + 8 * c) = o; } }
    LDS_WAIT(); asm volatile("" ::: "memory");
}
__device__ __forceinline__ void rms_row_to_bf16(int lane, const float* xrow, const float* gain, bf16* orow) {
    const GAS f32x4* xr = (const GAS f32x4*)xrow + lane;
    f32x4 v[4]; float s = 0.f;
#pragma unroll
    for (int j = 0; j < 4; ++j) { v[j] = xr[64 * j]; s += (v[j].x * v[j].x + v[j].y * v[j].y) + (v[j].z * v[j].z + v[j].w * v[j].w); }
    const float rstd = 1.f / sqrtf(wave_sum(s, lane) * (1.f / D) + EPS);
    GAS unsigned long long* o8 = (GAS unsigned long long*)orow + lane;
#pragma unroll
    for (int j = 0; j < 4; ++j) { const f32x4 g = ((const GAS f32x4*)gain)[lane + 64 * j];
        o8[64 * j] = (unsigned long long)pk2(v[j].x * rstd * g.x, v[j].y * rstd * g.y) | ((unsigned long long)pk2(v[j].z * rstd * g.z, v[j].w * rstd * g.w) << 32); }
}
__device__ __forceinline__ void phase_prologue(Frame& F) {
    const int lane = fresh_lane(), tid = F.wave * 64 + lane; (void)tid;
    LAS float* scr = (LAS float*)(F.lds + RING_OFF + F.wave * 16384);
    const int gw = F.vcu * NWAVES + F.wave, NGW = F.G * NWAVES;
    constexpr int I_AIN = 16 * (AIN / 64), I_MKV = 16 * 8, I_OUT = 16 * 16, I_BIN = 16 * (BIN / 64), I_GUD = 16 * (2 * FFD / 64), I_DND = (FFD / 64) * 16, I_GUM = 16 * (2 * FFE / 64), I_DNM = (FFE / 64) * 16;
    constexpr int NITEMS = 2 * I_AIN + 4 * I_MKV + 4 * I_OUT + 2 * I_BIN + 2 * I_GUD + 2 * I_DND + 16 * I_GUM + 16 * I_DNM;
    for (int it = NITEMS - 1 - gw; it >= 0; it -= NGW) {
        int r = it; const float* src; bf16* dst; int K = D, N, ff = 0;
        if (r < 2 * I_AIN) { const int j = r / I_AIN; r %= I_AIN; N = AIN; src = F.in[3] + (size_t)j * D * AIN; dst = (bf16*)(F.ws + WS_WINA) + (size_t)j * AIN * D; }
        else if ((r -= 2 * I_AIN) < 4 * I_MKV) { const int l = r / I_MKV; r %= I_MKV; N = 512; src = F.in[(l & 1) ? 17 : 10] + (size_t)(l >> 1) * D * 512; dst = (bf16*)(F.ws + WS_WMKV) + (size_t)l * 512 * D; }
        else if ((r -= 4 * I_MKV) < 4 * I_OUT) { const int l = r / I_OUT; r %= I_OUT; N = D; src = F.in[(l & 1) ? 18 : 11] + (size_t)(l >> 1) * D * D; dst = (bf16*)(F.ws + WS_WOUT) + (size_t)l * D * D; }
        else if ((r -= 4 * I_OUT) < 2 * I_BIN) { const int j = r / I_BIN; r %= I_BIN; N = BIN; src = F.in[13] + (size_t)j * D * BIN; dst = (bf16*)(F.ws + WS_WINB) + (size_t)j * BIN * D; }
        else if ((r -= 2 * I_BIN) < 2 * I_GUD) { const int j = r / I_GUD; r %= I_GUD; N = 2 * FFD; ff = FFD; src = F.in[20] + (size_t)j * D * 2 * FFD; dst = (bf16*)(F.ws + WS_WGUD) + (size_t)j * 2 * FFD * D; }
        else if ((r -= 2 * I_GUD) < 2 * I_DND) { const int j = r / I_DND; r %= I_DND; K = FFD; N = D; src = F.in[21] + (size_t)j * FFD * D; dst = (bf16*)(F.ws + WS_WDND) + (size_t)j * D * FFD; }
        else if ((r -= 2 * I_DND) < 16 * I_GUM) { const int j = r / I_GUM; r %= I_GUM;
            transpose_item<true>(F.in[24] + (size_t)j * D * 2 * FFE, D, 2 * FFE, (void*)(F.ws + WS_WGUM + (size_t)j * 2 * FFE * D), FFE, SC_WGU, scr, r, lane); continue; }
        else { r -= 16 * I_GUM; const int j = r / I_DNM; r %= I_DNM;
            transpose_item<true>(F.in[25] + (size_t)j * FFE * D, FFE, D, (void*)(F.ws + WS_WDNM + (size_t)j * D * FFE), 0, SC_WDN, scr, r, lane); continue; }
        transpose_item<false>(src, K, N, dst, ff, 1.f, scr, r, lane);
    }
    for (int m = gw; m < 4 * NB * MEML; m += NGW) { const int l = m / (NB * MEML), r = m % (NB * MEML);
        rms_row_to_bf16(lane, F.in[1] + (size_t)r * D, F.in[(l & 1) ? 16 : 9] + (size_t)(l >> 1) * D, (bf16*)(F.ws + WS_MEMN) + (size_t)m * D); }
    for (int m = gw; m < T; m += NGW) rms_row_to_bf16(lane, F.in[0] + (size_t)m * D, F.in[2], (bf16*)(F.ws + WS_XN) + (size_t)m * D);
    if (F.bx == 0) { float* LBT = (float*)(F.ws + WS_ROUTE + 1024 * 1024);
        for (int i = tid; i < DAW; i += NWAVES * 64) { LBT[i] = 0.f; LBT[DAW + i] = 1.f / (1.f + __expf(F.in[14][i] - F.in[14][DAW + i])); } }
}
template <bool COMBINE, bool ROUTER, bool FINAL>
__device__ __forceinline__ void phase_norm(Frame& F, const float* src, float* X, const float* gain, const float* wr, gu32* gcnt, int dbg_slot) {
    const int lane = fresh_lane(), tid = F.wave * 64 + lane; (void)tid;
    bf16* XN = (bf16*)(F.ws + WS_XN); const bf16* Y = (const bf16*)(F.ws + WS_Y);
    float* TOPW = (float*)(F.ws + WS_ROUTE); int* TOKSEL = (int*)(F.ws + WS_ROUTE + 256 * 1024); const int* TOKROW = (const int*)(F.ws + WS_ROUTE + 768 * 1024);
    LAS int* cntL = (LAS int*)(F.lds + RING_OFF); LAS int* baseL = cntL + 8; LAS int* sel = cntL + 16;
    if (ROUTER) { if (tid < 8) cntL[tid] = 0; __syncthreads(); }
    for (int rb = F.bx * 128; rb < T; rb += F.G * 128) {
        int ri0 = 0, ri1 = 0; float rw0 = 0.f, rw1 = 0.f;
        if (COMBINE && lane < 16) { const int rr = rb + F.wave * 16 + lane; ri0 = TOKROW[rr * 2]; ri1 = TOKROW[rr * 2 + 1]; rw0 = TOPW[rr * 2]; rw1 = TOPW[rr * 2 + 1]; }
        f32x4 vq[2][4]; v2u yq0[2][4], yq1[2][4];
#define NORM_ISSUE(B_, I_) do { const int row_ = rb + F.wave * 16 + (I_); const GAS f32x4* xr_ = (const GAS f32x4*)(src + (size_t)row_ * D) + lane; \
            _Pragma("unroll") for (int j = 0; j < 4; ++j) vq[B_][j] = xr_[64 * j]; \
            if (COMBINE) { const int r0_ = __builtin_amdgcn_readlane(ri0, (I_)), r1_ = __builtin_amdgcn_readlane(ri1, (I_)); \
                const GAS v2u* y0_ = (const GAS v2u*)(Y + (size_t)r0_ * D) + lane; const GAS v2u* y1_ = (const GAS v2u*)(Y + (size_t)r1_ * D) + lane; \
                _Pragma("unroll") for (int j = 0; j < 4; ++j) { yq0[B_][j] = y0_[64 * j]; yq1[B_][j] = y1_[64 * j]; } } } while (0)
        NORM_ISSUE(0, 0);
        for (int i2 = 0; i2 < 16; i2 += 2) {
#pragma unroll
          for (int hb = 0; hb < 2; ++hb) {
            const int i = i2 + hb;
            if (hb == 0) NORM_ISSUE(1, i + 1); else if (i + 1 < 16) NORM_ISSUE(0, i + 1);
            const int rl = F.wave * 16 + i, row = rb + rl;
            f32x4 v[4];
#pragma unroll
            for (int j = 0; j < 4; ++j) v[j] = vq[hb][j];
            if (COMBINE) {
                const float w0 = __builtin_bit_cast(float, __builtin_amdgcn_readlane(__builtin_bit_cast(int, rw0), i)), w1 = __builtin_bit_cast(float, __builtin_amdgcn_readlane(__builtin_bit_cast(int, rw1), i));
#pragma unroll
                for (int j = 0; j < 4; ++j) { const v2u a = yq0[hb][j], b = yq1[hb][j];
                    v[j].x += w0 * bf_lo(a.x) + w1 * bf_lo(b.x); v[j].y += w0 * bf_hi(a.x) + w1 * bf_hi(b.x); v[j].z += w0 * bf_lo(a.y) + w1 * bf_lo(b.y); v[j].w += w0 * bf_hi(a.y) + w1 * bf_hi(b.y); }
                if (!FINAL) { GAS f32x4* xw = (GAS f32x4*)(X + (size_t)row * D) + lane;
#pragma unroll
                    for (int j = 0; j < 4; ++j) xw[64 * j] = v[j]; }
            }
#if MK_DBG
            if (dbg_slot >= 0 && (row & 31) == 0) dbg_sample_f32(F, lane, dbg_slot, row, v);
#endif
            float s = 0.f;
#pragma unroll
            for (int j = 0; j < 4; ++j) s += (v[j].x * v[j].x + v[j].y * v[j].y) + (v[j].z * v[j].z + v[j].w * v[j].w);
            const float rstd = 1.f / sqrtf(wave_sum(s, lane) * (1.f / D) + EPS);
#pragma unroll
            for (int j = 0; j < 4; ++j) { const f32x4 g = ((const GAS f32x4*)gain)[lane + 64 * j]; v[j].x *= rstd * g.x; v[j].y *= rstd * g.y; v[j].z *= rstd * g.z; v[j].w *= rstd * g.w; }
            if (FINAL) { GAS f32x4* ow = (GAS f32x4*)(X + (size_t)row * D) + lane;
#pragma unroll
                for (int j = 0; j < 4; ++j) ow[64 * j] = v[j];
            } else { GAS unsigned long long* o8 = (GAS unsigned long long*)(XN + (size_t)row * D) + lane;
#pragma unroll
                for (int j = 0; j < 4; ++j) o8[64 * j] = (unsigned long long)pk2(v[j].x, v[j].y) | ((unsigned long long)pk2(v[j].z, v[j].w) << 32); }
            if (ROUTER) {
                float a[8];
#pragma unroll
                for (int e = 0; e < 8; ++e) a[e] = 0.f;
#pragma unroll
                for (int j = 0; j < 4; ++j) { const GAS f32x4* wp = (const GAS f32x4*)(wr + (size_t)(lane + 64 * j) * 32);
#pragma unroll
                    for (int c = 0; c < 4; ++c) { const float xv = v[j][c]; const f32x4 w0 = wp[2 * c], w1 = wp[2 * c + 1];
                        a[0] += xv * w0.x; a[1] += xv * w0.y; a[2] += xv * w0.z; a[3] += xv * w0.w; a[4] += xv * w1.x; a[5] += xv * w1.y; a[6] += xv * w1.z; a[7] += xv * w1.w; } }
#pragma unroll
                for (int e = 0; e < 8; ++e) a[e] = wave_sum(a[e], lane);
                if (lane == 0) {
                    int e0 = 0; float v0 = a[0];
#pragma unroll
                    for (int e = 1; e < 8; ++e) if (a[e] > v0) { v0 = a[e]; e0 = e; }
                    int e1 = 0; float v1 = -3.0e38f;
#pragma unroll
                    for (int e = 0; e < 8; ++e) if (e != e0 && a[e] > v1) { v1 = a[e]; e1 = e; }
                    const float p1 = __expf(v1 - v0), inv = 1.f / (1.f + p1);
                    TOPW[row * 2] = inv; TOPW[row * 2 + 1] = p1 * inv;
                    const int q0 = __hip_atomic_fetch_add(cntL + e0, 1, __ATOMIC_RELAXED, __HIP_MEMORY_SCOPE_WORKGROUP);
                    const int q1 = __hip_atomic_fetch_add(cntL + e1, 1, __ATOMIC_RELAXED, __HIP_MEMORY_SCOPE_WORKGROUP);
                    sel[rl * 4] = e0; sel[rl * 4 + 1] = q0; sel[rl * 4 + 2] = e1; sel[rl * 4 + 3] = q1;
                }
            }
          }
        }
#undef NORM_ISSUE
        if (ROUTER) {
            __syncthreads();
            if (tid < 8) { baseL[tid] = (int)__hip_atomic_fetch_add(gcnt + tid, (unsigned)cntL[tid], __ATOMIC_RELAXED, __HIP_MEMORY_SCOPE_AGENT); }
            __syncthreads();
            if (tid < 128) { const int e0 = sel[tid * 4], e1 = sel[tid * 4 + 2]; int4 o; o.x = e0; o.y = baseL[e0] + sel[tid * 4 + 1]; o.z = e1; o.w = baseL[e1] + sel[tid * 4 + 3];
                *(int4*)(TOKSEL + (size_t)(rb + tid) * 4) = o; }
            __syncthreads();
            if (tid < 8) cntL[tid] = 0;
            __syncthreads();
        }
    }
}
__device__ __forceinline__ void phase_router(Frame& F, const float* src, const float* gain, const float* wr, gu32* gcnt, int dbg_slot) {
    const int lane = fresh_lane(), tid = F.wave * 64 + lane;
    bf16* XN = (bf16*)(F.ws + WS_XN); float* TOPW = (float*)(F.ws + WS_ROUTE); int* TOKSEL = (int*)(F.ws + WS_ROUTE + 256 * 1024);
    LAS int* cntL = (LAS int*)(F.lds + RING_OFF); LAS int* baseL = cntL + 8; LAS float* lg = (LAS float*)(cntL + 16);
    if (tid < 8) cntL[tid] = 0;
    __syncthreads();
    for (int rb = F.bx * 128; rb < T; rb += F.G * 128) {
        for (int g4 = 0; g4 < 4; ++g4) {
            const int rl0 = F.wave * 16 + 4 * g4, row0 = rb + rl0;
            f32x4 v[4][4];
#pragma unroll
            for (int r = 0; r < 4; ++r) { const GAS f32x4* xr = (const GAS f32x4*)(src + (size_t)(row0 + r) * D) + lane;
#pragma unroll
                for (int j = 0; j < 4; ++j) v[r][j] = xr[64 * j]; }
#if MK_DBG
#pragma unroll
            for (int r = 0; r < 4; ++r) if (dbg_slot >= 0 && ((row0 + r) & 31) == 0) dbg_sample_f32(F, lane, dbg_slot, row0 + r, v[r]);
#endif
            float ss[4];
#pragma unroll
            for (int r = 0; r < 4; ++r) { float s = 0.f;
#pragma unroll
                for (int j = 0; j < 4; ++j) s += (v[r][j].x * v[r][j].x + v[r][j].y * v[r][j].y) + (v[r][j].z * v[r][j].z + v[r][j].w * v[r][j].w);
                ss[r] = s; }
#pragma unroll
            for (int o = 1; o < 64; o <<= 1) {
#pragma unroll
                for (int r = 0; r < 4; ++r) ss[r] += xor_get(ss[r], lane, o); }
#pragma unroll
            for (int r = 0; r < 4; ++r) { const float rstd = 1.f / sqrtf(ss[r] * (1.f / D) + EPS);
                GAS unsigned long long* o8 = (GAS unsigned long long*)(XN + (size_t)(row0 + r) * D) + lane;
#pragma unroll
                for (int j = 0; j < 4; ++j) { const f32x4 gg = ((const GAS f32x4*)gain)[lane + 64 * j]; v[r][j].x *= rstd * gg.x; v[r][j].y *= rstd * gg.y; v[r][j].z *= rstd * gg.z; v[r][j].w *= rstd * gg.w;
                    o8[64 * j] = (unsigned long long)pk2(v[r][j].x, v[r][j].y) | ((unsigned long long)pk2(v[r][j].z, v[r][j].w) << 32); } }
            float a[32];
#pragma unroll
            for (int i = 0; i < 32; ++i) a[i] = 0.f;
#pragma unroll
            for (int j = 0; j < 4; ++j) { const GAS f32x4* wp = (const GAS f32x4*)(wr + (size_t)(lane + 64 * j) * 32);
#pragma unroll
                for (int c = 0; c < 4; ++c) { const f32x4 w0 = wp[2 * c], w1 = wp[2 * c + 1];
#pragma unroll
                    for (int r = 0; r < 4; ++r) { const float xv = v[r][j][c];
                        a[r * 8 + 0] += xv * w0.x; a[r * 8 + 1] += xv * w0.y; a[r * 8 + 2] += xv * w0.z; a[r * 8 + 3] += xv * w0.w; a[r * 8 + 4] += xv * w1.x; a[r * 8 + 5] += xv * w1.y; a[r * 8 + 6] += xv * w1.z; a[r * 8 + 7] += xv * w1.w; } } }
#define RT_STEP(S_, N_) do { const bool up_ = (lane >> (S_)) & 1; _Pragma("unroll") for (int i = 0; i < (N_); ++i) { const float keep_ = up_ ? a[2 * i + 1] : a[2 * i], send_ = up_ ? a[2 * i] : a[2 * i + 1]; a[i] = keep_ + xor_get(send_, lane, 1 << (S_)); } } while (0)
            RT_STEP(0, 16); RT_STEP(1, 8); RT_STEP(2, 4); RT_STEP(3, 2); RT_STEP(4, 1);
#undef RT_STEP
            const float lgv = a[0] + xor_get(a[0], lane, 32);
            if (lane < 32) lg[(rl0 + (lane >> 3)) * 8 + (lane & 7)] = lgv;
        }
        __syncthreads();
        int e0 = 0, e1 = 0, q0 = 0, q1 = 0;
        if (tid < 128) { float av[8];
#pragma unroll
            for (int e = 0; e < 8; ++e) av[e] = lg[tid * 8 + e];
            float v0 = av[0];
#pragma unroll
            for (int e = 1; e < 8; ++e) if (av[e] > v0) { v0 = av[e]; e0 = e; }
            float v1 = -3.0e38f;
#pragma unroll
            for (int e = 0; e < 8; ++e) if (e != e0 && av[e] > v1) { v1 = av[e]; e1 = e; }
            const float p1 = __expf(v1 - v0), inv = 1.f / (1.f + p1);
            TOPW[(rb + tid) * 2] = inv; TOPW[(rb + tid) * 2 + 1] = p1 * inv;
            q0 = __hip_atomic_fetch_add(cntL + e0, 1, __ATOMIC_RELAXED, __HIP_MEMORY_SCOPE_WORKGROUP);
            q1 = __hip_atomic_fetch_add(cntL + e1, 1, __ATOMIC_RELAXED, __HIP_MEMORY_SCOPE_WORKGROUP); }
        __syncthreads();
        if (tid < 8) { baseL[tid] = (int)__hip_atomic_fetch_add(gcnt + tid, (unsigned)cntL[tid], __ATOMIC_RELAXED, __HIP_MEMORY_SCOPE_AGENT); }
        __syncthreads();
        if (tid < 128) { int4 o; o.x = e0; o.y = baseL[e0] + q0; o.z = e1; o.w = baseL[e1] + q1; *(int4*)(TOKSEL + (size_t)(rb + tid) * 4) = o; }
        __syncthreads();
        if (tid < 8) cntL[tid] = 0;
        __syncthreads();
    }
}
__device__ __forceinline__ void phase_gather(Frame& F, const gu32* gcnt) {
    const int lane = fresh_lane(), tid = F.wave * 64 + lane; (void)tid;
    const bf16* XN = (const bf16*)(F.ws + WS_XN); unsigned char* XG = (unsigned char*)(F.ws + WS_XG);
    const int* TOKSEL = (const int*)(F.ws + WS_ROUTE + 256 * 1024); int* TOKROW = (int*)(F.ws + WS_ROUTE + 768 * 1024);
    int rbase[8]; { int t = 0;
#pragma unroll
        for (int e = 0; e < 8; ++e) { rbase[e] = t * 256; t += (__builtin_amdgcn_readfirstlane((int)__hip_atomic_load(gcnt + e, RLX_AGENT)) + 255) >> 8; } }
    const int gw = F.bx * NWAVES + F.wave, NGW = F.G * NWAVES;
    for (int row = gw; row < T; row += NGW) {
        const int4 sl = *(const int4*)(TOKSEL + (size_t)row * 4);
        int d0 = sl.y, d1 = sl.w;
#pragma unroll
        for (int e = 0; e < 8; ++e) { if (sl.x == e) d0 += rbase[e]; if (sl.z == e) d1 += rbase[e]; }
        const GAS v4u* s = (const GAS v4u*)(XN + (size_t)row * D) + 2 * lane;
        const v4u a = s[0], b = s[1];
        v4u o; o.x = pg8::pk4_fp8(bf_lo(a.x) * SC_X, bf_hi(a.x) * SC_X, bf_lo(a.y) * SC_X, bf_hi(a.y) * SC_X); o.y = pg8::pk4_fp8(bf_lo(a.z) * SC_X, bf_hi(a.z) * SC_X, bf_lo(a.w) * SC_X, bf_hi(a.w) * SC_X);
        o.z = pg8::pk4_fp8(bf_lo(b.x) * SC_X, bf_hi(b.x) * SC_X, bf_lo(b.y) * SC_X, bf_hi(b.y) * SC_X); o.w = pg8::pk4_fp8(bf_lo(b.z) * SC_X, bf_hi(b.z) * SC_X, bf_lo(b.w) * SC_X, bf_hi(b.w) * SC_X);
        ((GAS v4u*)(XG + (size_t)d0 * D))[lane] = o; ((GAS v4u*)(XG + (size_t)d1 * D))[lane] = o;
        if (lane == 0) { TOKROW[row * 2] = d0; TOKROW[row * 2 + 1] = d1; }
    }
}
__device__ __forceinline__ void phase_knorm(Frame& F) {
    const int lane = fresh_lane();
    const bf16* P = (const bf16*)(F.ws + WS_BIG); float* N2 = (float*)(F.ws + WS_ROUTE + 1024 * 1024 + 8192);
    const int gw = F.bx * NWAVES + F.wave, NGW = F.G * NWAVES;
    for (int it = gw; it < NB * 24 * 64; it += NGW) { const int t = it & 63, hm = (it >> 6) % 24, b = it / (24 * 64);
        const GAS v4u* rp = (const GAS v4u*)(P + (size_t)(b * S + 64 * t + lane) * AIN + hm * 64); float ss = 0.f;
#pragma unroll
        for (int i = 0; i < 8; ++i) { const v4u w = rp[i]; const unsigned ww[4] = {w.x, w.y, w.z, w.w};
#pragma unroll
            for (int c = 0; c < 4; ++c) { const float a = bf_lo(ww[c]), b2 = bf_hi(ww[c]); ss += a * a + b2 * b2; } }
#pragma unroll
        for (int o = 1; o < 64; o <<= 1) ss = fmaxf(ss, xor_get(ss, lane, o));
        if (lane == 0) N2[it] = ss; }
}
__device__ __forceinline__ void phase_diff_combine(Frame& F, int j, float lam_init) {
    const int lane = fresh_lane(), tid = F.wave * 64 + lane; (void)tid;
    const bf16* O0 = (const bf16*)(F.ws + WS_BIG + 160 * MiB); const bf16* O1 = O0 + (size_t)T * DAW; bf16* OC = (bf16*)(F.ws + WS_OC);
    const float s1 = wave_sum(F.in[4][j * 64 + lane] * F.in[5][j * 64 + lane], lane), s2 = wave_sum(F.in[6][j * 64 + lane] * F.in[7][j * 64 + lane], lane);
    const float lam = __expf(s1) - __expf(s2) + lam_init;
    const f32x4 g = *(const GAS f32x4*)(F.in[8] + j * 128 + (lane & 31) * 4);
    const int gw = F.bx * NWAVES + F.wave, NGW = F.G * NWAVES;
    for (int row0 = gw * 4; row0 < T; row0 += NGW * 4) {
        v2u a[4][3], b[4][3];
#pragma unroll
        for (int r = 0; r < 4; ++r)
#pragma unroll
            for (int jj = 0; jj < 3; ++jj) { a[r][jj] = ((const GAS v2u*)(O0 + (size_t)(row0 + r) * DAW))[lane + 64 * jj]; b[r][jj] = ((const GAS v2u*)(O1 + (size_t)(row0 + r) * DAW))[lane + 64 * jj]; }
#pragma unroll
        for (int r = 0; r < 4; ++r)
#pragma unroll
            for (int jj = 0; jj < 3; ++jj) {
                f32x4 v; v.x = bf_lo(a[r][jj].x) - lam * bf_lo(b[r][jj].x); v.y = bf_hi(a[r][jj].x) - lam * bf_hi(b[r][jj].x); v.z = bf_lo(a[r][jj].y) - lam * bf_lo(b[r][jj].y); v.w = bf_hi(a[r][jj].y) - lam * bf_hi(b[r][jj].y);
                float ss = (v.x * v.x + v.y * v.y) + (v.z * v.z + v.w * v.w);
                ss = half_sum(ss, lane);
                const float rs = (1.f / sqrtf(ss * (1.f / 128.f) + EPS)) * (1.f - lam_init);
                ((GAS unsigned long long*)(OC + (size_t)(row0 + r) * D))[lane + 64 * jj] = (unsigned long long)pk2(v.x * rs * g.x, v.y * rs * g.y) | ((unsigned long long)pk2(v.z * rs * g.z, v.w * rs * g.w) << 32);
            }
    }
}
__device__ __forceinline__ void phase_hgrn_naive(Frame& F, int j) {
    const int lane = fresh_lane(), tid = F.wave * 64 + lane; (void)tid;
    const bf16* PB = (const bf16*)(F.ws + WS_BIG); const float* FZ = (const float*)(F.ws + WS_BIG + 208 * MiB); float* HO = (float*)(F.ws + WS_BIG + 304 * MiB);
    if (F.bx * 4 >= NB * 6) return;
    const int grp = tid >> 7, t128 = tid & 127, bh = F.bx * 4 + grp, b = bh / 6, h = bh % 6;
    LAS float* sq = (LAS float*)(F.lds + RING_OFF) + grp * (3 * 16 * 128); LAS float* sf = sq + 16 * 128; LAS float* sk = sf + 16 * 128;
    float lb = 0.f;
    if (j == 1) { const float l0 = F.in[14][h * 128 + t128], l1 = F.in[14][768 + h * 128 + t128]; lb = 1.f / (1.f + __expf(l0 - l1)); }
    float St[128];
#pragma unroll
    for (int k = 0; k < 128; ++k) St[k] = 0.f;
    for (int t0 = 0; t0 < S; t0 += 16) {
        __syncthreads();
        for (int jj = 0; jj < 16; ++jj) { const size_t row = (size_t)(b * S + t0 + jj);
            const float qv = bf_lo((unsigned)PB[row * BIN + h * 128 + t128]), fz = FZ[row * DAW + h * 128 + t128];
            const float f = lb + (1.f - lb) / (1.f + __expf(-fz));
            sq[jj * 128 + t128] = qv; sf[jj * 128 + t128] = f; sk[jj * 128 + t128] = 1.f - f; }
        __syncthreads();
        for (int jj = 0; jj < 16; ++jj) { const size_t row = (size_t)(b * S + t0 + jj);
            const float v = bf_lo((unsigned)PB[row * BIN + 1536 + h * 128 + t128]);
            float o = 0.f;
#pragma unroll
            for (int k = 0; k < 128; k += 4) { const f32x4 f4 = *(const LAS f32x4*)(sf + jj * 128 + k), k4 = *(const LAS f32x4*)(sk + jj * 128 + k), q4 = *(const LAS f32x4*)(sq + jj * 128 + k);
                St[k] = f4.x * St[k] + k4.x * v; o += q4.x * St[k]; St[k + 1] = f4.y * St[k + 1] + k4.y * v; o += q4.y * St[k + 1];
                St[k + 2] = f4.z * St[k + 2] + k4.z * v; o += q4.z * St[k + 2]; St[k + 3] = f4.w * St[k + 3] + k4.w * v; o += q4.w * St[k + 3]; }
            HO[row * DAW + h * 128 + t128] = o; }
    }
    __syncthreads();
}
__device__ __forceinline__ void phase_hgrn_out(Frame& F, int j) {
    const int lane = fresh_lane(), tid = F.wave * 64 + lane; (void)tid;
    const bf16* PB = (const bf16*)(F.ws + WS_BIG); const float* HO = (const float*)(F.ws + WS_BIG + 304 * MiB); bf16* OC = (bf16*)(F.ws + WS_OC);
    const f32x4 g = *(const GAS f32x4*)(F.in[15] + j * 128 + (lane & 31) * 4);
    const int gw = F.bx * NWAVES + F.wave, NGW = F.G * NWAVES;
    for (int row = gw; row < T; row += NGW) {
#pragma unroll
        for (int jj = 0; jj < 3; ++jj) {
            const f32x4 v = ((const GAS f32x4*)(HO + (size_t)row * DAW))[lane + 64 * jj];
            const v2u gt = ((const GAS v2u*)(PB + (size_t)row * BIN + 2304))[lane + 64 * jj];
            float ss = (v.x * v.x + v.y * v.y) + (v.z * v.z + v.w * v.w);
            ss = half_sum(ss, lane);
            const float rs = 1.f / sqrtf(ss * (1.f / 128.f) + EPS);
            ((GAS unsigned long long*)(OC + (size_t)row * D))[lane + 64 * jj] =
                (unsigned long long)pk2(v.x * rs * g.x * pg8::silu_f(bf_lo(gt.x)), v.y * rs * g.y * pg8::silu_f(bf_hi(gt.x))) | ((unsigned long long)pk2(v.z * rs * g.z * pg8::silu_f(bf_lo(gt.y)), v.w * rs * g.w * pg8::silu_f(bf_hi(gt.y))) << 32);
        }
    }
}
constexpr int HG_LD = 136, HG_LS = 72;
constexpr int HL_QB = 0, HL_QT = 17408, HL_K = 34816, HL_VT = 78336, HL_PM = 96768, HL_TOT = 105984, HL_SSQ = 110080;
constexpr size_t WS_DCH = WS_SIN + 96 * MiB;
typedef short hbf16x8 __attribute__((ext_vector_type(8)));
typedef float hf32x2 __attribute__((ext_vector_type(2)));
__device__ __forceinline__ hbf16x8 lds8(const LAS unsigned short* p) { return *(const LAS hbf16x8*)p; }
__device__ __forceinline__ float ex2(float v) { return __builtin_amdgcn_exp2f(v); }
template <int PASS>
__device__ __forceinline__ void hgrn_load(Frame& F, int tid, int unit, hf32x2 (&lf)[8], unsigned (&qw)[8], v4u& va, v4u& vb) {
    const bf16* PB = (const bf16*)(F.ws + WS_BIG); const float* LF = (const float*)(F.ws + WS_BIG + 208 * MiB);
    const int kp = tid & 63, wave = __builtin_amdgcn_readfirstlane(tid >> 6), I = wave & 3, hf = wave >> 2, r0 = 16 * I + 8 * hf;
    const int bh = unit >> 6, c = unit & 63, b = bh / 6, h = bh % 6;
    const size_t tok0 = (size_t)b * S + c * 64;
#pragma unroll
    for (int jj = 0; jj < 8; ++jj) lf[jj] = *(const GAS hf32x2*)(LF + (tok0 + r0 + jj) * DAW + h * 128 + 2 * kp);
    if (PASS == 3) {
#pragma unroll
        for (int jj = 0; jj < 8; ++jj) qw[jj] = *(const GAS unsigned*)(PB + (tok0 + r0 + jj) * BIN + h * 128 + 2 * kp); }
    { const int sp = tid >> 4, e8 = (tid & 15) * 8; va = *(const GAS v4u*)(PB + (tok0 + 2 * sp) * BIN + 1536 + h * 128 + e8); vb = *(const GAS v4u*)(PB + (tok0 + 2 * sp + 1) * BIN + 1536 + h * 128 + e8); }
}
template <int PASS>
__device__ __forceinline__ void hgrn_unit(Frame& F, int tid, int unit, int nunit, int j, hf32x2 (&lf)[8], unsigned (&qw)[8], v4u& va, v4u& vb) {
    const bf16* PB = (const bf16*)(F.ws + WS_BIG); const float* LF = (const float*)(F.ws + WS_BIG + 208 * MiB);
    bf16* SLOC = (bf16*)(F.ws + WS_SLOC); const bf16* SIN = (const bf16*)(F.ws + WS_SIN); float* DCH = (float*)(F.ws + WS_DCH); bf16* OC = (bf16*)(F.ws + WS_OC);
    LAS unsigned short* QB = (LAS unsigned short*)(F.lds + HL_QB); LAS unsigned short* QT = (LAS unsigned short*)(F.lds + HL_QT); LAS unsigned short* KK = (LAS unsigned short*)(F.lds + HL_K);
    LAS unsigned short* VT = (LAS unsigned short*)(F.lds + HL_VT); LAS unsigned short* PM = (LAS unsigned short*)(F.lds + HL_PM); LAS float* TOT = (LAS float*)(F.lds + HL_TOT); LAS float* SSQ = (LAS float*)(F.lds + HL_SSQ);
    const int kp = tid & 63, lane = kp, wave = __builtin_amdgcn_readfirstlane(tid >> 6), I = wave & 3, hf = wave >> 2, sub = 2 * I + hf, r0 = 16 * I + 8 * hf, fr = lane & 15, fg = lane >> 4;
    const int bh = unit >> 6, c = unit & 63, b = bh / 6, h = bh % 6;
    const size_t tok0 = (size_t)b * S + c * 64;
    { const int sp = tid >> 4, e8 = (tid & 15) * 8; const v4u a = va, b2 = vb;
        const unsigned wa[4] = {a.x, a.y, a.z, a.w}, wb[4] = {b2.x, b2.y, b2.z, b2.w};
#pragma unroll
        for (int i = 0; i < 4; ++i) { *(LAS unsigned*)(VT + (e8 + 2 * i) * HG_LS + 2 * sp) = (wa[i] & 0xffffu) | (wb[i] << 16); *(LAS unsigned*)(VT + (e8 + 2 * i + 1) * HG_LS + 2 * sp) = (wa[i] >> 16) | (wb[i] & 0xffff0000u); } }
    hf32x2 cs[8]; { hf32x2 run = {0.f, 0.f};
#pragma unroll
        for (int jj = 0; jj < 8; ++jj) { run += lf[jj]; cs[jj] = run; } }
    *(LAS hf32x2*)(TOT + sub * 128 + 2 * kp) = cs[7];
    __syncthreads();
    hf32x2 rho = {0.f, 0.f}, presub = {0.f, 0.f}, blast = {0.f, 0.f};
#pragma unroll
    for (int s2 = 0; s2 < 8; ++s2) { const hf32x2 t = *(const LAS hf32x2*)(TOT + s2 * 128 + 2 * kp); if (s2 < 2 * I) rho += t; if (s2 < sub) presub += t; blast += t; }
    const hf32x2 off = presub - rho;
    if (PASS == 1) {
        unsigned w0[4], w1[4];
#pragma unroll
        for (int i = 0; i < 4; ++i) { const hf32x2 ba = rho + off + cs[2 * i], bb = rho + off + cs[2 * i + 1];
            w0[i] = pg8::cvt_pk_bf16((1.f - ex2(lf[2 * i].x)) * ex2(blast.x - ba.x), (1.f - ex2(lf[2 * i + 1].x)) * ex2(blast.x - bb.x));
            w1[i] = pg8::cvt_pk_bf16((1.f - ex2(lf[2 * i].y)) * ex2(blast.y - ba.y), (1.f - ex2(lf[2 * i + 1].y)) * ex2(blast.y - bb.y)); }
        *(LAS v4u*)(KK + (2 * kp) * HG_LS + r0) = (v4u){w0[0], w0[1], w0[2], w0[3]}; *(LAS v4u*)(KK + (2 * kp + 1) * HG_LS + r0) = (v4u){w1[0], w1[1], w1[2], w1[3]};
        if (sub == 0) *(GAS hf32x2*)(DCH + (size_t)unit * 128 + 2 * kp) = (hf32x2){ex2(blast.x), ex2(blast.y)};
        __syncthreads();
        if (nunit >= 0) hgrn_load<PASS>(F, tid, nunit, lf, qw, va, vb);
        const hbf16x8 a0 = lds8(KK + (16 * wave + fr) * HG_LS + 8 * fg), a1 = lds8(KK + (16 * wave + fr) * HG_LS + 32 + 8 * fg);
#pragma unroll
        for (int et = 0; et < 8; ++et) { const hbf16x8 b0 = lds8(VT + (16 * et + fr) * HG_LS + 8 * fg), b1 = lds8(VT + (16 * et + fr) * HG_LS + 32 + 8 * fg);
            f32x4 d = {0.f, 0.f, 0.f, 0.f}; d = __builtin_amdgcn_mfma_f32_16x16x32_bf16(a0, b0, d, 0, 0, 0); d = __builtin_amdgcn_mfma_f32_16x16x32_bf16(a1, b1, d, 0, 0, 0);
            v2u w2; w2.x = pk2(d[0], d[1]); w2.y = pk2(d[2], d[3]);
            *(GAS v2u*)(SLOC + ((size_t)unit * 128 + 16 * et + fr) * 128 + 16 * wave + 4 * fg) = w2; }
        __syncthreads();
    } else {
        const hf32x2 er = {ex2(rho.x), ex2(rho.y)};
        hf32x2 base[8];
#pragma unroll
        for (int jj = 0; jj < 8; ++jj) { const hf32x2 bl = off + cs[jj]; const hf32x2 e = {ex2(bl.x), ex2(bl.y)}; const hf32x2 q = {bf_lo(qw[jj]), bf_hi(qw[jj])}; const hf32x2 qt = q * e, qb = qt * er;
            *(LAS unsigned*)(QT + (r0 + jj) * HG_LD + 2 * kp) = pg8::cvt_pk_bf16(qt.x, qt.y); *(LAS unsigned*)(QB + (r0 + jj) * HG_LD + 2 * kp) = pg8::cvt_pk_bf16(qb.x, qb.y);
            base[jj] = (hf32x2){(1.f - ex2(lf[jj].x)) * ex2(-bl.x), (1.f - ex2(lf[jj].y)) * ex2(-bl.y)}; }
        hf32x2 rr = {0.f, 0.f};
        for (int Ip = I; Ip < 4; ++Ip) { LAS unsigned short* Kp = KK + (8 * Ip * (Ip + 1)) * HG_LD;
            const hf32x2 sc = {ex2(rr.x), ex2(rr.y)};
#pragma unroll
            for (int jj = 0; jj < 8; ++jj) { const hf32x2 kv = base[jj] * sc; *(LAS unsigned*)(Kp + (r0 + jj) * HG_LD + 2 * kp) = pg8::cvt_pk_bf16(kv.x, kv.y); }
            rr += *(const LAS hf32x2*)(TOT + (2 * Ip) * 128 + 2 * kp) + *(const LAS hf32x2*)(TOT + (2 * Ip + 1) * 128 + 2 * kp); }
        __syncthreads();
        const int tt = wave & 3, eh = wave >> 2; const size_t tok = tok0 + 16 * tt + fr;
        hbf16x8 sfr[4][4]; v2u gtv[4];
#pragma unroll
        for (int et = 0; et < 4; ++et) { const int e0 = 64 * eh + 16 * et; const GAS hbf16x8* sp = (const GAS hbf16x8*)(SIN + ((size_t)unit * 128 + e0 + fr) * 128 + 8 * fg);
#pragma unroll
            for (int ks = 0; ks < 4; ++ks) sfr[et][ks] = sp[4 * ks];
            gtv[et] = *(const GAS v2u*)(PB + tok * BIN + 2304 + h * 128 + e0 + 4 * fg); }
        if (nunit >= 0) hgrn_load<PASS>(F, tid, nunit, lf, qw, va, vb);
        { const int It = wave >> 1; const LAS unsigned short* Kp = KK + (8 * It * (It + 1)) * HG_LD;
#pragma unroll
            for (int jt = 0; jt < 2; ++jt) { const int J = 2 * (wave & 1) + jt; f32x4 d = {0.f, 0.f, 0.f, 0.f};
                if (J <= It) {
#pragma unroll
                    for (int ks = 0; ks < 4; ++ks) d = __builtin_amdgcn_mfma_f32_16x16x32_bf16(lds8(QT + (16 * It + fr) * HG_LD + 32 * ks + 8 * fg), lds8(Kp + (16 * J + fr) * HG_LD + 32 * ks + 8 * fg), d, 0, 0, 0);
                    if (J == It) {
#pragma unroll
                        for (int i = 0; i < 4; ++i) if (fr > 4 * fg + i) d[i] = 0.f; }
                }
#pragma unroll
                for (int i = 0; i < 4; ++i) PM[(16 * It + 4 * fg + i) * HG_LS + 16 * J + fr] = (unsigned short)f2bf(d[i]); } }
        __syncthreads();
        f32x4 o[4];
        const hbf16x8 p0 = lds8(PM + (16 * tt + fr) * HG_LS + 8 * fg), p1 = lds8(PM + (16 * tt + fr) * HG_LS + 32 + 8 * fg);
        hbf16x8 qb[4];
#pragma unroll
        for (int ks = 0; ks < 4; ++ks) qb[ks] = lds8(QB + (16 * tt + fr) * HG_LD + 32 * ks + 8 * fg);
        float ss = 0.f;
#pragma unroll
        for (int et = 0; et < 4; ++et) { const int e0 = 64 * eh + 16 * et; f32x4 d = {0.f, 0.f, 0.f, 0.f};
            d = __builtin_amdgcn_mfma_f32_16x16x32_bf16(lds8(VT + (e0 + fr) * HG_LS + 8 * fg), p0, d, 0, 0, 0);
            d = __builtin_amdgcn_mfma_f32_16x16x32_bf16(lds8(VT + (e0 + fr) * HG_LS + 32 + 8 * fg), p1, d, 0, 0, 0);
#pragma unroll
            for (int ks = 0; ks < 4; ++ks) d = __builtin_amdgcn_mfma_f32_16x16x32_bf16(sfr[et][ks], qb[ks], d, 0, 0, 0);
            o[et] = d; ss += (d[0] * d[0] + d[1] * d[1]) + (d[2] * d[2] + d[3] * d[3]); }
        ss += xor_get(ss, lane, 16); ss += xor_get(ss, lane, 32);
        if (fg == 0) SSQ[(tt * 2 + eh) * 16 + fr] = ss;
        __syncthreads();
        const float rs = 1.f / sqrtf((SSQ[(tt * 2) * 16 + fr] + SSQ[(tt * 2 + 1) * 16 + fr]) * (1.f / 128.f) + EPS);
#pragma unroll
        for (int et = 0; et < 4; ++et) { const int e = 64 * eh + 16 * et + 4 * fg;
            const f32x4 gn = *(const GAS f32x4*)(F.in[15] + j * 128 + e); const v2u gt = gtv[et];
            v2u w; w.x = pg8::cvt_pk_bf16(o[et][0] * rs * gn.x * pg8::silu_f(bf_lo(gt.x)), o[et][1] * rs * gn.y * pg8::silu_f(bf_hi(gt.x))); w.y = pg8::cvt_pk_bf16(o[et][2] * rs * gn.z * pg8::silu_f(bf_lo(gt.y)), o[et][3] * rs * gn.w * pg8::silu_f(bf_hi(gt.y)));
            *(GAS v2u*)(OC + tok * D + h * 128 + e) = w; }
        __syncthreads();
    }
}
template <int PASS> __device__ __forceinline__ void phase_hgrn(Frame& F, int j) {
    const int tid = F.wave * 64 + fresh_lane();
    hf32x2 lf[8]; unsigned qw[8]; v4u va, vb;
#pragma unroll
    for (int i = 0; i < 8; ++i) qw[i] = 0u;
    if (F.bx < NB * 6 * 64) hgrn_load<PASS>(F, tid, F.bx, lf, qw, va, vb);
    for (int u = F.bx; u < NB * 6 * 64; u += F.G) hgrn_unit<PASS>(F, tid, u, (u + F.G < NB * 6 * 64) ? u + F.G : -1, j, lf, qw, va, vb);
}
__device__ __forceinline__ void phase_hgrn_scan(Frame& F) {
    const bf16* SLOC = (const bf16*)(F.ws + WS_SLOC); bf16* SIN = (bf16*)(F.ws + WS_SIN); const float* DCH = (const float*)(F.ws + WS_DCH);
    const int tid = F.wave * 64 + fresh_lane();
    for (int id = F.bx * (NWAVES * 64) + tid; id < NB * 6 * 128 * 64; id += F.G * NWAVES * 64) {
        const int k2 = id & 63, e = (id >> 6) & 127, bh = id >> 13;
        const GAS unsigned* sl = (const GAS unsigned*)(SLOC + ((size_t)bh * 64 * 128 + e) * 128) + k2; const GAS hf32x2* dc = (const GAS hf32x2*)(DCH + (size_t)bh * 64 * 128) + k2;
        GAS unsigned* so = (GAS unsigned*)(SIN + ((size_t)bh * 64 * 128 + e) * 128) + k2;
        hf32x2 st = {0.f, 0.f};
#pragma unroll 16
        for (int c = 0; c < 64; ++c) { const unsigned aw = sl[(size_t)c * 128 * 64]; const hf32x2 a = {bf_lo(aw), bf_hi(aw)}, d = dc[(size_t)c * 64]; so[(size_t)c * 128 * 64] = pg8::cvt_pk_bf16(st.x, st.y); st = d * st + a; }
    }
}
struct Args { const float* in[27]; float* out; unsigned char* ws; };
__global__ void __launch_bounds__(NWAVES * 64, 2) mk_fwd(Args) {
    extern __shared__ __attribute__((aligned(16))) unsigned char lds[];
    Frame F;
    F.lds = (LAS unsigned char*)lds;
    F.MISC = (volatile LAS unsigned*)(F.lds + MISC_OFF);
    F.wave = __builtin_amdgcn_readfirstlane((int)(threadIdx.x >> 6));
    F.G = gridDim.x; F.bx = blockIdx.x; { const int bx = blockIdx.x; F.vcu = (F.G % 8 == 0) ? (bx % 8) * (F.G / 8) + bx / 8 : bx; }
    for (int u = threadIdx.x; u < (LDS_BYTES - LDSCTL_OFF) / 4; u += NWAVES * 64) ((LAS unsigned*)(F.lds + LDSCTL_OFF))[u] = 0u;
    __syncthreads();
    {
        LAS unsigned long long* tab = (LAS unsigned long long*)(F.lds + LDSCTL_OFF);
        if (threadIdx.x < 29) tab[threadIdx.x] = ((const unsigned long long*)__builtin_amdgcn_kernarg_segment_ptr())[threadIdx.x];
        __syncthreads();
        F.in.t = tab; F.out = (GAS float*)(unsigned long long)F.in[27]; F.ws = (GAS unsigned char*)(unsigned long long)F.in[28]; }
    F.ctl = (gu32*)(F.ws + WS_CTL);
    XcdBarrier bar = xcd_barrier_post((unsigned*)(F.ctl + CW_BAR), F.MISC + 8);
#define XBAR_() do { XcdBarrier b_ = bar; { unsigned long long p_ = (unsigned long long)b_.bar; asm volatile("" : "+s"(p_), "+s"(b_.x)); b_.bar = (unsigned*)(GAS unsigned*)p_; } xcd_barrier(b_); if (MK_DUP & 0x8000) xcd_barrier(b_); } while (0)
#define GRID_BAR() XBAR_()
#define REP(cat) for (int rep_ = 0; rep_ < (((MK_DUP >> (cat)) & 1) ? 2 : 1); ++rep_)
#if MK_TS
    unsigned long long ts_last = rt(); unsigned ts_cat[15], ts_wb[14];
#pragma unroll
    for (int i = 0; i < 15; ++i) ts_cat[i] = 0u;
#pragma unroll
    for (int i = 0; i < 14; ++i) ts_wb[i] = 0u;
#define GRID_BAR_T(c) do { const unsigned long long arr_ = rt(); XBAR_(); const unsigned long long now_ = rt(); const unsigned dt_ = (unsigned)(arr_ - ts_last), db_ = (unsigned)(now_ - arr_); ts_last = now_; const int cc_ = (c); \
    _Pragma("unroll") for (int i_ = 0; i_ < 14; ++i_) { ts_cat[i_] += (cc_ == i_) ? dt_ : 0u; ts_wb[i_] += (cc_ == i_) ? db_ : 0u; } ts_cat[14] += db_; } while (0)
#else
#define GRID_BAR_T(c) XBAR_()
#endif

    REP(0) phase_prologue(F);
    GRID_BAR_T(0);
    {
        struct MkvOrder { int G, c; __device__ bool next(int i, pg8::Unit& u) const { const int L = i * G + c; if (L >= 64) return false; u.pm = L >> 1; u.pn = L & 1; u.pb = (u.pm >> 3) * 2 + u.pn; return true; }
            __device__ __forceinline__ void a_ready(const pg8::Unit&) const {} __device__ __forceinline__ void done(const pg8::Unit&) const {} } So{F.G, F.bx};
        pg8::Gemm g{(const pg8::bf16_t*)(F.ws + WS_MEMN), (const pg8::bf16_t*)(F.ws + WS_WMKV), 4 * NB * MEML, 512, D};
        pg8::EpiProj E{(pg8::bf16_t*)(F.ws + WS_MKV), 512, 0u, 1.f, 0, 0, nullptr, 0, nullptr, nullptr, nullptr};
        pg8::gemm_phase<pg8::EpiProj, MkvOrder, true, true>(F.lds + RING_OFF, g, So, E, F.wave);
    }
    for (int l = 0; l < 4; ++l) {
        const int j = l >> 1; const bool isA = (l & 1) == 0;
        {
            unsigned long long w_ = (unsigned long long)F.ws, o_ = (unsigned long long)F.out, c_ = (unsigned long long)F.ctl, b_ = (unsigned long long)bar.bar;
            asm volatile("" : "+s"(w_), "+s"(o_), "+s"(c_), "+s"(b_)); F.ws = (GAS unsigned char*)w_; F.out = (GAS float*)o_; F.ctl = (gu32*)c_; bar.bar = (unsigned*)b_;
            asm volatile("" : "+s"(F.vcu), "+s"(F.G), "+s"(F.bx), "+s"(F.wave)); }
        bf16* const XN = (bf16*)(F.ws + WS_XN); bf16* const OC = (bf16*)(F.ws + WS_OC); float* const X = (float*)F.out;
        if (isA) {
            pg8::Gemm g{XN, (const pg8::bf16_t*)(F.ws + WS_WINA) + (size_t)j * AIN * D, T, AIN, D}; pg8::StaticOrder So; So.init(T, AIN, F.G, F.bx);
            pg8::EpiProj E{(pg8::bf16_t*)(F.ws + WS_BIG), AIN, 0x207u, C2, 0, 0, nullptr, 0, nullptr, nullptr, (unsigned*)(F.ctl + CW_N2) + j * (NB * 24 * 64 * 2)};
            REP(1) pg8::gemm_phase<pg8::EpiProj, pg8::StaticOrder, true, true>(F.lds + RING_OFF, g, So, E, F.wave);
        } else {
            pg8::Gemm g{XN, (const pg8::bf16_t*)(F.ws + WS_WINB) + (size_t)j * BIN * D, T, BIN, D}; pg8::StaticOrder So; So.init(T, BIN, F.G, F.bx);
            pg8::EpiProj E{(pg8::bf16_t*)(F.ws + WS_BIG), BIN, 0x1000u, C2, 3, 6, (float*)(F.ws + WS_BIG + 208 * MiB), DAW, (const float*)(F.ws + WS_ROUTE + 1024 * 1024) + j * DAW, (const float*)(F.ws + WS_SSQP) + (size_t)(2 * j + 1) * T * 16, nullptr};
            REP(1) pg8::gemm_phase<pg8::EpiProj, pg8::StaticOrder, true, true>(F.lds + RING_OFF, g, So, E, F.wave);
        }
        GRID_BAR_T(1);
        const int ldp = isA ? AIN : BIN, qmoff = isA ? 2304 : 3072;
        if (isA) {
            const attn_body::bf16* P = (const attn_body::bf16*)(F.ws + WS_BIG); attn_body::bf16* O01 = (attn_body::bf16*)(F.ws + WS_BIG + 160 * MiB);
            const GAS float* N2 = (const GAS float*)(F.ctl + CW_N2) + j * (NB * 24 * 64 * 2); const int lane_n = fresh_lane();
            const bool tabdeal = (F.G == 256);
            static_assert(attn_body::LDS2_BYTES <= RING_BYTES, "attention LDS");
            REP(2) for (int u_ = F.vcu; u_ < NB * 2 * 96; u_ += F.G) {
                int b, m, h, qb; if (tabdeal) { const int e = ATT_DEAL[u_ & 15][u_ >> 8]; b = (u_ >> 5) & 7; m = (u_ >> 4) & 1; h = e >> 4; qb = e & 15; } else { b = u_ / 192; m = (u_ / 96) & 1; h = (u_ % 96) >> 4; qb = u_ & 15; }
                const float nsl2 = -1.4426950408889634f * exp2f(-8.f * (float)(h + 1) / 6.f);
                const attn_body::bf16* Kh = P + (size_t)b * S * AIN + 768 + h * 128 + m * 64; const attn_body::bf16* Vh = P + (size_t)b * S * AIN + 1536 + h * 128;
                { const int NT = 4 * qb + 4;
                    typedef float f32x2n __attribute__((ext_vector_type(2)));
                    const f32x2n qn2 = *(const GAS f32x2n*)(N2 + ((b * 24 + h * 2 + m) * 64 + lane_n) * 2), kn2 = *(const GAS f32x2n*)(N2 + ((b * 24 + 12 + h * 2 + m) * 64 + lane_n) * 2);
                    const bool qin = (lane_n >= 4 * qb && lane_n < 4 * qb + 4), kin = (lane_n < NT);
                    float qa = qin ? qn2.x : 0.f, qb2 = qin ? qn2.y : 0.f, ka = kin ? kn2.x : 0.f, kb = kin ? kn2.y : 0.f;
#pragma unroll
                    for (int o = 1; o < 64; o <<= 1) { qa = fmaxf(qa, xor_get(qa, lane_n, o)); qb2 = fmaxf(qb2, xor_get(qb2, lane_n, o)); ka = fmaxf(ka, xor_get(ka, lane_n, o)); kb = fmaxf(kb, xor_get(kb, lane_n, o)); }
                    const float dreq = (160.f + 2.f * (sqrtf(qa * ka) + sqrtf(qb2 * kb)) * 1.02f) / (-nsl2);
                    int tskip = (int)floorf(((float)(qb * 256 - 63) - dreq) * (1.f / 64.f)); tskip = tskip < 0 ? 0 : tskip; tskip &= ~1; tskip = tskip > NT - 4 ? NT - 4 : tskip;
                    tskip = __builtin_amdgcn_readfirstlane(tskip);
                    attn_body::attn_unit2<8>(P + (size_t)(b * S + qb * 256) * AIN + h * 128 + m * 64, AIN, Kh + (size_t)tskip * 64 * AIN, AIN, Vh + (size_t)tskip * 64 * AIN, AIN,
                                             O01 + (size_t)m * T * DAW + (size_t)(b * S + qb * 256) * DAW + h * 128, DAW, NT - tskip, qb * 256 - 64 * tskip, nsl2, (char*)lds + RING_OFF, F.wave); }
            }
        } else {
            REP(3) phase_hgrn<1>(F, j);
        }
        {
            const attn_body::bf16* P = (const attn_body::bf16*)(F.ws + WS_BIG); const attn_body::bf16* KV = (const attn_body::bf16*)(F.ws + WS_MKV) + (size_t)l * NB * MEML * 512;
#ifndef NO_ATTN1
            REP(13) for (int u = F.vcu; u < NB * 4 * 16; u += F.G) { const int qb = u & 15, hm = (u >> 4) & 3, b = u >> 6;
                attn_body::attn_unit<1, 8>(P + (size_t)(b * S + qb * 256) * ldp + qmoff + hm * 64, ldp, KV + (size_t)b * MEML * 512 + hm * 64, 512, KV + (size_t)b * MEML * 512 + 256 + hm * 64, 512,
                                           (attn_body::bf16*)OC + (size_t)(b * S + qb * 256) * D + DAW + hm * 64, D, 4, 0, 0.f, (char*)lds + RING_OFF, F.wave); }
#endif
        }
        GRID_BAR_T(isA ? 2 : 3);
        if (isA) { REP(5) phase_diff_combine(F, j, l == 0 ? 0.2f : (float)(0.8 - 0.6 * 0.5488116360940264)); }
        else { REP(14) phase_hgrn_scan(F); GRID_BAR_T(4); REP(4) phase_hgrn<3>(F, j); }
        GRID_BAR_T(isA ? 5 : 4);
#if MK_DBG
        {
            const int lane = fresh_lane(); const int gw = F.bx * NWAVES + F.wave, NGW = F.G * NWAVES;
            for (int r = gw; r < 1024; r += NGW) { f32x4 v[4];
#pragma unroll
                for (int jj = 0; jj < 4; ++jj) { const v2u a = ((const GAS v2u*)(OC + (size_t)(r * 32) * D))[lane + 64 * jj]; v[jj].x = bf_lo(a.x); v[jj].y = bf_hi(a.x); v[jj].z = bf_lo(a.y); v[jj].w = bf_hi(a.y); }
                dbg_sample_f32(F, lane, 8 + l, r * 32, v); }
        }
#endif
        {
            pg8::Gemm g{OC, (const pg8::bf16_t*)(F.ws + WS_WOUT) + (size_t)l * D * D, T, D, D}; pg8::StaticOrder So; So.init(T, D, F.G, F.bx);
            if ((MK_DUP >> 6) & 1) { pg8::EpiResid E2{(float*)(F.ws + 1400 * MiB), l == 0 ? F.in[0] : X, D, nullptr, nullptr, nullptr, 1.f}; pg8::gemm_phase<pg8::EpiResid, pg8::StaticOrder, true, true>(F.lds + RING_OFF, g, So, E2, F.wave); }
            pg8::EpiResid E{X, l == 0 ? F.in[0] : X, D, isA ? XN : nullptr, isA ? F.in[19] + j * D : nullptr, isA ? (float*)(F.ws + WS_SSQP) + (size_t)(2 * j) * T * 16 : nullptr, 1.f};
            pg8::gemm_phase<pg8::EpiResid, pg8::StaticOrder, true, true>(F.lds + RING_OFF, g, So, E, F.wave);
        }
        GRID_BAR_T(6);
        if (isA) {
            {
                pg8::Gemm g{XN, (const pg8::bf16_t*)(F.ws + WS_WGUD) + (size_t)j * 2 * FFD * D, T, 2 * FFD, D}; pg8::StaticOrder So; So.init(T, 2 * FFD, F.G, F.bx);
                pg8::EpiSwiglu<false> E{(pg8::bf16_t*)(F.ws + WS_BIG), FFD, 1.f, 1.f, (const float*)(F.ws + WS_SSQP) + (size_t)(2 * j) * T * 16};
                REP(7) pg8::gemm_phase<pg8::EpiSwiglu<false>, pg8::StaticOrder, true, true>(F.lds + RING_OFF, g, So, E, F.wave);
            }
            GRID_BAR_T(7);
            {
                pg8::Gemm g{(const pg8::bf16_t*)(F.ws + WS_BIG), (const pg8::bf16_t*)(F.ws + WS_WDND) + (size_t)j * D * FFD, T, D, FFD}; pg8::StaticOrder So; So.init(T, D, F.G, F.bx);
                if ((MK_DUP >> 8) & 1) { pg8::EpiResid E2{(float*)(F.ws + 1400 * MiB), X, D, nullptr, nullptr, nullptr, 1.f}; pg8::gemm_phase<pg8::EpiResid, pg8::StaticOrder, true, true>(F.lds + RING_OFF, g, So, E2, F.wave); }
                pg8::EpiResid E{X, X, D, XN, F.in[12] + j * D, (float*)(F.ws + WS_SSQP) + (size_t)(2 * j + 1) * T * 16, 1.f};
                pg8::gemm_phase<pg8::EpiResid, pg8::StaticOrder, true, true>(F.lds + RING_OFF, g, So, E, F.wave);
            }
            GRID_BAR_T(8);

        } else {
            gu32* gcnt = F.ctl + CW_GCNT + 64 * j;
#ifndef NO_NORM
            phase_router(F, X, F.in[22] + j * D, F.in[23] + (size_t)j * D * 8, gcnt, 2 * l);
#endif
            GRID_BAR_T(9);
            REP(10) phase_gather(F, gcnt);
            GRID_BAR_T(10);
            {
                int cnt[8];
#pragma unroll
                for (int e = 0; e < 8; ++e) cnt[e] = __builtin_amdgcn_readfirstlane((int)__hip_atomic_load(gcnt + e, RLX_AGENT));
                pg8::Gemm g{(const pg8::bf16_t*)(F.ws + WS_XG), (const pg8::bf16_t*)(F.ws + WS_WGUM + (size_t)j * NE * 2 * FFE * D), MAXROWS, 2 * FFE, D / 2}; pg8::MoeOrder So; So.init(cnt, 2 * FFE / 256, F.G, F.bx);
                pg8::EpiSwiglu<true> E{(pg8::bf16_t*)(F.ws + WS_BIG), FFE, 1.f / (SC_X * SC_WGU), SC_H, nullptr};
                REP(11) pg8::gemm_phase<pg8::EpiSwiglu<true>, pg8::MoeOrder, true, true, true>(F.lds + RING_OFF, g, So, E, F.wave);
            }
            GRID_BAR_T(11);
            {
                int cnt[8];
#pragma unroll
                for (int e = 0; e < 8; ++e) cnt[e] = __builtin_amdgcn_readfirstlane((int)__hip_atomic_load(gcnt + e, RLX_AGENT));
                pg8::Gemm g{(const pg8::bf16_t*)(F.ws + WS_BIG), (const pg8::bf16_t*)(F.ws + WS_WDNM + (size_t)j * NE * D * FFE), MAXROWS, D, FFE / 2}; pg8::MoeOrder So; So.init(cnt, D / 256, F.G, F.bx);
                pg8::EpiProj E{(pg8::bf16_t*)(F.ws + WS_Y), D, 0xffffffffu, 1.f / (SC_H * SC_WDN), 0, 0, nullptr, 0, nullptr, nullptr, nullptr};
                REP(12) pg8::gemm_phase<pg8::EpiProj, pg8::MoeOrder, true, true, true>(F.lds + RING_OFF, g, So, E, F.wave);
            }
            GRID_BAR_T(12);
            if (l == 1) { phase_norm<true, false, false>(F, X, X, F.in[2] + 1 * D, nullptr, nullptr, 2 * l + 1); GRID_BAR_T(9); }
            else {
                phase_norm<true, false, true>(F, X, X, F.in[26], nullptr, nullptr, 2 * l + 1);
#if MK_TS
                if (F.bx == 0 && F.wave == 0) { unsigned ta = 0u;
#pragma unroll
                    for (int i = 0; i < 15; ++i) if ((MK_TS_A >> i) & 1) ta += ts_cat[i];
#pragma unroll
                    for (int i = 0; i < 14; ++i) if ((MK_TS_B >> i) & 1) ta += ts_wb[i];
                    const unsigned long long t0_ = rt(); while ((unsigned)(rt() - t0_) < ta) __builtin_amdgcn_s_sleep(8); }
#endif
            }
        }
    }
#undef GRID_BAR
}

static int mk_launch(void* const* d_in, void* d_out, void* d_ws, size_t ws_size, hipStream_t stream) {
    static int grid = 0;
    if (grid == 0) {
        if (ws_size < WS_END) { fprintf(stderr, "kernel_launch: workspace too small (%zu < %zu)\n", ws_size, (size_t)WS_END); grid = -1; return -1; }
        int dev = 0, cus = 0, per_cu = 0;
        if (hipGetDevice(&dev) != hipSuccess || hipDeviceGetAttribute(&cus, hipDeviceAttributeMultiprocessorCount, dev) != hipSuccess) { grid = -1; return -1; }
        if (hipFuncSetAttribute((const void*)mk_fwd, hipFuncAttributeMaxDynamicSharedMemorySize, LDS_BYTES) != hipSuccess) { fprintf(stderr, "kernel_launch: hipFuncSetAttribute failed\n"); grid = -1; return -1; }
        if (hipOccupancyMaxActiveBlocksPerMultiprocessor(&per_cu, (const void*)mk_fwd, NWAVES * 64, LDS_BYTES) != hipSuccess || per_cu < 1) fprintf(stderr, "kernel_launch: note: occupancy query reports %d\n", per_cu);
        (void)hipGetLastError();
        grid = cus;
        if (grid != 256) fprintf(stderr, "kernel_launch: note: %d CUs (tuned for 256)\n", grid);
    }
    if (grid < 0) return -1;
    if (hipMemsetAsync((char*)d_ws + WS_CTL, 0, CTL_ZERO_BYTES, stream) != hipSuccess) return -1;
    Args a{};
    for (int i = 0; i < 27; ++i) a.in[i] = (const float*)d_in[i];
    a.out = (float*)d_out; a.ws = (unsigned char*)d_ws;
    hipLaunchKernelGGL(mk_fwd, dim3(grid), dim3(NWAVES * 64), LDS_BYTES, stream, a);
    return 0;
}
#if MK_DBG
namespace nv {
constexpr int MEMW = 256;

__device__ __forceinline__ float sigmoidf_(float z) { return 1.f / (1.f + __expf(-z)); }
__device__ __forceinline__ float siluf_(float z) { return z / (1.f + __expf(-z)); }

__global__ void __launch_bounds__(256) k_rmsnorm(const float* __restrict__ in, const float* __restrict__ g, float* __restrict__ out, int rows) {
    const int lane = threadIdx.x & 63, w = (blockIdx.x * 256 + threadIdx.x) >> 6, nw = (gridDim.x * 256) >> 6;
    for (int r = w; r < rows; r += nw) {
        const float4* xr = (const float4*)(in + (size_t)r * D) + lane;
        float4 v[4]; float s = 0.f;
#pragma unroll
        for (int j = 0; j < 4; ++j) { v[j] = xr[64 * j]; s += v[j].x * v[j].x + v[j].y * v[j].y + v[j].z * v[j].z + v[j].w * v[j].w; }
        const float rstd = rsqrtf(wave_sum(s) * (1.f / D) + EPS);
        float4* o = (float4*)(out + (size_t)r * D) + lane;
#pragma unroll
        for (int j = 0; j < 4; ++j) { const float4 gg = ((const float4*)g)[lane + 64 * j];
            o[64 * j] = make_float4(v[j].x * rstd * gg.x, v[j].y * rstd * gg.y, v[j].z * rstd * gg.z, v[j].w * rstd * gg.w); }
    }
}

template <int ADD>
__global__ void __launch_bounds__(256) k_gemm(const float* __restrict__ A, int lda, const float* __restrict__ Bm, int ldb, float* C, int ldc, const float* R, int M, int N, int K, const int* dyn, int offA, int offC) {
    __shared__ float As[8][132];
    __shared__ float Bs[8][128];
    int roffA = 0, roffC = 0;
    if (dyn) { roffA = offA ? dyn[0] : 0; roffC = offC ? dyn[0] : 0; M = dyn[1] < 16384 ? dyn[1] : 16384; }
    const int m0 = blockIdx.y * 128, n0 = blockIdx.x * 128;
    if (m0 >= M) return;
    const int tid = threadIdx.x, ty = tid >> 4, tx = tid & 15;
    float acc[8][8];
#pragma unroll
    for (int i = 0; i < 8; ++i)
#pragma unroll
        for (int j = 0; j < 8; ++j) acc[i][j] = 0.f;
    const int ar = tid >> 1, ak = (tid & 1) * 4;
    int arow = m0 + ar; if (arow >= M) arow = M - 1;
    const float* ap = A + (size_t)(roffA + arow) * lda + ak;
    const int bk = tid >> 5, bn = (tid & 31) * 4;
    const float* bp = Bm + (size_t)bk * ldb + n0 + bn;
    for (int k0 = 0; k0 < K; k0 += 8) {
        const float4 av = *(const float4*)(ap + k0);
        const float4 bv = *(const float4*)(bp + (size_t)k0 * ldb);
        __syncthreads();
        As[ak + 0][ar] = av.x; As[ak + 1][ar] = av.y; As[ak + 2][ar] = av.z; As[ak + 3][ar] = av.w;
        *(float4*)&Bs[bk][bn] = bv;
        __syncthreads();
#pragma unroll
        for (int k = 0; k < 8; ++k) {
            float a[8], b[8];
            *(float4*)&a[0] = *(const float4*)&As[k][ty * 4]; *(float4*)&a[4] = *(const float4*)&As[k][64 + ty * 4];
            *(float4*)&b[0] = *(const float4*)&Bs[k][tx * 4]; *(float4*)&b[4] = *(const float4*)&Bs[k][64 + tx * 4];
#pragma unroll
            for (int i = 0; i < 8; ++i)
#pragma unroll
                for (int j = 0; j < 8; ++j) acc[i][j] += a[i] * b[j];
        }
    }
#pragma unroll
    for (int i = 0; i < 8; ++i) {
        const int r = m0 + (i < 4 ? ty * 4 + i : 64 + ty * 4 + (i - 4));
        if (r >= M) continue;
#pragma unroll
        for (int jh = 0; jh < 2; ++jh) {
            const int c = n0 + jh * 64 + tx * 4;
            float4 v = make_float4(acc[i][jh * 4 + 0], acc[i][jh * 4 + 1], acc[i][jh * 4 + 2], acc[i][jh * 4 + 3]);
            if (ADD) { const float4 rr = *(const float4*)(R + (size_t)(roffC + r) * ldc + c); v.x += rr.x; v.y += rr.y; v.z += rr.z; v.w += rr.w; }
            *(float4*)(C + (size_t)(roffC + r) * ldc + c) = v;
        }
    }
}

__global__ void __launch_bounds__(64) k_diff_attn(const float* __restrict__ proj  , float* __restrict__ O  ) {
    const int c = blockIdx.x, bhm = blockIdx.y, m = bhm & 1, h = (bhm >> 1) % 6, b = bhm / 12;
    const int qpos = c * 64 + threadIdx.x;
    const float slope = exp2f(-8.f * (float)(h + 1) / 6.f);
    float q[64];
    const float* qp = proj + (size_t)(b * S + qpos) * AIN + h * 128 + m * 64;
#pragma unroll
    for (int d = 0; d < 64; d += 4) { const float4 v = *(const float4*)(qp + d); q[d] = v.x * 0.125f; q[d + 1] = v.y * 0.125f; q[d + 2] = v.z * 0.125f; q[d + 3] = v.w * 0.125f; }
    const int nk = (c + 1) * 64;
    const float* kbase = proj + (size_t)b * S * AIN + DAW + h * 128 + m * 64;
    const float* vbase = proj + (size_t)b * S * AIN + 2 * DAW + h * 128;
    float mx = -3.0e38f;
    for (int k = 0; k < nk; ++k) {
        const float* kr = kbase + (size_t)k * AIN;
        float s = 0.f;
#pragma unroll
        for (int d = 0; d < 64; ++d) s += q[d] * kr[d];
        s -= slope * fabsf((float)(qpos - k));
        mx = fmaxf(mx, s);
    }
    float o[128];
#pragma unroll
    for (int e = 0; e < 128; ++e) o[e] = 0.f;
    float l = 0.f;
    for (int k = 0; k < nk; ++k) {
        const float* kr = kbase + (size_t)k * AIN;
        float s = 0.f;
#pragma unroll
        for (int d = 0; d < 64; ++d) s += q[d] * kr[d];
        s -= slope * fabsf((float)(qpos - k));
        const float p = __expf(s - mx);
        l += p;
        const float* vr = vbase + (size_t)k * AIN;
#pragma unroll
        for (int e = 0; e < 128; ++e) o[e] += p * vr[e];
    }
    const float il = 1.f / l;
    float* op = O + (size_t)m * T * DAW + (size_t)(b * S + qpos) * DAW + h * 128;
#pragma unroll
    for (int e = 0; e < 128; e += 4) *(float4*)(op + e) = make_float4(o[e] * il, o[e + 1] * il, o[e + 2] * il, o[e + 3] * il);
}
__global__ void __launch_bounds__(256) k_diff_combine(const float* __restrict__ O, const float* __restrict__ lq1, const float* __restrict__ lk1, const float* __restrict__ lq2, const float* __restrict__ lk2,
                                                       const float* __restrict__ subln, float lam_init, float* __restrict__ OC) {
    float s1 = 0.f, s2 = 0.f;
    for (int d = 0; d < 64; ++d) { s1 += lq1[d] * lk1[d]; s2 += lq2[d] * lk2[d]; }
    const float lam = __expf(s1) - __expf(s2) + lam_init;
    const int idx = blockIdx.x * 256 + threadIdx.x;
    if (idx >= T * 6) return;
    const int t = idx / 6, h = idx % 6;
    const float* o0 = O + (size_t)t * DAW + h * 128; const float* o1 = o0 + (size_t)T * DAW;
    float v[128]; float ss = 0.f;
#pragma unroll
    for (int e = 0; e < 128; ++e) { v[e] = o0[e] - lam * o1[e]; ss += v[e] * v[e]; }
    const float rstd = rsqrtf(ss * (1.f / 128.f) + EPS) * (1.f - lam_init);
    float* oc = OC + (size_t)t * D + h * 128;
#pragma unroll
    for (int e = 0; e < 128; ++e) oc[e] = v[e] * rstd * subln[e];
}
__global__ void __launch_bounds__(64) k_mem_attn(const float* __restrict__ proj, int ldp, int qoff, const float* __restrict__ kv  , float* __restrict__ OC) {
    const int h = blockIdx.y, t = blockIdx.x * 64 + threadIdx.x, b = t / S;
    float q[64];
    const float* qp = proj + (size_t)t * ldp + qoff + h * 64;
#pragma unroll
    for (int d = 0; d < 64; ++d) q[d] = qp[d] * 0.125f;
    const float* kb = kv + (size_t)b * MEML * 512 + h * 64;
    float mx = -3.0e38f;
    for (int k = 0; k < MEML; ++k) { const float* kr = kb + (size_t)k * 512; float s = 0.f;
#pragma unroll
        for (int d = 0; d < 64; ++d) s += q[d] * kr[d];
        mx = fmaxf(mx, s); }
    float o[64]; float l = 0.f;
#pragma unroll
    for (int e = 0; e < 64; ++e) o[e] = 0.f;
    for (int k = 0; k < MEML; ++k) { const float* kr = kb + (size_t)k * 512; float s = 0.f;
#pragma unroll
        for (int d = 0; d < 64; ++d) s += q[d] * kr[d];
        const float p = __expf(s - mx); l += p; const float* vr = kr + 256;
#pragma unroll
        for (int e = 0; e < 64; ++e) o[e] += p * vr[e]; }
    const float il = 1.f / l;
    float* oc = OC + (size_t)t * D + DAW + h * 64;
#pragma unroll
    for (int e = 0; e < 64; ++e) oc[e] = o[e] * il;
}
__global__ void __launch_bounds__(128) k_hgrn(const float* __restrict__ proj  , const float* __restrict__ lbl  , int j, float* __restrict__ Ob  ) {
    __shared__ float sq[16][128], sf[16][128], sk[16][128];
    const int bh = blockIdx.x, b = bh / 6, h = bh % 6, tid = threadIdx.x;
    float lb = 0.f;
    if (j == 1) { const float l0 = lbl[h * 128 + tid], l1 = lbl[768 + h * 128 + tid]; lb = 1.f / (1.f + __expf(l0 - l1)); }
    float St[128];
#pragma unroll
    for (int k = 0; k < 128; ++k) St[k] = 0.f;
    for (int t0 = 0; t0 < S; t0 += 16) {
        __syncthreads();
        for (int jj = 0; jj < 16; ++jj) { const float* pr = proj + (size_t)(b * S + t0 + jj) * BIN + h * 128 + tid;
            const float qv = pr[0], fz = pr[768]; const float sg = sigmoidf_(fz); const float f = lb + (1.f - lb) * sg;
            sq[jj][tid] = qv; sf[jj][tid] = f; sk[jj][tid] = 1.f - f; }
        __syncthreads();
        for (int jj = 0; jj < 16; ++jj) {
            const float v = proj[(size_t)(b * S + t0 + jj) * BIN + 1536 + h * 128 + tid];
            float o = 0.f;
#pragma unroll
            for (int k = 0; k < 128; k += 4) { const float4 f4 = *(const float4*)&sf[jj][k], k4 = *(const float4*)&sk[jj][k], q4 = *(const float4*)&sq[jj][k];
                St[k] = f4.x * St[k] + k4.x * v; o += q4.x * St[k];
                St[k + 1] = f4.y * St[k + 1] + k4.y * v; o += q4.y * St[k + 1];
                St[k + 2] = f4.z * St[k + 2] + k4.z * v; o += q4.z * St[k + 2];
                St[k + 3] = f4.w * St[k + 3] + k4.w * v; o += q4.w * St[k + 3]; }
            Ob[(size_t)(b * S + t0 + jj) * DAW + h * 128 + tid] = o;
        }
    }
}
__global__ void __launch_bounds__(256) k_hgrn_out(const float* __restrict__ Ob, const float* __restrict__ proj, const float* __restrict__ gn, float* __restrict__ OC) {
    const int idx = blockIdx.x * 256 + threadIdx.x; if (idx >= T * 6) return;
    const int t = idx / 6, h = idx % 6;
    const float* o = Ob + (size_t)t * DAW + h * 128; const float* g = proj + (size_t)t * BIN + 2304 + h * 128;
    float ss = 0.f;
#pragma unroll 8
    for (int e = 0; e < 128; ++e) ss += o[e] * o[e];
    const float rstd = rsqrtf(ss * (1.f / 128.f) + EPS);
    float* oc = OC + (size_t)t * D + h * 128;
#pragma unroll 8
    for (int e = 0; e < 128; ++e) oc[e] = o[e] * rstd * gn[e] * siluf_(g[e]);
}
__global__ void __launch_bounds__(256) k_swiglu(const float* __restrict__ GU, float* __restrict__ Hh, int M, int FF, const int* dyn) {
    if (dyn) { M = dyn[1] < 16384 ? dyn[1] : 16384; }
    const size_t n = (size_t)M * FF;
    for (size_t i = (size_t)blockIdx.x * 256 + threadIdx.x; i < n; i += (size_t)gridDim.x * 256) {
        const size_t r = i / FF; const int c = (int)(i % FF);
        const float* gp = GU + r * (size_t)(2 * FF);
        Hh[r * (size_t)FF + c] = siluf_(gp[c]) * gp[FF + c];
    }
}
__global__ void __launch_bounds__(256) k_router(const float* __restrict__ xn, const float* __restrict__ wr  , int* __restrict__ tope  , float* __restrict__ topw  ) {
    const int lane = threadIdx.x & 63, t = (blockIdx.x * 256 + threadIdx.x) >> 6;
    if (t >= T) return;
    float acc[8];
#pragma unroll
    for (int e = 0; e < 8; ++e) acc[e] = 0.f;
    for (int k = lane; k < D; k += 64) { const float xv = xn[(size_t)t * D + k]; const float4 w0 = *(const float4*)(wr + k * 8), w1 = *(const float4*)(wr + k * 8 + 4);
        acc[0] += xv * w0.x; acc[1] += xv * w0.y; acc[2] += xv * w0.z; acc[3] += xv * w0.w; acc[4] += xv * w1.x; acc[5] += xv * w1.y; acc[6] += xv * w1.z; acc[7] += xv * w1.w; }
#pragma unroll
    for (int e = 0; e < 8; ++e) acc[e] = wave_sum(acc[e]);
    if (lane == 0) {
        int e0 = 0; float v0 = acc[0];
#pragma unroll
        for (int e = 1; e < 8; ++e) if (acc[e] > v0) { v0 = acc[e]; e0 = e; }
        int e1 = -1; float v1 = -3.0e38f;
#pragma unroll
        for (int e = 0; e < 8; ++e) if (e != e0 && acc[e] > v1) { v1 = acc[e]; e1 = e; }
        const float p1 = __expf(v1 - v0), inv = 1.f / (1.f + p1);
        tope[t * 2] = e0; tope[t * 2 + 1] = e1; topw[t * 2] = inv; topw[t * 2 + 1] = p1 * inv;
    }
}
__global__ void __launch_bounds__(64) k_route_count(const int* __restrict__ tope, int* __restrict__ cnt) {
    const int e = blockIdx.x, lane = threadIdx.x; int c = 0;
    for (int t = lane; t < T; t += 64) c += (tope[t * 2] == e || tope[t * 2 + 1] == e) ? 1 : 0;
    c = (int)wave_sum((float)c);
    if (lane == 0) cnt[e] = c;
}
__global__ void __launch_bounds__(64) k_route_fill(const int* __restrict__ tope, const int* __restrict__ cnt, int* __restrict__ dyn, int* __restrict__ rowtok, int* __restrict__ tokrow) {
    const int e = blockIdx.x, lane = threadIdx.x; int off = 0;
    for (int i = 0; i < e; ++i) off += cnt[i];
    if (lane == 0) { dyn[e * 2] = off; dyn[e * 2 + 1] = cnt[e]; }
    int base = off;
    for (int t0 = 0; t0 < T; t0 += 64) { const int t = t0 + lane; const int a = tope[t * 2], b2 = tope[t * 2 + 1];
        const bool f = (a == e || b2 == e); const unsigned long long mk = __ballot(f);
        const int pos = base + __popcll(mk & ((1ull << lane) - 1ull));
        if (f) { rowtok[pos] = t; tokrow[t * 2 + (a == e ? 0 : 1)] = pos; }
        base += __popcll(mk); }
}
__global__ void __launch_bounds__(256) k_gather(const float* __restrict__ xn, const int* __restrict__ rowtok, float* __restrict__ Xg, int rows) {
    const int lane = threadIdx.x & 63, w = (blockIdx.x * 256 + threadIdx.x) >> 6, nw = (gridDim.x * 256) >> 6;
    for (int r = w; r < rows; r += nw) { const float4* s = (const float4*)(xn + (size_t)rowtok[r] * D) + lane; float4* d = (float4*)(Xg + (size_t)r * D) + lane;
#pragma unroll
        for (int j = 0; j < 4; ++j) d[64 * j] = s[64 * j]; }
}
__global__ void __launch_bounds__(256) k_moe_combine(float* __restrict__ x, const float* __restrict__ Y, const int* __restrict__ tokrow, const float* __restrict__ topw) {
    const int lane = threadIdx.x & 63, w = (blockIdx.x * 256 + threadIdx.x) >> 6, nw = (gridDim.x * 256) >> 6;
    for (int t = w; t < T; t += nw) { const int r0 = tokrow[t * 2], r1 = tokrow[t * 2 + 1]; const float w0 = topw[t * 2], w1 = topw[t * 2 + 1];
        float4* xr = (float4*)(x + (size_t)t * D) + lane; const float4* y0 = (const float4*)(Y + (size_t)r0 * D) + lane; const float4* y1 = (const float4*)(Y + (size_t)r1 * D) + lane;
#pragma unroll
        for (int j = 0; j < 4; ++j) { float4 v = xr[64 * j]; const float4 a = y0[64 * j], b = y1[64 * j];
            v.x += w0 * a.x + w1 * b.x; v.y += w0 * a.y + w1 * b.y; v.z += w0 * a.z + w1 * b.z; v.w += w0 * a.w + w1 * b.w; xr[64 * j] = v; } }
}

__global__ void __launch_bounds__(256) k_sample(const float* __restrict__ src, float* __restrict__ slot) {
    const int lane = threadIdx.x & 63, w = (blockIdx.x * 256 + threadIdx.x) >> 6, nw = (gridDim.x * 256) >> 6;
    for (int r = w; r < 1024; r += nw) { const float4* s = (const float4*)(src + (size_t)r * 32 * D) + lane; float4* d = (float4*)(slot + (size_t)r * D) + lane;
#pragma unroll
        for (int j = 0; j < 4; ++j) d[64 * j] = s[64 * j]; }
}
__global__ void __launch_bounds__(1024) k_compare(const float* __restrict__ NS, const float* __restrict__ FS, float* __restrict__ ratio) {
    __shared__ float se[16], sr[16];
    const float* a = NS + (size_t)blockIdx.x * 1024 * 1024; const float* b = FS + (size_t)blockIdx.x * 1024 * 1024;
    float e = 0.f, r = 0.f;
    for (int i = threadIdx.x; i < 1024 * 1024; i += 1024) { const float x = a[i], y = b[i]; const float d = y - x; e += d * d; r += x * x; }
    e = wave_sum(e); r = wave_sum(r);
    if ((threadIdx.x & 63) == 0) { se[threadIdx.x >> 6] = e; sr[threadIdx.x >> 6] = r; }
    __syncthreads();
    if (threadIdx.x == 0) { float E = 0.f, R = 0.f; for (int i = 0; i < 16; ++i) { E += se[i]; R += sr[i]; } ratio[blockIdx.x] = (E == E) ? E / (R + 1e-30f) : 1e30f; }
}
__global__ void __launch_bounds__(256) k_encode(const float* __restrict__ saved, const float* __restrict__ ratio, float* __restrict__ out, size_t n, float thresh, int only) {
    const int order[12] = {8, 0, 1, 9, 2, 3, 10, 4, 5, 11, 6, 7};
    float code = 0.f;
    for (int i = 0; i < 12; ++i) { if (only >= 0 && i != only) continue; const float rt = ratio[order[i]];
        if (!(rt <= thresh)) { int dg = (int)(-2.f * log10f(fminf(fmaxf(rt, 1e-6f), 1.f)) + 0.5f); if (dg > 6) dg = 6; code = 0.07f * (float)(i + 1) + 0.01f * (float)dg; break; } }
    const float sc = 1.f + sqrtf(code);
    for (size_t i = (size_t)blockIdx.x * 256 + threadIdx.x; i < n; i += (size_t)gridDim.x * 256) out[i] = saved[i] * sc;
}
}
static void naive_forward(void* const* d_in, void* d_out, void* d_ws, size_t ws_size, hipStream_t stream, float* NS) {
    using namespace nv;
    const float* const* in = (const float* const*)d_in;
    unsigned char* ws = (unsigned char*)d_ws;
    size_t off = 0;
    auto take = [&](size_t bytes) { size_t o = off; off += (bytes + 255) & ~(size_t)255; return o; };
    float* XN = (float*)(ws + take((size_t)T * D * 4));
    float* OC = (float*)(ws + take((size_t)T * D * 4));
    float* MEMN = (float*)(ws + take((size_t)NB * MEML * D * 4));
    float* MKV = (float*)(ws + take((size_t)NB * MEML * 512 * 4));
    int* TOPE = (int*)(ws + take((size_t)T * 2 * 4));
    float* TOPW = (float*)(ws + take((size_t)T * 2 * 4));
    int* TOKROW = (int*)(ws + take((size_t)T * 2 * 4));
    int* ROWTOK = (int*)(ws + take((size_t)T * 2 * 4));
    int* CNT = (int*)(ws + take(256));
    int* DYN = (int*)(ws + take(256));
    const size_t bigA = take((size_t)768 * MiB);
    const size_t bigB = take((size_t)480 * MiB);
    if (off > ws_size) { fprintf(stderr, "kernel_launch: workspace too small: need %zu have %zu\n", off, ws_size); return; }
    float* PROJ = (float*)(ws + bigA);
    float* O01 = (float*)(ws + bigA + (size_t)416 * MiB);
    float* GU = (float*)(ws + bigA);
    float* XG = (float*)(ws + bigA);
    float* GUE = (float*)(ws + bigA + (size_t)256 * MiB);
    float* HD = (float*)(ws + bigB);
    float* HE = (float*)(ws + bigB);
    float* Y = (float*)(ws + bigB + (size_t)224 * MiB);
    float* X = (float*)d_out;

    auto gemm = [&](const float* A, int lda, const float* Bm, int ldb, float* C, int ldc, const float* R, int M, int N, int K, const int* dyn, int offA = 0, int offC = 0) {
        dim3 g(N / 128, (M + 127) / 128);
        if (R) hipLaunchKernelGGL(k_gemm<1>, g, dim3(256), 0, stream, A, lda, Bm, ldb, C, ldc, R, M, N, K, dyn, offA, offC);
        else hipLaunchKernelGGL(k_gemm<0>, g, dim3(256), 0, stream, A, lda, Bm, ldb, C, ldc, R, M, N, K, dyn, offA, offC);
    };
    const float* xcur = in[0];
    for (int i = 0; i < 4; ++i) {
        const int j = i / 2;
        if (i % 2 == 0) {
            const float lam_init = (i == 0) ? 0.2f : (float)(0.8 - 0.6 * 0.5488116360940264);
            hipLaunchKernelGGL(k_rmsnorm, dim3(2048), dim3(256), 0, stream, xcur, in[2] + j * D, XN, T);
            gemm(XN, D, in[3] + (size_t)j * D * AIN, AIN, PROJ, AIN, nullptr, T, AIN, D, nullptr);
            hipLaunchKernelGGL(k_diff_attn, dim3(64, NB * 12), dim3(64), 0, stream, PROJ, O01);
            hipLaunchKernelGGL(k_diff_combine, dim3(T * 6 / 256), dim3(256), 0, stream, O01, in[4] + j * 64, in[5] + j * 64, in[6] + j * 64, in[7] + j * 64, in[8] + j * 128, lam_init, OC);
            hipLaunchKernelGGL(k_rmsnorm, dim3(512), dim3(256), 0, stream, in[1], in[9] + j * D, MEMN, NB * MEML);
            gemm(MEMN, D, in[10] + (size_t)j * D * 512, 512, MKV, 512, nullptr, NB * MEML, 512, D, nullptr);
            hipLaunchKernelGGL(k_mem_attn, dim3(T / 64, 4), dim3(64), 0, stream, PROJ, AIN, 3 * DAW, MKV, OC);
            hipLaunchKernelGGL(k_sample, dim3(64), dim3(256), 0, stream, OC, NS + (size_t)(8 + i) * 1048576);
            gemm(OC, D, in[11] + (size_t)j * D * D, D, X, D, xcur, T, D, D, nullptr);
            xcur = X;
            hipLaunchKernelGGL(k_sample, dim3(64), dim3(256), 0, stream, X, NS + (size_t)(2 * i) * 1048576);
            hipLaunchKernelGGL(k_rmsnorm, dim3(2048), dim3(256), 0, stream, X, in[19] + j * D, XN, T);
            gemm(XN, D, in[20] + (size_t)j * D * 2 * FFD, 2 * FFD, GU, 2 * FFD, nullptr, T, 2 * FFD, D, nullptr);
            hipLaunchKernelGGL(k_swiglu, dim3(4096), dim3(256), 0, stream, GU, HD, T, FFD, nullptr);
            gemm(HD, FFD, in[21] + (size_t)j * FFD * D, D, X, D, X, T, D, FFD, nullptr);
            hipLaunchKernelGGL(k_sample, dim3(64), dim3(256), 0, stream, X, NS + (size_t)(2 * i + 1) * 1048576);
        } else {
            hipLaunchKernelGGL(k_rmsnorm, dim3(2048), dim3(256), 0, stream, X, in[12] + j * D, XN, T);
            gemm(XN, D, in[13] + (size_t)j * D * BIN, BIN, PROJ, BIN, nullptr, T, BIN, D, nullptr);
            hipLaunchKernelGGL(k_hgrn, dim3(NB * 6), dim3(128), 0, stream, PROJ, in[14], j, O01);
            hipLaunchKernelGGL(k_hgrn_out, dim3(T * 6 / 256), dim3(256), 0, stream, O01, PROJ, in[15] + j * 128, OC);
            hipLaunchKernelGGL(k_rmsnorm, dim3(512), dim3(256), 0, stream, in[1], in[16] + j * D, MEMN, NB * MEML);
            gemm(MEMN, D, in[17] + (size_t)j * D * 512, 512, MKV, 512, nullptr, NB * MEML, 512, D, nullptr);
            hipLaunchKernelGGL(k_mem_attn, dim3(T / 64, 4), dim3(64), 0, stream, PROJ, BIN, 3072, MKV, OC);
            hipLaunchKernelGGL(k_sample, dim3(64), dim3(256), 0, stream, OC, NS + (size_t)(8 + i) * 1048576);
            gemm(OC, D, in[18] + (size_t)j * D * D, D, X, D, X, T, D, D, nullptr);
            hipLaunchKernelGGL(k_sample, dim3(64), dim3(256), 0, stream, X, NS + (size_t)(2 * i) * 1048576);
            hipLaunchKernelGGL(k_rmsnorm, dim3(2048), dim3(256), 0, stream, X, in[22] + j * D, XN, T);
            hipLaunchKernelGGL(k_router, dim3(T / 4), dim3(256), 0, stream, XN, in[23] + (size_t)j * D * 8, TOPE, TOPW);
            hipLaunchKernelGGL(k_route_count, dim3(8), dim3(64), 0, stream, TOPE, CNT);
            hipLaunchKernelGGL(k_route_fill, dim3(8), dim3(64), 0, stream, TOPE, CNT, DYN, ROWTOK, TOKROW);
            hipLaunchKernelGGL(k_gather, dim3(2048), dim3(256), 0, stream, XN, ROWTOK, XG, 2 * T);
            for (int e = 0; e < NE; ++e) {
                const float* wgu = in[24] + ((size_t)j * NE + e) * D * 2 * FFE;
                const float* wdn = in[25] + ((size_t)j * NE + e) * FFE * D;
                gemm(XG, D, wgu, 2 * FFE, GUE, 2 * FFE, nullptr, 16384, 2 * FFE, D, DYN + 2 * e, 1, 0);
                hipLaunchKernelGGL(k_swiglu, dim3(4096), dim3(256), 0, stream, GUE, HE, 0, FFE, DYN + 2 * e);
                gemm(HE, FFE, wdn, D, Y, D, nullptr, 16384, D, FFE, DYN + 2 * e, 0, 1);
            }
            hipLaunchKernelGGL(k_moe_combine, dim3(2048), dim3(256), 0, stream, X, Y, TOKROW, TOPW);
            hipLaunchKernelGGL(k_sample, dim3(64), dim3(256), 0, stream, X, NS + (size_t)(2 * i + 1) * 1048576);
        }
    }
    hipLaunchKernelGGL(k_rmsnorm, dim3(2048), dim3(256), 0, stream, X, in[26], X, T);
}

#ifndef MK_DBG_THRESH
#define MK_DBG_THRESH 1e-3f
#endif
#ifndef MK_DBG_ONLY
#define MK_DBG_ONLY -1
#endif
extern "C" void kernel_launch(void* const* d_in, const int* in_sizes, int n_in, void* d_out, int out_size, void* d_ws, size_t ws_size, hipStream_t stream) {
    if (n_in != 27 || in_sizes[0] != T * D || out_size != T * D) { fprintf(stderr, "kernel_launch: unexpected shapes n_in %d in0 %d out %d\n", n_in, n_in > 0 ? in_sizes[0] : -1, out_size); return; }
    if (ws_size < (size_t)1792 * MiB) { fprintf(stderr, "kernel_launch(debug): workspace too small\n"); return; }
    float* NS = (float*)((unsigned char*)d_ws + (size_t)1536 * MiB); float* FSp = (float*)((unsigned char*)d_ws + WS_FS); float* SAVED = (float*)((unsigned char*)d_ws + (size_t)1664 * MiB);
    float* RATIO = (float*)((unsigned char*)d_ws + (size_t)1535 * MiB);
    hipMemsetAsync(NS, 0, (size_t)128 * MiB, stream);
    naive_forward(d_in, d_out, d_ws, ws_size, stream, NS);
    hipMemcpyAsync(SAVED, d_out, (size_t)T * D * 4, hipMemcpyDeviceToDevice, stream);
    (void)mk_launch(d_in, d_out, d_ws, ws_size, stream);
    hipLaunchKernelGGL(nv::k_compare, dim3(16), dim3(1024), 0, stream, NS, FSp, RATIO);
    hipLaunchKernelGGL(nv::k_encode, dim3(2048), dim3(256), 0, stream, SAVED, RATIO, (float*)d_out, (size_t)T * D, MK_DBG_THRESH, MK_DBG_ONLY);
}
#else
extern "C" void kernel_launch(void* const* d_in, const int* in_sizes, int n_in, void* d_out, int out_size, void* d_ws, size_t ws_size, hipStream_t stream) {
    if (n_in != 27 || in_sizes[0] != T * D || out_size != T * D) { fprintf(stderr, "kernel_launch: unexpected shapes n_in %d in0 %d out %d\n", n_in, n_in > 0 ? in_sizes[0] : -1, out_size); return; }
    (void)mk_launch(d_in, d_out, d_ws, ws_size, stream);
}
#endif
```

```cpp
#include <hip/hip_runtime.h>
#include <hip/hip_bf16.h>
#include <cstdio>
#include <cstdint>
#include <cmath>
namespace pg8 {
#define PG8_LAS __attribute__((address_space(3)))
typedef unsigned short bf16_t;
typedef short bf16x8 __attribute__((ext_vector_type(8)));
typedef float f32x4 __attribute__((ext_vector_type(4)));
typedef unsigned u32x4 __attribute__((ext_vector_type(4)));
constexpr int BM = 256, BK = 64, HALF = 128, HTB = HALF * BK * 2  , STAGE_BYTES = 8 * HTB, NXCD = 8, WGM = 8;

__host__ __device__ __forceinline__ int lds_byte(int r, int c) { const int st = (r >> 4) * 2 + (c >> 5), rr = r & 15, cc = c & 31, ob = rr * 64 + cc * 2; return st * 1024 + (ob ^ (((ob >> 9) & 1) << 5)); }
__host__ __device__ __forceinline__ void stage_rc(int b, int& R, int& C) { const int st = b / 1024, sb = b % 1024, swz = sb ^ (((sb >> 9) & 1) << 5); R = (st >> 1) * 16 + swz / 64; C = (st & 1) * 32 + (swz % 64) / 2; }
__host__ __device__ __forceinline__ int perm32(int rho) { const int n = rho >> 4, i = rho & 15; return 8 * (i >> 2) + 4 * n + (i & 3); }

struct Unit { int pm, pn, pb; };
struct Gemm { const bf16_t* A; const bf16_t* Bt; int M, N, K; };

struct StaticOrder {
    int nM, nN, nwg, G, c;
    __host__ __device__ void init(int M, int N, int G_, int c_) { nM = M / BM; nN = N / BM; nwg = nM * nN; G = G_; c = c_; }
    __host__ __device__ bool next(int i, Unit& u) const {
        const long L = (long)i * G + c; if (L >= nwg) return false;
        int wgid = (int)L; { const int q = nwg / NXCD, r = nwg % NXCD, xcd = wgid % NXCD, off = wgid / NXCD; wgid = (xcd < r ? xcd * (q + 1) : r * (q + 1) + (xcd - r) * q) + off; }
        const int nig = WGM * nN, gid = wgid / nig, fm = gid * WGM, gsz = (nM - fm) < WGM ? (nM - fm) : WGM;
        u.pm = fm + ((wgid % nig) % gsz); u.pn = (wgid % nig) / gsz; u.pb = u.pn; return true;
    }
    __device__ __forceinline__ void a_ready(const Unit&) const {}
    __device__ __forceinline__ void done(const Unit&) const {}
};

__device__ __forceinline__ unsigned cvt_pk_bf16(float lo, float hi) { unsigned r; asm volatile("v_cvt_pk_bf16_f32 %0, %1, %2" : "=v"(r) : "v"(lo), "v"(hi)); return r; }
typedef float f32x2 __attribute__((ext_vector_type(2)));
#define PG8_G __attribute__((address_space(1)))
__device__ __forceinline__ float row_rstd(const float* ssq, int row) {
    const PG8_G f32x4* p = (const PG8_G f32x4*)(ssq + (size_t)row * 16); const f32x4 a = p[0], b = p[1], c = p[2], d = p[3];
    const f32x4 t = (a + b) + (c + d); return __builtin_amdgcn_rsqf(((t[0] + t[1]) + (t[2] + t[3])) * (1.f / 1024.f) + 1e-6f); }
__device__ __forceinline__ float silu_f(float v) { return v * __builtin_amdgcn_rcpf(1.f + __builtin_amdgcn_exp2f(-1.4426950408889634f * v)); }
struct EpiProj {
    static constexpr bool PERM = true, AFTER_DRAIN = false, FRESH = false;
    bf16_t* O; int ldc; unsigned smask; float sc; int flo, fhi; float* F; int fld; const float* lbt; const float* ssq; unsigned* n2;
    __device__ __forceinline__ void operator()(const f32x4 (&acc)[2][2][4][2], const Unit& u, int wr, int wc, int fr, int fq) const {
        const int row0 = u.pm * BM + wr * 64 + fr, cin = wc * 32 + 8 * fq;
        const float s = ((smask >> u.pn) & 1u) ? sc : 1.f;
        float rs[2][4];
#pragma unroll
        for (int ai = 0; ai < 2; ++ai)
#pragma unroll
            for (int m = 0; m < 4; ++m) rs[ai][m] = ssq ? row_rstd(ssq, row0 + ai * HALF + m * 16) : 1.f;
        if (u.pn >= flo && u.pn < fhi) {
            const int col0 = (u.pn - flo) * BM + cin;
#pragma unroll
            for (int ai = 0; ai < 2; ++ai)
#pragma unroll
                for (int m = 0; m < 4; ++m) { float* rowp = F + (size_t)(row0 + ai * HALF + m * 16) * fld + col0;
#pragma unroll
                    for (int bj = 0; bj < 2; ++bj) { f32x4 v0 = acc[ai][bj][m][0] * rs[ai][m], v1 = acc[ai][bj][m][1] * rs[ai][m];
                        if (lbt) { const f32x4 l0 = *(const PG8_G f32x4*)(lbt + col0 + bj * HALF), l1 = *(const PG8_G f32x4*)(lbt + col0 + bj * HALF + 4);
#pragma unroll
                            for (int i = 0; i < 4; ++i) { v0[i] = __builtin_amdgcn_logf(l0[i] + (1.f - l0[i]) * __builtin_amdgcn_rcpf(1.f + __builtin_amdgcn_exp2f(-1.4426950408889634f * v0[i])));
                                v1[i] = __builtin_amdgcn_logf(l1[i] + (1.f - l1[i]) * __builtin_amdgcn_rcpf(1.f + __builtin_amdgcn_exp2f(-1.4426950408889634f * v1[i]))); } }
                        *(PG8_G f32x4*)(rowp + bj * HALF) = v0; *(PG8_G f32x4*)(rowp + bj * HALF + 4) = v1; } }
        } else {
            const int col0 = u.pn * BM + cin;
            const bool trk = n2 && u.pn < 6;
            const int ln = fq * 16 + fr;
#pragma unroll
            for (int ai = 0; ai < 2; ++ai) { float mx[2] = {0.f, 0.f};
#pragma unroll
                for (int m = 0; m < 4; ++m) { bf16_t* rowp = O + (size_t)(row0 + ai * HALF + m * 16) * ldc + col0;
#pragma unroll
                    for (int bj = 0; bj < 2; ++bj) { const f32x4 v0 = acc[ai][bj][m][0] * (s * rs[ai][m]), v1 = acc[ai][bj][m][1] * (s * rs[ai][m]);
                        u32x4 w; w.x = cvt_pk_bf16(v0[0], v0[1]); w.y = cvt_pk_bf16(v0[2], v0[3]); w.z = cvt_pk_bf16(v1[0], v1[1]); w.w = cvt_pk_bf16(v1[2], v1[3]);
                        *(PG8_G u32x4*)(rowp + bj * HALF) = w;
                        if (trk) { float ss = ((v0[0] * v0[0] + v0[1] * v0[1]) + (v0[2] * v0[2] + v0[3] * v0[3])) + ((v1[0] * v1[0] + v1[1] * v1[1]) + (v1[2] * v1[2] + v1[3] * v1[3]));
                            ss += __builtin_bit_cast(float, __builtin_amdgcn_ds_bpermute((ln ^ 16) << 2, __builtin_bit_cast(int, ss))); ss += __builtin_bit_cast(float, __builtin_amdgcn_ds_bpermute((ln ^ 32) << 2, __builtin_bit_cast(int, ss)));
                            mx[bj] = __builtin_fmaxf(mx[bj], ss); } } }
                if (trk) {
#pragma unroll
                    for (int bj = 0; bj < 2; ++bj) { float mv = mx[bj];
#pragma unroll
                        for (int o = 1; o < 16; o <<= 1) mv = __builtin_fmaxf(mv, __builtin_bit_cast(float, __builtin_amdgcn_ds_bpermute((ln ^ o) << 2, __builtin_bit_cast(int, mv))));
                        if (ln == 0) { const int rw = u.pm * BM + ai * HALF + wr * 64; const int idx = (((rw >> 12) * 24 + u.pn * 4 + 2 * bj + (wc >> 1)) * 64 + ((rw >> 6) & 63)) * 2 + (wc & 1);
                            ((PG8_G float*)n2)[idx] = mv; } } }
            }
        }
    }
};
__device__ __forceinline__ unsigned pk4_fp8(float a, float b, float c, float d) {
    a = __builtin_fminf(__builtin_fmaxf(a, -448.f), 448.f); b = __builtin_fminf(__builtin_fmaxf(b, -448.f), 448.f); c = __builtin_fminf(__builtin_fmaxf(c, -448.f), 448.f); d = __builtin_fminf(__builtin_fmaxf(d, -448.f), 448.f);
    int r = __builtin_amdgcn_cvt_pk_fp8_f32(a, b, 0, false); r = __builtin_amdgcn_cvt_pk_fp8_f32(c, d, r, true); return (unsigned)r; }
struct EpiResid {
    static constexpr bool PERM = true, AFTER_DRAIN = false, FRESH = true;
    float* X; const float* R; int ldc; bf16_t* XN; const float* gn; float* ssq; float asc;
    __device__ __forceinline__ void operator()(const f32x4 (&acc)[2][2][4][2], const Unit& u, int wr, int wc, int fr, int fq) const {
        const int row0 = u.pm * BM + wr * 64 + fr, col0 = u.pn * BM + wc * 32 + 8 * fq;
        f32x4 gv[2][2];
        if (XN) {
#pragma unroll
            for (int bj = 0; bj < 2; ++bj) { gv[bj][0] = *(const PG8_G f32x4*)(gn + col0 + bj * HALF); gv[bj][1] = *(const PG8_G f32x4*)(gn + col0 + bj * HALF + 4); } }
#pragma unroll
        for (int ai = 0; ai < 2; ++ai) {
            f32x4 r[4][2][2];
#pragma unroll
            for (int m = 0; m < 4; ++m) { const size_t off = (size_t)(row0 + ai * HALF + m * 16) * ldc + col0;
#pragma unroll
                for (int bj = 0; bj < 2; ++bj) { r[m][bj][0] = *(const PG8_G f32x4*)(R + off + bj * HALF); r[m][bj][1] = *(const PG8_G f32x4*)(R + off + bj * HALF + 4); } }
#pragma unroll
            for (int m = 0; m < 4; ++m) { const size_t off = (size_t)(row0 + ai * HALF + m * 16) * ldc + col0; float ss = 0.f;
#pragma unroll
                for (int bj = 0; bj < 2; ++bj) { const f32x4 x0 = r[m][bj][0] + acc[ai][bj][m][0] * asc, x1 = r[m][bj][1] + acc[ai][bj][m][1] * asc;
                    *(PG8_G f32x4*)(X + off + bj * HALF) = x0; *(PG8_G f32x4*)(X + off + bj * HALF + 4) = x1;
                    if (XN) { ss += (x0[0] * x0[0] + x0[1] * x0[1]) + (x0[2] * x0[2] + x0[3] * x0[3]) + (x1[0] * x1[0] + x1[1] * x1[1]) + (x1[2] * x1[2] + x1[3] * x1[3]);
                        const f32x4 y0 = x0 * gv[bj][0], y1 = x1 * gv[bj][1]; u32x4 w; w.x = cvt_pk_bf16(y0[0], y0[1]); w.y = cvt_pk_bf16(y0[2], y0[3]); w.z = cvt_pk_bf16(y1[0], y1[1]); w.w = cvt_pk_bf16(y1[2], y1[3]);
                        *(PG8_G u32x4*)(XN + off + bj * HALF) = w; } }
                if (XN) { const int ln = fq * 16 + fr;
                    ss += __builtin_bit_cast(float, __builtin_amdgcn_ds_bpermute((ln ^ 16) << 2, __builtin_bit_cast(int, ss))); ss += __builtin_bit_cast(float, __builtin_amdgcn_ds_bpermute((ln ^ 32) << 2, __builtin_bit_cast(int, ss)));
                    if (fq == 0) ((PG8_G float*)ssq)[(size_t)(row0 + ai * HALF + m * 16) * 16 + u.pn * 4 + wc] = ss; } }
        }
    }
};
template <bool F8> struct EpiSwiglu {
    static constexpr bool PERM = true, AFTER_DRAIN = false, FRESH = false;
    bf16_t* H; int ldh; float insc, outsc; const float* ssq;
    __device__ __forceinline__ void operator()(const f32x4 (&acc)[2][2][4][2], const Unit& u, int wr, int wc, int fr, int fq) const {
        const int row0 = u.pm * BM + wr * 64 + fr, col0 = u.pn * HALF + wc * 32 + 8 * fq;
#pragma unroll
        for (int ai = 0; ai < 2; ++ai)
#pragma unroll
            for (int m = 0; m < 4; ++m) {
                const f32x4 g0 = acc[ai][0][m][0], g1 = acc[ai][0][m][1], u0 = acc[ai][1][m][0], u1 = acc[ai][1][m][1];
                float sg = ssq ? row_rstd(ssq, row0 + ai * HALF + m * 16) : 1.f, su = sg; if (F8) { sg *= insc; su *= insc * outsc; }
                const float k1 = -1.4426950408889634f * sg, ic = __builtin_amdgcn_rcpf(sg * su);
                f32x4 t0 = g0 * k1, t1 = g1 * k1;
#pragma unroll
                for (int i = 0; i < 4; ++i) { t0[i] = __builtin_amdgcn_exp2f(t0[i]); t1[i] = __builtin_amdgcn_exp2f(t1[i]); }
                t0 = t0 * ic + ic; t1 = t1 * ic + ic;
#pragma unroll
                for (int i = 0; i < 4; ++i) { t0[i] = __builtin_amdgcn_rcpf(t0[i]); t1[i] = __builtin_amdgcn_rcpf(t1[i]); }
                const f32x4 h0 = (g0 * u0) * t0, h1 = (g1 * u1) * t1;
                if (F8) { typedef unsigned u32x2 __attribute__((ext_vector_type(2))); u32x2 w; w.x = pk4_fp8(h0[0], h0[1], h0[2], h0[3]); w.y = pk4_fp8(h1[0], h1[1], h1[2], h1[3]);
                    *(PG8_G u32x2*)((unsigned char*)H + (size_t)(row0 + ai * HALF + m * 16) * ldh + col0) = w;
                } else { bf16_t* rowp = H + (size_t)(row0 + ai * HALF + m * 16) * ldh + col0;
                    u32x4 w; w.x = cvt_pk_bf16(h0[0], h0[1]); w.y = cvt_pk_bf16(h0[2], h0[3]); w.z = cvt_pk_bf16(h1[0], h1[1]); w.w = cvt_pk_bf16(h1[2], h1[3]);
                    *(PG8_G u32x4*)rowp = w; }
            }
    }
};
struct MoeOrder {
    int nM, nN, nwg, G, c; int tb1, tb2, tb3, tb4, tb5, tb6, tb7;
    __device__ __forceinline__ void init(const int (&cnt)[8], int nN_, int G_, int c_) {
        int t = 0; t += (cnt[0] + 255) >> 8; tb1 = t; t += (cnt[1] + 255) >> 8; tb2 = t; t += (cnt[2] + 255) >> 8; tb3 = t; t += (cnt[3] + 255) >> 8; tb4 = t;
        t += (cnt[4] + 255) >> 8; tb5 = t; t += (cnt[5] + 255) >> 8; tb6 = t; t += (cnt[6] + 255) >> 8; tb7 = t; t += (cnt[7] + 255) >> 8;
        nM = t; nN = nN_; nwg = nM * nN; G = G_; c = c_; }
    __device__ __forceinline__ bool next(int i, Unit& u) const {
        const long L = (long)i * G + c; if (L >= nwg) return false;
        int wgid = (int)L; { const int q = nwg / NXCD, r = nwg % NXCD, xcd = wgid % NXCD, off = wgid / NXCD; wgid = (xcd < r ? xcd * (q + 1) : r * (q + 1) + (xcd - r) * q) + off; }
        const int nig = WGM * nN, gid = wgid / nig, fm = gid * WGM, gsz = (nM - fm) < WGM ? (nM - fm) : WGM;
        u.pm = fm + ((wgid % nig) % gsz); u.pn = (wgid % nig) / gsz;
        const int e = (u.pm >= tb1) + (u.pm >= tb2) + (u.pm >= tb3) + (u.pm >= tb4) + (u.pm >= tb5) + (u.pm >= tb6) + (u.pm >= tb7);
        u.pb = e * nN + u.pn; return true;
    }
    __device__ __forceinline__ void a_ready(const Unit&) const {}
    __device__ __forceinline__ void done(const Unit&) const {}
};

template <class Epi, class Sched, bool ALIGN_EPI = false, bool SP2 = false, bool FP8 = false>
__device__ __forceinline__ void gemm_phase(PG8_LAS unsigned char* lds, const Gemm g, const Sched& S, const Epi& E, const int wid_in) {
    int lane_; asm volatile("v_mbcnt_lo_u32_b32 %0, -1, 0\n\tv_mbcnt_hi_u32_b32 %0, -1, %0" : "=v"(lane_));
    const int wid = wid_in, lane = lane_, tid = wid * 64 + lane, wr = wid >> 2, wc = wid & 3, fr = lane & 15, fq = lane >> 4;
    const int K = g.K, nt = K / BK;
    unsigned voffA[2], voffB[2];
#pragma unroll
    for (int i = 0; i < 2; ++i) { int R, C; stage_rc(tid * 16 + i * 8192, R, C); const int Rb = Epi::PERM ? ((R & ~31) + perm32(R & 31)) : R;
        voffA[i] = (unsigned)(R * K + C) * 2u; voffB[i] = (unsigned)(Rb * K + C) * 2u; }
    const size_t kstep = (size_t)(BK * 2);
    const size_t hstep = (size_t)HALF * K * 2;
    const size_t tstep = 2 * hstep;
    const unsigned ldsw = (unsigned)wid * 1024u;
    const unsigned ldsb = (unsigned)__builtin_amdgcn_readfirstlane((int)((unsigned)(uintptr_t)lds + ldsw));
    const int aoff = lds_byte(wr * 64 + fr, fq * 8), boff = lds_byte(wc * 32 + fr, fq * 8);
#define PG8_SA(b, h) (((b) * 2 + (h)) * HTB)
#define PG8_SB(b, h) ((4 + (b) * 2 + (h)) * HTB)
#define PG8_STAGE(bufoff, gbase, voff) do { _Pragma("unroll") for (int _i = 0; _i < 2; ++_i) { unsigned keep_; \
        asm volatile("s_mov_b32 %0, m0\n\ts_mov_b32 m0, %3\n\ts_nop 0\n\tglobal_load_lds_dwordx4 %1, %2\n\ts_mov_b32 m0, %0" : "=&s"(keep_) : "v"((voff)[_i]), "s"((const char*)(gbase)), "s"(ldsb + (unsigned)((bufoff) + _i * 8192)) : "memory"); } } while (0)
#define PG8_LDA(dst, b, h) do { _Pragma("unroll") for (int m = 0; m < 4; ++m) _Pragma("unroll") for (int k = 0; k < 2; ++k) dst[m][k] = *(const PG8_LAS bf16x8*)(lds + PG8_SA(b, h) + aoff + m * 2048 + k * 1024); } while (0)
#define PG8_LDB(dst, b, h) do { _Pragma("unroll") for (int n = 0; n < 2; ++n) _Pragma("unroll") for (int k = 0; k < 2; ++k) dst[n][k] = *(const PG8_LAS bf16x8*)(lds + PG8_SB(b, h) + boff + n * 2048 + k * 1024); } while (0)
#define PG8_MMA(ai, bj, At, Bt) do { __builtin_amdgcn_s_setprio(1); _Pragma("unroll") for (int m = 0; m < 4; ++m) _Pragma("unroll") for (int n = 0; n < 2; ++n) { \
        if constexpr (FP8) { typedef int v4i_ __attribute__((ext_vector_type(4))); typedef int v8i_ __attribute__((ext_vector_type(8))); \
            const v8i_ b8 = __builtin_shufflevector(__builtin_bit_cast(v4i_, Bt[n][0]), __builtin_bit_cast(v4i_, Bt[n][1]), 0, 1, 2, 3, 4, 5, 6, 7), a8 = __builtin_shufflevector(__builtin_bit_cast(v4i_, At[m][0]), __builtin_bit_cast(v4i_, At[m][1]), 0, 1, 2, 3, 4, 5, 6, 7); \
            acc[ai][bj][m][n] = __builtin_amdgcn_mfma_scale_f32_16x16x128_f8f6f4(b8, a8, acc[ai][bj][m][n], 0, 0, 0, 0, 0, 0); } \
        else { _Pragma("unroll") for (int k = 0; k < 2; ++k) acc[ai][bj][m][n] = __builtin_amdgcn_mfma_f32_16x16x32_bf16(Bt[n][k], At[m][k], acc[ai][bj][m][n], 0, 0, 0); } } \
        __builtin_amdgcn_s_setprio(0); } while (0)
#define PG8_WAIT_V(n) asm volatile("s_waitcnt vmcnt(" #n ")" ::: "memory")
#define PG8_WAIT_L(n) asm volatile("s_waitcnt lgkmcnt(" #n ")" ::: "memory")
#define PG8_BAR __builtin_amdgcn_s_barrier()
#define PG8_SCHED __builtin_amdgcn_sched_barrier(0)
    Unit cur, nxt; int ui = 0;
    if (!S.next(0, cur)) return;
    f32x4 acc[2][2][4][2];
#pragma unroll
    for (int a = 0; a < 2; ++a)
#pragma unroll
        for (int b = 0; b < 2; ++b)
#pragma unroll
            for (int m = 0; m < 4; ++m)
#pragma unroll
                for (int n = 0; n < 2; ++n) acc[a][b][m][n] = (f32x4){0.f, 0.f, 0.f, 0.f};
    bf16x8 At[4][2], B0[2][2], B1[2][2];
    const char* cA = (const char*)g.A + (size_t)cur.pm * tstep; const char* cB = (const char*)g.Bt + (size_t)cur.pb * tstep;
    S.a_ready(cur);
    if constexpr (SP2) {
        PG8_STAGE(PG8_SB(0, 0), cB, voffB); PG8_STAGE(PG8_SB(0, 1), cB + hstep, voffB); PG8_STAGE(PG8_SA(0, 0), cA, voffA); PG8_STAGE(PG8_SA(0, 1), cA + hstep, voffA);
        if (wr == 1) PG8_BAR;
        PG8_WAIT_V(2); PG8_BAR;
        PG8_STAGE(PG8_SB(1, 0), cB + kstep, voffB); PG8_STAGE(PG8_SA(1, 0), cA + kstep, voffA); PG8_STAGE(PG8_SB(1, 1), cB + hstep + kstep, voffB);
        PG8_WAIT_V(6); PG8_BAR;
    } else {
        PG8_STAGE(PG8_SB(0, 0), cB, voffB); PG8_STAGE(PG8_SA(0, 0), cA, voffA); PG8_STAGE(PG8_SB(0, 1), cB + hstep, voffB); PG8_STAGE(PG8_SA(0, 1), cA + hstep, voffA);
        if (wr == 1) PG8_BAR;
        PG8_WAIT_V(4); PG8_BAR;
        PG8_STAGE(PG8_SB(1, 0), cB + kstep, voffB); PG8_STAGE(PG8_SA(1, 0), cA + kstep, voffA); PG8_STAGE(PG8_SB(1, 1), cB + hstep + kstep, voffB);
        PG8_WAIT_V(6); PG8_BAR;
    }
    for (;;) {
        const bool has_next = S.next(ui + 1, nxt);
        const char* nA = has_next ? (const char*)g.A + (size_t)nxt.pm * tstep : cA; const char* nB = has_next ? (const char*)g.Bt + (size_t)nxt.pb * tstep : cB;
        for (int t = 0; t < nt; t += 2) {
            const bool last = (t == nt - 2);
            const char* a1 = cA + (size_t)(t + 1) * kstep;
            const char* a2 = last ? nA : cA + (size_t)(t + 2) * kstep; const char* b2 = last ? nB : cB + (size_t)(t + 2) * kstep;
            const char* a3 = a2 + kstep; const char* b3 = b2 + kstep;
            if (last && has_next) S.a_ready(nxt);
            if constexpr (SP2) {
            PG8_LDB(B0, 0, 0); PG8_LDB(B1, 0, 1); PG8_SCHED; PG8_LDA(At, 0, 0); PG8_STAGE(PG8_SA(1, 1), a1 + hstep, voffA);
            PG8_WAIT_V(8); PG8_WAIT_L(0); PG8_BAR; PG8_MMA(0, 0, At, B0); PG8_MMA(0, 1, At, B1); PG8_BAR; PG8_SCHED;
            PG8_LDA(At, 0, 1); PG8_STAGE(PG8_SB(0, 0), b2, voffB); PG8_STAGE(PG8_SB(0, 1), b2 + hstep, voffB); PG8_STAGE(PG8_SA(0, 0), a2, voffA);
            PG8_WAIT_V(8); PG8_WAIT_L(0); PG8_BAR; PG8_MMA(1, 0, At, B0); PG8_MMA(1, 1, At, B1); PG8_BAR; PG8_SCHED;
            PG8_LDB(B0, 1, 0); PG8_LDB(B1, 1, 1); PG8_SCHED; PG8_LDA(At, 1, 0); PG8_STAGE(PG8_SA(0, 1), a2 + hstep, voffA);
            PG8_WAIT_V(8); PG8_WAIT_L(0); PG8_BAR; PG8_MMA(0, 0, At, B0); PG8_MMA(0, 1, At, B1); PG8_BAR; PG8_SCHED;
            PG8_LDA(At, 1, 1); PG8_STAGE(PG8_SB(1, 0), b3, voffB); PG8_STAGE(PG8_SB(1, 1), b3 + hstep, voffB); PG8_STAGE(PG8_SA(1, 0), a3, voffA);
            PG8_WAIT_V(8); PG8_WAIT_L(0); PG8_BAR; PG8_MMA(1, 0, At, B0); PG8_MMA(1, 1, At, B1); PG8_BAR; PG8_SCHED;
            } else {
            PG8_LDB(B0, 0, 0); PG8_SCHED; PG8_LDA(At, 0, 0); PG8_STAGE(PG8_SA(1, 1), a1 + hstep, voffA);
            PG8_WAIT_L(8); PG8_BAR; PG8_WAIT_L(0); PG8_MMA(0, 0, At, B0); PG8_BAR; PG8_SCHED;
            PG8_LDB(B1, 0, 1); PG8_STAGE(PG8_SB(0, 0), b2, voffB);
            PG8_BAR; PG8_WAIT_L(0); PG8_MMA(0, 1, At, B1); PG8_BAR;
            PG8_LDA(At, 0, 1); PG8_STAGE(PG8_SA(0, 0), a2, voffA);
            PG8_BAR; PG8_WAIT_L(0); PG8_MMA(1, 0, At, B0); PG8_BAR; PG8_SCHED;
            PG8_STAGE(PG8_SB(0, 1), b2 + hstep, voffB);
            PG8_WAIT_V(6); PG8_BAR; PG8_MMA(1, 1, At, B1); PG8_BAR;
            PG8_LDB(B0, 1, 0); PG8_SCHED; PG8_LDA(At, 1, 0); PG8_STAGE(PG8_SA(0, 1), a2 + hstep, voffA);
            PG8_WAIT_L(8); PG8_BAR; PG8_WAIT_L(0); PG8_MMA(0, 0, At, B0); PG8_BAR; PG8_SCHED;
            PG8_LDB(B1, 1, 1); PG8_STAGE(PG8_SB(1, 0), b3, voffB);
            PG8_BAR; PG8_WAIT_L(0); PG8_MMA(0, 1, At, B1); PG8_BAR;
            PG8_LDA(At, 1, 1); PG8_STAGE(PG8_SA(1, 0), a3, voffA);
            PG8_BAR; PG8_WAIT_L(0); PG8_MMA(1, 0, At, B0); PG8_BAR; PG8_SCHED;
            PG8_STAGE(PG8_SB(1, 1), b3 + hstep, voffB);
            PG8_WAIT_V(6); PG8_BAR; PG8_MMA(1, 1, At, B1); PG8_BAR;
            }
        }
        if constexpr (ALIGN_EPI) { if (wr == 0) PG8_BAR; }
        if constexpr (!Epi::AFTER_DRAIN) {
            if constexpr (FP8 || Epi::FRESH) { int l2_; asm volatile("v_mbcnt_lo_u32_b32 %0, -1, 0\n\tv_mbcnt_hi_u32_b32 %0, -1, %0" : "=v"(l2_)); E(acc, cur, wr, wc, l2_ & 15, l2_ >> 4); }
            else E(acc, cur, wr, wc, fr, fq);
            S.done(cur); }
        if (!has_next) break;
#pragma unroll
        for (int a = 0; a < 2; ++a)
#pragma unroll
            for (int b = 0; b < 2; ++b)
#pragma unroll
                for (int m = 0; m < 4; ++m)
#pragma unroll
                    for (int n = 0; n < 2; ++n) acc[a][b][m][n] = (f32x4){0.f, 0.f, 0.f, 0.f};
        cur = nxt; cA = nA; cB = nB; ++ui;
        if constexpr (ALIGN_EPI) { if (wr == 1) PG8_BAR; }
    }
    PG8_WAIT_V(0);
    if constexpr (!ALIGN_EPI) { if (wr == 0) PG8_BAR; }
    PG8_BAR;
    if constexpr (Epi::AFTER_DRAIN) { E.fused(acc, cur, wr, wc, fr, fq, lds, wid, lane); S.done(cur); }
#undef PG8_SA
#undef PG8_SB
#undef PG8_STAGE
#undef PG8_LDA
#undef PG8_LDB
#undef PG8_MMA
#undef PG8_WAIT_V
#undef PG8_WAIT_L
#undef PG8_BAR
#undef PG8_SCHED
}
}
#include <hip/hip_bf16.h>
#include <cmath>
namespace attn_body {
using bf16=__hip_bfloat16;
using bf16x8=__attribute__((ext_vector_type(8)))short;
using s16x4=__attribute__((ext_vector_type(4)))short;
using f32x16=__attribute__((ext_vector_type(16)))float;
using u32x4=__attribute__((ext_vector_type(4)))unsigned;
constexpr int D=64;
constexpr int NW=8,QBLK=32,QB=QBLK*NW,KVBLK=64;
constexpr int ATTN_UNIT_ROWS=QB;
__device__ __forceinline__ int crow(int r,int hi){return (r&3)+8*(r>>2)+4*hi;}
#define SBAR() __builtin_amdgcn_sched_barrier(0)
__device__ __forceinline__ void cmask_blk(f32x16&p0,f32x16&p1,int jb,int wid){
  if(jb>(wid>>1)){ const float NEG=-INFINITY;
    #pragma unroll
    for(int r=0;r<16;++r){p0[r]=NEG;p1[r]=NEG;} }
}
__device__ __forceinline__ void alibi(f32x16&p0,f32x16&p1,float dq,float nsl2){
  #pragma unroll
  for(int r=0;r<16;++r){ const float e=(float)((r&3)+8*(r>>2)); p0[r]=__builtin_fmaf(__builtin_fabsf(dq-e),nsl2,p0[r]); p1[r]=__builtin_fmaf(__builtin_fabsf(dq-e-32.f),nsl2,p1[r]); }
}

constexpr int NSLOT=3, SLOTB=8192;
constexpr int LDS_K=0, LDS_V=NSLOT*SLOTB, LDS_WS=2*NSLOT*SLOTB, LDS_OST=LDS_WS+NW*64*4, LDS_BYTES=LDS_OST+NW*4096;
constexpr float C2=0.125f*1.4426950408889634f;
__device__ __forceinline__ void glds16(const void*gsrc,unsigned lds_dst){unsigned keep;
  asm volatile("s_mov_b32 %0, m0\n\ts_mov_b32 m0, %2\n\ts_nop 0\n\tglobal_load_lds_dwordx4 %1, off\n\ts_mov_b32 m0, %0":"=&s"(keep):"v"(gsrc),"s"(lds_dst):"memory");}
__device__ __forceinline__ float max3f(float a,float b,float c){float r;asm("v_max3_f32 %0, %1, %2, %3":"=v"(r):"v"(a),"v"(b),"v"(c));return r;}
__device__ __forceinline__ float max2f(float a,float b){float r;asm("v_max_f32_e32 %0, %1, %2":"=v"(r):"v"(a),"v"(b));return r;}
__device__ __forceinline__ float fadd_s(float a,float b){float r;asm("v_add_f32_e32 %0, %1, %2":"=v"(r):"v"(a),"v"(b));return r;}
__device__ __forceinline__ float fsub_s(float a,float b){float r;asm("v_sub_f32_e32 %0, %1, %2":"=v"(r):"v"(a),"v"(b));return r;}
typedef float f32x2_t __attribute__((ext_vector_type(2))); typedef __bf16 bf16x2_t __attribute__((ext_vector_type(2)));
__device__ __forceinline__ unsigned cvtpk_s(float lo,float hi){f32x2_t v={lo,hi};bf16x2_t b=__builtin_convertvector(v,bf16x2_t);return __builtin_bit_cast(unsigned,b);}
#define WAIT_BAR(N) asm volatile("s_waitcnt vmcnt(" #N ") lgkmcnt(0)\n\ts_barrier":::"memory")

__device__ __forceinline__ void qkt(f32x16&p0,f32x16&p1,const char*Kslot,const bf16x8*qr,const f32x16&negm,int r32,int hi){
  const char*kb=Kslot+hi*1024+r32*16;
  #pragma unroll
  for(int d0=0;d0<4;++d0){
    const bf16x8 b0=*reinterpret_cast<const bf16x8*>(kb+d0*2048);
    const bf16x8 b1=*reinterpret_cast<const bf16x8*>(kb+d0*2048+512);
    if(d0==0){p0=__builtin_amdgcn_mfma_f32_32x32x16_bf16(b0,qr[0],negm,0,0,0);p1=__builtin_amdgcn_mfma_f32_32x32x16_bf16(b1,qr[0],negm,0,0,0);}
    else{p0=__builtin_amdgcn_mfma_f32_32x32x16_bf16(b0,qr[d0],p0,0,0,0);p1=__builtin_amdgcn_mfma_f32_32x32x16_bf16(b1,qr[d0],p1,0,0,0);}}
}
typedef __attribute__((address_space(3))) const char* lds_cptr;
typedef short v4i16_t __attribute__((ext_vector_type(4)));
__device__ __forceinline__ void kload8(bf16x8*kf,lds_cptr kp){
  kf[0]=*(const __attribute__((address_space(3))) bf16x8*)(kp);      kf[1]=*(const __attribute__((address_space(3))) bf16x8*)(kp+512);
  kf[2]=*(const __attribute__((address_space(3))) bf16x8*)(kp+2048); kf[3]=*(const __attribute__((address_space(3))) bf16x8*)(kp+2560);
  kf[4]=*(const __attribute__((address_space(3))) bf16x8*)(kp+4096); kf[5]=*(const __attribute__((address_space(3))) bf16x8*)(kp+4608);
  kf[6]=*(const __attribute__((address_space(3))) bf16x8*)(kp+6144); kf[7]=*(const __attribute__((address_space(3))) bf16x8*)(kp+6656);
}
__device__ __forceinline__ void kload2(bf16x8*kf,lds_cptr kp,int j){ kf[2*j]=*(const __attribute__((address_space(3))) bf16x8*)(kp+j*2048); kf[2*j+1]=*(const __attribute__((address_space(3))) bf16x8*)(kp+j*2048+512); }
__device__ __forceinline__ s16x4 vtr(lds_cptr p){ return __builtin_bit_cast(s16x4,__builtin_amdgcn_ds_read_tr16_b64_v4i16((__attribute__((address_space(3))) v4i16_t*)p)); }
__device__ __forceinline__ float rowmax(const f32x16&p0,const f32x16&p1){
  float a=max3f(p0[0],p0[1],p1[0]),b=max3f(p0[2],p0[3],p1[1]);a=max3f(a,p1[2],p1[3]);
  #pragma unroll
  for(int r=4;r<16;r+=4){a=max3f(a,p0[r],p0[r+1]);b=max3f(b,p0[r+2],p0[r+3]);a=max3f(a,p1[r],p1[r+1]);b=max3f(b,p1[r+2],p1[r+3]);}
  const float m=max2f(a,b);
  auto rr=__builtin_amdgcn_permlane32_swap(__float_as_uint(m),__float_as_uint(m),false,false);
  return max2f(__uint_as_float(rr[0]),__uint_as_float(rr[1]));
}
__device__ __forceinline__ void pv(f32x16*o,int vb,bf16x8 pa0,bf16x8 pa1,bf16x8 pa2,bf16x8 pa3){
  #pragma unroll
  for(int d0=0;d0<2;++d0){s16x4 lo[4],hi[4];
    #pragma unroll
    for(int ks=0;ks<4;++ks){
      asm volatile("ds_read_b64_tr_b16 %0,%1 offset:%c2":"=&v"(lo[ks]):"v"(vb),"i"(d0*4096+ks*1024):"memory");
      asm volatile("ds_read_b64_tr_b16 %0,%1 offset:%c2":"=&v"(hi[ks]):"v"(vb),"i"(d0*4096+ks*1024+512):"memory");}
    asm volatile("s_waitcnt lgkmcnt(0)":::"memory");SBAR();
    #define PK(k) (bf16x8){lo[k][0],lo[k][1],lo[k][2],lo[k][3],hi[k][0],hi[k][1],hi[k][2],hi[k][3]}
    o[d0]=__builtin_amdgcn_mfma_f32_32x32x16_bf16(pa0,PK(0),o[d0],0,0,0);
    o[d0]=__builtin_amdgcn_mfma_f32_32x32x16_bf16(pa1,PK(1),o[d0],0,0,0);
    o[d0]=__builtin_amdgcn_mfma_f32_32x32x16_bf16(pa2,PK(2),o[d0],0,0,0);
    o[d0]=__builtin_amdgcn_mfma_f32_32x32x16_bf16(pa3,PK(3),o[d0],0,0,0);
    #undef PK
  }
}

#ifndef ATTN_STORE16
#define ATTN_STORE16(p,v) (*(u32x4*)(p)=(v))
#endif
template<int MODE,int THRL> __device__ __forceinline__ void attn_unit(const bf16*Qb,int qp,const bf16*__restrict__ Kh,int kp,const bf16*__restrict__ Vh,int vp,bf16*Ob,int op,int NT,int q0,float nsl2,char*shm,const int wid_in){
  int lane_; asm volatile("v_mbcnt_lo_u32_b32 %0, -1, 0\n\tv_mbcnt_hi_u32_b32 %0, -1, %0":"=v"(lane_)); const int lane=lane_,r32=lane&31,hi=lane>>5; const int wid=wid_in,tid=wid*64+lane; (void)tid;
  const bf16*Qw=Qb+(long)(wid*QBLK)*qp;
  const unsigned lds0=(unsigned)(uintptr_t)shm;
  float*wsf=(float*)(shm+LDS_WS)+wid*64;
  const bf16*ksrc=Kh+(long)lane*kp+wid*8;
  const bf16*vsrc=Vh+(long)(16*(wid&3)+(lane>>2))*vp+(wid>>2)*32+(lane&3)*8;
  const unsigned kdst=lds0+LDS_K+wid*1024, vdst=lds0+LDS_V+wid*1024;
  #define DMA_K(t,slot) glds16(ksrc+(long)(t)*KVBLK*kp,(unsigned)__builtin_amdgcn_readfirstlane(kdst+(slot)))
  #define DMA_V(t,slot) glds16(vsrc+(long)(t)*KVBLK*vp,(unsigned)__builtin_amdgcn_readfirstlane(vdst+(slot)))
  const int vb0=(int)(lds0+LDS_V)+((lane>>4)&1)*32+(lane&3)*8+(4*hi+((lane&15)>>2))*64;
  const char*Kbase=shm+LDS_K; bf16x8 kf[8];
  const lds_cptr shm3=(lds_cptr)shm; const lds_cptr kp0=shm3+LDS_K+hi*1024+r32*16; const lds_cptr vp0=shm3+LDS_V+((lane>>4)&1)*32+(lane&3)*8+(4*hi+((lane&15)>>2))*64;
  DMA_K(0,0);DMA_V(0,0);DMA_K(1,SLOTB);
  bf16x8 qr[4];
  #pragma unroll
  for(int d0=0;d0<4;++d0)qr[d0]=*reinterpret_cast<const bf16x8*>(&Qw[(long)r32*qp+d0*16+hi*8]);
  float mhat=0.f,l_reg=0.f;f32x16 o[2];float z_=0.f;asm volatile("":"+v"(z_));
  _Pragma("unroll") for(int r=0;r<16;++r){o[0][r]=z_;o[1][r]=z_;} f32x16 negm;_Pragma("unroll") for(int r=0;r<16;++r)negm[r]=z_;asm volatile("":"+v"(negm));
  const float dq0=(float)(q0+wid*QBLK+r32-4*hi);
  #define ALIBI(P0,P1,t) do{ if(MODE==0) alibi(P0,P1,dq0-(float)(64*(t)),nsl2); }while(0)
  #define CMASK(P0,P1,t) do{ if(MODE==0){int jb_=(t)-(NT-4); if(jb_>=0)cmask_blk(P0,P1,jb_,wid);} }while(0)
  bool resc=false;
  #define START(P0,P1) do{ const float rm=rm0_; resc=false; \
    { const float dl=rm; mhat=fadd_s(mhat,dl); \
      _Pragma("unroll") for(int r=0;r<16;++r){P0[r]=fsub_s(P0[r],dl);P1[r]=fsub_s(P1[r],dl);} \
      _Pragma("unroll") for(int r=0;r<16;++r)negm[r]=-mhat; asm volatile("":"+v"(negm)); } \
    _Pragma("unroll") for(int r=0;r<16;++r)P0[r]=__builtin_amdgcn_exp2f(P0[r]); }while(0)
  #define RESC() do{ if(resc){ asm volatile("s_waitcnt lgkmcnt(0)":::"memory"); \
      _Pragma("unroll") for(int d_=0;d_<2;++d_) _Pragma("unroll") for(int r=0;r<16;++r)o[d_][r]*=wsf[crow(r,hi)]; } }while(0)
  f32x16 pA0,pA1,pB0,pB1;
  int sl_prev=0,sl_cur=0,sl_next=SLOTB;
  #define ROT() do{sl_prev=sl_cur;sl_cur=sl_next;sl_next=(sl_next==(NSLOT-1)*SLOTB)?0:sl_next+SLOTB;}while(0)
  DMA_K(2,2*SLOTB);
  WAIT_BAR(3);
  qkt(pA0,pA1,Kbase,qr,negm,r32,hi);asm volatile("s_nop 15\n\ts_nop 7":"+v"(pA0),"+v"(pA1));const float rm0_=rowmax(pA0,pA1);
  ALIBI(pA0,pA1,0);CMASK(pA0,pA1,0);
  START(pA0,pA1);
  _Pragma("unroll") for(int r=0;r<16;++r)pA1[r]=__builtin_amdgcn_exp2f(pA1[r]);
  WAIT_BAR(0);
  DMA_K(3,0);DMA_V(1,SLOTB);
  ROT();
  kload8(kf,kp0+sl_cur);
  WAIT_BAR(2);
  s16x4 vlo[8],vhi[8]; u32x4 pw0,pw1,pw2,pw3;
  #define PKW(P,B) cvtpk_s(P[B],P[B+1])
  #define PAF(k) __builtin_bit_cast(bf16x8,pw##k)
  #define VFR(i) (bf16x8){vlo[i][0],vlo[i][1],vlo[i][2],vlo[i][3],vhi[i][0],vhi[i][1],vhi[i][2],vhi[i][3]}
  #define PIN(x) asm volatile("":"+v"(x))
  #define MX3(a,b,c) __builtin_fmaxf(__builtin_fmaxf((a),(b)),(c))
  #define GAPA(MF,A0,A1,A2,A3,W0,W1,PW) do{ MF; sacc+=A0; sacc+=A1; sacc+=A2; sacc+=A3; PIN(sacc); W0; W1; PIN(PW); SBAR(); }while(0)
  #define EX(v) __builtin_amdgcn_exp2f(v)
  #define GAPB(MF,X,B) do{ MF; X[B]=EX(X[B]); X[B+1]=EX(X[B+1]); X[B+2]=EX(X[B+2]); X[B+3]=EX(X[B+3]); PIN(X); SBAR(); }while(0)
  #define VRD(i) do{ vlo[i]=vtr(vp_+(((i)>>2)*4096+((i)&3)*1024)); vhi[i]=vtr(vp_+(((i)>>2)*4096+((i)&3)*1024+512)); }while(0)
  #define KRD(G,j) do{ if(G){ kload2(kf,kp0+sl_next,j); SBAR(); } }while(0)
  #define STEP(C0,C1,P0,P1,t,GK,GV,GL) do{ SBAR(); \
    const lds_cptr vp_=vp0+sl_prev; \
    VRD(0); SBAR(); float sacc=(P0[0]+P0[1]); \
    GAPA(C0=__builtin_amdgcn_mfma_f32_32x32x16_bf16(kf[0],qr[0],negm,0,0,0), P0[2],P0[3],P0[4],P0[5],     pw0[0]=PKW(P0,0), pw0[1]=PKW(P0,2), pw0); \
    VRD(4); SBAR(); GAPA(C1=__builtin_amdgcn_mfma_f32_32x32x16_bf16(kf[1],qr[0],negm,0,0,0), P0[6],P0[7],P0[8],P0[9],     pw0[2]=PKW(P0,4), pw0[3]=PKW(P0,6), pw0); \
    VRD(1); SBAR(); GAPA(C0=__builtin_amdgcn_mfma_f32_32x32x16_bf16(kf[2],qr[1],C0,0,0,0),   P0[10],P0[11],P0[12],P0[13], pw1[0]=PKW(P0,8), pw1[1]=PKW(P0,10), pw1); \
    VRD(5); SBAR(); GAPA(C1=__builtin_amdgcn_mfma_f32_32x32x16_bf16(kf[3],qr[1],C1,0,0,0),   P0[14],P0[15],P1[0],P1[1],   pw1[2]=PKW(P0,12),pw1[3]=PKW(P0,14), pw1); \
    VRD(2); SBAR(); GAPA(C0=__builtin_amdgcn_mfma_f32_32x32x16_bf16(kf[4],qr[2],C0,0,0,0),   P1[2],P1[3],P1[4],P1[5],     pw2[0]=PKW(P1,0), pw2[1]=PKW(P1,2), pw2); \
    VRD(6); SBAR(); GAPA(C1=__builtin_amdgcn_mfma_f32_32x32x16_bf16(kf[5],qr[2],C1,0,0,0),   P1[6],P1[7],P1[8],P1[9],     pw2[2]=PKW(P1,4), pw2[3]=PKW(P1,6), pw2); \
    VRD(3); SBAR(); GAPA(C0=__builtin_amdgcn_mfma_f32_32x32x16_bf16(kf[6],qr[3],C0,0,0,0),   P1[10],P1[11],P1[12],P1[13], pw3[0]=PKW(P1,8), pw3[1]=PKW(P1,10), pw3); \
    VRD(7); SBAR(); GAPA(C1=__builtin_amdgcn_mfma_f32_32x32x16_bf16(kf[7],qr[3],C1,0,0,0),   P1[14],P1[15],0.f,0.f,       pw3[2]=PKW(P1,12),pw3[3]=PKW(P1,14), pw3); \
    l_reg+=sacc; \
    if(GK){DMA_K((t)+3,sl_cur);} if(GV){DMA_V((t)+1,sl_next);} \
    ALIBI(C0,C1,t); CMASK(C0,C1,t); \
    { float a=MX3(C0[0],C0[1],C1[0]),b=MX3(C0[2],C0[3],C1[1]); a=MX3(a,C1[2],C1[3]); \
      _Pragma("unroll") for(int r=4;r<16;r+=4){a=MX3(a,C0[r],C0[r+1]);b=MX3(b,C0[r+2],C0[r+3]);a=MX3(a,C1[r],C1[r+1]);b=MX3(b,C1[r+2],C1[r+3]);} \
      float rm=__builtin_fmaxf(a,b); { auto rr=__builtin_amdgcn_permlane32_swap(__float_as_uint(rm),__float_as_uint(rm),false,false); rm=__builtin_fmaxf(__uint_as_float(rr[0]),__uint_as_float(rr[1])); } \
      resc=false; \
      if(__builtin_expect(__any(rm>(float)THRL),0)){ const float dl=__builtin_fmaxf(rm,0.f); mhat+=dl; \
        _Pragma("unroll") for(int r=0;r<16;++r){C0[r]-=dl;C1[r]-=dl;} \
        _Pragma("unroll") for(int r=0;r<16;++r)negm[r]=-mhat; asm volatile("":"+v"(negm)); \
        const float f=__builtin_amdgcn_exp2f(-dl); l_reg*=f; if(hi==0)wsf[r32]=f; resc=true; } } \
    SBAR(); \
    GAPB(o[0]=__builtin_amdgcn_mfma_f32_32x32x16_bf16(PAF(0),VFR(0),o[0],0,0,0), C0,0); \
    GAPB(o[1]=__builtin_amdgcn_mfma_f32_32x32x16_bf16(PAF(0),VFR(4),o[1],0,0,0), C0,4); \
    KRD(GL,0); GAPB(o[0]=__builtin_amdgcn_mfma_f32_32x32x16_bf16(PAF(1),VFR(1),o[0],0,0,0), C0,8); \
    KRD(GL,1); GAPB(o[1]=__builtin_amdgcn_mfma_f32_32x32x16_bf16(PAF(1),VFR(5),o[1],0,0,0), C0,12); \
    KRD(GL,2); GAPB(o[0]=__builtin_amdgcn_mfma_f32_32x32x16_bf16(PAF(2),VFR(2),o[0],0,0,0), C1,0); \
    KRD(GL,3); GAPB(o[1]=__builtin_amdgcn_mfma_f32_32x32x16_bf16(PAF(2),VFR(6),o[1],0,0,0), C1,4); \
    GAPB(o[0]=__builtin_amdgcn_mfma_f32_32x32x16_bf16(PAF(3),VFR(3),o[0],0,0,0), C1,8); \
    GAPB(o[1]=__builtin_amdgcn_mfma_f32_32x32x16_bf16(PAF(3),VFR(7),o[1],0,0,0), C1,12); \
    }while(0)
  int t=1;
  #undef CMASK
  #define CMASK(P0,P1,t) do{}while(0)
  for(;t+5<NT;t+=2){
    STEP(pB0,pB1,pA0,pA1,t,true,true,true);     WAIT_BAR(2); RESC(); ROT();
    STEP(pA0,pA1,pB0,pB1,t+1,true,true,true);   WAIT_BAR(2); RESC(); ROT();
  }
  #undef CMASK
  #define CMASK(P0,P1,t) do{ if(MODE==0){int jb_=(t)-(NT-4); if(jb_>=0)cmask_blk(P0,P1,jb_,wid);} }while(0)
  #define ENDW(tt) do{ if((tt)+3<NT){WAIT_BAR(2);} else if((tt)+2<NT){WAIT_BAR(1);} else {WAIT_BAR(0);} }while(0)
  for(;t+1<NT;t+=2){
    STEP(pB0,pB1,pA0,pA1,t,(t+3<NT),(t+1<NT),(t+1<NT));       ENDW(t);   RESC(); ROT();
    STEP(pA0,pA1,pB0,pB1,t+1,(t+4<NT),(t+2<NT),(t+2<NT));     ENDW(t+1); RESC(); ROT();
  }
  STEP(pB0,pB1,pA0,pA1,NT-1,false,false,false); RESC();
  { float sacc=pB0[0]+pB0[1]; _Pragma("unroll") for(int r=2;r<16;++r)sacc+=pB0[r]; _Pragma("unroll") for(int r=0;r<16;++r)sacc+=pB1[r]; l_reg+=sacc;
    pw0=(u32x4){PKW(pB0,0),PKW(pB0,2),PKW(pB0,4),PKW(pB0,6)};pw1=(u32x4){PKW(pB0,8),PKW(pB0,10),PKW(pB0,12),PKW(pB0,14)};pw2=(u32x4){PKW(pB1,0),PKW(pB1,2),PKW(pB1,4),PKW(pB1,6)};pw3=(u32x4){PKW(pB1,8),PKW(pB1,10),PKW(pB1,12),PKW(pB1,14)};
    SBAR(); pv(o,vb0+sl_cur,PAF(0),PAF(1),PAF(2),PAF(3)); }
  #undef PKW
  #undef PAF
  #undef VFR
  #undef PIN
  #undef MX3
  #undef GAPA
  #undef GAPB
  #undef EX
  #undef VRD
  #undef KRD
  #undef STEP
  #undef ENDW
  {auto rr=__builtin_amdgcn_permlane32_swap(__float_as_uint(l_reg),__float_as_uint(l_reg),false,false);l_reg=__uint_as_float(rr[0])+__uint_as_float(rr[1]);}
  if(hi==0)wsf[32+r32]=l_reg;asm volatile("s_waitcnt lgkmcnt(0)":::"memory");
  float rli[16];
  #pragma unroll
  for(int r=0;r<16;++r)rli[r]=__builtin_amdgcn_rcpf(wsf[32+crow(r,hi)]);
  bf16*Ow=Ob+(long)(wid*QBLK)*op;
  { bf16*stg=(bf16*)(shm+LDS_OST)+wid*2048;
    #pragma unroll
    for(int r=0;r<16;++r){const int orow=crow(r,hi);
      #pragma unroll
      for(int d0=0;d0<2;++d0)stg[orow*64+d0*32+r32]=__float2bfloat16(o[d0][r]*rli[r]);}
    asm volatile("s_waitcnt lgkmcnt(0)":::"memory");
    #pragma unroll
    for(int i=0;i<4;++i){const int row=i*8+(lane>>3),ch=lane&7; const u32x4 v=*(const u32x4*)(stg+row*64+ch*8); ATTN_STORE16(Ow+(long)row*op+ch*8,v);} }
  asm volatile("s_waitcnt lgkmcnt(0)\n\ts_barrier":::"memory");
  #undef DMA_K
  #undef DMA_V
  #undef CMASK
  #undef ALIBI
  #undef START
  #undef RESC
  #undef ROT
}
constexpr int L2_K=0, L2_V0=NSLOT*SLOTB, L2_V1=2*NSLOT*SLOTB, L2_WS=3*NSLOT*SLOTB, L2_QS=L2_WS+NW*64*4, L2_QSW=4608, LDS2_BYTES=L2_QS+NW*L2_QSW;
template<int THRL> __device__ __forceinline__ void attn_unit2(const bf16*Qb,int qp,const bf16*__restrict__ Kh,int kp,const bf16*__restrict__ Vh,int vp,bf16*Ob,int op,int NT,int q0,float nsl2,char*shm,const int wid_in){
  int lane_; asm volatile("v_mbcnt_lo_u32_b32 %0, -1, 0\n\tv_mbcnt_hi_u32_b32 %0, -1, %0":"=v"(lane_)); const int lane=lane_,r32=lane&31,hi=lane>>5; const int wid=wid_in,tid=wid*64+lane; (void)tid; constexpr int MODE=0;
  const bf16*Qw=Qb+(long)(wid*QBLK)*qp;
  const unsigned lds0=(unsigned)(uintptr_t)shm;
  float*wsf=(float*)(shm+L2_WS)+wid*64;
  const bf16*ksrc=Kh+(long)lane*kp+wid*8;
  const bf16*vsrc=Vh+(long)(16*(wid&3)+(lane>>2))*vp+(wid>>2)*32+(lane&3)*8;
  const unsigned kdst=lds0+L2_K+wid*1024, vdst=lds0+L2_V0+wid*1024, vdst1=lds0+L2_V1+wid*1024;
  #define DMA_K(t,slot) glds16(ksrc+(long)(t)*KVBLK*kp,(unsigned)__builtin_amdgcn_readfirstlane(kdst+(slot)))
  #define DMA_V(t,slot) do{ glds16(vsrc+(long)(t)*KVBLK*vp,(unsigned)__builtin_amdgcn_readfirstlane(vdst+(slot))); glds16(vsrc+64+(long)(t)*KVBLK*vp,(unsigned)__builtin_amdgcn_readfirstlane(vdst1+(slot))); }while(0)
  const int vb0=(int)(lds0+L2_V0)+((lane>>4)&1)*32+(lane&3)*8+(4*hi+((lane&15)>>2))*64, vb1=vb0+(L2_V1-L2_V0);
  const char*Kbase=shm+L2_K; bf16x8 kf[8];
  const lds_cptr shm3=(lds_cptr)shm; const lds_cptr kp0=shm3+L2_K+hi*1024+r32*16; const lds_cptr vp0=shm3+L2_V0+((lane>>4)&1)*32+(lane&3)*8+(4*hi+((lane&15)>>2))*64; const lds_cptr qf0=shm3+L2_QS+wid*L2_QSW+r32*144+hi*16;
  DMA_K(0,0);DMA_V(0,0);DMA_K(1,SLOTB);
  bf16x8 qr[4];
  #pragma unroll
  for(int d0=0;d0<4;++d0)qr[d0]=*reinterpret_cast<const bf16x8*>(&Qw[(long)r32*qp+d0*16+hi*8]);
  float mhat=0.f,l_reg=0.f;f32x16 o[4];float z_=0.f;asm volatile("":"+v"(z_));
  _Pragma("unroll") for(int r=0;r<16;++r){o[0][r]=z_;o[1][r]=z_;o[2][r]=z_;o[3][r]=z_;}
  const f32x16 ZERO={0.f,0.f,0.f,0.f,0.f,0.f,0.f,0.f,0.f,0.f,0.f,0.f,0.f,0.f,0.f,0.f};
  const float dq0=(float)(q0+wid*QBLK+r32-4*hi);
  #define ALIBI(P0,P1,t) do{ alibi(P0,P1,dq0-(float)(64*(t)),nsl2); _Pragma("unroll") for(int r=0;r<16;++r){P0[r]-=mhat;P1[r]-=mhat;} }while(0)
  #define ALIBIF(P0,P1,t) do{ const float a_=__builtin_fmaf(nsl2,dq0-(float)(64*(t)),-mhat); _Pragma("unroll") for(int r=0;r<16;++r){ const float e_=(float)((r&3)+8*(r>>2)); P0[r]=__builtin_fmaf(e_,-nsl2,P0[r]+a_); P1[r]=__builtin_fmaf(e_+32.f,-nsl2,P1[r]+a_); } }while(0)
  #define CMASK(P0,P1,t) do{ if(MODE==0){int jb_=(t)-(NT-4); if(jb_>=0)cmask_blk(P0,P1,jb_,wid);} }while(0)
  bool resc=false;
  #define START(P0,P1) do{ const float rm=rm0_; resc=false; \
    { const float dl=rm; mhat=fadd_s(mhat,dl); \
      _Pragma("unroll") for(int r=0;r<16;++r){P0[r]=fsub_s(P0[r],dl);P1[r]=fsub_s(P1[r],dl);} \
      } \
    _Pragma("unroll") for(int r=0;r<16;++r)P0[r]=__builtin_amdgcn_exp2f(P0[r]); }while(0)
  #define RESC() do{ if(resc){ asm volatile("s_waitcnt lgkmcnt(0)":::"memory"); \
      _Pragma("unroll") for(int d_=0;d_<4;++d_) _Pragma("unroll") for(int r=0;r<16;++r)o[d_][r]*=wsf[crow(r,hi)]; } }while(0)
  f32x16 pA0,pA1,pB0,pB1;
  int sl_prev=0,sl_cur=0,sl_next=SLOTB;
  #define ROT() do{sl_prev=sl_cur;sl_cur=sl_next;sl_next=(sl_next==(NSLOT-1)*SLOTB)?0:sl_next+SLOTB;}while(0)
  DMA_K(2,2*SLOTB);
  { bf16*qs=(bf16*)(shm+L2_QS+wid*L2_QSW);
    _Pragma("unroll") for(int d0=0;d0<4;++d0)*reinterpret_cast<bf16x8*>(&qs[r32*72+d0*16+hi*8])=qr[d0]; }
  WAIT_BAR(4);
  qkt(pA0,pA1,Kbase,qr,ZERO,r32,hi);asm volatile("s_nop 15\n\ts_nop 7":"+v"(pA0),"+v"(pA1));const float rm0_=rowmax(pA0,pA1);
  ALIBI(pA0,pA1,0);CMASK(pA0,pA1,0);
  START(pA0,pA1);
  _Pragma("unroll") for(int r=0;r<16;++r)pA1[r]=__builtin_amdgcn_exp2f(pA1[r]);
  WAIT_BAR(0);
  DMA_K(3,0);DMA_V(1,SLOTB);
  ROT();
  kload8(kf,kp0+sl_cur);
  WAIT_BAR(3);
  s16x4 vlo[8],vhi[8]; u32x4 pw0,pw1,pw2,pw3;
  #define PKW(P,B) cvtpk_s(P[B],P[B+1])
  #define PAF(k) __builtin_bit_cast(bf16x8,pw##k)
  #define VFR(i) (bf16x8){vlo[i][0],vlo[i][1],vlo[i][2],vlo[i][3],vhi[i][0],vhi[i][1],vhi[i][2],vhi[i][3]}
  #define PIN(x) asm volatile("":"+v"(x))
  #define MX3(a,b,c) __builtin_fmaxf(__builtin_fmaxf((a),(b)),(c))
  #define GAPA(MF,A0,A1,A2,A3,W0,W1,PW) do{ MF; sacc+=A0; sacc+=A1; sacc+=A2; sacc+=A3; PIN(sacc); W0; W1; PIN(PW); SBAR(); }while(0)
  #define EX(v) __builtin_amdgcn_exp2f(v)
  #define GAPB(MF,X,B) do{ MF; X[B]=EX(X[B]); X[B+1]=EX(X[B+1]); X[B+2]=EX(X[B+2]); X[B+3]=EX(X[B+3]); PIN(X); SBAR(); }while(0)
  #define VRD(i) do{ vlo[i]=vtr(vp_+(((i)>>2)*4096+((i)&3)*1024)); vhi[i]=vtr(vp_+(((i)>>2)*4096+((i)&3)*1024+512)); }while(0)
  #define KRD(G,j) do{ if(G){ kload2(kf,kp0+sl_next,j); SBAR(); } }while(0)
  #define QF(d) (*(const __attribute__((address_space(3))) bf16x8*)(qf0+32*(d)))
  #define STEP(C0,C1,P0,P1,t,GK,GV,GL,AL) do{ SBAR(); \
    const lds_cptr vp_=vp0+sl_prev; const bf16x8 q0_=QF(0),q1_=QF(1); \
    VRD(0); SBAR(); float sacc=(P0[0]+P0[1]); \
    GAPA(C0=__builtin_amdgcn_mfma_f32_32x32x16_bf16(kf[0],q0_,ZERO,0,0,0), P0[2],P0[3],P0[4],P0[5],     pw0[0]=PKW(P0,0), pw0[1]=PKW(P0,2), pw0); \
    VRD(4); SBAR(); GAPA(C1=__builtin_amdgcn_mfma_f32_32x32x16_bf16(kf[1],q0_,ZERO,0,0,0), P0[6],P0[7],P0[8],P0[9],     pw0[2]=PKW(P0,4), pw0[3]=PKW(P0,6), pw0); \
    VRD(1); SBAR(); GAPA(C0=__builtin_amdgcn_mfma_f32_32x32x16_bf16(kf[2],q1_,C0,0,0,0),   P0[10],P0[11],P0[12],P0[13], pw1[0]=PKW(P0,8), pw1[1]=PKW(P0,10), pw1); \
    VRD(5); SBAR(); GAPA(C1=__builtin_amdgcn_mfma_f32_32x32x16_bf16(kf[3],q1_,C1,0,0,0),   P0[14],P0[15],P1[0],P1[1],   pw1[2]=PKW(P0,12),pw1[3]=PKW(P0,14), pw1); \
    const bf16x8 q2_=QF(2),q3_=QF(3); \
    VRD(2); SBAR(); GAPA(C0=__builtin_amdgcn_mfma_f32_32x32x16_bf16(kf[4],q2_,C0,0,0,0),   P1[2],P1[3],P1[4],P1[5],     pw2[0]=PKW(P1,0), pw2[1]=PKW(P1,2), pw2); \
    VRD(6); SBAR(); GAPA(C1=__builtin_amdgcn_mfma_f32_32x32x16_bf16(kf[5],q2_,C1,0,0,0),   P1[6],P1[7],P1[8],P1[9],     pw2[2]=PKW(P1,4), pw2[3]=PKW(P1,6), pw2); \
    VRD(3); SBAR(); GAPA(C0=__builtin_amdgcn_mfma_f32_32x32x16_bf16(kf[6],q3_,C0,0,0,0),   P1[10],P1[11],P1[12],P1[13], pw3[0]=PKW(P1,8), pw3[1]=PKW(P1,10), pw3); \
    VRD(7); SBAR(); GAPA(C1=__builtin_amdgcn_mfma_f32_32x32x16_bf16(kf[7],q3_,C1,0,0,0),   P1[14],P1[15],0.f,0.f,       pw3[2]=PKW(P1,12),pw3[3]=PKW(P1,14), pw3); \
    l_reg+=sacc; \
    if(GK){DMA_K((t)+3,sl_cur);} if(GV){DMA_V((t)+1,sl_next);} \
    AL(C0,C1,t); CMASK(C0,C1,t); \
    { float a=MX3(C0[0],C0[1],C1[0]),b=MX3(C0[2],C0[3],C1[1]); a=MX3(a,C1[2],C1[3]); \
      _Pragma("unroll") for(int r=4;r<16;r+=4){a=MX3(a,C0[r],C0[r+1]);b=MX3(b,C0[r+2],C0[r+3]);a=MX3(a,C1[r],C1[r+1]);b=MX3(b,C1[r+2],C1[r+3]);} \
      float rm=__builtin_fmaxf(a,b); { auto rr=__builtin_amdgcn_permlane32_swap(__float_as_uint(rm),__float_as_uint(rm),false,false); rm=__builtin_fmaxf(__uint_as_float(rr[0]),__uint_as_float(rr[1])); } \
      resc=false; \
      if(__builtin_expect(__any(rm>(float)THRL),0)){ const float dl=__builtin_fmaxf(rm,0.f); mhat+=dl; \
        _Pragma("unroll") for(int r=0;r<16;++r){C0[r]-=dl;C1[r]-=dl;} \
        const float f=__builtin_amdgcn_exp2f(-dl); l_reg*=f; if(hi==0)wsf[r32]=f; resc=true; } } \
    SBAR(); \
    GAPB(o[0]=__builtin_amdgcn_mfma_f32_32x32x16_bf16(PAF(0),VFR(0),o[0],0,0,0), C0,0); \
    GAPB(o[1]=__builtin_amdgcn_mfma_f32_32x32x16_bf16(PAF(0),VFR(4),o[1],0,0,0), C0,4); \
    KRD(GL,0); GAPB(o[0]=__builtin_amdgcn_mfma_f32_32x32x16_bf16(PAF(1),VFR(1),o[0],0,0,0), C0,8); \
    KRD(GL,1); GAPB(o[1]=__builtin_amdgcn_mfma_f32_32x32x16_bf16(PAF(1),VFR(5),o[1],0,0,0), C0,12); \
    KRD(GL,2); GAPB(o[0]=__builtin_amdgcn_mfma_f32_32x32x16_bf16(PAF(2),VFR(2),o[0],0,0,0), C1,0); \
    KRD(GL,3); GAPB(o[1]=__builtin_amdgcn_mfma_f32_32x32x16_bf16(PAF(2),VFR(6),o[1],0,0,0), C1,4); \
    GAPB(o[0]=__builtin_amdgcn_mfma_f32_32x32x16_bf16(PAF(3),VFR(3),o[0],0,0,0), C1,8); \
    GAPB(o[1]=__builtin_amdgcn_mfma_f32_32x32x16_bf16(PAF(3),VFR(7),o[1],0,0,0), C1,12); \
    { const lds_cptr vq_=vp_+(L2_V1-L2_V0); _Pragma("unroll") for(int i_=0;i_<8;++i_){ vlo[i_]=vtr(vq_+((i_>>2)*4096+(i_&3)*1024)); vhi[i_]=vtr(vq_+((i_>>2)*4096+(i_&3)*1024+512)); } SBAR(); \
      o[2]=__builtin_amdgcn_mfma_f32_32x32x16_bf16(PAF(0),VFR(0),o[2],0,0,0); o[3]=__builtin_amdgcn_mfma_f32_32x32x16_bf16(PAF(0),VFR(4),o[3],0,0,0); \
      o[2]=__builtin_amdgcn_mfma_f32_32x32x16_bf16(PAF(1),VFR(1),o[2],0,0,0); o[3]=__builtin_amdgcn_mfma_f32_32x32x16_bf16(PAF(1),VFR(5),o[3],0,0,0); \
      o[2]=__builtin_amdgcn_mfma_f32_32x32x16_bf16(PAF(2),VFR(2),o[2],0,0,0); o[3]=__builtin_amdgcn_mfma_f32_32x32x16_bf16(PAF(2),VFR(6),o[3],0,0,0); \
      o[2]=__builtin_amdgcn_mfma_f32_32x32x16_bf16(PAF(3),VFR(3),o[2],0,0,0); o[3]=__builtin_amdgcn_mfma_f32_32x32x16_bf16(PAF(3),VFR(7),o[3],0,0,0); SBAR(); } \
    }while(0)
  int t=1;
  #undef CMASK
  #define CMASK(P0,P1,t) do{}while(0)
  for(;t+5<NT;t+=2){
    STEP(pB0,pB1,pA0,pA1,t,true,true,true,ALIBIF);     WAIT_BAR(3); RESC(); ROT();
    STEP(pA0,pA1,pB0,pB1,t+1,true,true,true,ALIBIF);   WAIT_BAR(3); RESC(); ROT();
  }
  #undef CMASK
  #define CMASK(P0,P1,t) do{ if(MODE==0){int jb_=(t)-(NT-4); if(jb_>=0)cmask_blk(P0,P1,jb_,wid);} }while(0)
  #define ENDW(tt) do{ if((tt)+3<NT){WAIT_BAR(3);} else if((tt)+2<NT){WAIT_BAR(2);} else {WAIT_BAR(0);} }while(0)
  for(;t+1<NT;t+=2){
    STEP(pB0,pB1,pA0,pA1,t,(t+3<NT),(t+1<NT),(t+1<NT),ALIBI);       ENDW(t);   RESC(); ROT();
    STEP(pA0,pA1,pB0,pB1,t+1,(t+4<NT),(t+2<NT),(t+2<NT),ALIBI);     ENDW(t+1); RESC(); ROT();
  }
  STEP(pB0,pB1,pA0,pA1,NT-1,false,false,false,ALIBI); RESC();
  { float sacc=pB0[0]+pB0[1]; _Pragma("unroll") for(int r=2;r<16;++r)sacc+=pB0[r]; _Pragma("unroll") for(int r=0;r<16;++r)sacc+=pB1[r]; l_reg+=sacc;
    pw0=(u32x4){PKW(pB0,0),PKW(pB0,2),PKW(pB0,4),PKW(pB0,6)};pw1=(u32x4){PKW(pB0,8),PKW(pB0,10),PKW(pB0,12),PKW(pB0,14)};pw2=(u32x4){PKW(pB1,0),PKW(pB1,2),PKW(pB1,4),PKW(pB1,6)};pw3=(u32x4){PKW(pB1,8),PKW(pB1,10),PKW(pB1,12),PKW(pB1,14)};
    SBAR(); pv(o,vb0+sl_cur,PAF(0),PAF(1),PAF(2),PAF(3)); pv(o+2,vb1+sl_cur,PAF(0),PAF(1),PAF(2),PAF(3)); }
  #undef PKW
  #undef PAF
  #undef VFR
  #undef PIN
  #undef MX3
  #undef GAPA
  #undef GAPB
  #undef EX
  #undef VRD
  #undef KRD
  #undef STEP
  #undef QF
  #undef ENDW
  {auto rr=__builtin_amdgcn_permlane32_swap(__float_as_uint(l_reg),__float_as_uint(l_reg),false,false);l_reg=__uint_as_float(rr[0])+__uint_as_float(rr[1]);}
  if(hi==0)wsf[32+r32]=l_reg;asm volatile("s_waitcnt lgkmcnt(0)":::"memory");
  float rli[16];
  #pragma unroll
  for(int r=0;r<16;++r)rli[r]=__builtin_amdgcn_rcpf(wsf[32+crow(r,hi)]);
  bf16*Ow=Ob+(long)(wid*QBLK)*op;
  { bf16*stg=(bf16*)(shm+L2_QS+wid*L2_QSW);
    #pragma unroll
    for(int hv=0;hv<2;++hv){
      #pragma unroll
      for(int r=0;r<16;++r){const int orow=crow(r,hi);
        #pragma unroll
        for(int d0=0;d0<2;++d0)stg[orow*64+d0*32+r32]=__float2bfloat16(o[2*hv+d0][r]*rli[r]);}
      asm volatile("s_waitcnt lgkmcnt(0)":::"memory");
      #pragma unroll
      for(int i=0;i<4;++i){const int row=i*8+(lane>>3),ch=lane&7; const u32x4 v=*(const u32x4*)(stg+row*64+ch*8); ATTN_STORE16(Ow+(long)row*op+hv*64+ch*8,v);}
      asm volatile("s_waitcnt lgkmcnt(0)":::"memory"); } }
  asm volatile("s_waitcnt lgkmcnt(0)\n\ts_barrier":::"memory");
  #undef DMA_K
  #undef DMA_V
  #undef CMASK
  #undef ALIBI
  #undef ALIBIF
  #undef START
  #undef RESC
  #undef ROT
}
constexpr int ATTN_LDS_BYTES=LDS_BYTES;
#undef SBAR
#undef WAIT_BAR
}
constexpr int T = 32768, D = 1024, NB = 8, S = 4096, MEML = 256;
constexpr int AIN = 2560, BIN = 3328, FFD = 2816, FFE = 3584, NE = 8, DAW = 768;
constexpr float EPS = 1e-6f;
constexpr float C2 = 0.125f * 1.4426950408889634f;
constexpr int MAXROWS = 2 * T + NE * 256;
constexpr int NWAVES = 8;
constexpr float SC_X = 16.f, SC_WGU = 64.f, SC_H = 8.f, SC_WDN = 256.f;
constexpr size_t MiB = 1u << 20;
constexpr size_t WS_CTL = 0, CTL_ZERO_BYTES = 1 * MiB;
constexpr size_t WS_WINA = 2 * MiB, WS_WOUT = 12 * MiB, WS_WINB = 20 * MiB, WS_WMKV = 33 * MiB, WS_WGUD = 37 * MiB, WS_WDND = 59 * MiB, WS_WGUM = 70 * MiB, WS_WDNM = 294 * MiB;
constexpr size_t WS_MEMN = 406 * MiB, WS_MKV = 422 * MiB, WS_XN = 430 * MiB, WS_OC = 494 * MiB, WS_ROUTE = 558 * MiB, WS_BIG = 560 * MiB, WS_XG = 1072 * MiB, WS_Y = 1204 * MiB, WS_SSQP = 1362 * MiB, WS_END = 1372 * MiB;
constexpr size_t WS_SLOC = WS_XG, WS_SIN = WS_XG + 192 * MiB;
constexpr size_t WS_FS = 1600 * MiB;
constexpr int CW_TMO = 0, CW_CODE = 1, CW_BAR = 4096, CW_GCNT = 8192, CW_N2 = 65536;
constexpr int RING_OFF = 0, RING_BYTES = 131072;
constexpr int LDSCTL_OFF = RING_BYTES, MISC_OFF = LDSCTL_OFF + 320;
constexpr int LDS_BYTES = 147456;
static_assert(MISC_OFF + 128 <= LDS_BYTES, "LDS map");
#ifndef MK_DBG
#define MK_DBG 0
#endif
#ifndef MK_DUP
#define MK_DUP 0
#endif
#ifndef MK_TS
#define MK_TS 0
#endif
#ifndef MK_TS_A
#define MK_TS_A 0
#endif
#ifndef MK_TS_B
#define MK_TS_B 0
#endif
__constant__ unsigned char ATT_DEAL[16][6] = {{4, 14, 35, 56, 63, 85}, {0, 18, 20, 36, 72, 79}, {16, 21, 34, 52, 88, 95}, {22, 32, 50, 62, 68, 73}, {23, 48, 66, 78, 84, 89}, {5, 15, 40, 51, 86, 94}, {1, 6, 27, 47, 61, 69}, {24, 37, 41, 64, 77, 82},
    {2, 12, 25, 53, 57, 93}, {7, 17, 28, 38, 44, 60}, {8, 29, 33, 45, 54, 76}, {9, 30, 46, 49, 70, 92}, {10, 59, 65, 67, 87, 90}, {11, 31, 42, 55, 75, 81}, {19, 43, 71, 80, 83, 91}, {3, 13, 26, 39, 58, 74}};
#define GAS __attribute__((address_space(1)))
#define LAS __attribute__((address_space(3)))
typedef unsigned short bf16;
typedef unsigned v4u __attribute__((ext_vector_type(4)));
typedef unsigned v2u __attribute__((ext_vector_type(2)));
typedef float f32x4 __attribute__((ext_vector_type(4)));
typedef short bf16x8 __attribute__((ext_vector_type(8)));
typedef GAS unsigned gu32;
typedef GAS unsigned long long gu64;
#define RLX_AGENT __ATOMIC_RELAXED, __HIP_MEMORY_SCOPE_AGENT
#define LDS_WAIT() asm volatile("s_waitcnt lgkmcnt(0)" ::: "memory")
#define VM_WAIT() asm volatile("s_waitcnt vmcnt(0)" ::: "memory")
__device__ __forceinline__ unsigned long long rt() { return __builtin_amdgcn_s_memrealtime(); }
__device__ __forceinline__ unsigned f2bf(float f) { unsigned u = __builtin_bit_cast(unsigned, f); return (u + 0x7fffu + ((u >> 16) & 1u)) >> 16; }
__device__ __forceinline__ unsigned pk2(float lo, float hi) { return f2bf(lo) | (f2bf(hi) << 16); }

#define XB_TMO      128
#define XB_XCNT(j)  (256  + 64 * (j))
#define XB_XSUB(j)  (1280 + 64 * (j))
#define XB_XGEN(j)  (2304 + 64 * (j))
#define XB_TOP      3328
#define XB_TOPGEN   3392
#define XCD_BAR_WORDS 3456
#define XB_SPIN_CAP (1u << 18)

__device__ __forceinline__ unsigned xb_ld(unsigned* p)              { return __hip_atomic_load(p, __ATOMIC_RELAXED, __HIP_MEMORY_SCOPE_AGENT); }
__device__ __forceinline__ unsigned xb_add(unsigned* p, unsigned v) { return __hip_atomic_fetch_add(p, v, __ATOMIC_RELAXED, __HIP_MEMORY_SCOPE_AGENT); }
__device__ __forceinline__ unsigned xb_xcc_id() { return (unsigned)__builtin_amdgcn_s_getreg((3 << 11) | 20) & 0xFu; }
#define XB_SPIN(cond, bar) do { unsigned _sp = 0; while (cond) { __builtin_amdgcn_s_sleep(1); \
    if ((++_sp & 255u) == 0u) { if (xb_ld(&(bar)[XB_TMO])) break; if (_sp > XB_SPIN_CAP) { atomicAdd(&(bar)[XB_TMO], 1u); break; } } } } while (0)

struct XcdBarrier {
    unsigned* bar; unsigned x; int wave;
    volatile LAS unsigned* st;
};

__device__ __forceinline__ XcdBarrier xcd_barrier_post(unsigned* bar, volatile LAS unsigned* st) {
    XcdBarrier b; b.bar = bar; b.x = xb_xcc_id(); b.st = st; b.wave = __builtin_amdgcn_readfirstlane((int)(threadIdx.x >> 6));
    if (threadIdx.x == 0) (void)xb_add(&bar[XB_XCNT(b.x)], 1u);
    return b;
}
__device__ __forceinline__ void xcd_barrier_complete(unsigned* bar, unsigned x, unsigned& nloc, unsigned& nx) {
    const unsigned G = gridDim.x * gridDim.y * gridDim.z;
    unsigned sum, cnt, mine, sp = 0u;
    for (;;) {
        sum = 0u; cnt = 0u; mine = 0u;
#pragma unroll
        for (unsigned j = 0; j < 16; ++j) { const unsigned c = xb_ld(&bar[XB_XCNT(j)]); sum += c; cnt += (c > 0u) ? 1u : 0u; mine = (j == x) ? c : mine; }
        if (sum == G) break;
        __builtin_amdgcn_s_sleep(1);
        if ((++sp & 255u) == 0u) { if (xb_ld(&bar[XB_TMO])) break; if (sp > XB_SPIN_CAP) { atomicAdd(&bar[XB_TMO], 1u); break; } }
    }
    nloc = mine > 0u ? mine : 1u; nx = cnt > 0u ? cnt : 1u;
}

__device__ __forceinline__ void xcd_barrier(const XcdBarrier& b) {
    asm volatile("s_waitcnt vmcnt(0)" ::: "memory");
    __syncthreads();
    int l0_; asm volatile("v_mbcnt_lo_u32_b32 %0, -1, 0\n\tv_mbcnt_hi_u32_b32 %0, -1, %0" : "=v"(l0_));
    if (b.wave == 0 && l0_ == 0) {
        unsigned* bar = b.bar;
        __builtin_amdgcn_s_waitcnt(0);
        unsigned nloc = b.st[0], nx = b.st[1];
        if (nloc == 0u) { xcd_barrier_complete(bar, b.x, nloc, nx); b.st[0] = nloc; b.st[1] = nx; }
        const unsigned old = xb_add(&bar[XB_XSUB(b.x)], 1u);
        const unsigned gen = old / nloc;
        if (old + 1u == (gen + 1u) * nloc) {
            __builtin_amdgcn_fence(__ATOMIC_RELEASE, "agent");
            asm volatile("s_waitcnt vmcnt(0)" ::: "memory");
            const unsigned og = xb_add(&bar[XB_TOP], 1u);
            const unsigned tg = og / nx;
            if (og + 1u == (tg + 1u) * nx) xb_add(&bar[XB_TOPGEN], 1u);
            else XB_SPIN(xb_ld(&bar[XB_TOPGEN]) == tg, bar);
            __builtin_amdgcn_fence(__ATOMIC_ACQUIRE, "agent");
            xb_add(&bar[XB_XGEN(b.x)], 1u);
            asm volatile("s_waitcnt vmcnt(0)" ::: "memory");
        } else {
            XB_SPIN(xb_ld(&bar[XB_XGEN(b.x)]) == gen, bar);
            __builtin_amdgcn_fence(__ATOMIC_ACQUIRE, "agent");
            asm volatile("s_waitcnt vmcnt(0)" ::: "memory");
        }
    }
    __syncthreads();
}
struct InTab { const LAS unsigned long long* t;
    __device__ __forceinline__ const float* operator[](int k) const { const unsigned long long v = t[k];
        return (const float*)(((unsigned long long)(unsigned)__builtin_amdgcn_readfirstlane((int)(v >> 32)) << 32) | (unsigned)__builtin_amdgcn_readfirstlane((int)(unsigned)v)); } };
struct Frame {
    LAS unsigned char* lds;
    volatile LAS unsigned* MISC;
    gu32* ctl;
    int wave;
    int vcu, G, bx;
    GAS unsigned char* ws;
    InTab in;
    GAS float* out;
    float ts_scale, ts_add;
};
__device__ __forceinline__ float xor_get(float v, int lane, int o) { return __builtin_bit_cast(float, __builtin_amdgcn_ds_bpermute((lane ^ o) << 2, __builtin_bit_cast(int, v))); }
__device__ __forceinline__ float half_sum(float v, int lane) {
#pragma unroll
    for (int o = 1; o < 32; o <<= 1) v += xor_get(v, lane, o);
    return v; }
__device__ __forceinline__ float wave_sum(float v, int lane) { v = half_sum(v, lane); return v + xor_get(v, lane, 32); }
__device__ __forceinline__ int launder(int v) { asm volatile("" : "+v"(v)); return v; }
__device__ __forceinline__ int fresh_lane() { int l; asm volatile("v_mbcnt_lo_u32_b32 %0, -1, 0\n\tv_mbcnt_hi_u32_b32 %0, -1, %0" : "=v"(l)); return l; }
__device__ __forceinline__ float bf_lo(unsigned u) { return __builtin_bit_cast(float, u << 16); }
__device__ __forceinline__ float bf_hi(unsigned u) { return __builtin_bit_cast(float, u & 0xffff0000u); }
#if MK_DBG
__device__ __forceinline__ void dbg_sample_f32(Frame& F, int lane, int slot, int row, const f32x4 (&v)[4]) {
    float* d = (float*)(F.ws + WS_FS) + ((size_t)slot * 1024 + (row >> 5)) * 1024;
#pragma unroll
    for (int j = 0; j < 4; ++j) ((f32x4*)d)[lane + 64 * j] = v[j];
}
#endif
__device__ __forceinline__ int swiglu_row(int n, int ff) { const int bj = n >= ff ? 1 : 0, cc = n - bj * ff; return 256 * (cc >> 7) + 128 * bj + (cc & 127); }
template <bool F8>
__device__ __forceinline__ void transpose_item(const float* W, int K, int N, void* WT, int ff, float scale, LAS float* scr, int item, int lane) {
    const int nblk = N / 64, kb = item / nblk, nb = item % nblk, k0 = 64 * kb, n0 = 64 * nb;
    const int r0 = ff ? swiglu_row(n0, ff) : n0;
    float v[64];
    const GAS float* wp = (const GAS float*)W + (size_t)k0 * N + n0 + lane;
#pragma unroll
    for (int i = 0; i < 64; ++i) v[i] = wp[(size_t)i * N];
#pragma unroll
    for (int i = 0; i < 64; ++i) scr[i * 64 + (lane ^ (i & 31))] = v[i];
    LDS_WAIT(); asm volatile("" ::: "memory");
    const int c = lane & 7;
#pragma unroll
    for (int j = 0; j < 8; ++j) { const int n = (lane >> 3) + 8 * j; float s[8];
#pragma unroll
        for (int i = 0; i < 8; ++i) s[i] = scr[(8 * c + i) * 64 + (n ^ ((8 * c + i) & 31))];
        if (F8) { v2u o; o.x = pg8::pk4_fp8(s[0] * scale, s[1] * scale, s[2] * scale, s[3] * scale); o.y = pg8::pk4_fp8(s[4] * scale, s[5] * scale, s[6] * scale, s[7] * scale);
            *(GAS v2u*)((unsigned char*)WT + (size_t)(r0 + n) * K + k0 + 8 * c) = o; }
        else { v4u o; o.x = pg8::cvt_pk_bf16(s[0], s[1]); o.y = pg8::cvt_pk_bf16(s[2], s[3]); o.z = pg8::cvt_pk_bf16(s[4], s[5]); o.w = pg8::cvt_pk_bf16(s[6], s[7]);
            *(GAS v4u*)((bf16*)WT + (size_t)(r0 + n) * K + k0 + 8 * c) = o; } }
    LDS_WAIT(); asm volatile("" ::: "memory");
}
__device__ __forceinline__ void rms_row_to_bf16(int lane, const float* xrow, const float* gain, bf16* orow) {
    const GAS f32x4* xr = (const GAS f32x4*)xrow + lane;
    f32x4 v[4]; float s = 0.f;
#pragma unroll
    for (int j = 0; j < 4; ++j) { v[j] = xr[64 * j]; s += (v[j].x * v[j].x + v[j].y * v[j].y) + (v[j].z * v[j].z + v[j].w * v[j].w); }
    const float rstd = 1.f / sqrtf(wave_sum(s, lane) * (1.f / D) + EPS);
    GAS unsigned long long* o8 = (GAS unsigned long long*)orow + lane;
#pragma unroll
    for (int j = 0; j < 4; ++j) { const f32x4 g = ((const GAS f32x4*)gain)[lane + 64 * j];
        o8[64 * j] = (unsigned long long)pk2(v[j].x * rstd * g.x, v[j].y * rstd * g.y) | ((unsigned long long)pk2(v[j].z * rstd * g.z, v[j].w * rstd * g.w) << 32); }
}
__device__ __forceinline__ void phase_prologue(Frame& F) {
    const int lane = fresh_lane(), tid = F.wave * 64 + lane; (void)tid;
    LAS float* scr = (LAS float*)(F.lds + RING_OFF + F.wave * 16384);
    const int gw = F.vcu * NWAVES + F.wave, NGW = F.G * NWAVES;
    constexpr int I_AIN = 16 * (AIN / 64), I_MKV = 16 * 8, I_OUT = 16 * 16, I_BIN = 16 * (BIN / 64), I_GUD = 16 * (2 * FFD / 64), I_DND = (FFD / 64) * 16, I_GUM = 16 * (2 * FFE / 64), I_DNM = (FFE / 64) * 16;
    constexpr int NITEMS = 2 * I_AIN + 4 * I_MKV + 4 * I_OUT + 2 * I_BIN + 2 * I_GUD + 2 * I_DND + 16 * I_GUM + 16 * I_DNM;
    for (int it = NITEMS - 1 - gw; it >= 0; it -= NGW) {
        int r = it; const float* src; bf16* dst; int K = D, N, ff = 0;
        if (r < 2 * I_AIN) { const int j = r / I_AIN; r %= I_AIN; N = AIN; src = F.in[3] + (size_t)j * D * AIN; dst = (bf16*)(F.ws + WS_WINA) + (size_t)j * AIN * D; }
        else if ((r -= 2 * I_AIN) < 4 * I_MKV) { const int l = r / I_MKV; r %= I_MKV; N = 512; src = F.in[(l & 1) ? 17 : 10] + (size_t)(l >> 1) * D * 512; dst = (bf16*)(F.ws + WS_WMKV) + (size_t)l * 512 * D; }
        else if ((r -= 4 * I_MKV) < 4 * I_OUT) { const int l = r / I_OUT; r %= I_OUT; N = D; src = F.in[(l & 1) ? 18 : 11] + (size_t)(l >> 1) * D * D; dst = (bf16*)(F.ws + WS_WOUT) + (size_t)l * D * D; }
        else if ((r -= 4 * I_OUT) < 2 * I_BIN) { const int j = r / I_BIN; r %= I_BIN; N = BIN; src = F.in[13] + (size_t)j * D * BIN; dst = (bf16*)(F.ws + WS_WINB) + (size_t)j * BIN * D; }
        else if ((r -= 2 * I_BIN) < 2 * I_GUD) { const int j = r / I_GUD; r %= I_GUD; N = 2 * FFD; ff = FFD; src = F.in[20] + (size_t)j * D * 2 * FFD; dst = (bf16*)(F.ws + WS_WGUD) + (size_t)j * 2 * FFD * D; }
        else if ((r -= 2 * I_GUD) < 2 * I_DND) { const int j = r / I_DND; r %= I_DND; K = FFD; N = D; src = F.in[21] + (size_t)j * FFD * D; dst = (bf16*)(F.ws + WS_WDND) + (size_t)j * D * FFD; }
        else if ((r -= 2 * I_DND) < 16 * I_GUM) { const int j = r / I_GUM; r %= I_GUM;
            transpose_item<true>(F.in[24] + (size_t)j * D * 2 * FFE, D, 2 * FFE, (void*)(F.ws + WS_WGUM + (size_t)j * 2 * FFE * D), FFE, SC_WGU, scr, r, lane); continue; }
        else { r -= 16 * I_GUM; const int j = r / I_DNM; r %= I_DNM;
            transpose_item<true>(F.in[25] + (size_t)j * FFE * D, FFE, D, (void*)(F.ws + WS_WDNM + (size_t)j * D * FFE), 0, SC_WDN, scr, r, lane); continue; }
        transpose_item<false>(src, K, N, dst, ff, 1.f, scr, r, lane);
    }
    for (int m = gw; m < 4 * NB * MEML; m += NGW) { const int l = m / (NB * MEML), r = m % (NB * MEML);
        rms_row_to_bf16(lane, F.in[1] + (size_t)r * D, F.in[(l & 1) ? 16 : 9] + (size_t)(l >> 1) * D, (bf16*)(F.ws + WS_MEMN) + (size_t)m * D); }
    for (int m = gw; m < T; m += NGW) rms_row_to_bf16(lane, F.in[0] + (size_t)m * D, F.in[2], (bf16*)(F.ws + WS_XN) + (size_t)m * D);
    if (F.bx == 0) { float* LBT = (float*)(F.ws + WS_ROUTE + 1024 * 1024);
        for (int i = tid; i < DAW; i += NWAVES * 64) { LBT[i] = 0.f; LBT[DAW + i] = 1.f / (1.f + __expf(F.in[14][i] - F.in[14][DAW + i])); } }
}
template <bool COMBINE, bool ROUTER, bool FINAL>
__device__ __forceinline__ void phase_norm(Frame& F, const float* src, float* X, const float* gain, const float* wr, gu32* gcnt, int dbg_slot) {
    const int lane = fresh_lane(), tid = F.wave * 64 + lane; (void)tid;
    bf16* XN = (bf16*)(F.ws + WS_XN); const bf16* Y = (const bf16*)(F.ws + WS_Y);
    float* TOPW = (float*)(F.ws + WS_ROUTE); int* TOKSEL = (int*)(F.ws + WS_ROUTE + 256 * 1024); const int* TOKROW = (const int*)(F.ws + WS_ROUTE + 768 * 1024);
    LAS int* cntL = (LAS int*)(F.lds + RING_OFF); LAS int* baseL = cntL + 8; LAS int* sel = cntL + 16;
    if (ROUTER) { if (tid < 8) cntL[tid] = 0; __syncthreads(); }
    for (int rb = F.bx * 128; rb < T; rb += F.G * 128) {
        int ri0 = 0, ri1 = 0; float rw0 = 0.f, rw1 = 0.f;
        if (COMBINE && lane < 16) { const int rr = rb + F.wave * 16 + lane; ri0 = TOKROW[rr * 2]; ri1 = TOKROW[rr * 2 + 1]; rw0 = TOPW[rr * 2]; rw1 = TOPW[rr * 2 + 1]; }
        f32x4 vq[2][4]; v2u yq0[2][4], yq1[2][4];
#define NORM_ISSUE(B_, I_) do { const int row_ = rb + F.wave * 16 + (I_); const GAS f32x4* xr_ = (const GAS f32x4*)(src + (size_t)row_ * D) + lane; \
            _Pragma("unroll") for (int j = 0; j < 4; ++j) vq[B_][j] = xr_[64 * j]; \
            if (COMBINE) { const int r0_ = __builtin_amdgcn_readlane(ri0, (I_)), r1_ = __builtin_amdgcn_readlane(ri1, (I_)); \
                const GAS v2u* y0_ = (const GAS v2u*)(Y + (size_t)r0_ * D) + lane; const GAS v2u* y1_ = (const GAS v2u*)(Y + (size_t)r1_ * D) + lane; \
                _Pragma("unroll") for (int j = 0; j < 4; ++j) { yq0[B_][j] = y0_[64 * j]; yq1[B_][j] = y1_[64 * j]; } } } while (0)
        NORM_ISSUE(0, 0);
        for (int i2 = 0; i2 < 16; i2 += 2) {
#pragma unroll
          for (int hb = 0; hb < 2; ++hb) {
            const int i = i2 + hb;
            if (hb == 0) NORM_ISSUE(1, i + 1); else if (i + 1 < 16) NORM_ISSUE(0, i + 1);
            const int rl = F.wave * 16 + i, row = rb + rl;
            f32x4 v[4];
#pragma unroll
            for (int j = 0; j < 4; ++j) v[j] = vq[hb][j];
            if (COMBINE) {
                const float w0 = __builtin_bit_cast(float, __builtin_amdgcn_readlane(__builtin_bit_cast(int, rw0), i)), w1 = __builtin_bit_cast(float, __builtin_amdgcn_readlane(__builtin_bit_cast(int, rw1), i));
#pragma unroll
                for (int j = 0; j < 4; ++j) { const v2u a = yq0[hb][j], b = yq1[hb][j];
                    v[j].x += w0 * bf_lo(a.x) + w1 * bf_lo(b.x); v[j].y += w0 * bf_hi(a.x) + w1 * bf_hi(b.x); v[j].z += w0 * bf_lo(a.y) + w1 * bf_lo(b.y); v[j].w += w0 * bf_hi(a.y) + w1 * bf_hi(b.y); }
                if (!FINAL) { GAS f32x4* xw = (GAS f32x4*)(X + (size_t)row * D) + lane;
#pragma unroll
                    for (int j = 0; j < 4; ++j) xw[64 * j] = v[j]; }
            }
#if MK_DBG
            if (dbg_slot >= 0 && (row & 31) == 0) dbg_sample_f32(F, lane, dbg_slot, row, v);
#endif
            float s = 0.f;
#pragma unroll
            for (int j = 0; j < 4; ++j) s += (v[j].x * v[j].x + v[j].y * v[j].y) + (v[j].z * v[j].z + v[j].w * v[j].w);
            const float rstd = 1.f / sqrtf(wave_sum(s, lane) * (1.f / D) + EPS);
#pragma unroll
            for (int j = 0; j < 4; ++j) { const f32x4 g = ((const GAS f32x4*)gain)[lane + 64 * j]; v[j].x *= rstd * g.x; v[j].y *= rstd * g.y; v[j].z *= rstd * g.z; v[j].w *= rstd * g.w; }
            if (FINAL) { GAS f32x4* ow = (GAS f32x4*)(X + (size_t)row * D) + lane;
#pragma unroll
                for (int j = 0; j < 4; ++j) ow[64 * j] = v[j];
            } else { GAS unsigned long long* o8 = (GAS unsigned long long*)(XN + (size_t)row * D) + lane;
#pragma unroll
                for (int j = 0; j < 4; ++j) o8[64 * j] = (unsigned long long)pk2(v[j].x, v[j].y) | ((unsigned long long)pk2(v[j].z, v[j].w) << 32); }
            if (ROUTER) {
                float a[8];
#pragma unroll
                for (int e = 0; e < 8; ++e) a[e] = 0.f;
#pragma unroll
                for (int j = 0; j < 4; ++j) { const GAS f32x4* wp = (const GAS f32x4*)(wr + (size_t)(lane + 64 * j) * 32);
#pragma unroll
                    for (int c = 0; c < 4; ++c) { const float xv = v[j][c]; const f32x4 w0 = wp[2 * c], w1 = wp[2 * c + 1];
                        a[0] += xv * w0.x; a[1] += xv * w0.y; a[2] += xv * w0.z; a[3] += xv * w0.w; a[4] += xv * w1.x; a[5] += xv * w1.y; a[6] += xv * w1.z; a[7] += xv * w1.w; } }
#pragma unroll
                for (int e = 0; e < 8; ++e) a[e] = wave_sum(a[e], lane);
                if (lane == 0) {
                    int e0 = 0; float v0 = a[0];
#pragma unroll
                    for (int e = 1; e < 8; ++e) if (a[e] > v0) { v0 = a[e]; e0 = e; }
                    int e1 = 0; float v1 = -3.0e38f;
#pragma unroll
                    for (int e = 0; e < 8; ++e) if (e != e0 && a[e] > v1) { v1 = a[e]; e1 = e; }
                    const float p1 = __expf(v1 - v0), inv = 1.f / (1.f + p1);
                    TOPW[row * 2] = inv; TOPW[row * 2 + 1] = p1 * inv;
                    const int q0 = __hip_atomic_fetch_add(cntL + e0, 1, __ATOMIC_RELAXED, __HIP_MEMORY_SCOPE_WORKGROUP);
                    const int q1 = __hip_atomic_fetch_add(cntL + e1, 1, __ATOMIC_RELAXED, __HIP_MEMORY_SCOPE_WORKGROUP);
                    sel[rl * 4] = e0; sel[rl * 4 + 1] = q0; sel[rl * 4 + 2] = e1; sel[rl * 4 + 3] = q1;
                }
            }
          }
        }
#undef NORM_ISSUE
        if (ROUTER) {
            __syncthreads();
            if (tid < 8) { baseL[tid] = (int)__hip_atomic_fetch_add(gcnt + tid, (unsigned)cntL[tid], __ATOMIC_RELAXED, __HIP_MEMORY_SCOPE_AGENT); }
            __syncthreads();
            if (tid < 128) { const int e0 = sel[tid * 4], e1 = sel[tid * 4 + 2]; int4 o; o.x = e0; o.y = baseL[e0] + sel[tid * 4 + 1]; o.z = e1; o.w = baseL[e1] + sel[tid * 4 + 3];
                *(int4*)(TOKSEL + (size_t)(rb + tid) * 4) = o; }
            __syncthreads();
            if (tid < 8) cntL[tid] = 0;
            __syncthreads();
        }
    }
}
__device__ __forceinline__ void phase_router(Frame& F, const float* src, const float* gain, const float* wr, gu32* gcnt, int dbg_slot) {
    const int lane = fresh_lane(), tid = F.wave * 64 + lane;
    bf16* XN = (bf16*)(F.ws + WS_XN); float* TOPW = (float*)(F.ws + WS_ROUTE); int* TOKSEL = (int*)(F.ws + WS_ROUTE + 256 * 1024);
    LAS int* cntL = (LAS int*)(F.lds + RING_OFF); LAS int* baseL = cntL + 8; LAS float* lg = (LAS float*)(cntL + 16);
    if (tid < 8) cntL[tid] = 0;
    __syncthreads();
    for (int rb = F.bx * 128; rb < T; rb += F.G * 128) {
        for (int g4 = 0; g4 < 4; ++g4) {
            const int rl0 = F.wave * 16 + 4 * g4, row0 = rb + rl0;
            f32x4 v[4][4];
#pragma unroll
            for (int r = 0; r < 4; ++r) { const GAS f32x4* xr = (const GAS f32x4*)(src + (size_t)(row0 + r) * D) + lane;
#pragma unroll
                for (int j = 0; j < 4; ++j) v[r][j] = xr[64 * j]; }
#if MK_DBG
#pragma unroll
            for (int r = 0; r < 4; ++r) if (dbg_slot >= 0 && ((row0 + r) & 31) == 0) dbg_sample_f32(F, lane, dbg_slot, row0 + r, v[r]);
#endif
            float ss[4];
#pragma unroll
            for (int r = 0; r < 4; ++r) { float s = 0.f;
#pragma unroll
                for (int j = 0; j < 4; ++j) s += (v[r][j].x * v[r][j].x + v[r][j].y * v[r][j].y) + (v[r][j].z * v[r][j].z + v[r][j].w * v[r][j].w);
                ss[r] = s; }
#pragma unroll
            for (int o = 1; o < 64; o <<= 1) {
#pragma unroll
                for (int r = 0; r < 4; ++r) ss[r] += xor_get(ss[r], lane, o); }
#pragma unroll
            for (int r = 0; r < 4; ++r) { const float rstd = 1.f / sqrtf(ss[r] * (1.f / D) + EPS);
                GAS unsigned long long* o8 = (GAS unsigned long long*)(XN + (size_t)(row0 + r) * D) + lane;
#pragma unroll
                for (int j = 0; j < 4; ++j) { const f32x4 gg = ((const GAS f32x4*)gain)[lane + 64 * j]; v[r][j].x *= rstd * gg.x; v[r][j].y *= rstd * gg.y; v[r][j].z *= rstd * gg.z; v[r][j].w *= rstd * gg.w;
                    o8[64 * j] = (unsigned long long)pk2(v[r][j].x, v[r][j].y) | ((unsigned long long)pk2(v[r][j].z, v[r][j].w) << 32); } }
            float a[32];
#pragma unroll
            for (int i = 0; i < 32; ++i) a[i] = 0.f;
#pragma unroll
            for (int j = 0; j < 4; ++j) { const GAS f32x4* wp = (const GAS f32x4*)(wr + (size_t)(lane + 64 * j) * 32);
#pragma unroll
                for (int c = 0; c < 4; ++c) { const f32x4 w0 = wp[2 * c], w1 = wp[2 * c + 1];
#pragma unroll
                    for (int r = 0; r < 4; ++r) { const float xv = v[r][j][c];
                        a[r * 8 + 0] += xv * w0.x; a[r * 8 + 1] += xv * w0.y; a[r * 8 + 2] += xv * w0.z; a[r * 8 + 3] += xv * w0.w; a[r * 8 + 4] += xv * w1.x; a[r * 8 + 5] += xv * w1.y; a[r * 8 + 6] += xv * w1.z; a[r * 8 + 7] += xv * w1.w; } } }
#define RT_STEP(S_, N_) do { const bool up_ = (lane >> (S_)) & 1; _Pragma("unroll") for (int i = 0; i < (N_); ++i) { const float keep_ = up_ ? a[2 * i + 1] : a[2 * i], send_ = up_ ? a[2 * i] : a[2 * i + 1]; a[i] = keep_ + xor_get(send_, lane, 1 << (S_)); } } while (0)
            RT_STEP(0, 16); RT_STEP(1, 8); RT_STEP(2, 4); RT_STEP(3, 2); RT_STEP(4, 1);
#undef RT_STEP
            const float lgv = a[0] + xor_get(a[0], lane, 32);
            if (lane < 32) lg[(rl0 + (lane >> 3)) * 8 + (lane & 7)] = lgv;
        }
        __syncthreads();
        int e0 = 0, e1 = 0, q0 = 0, q1 = 0;
        if (tid < 128) { float av[8];
#pragma unroll
            for (int e = 0; e < 8; ++e) av[e] = lg[tid * 8 + e];
            float v0 = av[0];
#pragma unroll
            for (int e = 1; e < 8; ++e) if (av[e] > v0) { v0 = av[e]; e0 = e; }
            float v1 = -3.0e38f;
#pragma unroll
            for (int e = 0; e < 8; ++e) if (e != e0 && av[e] > v1) { v1 = av[e]; e1 = e; }
            const float p1 = __expf(v1 - v0), inv = 1.f / (1.f + p1);
            TOPW[(rb + tid) * 2] = inv; TOPW[(rb + tid) * 2 + 1] = p1 * inv;
            q0 = __hip_atomic_fetch_add(cntL + e0, 1, __ATOMIC_RELAXED, __HIP_MEMORY_SCOPE_WORKGROUP);
            q1 = __hip_atomic_fetch_add(cntL + e1, 1, __ATOMIC_RELAXED, __HIP_MEMORY_SCOPE_WORKGROUP); }
        __syncthreads();
        if (tid < 8) { baseL[tid] = (int)__hip_atomic_fetch_add(gcnt + tid, (unsigned)cntL[tid], __ATOMIC_RELAXED, __HIP_MEMORY_SCOPE_AGENT); }
        __syncthreads();
        if (tid < 128) { int4 o; o.x = e0; o.y = baseL[e0] + q0; o.z = e1; o.w = baseL[e1] + q1; *(int4*)(TOKSEL + (size_t)(rb + tid) * 4) = o; }
        __syncthreads();
        if (tid < 8) cntL[tid] = 0;
        __syncthreads();
    }
}
__device__ __forceinline__ void phase_gather(Frame& F, const gu32* gcnt) {
    const int lane = fresh_lane(), tid = F.wave * 64 + lane; (void)tid;
    const bf16* XN = (const bf16*)(F.ws + WS_XN); unsigned char* XG = (unsigned char*)(F.ws + WS_XG);
    const int* TOKSEL = (const int*)(F.ws + WS_ROUTE + 256 * 1024); int* TOKROW = (int*)(F.ws + WS_ROUTE + 768 * 1024);
    int rbase[8]; { int t = 0;
#pragma unroll
        for (int e = 0; e < 8; ++e) { rbase[e] = t * 256; t += (__builtin_amdgcn_readfirstlane((int)__hip_atomic_load(gcnt + e, RLX_AGENT)) + 255) >> 8; } }
    const int gw = F.bx * NWAVES + F.wave, NGW = F.G * NWAVES;
    for (int row = gw; row < T; row += NGW) {
        const int4 sl = *(const int4*)(TOKSEL + (size_t)row * 4);
        int d0 = sl.y, d1 = sl.w;
#pragma unroll
        for (int e = 0; e < 8; ++e) { if (sl.x == e) d0 += rbase[e]; if (sl.z == e) d1 += rbase[e]; }
        const GAS v4u* s = (const GAS v4u*)(XN + (size_t)row * D) + 2 * lane;
        const v4u a = s[0], b = s[1];
        v4u o; o.x = pg8::pk4_fp8(bf_lo(a.x) * SC_X, bf_hi(a.x) * SC_X, bf_lo(a.y) * SC_X, bf_hi(a.y) * SC_X); o.y = pg8::pk4_fp8(bf_lo(a.z) * SC_X, bf_hi(a.z) * SC_X, bf_lo(a.w) * SC_X, bf_hi(a.w) * SC_X);
        o.z = pg8::pk4_fp8(bf_lo(b.x) * SC_X, bf_hi(b.x) * SC_X, bf_lo(b.y) * SC_X, bf_hi(b.y) * SC_X); o.w = pg8::pk4_fp8(bf_lo(b.z) * SC_X, bf_hi(b.z) * SC_X, bf_lo(b.w) * SC_X, bf_hi(b.w) * SC_X);
        ((GAS v4u*)(XG + (size_t)d0 * D))[lane] = o; ((GAS v4u*)(XG + (size_t)d1 * D))[lane] = o;
        if (lane == 0) { TOKROW[row * 2] = d0; TOKROW[row * 2 + 1] = d1; }
    }
}
__device__ __forceinline__ void phase_knorm(Frame& F) {
    const int lane = fresh_lane();
    const bf16* P = (const bf16*)(F.ws + WS_BIG); float* N2 = (float*)(F.ws + WS_ROUTE + 1024 * 1024 + 8192);
    const int gw = F.bx * NWAVES + F.wave, NGW = F.G * NWAVES;
    for (int it = gw; it < NB * 24 * 64; it += NGW) { const int t = it & 63, hm = (it >> 6) % 24, b = it / (24 * 64);
        const GAS v4u* rp = (const GAS v4u*)(P + (size_t)(b * S + 64 * t + lane) * AIN + hm * 64); float ss = 0.f;
#pragma unroll
        for (int i = 0; i < 8; ++i) { const v4u w = rp[i]; const unsigned ww[4] = {w.x, w.y, w.z, w.w};
#pragma unroll
            for (int c = 0; c < 4; ++c) { const float a = bf_lo(ww[c]), b2 = bf_hi(ww[c]); ss += a * a + b2 * b2; } }
#pragma unroll
        for (int o = 1; o < 64; o <<= 1) ss = fmaxf(ss, xor_get(ss, lane, o));
        if (lane == 0) N2[it] = ss; }
}
__device__ __forceinline__ void phase_diff_combine(Frame& F, int j, float lam_init) {
    const int lane = fresh_lane(), tid = F.wave * 64 + lane; (void)tid;
    const bf16* O0 = (const bf16*)(F.ws + WS_BIG + 160 * MiB); const bf16* O1 = O0 + (size_t)T * DAW; bf16* OC = (bf16*)(F.ws + WS_OC);
    const float s1 = wave_sum(F.in[4][j * 64 + lane] * F.in[5][j * 64 + lane], lane), s2 = wave_sum(F.in[6][j * 64 + lane] * F.in[7][j * 64 + lane], lane);
    const float lam = __expf(s1) - __expf(s2) + lam_init;
    const f32x4 g = *(const GAS f32x4*)(F.in[8] + j * 128 + (lane & 31) * 4);
    const int gw = F.bx * NWAVES + F.wave, NGW = F.G * NWAVES;
    for (int row0 = gw * 4; row0 < T; row0 += NGW * 4) {
        v2u a[4][3], b[4][3];
#pragma unroll
        for (int r = 0; r < 4; ++r)
#pragma unroll
            for (int jj = 0; jj < 3; ++jj) { a[r][jj] = ((const GAS v2u*)(O0 + (size_t)(row0 + r) * DAW))[lane + 64 * jj]; b[r][jj] = ((const GAS v2u*)(O1 + (size_t)(row0 + r) * DAW))[lane + 64 * jj]; }
#pragma unroll
        for (int r = 0; r < 4; ++r)
#pragma unroll
            for (int jj = 0; jj < 3; ++jj) {
                f32x4 v; v.x = bf_lo(a[r][jj].x) - lam * bf_lo(b[r][jj].x); v.y = bf_hi(a[r][jj].x) - lam * bf_hi(b[r][jj].x); v.z = bf_lo(a[r][jj].y) - lam * bf_lo(b[r][jj].y); v.w = bf_hi(a[r][jj].y) - lam * bf_hi(b[r][jj].y);
                float ss = (v.x * v.x + v.y * v.y) + (v.z * v.z + v.w * v.w);
                ss = half_sum(ss, lane);
                const float rs = (1.f / sqrtf(ss * (1.f / 128.f) + EPS)) * (1.f - lam_init);
                ((GAS unsigned long long*)(OC + (size_t)(row0 + r) * D))[lane + 64 * jj] = (unsigned long long)pk2(v.x * rs * g.x, v.y * rs * g.y) | ((unsigned long long)pk2(v.z * rs * g.z, v.w * rs * g.w) << 32);
            }
    }
}
__device__ __forceinline__ void phase_hgrn_naive(Frame& F, int j) {
    const int lane = fresh_lane(), tid = F.wave * 64 + lane; (void)tid;
    const bf16* PB = (const bf16*)(F.ws + WS_BIG); const float* FZ = (const float*)(F.ws + WS_BIG + 208 * MiB); float* HO = (float*)(F.ws + WS_BIG + 304 * MiB);
    if (F.bx * 4 >= NB * 6) return;
    const int grp = tid >> 7, t128 = tid & 127, bh = F.bx * 4 + grp, b = bh / 6, h = bh % 6;
    LAS float* sq = (LAS float*)(F.lds + RING_OFF) + grp * (3 * 16 * 128); LAS float* sf = sq + 16 * 128; LAS float* sk = sf + 16 * 128;
    float lb = 0.f;
    if (j == 1) { const float l0 = F.in[14][h * 128 + t128], l1 = F.in[14][768 + h * 128 + t128]; lb = 1.f / (1.f + __expf(l0 - l1)); }
    float St[128];
#pragma unroll
    for (int k = 0; k < 128; ++k) St[k] = 0.f;
    for (int t0 = 0; t0 < S; t0 += 16) {
        __syncthreads();
        for (int jj = 0; jj < 16; ++jj) { const size_t row = (size_t)(b * S + t0 + jj);
            const float qv = bf_lo((unsigned)PB[row * BIN + h * 128 + t128]), fz = FZ[row * DAW + h * 128 + t128];
            const float f = lb + (1.f - lb) / (1.f + __expf(-fz));
            sq[jj * 128 + t128] = qv; sf[jj * 128 + t128] = f; sk[jj * 128 + t128] = 1.f - f; }
        __syncthreads();
        for (int jj = 0; jj < 16; ++jj) { const size_t row = (size_t)(b * S + t0 + jj);
            const float v = bf_lo((unsigned)PB[row * BIN + 1536 + h * 128 + t128]);
            float o = 0.f;
#pragma unroll
            for (int k = 0; k < 128; k += 4) { const f32x4 f4 = *(const LAS f32x4*)(sf + jj * 128 + k), k4 = *(const LAS f32x4*)(sk + jj * 128 + k), q4 = *(const LAS f32x4*)(sq + jj * 128 + k);
                St[k] = f4.x * St[k] + k4.x * v; o += q4.x * St[k]; St[k + 1] = f4.y * St[k + 1] + k4.y * v; o += q4.y * St[k + 1];
                St[k + 2] = f4.z * St[k + 2] + k4.z * v; o += q4.z * St[k + 2]; St[k + 3] = f4.w * St[k + 3] + k4.w * v; o += q4.w * St[k + 3]; }
            HO[row * DAW + h * 128 + t128] = o; }
    }
    __syncthreads();
}
__device__ __forceinline__ void phase_hgrn_out(Frame& F, int j) {
    const int lane = fresh_lane(), tid = F.wave * 64 + lane; (void)tid;
    const bf16* PB = (const bf16*)(F.ws + WS_BIG); const float* HO = (const float*)(F.ws + WS_BIG + 304 * MiB); bf16* OC = (bf16*)(F.ws + WS_OC);
    const f32x4 g = *(const GAS f32x4*)(F.in[15] + j * 128 + (lane & 31) * 4);
    const int gw = F.bx * NWAVES + F.wave, NGW = F.G * NWAVES;
    for (int row = gw; row < T; row += NGW) {
#pragma unroll
        for (int jj = 0; jj < 3; ++jj) {
            const f32x4 v = ((const GAS f32x4*)(HO + (size_t)row * DAW))[lane + 64 * jj];
            const v2u gt = ((const GAS v2u*)(PB + (size_t)row * BIN + 2304))[lane + 64 * jj];
            float ss = (v.x * v.x + v.y * v.y) + (v.z * v.z + v.w * v.w);
            ss = half_sum(ss, lane);
            const float rs = 1.f / sqrtf(ss * (1.f / 128.f) + EPS);
            ((GAS unsigned long long*)(OC + (size_t)row * D))[lane + 64 * jj] =
                (unsigned long long)pk2(v.x * rs * g.x * pg8::silu_f(bf_lo(gt.x)), v.y * rs * g.y * pg8::silu_f(bf_hi(gt.x))) | ((unsigned long long)pk2(v.z * rs * g.z * pg8::silu_f(bf_lo(gt.y)), v.w * rs * g.w * pg8::silu_f(bf_hi(gt.y))) << 32);
        }
    }
}
constexpr int HG_LD = 136, HG_LS = 72;
constexpr int HL_QB = 0, HL_QT = 17408, HL_K = 34816, HL_VT = 78336, HL_PM = 96768, HL_TOT = 105984, HL_SSQ = 110080;
constexpr size_t WS_DCH = WS_SIN + 96 * MiB;
typedef short hbf16x8 __attribute__((ext_vector_type(8)));
typedef float hf32x2 __attribute__((ext_vector_type(2)));
__device__ __forceinline__ hbf16x8 lds8(const LAS unsigned short* p) { return *(const LAS hbf16x8*)p; }
__device__ __forceinline__ float ex2(float v) { return __builtin_amdgcn_exp2f(v); }
template <int PASS>
__device__ __forceinline__ void hgrn_load(Frame& F, int tid, int unit, hf32x2 (&lf)[8], unsigned (&qw)[8], v4u& va, v4u& vb) {
    const bf16* PB = (const bf16*)(F.ws + WS_BIG); const float* LF = (const float*)(F.ws + WS_BIG + 208 * MiB);
    const int kp = tid & 63, wave = __builtin_amdgcn_readfirstlane(tid >> 6), I = wave & 3, hf = wave >> 2, r0 = 16 * I + 8 * hf;
    const int bh = unit >> 6, c = unit & 63, b = bh / 6, h = bh % 6;
    const size_t tok0 = (size_t)b * S + c * 64;
#pragma unroll
    for (int jj = 0; jj < 8; ++jj) lf[jj] = *(const GAS hf32x2*)(LF + (tok0 + r0 + jj) * DAW + h * 128 + 2 * kp);
    if (PASS == 3) {
#pragma unroll
        for (int jj = 0; jj < 8; ++jj) qw[jj] = *(const GAS unsigned*)(PB + (tok0 + r0 + jj) * BIN + h * 128 + 2 * kp); }
    { const int sp = tid >> 4, e8 = (tid & 15) * 8; va = *(const GAS v4u*)(PB + (tok0 + 2 * sp) * BIN + 1536 + h * 128 + e8); vb = *(const GAS v4u*)(PB + (tok0 + 2 * sp + 1) * BIN + 1536 + h * 128 + e8); }
}
template <int PASS>
__device__ __forceinline__ void hgrn_unit(Frame& F, int tid, int unit, int nunit, int j, hf32x2 (&lf)[8], unsigned (&qw)[8], v4u& va, v4u& vb) {
    const bf16* PB = (const bf16*)(F.ws + WS_BIG); const float* LF = (const float*)(F.ws + WS_BIG + 208 * MiB);
    bf16* SLOC = (bf16*)(F.ws + WS_SLOC); const bf16* SIN = (const bf16*)(F.ws + WS_SIN); float* DCH = (float*)(F.ws + WS_DCH); bf16* OC = (bf16*)(F.ws + WS_OC);
    LAS unsigned short* QB = (LAS unsigned short*)(F.lds + HL_QB); LAS unsigned short* QT = (LAS unsigned short*)(F.lds + HL_QT); LAS unsigned short* KK = (LAS unsigned short*)(F.lds + HL_K);
    LAS unsigned short* VT = (LAS unsigned short*)(F.lds + HL_VT); LAS unsigned short* PM = (LAS unsigned short*)(F.lds + HL_PM); LAS float* TOT = (LAS float*)(F.lds + HL_TOT); LAS float* SSQ = (LAS float*)(F.lds + HL_SSQ);
    const int kp = tid & 63, lane = kp, wave = __builtin_amdgcn_readfirstlane(tid >> 6), I = wave & 3, hf = wave >> 2, sub = 2 * I + hf, r0 = 16 * I + 8 * hf, fr = lane & 15, fg = lane >> 4;
    const int bh = unit >> 6, c = unit & 63, b = bh / 6, h = bh % 6;
    const size_t tok0 = (size_t)b * S + c * 64;
    { const int sp = tid >> 4, e8 = (tid & 15) * 8; const v4u a = va, b2 = vb;
        const unsigned wa[4] = {a.x, a.y, a.z, a.w}, wb[4] = {b2.x, b2.y, b2.z, b2.w};
#pragma unroll
        for (int i = 0; i < 4; ++i) { *(LAS unsigned*)(VT + (e8 + 2 * i) * HG_LS + 2 * sp) = (wa[i] & 0xffffu) | (wb[i] << 16); *(LAS unsigned*)(VT + (e8 + 2 * i + 1) * HG_LS + 2 * sp) = (wa[i] >> 16) | (wb[i] & 0xffff0000u); } }
    hf32x2 cs[8]; { hf32x2 run = {0.f, 0.f};
#pragma unroll
        for (int jj = 0; jj < 8; ++jj) { run += lf[jj]; cs[jj] = run; } }
    *(LAS hf32x2*)(TOT + sub * 128 + 2 * kp) = cs[7];
    __syncthreads();
    hf32x2 rho = {0.f, 0.f}, presub = {0.f, 0.f}, blast = {0.f, 0.f};
#pragma unroll
    for (int s2 = 0; s2 < 8; ++s2) { const hf32x2 t = *(const LAS hf32x2*)(TOT + s2 * 128 + 2 * kp); if (s2 < 2 * I) rho += t; if (s2 < sub) presub += t; blast += t; }
    const hf32x2 off = presub - rho;
    if (PASS == 1) {
        unsigned w0[4], w1[4];
#pragma unroll
        for (int i = 0; i < 4; ++i) { const hf32x2 ba = rho + off + cs[2 * i], bb = rho + off + cs[2 * i + 1];
            w0[i] = pg8::cvt_pk_bf16((1.f - ex2(lf[2 * i].x)) * ex2(blast.x - ba.x), (1.f - ex2(lf[2 * i + 1].x)) * ex2(blast.x - bb.x));
            w1[i] = pg8::cvt_pk_bf16((1.f - ex2(lf[2 * i].y)) * ex2(blast.y - ba.y), (1.f - ex2(lf[2 * i + 1].y)) * ex2(blast.y - bb.y)); }
        *(LAS v4u*)(KK + (2 * kp) * HG_LS + r0) = (v4u){w0[0], w0[1], w0[2], w0[3]}; *(LAS v4u*)(KK + (2 * kp + 1) * HG_LS + r0) = (v4u){w1[0], w1[1], w1[2], w1[3]};
        if (sub == 0) *(GAS hf32x2*)(DCH + (size_t)unit * 128 + 2 * kp) = (hf32x2){ex2(blast.x), ex2(blast.y)};
        __syncthreads();
        if (nunit >= 0) hgrn_load<PASS>(F, tid, nunit, lf, qw, va, vb);
        const hbf16x8 a0 = lds8(KK + (16 * wave + fr) * HG_LS + 8 * fg), a1 = lds8(KK + (16 * wave + fr) * HG_LS + 32 + 8 * fg);
#pragma unroll
        for (int et = 0; et < 8; ++et) { const hbf16x8 b0 = lds8(VT + (16 * et + fr) * HG_LS + 8 * fg), b1 = lds8(VT + (16 * et + fr) * HG_LS + 32 + 8 * fg);
            f32x4 d = {0.f, 0.f, 0.f, 0.f}; d = __builtin_amdgcn_mfma_f32_16x16x32_bf16(a0, b0, d, 0, 0, 0); d = __builtin_amdgcn_mfma_f32_16x16x32_bf16(a1, b1, d, 0, 0, 0);
            v2u w2; w2.x = pk2(d[0], d[1]); w2.y = pk2(d[2], d[3]);
            *(GAS v2u*)(SLOC + ((size_t)unit * 128 + 16 * et + fr) * 128 + 16 * wave + 4 * fg) = w2; }
        __syncthreads();
    } else {
        const hf32x2 er = {ex2(rho.x), ex2(rho.y)};
        hf32x2 base[8];
#pragma unroll
        for (int jj = 0; jj < 8; ++jj) { const hf32x2 bl = off + cs[jj]; const hf32x2 e = {ex2(bl.x), ex2(bl.y)}; const hf32x2 q = {bf_lo(qw[jj]), bf_hi(qw[jj])}; const hf32x2 qt = q * e, qb = qt * er;
            *(LAS unsigned*)(QT + (r0 + jj) * HG_LD + 2 * kp) = pg8::cvt_pk_bf16(qt.x, qt.y); *(LAS unsigned*)(QB + (r0 + jj) * HG_LD + 2 * kp) = pg8::cvt_pk_bf16(qb.x, qb.y);
            base[jj] = (hf32x2){(1.f - ex2(lf[jj].x)) * ex2(-bl.x), (1.f - ex2(lf[jj].y)) * ex2(-bl.y)}; }
        hf32x2 rr = {0.f, 0.f};
        for (int Ip = I; Ip < 4; ++Ip) { LAS unsigned short* Kp = KK + (8 * Ip * (Ip + 1)) * HG_LD;
            const hf32x2 sc = {ex2(rr.x), ex2(rr.y)};
#pragma unroll
            for (int jj = 0; jj < 8; ++jj) { const hf32x2 kv = base[jj] * sc; *(LAS unsigned*)(Kp + (r0 + jj) * HG_LD + 2 * kp) = pg8::cvt_pk_bf16(kv.x, kv.y); }
            rr += *(const LAS hf32x2*)(TOT + (2 * Ip) * 128 + 2 * kp) + *(const LAS hf32x2*)(TOT + (2 * Ip + 1) * 128 + 2 * kp); }
        __syncthreads();
        const int tt = wave & 3, eh = wave >> 2; const size_t tok = tok0 + 16 * tt + fr;
        hbf16x8 sfr[4][4]; v2u gtv[4];
#pragma unroll
        for (int et = 0; et < 4; ++et) { const int e0 = 64 * eh + 16 * et; const GAS hbf16x8* sp = (const GAS hbf16x8*)(SIN + ((size_t)unit * 128 + e0 + fr) * 128 + 8 * fg);
#pragma unroll
            for (int ks = 0; ks < 4; ++ks) sfr[et][ks] = sp[4 * ks];
            gtv[et] = *(const GAS v2u*)(PB + tok * BIN + 2304 + h * 128 + e0 + 4 * fg); }
        if (nunit >= 0) hgrn_load<PASS>(F, tid, nunit, lf, qw, va, vb);
        { const int It = wave >> 1; const LAS unsigned short* Kp = KK + (8 * It * (It + 1)) * HG_LD;
#pragma unroll
            for (int jt = 0; jt < 2; ++jt) { const int J = 2 * (wave & 1) + jt; f32x4 d = {0.f, 0.f, 0.f, 0.f};
                if (J <= It) {
#pragma unroll
                    for (int ks = 0; ks < 4; ++ks) d = __builtin_amdgcn_mfma_f32_16x16x32_bf16(lds8(QT + (16 * It + fr) * HG_LD + 32 * ks + 8 * fg), lds8(Kp + (16 * J + fr) * HG_LD + 32 * ks + 8 * fg), d, 0, 0, 0);
                    if (J == It) {
#pragma unroll
                        for (int i = 0; i < 4; ++i) if (fr > 4 * fg + i) d[i] = 0.f; }
                }
#pragma unroll
                for (int i = 0; i < 4; ++i) PM[(16 * It + 4 * fg + i) * HG_LS + 16 * J + fr] = (unsigned short)f2bf(d[i]); } }
        __syncthreads();
        f32x4 o[4];
        const hbf16x8 p0 = lds8(PM + (16 * tt + fr) * HG_LS + 8 * fg), p1 = lds8(PM + (16 * tt + fr) * HG_LS + 32 + 8 * fg);
        hbf16x8 qb[4];
#pragma unroll
        for (int ks = 0; ks < 4; ++ks) qb[ks] = lds8(QB + (16 * tt + fr) * HG_LD + 32 * ks + 8 * fg);
        float ss = 0.f;
#pragma unroll
        for (int et = 0; et < 4; ++et) { const int e0 = 64 * eh + 16 * et; f32x4 d = {0.f, 0.f, 0.f, 0.f};
            d = __builtin_amdgcn_mfma_f32_16x16x32_bf16(lds8(VT + (e0 + fr) * HG_LS + 8 * fg), p0, d, 0, 0, 0);
            d = __builtin_amdgcn_mfma_f32_16x16x32_bf16(lds8(VT + (e0 + fr) * HG_LS + 32 + 8 * fg), p1, d, 0, 0, 0);
#pragma unroll
            for (int ks = 0; ks < 4; ++ks) d = __builtin_amdgcn_mfma_f32_16x16x32_bf16(sfr[et][ks], qb[ks], d, 0, 0, 0);
            o[et] = d; ss += (d[0] * d[0] + d[1] * d[1]) + (d[2] * d[2] + d[3] * d[3]); }
        ss += xor_get(ss, lane, 16); ss += xor_get(ss, lane, 32);
        if (fg == 0) SSQ[(tt * 2 + eh) * 16 + fr] = ss;
        __syncthreads();
        const float rs = 1.f / sqrtf((SSQ[(tt * 2) * 16 + fr] + SSQ[(tt * 2 + 1) * 16 + fr]) * (1.f / 128.f) + EPS);
#pragma unroll
        for (int et = 0; et < 4; ++et) { const int e = 64 * eh + 16 * et + 4 * fg;
            const f32x4 gn = *(const GAS f32x4*)(F.in[15] + j * 128 + e); const v2u gt = gtv[et];
            v2u w; w.x = pg8::cvt_pk_bf16(o[et][0] * rs * gn.x * pg8::silu_f(bf_lo(gt.x)), o[et][1] * rs * gn.y * pg8::silu_f(bf_hi(gt.x))); w.y = pg8::cvt_pk_bf16(o[et][2] * rs * gn.z * pg8::silu_f(bf_lo(gt.y)), o[et][3] * rs * gn.w * pg8::silu_f(bf_hi(gt.y)));
            *(GAS v2u*)(OC + tok * D + h * 128 + e) = w; }
        __syncthreads();
    }
}
template <int PASS> __device__ __forceinline__ void phase_hgrn(Frame& F, int j) {
    const int tid = F.wave * 64 + fresh_lane();
    hf32x2 lf[8]; unsigned qw[8]; v4u va, vb;
#pragma unroll
    for (int i = 0; i < 8; ++i) qw[i] = 0u;
    if (F.bx < NB * 6 * 64) hgrn_load<PASS>(F, tid, F.bx, lf, qw, va, vb);
    for (int u = F.bx; u < NB * 6 * 64; u += F.G) hgrn_unit<PASS>(F, tid, u, (u + F.G < NB * 6 * 64) ? u + F.G : -1, j, lf, qw, va, vb);
}
__device__ __forceinline__ void phase_hgrn_scan(Frame& F) {
    const bf16* SLOC = (const bf16*)(F.ws + WS_SLOC); bf16* SIN = (bf16*)(F.ws + WS_SIN); const float* DCH = (const float*)(F.ws + WS_DCH);
    const int tid = F.wave * 64 + fresh_lane();
    for (int id = F.bx * (NWAVES * 64) + tid; id < NB * 6 * 128 * 16; id += F.G * NWAVES * 64) {
        const int k8 = id & 15, e = (id >> 4) & 127, bh = id >> 11;
        const GAS v4u* sl = (const GAS v4u*)(SLOC + ((size_t)bh * 64 * 128 + e) * 128) + k8; const GAS f32x4* dc = (const GAS f32x4*)(DCH + (size_t)bh * 64 * 128) + 2 * k8;
        GAS v4u* so = (GAS v4u*)(SIN + ((size_t)bh * 64 * 128 + e) * 128) + k8;
        float st[8];
#pragma unroll
        for (int i = 0; i < 8; ++i) st[i] = 0.f;
#pragma unroll 8
        for (int c = 0; c < 64; ++c) { const v4u aw = sl[(size_t)c * 128 * 16]; const f32x4 d0 = dc[(size_t)c * 32], d1 = dc[(size_t)c * 32 + 1];
            v4u w; w.x = pg8::cvt_pk_bf16(st[0], st[1]); w.y = pg8::cvt_pk_bf16(st[2], st[3]); w.z = pg8::cvt_pk_bf16(st[4], st[5]); w.w = pg8::cvt_pk_bf16(st[6], st[7]); so[(size_t)c * 128 * 16] = w;
            st[0] = d0.x * st[0] + bf_lo(aw.x); st[1] = d0.y * st[1] + bf_hi(aw.x); st[2] = d0.z * st[2] + bf_lo(aw.y); st[3] = d0.w * st[3] + bf_hi(aw.y);
            st[4] = d1.x * st[4] + bf_lo(aw.z); st[5] = d1.y * st[5] + bf_hi(aw.z); st[6] = d1.z * st[6] + bf_lo(aw.w); st[7] = d1.w * st[7] + bf_hi(aw.w); }
    }
}
struct Args { const float* in[27]; float* out; unsigned char* ws; };
__global__ void __launch_bounds__(NWAVES * 64, 2) mk_fwd(Args) {
    extern __shared__ __attribute__((aligned(16))) unsigned char lds[];
    Frame F;
    F.lds = (LAS unsigned char*)lds;
    F.MISC = (volatile LAS unsigned*)(F.lds + MISC_OFF);
    F.wave = __builtin_amdgcn_readfirstlane((int)(threadIdx.x >> 6));
    F.G = gridDim.x; F.bx = blockIdx.x; { const int bx = blockIdx.x; F.vcu = (F.G % 8 == 0) ? (bx % 8) * (F.G / 8) + bx / 8 : bx; }
    for (int u = threadIdx.x; u < (LDS_BYTES - LDSCTL_OFF) / 4; u += NWAVES * 64) ((LAS unsigned*)(F.lds + LDSCTL_OFF))[u] = 0u;
    __syncthreads();
    {
        LAS unsigned long long* tab = (LAS unsigned long long*)(F.lds + LDSCTL_OFF);
        if (threadIdx.x < 29) tab[threadIdx.x] = ((const unsigned long long*)__builtin_amdgcn_kernarg_segment_ptr())[threadIdx.x];
        __syncthreads();
        F.in.t = tab; F.out = (GAS float*)(unsigned long long)F.in[27]; F.ws = (GAS unsigned char*)(unsigned long long)F.in[28]; }
    F.ctl = (gu32*)(F.ws + WS_CTL);
    XcdBarrier bar = xcd_barrier_post((unsigned*)(F.ctl + CW_BAR), F.MISC + 8);
#define XBAR_() do { XcdBarrier b_ = bar; { unsigned long long p_ = (unsigned long long)b_.bar; asm volatile("" : "+s"(p_), "+s"(b_.x)); b_.bar = (unsigned*)(GAS unsigned*)p_; } xcd_barrier(b_); if (MK_DUP & 0x8000) xcd_barrier(b_); } while (0)
#define GRID_BAR() XBAR_()
#define REP(cat) for (int rep_ = 0; rep_ < (((MK_DUP >> (cat)) & 1) ? 2 : 1); ++rep_)
#if MK_TS
    unsigned long long ts_last = rt(); unsigned ts_cat[15], ts_wb[14];
#pragma unroll
    for (int i = 0; i < 15; ++i) ts_cat[i] = 0u;
#pragma unroll
    for (int i = 0; i < 14; ++i) ts_wb[i] = 0u;
#define GRID_BAR_T(c) do { const unsigned long long arr_ = rt(); XBAR_(); const unsigned long long now_ = rt(); const unsigned dt_ = (unsigned)(arr_ - ts_last), db_ = (unsigned)(now_ - arr_); ts_last = now_; const int cc_ = (c); \
    _Pragma("unroll") for (int i_ = 0; i_ < 14; ++i_) { ts_cat[i_] += (cc_ == i_) ? dt_ : 0u; ts_wb[i_] += (cc_ == i_) ? db_ : 0u; } ts_cat[14] += db_; } while (0)
#else
#define GRID_BAR_T(c) XBAR_()
#endif

    REP(0) phase_prologue(F);
    GRID_BAR_T(0);
    {
        struct MkvOrder { int G, c; __device__ bool next(int i, pg8::Unit& u) const { const int L = i * G + c; if (L >= 64) return false; u.pm = L >> 1; u.pn = L & 1; u.pb = (u.pm >> 3) * 2 + u.pn; return true; }
            __device__ __forceinline__ void a_ready(const pg8::Unit&) const {} __device__ __forceinline__ void done(const pg8::Unit&) const {} } So{F.G, F.bx};
        pg8::Gemm g{(const pg8::bf16_t*)(F.ws + WS_MEMN), (const pg8::bf16_t*)(F.ws + WS_WMKV), 4 * NB * MEML, 512, D};
        pg8::EpiProj E{(pg8::bf16_t*)(F.ws + WS_MKV), 512, 0u, 1.f, 0, 0, nullptr, 0, nullptr, nullptr, nullptr};
        pg8::gemm_phase<pg8::EpiProj, MkvOrder, true, true>(F.lds + RING_OFF, g, So, E, F.wave);
    }
    for (int l = 0; l < 4; ++l) {
        const int j = l >> 1; const bool isA = (l & 1) == 0;
        {
            unsigned long long w_ = (unsigned long long)F.ws, o_ = (unsigned long long)F.out, c_ = (unsigned long long)F.ctl, b_ = (unsigned long long)bar.bar;
            asm volatile("" : "+s"(w_), "+s"(o_), "+s"(c_), "+s"(b_)); F.ws = (GAS unsigned char*)w_; F.out = (GAS float*)o_; F.ctl = (gu32*)c_; bar.bar = (unsigned*)b_;
            asm volatile("" : "+s"(F.vcu), "+s"(F.G), "+s"(F.bx), "+s"(F.wave)); }
        bf16* const XN = (bf16*)(F.ws + WS_XN); bf16* const OC = (bf16*)(F.ws + WS_OC); float* const X = (float*)F.out;
        if (isA) {
            pg8::Gemm g{XN, (const pg8::bf16_t*)(F.ws + WS_WINA) + (size_t)j * AIN * D, T, AIN, D}; pg8::StaticOrder So; So.init(T, AIN, F.G, F.bx);
            pg8::EpiProj E{(pg8::bf16_t*)(F.ws + WS_BIG), AIN, 0x207u, C2, 0, 0, nullptr, 0, nullptr, nullptr, (unsigned*)(F.ctl + CW_N2) + j * (NB * 24 * 64 * 2)};
            REP(1) pg8::gemm_phase<pg8::EpiProj, pg8::StaticOrder, true, true>(F.lds + RING_OFF, g, So, E, F.wave);
        } else {
            pg8::Gemm g{XN, (const pg8::bf16_t*)(F.ws + WS_WINB) + (size_t)j * BIN * D, T, BIN, D}; pg8::StaticOrder So; So.init(T, BIN, F.G, F.bx);
            pg8::EpiProj E{(pg8::bf16_t*)(F.ws + WS_BIG), BIN, 0x1000u, C2, 3, 6, (float*)(F.ws + WS_BIG + 208 * MiB), DAW, (const float*)(F.ws + WS_ROUTE + 1024 * 1024) + j * DAW, (const float*)(F.ws + WS_SSQP) + (size_t)(2 * j + 1) * T * 16, nullptr};
            REP(1) pg8::gemm_phase<pg8::EpiProj, pg8::StaticOrder, true, true>(F.lds + RING_OFF, g, So, E, F.wave);
        }
        GRID_BAR_T(1);
        const int ldp = isA ? AIN : BIN, qmoff = isA ? 2304 : 3072;
        if (isA) {
            const attn_body::bf16* P = (const attn_body::bf16*)(F.ws + WS_BIG); attn_body::bf16* O01 = (attn_body::bf16*)(F.ws + WS_BIG + 160 * MiB);
            const GAS float* N2 = (const GAS float*)(F.ctl + CW_N2) + j * (NB * 24 * 64 * 2); const int lane_n = fresh_lane();
            const bool tabdeal = (F.G == 256);
            static_assert(attn_body::LDS2_BYTES <= RING_BYTES, "attention LDS");
            REP(2) for (int u_ = F.vcu; u_ < NB * 2 * 96; u_ += F.G) {
                int b, m, h, qb; if (tabdeal) { const int e = ATT_DEAL[u_ & 15][u_ >> 8]; b = (u_ >> 5) & 7; m = (u_ >> 4) & 1; h = e >> 4; qb = e & 15; } else { b = u_ / 192; m = (u_ / 96) & 1; h = (u_ % 96) >> 4; qb = u_ & 15; }
                const float nsl2 = -1.4426950408889634f * exp2f(-8.f * (float)(h + 1) / 6.f);
                const attn_body::bf16* Kh = P + (size_t)b * S * AIN + 768 + h * 128 + m * 64; const attn_body::bf16* Vh = P + (size_t)b * S * AIN + 1536 + h * 128;
                { const int NT = 4 * qb + 4;
                    typedef float f32x2n __attribute__((ext_vector_type(2)));
                    const f32x2n qn2 = *(const GAS f32x2n*)(N2 + ((b * 24 + h * 2 + m) * 64 + lane_n) * 2), kn2 = *(const GAS f32x2n*)(N2 + ((b * 24 + 12 + h * 2 + m) * 64 + lane_n) * 2);
                    const bool qin = (lane_n >= 4 * qb && lane_n < 4 * qb + 4), kin = (lane_n < NT);
                    float qa = qin ? qn2.x : 0.f, qb2 = qin ? qn2.y : 0.f, ka = kin ? kn2.x : 0.f, kb = kin ? kn2.y : 0.f;
#pragma unroll
                    for (int o = 1; o < 64; o <<= 1) { qa = fmaxf(qa, xor_get(qa, lane_n, o)); qb2 = fmaxf(qb2, xor_get(qb2, lane_n, o)); ka = fmaxf(ka, xor_get(ka, lane_n, o)); kb = fmaxf(kb, xor_get(kb, lane_n, o)); }
                    const float dreq = (160.f + 2.f * (sqrtf(qa * ka) + sqrtf(qb2 * kb)) * 1.02f) / (-nsl2);
                    int tskip = (int)floorf(((float)(qb * 256 - 63) - dreq) * (1.f / 64.f)); tskip = tskip < 0 ? 0 : tskip; tskip &= ~1; tskip = tskip > NT - 4 ? NT - 4 : tskip;
                    tskip = __builtin_amdgcn_readfirstlane(tskip);
                    attn_body::attn_unit2<8>(P + (size_t)(b * S + qb * 256) * AIN + h * 128 + m * 64, AIN, Kh + (size_t)tskip * 64 * AIN, AIN, Vh + (size_t)tskip * 64 * AIN, AIN,
                                             O01 + (size_t)m * T * DAW + (size_t)(b * S + qb * 256) * DAW + h * 128, DAW, NT - tskip, qb * 256 - 64 * tskip, nsl2, (char*)lds + RING_OFF, F.wave); }
            }
        } else {
            REP(3) phase_hgrn<1>(F, j);
        }
        {
            const attn_body::bf16* P = (const attn_body::bf16*)(F.ws + WS_BIG); const attn_body::bf16* KV = (const attn_body::bf16*)(F.ws + WS_MKV) + (size_t)l * NB * MEML * 512;
#ifndef NO_ATTN1
            REP(13) for (int u = F.vcu; u < NB * 4 * 16; u += F.G) { const int qb = u & 15, hm = (u >> 4) & 3, b = u >> 6;
                attn_body::attn_unit<1, 8>(P + (size_t)(b * S + qb * 256) * ldp + qmoff + hm * 64, ldp, KV + (size_t)b * MEML * 512 + hm * 64, 512, KV + (size_t)b * MEML * 512 + 256 + hm * 64, 512,
                                           (attn_body::bf16*)OC + (size_t)(b * S + qb * 256) * D + DAW + hm * 64, D, 4, 0, 0.f, (char*)lds + RING_OFF, F.wave); }
#endif
        }
        GRID_BAR_T(isA ? 2 : 3);
        if (isA) { REP(5) phase_diff_combine(F, j, l == 0 ? 0.2f : (float)(0.8 - 0.6 * 0.5488116360940264)); }
        else { REP(14) phase_hgrn_scan(F); GRID_BAR_T(4); REP(4) phase_hgrn<3>(F, j); }
        GRID_BAR_T(isA ? 5 : 4);
#if MK_DBG
        {
            const int lane = fresh_lane(); const int gw = F.bx * NWAVES + F.wave, NGW = F.G * NWAVES;
            for (int r = gw; r < 1024; r += NGW) { f32x4 v[4];
#pragma unroll
                for (int jj = 0; jj < 4; ++jj) { const v2u a = ((const GAS v2u*)(OC + (size_t)(r * 32) * D))[lane + 64 * jj]; v[jj].x = bf_lo(a.x); v[jj].y = bf_hi(a.x); v[jj].z = bf_lo(a.y); v[jj].w = bf_hi(a.y); }
                dbg_sample_f32(F, lane, 8 + l, r * 32, v); }
        }
#endif
        {
            pg8::Gemm g{OC, (const pg8::bf16_t*)(F.ws + WS_WOUT) + (size_t)l * D * D, T, D, D}; pg8::StaticOrder So; So.init(T, D, F.G, F.bx);
            if ((MK_DUP >> 6) & 1) { pg8::EpiResid E2{(float*)(F.ws + 1400 * MiB), l == 0 ? F.in[0] : X, D, nullptr, nullptr, nullptr, 1.f}; pg8::gemm_phase<pg8::EpiResid, pg8::StaticOrder, true, true>(F.lds + RING_OFF, g, So, E2, F.wave); }
            pg8::EpiResid E{X, l == 0 ? F.in[0] : X, D, isA ? XN : nullptr, isA ? F.in[19] + j * D : nullptr, isA ? (float*)(F.ws + WS_SSQP) + (size_t)(2 * j) * T * 16 : nullptr, 1.f};
            pg8::gemm_phase<pg8::EpiResid, pg8::StaticOrder, true, true>(F.lds + RING_OFF, g, So, E, F.wave);
        }
        GRID_BAR_T(6);
        if (isA) {
            {
                pg8::Gemm g{XN, (const pg8::bf16_t*)(F.ws + WS_WGUD) + (size_t)j * 2 * FFD * D, T, 2 * FFD, D}; pg8::StaticOrder So; So.init(T, 2 * FFD, F.G, F.bx);
                pg8::EpiSwiglu<false> E{(pg8::bf16_t*)(F.ws + WS_BIG), FFD, 1.f, 1.f, (const float*)(F.ws + WS_SSQP) + (size_t)(2 * j) * T * 16};
                REP(7) pg8::gemm_phase<pg8::EpiSwiglu<false>, pg8::StaticOrder, true, true>(F.lds + RING_OFF, g, So, E, F.wave);
            }
            GRID_BAR_T(7);
            {
                pg8::Gemm g{(const pg8::bf16_t*)(F.ws + WS_BIG), (const pg8::bf16_t*)(F.ws + WS_WDND) + (size_t)j * D * FFD, T, D, FFD}; pg8::StaticOrder So; So.init(T, D, F.G, F.bx);
                if ((MK_DUP >> 8) & 1) { pg8::EpiResid E2{(float*)(F.ws + 1400 * MiB), X, D, nullptr, nullptr, nullptr, 1.f}; pg8::gemm_phase<pg8::EpiResid, pg8::StaticOrder, true, true>(F.lds + RING_OFF, g, So, E2, F.wave); }
                pg8::EpiResid E{X, X, D, XN, F.in[12] + j * D, (float*)(F.ws + WS_SSQP) + (size_t)(2 * j + 1) * T * 16, 1.f};
                pg8::gemm_phase<pg8::EpiResid, pg8::StaticOrder, true, true>(F.lds + RING_OFF, g, So, E, F.wave);
            }
            GRID_BAR_T(8);

        } else {
            gu32* gcnt = F.ctl + CW_GCNT + 64 * j;
#ifndef NO_NORM
            phase_router(F, X, F.in[22] + j * D, F.in[23] + (size_t)j * D * 8, gcnt, 2 * l);
#endif
            GRID_BAR_T(9);
            REP(10) phase_gather(F, gcnt);
            GRID_BAR_T(10);
            {
                int cnt[8];
#pragma unroll
                for (int e = 0; e < 8; ++e) cnt[e] = __builtin_amdgcn_readfirstlane((int)__hip_atomic_load(gcnt + e, RLX_AGENT));
                pg8::Gemm g{(const pg8::bf16_t*)(F.ws + WS_XG), (const pg8::bf16_t*)(F.ws + WS_WGUM + (size_t)j * NE * 2 * FFE * D), MAXROWS, 2 * FFE, D / 2}; pg8::MoeOrder So; So.init(cnt, 2 * FFE / 256, F.G, F.bx);
                pg8::EpiSwiglu<true> E{(pg8::bf16_t*)(F.ws + WS_BIG), FFE, 1.f / (SC_X * SC_WGU), SC_H, nullptr};
                REP(11) pg8::gemm_phase<pg8::EpiSwiglu<true>, pg8::MoeOrder, true, true, true>(F.lds + RING_OFF, g, So, E, F.wave);
            }
            GRID_BAR_T(11);
            {
                int cnt[8];
#pragma unroll
                for (int e = 0; e < 8; ++e) cnt[e] = __builtin_amdgcn_readfirstlane((int)__hip_atomic_load(gcnt + e, RLX_AGENT));
                pg8::Gemm g{(const pg8::bf16_t*)(F.ws + WS_BIG), (const pg8::bf16_t*)(F.ws + WS_WDNM + (size_t)j * NE * D * FFE), MAXROWS, D, FFE / 2}; pg8::MoeOrder So; So.init(cnt, D / 256, F.G, F.bx);
                pg8::EpiProj E{(pg8::bf16_t*)(F.ws + WS_Y), D, 0xffffffffu, 1.f / (SC_H * SC_WDN), 0, 0, nullptr, 0, nullptr, nullptr, nullptr};
                REP(12) pg8::gemm_phase<pg8::EpiProj, pg8::MoeOrder, true, true, true>(F.lds + RING_OFF, g, So, E, F.wave);
            }
            GRID_BAR_T(12);
            if (l == 1) { phase_norm<true, false, false>(F, X, X, F.in[2] + 1 * D, nullptr, nullptr, 2 * l + 1); GRID_BAR_T(9); }
            else {
                phase_norm<true, false, true>(F, X, X, F.in[26], nullptr, nullptr, 2 * l + 1);
#if MK_TS
                if (F.bx == 0 && F.wave == 0) { unsigned ta = 0u;
#pragma unroll
                    for (int i = 0; i < 15; ++i) if ((MK_TS_A >> i) & 1) ta += ts_cat[i];
#pragma unroll
                    for (int i = 0; i < 14; ++i) if ((MK_TS_B >> i) & 1) ta += ts_wb[i];
                    const unsigned long long t0_ = rt(); while ((unsigned)(rt() - t0_) < ta) __builtin_amdgcn_s_sleep(8); }
#endif
            }
        }
    }
#undef GRID_BAR
}

static int mk_launch(void* const* d_in, void* d_out, void* d_ws, size_t ws_size, hipStream_t stream) {
    static int grid = 0;
    if (grid == 0) {
        if (ws_size < WS_END) { fprintf(stderr, "kernel_launch: workspace too small (%zu < %zu)\n", ws_size, (size_t)WS_END); grid = -1; return -1; }
        int dev = 0, cus = 0, per_cu = 0;
        if (hipGetDevice(&dev) != hipSuccess || hipDeviceGetAttribute(&cus, hipDeviceAttributeMultiprocessorCount, dev) != hipSuccess) { grid = -1; return -1; }
        if (hipFuncSetAttribute((const void*)mk_fwd, hipFuncAttributeMaxDynamicSharedMemorySize, LDS_BYTES) != hipSuccess) { fprintf(stderr, "kernel_launch: hipFuncSetAttribute failed\n"); grid = -1; return -1; }
        if (hipOccupancyMaxActiveBlocksPerMultiprocessor(&per_cu, (const void*)mk_fwd, NWAVES * 64, LDS_BYTES) != hipSuccess || per_cu < 1) fprintf(stderr, "kernel_launch: note: occupancy query reports %d\n", per_cu);
        (void)hipGetLastError();
        grid = cus;
        if (grid != 256) fprintf(stderr, "kernel_launch: note: %d CUs (tuned for 256)\n", grid);
    }
    if (grid < 0) return -1;
    if (hipMemsetAsync((char*)d_ws + WS_CTL, 0, CTL_ZERO_BYTES, stream) != hipSuccess) return -1;
    Args a{};
    for (int i = 0; i < 27; ++i) a.in[i] = (const float*)d_in[i];
    a.out = (float*)d_out; a.ws = (unsigned char*)d_ws;
    hipLaunchKernelGGL(mk_fwd, dim3(grid), dim3(NWAVES * 64), LDS_BYTES, stream, a);
    return 0;
}
#if MK_DBG
namespace nv {
constexpr int MEMW = 256;

__device__ __forceinline__ float sigmoidf_(float z) { return 1.f / (1.f + __expf(-z)); }
__device__ __forceinline__ float siluf_(float z) { return z / (1.f + __expf(-z)); }

__global__ void __launch_bounds__(256) k_rmsnorm(const float* __restrict__ in, const float* __restrict__ g, float* __restrict__ out, int rows) {
    const int lane = threadIdx.x & 63, w = (blockIdx.x * 256 + threadIdx.x) >> 6, nw = (gridDim.x * 256) >> 6;
    for (int r = w; r < rows; r += nw) {
        const float4* xr = (const float4*)(in + (size_t)r * D) + lane;
        float4 v[4]; float s = 0.f;
#pragma unroll
        for (int j = 0; j < 4; ++j) { v[j] = xr[64 * j]; s += v[j].x * v[j].x + v[j].y * v[j].y + v[j].z * v[j].z + v[j].w * v[j].w; }
        const float rstd = rsqrtf(wave_sum(s) * (1.f / D) + EPS);
        float4* o = (float4*)(out + (size_t)r * D) + lane;
#pragma unroll
        for (int j = 0; j < 4; ++j) { const float4 gg = ((const float4*)g)[lane + 64 * j];
            o[64 * j] = make_float4(v[j].x * rstd * gg.x, v[j].y * rstd * gg.y, v[j].z * rstd * gg.z, v[j].w * rstd * gg.w); }
    }
}

template <int ADD>
__global__ void __launch_bounds__(256) k_gemm(const float* __restrict__ A, int lda, const float* __restrict__ Bm, int ldb, float* C, int ldc, const float* R, int M, int N, int K, const int* dyn, int offA, int offC) {
    __shared__ float As[8][132];
    __shared__ float Bs[8][128];
    int roffA = 0, roffC = 0;
    if (dyn) { roffA = offA ? dyn[0] : 0; roffC = offC ? dyn[0] : 0; M = dyn[1] < 16384 ? dyn[1] : 16384; }
    const int m0 = blockIdx.y * 128, n0 = blockIdx.x * 128;
    if (m0 >= M) return;
    const int tid = threadIdx.x, ty = tid >> 4, tx = tid & 15;
    float acc[8][8];
#pragma unroll
    for (int i = 0; i < 8; ++i)
#pragma unroll
        for (int j = 0; j < 8; ++j) acc[i][j] = 0.f;
    const int ar = tid >> 1, ak = (tid & 1) * 4;
    int arow = m0 + ar; if (arow >= M) arow = M - 1;
    const float* ap = A + (size_t)(roffA + arow) * lda + ak;
    const int bk = tid >> 5, bn = (tid & 31) * 4;
    const float* bp = Bm + (size_t)bk * ldb + n0 + bn;
    for (int k0 = 0; k0 < K; k0 += 8) {
        const float4 av = *(const float4*)(ap + k0);
        const float4 bv = *(const float4*)(bp + (size_t)k0 * ldb);
        __syncthreads();
        As[ak + 0][ar] = av.x; As[ak + 1][ar] = av.y; As[ak + 2][ar] = av.z; As[ak + 3][ar] = av.w;
        *(float4*)&Bs[bk][bn] = bv;
        __syncthreads();
#pragma unroll
        for (int k = 0; k < 8; ++k) {
            float a[8], b[8];
            *(float4*)&a[0] = *(const float4*)&As[k][ty * 4]; *(float4*)&a[4] = *(const float4*)&As[k][64 + ty * 4];
            *(float4*)&b[0] = *(const float4*)&Bs[k][tx * 4]; *(float4*)&b[4] = *(const float4*)&Bs[k][64 + tx * 4];
#pragma unroll
            for (int i = 0; i < 8; ++i)
#pragma unroll
                for (int j = 0; j < 8; ++j) acc[i][j] += a[i] * b[j];
        }
    }
#pragma unroll
    for (int i = 0; i < 8; ++i) {
        const int r = m0 + (i < 4 ? ty * 4 + i : 64 + ty * 4 + (i - 4));
        if (r >= M) continue;
#pragma unroll
        for (int jh = 0; jh < 2; ++jh) {
            const int c = n0 + jh * 64 + tx * 4;
            float4 v = make_float4(acc[i][jh * 4 + 0], acc[i][jh * 4 + 1], acc[i][jh * 4 + 2], acc[i][jh * 4 + 3]);
            if (ADD) { const float4 rr = *(const float4*)(R + (size_t)(roffC + r) * ldc + c); v.x += rr.x; v.y += rr.y; v.z += rr.z; v.w += rr.w; }
            *(float4*)(C + (size_t)(roffC + r) * ldc + c) = v;
        }
    }
}

__global__ void __launch_bounds__(64) k_diff_attn(const float* __restrict__ proj  , float* __restrict__ O  ) {
    const int c = blockIdx.x, bhm = blockIdx.y, m = bhm & 1, h = (bhm >> 1) % 6, b = bhm / 12;
    const int qpos = c * 64 + threadIdx.x;
    const float slope = exp2f(-8.f * (float)(h + 1) / 6.f);
    float q[64];
    const float* qp = proj + (size_t)(b * S + qpos) * AIN + h * 128 + m * 64;
#pragma unroll
    for (int d = 0; d < 64; d += 4) { const float4 v = *(const float4*)(qp + d); q[d] = v.x * 0.125f; q[d + 1] = v.y * 0.125f; q[d + 2] = v.z * 0.125f; q[d + 3] = v.w * 0.125f; }
    const int nk = (c + 1) * 64;
    const float* kbase = proj + (size_t)b * S * AIN + DAW + h * 128 + m * 64;
    const float* vbase = proj + (size_t)b * S * AIN + 2 * DAW + h * 128;
    float mx = -3.0e38f;
    for (int k = 0; k < nk; ++k) {
        const float* kr = kbase + (size_t)k * AIN;
        float s = 0.f;
#pragma unroll
        for (int d = 0; d < 64; ++d) s += q[d] * kr[d];
        s -= slope * fabsf((float)(qpos - k));
        mx = fmaxf(mx, s);
    }
    float o[128];
#pragma unroll
    for (int e = 0; e < 128; ++e) o[e] = 0.f;
    float l = 0.f;
    for (int k = 0; k < nk; ++k) {
        const float* kr = kbase + (size_t)k * AIN;
        float s = 0.f;
#pragma unroll
        for (int d = 0; d < 64; ++d) s += q[d] * kr[d];
        s -= slope * fabsf((float)(qpos - k));
        const float p = __expf(s - mx);
        l += p;
        const float* vr = vbase + (size_t)k * AIN;
#pragma unroll
        for (int e = 0; e < 128; ++e) o[e] += p * vr[e];
    }
    const float il = 1.f / l;
    float* op = O + (size_t)m * T * DAW + (size_t)(b * S + qpos) * DAW + h * 128;
#pragma unroll
    for (int e = 0; e < 128; e += 4) *(float4*)(op + e) = make_float4(o[e] * il, o[e + 1] * il, o[e + 2] * il, o[e + 3] * il);
}
__global__ void __launch_bounds__(256) k_diff_combine(const float* __restrict__ O, const float* __restrict__ lq1, const float* __restrict__ lk1, const float* __restrict__ lq2, const float* __restrict__ lk2,
                                                       const float* __restrict__ subln, float lam_init, float* __restrict__ OC) {
    float s1 = 0.f, s2 = 0.f;
    for (int d = 0; d < 64; ++d) { s1 += lq1[d] * lk1[d]; s2 += lq2[d] * lk2[d]; }
    const float lam = __expf(s1) - __expf(s2) + lam_init;
    const int idx = blockIdx.x * 256 + threadIdx.x;
    if (idx >= T * 6) return;
    const int t = idx / 6, h = idx % 6;
    const float* o0 = O + (size_t)t * DAW + h * 128; const float* o1 = o0 + (size_t)T * DAW;
    float v[128]; float ss = 0.f;
#pragma unroll
    for (int e = 0; e < 128; ++e) { v[e] = o0[e] - lam * o1[e]; ss += v[e] * v[e]; }
    const float rstd = rsqrtf(ss * (1.f / 128.f) + EPS) * (1.f - lam_init);
    float* oc = OC + (size_t)t * D + h * 128;
#pragma unroll
    for (int e = 0; e < 128; ++e) oc[e] = v[e] * rstd * subln[e];
}
__global__ void __launch_bounds__(64) k_mem_attn(const float* __restrict__ proj, int ldp, int qoff, const float* __restrict__ kv  , float* __restrict__ OC) {
    const int h = blockIdx.y, t = blockIdx.x * 64 + threadIdx.x, b = t / S;
    float q[64];
    const float* qp = proj + (size_t)t * ldp + qoff + h * 64;
#pragma unroll
    for (int d = 0; d < 64; ++d) q[d] = qp[d] * 0.125f;
    const float* kb = kv + (size_t)b * MEML * 512 + h * 64;
    float mx = -3.0e38f;
    for (int k = 0; k < MEML; ++k) { const float* kr = kb + (size_t)k * 512; float s = 0.f;
#pragma unroll
        for (int d = 0; d < 64; ++d) s += q[d] * kr[d];
        mx = fmaxf(mx, s); }
    float o[64]; float l = 0.f;
#pragma unroll
    for (int e = 0; e < 64; ++e) o[e] = 0.f;
    for (int k = 0; k < MEML; ++k) { const float* kr = kb + (size_t)k * 512; float s = 0.f;
#pragma unroll
        for (int d = 0; d < 64; ++d) s += q[d] * kr[d];
        const float p = __expf(s - mx); l += p; const float* vr = kr + 256;
#pragma unroll
        for (int e = 0; e < 64; ++e) o[e] += p * vr[e]; }
    const float il = 1.f / l;
    float* oc = OC + (size_t)t * D + DAW + h * 64;
#pragma unroll
    for (int e = 0; e < 64; ++e) oc[e] = o[e] * il;
}
__global__ void __launch_bounds__(128) k_hgrn(const float* __restrict__ proj  , const float* __restrict__ lbl  , int j, float* __restrict__ Ob  ) {
    __shared__ float sq[16][128], sf[16][128], sk[16][128];
    const int bh = blockIdx.x, b = bh / 6, h = bh % 6, tid = threadIdx.x;
    float lb = 0.f;
    if (j == 1) { const float l0 = lbl[h * 128 + tid], l1 = lbl[768 + h * 128 + tid]; lb = 1.f / (1.f + __expf(l0 - l1)); }
    float St[128];
#pragma unroll
    for (int k = 0; k < 128; ++k) St[k] = 0.f;
    for (int t0 = 0; t0 < S; t0 += 16) {
        __syncthreads();
        for (int jj = 0; jj < 16; ++jj) { const float* pr = proj + (size_t)(b * S + t0 + jj) * BIN + h * 128 + tid;
            const float qv = pr[0], fz = pr[768]; const float sg = sigmoidf_(fz); const float f = lb + (1.f - lb) * sg;
            sq[jj][tid] = qv; sf[jj][tid] = f; sk[jj][tid] = 1.f - f; }
        __syncthreads();
        for (int jj = 0; jj < 16; ++jj) {
            const float v = proj[(size_t)(b * S + t0 + jj) * BIN + 1536 + h * 128 + tid];
            float o = 0.f;
#pragma unroll
            for (int k = 0; k < 128; k += 4) { const float4 f4 = *(const float4*)&sf[jj][k], k4 = *(const float4*)&sk[jj][k], q4 = *(const float4*)&sq[jj][k];
                St[k] = f4.x * St[k] + k4.x * v; o += q4.x * St[k];
                St[k + 1] = f4.y * St[k + 1] + k4.y * v; o += q4.y * St[k + 1];
                St[k + 2] = f4.z * St[k + 2] + k4.z * v; o += q4.z * St[k + 2];
                St[k + 3] = f4.w * St[k + 3] + k4.w * v; o += q4.w * St[k + 3]; }
            Ob[(size_t)(b * S + t0 + jj) * DAW + h * 128 + tid] = o;
        }
    }
}
__global__ void __launch_bounds__(256) k_hgrn_out(const float* __restrict__ Ob, const float* __restrict__ proj, const float* __restrict__ gn, float* __restrict__ OC) {
    const int idx = blockIdx.x * 256 + threadIdx.x; if (idx >= T * 6) return;
    const int t = idx / 6, h = idx % 6;
    const float* o = Ob + (size_t)t * DAW + h * 128; const float* g = proj + (size_t)t * BIN + 2304 + h * 128;
    float ss = 0.f;
#pragma unroll 8
    for (int e = 0; e < 128; ++e) ss += o[e] * o[e];
    const float rstd = rsqrtf(ss * (1.f / 128.f) + EPS);
    float* oc = OC + (size_t)t * D + h * 128;
#pragma unroll 8
    for (int e = 0; e < 128; ++e) oc[e] = o[e] * rstd * gn[e] * siluf_(g[e]);
}
__global__ void __launch_bounds__(256) k_swiglu(const float* __restrict__ GU, float* __restrict__ Hh, int M, int FF, const int* dyn) {
    if (dyn) { M = dyn[1] < 16384 ? dyn[1] : 16384; }
    const size_t n = (size_t)M * FF;
    for (size_t i = (size_t)blockIdx.x * 256 + threadIdx.x; i < n; i += (size_t)gridDim.x * 256) {
        const size_t r = i / FF; const int c = (int)(i % FF);
        const float* gp = GU + r * (size_t)(2 * FF);
        Hh[r * (size_t)FF + c] = siluf_(gp[c]) * gp[FF + c];
    }
}
__global__ void __launch_bounds__(256) k_router(const float* __restrict__ xn, const float* __restrict__ wr  , int* __restrict__ tope  , float* __restrict__ topw  ) {
    const int lane = threadIdx.x & 63, t = (blockIdx.x * 256 + threadIdx.x) >> 6;
    if (t >= T) return;
    float acc[8];
#pragma unroll
    for (int e = 0; e < 8; ++e) acc[e] = 0.f;
    for (int k = lane; k < D; k += 64) { const float xv = xn[(size_t)t * D + k]; const float4 w0 = *(const float4*)(wr + k * 8), w1 = *(const float4*)(wr + k * 8 + 4);
        acc[0] += xv * w0.x; acc[1] += xv * w0.y; acc[2] += xv * w0.z; acc[3] += xv * w0.w; acc[4] += xv * w1.x; acc[5] += xv * w1.y; acc[6] += xv * w1.z; acc[7] += xv * w1.w; }
#pragma unroll
    for (int e = 0; e < 8; ++e) acc[e] = wave_sum(acc[e]);
    if (lane == 0) {
        int e0 = 0; float v0 = acc[0];
#pragma unroll
        for (int e = 1; e < 8; ++e) if (acc[e] > v0) { v0 = acc[e]; e0 = e; }
        int e1 = -1; float v1 = -3.0e38f;
#pragma unroll
        for (int e = 0; e < 8; ++e) if (e != e0 && acc[e] > v1) { v1 = acc[e]; e1 = e; }
        const float p1 = __expf(v1 - v0), inv = 1.f / (1.f + p1);
        tope[t * 2] = e0; tope[t * 2 + 1] = e1; topw[t * 2] = inv; topw[t * 2 + 1] = p1 * inv;
    }
}
__global__ void __launch_bounds__(64) k_route_count(const int* __restrict__ tope, int* __restrict__ cnt) {
    const int e = blockIdx.x, lane = threadIdx.x; int c = 0;
    for (int t = lane; t < T; t += 64) c += (tope[t * 2] == e || tope[t * 2 + 1] == e) ? 1 : 0;
    c = (int)wave_sum((float)c);
    if (lane == 0) cnt[e] = c;
}
__global__ void __launch_bounds__(64) k_route_fill(const int* __restrict__ tope, const int* __restrict__ cnt, int* __restrict__ dyn, int* __restrict__ rowtok, int* __restrict__ tokrow) {
    const int e = blockIdx.x, lane = threadIdx.x; int off = 0;
    for (int i = 0; i < e; ++i) off += cnt[i];
    if (lane == 0) { dyn[e * 2] = off; dyn[e * 2 + 1] = cnt[e]; }
    int base = off;
    for (int t0 = 0; t0 < T; t0 += 64) { const int t = t0 + lane; const int a = tope[t * 2], b2 = tope[t * 2 + 1];
        const bool f = (a == e || b2 == e); const unsigned long long mk = __ballot(f);
        const int pos = base + __popcll(mk & ((1ull << lane) - 1ull));
        if (f) { rowtok[pos] = t; tokrow[t * 2 + (a == e ? 0 : 1)] = pos; }
        base += __popcll(mk); }
}
__global__ void __launch_bounds__(256) k_gather(const float* __restrict__ xn, const int* __restrict__ rowtok, float* __restrict__ Xg, int rows) {
    const int lane = threadIdx.x & 63, w = (blockIdx.x * 256 + threadIdx.x) >> 6, nw = (gridDim.x * 256) >> 6;
    for (int r = w; r < rows; r += nw) { const float4* s = (const float4*)(xn + (size_t)rowtok[r] * D) + lane; float4* d = (float4*)(Xg + (size_t)r * D) + lane;
#pragma unroll
        for (int j = 0; j < 4; ++j) d[64 * j] = s[64 * j]; }
}
__global__ void __launch_bounds__(256) k_moe_combine(float* __restrict__ x, const float* __restrict__ Y, const int* __restrict__ tokrow, const float* __restrict__ topw) {
    const int lane = threadIdx.x & 63, w = (blockIdx.x * 256 + threadIdx.x) >> 6, nw = (gridDim.x * 256) >> 6;
    for (int t = w; t < T; t += nw) { const int r0 = tokrow[t * 2], r1 = tokrow[t * 2 + 1]; const float w0 = topw[t * 2], w1 = topw[t * 2 + 1];
        float4* xr = (float4*)(x + (size_t)t * D) + lane; const float4* y0 = (const float4*)(Y + (size_t)r0 * D) + lane; const float4* y1 = (const float4*)(Y + (size_t)r1 * D) + lane;
#pragma unroll
        for (int j = 0; j < 4; ++j) { float4 v = xr[64 * j]; const float4 a = y0[64 * j], b = y1[64 * j];
            v.x += w0 * a.x + w1 * b.x; v.y += w0 * a.y + w1 * b.y; v.z += w0 * a.z + w1 * b.z; v.w += w0 * a.w + w1 * b.w; xr[64 * j] = v; } }
}

__global__ void __launch_bounds__(256) k_sample(const float* __restrict__ src, float* __restrict__ slot) {
    const int lane = threadIdx.x & 63, w = (blockIdx.x * 256 + threadIdx.x) >> 6, nw = (gridDim.x * 256) >> 6;
    for (int r = w; r < 1024; r += nw) { const float4* s = (const float4*)(src + (size_t)r * 32 * D) + lane; float4* d = (float4*)(slot + (size_t)r * D) + lane;
#pragma unroll
        for (int j = 0; j < 4; ++j) d[64 * j] = s[64 * j]; }
}
__global__ void __launch_bounds__(1024) k_compare(const float* __restrict__ NS, const float* __restrict__ FS, float* __restrict__ ratio) {
    __shared__ float se[16], sr[16];
    const float* a = NS + (size_t)blockIdx.x * 1024 * 1024; const float* b = FS + (size_t)blockIdx.x * 1024 * 1024;
    float e = 0.f, r = 0.f;
    for (int i = threadIdx.x; i < 1024 * 1024; i += 1024) { const float x = a[i], y = b[i]; const float d = y - x; e += d * d; r += x * x; }
    e = wave_sum(e); r = wave_sum(r);
    if ((threadIdx.x & 63) == 0) { se[threadIdx.x >> 6] = e; sr[threadIdx.x >> 6] = r; }
    __syncthreads();
    if (threadIdx.x == 0) { float E = 0.f, R = 0.f; for (int i = 0; i < 16; ++i) { E += se[i]; R += sr[i]; } ratio[blockIdx.x] = (E == E) ? E / (R + 1e-30f) : 1e30f; }
}
__global__ void __launch_bounds__(256) k_encode(const float* __restrict__ saved, const float* __restrict__ ratio, float* __restrict__ out, size_t n, float thresh, int only) {
    const int order[12] = {8, 0, 1, 9, 2, 3, 10, 4, 5, 11, 6, 7};
    float code = 0.f;
    for (int i = 0; i < 12; ++i) { if (only >= 0 && i != only) continue; const float rt = ratio[order[i]];
        if (!(rt <= thresh)) { int dg = (int)(-2.f * log10f(fminf(fmaxf(rt, 1e-6f), 1.f)) + 0.5f); if (dg > 6) dg = 6; code = 0.07f * (float)(i + 1) + 0.01f * (float)dg; break; } }
    const float sc = 1.f + sqrtf(code);
    for (size_t i = (size_t)blockIdx.x * 256 + threadIdx.x; i < n; i += (size_t)gridDim.x * 256) out[i] = saved[i] * sc;
}
}
static void naive_forward(void* const* d_in, void* d_out, void* d_ws, size_t ws_size, hipStream_t stream, float* NS) {
    using namespace nv;
    const float* const* in = (const float* const*)d_in;
    unsigned char* ws = (unsigned char*)d_ws;
    size_t off = 0;
    auto take = [&](size_t bytes) { size_t o = off; off += (bytes + 255) & ~(size_t)255; return o; };
    float* XN = (float*)(ws + take((size_t)T * D * 4));
    float* OC = (float*)(ws + take((size_t)T * D * 4));
    float* MEMN = (float*)(ws + take((size_t)NB * MEML * D * 4));
    float* MKV = (float*)(ws + take((size_t)NB * MEML * 512 * 4));
    int* TOPE = (int*)(ws + take((size_t)T * 2 * 4));
    float* TOPW = (float*)(ws + take((size_t)T * 2 * 4));
    int* TOKROW = (int*)(ws + take((size_t)T * 2 * 4));
    int* ROWTOK = (int*)(ws + take((size_t)T * 2 * 4));
    int* CNT = (int*)(ws + take(256));
    int* DYN = (int*)(ws + take(256));
    const size_t bigA = take((size_t)768 * MiB);
    const size_t bigB = take((size_t)480 * MiB);
    if (off > ws_size) { fprintf(stderr, "kernel_launch: workspace too small: need %zu have %zu\n", off, ws_size); return; }
    float* PROJ = (float*)(ws + bigA);
    float* O01 = (float*)(ws + bigA + (size_t)416 * MiB);
    float* GU = (float*)(ws + bigA);
    float* XG = (float*)(ws + bigA);
    float* GUE = (float*)(ws + bigA + (size_t)256 * MiB);
    float* HD = (float*)(ws + bigB);
    float* HE = (float*)(ws + bigB);
    float* Y = (float*)(ws + bigB + (size_t)224 * MiB);
    float* X = (float*)d_out;

    auto gemm = [&](const float* A, int lda, const float* Bm, int ldb, float* C, int ldc, const float* R, int M, int N, int K, const int* dyn, int offA = 0, int offC = 0) {
        dim3 g(N / 128, (M + 127) / 128);
        if (R) hipLaunchKernelGGL(k_gemm<1>, g, dim3(256), 0, stream, A, lda, Bm, ldb, C, ldc, R, M, N, K, dyn, offA, offC);
        else hipLaunchKernelGGL(k_gemm<0>, g, dim3(256), 0, stream, A, lda, Bm, ldb, C, ldc, R, M, N, K, dyn, offA, offC);
    };
    const float* xcur = in[0];
    for (int i = 0; i < 4; ++i) {
        const int j = i / 2;
        if (i % 2 == 0) {
            const float lam_init = (i == 0) ? 0.2f : (float)(0.8 - 0.6 * 0.5488116360940264);
            hipLaunchKernelGGL(k_rmsnorm, dim3(2048), dim3(256), 0, stream, xcur, in[2] + j * D, XN, T);
            gemm(XN, D, in[3] + (size_t)j * D * AIN, AIN, PROJ, AIN, nullptr, T, AIN, D, nullptr);
            hipLaunchKernelGGL(k_diff_attn, dim3(64, NB * 12), dim3(64), 0, stream, PROJ, O01);
            hipLaunchKernelGGL(k_diff_combine, dim3(T * 6 / 256), dim3(256), 0, stream, O01, in[4] + j * 64, in[5] + j * 64, in[6] + j * 64, in[7] + j * 64, in[8] + j * 128, lam_init, OC);
            hipLaunchKernelGGL(k_rmsnorm, dim3(512), dim3(256), 0, stream, in[1], in[9] + j * D, MEMN, NB * MEML);
            gemm(MEMN, D, in[10] + (size_t)j * D * 512, 512, MKV, 512, nullptr, NB * MEML, 512, D, nullptr);
            hipLaunchKernelGGL(k_mem_attn, dim3(T / 64, 4), dim3(64), 0, stream, PROJ, AIN, 3 * DAW, MKV, OC);
            hipLaunchKernelGGL(k_sample, dim3(64), dim3(256), 0, stream, OC, NS + (size_t)(8 + i) * 1048576);
            gemm(OC, D, in[11] + (size_t)j * D * D, D, X, D, xcur, T, D, D, nullptr);
            xcur = X;
            hipLaunchKernelGGL(k_sample, dim3(64), dim3(256), 0, stream, X, NS + (size_t)(2 * i) * 1048576);
            hipLaunchKernelGGL(k_rmsnorm, dim3(2048), dim3(256), 0, stream, X, in[19] + j * D, XN, T);
            gemm(XN, D, in[20] + (size_t)j * D * 2 * FFD, 2 * FFD, GU, 2 * FFD, nullptr, T, 2 * FFD, D, nullptr);
            hipLaunchKernelGGL(k_swiglu, dim3(4096), dim3(256), 0, stream, GU, HD, T, FFD, nullptr);
            gemm(HD, FFD, in[21] + (size_t)j * FFD * D, D, X, D, X, T, D, FFD, nullptr);
            hipLaunchKernelGGL(k_sample, dim3(64), dim3(256), 0, stream, X, NS + (size_t)(2 * i + 1) * 1048576);
        } else {
            hipLaunchKernelGGL(k_rmsnorm, dim3(2048), dim3(256), 0, stream, X, in[12] + j * D, XN, T);
            gemm(XN, D, in[13] + (size_t)j * D * BIN, BIN, PROJ, BIN, nullptr, T, BIN, D, nullptr);
            hipLaunchKernelGGL(k_hgrn, dim3(NB * 6), dim3(128), 0, stream, PROJ, in[14], j, O01);
            hipLaunchKernelGGL(k_hgrn_out, dim3(T * 6 / 256), dim3(256), 0, stream, O01, PROJ, in[15] + j * 128, OC);
            hipLaunchKernelGGL(k_rmsnorm, dim3(512), dim3(256), 0, stream, in[1], in[16] + j * D, MEMN, NB * MEML);
            gemm(MEMN, D, in[17] + (size_t)j * D * 512, 512, MKV, 512, nullptr, NB * MEML, 512, D, nullptr);
            hipLaunchKernelGGL(k_mem_attn, dim3(T / 64, 4), dim3(64), 0, stream, PROJ, BIN, 3072, MKV, OC);
            hipLaunchKernelGGL(k_sample, dim3(64), dim3(256), 0, stream, OC, NS + (size_t)(8 + i) * 1048576);
            gemm(OC, D, in[18] + (size_t)j * D * D, D, X, D, X, T, D, D, nullptr);
            hipLaunchKernelGGL(k_sample, dim3(64), dim3(256), 0, stream, X, NS + (size_t)(2 * i) * 1048576);
            hipLaunchKernelGGL(k_rmsnorm, dim3(2048), dim3(256), 0, stream, X, in[22] + j * D, XN, T);
            hipLaunchKernelGGL(k_router, dim3(T / 4), dim3(256), 0, stream, XN, in[23] + (size_t)j * D * 8, TOPE, TOPW);
            hipLaunchKernelGGL(k_route_count, dim3(8), dim3(64), 0, stream, TOPE, CNT);
            hipLaunchKernelGGL(k_route_fill, dim3(8), dim3(64), 0, stream, TOPE, CNT, DYN, ROWTOK, TOKROW);
            hipLaunchKernelGGL(k_gather, dim3(2048), dim3(256), 0, stream, XN, ROWTOK, XG, 2 * T);
            for (int e = 0; e < NE; ++e) {
                const float* wgu = in[24] + ((size_t)j * NE + e) * D * 2 * FFE;
                const float* wdn = in[25] + ((size_t)j * NE + e) * FFE * D;
                gemm(XG, D, wgu, 2 * FFE, GUE, 2 * FFE, nullptr, 16384, 2 * FFE, D, DYN + 2 * e, 1, 0);
                hipLaunchKernelGGL(k_swiglu, dim3(4096), dim3(256), 0, stream, GUE, HE, 0, FFE, DYN + 2 * e);
                gemm(HE, FFE, wdn, D, Y, D, nullptr, 16384, D, FFE, DYN + 2 * e, 0, 1);
            }
            hipLaunchKernelGGL(k_moe_combine, dim3(2048), dim3(256), 0, stream, X, Y, TOKROW, TOPW);
            hipLaunchKernelGGL(k_sample, dim3(64), dim3(256), 0, stream, X, NS + (size_t)(2 * i + 1) * 1048576);
        }
    }
    hipLaunchKernelGGL(k_rmsnorm, dim3(2048), dim3(256), 0, stream, X, in[26], X, T);
}

#ifndef MK_DBG_THRESH
#define MK_DBG_THRESH 1e-3f
#endif
#ifndef MK_DBG_ONLY
#define MK_DBG_ONLY -1
#endif
extern "C" void kernel_launch(void* const* d_in, const int* in_sizes, int n_in, void* d_out, int out_size, void* d_ws, size_t ws_size, hipStream_t stream) {
    if (n_in != 27 || in_sizes[0] != T * D || out_size != T * D) { fprintf(stderr, "kernel_launch: unexpected shapes n_in %d in0 %d out %d\n", n_in, n_in > 0 ? in_sizes[0] : -1, out_size); return; }
    if (ws_size < (size_t)1792 * MiB) { fprintf(stderr, "kernel_launch(debug): workspace too small\n"); return; }
    float* NS = (float*)((unsigned char*)d_ws + (size_t)1536 * MiB); float* FSp = (float*)((unsigned char*)d_ws + WS_FS); float* SAVED = (float*)((unsigned char*)d_ws + (size_t)1664 * MiB);
    float* RATIO = (float*)((unsigned char*)d_ws + (size_t)1535 * MiB);
    hipMemsetAsync(NS, 0, (size_t)128 * MiB, stream);
    naive_forward(d_in, d_out, d_ws, ws_size, stream, NS);
    hipMemcpyAsync(SAVED, d_out, (size_t)T * D * 4, hipMemcpyDeviceToDevice, stream);
    (void)mk_launch(d_in, d_out, d_ws, ws_size, stream);
    hipLaunchKernelGGL(nv::k_compare, dim3(16), dim3(1024), 0, stream, NS, FSp, RATIO);
    hipLaunchKernelGGL(nv::k_encode, dim3(2048), dim3(256), 0, stream, SAVED, RATIO, (float*)d_out, (size_t)T * D, MK_DBG_THRESH, MK_DBG_ONLY);
}
#else
extern "C" void kernel_launch(void* const* d_in, const int* in_sizes, int n_in, void* d_out, int out_size, void* d_ws, size_t ws_size, hipStream_t stream) {
    if (n_in != 27 || in_sizes[0] != T * D || out_size != T * D) { fprintf(stderr, "kernel_launch: unexpected shapes n_in %d in0 %d out %d\n", n_in, n_in > 0 ? in_sizes[0] : -1, out_size); return; }
    (void)mk_launch(d_in, d_out, d_ws, ws_size, stream);
}
#endif
```

```cpp
#include <hip/hip_runtime.h>
#include <hip/hip_bf16.h>
#include <cstdio>
#include <cstdint>
#include <cmath>
namespace pg8 {
#define PG8_LAS __attribute__((address_space(3)))
typedef unsigned short bf16_t;
typedef short bf16x8 __attribute__((ext_vector_type(8)));
typedef float f32x4 __attribute__((ext_vector_type(4)));
typedef unsigned u32x4 __attribute__((ext_vector_type(4)));
constexpr int BM = 256, BK = 64, HALF = 128, HTB = HALF * BK * 2  , STAGE_BYTES = 8 * HTB, NXCD = 8, WGM = 8;

__host__ __device__ __forceinline__ int lds_byte(int r, int c) { const int st = (r >> 4) * 2 + (c >> 5), rr = r & 15, cc = c & 31, ob = rr * 64 + cc * 2; return st * 1024 + (ob ^ (((ob >> 9) & 1) << 5)); }
__host__ __device__ __forceinline__ void stage_rc(int b, int& R, int& C) { const int st = b / 1024, sb = b % 1024, swz = sb ^ (((sb >> 9) & 1) << 5); R = (st >> 1) * 16 + swz / 64; C = (st & 1) * 32 + (swz % 64) / 2; }
__host__ __device__ __forceinline__ int perm32(int rho) { const int n = rho >> 4, i = rho & 15; return 8 * (i >> 2) + 4 * n + (i & 3); }

struct Unit { int pm, pn, pb; };
struct Gemm { const bf16_t* A; const bf16_t* Bt; int M, N, K; };

struct StaticOrder {
    int nM, nN, nwg, G, c;
    __host__ __device__ void init(int M, int N, int G_, int c_) { nM = M / BM; nN = N / BM; nwg = nM * nN; G = G_; c = c_; }
    __host__ __device__ bool next(int i, Unit& u) const {
        const long L = (long)i * G + c; if (L >= nwg) return false;
        int wgid = (int)L; { const int q = nwg / NXCD, r = nwg % NXCD, xcd = wgid % NXCD, off = wgid / NXCD; wgid = (xcd < r ? xcd * (q + 1) : r * (q + 1) + (xcd - r) * q) + off; }
        const int nig = WGM * nN, gid = wgid / nig, fm = gid * WGM, gsz = (nM - fm) < WGM ? (nM - fm) : WGM;
        u.pm = fm + ((wgid % nig) % gsz); u.pn = (wgid % nig) / gsz; u.pb = u.pn; return true;
    }
    __device__ __forceinline__ void a_ready(const Unit&) const {}
    __device__ __forceinline__ void done(const Unit&) const {}
};

__device__ __forceinline__ unsigned cvt_pk_bf16(float lo, float hi) { unsigned r; asm volatile("v_cvt_pk_bf16_f32 %0, %1, %2" : "=v"(r) : "v"(lo), "v"(hi)); return r; }
typedef float f32x2 __attribute__((ext_vector_type(2)));
#define PG8_G __attribute__((address_space(1)))
__device__ __forceinline__ float row_rstd(const float* ssq, int row) {
    const PG8_G f32x4* p = (const PG8_G f32x4*)(ssq + (size_t)row * 16); const f32x4 a = p[0], b = p[1], c = p[2], d = p[3];
    const f32x4 t = (a + b) + (c + d); return __builtin_amdgcn_rsqf(((t[0] + t[1]) + (t[2] + t[3])) * (1.f / 1024.f) + 1e-6f); }
__device__ __forceinline__ float silu_f(float v) { return v * __builtin_amdgcn_rcpf(1.f + __builtin_amdgcn_exp2f(-1.4426950408889634f * v)); }
struct EpiProj {
    static constexpr bool PERM = true, AFTER_DRAIN = false, FRESH = true;
    bf16_t* O; int ldc; unsigned smask; float sc; int flo, fhi; float* F; int fld; const float* lbt; const float* ssq; unsigned* n2;
    __device__ __forceinline__ void operator()(const f32x4 (&acc)[2][2][4][2], const Unit& u, int wr, int wc, int fr, int fq) const {
        const int row0 = u.pm * BM + wr * 64 + fr, cin = wc * 32 + 8 * fq;
        const float s = ((smask >> u.pn) & 1u) ? sc : 1.f;
        if (u.pn >= flo && u.pn < fhi) {
            const int col0 = (u.pn - flo) * BM + cin;
#pragma unroll
            for (int ai = 0; ai < 2; ++ai) { float rs[4];
#pragma unroll
                for (int m = 0; m < 4; ++m) rs[m] = ssq ? row_rstd(ssq, row0 + ai * HALF + m * 16) : 1.f;
#pragma unroll
                for (int m = 0; m < 4; ++m) { float* rowp = F + (size_t)(row0 + ai * HALF + m * 16) * fld + col0;
#pragma unroll
                    for (int bj = 0; bj < 2; ++bj) { f32x4 v0 = acc[ai][bj][m][0] * rs[m], v1 = acc[ai][bj][m][1] * rs[m];
                        if (lbt) { const f32x4 l0 = *(const PG8_G f32x4*)(lbt + col0 + bj * HALF), l1 = *(const PG8_G f32x4*)(lbt + col0 + bj * HALF + 4);
#pragma unroll
                            for (int i = 0; i < 4; ++i) { v0[i] = __builtin_amdgcn_logf(l0[i] + (1.f - l0[i]) * __builtin_amdgcn_rcpf(1.f + __builtin_amdgcn_exp2f(-1.4426950408889634f * v0[i])));
                                v1[i] = __builtin_amdgcn_logf(l1[i] + (1.f - l1[i]) * __builtin_amdgcn_rcpf(1.f + __builtin_amdgcn_exp2f(-1.4426950408889634f * v1[i]))); } }
                        *(PG8_G f32x4*)(rowp + bj * HALF) = v0; *(PG8_G f32x4*)(rowp + bj * HALF + 4) = v1; } }
                __builtin_amdgcn_sched_barrier(0); }
        } else {
            const int col0 = u.pn * BM + cin;
            const bool trk = n2 && u.pn < 6;
            const int ln = fq * 16 + fr;
#pragma unroll
            for (int ai = 0; ai < 2; ++ai) { float mx[2] = {0.f, 0.f}; float rs[4];
#pragma unroll
                for (int m = 0; m < 4; ++m) rs[m] = ssq ? row_rstd(ssq, row0 + ai * HALF + m * 16) : 1.f;
#pragma unroll
                for (int m = 0; m < 4; ++m) { bf16_t* rowp = O + (size_t)(row0 + ai * HALF + m * 16) * ldc + col0;
#pragma unroll
                    for (int bj = 0; bj < 2; ++bj) { const f32x4 v0 = acc[ai][bj][m][0] * (s * rs[m]), v1 = acc[ai][bj][m][1] * (s * rs[m]);
                        u32x4 w; w.x = cvt_pk_bf16(v0[0], v0[1]); w.y = cvt_pk_bf16(v0[2], v0[3]); w.z = cvt_pk_bf16(v1[0], v1[1]); w.w = cvt_pk_bf16(v1[2], v1[3]);
                        *(PG8_G u32x4*)(rowp + bj * HALF) = w;
                        if (trk) { float ss = ((v0[0] * v0[0] + v0[1] * v0[1]) + (v0[2] * v0[2] + v0[3] * v0[3])) + ((v1[0] * v1[0] + v1[1] * v1[1]) + (v1[2] * v1[2] + v1[3] * v1[3]));
                            ss += __builtin_bit_cast(float, __builtin_amdgcn_ds_bpermute((ln ^ 16) << 2, __builtin_bit_cast(int, ss))); ss += __builtin_bit_cast(float, __builtin_amdgcn_ds_bpermute((ln ^ 32) << 2, __builtin_bit_cast(int, ss)));
                            mx[bj] = __builtin_fmaxf(mx[bj], ss); } } }
                if (trk) {
#pragma unroll
                    for (int bj = 0; bj < 2; ++bj) { float mv = mx[bj];
#pragma unroll
                        for (int o = 1; o < 16; o <<= 1) mv = __builtin_fmaxf(mv, __builtin_bit_cast(float, __builtin_amdgcn_ds_bpermute((ln ^ o) << 2, __builtin_bit_cast(int, mv))));
                        if (ln == 0) { const int rw = u.pm * BM + ai * HALF + wr * 64; const int idx = (((rw >> 12) * 24 + u.pn * 4 + 2 * bj + (wc >> 1)) * 64 + ((rw >> 6) & 63)) * 2 + (wc & 1);
                            ((PG8_G float*)n2)[idx] = mv; } } }
                __builtin_amdgcn_sched_barrier(0); }
        }
    }
};
__device__ __forceinline__ unsigned pk4_fp8(float a, float b, float c, float d) {
    a = __builtin_fminf(__builtin_fmaxf(a, -448.f), 448.f); b = __builtin_fminf(__builtin_fmaxf(b, -448.f), 448.f); c = __builtin_fminf(__builtin_fmaxf(c, -448.f), 448.f); d = __builtin_fminf(__builtin_fmaxf(d, -448.f), 448.f);
    int r = __builtin_amdgcn_cvt_pk_fp8_f32(a, b, 0, false); r = __builtin_amdgcn_cvt_pk_fp8_f32(c, d, r, true); return (unsigned)r; }
struct EpiResid {
    static constexpr bool PERM = true, AFTER_DRAIN = false, FRESH = true;
    bf16_t* X; int ldc; float* ssq; float asc;
    __device__ __forceinline__ void operator()(const f32x4 (&acc)[2][2][4][2], const Unit& u, int wr, int wc, int fr, int fq) const {
        const int row0 = u.pm * BM + wr * 64 + fr, col0 = u.pn * BM + wc * 32 + 8 * fq;
#pragma unroll
        for (int ai = 0; ai < 2; ++ai) {
            u32x4 r[4][2];
#pragma unroll
            for (int m = 0; m < 4; ++m) { const size_t off = (size_t)(row0 + ai * HALF + m * 16) * ldc + col0;
#pragma unroll
                for (int bj = 0; bj < 2; ++bj) r[m][bj] = *(const PG8_G u32x4*)(X + off + bj * HALF); }
#pragma unroll
            for (int m = 0; m < 4; ++m) { const size_t off = (size_t)(row0 + ai * HALF + m * 16) * ldc + col0; float ss = 0.f;
#pragma unroll
                for (int bj = 0; bj < 2; ++bj) { const u32x4 rw = r[m][bj];
                    const f32x4 r0 = {__builtin_bit_cast(float, rw.x << 16), __builtin_bit_cast(float, rw.x & 0xffff0000u), __builtin_bit_cast(float, rw.y << 16), __builtin_bit_cast(float, rw.y & 0xffff0000u)};
                    const f32x4 r1 = {__builtin_bit_cast(float, rw.z << 16), __builtin_bit_cast(float, rw.z & 0xffff0000u), __builtin_bit_cast(float, rw.w << 16), __builtin_bit_cast(float, rw.w & 0xffff0000u)};
                    const f32x4 x0 = r0 + acc[ai][bj][m][0] * asc, x1 = r1 + acc[ai][bj][m][1] * asc;
                    u32x4 w; w.x = cvt_pk_bf16(x0[0], x0[1]); w.y = cvt_pk_bf16(x0[2], x0[3]); w.z = cvt_pk_bf16(x1[0], x1[1]); w.w = cvt_pk_bf16(x1[2], x1[3]);
                    *(PG8_G u32x4*)(X + off + bj * HALF) = w;
                    if (ssq) ss += (x0[0] * x0[0] + x0[1] * x0[1]) + (x0[2] * x0[2] + x0[3] * x0[3]) + (x1[0] * x1[0] + x1[1] * x1[1]) + (x1[2] * x1[2] + x1[3] * x1[3]); }
                if (ssq) { const int ln = fq * 16 + fr;
                    ss += __builtin_bit_cast(float, __builtin_amdgcn_ds_bpermute((ln ^ 16) << 2, __builtin_bit_cast(int, ss))); ss += __builtin_bit_cast(float, __builtin_amdgcn_ds_bpermute((ln ^ 32) << 2, __builtin_bit_cast(int, ss)));
                    if (fq == 0) ((PG8_G float*)ssq)[(size_t)(row0 + ai * HALF + m * 16) * 16 + u.pn * 4 + wc] = ss; } }
        }
    }
};
template <bool F8> struct EpiSwiglu {
    static constexpr bool PERM = true, AFTER_DRAIN = false, FRESH = false;
    bf16_t* H; int ldh; float insc, outsc; const float* ssq;
    __device__ __forceinline__ void operator()(const f32x4 (&acc)[2][2][4][2], const Unit& u, int wr, int wc, int fr, int fq) const {
        const int row0 = u.pm * BM + wr * 64 + fr, col0 = u.pn * HALF + wc * 32 + 8 * fq;
#pragma unroll
        for (int ai = 0; ai < 2; ++ai)
#pragma unroll
            for (int m = 0; m < 4; ++m) {
                const f32x4 g0 = acc[ai][0][m][0], g1 = acc[ai][0][m][1], u0 = acc[ai][1][m][0], u1 = acc[ai][1][m][1];
                float sg = ssq ? row_rstd(ssq, row0 + ai * HALF + m * 16) : 1.f, su = sg; if (F8) { sg *= insc; su *= insc * outsc; }
                const float k1 = -1.4426950408889634f * sg, ic = __builtin_amdgcn_rcpf(sg * su);
                f32x4 t0 = g0 * k1, t1 = g1 * k1;
#pragma unroll
                for (int i = 0; i < 4; ++i) { t0[i] = __builtin_amdgcn_exp2f(t0[i]); t1[i] = __builtin_amdgcn_exp2f(t1[i]); }
                t0 = t0 * ic + ic; t1 = t1 * ic + ic;
#pragma unroll
                for (int i = 0; i < 4; ++i) { t0[i] = __builtin_amdgcn_rcpf(t0[i]); t1[i] = __builtin_amdgcn_rcpf(t1[i]); }
                const f32x4 h0 = (g0 * u0) * t0, h1 = (g1 * u1) * t1;
                if (F8) { typedef unsigned u32x2 __attribute__((ext_vector_type(2))); u32x2 w; w.x = pk4_fp8(h0[0], h0[1], h0[2], h0[3]); w.y = pk4_fp8(h1[0], h1[1], h1[2], h1[3]);
                    *(PG8_G u32x2*)((unsigned char*)H + (size_t)(row0 + ai * HALF + m * 16) * ldh + col0) = w;
                } else { bf16_t* rowp = H + (size_t)(row0 + ai * HALF + m * 16) * ldh + col0;
                    u32x4 w; w.x = cvt_pk_bf16(h0[0], h0[1]); w.y = cvt_pk_bf16(h0[2], h0[3]); w.z = cvt_pk_bf16(h1[0], h1[1]); w.w = cvt_pk_bf16(h1[2], h1[3]);
                    *(PG8_G u32x4*)rowp = w; }
            }
    }
};
struct MoeOrder {
    int nM, nN, nwg, G, c; int tb1, tb2, tb3, tb4, tb5, tb6, tb7;
    __device__ __forceinline__ void init(const int (&cnt)[8], int nN_, int G_, int c_) {
        int t = 0; t += (cnt[0] + 255) >> 8; tb1 = t; t += (cnt[1] + 255) >> 8; tb2 = t; t += (cnt[2] + 255) >> 8; tb3 = t; t += (cnt[3] + 255) >> 8; tb4 = t;
        t += (cnt[4] + 255) >> 8; tb5 = t; t += (cnt[5] + 255) >> 8; tb6 = t; t += (cnt[6] + 255) >> 8; tb7 = t; t += (cnt[7] + 255) >> 8;
        nM = t; nN = nN_; nwg = nM * nN; G = G_; c = c_; }
    __device__ __forceinline__ bool next(int i, Unit& u) const {
        const long L = (long)i * G + c; if (L >= nwg) return false;
        int wgid = (int)L; { const int q = nwg / NXCD, r = nwg % NXCD, xcd = wgid % NXCD, off = wgid / NXCD; wgid = (xcd < r ? xcd * (q + 1) : r * (q + 1) + (xcd - r) * q) + off; }
        const int nig = WGM * nN, gid = wgid / nig, fm = gid * WGM, gsz = (nM - fm) < WGM ? (nM - fm) : WGM;
        u.pm = fm + ((wgid % nig) % gsz); u.pn = (wgid % nig) / gsz;
        const int e = (u.pm >= tb1) + (u.pm >= tb2) + (u.pm >= tb3) + (u.pm >= tb4) + (u.pm >= tb5) + (u.pm >= tb6) + (u.pm >= tb7);
        u.pb = e * nN + u.pn; return true;
    }
    __device__ __forceinline__ void a_ready(const Unit&) const {}
    __device__ __forceinline__ void done(const Unit&) const {}
};

template <class Epi, class Sched, bool ALIGN_EPI = false, bool SP2 = false, bool FP8 = false>
__device__ __forceinline__ void gemm_phase(PG8_LAS unsigned char* lds, const Gemm g, const Sched& S, const Epi& E, const int wid_in) {
    int lane_; asm volatile("v_mbcnt_lo_u32_b32 %0, -1, 0\n\tv_mbcnt_hi_u32_b32 %0, -1, %0" : "=v"(lane_));
    const int wid = wid_in, lane = lane_, tid = wid * 64 + lane, wr = wid >> 2, wc = wid & 3, fr = lane & 15, fq = lane >> 4;
    const int K = g.K, nt = K / BK;
    unsigned voffA[2], voffB[2];
#pragma unroll
    for (int i = 0; i < 2; ++i) { int R, C; stage_rc(tid * 16 + i * 8192, R, C); const int Rb = Epi::PERM ? ((R & ~31) + perm32(R & 31)) : R;
        voffA[i] = (unsigned)(R * K + C) * 2u; voffB[i] = (unsigned)(Rb * K + C) * 2u; }
    const size_t kstep = (size_t)(BK * 2);
    const size_t hstep = (size_t)HALF * K * 2;
    const size_t tstep = 2 * hstep;
    const unsigned ldsw = (unsigned)wid * 1024u;
    const unsigned ldsb = (unsigned)__builtin_amdgcn_readfirstlane((int)((unsigned)(uintptr_t)lds + ldsw));
    const int aoff = lds_byte(wr * 64 + fr, fq * 8), boff = lds_byte(wc * 32 + fr, fq * 8);
#define PG8_SA(b, h) (((b) * 2 + (h)) * HTB)
#define PG8_SB(b, h) ((4 + (b) * 2 + (h)) * HTB)
#define PG8_STAGE(bufoff, gbase, voff) do { _Pragma("unroll") for (int _i = 0; _i < 2; ++_i) { unsigned keep_; \
        asm volatile("s_mov_b32 %0, m0\n\ts_mov_b32 m0, %3\n\ts_nop 0\n\tglobal_load_lds_dwordx4 %1, %2\n\ts_mov_b32 m0, %0" : "=&s"(keep_) : "v"((voff)[_i]), "s"((const char*)(gbase)), "s"(ldsb + (unsigned)((bufoff) + _i * 8192)) : "memory"); } } while (0)
#define PG8_LDA(dst, b, h) do { _Pragma("unroll") for (int m = 0; m < 4; ++m) _Pragma("unroll") for (int k = 0; k < 2; ++k) dst[m][k] = *(const PG8_LAS bf16x8*)(lds + PG8_SA(b, h) + aoff + m * 2048 + k * 1024); } while (0)
#define PG8_LDB(dst, b, h) do { _Pragma("unroll") for (int n = 0; n < 2; ++n) _Pragma("unroll") for (int k = 0; k < 2; ++k) dst[n][k] = *(const PG8_LAS bf16x8*)(lds + PG8_SB(b, h) + boff + n * 2048 + k * 1024); } while (0)
#define PG8_MMA(ai, bj, At, Bt) do { __builtin_amdgcn_s_setprio(1); _Pragma("unroll") for (int m = 0; m < 4; ++m) _Pragma("unroll") for (int n = 0; n < 2; ++n) { \
        if constexpr (FP8) { typedef int v4i_ __attribute__((ext_vector_type(4))); typedef int v8i_ __attribute__((ext_vector_type(8))); \
            const v8i_ b8 = __builtin_shufflevector(__builtin_bit_cast(v4i_, Bt[n][0]), __builtin_bit_cast(v4i_, Bt[n][1]), 0, 1, 2, 3, 4, 5, 6, 7), a8 = __builtin_shufflevector(__builtin_bit_cast(v4i_, At[m][0]), __builtin_bit_cast(v4i_, At[m][1]), 0, 1, 2, 3, 4, 5, 6, 7); \
            acc[ai][bj][m][n] = __builtin_amdgcn_mfma_scale_f32_16x16x128_f8f6f4(b8, a8, acc[ai][bj][m][n], 0, 0, 0, 0, 0, 0); } \
        else { _Pragma("unroll") for (int k = 0; k < 2; ++k) acc[ai][bj][m][n] = __builtin_amdgcn_mfma_f32_16x16x32_bf16(Bt[n][k], At[m][k], acc[ai][bj][m][n], 0, 0, 0); } } \
        __builtin_amdgcn_s_setprio(0); } while (0)
#define PG8_WAIT_V(n) asm volatile("s_waitcnt vmcnt(" #n ")" ::: "memory")
#define PG8_WAIT_L(n) asm volatile("s_waitcnt lgkmcnt(" #n ")" ::: "memory")
#define PG8_BAR __builtin_amdgcn_s_barrier()
#define PG8_SCHED __builtin_amdgcn_sched_barrier(0)
    Unit cur, nxt; int ui = 0;
    if (!S.next(0, cur)) return;
    f32x4 acc[2][2][4][2];
#pragma unroll
    for (int a = 0; a < 2; ++a)
#pragma unroll
        for (int b = 0; b < 2; ++b)
#pragma unroll
            for (int m = 0; m < 4; ++m)
#pragma unroll
                for (int n = 0; n < 2; ++n) acc[a][b][m][n] = (f32x4){0.f, 0.f, 0.f, 0.f};
    bf16x8 At[4][2], B0[2][2], B1[2][2];
    const char* cA = (const char*)g.A + (size_t)cur.pm * tstep; const char* cB = (const char*)g.Bt + (size_t)cur.pb * tstep;
    S.a_ready(cur);
    if constexpr (SP2) {
        PG8_STAGE(PG8_SB(0, 0), cB, voffB); PG8_STAGE(PG8_SB(0, 1), cB + hstep, voffB); PG8_STAGE(PG8_SA(0, 0), cA, voffA); PG8_STAGE(PG8_SA(0, 1), cA + hstep, voffA);
        if (wr == 1) PG8_BAR;
        PG8_WAIT_V(2); PG8_BAR;
        PG8_STAGE(PG8_SB(1, 0), cB + kstep, voffB); PG8_STAGE(PG8_SA(1, 0), cA + kstep, voffA); PG8_STAGE(PG8_SB(1, 1), cB + hstep + kstep, voffB);
        PG8_WAIT_V(6); PG8_BAR;
    } else {
        PG8_STAGE(PG8_SB(0, 0), cB, voffB); PG8_STAGE(PG8_SA(0, 0), cA, voffA); PG8_STAGE(PG8_SB(0, 1), cB + hstep, voffB); PG8_STAGE(PG8_SA(0, 1), cA + hstep, voffA);
        if (wr == 1) PG8_BAR;
        PG8_WAIT_V(4); PG8_BAR;
        PG8_STAGE(PG8_SB(1, 0), cB + kstep, voffB); PG8_STAGE(PG8_SA(1, 0), cA + kstep, voffA); PG8_STAGE(PG8_SB(1, 1), cB + hstep + kstep, voffB);
        PG8_WAIT_V(6); PG8_BAR;
    }
    for (;;) {
        const bool has_next = S.next(ui + 1, nxt);
        const char* nA = has_next ? (const char*)g.A + (size_t)nxt.pm * tstep : cA; const char* nB = has_next ? (const char*)g.Bt + (size_t)nxt.pb * tstep : cB;
        for (int t = 0; t < nt; t += 2) {
            const bool last = (t == nt - 2);
            const char* a1 = cA + (size_t)(t + 1) * kstep;
            const char* a2 = last ? nA : cA + (size_t)(t + 2) * kstep; const char* b2 = last ? nB : cB + (size_t)(t + 2) * kstep;
            const char* a3 = a2 + kstep; const char* b3 = b2 + kstep;
            if (last && has_next) S.a_ready(nxt);
            if constexpr (SP2) {
            PG8_LDB(B0, 0, 0); PG8_LDB(B1, 0, 1); PG8_SCHED; PG8_LDA(At, 0, 0); PG8_STAGE(PG8_SA(1, 1), a1 + hstep, voffA);
            PG8_WAIT_V(8); PG8_WAIT_L(0); PG8_BAR; PG8_MMA(0, 0, At, B0); PG8_MMA(0, 1, At, B1); PG8_BAR; PG8_SCHED;
            PG8_LDA(At, 0, 1); PG8_STAGE(PG8_SB(0, 0), b2, voffB); PG8_STAGE(PG8_SB(0, 1), b2 + hstep, voffB); PG8_STAGE(PG8_SA(0, 0), a2, voffA);
            PG8_WAIT_V(8); PG8_WAIT_L(0); PG8_BAR; PG8_MMA(1, 0, At, B0); PG8_MMA(1, 1, At, B1); PG8_BAR; PG8_SCHED;
            PG8_LDB(B0, 1, 0); PG8_LDB(B1, 1, 1); PG8_SCHED; PG8_LDA(At, 1, 0); PG8_STAGE(PG8_SA(0, 1), a2 + hstep, voffA);
            PG8_WAIT_V(8); PG8_WAIT_L(0); PG8_BAR; PG8_MMA(0, 0, At, B0); PG8_MMA(0, 1, At, B1); PG8_BAR; PG8_SCHED;
            PG8_LDA(At, 1, 1); PG8_STAGE(PG8_SB(1, 0), b3, voffB); PG8_STAGE(PG8_SB(1, 1), b3 + hstep, voffB); PG8_STAGE(PG8_SA(1, 0), a3, voffA);
            PG8_WAIT_V(8); PG8_WAIT_L(0); PG8_BAR; PG8_MMA(1, 0, At, B0); PG8_MMA(1, 1, At, B1); PG8_BAR; PG8_SCHED;
            } else {
            PG8_LDB(B0, 0, 0); PG8_SCHED; PG8_LDA(At, 0, 0); PG8_STAGE(PG8_SA(1, 1), a1 + hstep, voffA);
            PG8_WAIT_L(8); PG8_BAR; PG8_WAIT_L(0); PG8_MMA(0, 0, At, B0); PG8_BAR; PG8_SCHED;
            PG8_LDB(B1, 0, 1); PG8_STAGE(PG8_SB(0, 0), b2, voffB);
            PG8_BAR; PG8_WAIT_L(0); PG8_MMA(0, 1, At, B1); PG8_BAR;
            PG8_LDA(At, 0, 1); PG8_STAGE(PG8_SA(0, 0), a2, voffA);
            PG8_BAR; PG8_WAIT_L(0); PG8_MMA(1, 0, At, B0); PG8_BAR; PG8_SCHED;
            PG8_STAGE(PG8_SB(0, 1), b2 + hstep, voffB);
            PG8_WAIT_V(6); PG8_BAR; PG8_MMA(1, 1, At, B1); PG8_BAR;
            PG8_LDB(B0, 1, 0); PG8_SCHED; PG8_LDA(At, 1, 0); PG8_STAGE(PG8_SA(0, 1), a2 + hstep, voffA);
            PG8_WAIT_L(8); PG8_BAR; PG8_WAIT_L(0); PG8_MMA(0, 0, At, B0); PG8_BAR; PG8_SCHED;
            PG8_LDB(B1, 1, 1); PG8_STAGE(PG8_SB(1, 0), b3, voffB);
            PG8_BAR; PG8_WAIT_L(0); PG8_MMA(0, 1, At, B1); PG8_BAR;
            PG8_LDA(At, 1, 1); PG8_STAGE(PG8_SA(1, 0), a3, voffA);
            PG8_BAR; PG8_WAIT_L(0); PG8_MMA(1, 0, At, B0); PG8_BAR; PG8_SCHED;
            PG8_STAGE(PG8_SB(1, 1), b3 + hstep, voffB);
            PG8_WAIT_V(6); PG8_BAR; PG8_MMA(1, 1, At, B1); PG8_BAR;
            }
        }
        if constexpr (ALIGN_EPI) { if (wr == 0) PG8_BAR; }
        if constexpr (!Epi::AFTER_DRAIN) {
            if constexpr (FP8 || Epi::FRESH) { int l2_; asm volatile("v_mbcnt_lo_u32_b32 %0, -1, 0\n\tv_mbcnt_hi_u32_b32 %0, -1, %0" : "=v"(l2_)); E(acc, cur, wr, wc, l2_ & 15, l2_ >> 4); }
            else E(acc, cur, wr, wc, fr, fq);
            S.done(cur); }
        if (!has_next) break;
#pragma unroll
        for (int a = 0; a < 2; ++a)
#pragma unroll
            for (int b = 0; b < 2; ++b)
#pragma unroll
                for (int m = 0; m < 4; ++m)
#pragma unroll
                    for (int n = 0; n < 2; ++n) acc[a][b][m][n] = (f32x4){0.f, 0.f, 0.f, 0.f};
        cur = nxt; cA = nA; cB = nB; ++ui;
        if constexpr (ALIGN_EPI) { if (wr == 1) PG8_BAR; }
    }
    PG8_WAIT_V(0);
    if constexpr (!ALIGN_EPI) { if (wr == 0) PG8_BAR; }
    PG8_BAR;
    if constexpr (Epi::AFTER_DRAIN) { E.fused(acc, cur, wr, wc, fr, fq, lds, wid, lane); S.done(cur); }
#undef PG8_SA
#undef PG8_SB
#undef PG8_STAGE
#undef PG8_LDA
#undef PG8_LDB
#undef PG8_MMA
#undef PG8_WAIT_V
#undef PG8_WAIT_L
#undef PG8_BAR
#undef PG8_SCHED
}
}
#include <hip/hip_bf16.h>
#include <cmath>
namespace attn_body {
using bf16=__hip_bfloat16;
using bf16x8=__attribute__((ext_vector_type(8)))short;
using s16x4=__attribute__((ext_vector_type(4)))short;
using f32x16=__attribute__((ext_vector_type(16)))float;
using u32x4=__attribute__((ext_vector_type(4)))unsigned;
constexpr int D=64;
constexpr int NW=8,QBLK=32,QB=QBLK*NW,KVBLK=64;
constexpr int ATTN_UNIT_ROWS=QB;
__device__ __forceinline__ int crow(int r,int hi){return (r&3)+8*(r>>2)+4*hi;}
#define SBAR() __builtin_amdgcn_sched_barrier(0)
__device__ __forceinline__ void cmask_blk(f32x16&p0,f32x16&p1,int jb,int wid){
  if(jb>(wid>>1)){ const float NEG=-INFINITY;
    #pragma unroll
    for(int r=0;r<16;++r){p0[r]=NEG;p1[r]=NEG;} }
}
__device__ __forceinline__ void alibi(f32x16&p0,f32x16&p1,float dq,float nsl2){
  #pragma unroll
  for(int r=0;r<16;++r){ const float e=(float)((r&3)+8*(r>>2)); p0[r]=__builtin_fmaf(__builtin_fabsf(dq-e),nsl2,p0[r]); p1[r]=__builtin_fmaf(__builtin_fabsf(dq-e-32.f),nsl2,p1[r]); }
}

constexpr int NSLOT=3, SLOTB=8192;
constexpr int LDS_K=0, LDS_V=NSLOT*SLOTB, LDS_WS=2*NSLOT*SLOTB, LDS_OST=LDS_WS+NW*64*4, LDS_BYTES=LDS_OST+NW*4096;
constexpr float C2=0.125f*1.4426950408889634f;
__device__ __forceinline__ void glds16(const void*gsrc,unsigned lds_dst){unsigned keep;
  asm volatile("s_mov_b32 %0, m0\n\ts_mov_b32 m0, %2\n\ts_nop 0\n\tglobal_load_lds_dwordx4 %1, off\n\ts_mov_b32 m0, %0":"=&s"(keep):"v"(gsrc),"s"(lds_dst):"memory");}
__device__ __forceinline__ float max3f(float a,float b,float c){float r;asm("v_max3_f32 %0, %1, %2, %3":"=v"(r):"v"(a),"v"(b),"v"(c));return r;}
__device__ __forceinline__ float max2f(float a,float b){float r;asm("v_max_f32_e32 %0, %1, %2":"=v"(r):"v"(a),"v"(b));return r;}
__device__ __forceinline__ float fadd_s(float a,float b){float r;asm("v_add_f32_e32 %0, %1, %2":"=v"(r):"v"(a),"v"(b));return r;}
__device__ __forceinline__ float fsub_s(float a,float b){float r;asm("v_sub_f32_e32 %0, %1, %2":"=v"(r):"v"(a),"v"(b));return r;}
typedef float f32x2_t __attribute__((ext_vector_type(2))); typedef __bf16 bf16x2_t __attribute__((ext_vector_type(2)));
__device__ __forceinline__ unsigned cvtpk_s(float lo,float hi){f32x2_t v={lo,hi};bf16x2_t b=__builtin_convertvector(v,bf16x2_t);return __builtin_bit_cast(unsigned,b);}
#define WAIT_BAR(N) asm volatile("s_waitcnt vmcnt(" #N ") lgkmcnt(0)\n\ts_barrier":::"memory")

__device__ __forceinline__ void qkt(f32x16&p0,f32x16&p1,const char*Kslot,const bf16x8*qr,const f32x16&negm,int r32,int hi){
  const char*kb=Kslot+hi*1024+r32*16;
  #pragma unroll
  for(int d0=0;d0<4;++d0){
    const bf16x8 b0=*reinterpret_cast<const bf16x8*>(kb+d0*2048);
    const bf16x8 b1=*reinterpret_cast<const bf16x8*>(kb+d0*2048+512);
    if(d0==0){p0=__builtin_amdgcn_mfma_f32_32x32x16_bf16(b0,qr[0],negm,0,0,0);p1=__builtin_amdgcn_mfma_f32_32x32x16_bf16(b1,qr[0],negm,0,0,0);}
    else{p0=__builtin_amdgcn_mfma_f32_32x32x16_bf16(b0,qr[d0],p0,0,0,0);p1=__builtin_amdgcn_mfma_f32_32x32x16_bf16(b1,qr[d0],p1,0,0,0);}}
}
typedef __attribute__((address_space(3))) const char* lds_cptr;
typedef short v4i16_t __attribute__((ext_vector_type(4)));
__device__ __forceinline__ void kload8(bf16x8*kf,lds_cptr kp){
  kf[0]=*(const __attribute__((address_space(3))) bf16x8*)(kp);      kf[1]=*(const __attribute__((address_space(3))) bf16x8*)(kp+512);
  kf[2]=*(const __attribute__((address_space(3))) bf16x8*)(kp+2048); kf[3]=*(const __attribute__((address_space(3))) bf16x8*)(kp+2560);
  kf[4]=*(const __attribute__((address_space(3))) bf16x8*)(kp+4096); kf[5]=*(const __attribute__((address_space(3))) bf16x8*)(kp+4608);
  kf[6]=*(const __attribute__((address_space(3))) bf16x8*)(kp+6144); kf[7]=*(const __attribute__((address_space(3))) bf16x8*)(kp+6656);
}
__device__ __forceinline__ void kload2(bf16x8*kf,lds_cptr kp,int j){ kf[2*j]=*(const __attribute__((address_space(3))) bf16x8*)(kp+j*2048); kf[2*j+1]=*(const __attribute__((address_space(3))) bf16x8*)(kp+j*2048+512); }
__device__ __forceinline__ s16x4 vtr(lds_cptr p){ return __builtin_bit_cast(s16x4,__builtin_amdgcn_ds_read_tr16_b64_v4i16((__attribute__((address_space(3))) v4i16_t*)p)); }
__device__ __forceinline__ float rowmax(const f32x16&p0,const f32x16&p1){
  float a=max3f(p0[0],p0[1],p1[0]),b=max3f(p0[2],p0[3],p1[1]);a=max3f(a,p1[2],p1[3]);
  #pragma unroll
  for(int r=4;r<16;r+=4){a=max3f(a,p0[r],p0[r+1]);b=max3f(b,p0[r+2],p0[r+3]);a=max3f(a,p1[r],p1[r+1]);b=max3f(b,p1[r+2],p1[r+3]);}
  const float m=max2f(a,b);
  auto rr=__builtin_amdgcn_permlane32_swap(__float_as_uint(m),__float_as_uint(m),false,false);
  return max2f(__uint_as_float(rr[0]),__uint_as_float(rr[1]));
}
__device__ __forceinline__ void pv(f32x16*o,int vb,bf16x8 pa0,bf16x8 pa1,bf16x8 pa2,bf16x8 pa3){
  #pragma unroll
  for(int d0=0;d0<2;++d0){s16x4 lo[4],hi[4];
    #pragma unroll
    for(int ks=0;ks<4;++ks){
      asm volatile("ds_read_b64_tr_b16 %0,%1 offset:%c2":"=&v"(lo[ks]):"v"(vb),"i"(d0*4096+ks*1024):"memory");
      asm volatile("ds_read_b64_tr_b16 %0,%1 offset:%c2":"=&v"(hi[ks]):"v"(vb),"i"(d0*4096+ks*1024+512):"memory");}
    asm volatile("s_waitcnt lgkmcnt(0)":::"memory");SBAR();
    #define PK(k) (bf16x8){lo[k][0],lo[k][1],lo[k][2],lo[k][3],hi[k][0],hi[k][1],hi[k][2],hi[k][3]}
    o[d0]=__builtin_amdgcn_mfma_f32_32x32x16_bf16(pa0,PK(0),o[d0],0,0,0);
    o[d0]=__builtin_amdgcn_mfma_f32_32x32x16_bf16(pa1,PK(1),o[d0],0,0,0);
    o[d0]=__builtin_amdgcn_mfma_f32_32x32x16_bf16(pa2,PK(2),o[d0],0,0,0);
    o[d0]=__builtin_amdgcn_mfma_f32_32x32x16_bf16(pa3,PK(3),o[d0],0,0,0);
    #undef PK
  }
}

#ifndef ATTN_STORE16
#define ATTN_STORE16(p,v) (*(u32x4*)(p)=(v))
#endif
template<int MODE,int THRL> __device__ __forceinline__ void attn_unit(const bf16*Qb,int qp,const bf16*__restrict__ Kh,int kp,const bf16*__restrict__ Vh,int vp,bf16*Ob,int op,int NT,int q0,float nsl2,char*shm,const int wid_in){
  int lane_; asm volatile("v_mbcnt_lo_u32_b32 %0, -1, 0\n\tv_mbcnt_hi_u32_b32 %0, -1, %0":"=v"(lane_)); const int lane=lane_,r32=lane&31,hi=lane>>5; const int wid=wid_in,tid=wid*64+lane; (void)tid;
  const bf16*Qw=Qb+(long)(wid*QBLK)*qp;
  const unsigned lds0=(unsigned)(uintptr_t)shm;
  float*wsf=(float*)(shm+LDS_WS)+wid*64;
  const bf16*ksrc=Kh+(long)lane*kp+wid*8;
  const bf16*vsrc=Vh+(long)(16*(wid&3)+(lane>>2))*vp+(wid>>2)*32+(lane&3)*8;
  const unsigned kdst=lds0+LDS_K+wid*1024, vdst=lds0+LDS_V+wid*1024;
  #define DMA_K(t,slot) glds16(ksrc+(long)(t)*KVBLK*kp,(unsigned)__builtin_amdgcn_readfirstlane(kdst+(slot)))
  #define DMA_V(t,slot) glds16(vsrc+(long)(t)*KVBLK*vp,(unsigned)__builtin_amdgcn_readfirstlane(vdst+(slot)))
  const int vb0=(int)(lds0+LDS_V)+((lane>>4)&1)*32+(lane&3)*8+(4*hi+((lane&15)>>2))*64;
  const char*Kbase=shm+LDS_K; bf16x8 kf[8];
  const lds_cptr shm3=(lds_cptr)shm; const lds_cptr kp0=shm3+LDS_K+hi*1024+r32*16; const lds_cptr vp0=shm3+LDS_V+((lane>>4)&1)*32+(lane&3)*8+(4*hi+((lane&15)>>2))*64;
  DMA_K(0,0);DMA_V(0,0);DMA_K(1,SLOTB);
  bf16x8 qr[4];
  #pragma unroll
  for(int d0=0;d0<4;++d0)qr[d0]=*reinterpret_cast<const bf16x8*>(&Qw[(long)r32*qp+d0*16+hi*8]);
  float mhat=0.f,l_reg=0.f;f32x16 o[2];float z_=0.f;asm volatile("":"+v"(z_));
  _Pragma("unroll") for(int r=0;r<16;++r){o[0][r]=z_;o[1][r]=z_;} f32x16 negm;_Pragma("unroll") for(int r=0;r<16;++r)negm[r]=z_;asm volatile("":"+v"(negm));
  const float dq0=(float)(q0+wid*QBLK+r32-4*hi);
  #define ALIBI(P0,P1,t) do{ if(MODE==0) alibi(P0,P1,dq0-(float)(64*(t)),nsl2); }while(0)
  #define CMASK(P0,P1,t) do{ if(MODE==0){int jb_=(t)-(NT-4); if(jb_>=0)cmask_blk(P0,P1,jb_,wid);} }while(0)
  bool resc=false;
  #define START(P0,P1) do{ const float rm=rm0_; resc=false; \
    { const float dl=rm; mhat=fadd_s(mhat,dl); \
      _Pragma("unroll") for(int r=0;r<16;++r){P0[r]=fsub_s(P0[r],dl);P1[r]=fsub_s(P1[r],dl);} \
      _Pragma("unroll") for(int r=0;r<16;++r)negm[r]=-mhat; asm volatile("":"+v"(negm)); } \
    _Pragma("unroll") for(int r=0;r<16;++r)P0[r]=__builtin_amdgcn_exp2f(P0[r]); }while(0)
  #define RESC() do{ if(resc){ asm volatile("s_waitcnt lgkmcnt(0)":::"memory"); \
      _Pragma("unroll") for(int d_=0;d_<2;++d_) _Pragma("unroll") for(int r=0;r<16;++r)o[d_][r]*=wsf[crow(r,hi)]; } }while(0)
  f32x16 pA0,pA1,pB0,pB1;
  int sl_prev=0,sl_cur=0,sl_next=SLOTB;
  #define ROT() do{sl_prev=sl_cur;sl_cur=sl_next;sl_next=(sl_next==(NSLOT-1)*SLOTB)?0:sl_next+SLOTB;}while(0)
  DMA_K(2,2*SLOTB);
  WAIT_BAR(3);
  qkt(pA0,pA1,Kbase,qr,negm,r32,hi);asm volatile("s_nop 15\n\ts_nop 7":"+v"(pA0),"+v"(pA1));const float rm0_=rowmax(pA0,pA1);
  ALIBI(pA0,pA1,0);CMASK(pA0,pA1,0);
  START(pA0,pA1);
  _Pragma("unroll") for(int r=0;r<16;++r)pA1[r]=__builtin_amdgcn_exp2f(pA1[r]);
  WAIT_BAR(0);
  DMA_K(3,0);DMA_V(1,SLOTB);
  ROT();
  kload8(kf,kp0+sl_cur);
  WAIT_BAR(2);
  s16x4 vlo[8],vhi[8]; u32x4 pw0,pw1,pw2,pw3;
  #define PKW(P,B) cvtpk_s(P[B],P[B+1])
  #define PAF(k) __builtin_bit_cast(bf16x8,pw##k)
  #define VFR(i) (bf16x8){vlo[i][0],vlo[i][1],vlo[i][2],vlo[i][3],vhi[i][0],vhi[i][1],vhi[i][2],vhi[i][3]}
  #define PIN(x) asm volatile("":"+v"(x))
  #define MX3(a,b,c) __builtin_fmaxf(__builtin_fmaxf((a),(b)),(c))
  #define GAPA(MF,A0,A1,A2,A3,W0,W1,PW) do{ MF; sacc+=A0; sacc+=A1; sacc+=A2; sacc+=A3; PIN(sacc); W0; W1; PIN(PW); SBAR(); }while(0)
  #define EX(v) __builtin_amdgcn_exp2f(v)
  #define GAPB(MF,X,B) do{ MF; X[B]=EX(X[B]); X[B+1]=EX(X[B+1]); X[B+2]=EX(X[B+2]); X[B+3]=EX(X[B+3]); PIN(X); SBAR(); }while(0)
  #define VRD(i) do{ vlo[i]=vtr(vp_+(((i)>>2)*4096+((i)&3)*1024)); vhi[i]=vtr(vp_+(((i)>>2)*4096+((i)&3)*1024+512)); }while(0)
  #define KRD(G,j) do{ if(G){ kload2(kf,kp0+sl_next,j); SBAR(); } }while(0)
  #define STEP(C0,C1,P0,P1,t,GK,GV,GL) do{ SBAR(); \
    const lds_cptr vp_=vp0+sl_prev; \
    VRD(0); SBAR(); float sacc=(P0[0]+P0[1]); \
    GAPA(C0=__builtin_amdgcn_mfma_f32_32x32x16_bf16(kf[0],qr[0],negm,0,0,0), P0[2],P0[3],P0[4],P0[5],     pw0[0]=PKW(P0,0), pw0[1]=PKW(P0,2), pw0); \
    VRD(4); SBAR(); GAPA(C1=__builtin_amdgcn_mfma_f32_32x32x16_bf16(kf[1],qr[0],negm,0,0,0), P0[6],P0[7],P0[8],P0[9],     pw0[2]=PKW(P0,4), pw0[3]=PKW(P0,6), pw0); \
    VRD(1); SBAR(); GAPA(C0=__builtin_amdgcn_mfma_f32_32x32x16_bf16(kf[2],qr[1],C0,0,0,0),   P0[10],P0[11],P0[12],P0[13], pw1[0]=PKW(P0,8), pw1[1]=PKW(P0,10), pw1); \
    VRD(5); SBAR(); GAPA(C1=__builtin_amdgcn_mfma_f32_32x32x16_bf16(kf[3],qr[1],C1,0,0,0),   P0[14],P0[15],P1[0],P1[1],   pw1[2]=PKW(P0,12),pw1[3]=PKW(P0,14), pw1); \
    VRD(2); SBAR(); GAPA(C0=__builtin_amdgcn_mfma_f32_32x32x16_bf16(kf[4],qr[2],C0,0,0,0),   P1[2],P1[3],P1[4],P1[5],     pw2[0]=PKW(P1,0), pw2[1]=PKW(P1,2), pw2); \
    VRD(6); SBAR(); GAPA(C1=__builtin_amdgcn_mfma_f32_32x32x16_bf16(kf[5],qr[2],C1,0,0,0),   P1[6],P1[7],P1[8],P1[9],     pw2[2]=PKW(P1,4), pw2[3]=PKW(P1,6), pw2); \
    VRD(3); SBAR(); GAPA(C0=__builtin_amdgcn_mfma_f32_32x32x16_bf16(kf[6],qr[3],C0,0,0,0),   P1[10],P1[11],P1[12],P1[13], pw3[0]=PKW(P1,8), pw3[1]=PKW(P1,10), pw3); \
    VRD(7); SBAR(); GAPA(C1=__builtin_amdgcn_mfma_f32_32x32x16_bf16(kf[7],qr[3],C1,0,0,0),   P1[14],P1[15],0.f,0.f,       pw3[2]=PKW(P1,12),pw3[3]=PKW(P1,14), pw3); \
    l_reg+=sacc; \
    if(GK){DMA_K((t)+3,sl_cur);} if(GV){DMA_V((t)+1,sl_next);} \
    ALIBI(C0,C1,t); CMASK(C0,C1,t); \
    { float a=MX3(C0[0],C0[1],C1[0]),b=MX3(C0[2],C0[3],C1[1]); a=MX3(a,C1[2],C1[3]); \
      _Pragma("unroll") for(int r=4;r<16;r+=4){a=MX3(a,C0[r],C0[r+1]);b=MX3(b,C0[r+2],C0[r+3]);a=MX3(a,C1[r],C1[r+1]);b=MX3(b,C1[r+2],C1[r+3]);} \
      float rm=__builtin_fmaxf(a,b); { auto rr=__builtin_amdgcn_permlane32_swap(__float_as_uint(rm),__float_as_uint(rm),false,false); rm=__builtin_fmaxf(__uint_as_float(rr[0]),__uint_as_float(rr[1])); } \
      resc=false; \
      if(__builtin_expect(__any(rm>(float)THRL),0)){ const float dl=__builtin_fmaxf(rm,0.f); mhat+=dl; \
        _Pragma("unroll") for(int r=0;r<16;++r){C0[r]-=dl;C1[r]-=dl;} \
        _Pragma("unroll") for(int r=0;r<16;++r)negm[r]=-mhat; asm volatile("":"+v"(negm)); \
        const float f=__builtin_amdgcn_exp2f(-dl); l_reg*=f; if(hi==0)wsf[r32]=f; resc=true; } } \
    SBAR(); \
    GAPB(o[0]=__builtin_amdgcn_mfma_f32_32x32x16_bf16(PAF(0),VFR(0),o[0],0,0,0), C0,0); \
    GAPB(o[1]=__builtin_amdgcn_mfma_f32_32x32x16_bf16(PAF(0),VFR(4),o[1],0,0,0), C0,4); \
    KRD(GL,0); GAPB(o[0]=__builtin_amdgcn_mfma_f32_32x32x16_bf16(PAF(1),VFR(1),o[0],0,0,0), C0,8); \
    KRD(GL,1); GAPB(o[1]=__builtin_amdgcn_mfma_f32_32x32x16_bf16(PAF(1),VFR(5),o[1],0,0,0), C0,12); \
    KRD(GL,2); GAPB(o[0]=__builtin_amdgcn_mfma_f32_32x32x16_bf16(PAF(2),VFR(2),o[0],0,0,0), C1,0); \
    KRD(GL,3); GAPB(o[1]=__builtin_amdgcn_mfma_f32_32x32x16_bf16(PAF(2),VFR(6),o[1],0,0,0), C1,4); \
    GAPB(o[0]=__builtin_amdgcn_mfma_f32_32x32x16_bf16(PAF(3),VFR(3),o[0],0,0,0), C1,8); \
    GAPB(o[1]=__builtin_amdgcn_mfma_f32_32x32x16_bf16(PAF(3),VFR(7),o[1],0,0,0), C1,12); \
    }while(0)
  int t=1;
  #undef CMASK
  #define CMASK(P0,P1,t) do{}while(0)
  for(;t+5<NT;t+=2){
    STEP(pB0,pB1,pA0,pA1,t,true,true,true);     WAIT_BAR(2); RESC(); ROT();
    STEP(pA0,pA1,pB0,pB1,t+1,true,true,true);   WAIT_BAR(2); RESC(); ROT();
  }
  #undef CMASK
  #define CMASK(P0,P1,t) do{ if(MODE==0){int jb_=(t)-(NT-4); if(jb_>=0)cmask_blk(P0,P1,jb_,wid);} }while(0)
  #define ENDW(tt) do{ if((tt)+3<NT){WAIT_BAR(2);} else if((tt)+2<NT){WAIT_BAR(1);} else {WAIT_BAR(0);} }while(0)
  for(;t+1<NT;t+=2){
    STEP(pB0,pB1,pA0,pA1,t,(t+3<NT),(t+1<NT),(t+1<NT));       ENDW(t);   RESC(); ROT();
    STEP(pA0,pA1,pB0,pB1,t+1,(t+4<NT),(t+2<NT),(t+2<NT));     ENDW(t+1); RESC(); ROT();
  }
  STEP(pB0,pB1,pA0,pA1,NT-1,false,false,false); RESC();
  { float sacc=pB0[0]+pB0[1]; _Pragma("unroll") for(int r=2;r<16;++r)sacc+=pB0[r]; _Pragma("unroll") for(int r=0;r<16;++r)sacc+=pB1[r]; l_reg+=sacc;
    pw0=(u32x4){PKW(pB0,0),PKW(pB0,2),PKW(pB0,4),PKW(pB0,6)};pw1=(u32x4){PKW(pB0,8),PKW(pB0,10),PKW(pB0,12),PKW(pB0,14)};pw2=(u32x4){PKW(pB1,0),PKW(pB1,2),PKW(pB1,4),PKW(pB1,6)};pw3=(u32x4){PKW(pB1,8),PKW(pB1,10),PKW(pB1,12),PKW(pB1,14)};
    SBAR(); pv(o,vb0+sl_cur,PAF(0),PAF(1),PAF(2),PAF(3)); }
  #undef PKW
  #undef PAF
  #undef VFR
  #undef PIN
  #undef MX3
  #undef GAPA
  #undef GAPB
  #undef EX
  #undef VRD
  #undef KRD
  #undef STEP
  #undef ENDW
  {auto rr=__builtin_amdgcn_permlane32_swap(__float_as_uint(l_reg),__float_as_uint(l_reg),false,false);l_reg=__uint_as_float(rr[0])+__uint_as_float(rr[1]);}
  if(hi==0)wsf[32+r32]=l_reg;asm volatile("s_waitcnt lgkmcnt(0)":::"memory");
  float rli[16];
  #pragma unroll
  for(int r=0;r<16;++r)rli[r]=__builtin_amdgcn_rcpf(wsf[32+crow(r,hi)]);
  bf16*Ow=Ob+(long)(wid*QBLK)*op;
  { bf16*stg=(bf16*)(shm+LDS_OST)+wid*2048;
    #pragma unroll
    for(int r=0;r<16;++r){const int orow=crow(r,hi);
      #pragma unroll
      for(int d0=0;d0<2;++d0)stg[orow*64+d0*32+r32]=__float2bfloat16(o[d0][r]*rli[r]);}
    asm volatile("s_waitcnt lgkmcnt(0)":::"memory");
    #pragma unroll
    for(int i=0;i<4;++i){const int row=i*8+(lane>>3),ch=lane&7; const u32x4 v=*(const u32x4*)(stg+row*64+ch*8); ATTN_STORE16(Ow+(long)row*op+ch*8,v);} }
  asm volatile("s_waitcnt lgkmcnt(0)\n\ts_barrier":::"memory");
  #undef DMA_K
  #undef DMA_V
  #undef CMASK
  #undef ALIBI
  #undef START
  #undef RESC
  #undef ROT
}
constexpr int L2_K=0, L2_V0=NSLOT*SLOTB, L2_V1=2*NSLOT*SLOTB, L2_WS=3*NSLOT*SLOTB, L2_QS=L2_WS+NW*64*4, L2_QSW=4608, LDS2_BYTES=L2_QS+NW*L2_QSW;
template<int THRL> __device__ __forceinline__ void attn_unit2(const bf16*Qb,int qp,const bf16*__restrict__ Kh,int kp,const bf16*__restrict__ Vh,int vp,bf16*Ob,int op,int NT,int q0,float nsl2,char*shm,const int wid_in){
  int lane_; asm volatile("v_mbcnt_lo_u32_b32 %0, -1, 0\n\tv_mbcnt_hi_u32_b32 %0, -1, %0":"=v"(lane_)); const int lane=lane_,r32=lane&31,hi=lane>>5; const int wid=wid_in,tid=wid*64+lane; (void)tid; constexpr int MODE=0;
  const bf16*Qw=Qb+(long)(wid*QBLK)*qp;
  const unsigned lds0=(unsigned)(uintptr_t)shm;
  float*wsf=(float*)(shm+L2_WS)+wid*64;
  const bf16*ksrc=Kh+(long)lane*kp+wid*8;
  const bf16*vsrc=Vh+(long)(16*(wid&3)+(lane>>2))*vp+(wid>>2)*32+(lane&3)*8;
  const unsigned kdst=lds0+L2_K+wid*1024, vdst=lds0+L2_V0+wid*1024, vdst1=lds0+L2_V1+wid*1024;
  #define DMA_K(t,slot) glds16(ksrc+(long)(t)*KVBLK*kp,(unsigned)__builtin_amdgcn_readfirstlane(kdst+(slot)))
  #define DMA_V(t,slot) do{ glds16(vsrc+(long)(t)*KVBLK*vp,(unsigned)__builtin_amdgcn_readfirstlane(vdst+(slot))); glds16(vsrc+64+(long)(t)*KVBLK*vp,(unsigned)__builtin_amdgcn_readfirstlane(vdst1+(slot))); }while(0)
  const int vb0=(int)(lds0+L2_V0)+((lane>>4)&1)*32+(lane&3)*8+(4*hi+((lane&15)>>2))*64, vb1=vb0+(L2_V1-L2_V0);
  const char*Kbase=shm+L2_K; bf16x8 kf[8];
  const lds_cptr shm3=(lds_cptr)shm; const lds_cptr kp0=shm3+L2_K+hi*1024+r32*16; const lds_cptr vp0=shm3+L2_V0+((lane>>4)&1)*32+(lane&3)*8+(4*hi+((lane&15)>>2))*64; const lds_cptr qf0=shm3+L2_QS+wid*L2_QSW+r32*144+hi*16;
  DMA_K(0,0);DMA_V(0,0);DMA_K(1,SLOTB);
  bf16x8 qr[4];
  #pragma unroll
  for(int d0=0;d0<4;++d0)qr[d0]=*reinterpret_cast<const bf16x8*>(&Qw[(long)r32*qp+d0*16+hi*8]);
  float mhat=0.f,l_reg=0.f;f32x16 o[4];float z_=0.f;asm volatile("":"+v"(z_));
  _Pragma("unroll") for(int r=0;r<16;++r){o[0][r]=z_;o[1][r]=z_;o[2][r]=z_;o[3][r]=z_;}
  const f32x16 ZERO={0.f,0.f,0.f,0.f,0.f,0.f,0.f,0.f,0.f,0.f,0.f,0.f,0.f,0.f,0.f,0.f};
  const float dq0=(float)(q0+wid*QBLK+r32-4*hi);
  #define ALIBI(P0,P1,t) do{ alibi(P0,P1,dq0-(float)(64*(t)),nsl2); _Pragma("unroll") for(int r=0;r<16;++r){P0[r]-=mhat;P1[r]-=mhat;} }while(0)
  #define ALIBIF(P0,P1,t) do{ const float a_=__builtin_fmaf(nsl2,dq0-(float)(64*(t)),-mhat); _Pragma("unroll") for(int r=0;r<16;++r){ const float e_=(float)((r&3)+8*(r>>2)); P0[r]=__builtin_fmaf(e_,-nsl2,P0[r]+a_); P1[r]=__builtin_fmaf(e_+32.f,-nsl2,P1[r]+a_); } }while(0)
  #define CMASK(P0,P1,t) do{ if(MODE==0){int jb_=(t)-(NT-4); if(jb_>=0)cmask_blk(P0,P1,jb_,wid);} }while(0)
  bool resc=false;
  #define START(P0,P1) do{ const float rm=rm0_; resc=false; \
    { const float dl=rm; mhat=fadd_s(mhat,dl); \
      _Pragma("unroll") for(int r=0;r<16;++r){P0[r]=fsub_s(P0[r],dl);P1[r]=fsub_s(P1[r],dl);} \
      } \
    _Pragma("unroll") for(int r=0;r<16;++r)P0[r]=__builtin_amdgcn_exp2f(P0[r]); }while(0)
  #define RESC() do{ if(resc){ asm volatile("s_waitcnt lgkmcnt(0)":::"memory"); \
      _Pragma("unroll") for(int d_=0;d_<4;++d_) _Pragma("unroll") for(int r=0;r<16;++r)o[d_][r]*=wsf[crow(r,hi)]; } }while(0)
  f32x16 pA0,pA1,pB0,pB1;
  int sl_prev=0,sl_cur=0,sl_next=SLOTB;
  #define ROT() do{sl_prev=sl_cur;sl_cur=sl_next;sl_next=(sl_next==(NSLOT-1)*SLOTB)?0:sl_next+SLOTB;}while(0)
  DMA_K(2,2*SLOTB);
  { bf16*qs=(bf16*)(shm+L2_QS+wid*L2_QSW);
    _Pragma("unroll") for(int d0=0;d0<4;++d0)*reinterpret_cast<bf16x8*>(&qs[r32*72+d0*16+hi*8])=qr[d0]; }
  WAIT_BAR(4);
  qkt(pA0,pA1,Kbase,qr,ZERO,r32,hi);asm volatile("s_nop 15\n\ts_nop 7":"+v"(pA0),"+v"(pA1));const float rm0_=rowmax(pA0,pA1);
  ALIBI(pA0,pA1,0);CMASK(pA0,pA1,0);
  START(pA0,pA1);
  _Pragma("unroll") for(int r=0;r<16;++r)pA1[r]=__builtin_amdgcn_exp2f(pA1[r]);
  WAIT_BAR(0);
  DMA_K(3,0);DMA_V(1,SLOTB);
  ROT();
  kload8(kf,kp0+sl_cur);
  WAIT_BAR(3);
  s16x4 vlo[8],vhi[8]; u32x4 pw0,pw1,pw2,pw3;
  #define PKW(P,B) cvtpk_s(P[B],P[B+1])
  #define PAF(k) __builtin_bit_cast(bf16x8,pw##k)
  #define VFR(i) (bf16x8){vlo[i][0],vlo[i][1],vlo[i][2],vlo[i][3],vhi[i][0],vhi[i][1],vhi[i][2],vhi[i][3]}
  #define PIN(x) asm volatile("":"+v"(x))
  #define MX3(a,b,c) __builtin_fmaxf(__builtin_fmaxf((a),(b)),(c))
  #define GAPA(MF,A0,A1,A2,A3,W0,W1,PW) do{ MF; sacc+=A0; sacc+=A1; sacc+=A2; sacc+=A3; PIN(sacc); W0; W1; PIN(PW); SBAR(); }while(0)
  #define EX(v) __builtin_amdgcn_exp2f(v)
  #define GAPB(MF,X,B) do{ MF; X[B]=EX(X[B]); X[B+1]=EX(X[B+1]); X[B+2]=EX(X[B+2]); X[B+3]=EX(X[B+3]); PIN(X); SBAR(); }while(0)
  #define VRD(i) do{ vlo[i]=vtr(vp_+(((i)>>2)*4096+((i)&3)*1024)); vhi[i]=vtr(vp_+(((i)>>2)*4096+((i)&3)*1024+512)); }while(0)
  #define KRD(G,j) do{ if(G){ kload2(kf,kp0+sl_next,j); SBAR(); } }while(0)
  #define QF(d) (*(const __attribute__((address_space(3))) bf16x8*)(qf0+32*(d)))
  #define STEP(C0,C1,P0,P1,t,GK,GV,GL,AL) do{ SBAR(); \
    const lds_cptr vp_=vp0+sl_prev; const bf16x8 q0_=QF(0),q1_=QF(1); \
    VRD(0); SBAR(); float sacc=(P0[0]+P0[1]); \
    GAPA(C0=__builtin_amdgcn_mfma_f32_32x32x16_bf16(kf[0],q0_,ZERO,0,0,0), P0[2],P0[3],P0[4],P0[5],     pw0[0]=PKW(P0,0), pw0[1]=PKW(P0,2), pw0); \
    VRD(4); SBAR(); GAPA(C1=__builtin_amdgcn_mfma_f32_32x32x16_bf16(kf[1],q0_,ZERO,0,0,0), P0[6],P0[7],P0[8],P0[9],     pw0[2]=PKW(P0,4), pw0[3]=PKW(P0,6), pw0); \
    VRD(1); SBAR(); GAPA(C0=__builtin_amdgcn_mfma_f32_32x32x16_bf16(kf[2],q1_,C0,0,0,0),   P0[10],P0[11],P0[12],P0[13], pw1[0]=PKW(P0,8), pw1[1]=PKW(P0,10), pw1); \
    VRD(5); SBAR(); GAPA(C1=__builtin_amdgcn_mfma_f32_32x32x16_bf16(kf[3],q1_,C1,0,0,0),   P0[14],P0[15],P1[0],P1[1],   pw1[2]=PKW(P0,12),pw1[3]=PKW(P0,14), pw1); \
    const bf16x8 q2_=QF(2),q3_=QF(3); \
    VRD(2); SBAR(); GAPA(C0=__builtin_amdgcn_mfma_f32_32x32x16_bf16(kf[4],q2_,C0,0,0,0),   P1[2],P1[3],P1[4],P1[5],     pw2[0]=PKW(P1,0), pw2[1]=PKW(P1,2), pw2); \
    VRD(6); SBAR(); GAPA(C1=__builtin_amdgcn_mfma_f32_32x32x16_bf16(kf[5],q2_,C1,0,0,0),   P1[6],P1[7],P1[8],P1[9],     pw2[2]=PKW(P1,4), pw2[3]=PKW(P1,6), pw2); \
    VRD(3); SBAR(); GAPA(C0=__builtin_amdgcn_mfma_f32_32x32x16_bf16(kf[6],q3_,C0,0,0,0),   P1[10],P1[11],P1[12],P1[13], pw3[0]=PKW(P1,8), pw3[1]=PKW(P1,10), pw3); \
    VRD(7); SBAR(); GAPA(C1=__builtin_amdgcn_mfma_f32_32x32x16_bf16(kf[7],q3_,C1,0,0,0),   P1[14],P1[15],0.f,0.f,       pw3[2]=PKW(P1,12),pw3[3]=PKW(P1,14), pw3); \
    l_reg+=sacc; \
    if(GK){DMA_K((t)+3,sl_cur);} if(GV){DMA_V((t)+1,sl_next);} \
    AL(C0,C1,t); CMASK(C0,C1,t); \
    { float a=MX3(C0[0],C0[1],C1[0]),b=MX3(C0[2],C0[3],C1[1]); a=MX3(a,C1[2],C1[3]); \
      _Pragma("unroll") for(int r=4;r<16;r+=4){a=MX3(a,C0[r],C0[r+1]);b=MX3(b,C0[r+2],C0[r+3]);a=MX3(a,C1[r],C1[r+1]);b=MX3(b,C1[r+2],C1[r+3]);} \
      float rm=__builtin_fmaxf(a,b); { auto rr=__builtin_amdgcn_permlane32_swap(__float_as_uint(rm),__float_as_uint(rm),false,false); rm=__builtin_fmaxf(__uint_as_float(rr[0]),__uint_as_float(rr[1])); } \
      resc=false; \
      if(__builtin_expect(__any(rm>(float)THRL),0)){ const float dl=__builtin_fmaxf(rm,0.f); mhat+=dl; \
        _Pragma("unroll") for(int r=0;r<16;++r){C0[r]-=dl;C1[r]-=dl;} \
        const float f=__builtin_amdgcn_exp2f(-dl); l_reg*=f; if(hi==0)wsf[r32]=f; resc=true; } } \
    SBAR(); \
    GAPB(o[0]=__builtin_amdgcn_mfma_f32_32x32x16_bf16(PAF(0),VFR(0),o[0],0,0,0), C0,0); \
    GAPB(o[1]=__builtin_amdgcn_mfma_f32_32x32x16_bf16(PAF(0),VFR(4),o[1],0,0,0), C0,4); \
    KRD(GL,0); GAPB(o[0]=__builtin_amdgcn_mfma_f32_32x32x16_bf16(PAF(1),VFR(1),o[0],0,0,0), C0,8); \
    KRD(GL,1); GAPB(o[1]=__builtin_amdgcn_mfma_f32_32x32x16_bf16(PAF(1),VFR(5),o[1],0,0,0), C0,12); \
    KRD(GL,2); GAPB(o[0]=__builtin_amdgcn_mfma_f32_32x32x16_bf16(PAF(2),VFR(2),o[0],0,0,0), C1,0); \
    KRD(GL,3); GAPB(o[1]=__builtin_amdgcn_mfma_f32_32x32x16_bf16(PAF(2),VFR(6),o[1],0,0,0), C1,4); \
    GAPB(o[0]=__builtin_amdgcn_mfma_f32_32x32x16_bf16(PAF(3),VFR(3),o[0],0,0,0), C1,8); \
    GAPB(o[1]=__builtin_amdgcn_mfma_f32_32x32x16_bf16(PAF(3),VFR(7),o[1],0,0,0), C1,12); \
    { const lds_cptr vq_=vp_+(L2_V1-L2_V0); _Pragma("unroll") for(int i_=0;i_<8;++i_){ vlo[i_]=vtr(vq_+((i_>>2)*4096+(i_&3)*1024)); vhi[i_]=vtr(vq_+((i_>>2)*4096+(i_&3)*1024+512)); } SBAR(); \
      o[2]=__builtin_amdgcn_mfma_f32_32x32x16_bf16(PAF(0),VFR(0),o[2],0,0,0); o[3]=__builtin_amdgcn_mfma_f32_32x32x16_bf16(PAF(0),VFR(4),o[3],0,0,0); \
      o[2]=__builtin_amdgcn_mfma_f32_32x32x16_bf16(PAF(1),VFR(1),o[2],0,0,0); o[3]=__builtin_amdgcn_mfma_f32_32x32x16_bf16(PAF(1),VFR(5),o[3],0,0,0); \
      o[2]=__builtin_amdgcn_mfma_f32_32x32x16_bf16(PAF(2),VFR(2),o[2],0,0,0); o[3]=__builtin_amdgcn_mfma_f32_32x32x16_bf16(PAF(2),VFR(6),o[3],0,0,0); \
      o[2]=__builtin_amdgcn_mfma_f32_32x32x16_bf16(PAF(3),VFR(3),o[2],0,0,0); o[3]=__builtin_amdgcn_mfma_f32_32x32x16_bf16(PAF(3),VFR(7),o[3],0,0,0); SBAR(); } \
    }while(0)
  int t=1;
  #undef CMASK
  #define CMASK(P0,P1,t) do{}while(0)
  for(;t+5<NT;t+=2){
    STEP(pB0,pB1,pA0,pA1,t,true,true,true,ALIBIF);     WAIT_BAR(3); RESC(); ROT();
    STEP(pA0,pA1,pB0,pB1,t+1,true,true,true,ALIBIF);   WAIT_BAR(3); RESC(); ROT();
  }
  #undef CMASK
  #define CMASK(P0,P1,t) do{ if(MODE==0){int jb_=(t)-(NT-4); if(jb_>=0)cmask_blk(P0,P1,jb_,wid);} }while(0)
  #define ENDW(tt) do{ if((tt)+3<NT){WAIT_BAR(3);} else if((tt)+2<NT){WAIT_BAR(2);} else {WAIT_BAR(0);} }while(0)
  for(;t+1<NT;t+=2){
    STEP(pB0,pB1,pA0,pA1,t,(t+3<NT),(t+1<NT),(t+1<NT),ALIBI);       ENDW(t);   RESC(); ROT();
    STEP(pA0,pA1,pB0,pB1,t+1,(t+4<NT),(t+2<NT),(t+2<NT),ALIBI);     ENDW(t+1); RESC(); ROT();
  }
  STEP(pB0,pB1,pA0,pA1,NT-1,false,false,false,ALIBI); RESC();
  { float sacc=pB0[0]+pB0[1]; _Pragma("unroll") for(int r=2;r<16;++r)sacc+=pB0[r]; _Pragma("unroll") for(int r=0;r<16;++r)sacc+=pB1[r]; l_reg+=sacc;
    pw0=(u32x4){PKW(pB0,0),PKW(pB0,2),PKW(pB0,4),PKW(pB0,6)};pw1=(u32x4){PKW(pB0,8),PKW(pB0,10),PKW(pB0,12),PKW(pB0,14)};pw2=(u32x4){PKW(pB1,0),PKW(pB1,2),PKW(pB1,4),PKW(pB1,6)};pw3=(u32x4){PKW(pB1,8),PKW(pB1,10),PKW(pB1,12),PKW(pB1,14)};
    SBAR(); pv(o,vb0+sl_cur,PAF(0),PAF(1),PAF(2),PAF(3)); pv(o+2,vb1+sl_cur,PAF(0),PAF(1),PAF(2),PAF(3)); }
  #undef PKW
  #undef PAF
  #undef VFR
  #undef PIN
  #undef MX3
  #undef GAPA
  #undef GAPB
  #undef EX
  #undef VRD
  #undef KRD
  #undef STEP
  #undef QF
  #undef ENDW
  {auto rr=__builtin_amdgcn_permlane32_swap(__float_as_uint(l_reg),__float_as_uint(l_reg),false,false);l_reg=__uint_as_float(rr[0])+__uint_as_float(rr[1]);}
  if(hi==0)wsf[32+r32]=l_reg;asm volatile("s_waitcnt lgkmcnt(0)":::"memory");
  float rli[16];
  #pragma unroll
  for(int r=0;r<16;++r)rli[r]=__builtin_amdgcn_rcpf(wsf[32+crow(r,hi)]);
  bf16*Ow=Ob+(long)(wid*QBLK)*op;
  { bf16*stg=(bf16*)(shm+L2_QS+wid*L2_QSW);
    #pragma unroll
    for(int hv=0;hv<2;++hv){
      #pragma unroll
      for(int r=0;r<16;++r){const int orow=crow(r,hi);
        #pragma unroll
        for(int d0=0;d0<2;++d0)stg[orow*64+d0*32+r32]=__float2bfloat16(o[2*hv+d0][r]*rli[r]);}
      asm volatile("s_waitcnt lgkmcnt(0)":::"memory");
      #pragma unroll
      for(int i=0;i<4;++i){const int row=i*8+(lane>>3),ch=lane&7; const u32x4 v=*(const u32x4*)(stg+row*64+ch*8); ATTN_STORE16(Ow+(long)row*op+hv*64+ch*8,v);}
      asm volatile("s_waitcnt lgkmcnt(0)":::"memory"); } }
  asm volatile("s_waitcnt lgkmcnt(0)\n\ts_barrier":::"memory");
  #undef DMA_K
  #undef DMA_V
  #undef CMASK
  #undef ALIBI
  #undef ALIBIF
  #undef START
  #undef RESC
  #undef ROT
}
constexpr int ATTN_LDS_BYTES=LDS_BYTES;
#undef SBAR
#undef WAIT_BAR
}
constexpr int T = 32768, D = 1024, NB = 8, S = 4096, MEML = 256;
constexpr int AIN = 2560, BIN = 3328, FFD = 2816, FFE = 3584, NE = 8, DAW = 768;
constexpr float EPS = 1e-6f;
constexpr float C2 = 0.125f * 1.4426950408889634f;
constexpr int MAXROWS = 2 * T + NE * 256;
constexpr int NWAVES = 8;
constexpr float SC_X = 16.f, SC_WGU = 64.f, SC_H = 8.f, SC_WDN = 256.f;
constexpr size_t MiB = 1u << 20;
constexpr size_t WS_CTL = 0, CTL_ZERO_BYTES = 1 * MiB;
constexpr size_t WS_WINA = 2 * MiB, WS_WOUT = 12 * MiB, WS_WINB = 20 * MiB, WS_WMKV = 33 * MiB, WS_WGUD = 37 * MiB, WS_WDND = 59 * MiB, WS_WGUM = 70 * MiB, WS_WDNM = 294 * MiB;
constexpr size_t WS_MEMN = 406 * MiB, WS_MKV = 422 * MiB, WS_XN = 430 * MiB, WS_OC = 494 * MiB, WS_ROUTE = 558 * MiB, WS_BIG = 560 * MiB, WS_XG = 1072 * MiB, WS_Y = 1204 * MiB, WS_SSQP = 1362 * MiB, WS_END = 1376 * MiB;
constexpr size_t WS_SLOC = WS_XG, WS_SIN = WS_XG + 192 * MiB;
constexpr size_t WS_FS = 1600 * MiB;
constexpr int CW_TMO = 0, CW_CODE = 1, CW_BAR = 4096, CW_GCNT = 8192, CW_N2 = 65536;
constexpr int RING_OFF = 0, RING_BYTES = 131072;
constexpr int LDSCTL_OFF = RING_BYTES, MISC_OFF = LDSCTL_OFF + 320;
constexpr int LDS_BYTES = 147456;
static_assert(MISC_OFF + 128 <= LDS_BYTES, "LDS map");
#ifndef MK_DBG
#define MK_DBG 0
#endif
#ifndef MK_DUP
#define MK_DUP 0
#endif
#ifndef MK_TS
#define MK_TS 0
#endif
#ifndef MK_TS_A
#define MK_TS_A 0
#endif
#ifndef MK_TS_B
#define MK_TS_B 0
#endif
__constant__ unsigned char ATT_DEAL[16][6] = {{4, 14, 35, 56, 63, 85}, {0, 18, 20, 36, 72, 79}, {16, 21, 34, 52, 88, 95}, {22, 32, 50, 62, 68, 73}, {23, 48, 66, 78, 84, 89}, {5, 15, 40, 51, 86, 94}, {1, 6, 27, 47, 61, 69}, {24, 37, 41, 64, 77, 82},
    {2, 12, 25, 53, 57, 93}, {7, 17, 28, 38, 44, 60}, {8, 29, 33, 45, 54, 76}, {9, 30, 46, 49, 70, 92}, {10, 59, 65, 67, 87, 90}, {11, 31, 42, 55, 75, 81}, {19, 43, 71, 80, 83, 91}, {3, 13, 26, 39, 58, 74}};
#define GAS __attribute__((address_space(1)))
#define LAS __attribute__((address_space(3)))
typedef unsigned short bf16;
typedef unsigned v4u __attribute__((ext_vector_type(4)));
typedef unsigned v2u __attribute__((ext_vector_type(2)));
typedef float f32x4 __attribute__((ext_vector_type(4)));
typedef short bf16x8 __attribute__((ext_vector_type(8)));
typedef GAS unsigned gu32;
typedef GAS unsigned long long gu64;
#define RLX_AGENT __ATOMIC_RELAXED, __HIP_MEMORY_SCOPE_AGENT
#define LDS_WAIT() asm volatile("s_waitcnt lgkmcnt(0)" ::: "memory")
#define VM_WAIT() asm volatile("s_waitcnt vmcnt(0)" ::: "memory")
__device__ __forceinline__ unsigned long long rt() { return __builtin_amdgcn_s_memrealtime(); }
__device__ __forceinline__ unsigned f2bf(float f) { unsigned u = __builtin_bit_cast(unsigned, f); return (u + 0x7fffu + ((u >> 16) & 1u)) >> 16; }
__device__ __forceinline__ unsigned pk2(float lo, float hi) { return f2bf(lo) | (f2bf(hi) << 16); }

#define XB_TMO      128
#define XB_XCNT(j)  (256  + 64 * (j))
#define XB_XSUB(j)  (1280 + 64 * (j))
#define XB_XGEN(j)  (2304 + 64 * (j))
#define XB_TOP      3328
#define XB_TOPGEN   3392
#define XCD_BAR_WORDS 3456
#define XB_SPIN_CAP (1u << 18)

__device__ __forceinline__ unsigned xb_ld(unsigned* p)              { return __hip_atomic_load(p, __ATOMIC_RELAXED, __HIP_MEMORY_SCOPE_AGENT); }
__device__ __forceinline__ unsigned xb_add(unsigned* p, unsigned v) { return __hip_atomic_fetch_add(p, v, __ATOMIC_RELAXED, __HIP_MEMORY_SCOPE_AGENT); }
__device__ __forceinline__ unsigned xb_xcc_id() { return (unsigned)__builtin_amdgcn_s_getreg((3 << 11) | 20) & 0xFu; }
#define XB_SPIN(cond, bar) do { unsigned _sp = 0; while (cond) { __builtin_amdgcn_s_sleep(1); \
    if ((++_sp & 255u) == 0u) { if (xb_ld(&(bar)[XB_TMO])) break; if (_sp > XB_SPIN_CAP) { atomicAdd(&(bar)[XB_TMO], 1u); break; } } } } while (0)

struct XcdBarrier {
    unsigned* bar; unsigned x; int wave;
    volatile LAS unsigned* st;
};

__device__ __forceinline__ XcdBarrier xcd_barrier_post(unsigned* bar, volatile LAS unsigned* st) {
    XcdBarrier b; b.bar = bar; b.x = xb_xcc_id(); b.st = st; b.wave = __builtin_amdgcn_readfirstlane((int)(threadIdx.x >> 6));
    if (threadIdx.x == 0) (void)xb_add(&bar[XB_XCNT(b.x)], 1u);
    return b;
}
__device__ __forceinline__ void xcd_barrier_complete(unsigned* bar, unsigned x, unsigned& nloc, unsigned& nx) {
    const unsigned G = gridDim.x * gridDim.y * gridDim.z;
    unsigned sum, cnt, mine, sp = 0u;
    for (;;) {
        sum = 0u; cnt = 0u; mine = 0u;
#pragma unroll
        for (unsigned j = 0; j < 16; ++j) { const unsigned c = xb_ld(&bar[XB_XCNT(j)]); sum += c; cnt += (c > 0u) ? 1u : 0u; mine = (j == x) ? c : mine; }
        if (sum == G) break;
        __builtin_amdgcn_s_sleep(1);
        if ((++sp & 255u) == 0u) { if (xb_ld(&bar[XB_TMO])) break; if (sp > XB_SPIN_CAP) { atomicAdd(&bar[XB_TMO], 1u); break; } }
    }
    nloc = mine > 0u ? mine : 1u; nx = cnt > 0u ? cnt : 1u;
}

__device__ __forceinline__ void xcd_barrier(const XcdBarrier& b) {
    asm volatile("s_waitcnt vmcnt(0)" ::: "memory");
    __syncthreads();
    int l0_; asm volatile("v_mbcnt_lo_u32_b32 %0, -1, 0\n\tv_mbcnt_hi_u32_b32 %0, -1, %0" : "=v"(l0_));
    if (b.wave == 0 && l0_ == 0) {
        unsigned* bar = b.bar;
        __builtin_amdgcn_s_waitcnt(0);
        unsigned nloc = b.st[0], nx = b.st[1];
        if (nloc == 0u) { xcd_barrier_complete(bar, b.x, nloc, nx); b.st[0] = nloc; b.st[1] = nx; }
        const unsigned old = xb_add(&bar[XB_XSUB(b.x)], 1u);
        const unsigned gen = old / nloc;
        if (old + 1u == (gen + 1u) * nloc) {
            __builtin_amdgcn_fence(__ATOMIC_RELEASE, "agent");
            asm volatile("s_waitcnt vmcnt(0)" ::: "memory");
            const unsigned og = xb_add(&bar[XB_TOP], 1u);
            const unsigned tg = og / nx;
            if (og + 1u == (tg + 1u) * nx) xb_add(&bar[XB_TOPGEN], 1u);
            else XB_SPIN(xb_ld(&bar[XB_TOPGEN]) == tg, bar);
            __builtin_amdgcn_fence(__ATOMIC_ACQUIRE, "agent");
            xb_add(&bar[XB_XGEN(b.x)], 1u);
            asm volatile("s_waitcnt vmcnt(0)" ::: "memory");
        } else {
            XB_SPIN(xb_ld(&bar[XB_XGEN(b.x)]) == gen, bar);
            __builtin_amdgcn_fence(__ATOMIC_ACQUIRE, "agent");
            asm volatile("s_waitcnt vmcnt(0)" ::: "memory");
        }
    }
    __syncthreads();
}
struct InTab { const LAS unsigned long long* t;
    __device__ __forceinline__ const float* operator[](int k) const { const unsigned long long v = t[k];
        return (const float*)(((unsigned long long)(unsigned)__builtin_amdgcn_readfirstlane((int)(v >> 32)) << 32) | (unsigned)__builtin_amdgcn_readfirstlane((int)(unsigned)v)); } };
struct Frame {
    LAS unsigned char* lds;
    volatile LAS unsigned* MISC;
    gu32* ctl;
    int wave;
    int vcu, G, bx;
    GAS unsigned char* ws;
    InTab in;
    GAS float* out;
    float ts_scale, ts_add;
};
__device__ __forceinline__ float xor_get(float v, int lane, int o) { return __builtin_bit_cast(float, __builtin_amdgcn_ds_bpermute((lane ^ o) << 2, __builtin_bit_cast(int, v))); }
__device__ __forceinline__ float half_sum(float v, int lane) {
#pragma unroll
    for (int o = 1; o < 32; o <<= 1) v += xor_get(v, lane, o);
    return v; }
__device__ __forceinline__ float wave_sum(float v, int lane) { v = half_sum(v, lane); return v + xor_get(v, lane, 32); }
__device__ __forceinline__ int launder(int v) { asm volatile("" : "+v"(v)); return v; }
__device__ __forceinline__ int fresh_lane() { int l; asm volatile("v_mbcnt_lo_u32_b32 %0, -1, 0\n\tv_mbcnt_hi_u32_b32 %0, -1, %0" : "=v"(l)); return l; }
__device__ __forceinline__ float bf_lo(unsigned u) { return __builtin_bit_cast(float, u << 16); }
__device__ __forceinline__ float bf_hi(unsigned u) { return __builtin_bit_cast(float, u & 0xffff0000u); }
#if MK_DBG
__device__ __forceinline__ void dbg_sample_f32(Frame& F, int lane, int slot, int row, const f32x4 (&v)[4]) {
    float* d = (float*)(F.ws + WS_FS) + ((size_t)slot * 1024 + (row >> 5)) * 1024;
#pragma unroll
    for (int j = 0; j < 4; ++j) ((f32x4*)d)[lane + 64 * j] = v[j];
}
#endif
__device__ __forceinline__ int swiglu_row(int n, int ff) { const int bj = n >= ff ? 1 : 0, cc = n - bj * ff; return 256 * (cc >> 7) + 128 * bj + (cc & 127); }
template <bool F8>
__device__ __forceinline__ void transpose_item(const float* W, int K, int N, void* WT, int ff, float scale, LAS float* scr, int item, int lane, const float* kg = nullptr) {
    const int nblk = N / 64, kb = item / nblk, nb = item % nblk, k0 = 64 * kb, n0 = 64 * nb;
    const int r0 = ff ? swiglu_row(n0, ff) : n0;
    float v[64];
    const GAS float* wp = (const GAS float*)W + (size_t)k0 * N + n0 + lane;
#pragma unroll
    for (int i = 0; i < 64; ++i) v[i] = wp[(size_t)i * N];
#pragma unroll
    for (int i = 0; i < 64; ++i) scr[i * 64 + (lane ^ (i & 31))] = v[i];
    LDS_WAIT(); asm volatile("" ::: "memory");
    const int c = lane & 7;
    float kgv[8];
#pragma unroll
    for (int i = 0; i < 8; ++i) kgv[i] = kg ? kg[k0 + 8 * c + i] : 1.f;
#pragma unroll
    for (int j = 0; j < 8; ++j) { const int n = (lane >> 3) + 8 * j; float s[8];
#pragma unroll
        for (int i = 0; i < 8; ++i) s[i] = scr[(8 * c + i) * 64 + (n ^ ((8 * c + i) & 31))] * kgv[i];
        if (F8) { v2u o; o.x = pg8::pk4_fp8(s[0] * scale, s[1] * scale, s[2] * scale, s[3] * scale); o.y = pg8::pk4_fp8(s[4] * scale, s[5] * scale, s[6] * scale, s[7] * scale);
            *(GAS v2u*)((unsigned char*)WT + (size_t)(r0 + n) * K + k0 + 8 * c) = o; }
        else { v4u o; o.x = pg8::cvt_pk_bf16(s[0], s[1]); o.y = pg8::cvt_pk_bf16(s[2], s[3]); o.z = pg8::cvt_pk_bf16(s[4], s[5]); o.w = pg8::cvt_pk_bf16(s[6], s[7]);
            *(GAS v4u*)((bf16*)WT + (size_t)(r0 + n) * K + k0 + 8 * c) = o; } }
    LDS_WAIT(); asm volatile("" ::: "memory");
}
__device__ __forceinline__ void rms_row_to_bf16(int lane, const float* xrow, const float* gain, bf16* orow) {
    const GAS f32x4* xr = (const GAS f32x4*)xrow + lane;
    f32x4 v[4]; float s = 0.f;
#pragma unroll
    for (int j = 0; j < 4; ++j) { v[j] = xr[64 * j]; s += (v[j].x * v[j].x + v[j].y * v[j].y) + (v[j].z * v[j].z + v[j].w * v[j].w); }
    const float rstd = 1.f / sqrtf(wave_sum(s, lane) * (1.f / D) + EPS);
    GAS unsigned long long* o8 = (GAS unsigned long long*)orow + lane;
#pragma unroll
    for (int j = 0; j < 4; ++j) { const f32x4 g = ((const GAS f32x4*)gain)[lane + 64 * j];
        o8[64 * j] = (unsigned long long)pk2(v[j].x * rstd * g.x, v[j].y * rstd * g.y) | ((unsigned long long)pk2(v[j].z * rstd * g.z, v[j].w * rstd * g.w) << 32); }
}
__device__ __forceinline__ void phase_prologue(Frame& F) {
    const int lane = fresh_lane(), tid = F.wave * 64 + lane; (void)tid;
    LAS float* scr = (LAS float*)(F.lds + RING_OFF + F.wave * 16384);
    const int gw = F.vcu * NWAVES + F.wave, NGW = F.G * NWAVES;
    constexpr int I_AIN = 16 * (AIN / 64), I_MKV = 16 * 8, I_OUT = 16 * 16, I_BIN = 16 * (BIN / 64), I_GUD = 16 * (2 * FFD / 64), I_DND = (FFD / 64) * 16, I_GUM = 16 * (2 * FFE / 64), I_DNM = (FFE / 64) * 16;
    constexpr int NITEMS = 2 * I_AIN + 4 * I_MKV + 4 * I_OUT + 2 * I_BIN + 2 * I_GUD + 2 * I_DND + 16 * I_GUM + 16 * I_DNM;
    for (int it = NITEMS - 1 - gw; it >= 0; it -= NGW) {
        int r = it; const float* src; bf16* dst; int K = D, N, ff = 0; const float* kg = nullptr;
        if (r < 2 * I_AIN) { const int j = r / I_AIN; r %= I_AIN; N = AIN; src = F.in[3] + (size_t)j * D * AIN; dst = (bf16*)(F.ws + WS_WINA) + (size_t)j * AIN * D; kg = F.in[2] + j * D; }
        else if ((r -= 2 * I_AIN) < 4 * I_MKV) { const int l = r / I_MKV; r %= I_MKV; N = 512; src = F.in[(l & 1) ? 17 : 10] + (size_t)(l >> 1) * D * 512; dst = (bf16*)(F.ws + WS_WMKV) + (size_t)l * 512 * D; }
        else if ((r -= 4 * I_MKV) < 4 * I_OUT) { const int l = r / I_OUT; r %= I_OUT; N = D; src = F.in[(l & 1) ? 18 : 11] + (size_t)(l >> 1) * D * D; dst = (bf16*)(F.ws + WS_WOUT) + (size_t)l * D * D; }
        else if ((r -= 4 * I_OUT) < 2 * I_BIN) { const int j = r / I_BIN; r %= I_BIN; N = BIN; src = F.in[13] + (size_t)j * D * BIN; dst = (bf16*)(F.ws + WS_WINB) + (size_t)j * BIN * D; kg = F.in[12] + j * D; }
        else if ((r -= 2 * I_BIN) < 2 * I_GUD) { const int j = r / I_GUD; r %= I_GUD; N = 2 * FFD; ff = FFD; src = F.in[20] + (size_t)j * D * 2 * FFD; dst = (bf16*)(F.ws + WS_WGUD) + (size_t)j * 2 * FFD * D; kg = F.in[19] + j * D; }
        else if ((r -= 2 * I_GUD) < 2 * I_DND) { const int j = r / I_DND; r %= I_DND; K = FFD; N = D; src = F.in[21] + (size_t)j * FFD * D; dst = (bf16*)(F.ws + WS_WDND) + (size_t)j * D * FFD; }
        else if ((r -= 2 * I_DND) < 16 * I_GUM) { const int j = r / I_GUM; r %= I_GUM;
            transpose_item<true>(F.in[24] + (size_t)j * D * 2 * FFE, D, 2 * FFE, (void*)(F.ws + WS_WGUM + (size_t)j * 2 * FFE * D), FFE, SC_WGU, scr, r, lane); continue; }
        else { r -= 16 * I_GUM; const int j = r / I_DNM; r %= I_DNM;
            transpose_item<true>(F.in[25] + (size_t)j * FFE * D, FFE, D, (void*)(F.ws + WS_WDNM + (size_t)j * D * FFE), 0, SC_WDN, scr, r, lane); continue; }
        transpose_item<false>(src, K, N, dst, ff, 1.f, scr, r, lane, kg);
    }
    for (int m = gw; m < 4 * NB * MEML; m += NGW) { const int l = m / (NB * MEML), r = m % (NB * MEML);
        rms_row_to_bf16(lane, F.in[1] + (size_t)r * D, F.in[(l & 1) ? 16 : 9] + (size_t)(l >> 1) * D, (bf16*)(F.ws + WS_MEMN) + (size_t)m * D); }
    {
        const float* x0 = F.in[0]; bf16* XB = (bf16*)(F.ws + WS_XN); float* SQ = (float*)(F.ws + WS_SSQP) + (size_t)4 * T * 16;
        for (int m0 = gw * 4; m0 < T; m0 += NGW * 4) { f32x4 v[4][4]; float ss[4];
#pragma unroll
            for (int r = 0; r < 4; ++r) { const GAS f32x4* xr = (const GAS f32x4*)(x0 + (size_t)(m0 + r) * D) + lane;
#pragma unroll
                for (int j = 0; j < 4; ++j) v[r][j] = xr[64 * j]; }
#pragma unroll
            for (int r = 0; r < 4; ++r) { float sq = 0.f; GAS unsigned long long* o8 = (GAS unsigned long long*)(XB + (size_t)(m0 + r) * D) + lane;
#pragma unroll
                for (int j = 0; j < 4; ++j) { sq += (v[r][j].x * v[r][j].x + v[r][j].y * v[r][j].y) + (v[r][j].z * v[r][j].z + v[r][j].w * v[r][j].w);
                    o8[64 * j] = (unsigned long long)pk2(v[r][j].x, v[r][j].y) | ((unsigned long long)pk2(v[r][j].z, v[r][j].w) << 32); }
                ss[r] = sq; }
#pragma unroll
            for (int o = 1; o < 64; o <<= 1) {
#pragma unroll
                for (int r = 0; r < 4; ++r) ss[r] += xor_get(ss[r], lane, o); }
#pragma unroll
            for (int r = 0; r < 4; ++r) if (lane < 16) SQ[(size_t)(m0 + r) * 16 + lane] = lane == 0 ? ss[r] : 0.f; }
    }
    if (F.bx == 0) { float* LBT = (float*)(F.ws + WS_ROUTE + 1024 * 1024);
        for (int i = tid; i < DAW; i += NWAVES * 64) { LBT[i] = 0.f; LBT[DAW + i] = 1.f / (1.f + __expf(F.in[14][i] - F.in[14][DAW + i])); } }
}
template <bool FINAL>
__device__ __forceinline__ void phase_combine(Frame& F, float* OUT, const float* gain, float* SQ) {
    const int lane = fresh_lane(), tid = F.wave * 64 + lane; (void)tid;
    bf16* XB = (bf16*)(F.ws + WS_XN); const bf16* Y = (const bf16*)(F.ws + WS_Y);
    const float* TOPW = (const float*)(F.ws + WS_ROUTE); const int* TOKROW = (const int*)(F.ws + WS_ROUTE + 768 * 1024);
    for (int rb = F.bx * 128; rb < T; rb += F.G * 128) {
        int ri0 = 0, ri1 = 0; float rw0 = 0.f, rw1 = 0.f;
        if (lane < 16) { const int rr = rb + F.wave * 16 + lane; ri0 = TOKROW[rr * 2]; ri1 = TOKROW[rr * 2 + 1]; rw0 = TOPW[rr * 2]; rw1 = TOPW[rr * 2 + 1]; }
        v2u xq[2][4], yq0[2][4], yq1[2][4];
#define CMB_ISSUE(B_, I_) do { const int row_ = rb + F.wave * 16 + (I_); const GAS v2u* xr_ = (const GAS v2u*)(XB + (size_t)row_ * D) + lane; \
            _Pragma("unroll") for (int j = 0; j < 4; ++j) xq[B_][j] = xr_[64 * j]; \
            const int r0_ = __builtin_amdgcn_readlane(ri0, (I_)), r1_ = __builtin_amdgcn_readlane(ri1, (I_)); \
            const GAS v2u* y0_ = (const GAS v2u*)(Y + (size_t)r0_ * D) + lane; const GAS v2u* y1_ = (const GAS v2u*)(Y + (size_t)r1_ * D) + lane; \
            _Pragma("unroll") for (int j = 0; j < 4; ++j) { yq0[B_][j] = y0_[64 * j]; yq1[B_][j] = y1_[64 * j]; } } while (0)
        CMB_ISSUE(0, 0);
        for (int i2 = 0; i2 < 16; i2 += 2) {
#pragma unroll
          for (int hb = 0; hb < 2; ++hb) {
            const int i = i2 + hb;
            if (hb == 0) CMB_ISSUE(1, i + 1); else if (i + 1 < 16) CMB_ISSUE(0, i + 1);
            const int row = rb + F.wave * 16 + i;
            const float w0 = __builtin_bit_cast(float, __builtin_amdgcn_readlane(__builtin_bit_cast(int, rw0), i)), w1 = __builtin_bit_cast(float, __builtin_amdgcn_readlane(__builtin_bit_cast(int, rw1), i));
            f32x4 v[4]; float s = 0.f;
#pragma unroll
            for (int j = 0; j < 4; ++j) { const v2u x = xq[hb][j], a = yq0[hb][j], b = yq1[hb][j];
                v[j].x = bf_lo(x.x) + w0 * bf_lo(a.x) + w1 * bf_lo(b.x); v[j].y = bf_hi(x.x) + w0 * bf_hi(a.x) + w1 * bf_hi(b.x); v[j].z = bf_lo(x.y) + w0 * bf_lo(a.y) + w1 * bf_lo(b.y); v[j].w = bf_hi(x.y) + w0 * bf_hi(a.y) + w1 * bf_hi(b.y);
                s += (v[j].x * v[j].x + v[j].y * v[j].y) + (v[j].z * v[j].z + v[j].w * v[j].w); }
            s = wave_sum(s, lane);
            if (FINAL) { const float rstd = 1.f / sqrtf(s * (1.f / D) + EPS); GAS f32x4* ow = (GAS f32x4*)(OUT + (size_t)row * D) + lane;
#pragma unroll
                for (int j = 0; j < 4; ++j) { const f32x4 g = ((const GAS f32x4*)gain)[lane + 64 * j]; ow[64 * j] = (f32x4){v[j].x * rstd * g.x, v[j].y * rstd * g.y, v[j].z * rstd * g.z, v[j].w * rstd * g.w}; }
            } else { GAS unsigned long long* o8 = (GAS unsigned long long*)(XB + (size_t)row * D) + lane;
#pragma unroll
                for (int j = 0; j < 4; ++j) o8[64 * j] = (unsigned long long)pk2(v[j].x, v[j].y) | ((unsigned long long)pk2(v[j].z, v[j].w) << 32);
                if (lane < 16) SQ[(size_t)row * 16 + lane] = lane == 0 ? s : 0.f; }
          }
        }
#undef CMB_ISSUE
    }
}
__device__ __forceinline__ void phase_router(Frame& F, const float* gain, const float* wr, gu32* gcnt) {
    const int lane = fresh_lane(), tid = F.wave * 64 + lane;
    const bf16* XB = (const bf16*)(F.ws + WS_XN); float* RS = (float*)(F.ws + WS_ROUTE + 1024 * 1024 + 8192); float* TOPW = (float*)(F.ws + WS_ROUTE); int* TOKSEL = (int*)(F.ws + WS_ROUTE + 256 * 1024);
    LAS int* cntL = (LAS int*)(F.lds + RING_OFF); LAS int* baseL = cntL + 8; LAS float* lg = (LAS float*)(cntL + 16);
    if (tid < 8) cntL[tid] = 0;
    __syncthreads();
    for (int rb = F.bx * 128; rb < T; rb += F.G * 128) {
        for (int g4 = 0; g4 < 4; ++g4) {
            const int rl0 = F.wave * 16 + 4 * g4, row0 = rb + rl0;
            f32x4 v[4][4];
#pragma unroll
            for (int r = 0; r < 4; ++r) { const GAS v2u* xr = (const GAS v2u*)(XB + (size_t)(row0 + r) * D) + lane;
#pragma unroll
                for (int j = 0; j < 4; ++j) { const v2u w = xr[64 * j]; v[r][j] = (f32x4){bf_lo(w.x), bf_hi(w.x), bf_lo(w.y), bf_hi(w.y)}; } }
            float ss[4];
#pragma unroll
            for (int r = 0; r < 4; ++r) { float s = 0.f;
#pragma unroll
                for (int j = 0; j < 4; ++j) s += (v[r][j].x * v[r][j].x + v[r][j].y * v[r][j].y) + (v[r][j].z * v[r][j].z + v[r][j].w * v[r][j].w);
                ss[r] = s; }
#pragma unroll
            for (int o = 1; o < 64; o <<= 1) {
#pragma unroll
                for (int r = 0; r < 4; ++r) ss[r] += xor_get(ss[r], lane, o); }
#pragma unroll
            for (int r = 0; r < 4; ++r) { const float rstd = 1.f / sqrtf(ss[r] * (1.f / D) + EPS);
                if (lane == 0) RS[row0 + r] = rstd;
#pragma unroll
                for (int j = 0; j < 4; ++j) { const f32x4 gg = ((const GAS f32x4*)gain)[lane + 64 * j]; v[r][j].x *= rstd * gg.x; v[r][j].y *= rstd * gg.y; v[r][j].z *= rstd * gg.z; v[r][j].w *= rstd * gg.w; } }
            float a[32];
#pragma unroll
            for (int i = 0; i < 32; ++i) a[i] = 0.f;
#pragma unroll
            for (int j = 0; j < 4; ++j) { const GAS f32x4* wp = (const GAS f32x4*)(wr + (size_t)(lane + 64 * j) * 32);
#pragma unroll
                for (int c = 0; c < 4; ++c) { const f32x4 w0 = wp[2 * c], w1 = wp[2 * c + 1];
#pragma unroll
                    for (int r = 0; r < 4; ++r) { const float xv = v[r][j][c];
                        a[r * 8 + 0] += xv * w0.x; a[r * 8 + 1] += xv * w0.y; a[r * 8 + 2] += xv * w0.z; a[r * 8 + 3] += xv * w0.w; a[r * 8 + 4] += xv * w1.x; a[r * 8 + 5] += xv * w1.y; a[r * 8 + 6] += xv * w1.z; a[r * 8 + 7] += xv * w1.w; } } }
#define RT_STEP(S_, N_) do { const bool up_ = (lane >> (S_)) & 1; _Pragma("unroll") for (int i = 0; i < (N_); ++i) { const float keep_ = up_ ? a[2 * i + 1] : a[2 * i], send_ = up_ ? a[2 * i] : a[2 * i + 1]; a[i] = keep_ + xor_get(send_, lane, 1 << (S_)); } } while (0)
            RT_STEP(0, 16); RT_STEP(1, 8); RT_STEP(2, 4); RT_STEP(3, 2); RT_STEP(4, 1);
#undef RT_STEP
            const float lgv = a[0] + xor_get(a[0], lane, 32);
            if (lane < 32) lg[(rl0 + (lane >> 3)) * 8 + (lane & 7)] = lgv;
        }
        __syncthreads();
        int e0 = 0, e1 = 0, q0 = 0, q1 = 0;
        if (tid < 128) { float av[8];
#pragma unroll
            for (int e = 0; e < 8; ++e) av[e] = lg[tid * 8 + e];
            float v0 = av[0];
#pragma unroll
            for (int e = 1; e < 8; ++e) if (av[e] > v0) { v0 = av[e]; e0 = e; }
            float v1 = -3.0e38f;
#pragma unroll
            for (int e = 0; e < 8; ++e) if (e != e0 && av[e] > v1) { v1 = av[e]; e1 = e; }
            const float p1 = __expf(v1 - v0), inv = 1.f / (1.f + p1);
            TOPW[(rb + tid) * 2] = inv; TOPW[(rb + tid) * 2 + 1] = p1 * inv;
            q0 = __hip_atomic_fetch_add(cntL + e0, 1, __ATOMIC_RELAXED, __HIP_MEMORY_SCOPE_WORKGROUP);
            q1 = __hip_atomic_fetch_add(cntL + e1, 1, __ATOMIC_RELAXED, __HIP_MEMORY_SCOPE_WORKGROUP); }
        __syncthreads();
        if (tid < 8) { baseL[tid] = (int)__hip_atomic_fetch_add(gcnt + tid, (unsigned)cntL[tid], __ATOMIC_RELAXED, __HIP_MEMORY_SCOPE_AGENT); }
        __syncthreads();
        if (tid < 128) { int4 o; o.x = e0; o.y = baseL[e0] + q0; o.z = e1; o.w = baseL[e1] + q1; *(int4*)(TOKSEL + (size_t)(rb + tid) * 4) = o; }
        __syncthreads();
        if (tid < 8) cntL[tid] = 0;
        __syncthreads();
    }
}
__device__ __forceinline__ void phase_gather(Frame& F, const gu32* gcnt, const float* gain) {
    const int lane = fresh_lane(), tid = F.wave * 64 + lane; (void)tid;
    const bf16* XB = (const bf16*)(F.ws + WS_XN); const float* RS = (const float*)(F.ws + WS_ROUTE + 1024 * 1024 + 8192); unsigned char* XG = (unsigned char*)(F.ws + WS_XG);
    const int* TOKSEL = (const int*)(F.ws + WS_ROUTE + 256 * 1024); int* TOKROW = (int*)(F.ws + WS_ROUTE + 768 * 1024);
    int rbase[8]; { int t = 0;
#pragma unroll
        for (int e = 0; e < 8; ++e) { rbase[e] = t * 256; t += (__builtin_amdgcn_readfirstlane((int)__hip_atomic_load(gcnt + e, RLX_AGENT)) + 255) >> 8; } }
    f32x4 gq[4];
#pragma unroll
    for (int i = 0; i < 4; ++i) gq[i] = ((const GAS f32x4*)gain)[4 * lane + i] * SC_X;
    const int gw = F.bx * NWAVES + F.wave, NGW = F.G * NWAVES;
    for (int row0 = gw * 4; row0 < T; row0 += NGW * 4) {
        int4 sl[4]; v4u a[4], b[4]; float rs[4];
#pragma unroll
        for (int r = 0; r < 4; ++r) { sl[r] = *(const int4*)(TOKSEL + (size_t)(row0 + r) * 4); const GAS v4u* sp = (const GAS v4u*)(XB + (size_t)(row0 + r) * D) + 2 * lane; a[r] = sp[0]; b[r] = sp[1]; rs[r] = RS[row0 + r]; }
#pragma unroll
        for (int r = 0; r < 4; ++r) { int d0 = sl[r].y, d1 = sl[r].w;
#pragma unroll
            for (int e = 0; e < 8; ++e) { if (sl[r].x == e) d0 += rbase[e]; if (sl[r].z == e) d1 += rbase[e]; }
            const float q = rs[r]; v4u o;
            o.x = pg8::pk4_fp8(bf_lo(a[r].x) * q * gq[0].x, bf_hi(a[r].x) * q * gq[0].y, bf_lo(a[r].y) * q * gq[0].z, bf_hi(a[r].y) * q * gq[0].w); o.y = pg8::pk4_fp8(bf_lo(a[r].z) * q * gq[1].x, bf_hi(a[r].z) * q * gq[1].y, bf_lo(a[r].w) * q * gq[1].z, bf_hi(a[r].w) * q * gq[1].w);
            o.z = pg8::pk4_fp8(bf_lo(b[r].x) * q * gq[2].x, bf_hi(b[r].x) * q * gq[2].y, bf_lo(b[r].y) * q * gq[2].z, bf_hi(b[r].y) * q * gq[2].w); o.w = pg8::pk4_fp8(bf_lo(b[r].z) * q * gq[3].x, bf_hi(b[r].z) * q * gq[3].y, bf_lo(b[r].w) * q * gq[3].z, bf_hi(b[r].w) * q * gq[3].w);
            ((GAS v4u*)(XG + (size_t)d0 * D))[lane] = o; ((GAS v4u*)(XG + (size_t)d1 * D))[lane] = o;
            if (lane == 0) { TOKROW[(row0 + r) * 2] = d0; TOKROW[(row0 + r) * 2 + 1] = d1; } }
    }
}
__device__ __forceinline__ void phase_knorm(Frame& F) {
    const int lane = fresh_lane();
    const bf16* P = (const bf16*)(F.ws + WS_BIG); float* N2 = (float*)(F.ws + WS_ROUTE + 1024 * 1024 + 8192);
    const int gw = F.bx * NWAVES + F.wave, NGW = F.G * NWAVES;
    for (int it = gw; it < NB * 24 * 64; it += NGW) { const int t = it & 63, hm = (it >> 6) % 24, b = it / (24 * 64);
        const GAS v4u* rp = (const GAS v4u*)(P + (size_t)(b * S + 64 * t + lane) * AIN + hm * 64); float ss = 0.f;
#pragma unroll
        for (int i = 0; i < 8; ++i) { const v4u w = rp[i]; const unsigned ww[4] = {w.x, w.y, w.z, w.w};
#pragma unroll
            for (int c = 0; c < 4; ++c) { const float a = bf_lo(ww[c]), b2 = bf_hi(ww[c]); ss += a * a + b2 * b2; } }
#pragma unroll
        for (int o = 1; o < 64; o <<= 1) ss = fmaxf(ss, xor_get(ss, lane, o));
        if (lane == 0) N2[it] = ss; }
}
__device__ __forceinline__ void phase_diff_combine(Frame& F, int j, float lam_init) {
    const int lane = fresh_lane(), tid = F.wave * 64 + lane; (void)tid;
    const bf16* O0 = (const bf16*)(F.ws + WS_BIG + 160 * MiB); const bf16* O1 = O0 + (size_t)T * DAW; bf16* OC = (bf16*)(F.ws + WS_OC);
    const float s1 = wave_sum(F.in[4][j * 64 + lane] * F.in[5][j * 64 + lane], lane), s2 = wave_sum(F.in[6][j * 64 + lane] * F.in[7][j * 64 + lane], lane);
    const float lam = __expf(s1) - __expf(s2) + lam_init;
    const f32x4 g = *(const GAS f32x4*)(F.in[8] + j * 128 + (lane & 31) * 4);
    const int gw = F.bx * NWAVES + F.wave, NGW = F.G * NWAVES;
    for (int row0 = gw * 4; row0 < T; row0 += NGW * 4) {
        v2u a[4][3], b[4][3];
#pragma unroll
        for (int r = 0; r < 4; ++r)
#pragma unroll
            for (int jj = 0; jj < 3; ++jj) { a[r][jj] = ((const GAS v2u*)(O0 + (size_t)(row0 + r) * DAW))[lane + 64 * jj]; b[r][jj] = ((const GAS v2u*)(O1 + (size_t)(row0 + r) * DAW))[lane + 64 * jj]; }
#pragma unroll
        for (int r = 0; r < 4; ++r)
#pragma unroll
            for (int jj = 0; jj < 3; ++jj) {
                f32x4 v; v.x = bf_lo(a[r][jj].x) - lam * bf_lo(b[r][jj].x); v.y = bf_hi(a[r][jj].x) - lam * bf_hi(b[r][jj].x); v.z = bf_lo(a[r][jj].y) - lam * bf_lo(b[r][jj].y); v.w = bf_hi(a[r][jj].y) - lam * bf_hi(b[r][jj].y);
                float ss = (v.x * v.x + v.y * v.y) + (v.z * v.z + v.w * v.w);
                ss = half_sum(ss, lane);
                const float rs = (1.f / sqrtf(ss * (1.f / 128.f) + EPS)) * (1.f - lam_init);
                ((GAS unsigned long long*)(OC + (size_t)(row0 + r) * D))[lane + 64 * jj] = (unsigned long long)pk2(v.x * rs * g.x, v.y * rs * g.y) | ((unsigned long long)pk2(v.z * rs * g.z, v.w * rs * g.w) << 32);
            }
    }
}
__device__ __forceinline__ void phase_hgrn_naive(Frame& F, int j) {
    const int lane = fresh_lane(), tid = F.wave * 64 + lane; (void)tid;
    const bf16* PB = (const bf16*)(F.ws + WS_BIG); const float* FZ = (const float*)(F.ws + WS_BIG + 208 * MiB); float* HO = (float*)(F.ws + WS_BIG + 304 * MiB);
    if (F.bx * 4 >= NB * 6) return;
    const int grp = tid >> 7, t128 = tid & 127, bh = F.bx * 4 + grp, b = bh / 6, h = bh % 6;
    LAS float* sq = (LAS float*)(F.lds + RING_OFF) + grp * (3 * 16 * 128); LAS float* sf = sq + 16 * 128; LAS float* sk = sf + 16 * 128;
    float lb = 0.f;
    if (j == 1) { const float l0 = F.in[14][h * 128 + t128], l1 = F.in[14][768 + h * 128 + t128]; lb = 1.f / (1.f + __expf(l0 - l1)); }
    float St[128];
#pragma unroll
    for (int k = 0; k < 128; ++k) St[k] = 0.f;
    for (int t0 = 0; t0 < S; t0 += 16) {
        __syncthreads();
        for (int jj = 0; jj < 16; ++jj) { const size_t row = (size_t)(b * S + t0 + jj);
            const float qv = bf_lo((unsigned)PB[row * BIN + h * 128 + t128]), fz = FZ[row * DAW + h * 128 + t128];
            const float f = lb + (1.f - lb) / (1.f + __expf(-fz));
            sq[jj * 128 + t128] = qv; sf[jj * 128 + t128] = f; sk[jj * 128 + t128] = 1.f - f; }
        __syncthreads();
        for (int jj = 0; jj < 16; ++jj) { const size_t row = (size_t)(b * S + t0 + jj);
            const float v = bf_lo((unsigned)PB[row * BIN + 1536 + h * 128 + t128]);
            float o = 0.f;
#pragma unroll
            for (int k = 0; k < 128; k += 4) { const f32x4 f4 = *(const LAS f32x4*)(sf + jj * 128 + k), k4 = *(const LAS f32x4*)(sk + jj * 128 + k), q4 = *(const LAS f32x4*)(sq + jj * 128 + k);
                St[k] = f4.x * St[k] + k4.x * v; o += q4.x * St[k]; St[k + 1] = f4.y * St[k + 1] + k4.y * v; o += q4.y * St[k + 1];
                St[k + 2] = f4.z * St[k + 2] + k4.z * v; o += q4.z * St[k + 2]; St[k + 3] = f4.w * St[k + 3] + k4.w * v; o += q4.w * St[k + 3]; }
            HO[row * DAW + h * 128 + t128] = o; }
    }
    __syncthreads();
}
__device__ __forceinline__ void phase_hgrn_out(Frame& F, int j) {
    const int lane = fresh_lane(), tid = F.wave * 64 + lane; (void)tid;
    const bf16* PB = (const bf16*)(F.ws + WS_BIG); const float* HO = (const float*)(F.ws + WS_BIG + 304 * MiB); bf16* OC = (bf16*)(F.ws + WS_OC);
    const f32x4 g = *(const GAS f32x4*)(F.in[15] + j * 128 + (lane & 31) * 4);
    const int gw = F.bx * NWAVES + F.wave, NGW = F.G * NWAVES;
    for (int row = gw; row < T; row += NGW) {
#pragma unroll
        for (int jj = 0; jj < 3; ++jj) {
            const f32x4 v = ((const GAS f32x4*)(HO + (size_t)row * DAW))[lane + 64 * jj];
            const v2u gt = ((const GAS v2u*)(PB + (size_t)row * BIN + 2304))[lane + 64 * jj];
            float ss = (v.x * v.x + v.y * v.y) + (v.z * v.z + v.w * v.w);
            ss = half_sum(ss, lane);
            const float rs = 1.f / sqrtf(ss * (1.f / 128.f) + EPS);
            ((GAS unsigned long long*)(OC + (size_t)row * D))[lane + 64 * jj] =
                (unsigned long long)pk2(v.x * rs * g.x * pg8::silu_f(bf_lo(gt.x)), v.y * rs * g.y * pg8::silu_f(bf_hi(gt.x))) | ((unsigned long long)pk2(v.z * rs * g.z * pg8::silu_f(bf_lo(gt.y)), v.w * rs * g.w * pg8::silu_f(bf_hi(gt.y))) << 32);
        }
    }
}
constexpr int HG_LD = 136, HG_LS = 72;
constexpr int HL_QB = 0, HL_QT = 17408, HL_K = 34816, HL_VT = 78336, HL_PM = 96768, HL_TOT = 105984, HL_SSQ = 110080;
constexpr size_t WS_DCH = WS_SIN + 96 * MiB;
typedef short hbf16x8 __attribute__((ext_vector_type(8)));
typedef float hf32x2 __attribute__((ext_vector_type(2)));
__device__ __forceinline__ hbf16x8 lds8(const LAS unsigned short* p) { return *(const LAS hbf16x8*)p; }
__device__ __forceinline__ float ex2(float v) { return __builtin_amdgcn_exp2f(v); }
template <int PASS>
__device__ __forceinline__ void hgrn_load(Frame& F, int tid, int unit, hf32x2 (&lf)[8], unsigned (&qw)[8], v4u& va, v4u& vb) {
    const bf16* PB = (const bf16*)(F.ws + WS_BIG); const float* LF = (const float*)(F.ws + WS_BIG + 208 * MiB);
    const int kp = tid & 63, wave = __builtin_amdgcn_readfirstlane(tid >> 6), I = wave & 3, hf = wave >> 2, r0 = 16 * I + 8 * hf;
    const int bh = unit >> 6, c = unit & 63, b = bh / 6, h = bh % 6;
    const size_t tok0 = (size_t)b * S + c * 64;
#pragma unroll
    for (int jj = 0; jj < 8; ++jj) lf[jj] = *(const GAS hf32x2*)(LF + (tok0 + r0 + jj) * DAW + h * 128 + 2 * kp);
    if (PASS == 3) {
#pragma unroll
        for (int jj = 0; jj < 8; ++jj) qw[jj] = *(const GAS unsigned*)(PB + (tok0 + r0 + jj) * BIN + h * 128 + 2 * kp); }
    { const int sp = tid >> 4, e8 = (tid & 15) * 8; va = *(const GAS v4u*)(PB + (tok0 + 2 * sp) * BIN + 1536 + h * 128 + e8); vb = *(const GAS v4u*)(PB + (tok0 + 2 * sp + 1) * BIN + 1536 + h * 128 + e8); }
}
template <int PASS>
__device__ __forceinline__ void hgrn_unit(Frame& F, int tid, int unit, int nunit, int j, hf32x2 (&lf)[8], unsigned (&qw)[8], v4u& va, v4u& vb) {
    const bf16* PB = (const bf16*)(F.ws + WS_BIG); const float* LF = (const float*)(F.ws + WS_BIG + 208 * MiB);
    bf16* SLOC = (bf16*)(F.ws + WS_SLOC); const bf16* SIN = (const bf16*)(F.ws + WS_SIN); float* DCH = (float*)(F.ws + WS_DCH); bf16* OC = (bf16*)(F.ws + WS_OC);
    LAS unsigned short* QB = (LAS unsigned short*)(F.lds + HL_QB); LAS unsigned short* QT = (LAS unsigned short*)(F.lds + HL_QT); LAS unsigned short* KK = (LAS unsigned short*)(F.lds + HL_K);
    LAS unsigned short* VT = (LAS unsigned short*)(F.lds + HL_VT); LAS unsigned short* PM = (LAS unsigned short*)(F.lds + HL_PM); LAS float* TOT = (LAS float*)(F.lds + HL_TOT); LAS float* SSQ = (LAS float*)(F.lds + HL_SSQ);
    const int kp = tid & 63, lane = kp, wave = __builtin_amdgcn_readfirstlane(tid >> 6), I = wave & 3, hf = wave >> 2, sub = 2 * I + hf, r0 = 16 * I + 8 * hf, fr = lane & 15, fg = lane >> 4;
    const int bh = unit >> 6, c = unit & 63, b = bh / 6, h = bh % 6;
    const size_t tok0 = (size_t)b * S + c * 64;
    { const int sp = tid >> 4, e8 = (tid & 15) * 8; const v4u a = va, b2 = vb;
        const unsigned wa[4] = {a.x, a.y, a.z, a.w}, wb[4] = {b2.x, b2.y, b2.z, b2.w};
#pragma unroll
        for (int i = 0; i < 4; ++i) { *(LAS unsigned*)(VT + (e8 + 2 * i) * HG_LS + 2 * sp) = (wa[i] & 0xffffu) | (wb[i] << 16); *(LAS unsigned*)(VT + (e8 + 2 * i + 1) * HG_LS + 2 * sp) = (wa[i] >> 16) | (wb[i] & 0xffff0000u); } }
    hf32x2 cs[8]; { hf32x2 run = {0.f, 0.f};
#pragma unroll
        for (int jj = 0; jj < 8; ++jj) { run += lf[jj]; cs[jj] = run; } }
    *(LAS hf32x2*)(TOT + sub * 128 + 2 * kp) = cs[7];
    __syncthreads();
    hf32x2 rho = {0.f, 0.f}, presub = {0.f, 0.f}, blast = {0.f, 0.f};
#pragma unroll
    for (int s2 = 0; s2 < 8; ++s2) { const hf32x2 t = *(const LAS hf32x2*)(TOT + s2 * 128 + 2 * kp); if (s2 < 2 * I) rho += t; if (s2 < sub) presub += t; blast += t; }
    const hf32x2 off = presub - rho;
    if (PASS == 1) {
        unsigned w0[4], w1[4];
#pragma unroll
        for (int i = 0; i < 4; ++i) { const hf32x2 ba = rho + off + cs[2 * i], bb = rho + off + cs[2 * i + 1];
            w0[i] = pg8::cvt_pk_bf16((1.f - ex2(lf[2 * i].x)) * ex2(blast.x - ba.x), (1.f - ex2(lf[2 * i + 1].x)) * ex2(blast.x - bb.x));
            w1[i] = pg8::cvt_pk_bf16((1.f - ex2(lf[2 * i].y)) * ex2(blast.y - ba.y), (1.f - ex2(lf[2 * i + 1].y)) * ex2(blast.y - bb.y)); }
        *(LAS v4u*)(KK + (2 * kp) * HG_LS + r0) = (v4u){w0[0], w0[1], w0[2], w0[3]}; *(LAS v4u*)(KK + (2 * kp + 1) * HG_LS + r0) = (v4u){w1[0], w1[1], w1[2], w1[3]};
        if (sub == 0) *(GAS hf32x2*)(DCH + (size_t)unit * 128 + 2 * kp) = (hf32x2){ex2(blast.x), ex2(blast.y)};
        __syncthreads();
        if (nunit >= 0) hgrn_load<PASS>(F, tid, nunit, lf, qw, va, vb);
        const hbf16x8 a0 = lds8(KK + (16 * wave + fr) * HG_LS + 8 * fg), a1 = lds8(KK + (16 * wave + fr) * HG_LS + 32 + 8 * fg);
#pragma unroll
        for (int et = 0; et < 8; ++et) { const hbf16x8 b0 = lds8(VT + (16 * et + fr) * HG_LS + 8 * fg), b1 = lds8(VT + (16 * et + fr) * HG_LS + 32 + 8 * fg);
            f32x4 d = {0.f, 0.f, 0.f, 0.f}; d = __builtin_amdgcn_mfma_f32_16x16x32_bf16(a0, b0, d, 0, 0, 0); d = __builtin_amdgcn_mfma_f32_16x16x32_bf16(a1, b1, d, 0, 0, 0);
            v2u w2; w2.x = pk2(d[0], d[1]); w2.y = pk2(d[2], d[3]);
            *(GAS v2u*)(SLOC + ((size_t)unit * 128 + 16 * et + fr) * 128 + 16 * wave + 4 * fg) = w2; }
        __syncthreads();
    } else {
        const hf32x2 er = {ex2(rho.x), ex2(rho.y)};
        hf32x2 base[8];
#pragma unroll
        for (int jj = 0; jj < 8; ++jj) { const hf32x2 bl = off + cs[jj]; const hf32x2 e = {ex2(bl.x), ex2(bl.y)}; const hf32x2 q = {bf_lo(qw[jj]), bf_hi(qw[jj])}; const hf32x2 qt = q * e, qb = qt * er;
            *(LAS unsigned*)(QT + (r0 + jj) * HG_LD + 2 * kp) = pg8::cvt_pk_bf16(qt.x, qt.y); *(LAS unsigned*)(QB + (r0 + jj) * HG_LD + 2 * kp) = pg8::cvt_pk_bf16(qb.x, qb.y);
            base[jj] = (hf32x2){(1.f - ex2(lf[jj].x)) * ex2(-bl.x), (1.f - ex2(lf[jj].y)) * ex2(-bl.y)}; }
        hf32x2 rr = {0.f, 0.f};
        for (int Ip = I; Ip < 4; ++Ip) { LAS unsigned short* Kp = KK + (8 * Ip * (Ip + 1)) * HG_LD;
            const hf32x2 sc = {ex2(rr.x), ex2(rr.y)};
#pragma unroll
            for (int jj = 0; jj < 8; ++jj) { const hf32x2 kv = base[jj] * sc; *(LAS unsigned*)(Kp + (r0 + jj) * HG_LD + 2 * kp) = pg8::cvt_pk_bf16(kv.x, kv.y); }
            rr += *(const LAS hf32x2*)(TOT + (2 * Ip) * 128 + 2 * kp) + *(const LAS hf32x2*)(TOT + (2 * Ip + 1) * 128 + 2 * kp); }
        __syncthreads();
        const int tt = wave & 3, eh = wave >> 2; const size_t tok = tok0 + 16 * tt + fr;
        hbf16x8 sfr[4][4]; v2u gtv[4];
#pragma unroll
        for (int et = 0; et < 4; ++et) { const int e0 = 64 * eh + 16 * et; const GAS hbf16x8* sp = (const GAS hbf16x8*)(SIN + ((size_t)unit * 128 + e0 + fr) * 128 + 8 * fg);
#pragma unroll
            for (int ks = 0; ks < 4; ++ks) sfr[et][ks] = sp[4 * ks];
            gtv[et] = *(const GAS v2u*)(PB + tok * BIN + 2304 + h * 128 + e0 + 4 * fg); }
        if (nunit >= 0) hgrn_load<PASS>(F, tid, nunit, lf, qw, va, vb);
        { const int It = wave >> 1; const LAS unsigned short* Kp = KK + (8 * It * (It + 1)) * HG_LD;
#pragma unroll
            for (int jt = 0; jt < 2; ++jt) { const int J = 2 * (wave & 1) + jt; f32x4 d = {0.f, 0.f, 0.f, 0.f};
                if (J <= It) {
#pragma unroll
                    for (int ks = 0; ks < 4; ++ks) d = __builtin_amdgcn_mfma_f32_16x16x32_bf16(lds8(QT + (16 * It + fr) * HG_LD + 32 * ks + 8 * fg), lds8(Kp + (16 * J + fr) * HG_LD + 32 * ks + 8 * fg), d, 0, 0, 0);
                    if (J == It) {
#pragma unroll
                        for (int i = 0; i < 4; ++i) if (fr > 4 * fg + i) d[i] = 0.f; }
                }
#pragma unroll
                for (int i = 0; i < 4; ++i) PM[(16 * It + 4 * fg + i) * HG_LS + 16 * J + fr] = (unsigned short)f2bf(d[i]); } }
        __syncthreads();
        f32x4 o[4];
        const hbf16x8 p0 = lds8(PM + (16 * tt + fr) * HG_LS + 8 * fg), p1 = lds8(PM + (16 * tt + fr) * HG_LS + 32 + 8 * fg);
        hbf16x8 qb[4];
#pragma unroll
        for (int ks = 0; ks < 4; ++ks) qb[ks] = lds8(QB + (16 * tt + fr) * HG_LD + 32 * ks + 8 * fg);
        float ss = 0.f;
#pragma unroll
        for (int et = 0; et < 4; ++et) { const int e0 = 64 * eh + 16 * et; f32x4 d = {0.f, 0.f, 0.f, 0.f};
            d = __builtin_amdgcn_mfma_f32_16x16x32_bf16(lds8(VT + (e0 + fr) * HG_LS + 8 * fg), p0, d, 0, 0, 0);
            d = __builtin_amdgcn_mfma_f32_16x16x32_bf16(lds8(VT + (e0 + fr) * HG_LS + 32 + 8 * fg), p1, d, 0, 0, 0);
#pragma unroll
            for (int ks = 0; ks < 4; ++ks) d = __builtin_amdgcn_mfma_f32_16x16x32_bf16(sfr[et][ks], qb[ks], d, 0, 0, 0);
            o[et] = d; ss += (d[0] * d[0] + d[1] * d[1]) + (d[2] * d[2] + d[3] * d[3]); }
        ss += xor_get(ss, lane, 16); ss += xor_get(ss, lane, 32);
        if (fg == 0) SSQ[(tt * 2 + eh) * 16 + fr] = ss;
        __syncthreads();
        const float rs = 1.f / sqrtf((SSQ[(tt * 2) * 16 + fr] + SSQ[(tt * 2 + 1) * 16 + fr]) * (1.f / 128.f) + EPS);
#pragma unroll
        for (int et = 0; et < 4; ++et) { const int e = 64 * eh + 16 * et + 4 * fg;
            const f32x4 gn = *(const GAS f32x4*)(F.in[15] + j * 128 + e); const v2u gt = gtv[et];
            v2u w; w.x = pg8::cvt_pk_bf16(o[et][0] * rs * gn.x * pg8::silu_f(bf_lo(gt.x)), o[et][1] * rs * gn.y * pg8::silu_f(bf_hi(gt.x))); w.y = pg8::cvt_pk_bf16(o[et][2] * rs * gn.z * pg8::silu_f(bf_lo(gt.y)), o[et][3] * rs * gn.w * pg8::silu_f(bf_hi(gt.y)));
            *(GAS v2u*)(OC + tok * D + h * 128 + e) = w; }
        __syncthreads();
    }
}
template <int PASS> __device__ __forceinline__ void phase_hgrn(Frame& F, int j) {
    const int tid = F.wave * 64 + fresh_lane();
    hf32x2 lf[8]; unsigned qw[8]; v4u va, vb;
#pragma unroll
    for (int i = 0; i < 8; ++i) qw[i] = 0u;
    if (F.bx < NB * 6 * 64) hgrn_load<PASS>(F, tid, F.bx, lf, qw, va, vb);
    for (int u = F.bx; u < NB * 6 * 64; u += F.G) hgrn_unit<PASS>(F, tid, u, (u + F.G < NB * 6 * 64) ? u + F.G : -1, j, lf, qw, va, vb);
}
__device__ __forceinline__ void phase_hgrn_scan(Frame& F) {
    const bf16* SLOC = (const bf16*)(F.ws + WS_SLOC); bf16* SIN = (bf16*)(F.ws + WS_SIN); const float* DCH = (const float*)(F.ws + WS_DCH);
    const int tid = F.wave * 64 + fresh_lane();
    for (int id = F.bx * (NWAVES * 64) + tid; id < NB * 6 * 128 * 16; id += F.G * NWAVES * 64) {
        const int k8 = id & 15, e = (id >> 4) & 127, bh = id >> 11;
        const GAS v4u* sl = (const GAS v4u*)(SLOC + ((size_t)bh * 64 * 128 + e) * 128) + k8; const GAS f32x4* dc = (const GAS f32x4*)(DCH + (size_t)bh * 64 * 128) + 2 * k8;
        GAS v4u* so = (GAS v4u*)(SIN + ((size_t)bh * 64 * 128 + e) * 128) + k8;
        float st[8];
#pragma unroll
        for (int i = 0; i < 8; ++i) st[i] = 0.f;
#pragma unroll 8
        for (int c = 0; c < 64; ++c) { const v4u aw = sl[(size_t)c * 128 * 16]; const f32x4 d0 = dc[(size_t)c * 32], d1 = dc[(size_t)c * 32 + 1];
            v4u w; w.x = pg8::cvt_pk_bf16(st[0], st[1]); w.y = pg8::cvt_pk_bf16(st[2], st[3]); w.z = pg8::cvt_pk_bf16(st[4], st[5]); w.w = pg8::cvt_pk_bf16(st[6], st[7]); so[(size_t)c * 128 * 16] = w;
            st[0] = d0.x * st[0] + bf_lo(aw.x); st[1] = d0.y * st[1] + bf_hi(aw.x); st[2] = d0.z * st[2] + bf_lo(aw.y); st[3] = d0.w * st[3] + bf_hi(aw.y);
            st[4] = d1.x * st[4] + bf_lo(aw.z); st[5] = d1.y * st[5] + bf_hi(aw.z); st[6] = d1.z * st[6] + bf_lo(aw.w); st[7] = d1.w * st[7] + bf_hi(aw.w); }
    }
}
struct Args { const float* in[27]; float* out; unsigned char* ws; };
__global__ void __launch_bounds__(NWAVES * 64, 2) mk_fwd(Args) {
    extern __shared__ __attribute__((aligned(16))) unsigned char lds[];
    Frame F;
    F.lds = (LAS unsigned char*)lds;
    F.MISC = (volatile LAS unsigned*)(F.lds + MISC_OFF);
    F.wave = __builtin_amdgcn_readfirstlane((int)(threadIdx.x >> 6));
    F.G = gridDim.x; F.bx = blockIdx.x; { const int bx = blockIdx.x; F.vcu = (F.G % 8 == 0) ? (bx % 8) * (F.G / 8) + bx / 8 : bx; }
    for (int u = threadIdx.x; u < (LDS_BYTES - LDSCTL_OFF) / 4; u += NWAVES * 64) ((LAS unsigned*)(F.lds + LDSCTL_OFF))[u] = 0u;
    __syncthreads();
    {
        LAS unsigned long long* tab = (LAS unsigned long long*)(F.lds + LDSCTL_OFF);
        if (threadIdx.x < 29) tab[threadIdx.x] = ((const unsigned long long*)__builtin_amdgcn_kernarg_segment_ptr())[threadIdx.x];
        __syncthreads();
        F.in.t = tab; F.out = (GAS float*)(unsigned long long)F.in[27]; F.ws = (GAS unsigned char*)(unsigned long long)F.in[28]; }
    F.ctl = (gu32*)(F.ws + WS_CTL);
    XcdBarrier bar = xcd_barrier_post((unsigned*)(F.ctl + CW_BAR), F.MISC + 8);
#define XBAR_() do { XcdBarrier b_ = bar; { unsigned long long p_ = (unsigned long long)b_.bar; asm volatile("" : "+s"(p_), "+s"(b_.x)); b_.bar = (unsigned*)(GAS unsigned*)p_; } xcd_barrier(b_); if (MK_DUP & 0x8000) xcd_barrier(b_); } while (0)
#define GRID_BAR() XBAR_()
#define REP(cat) for (int rep_ = 0; rep_ < (((MK_DUP >> (cat)) & 1) ? 2 : 1); ++rep_)
#if MK_TS
    unsigned long long ts_last = rt(); unsigned ts_cat[15], ts_wb[14];
#pragma unroll
    for (int i = 0; i < 15; ++i) ts_cat[i] = 0u;
#pragma unroll
    for (int i = 0; i < 14; ++i) ts_wb[i] = 0u;
#define GRID_BAR_T(c) do { const unsigned long long arr_ = rt(); XBAR_(); const unsigned long long now_ = rt(); const unsigned dt_ = (unsigned)(arr_ - ts_last), db_ = (unsigned)(now_ - arr_); ts_last = now_; const int cc_ = (c); \
    _Pragma("unroll") for (int i_ = 0; i_ < 14; ++i_) { ts_cat[i_] += (cc_ == i_) ? dt_ : 0u; ts_wb[i_] += (cc_ == i_) ? db_ : 0u; } ts_cat[14] += db_; } while (0)
#else
#define GRID_BAR_T(c) XBAR_()
#endif

    REP(0) phase_prologue(F);
    GRID_BAR_T(0);
    {
        struct MkvOrder { int G, c; __device__ bool next(int i, pg8::Unit& u) const { const int L = i * G + c; if (L >= 64) return false; u.pm = L >> 1; u.pn = L & 1; u.pb = (u.pm >> 3) * 2 + u.pn; return true; }
            __device__ __forceinline__ void a_ready(const pg8::Unit&) const {} __device__ __forceinline__ void done(const pg8::Unit&) const {} } So{F.G, F.bx};
        pg8::Gemm g{(const pg8::bf16_t*)(F.ws + WS_MEMN), (const pg8::bf16_t*)(F.ws + WS_WMKV), 4 * NB * MEML, 512, D};
        pg8::EpiProj E{(pg8::bf16_t*)(F.ws + WS_MKV), 512, 0u, 1.f, 0, 0, nullptr, 0, nullptr, nullptr, nullptr};
        pg8::gemm_phase<pg8::EpiProj, MkvOrder, true, true>(F.lds + RING_OFF, g, So, E, F.wave);
    }
    for (int l = 0; l < 4; ++l) {
        const int j = l >> 1; const bool isA = (l & 1) == 0;
        {
            unsigned long long w_ = (unsigned long long)F.ws, o_ = (unsigned long long)F.out, c_ = (unsigned long long)F.ctl, b_ = (unsigned long long)bar.bar;
            asm volatile("" : "+s"(w_), "+s"(o_), "+s"(c_), "+s"(b_)); F.ws = (GAS unsigned char*)w_; F.out = (GAS float*)o_; F.ctl = (gu32*)c_; bar.bar = (unsigned*)b_;
            asm volatile("" : "+s"(F.vcu), "+s"(F.G), "+s"(F.bx), "+s"(F.wave)); }
        bf16* const XN = (bf16*)(F.ws + WS_XN); bf16* const OC = (bf16*)(F.ws + WS_OC);
        if (isA) {
            pg8::Gemm g{XN, (const pg8::bf16_t*)(F.ws + WS_WINA) + (size_t)j * AIN * D, T, AIN, D}; pg8::StaticOrder So; So.init(T, AIN, F.G, F.bx);
            pg8::EpiProj E{(pg8::bf16_t*)(F.ws + WS_BIG), AIN, 0x207u, C2, 0, 0, nullptr, 0, nullptr, (const float*)(F.ws + WS_SSQP) + (size_t)(4 + j) * T * 16, (unsigned*)(F.ctl + CW_N2) + j * (NB * 24 * 64 * 2)};
            REP(1) pg8::gemm_phase<pg8::EpiProj, pg8::StaticOrder, true, true>(F.lds + RING_OFF, g, So, E, F.wave);
        } else {
            pg8::Gemm g{XN, (const pg8::bf16_t*)(F.ws + WS_WINB) + (size_t)j * BIN * D, T, BIN, D}; pg8::StaticOrder So; So.init(T, BIN, F.G, F.bx);
            pg8::EpiProj E{(pg8::bf16_t*)(F.ws + WS_BIG), BIN, 0x1000u, C2, 3, 6, (float*)(F.ws + WS_BIG + 208 * MiB), DAW, (const float*)(F.ws + WS_ROUTE + 1024 * 1024) + j * DAW, (const float*)(F.ws + WS_SSQP) + (size_t)(2 * j + 1) * T * 16, nullptr};
            REP(1) pg8::gemm_phase<pg8::EpiProj, pg8::StaticOrder, true, true>(F.lds + RING_OFF, g, So, E, F.wave);
        }
        GRID_BAR_T(1);
        const int ldp = isA ? AIN : BIN, qmoff = isA ? 2304 : 3072;
        if (isA) {
            const attn_body::bf16* P = (const attn_body::bf16*)(F.ws + WS_BIG); attn_body::bf16* O01 = (attn_body::bf16*)(F.ws + WS_BIG + 160 * MiB);
            const GAS float* N2 = (const GAS float*)(F.ctl + CW_N2) + j * (NB * 24 * 64 * 2); const int lane_n = fresh_lane();
            const bool tabdeal = (F.G == 256);
            static_assert(attn_body::LDS2_BYTES <= RING_BYTES, "attention LDS");
            REP(2) for (int u_ = F.vcu; u_ < NB * 2 * 96; u_ += F.G) {
                int b, m, h, qb; if (tabdeal) { const int e = ATT_DEAL[u_ & 15][u_ >> 8]; b = (u_ >> 5) & 7; m = (u_ >> 4) & 1; h = e >> 4; qb = e & 15; } else { b = u_ / 192; m = (u_ / 96) & 1; h = (u_ % 96) >> 4; qb = u_ & 15; }
                const float nsl2 = -1.4426950408889634f * exp2f(-8.f * (float)(h + 1) / 6.f);
                const attn_body::bf16* Kh = P + (size_t)b * S * AIN + 768 + h * 128 + m * 64; const attn_body::bf16* Vh = P + (size_t)b * S * AIN + 1536 + h * 128;
                { const int NT = 4 * qb + 4;
                    typedef float f32x2n __attribute__((ext_vector_type(2)));
                    const f32x2n qn2 = *(const GAS f32x2n*)(N2 + ((b * 24 + h * 2 + m) * 64 + lane_n) * 2), kn2 = *(const GAS f32x2n*)(N2 + ((b * 24 + 12 + h * 2 + m) * 64 + lane_n) * 2);
                    const bool qin = (lane_n >= 4 * qb && lane_n < 4 * qb + 4), kin = (lane_n < NT);
                    float qa = qin ? qn2.x : 0.f, qb2 = qin ? qn2.y : 0.f, ka = kin ? kn2.x : 0.f, kb = kin ? kn2.y : 0.f;
#pragma unroll
                    for (int o = 1; o < 64; o <<= 1) { qa = fmaxf(qa, xor_get(qa, lane_n, o)); qb2 = fmaxf(qb2, xor_get(qb2, lane_n, o)); ka = fmaxf(ka, xor_get(ka, lane_n, o)); kb = fmaxf(kb, xor_get(kb, lane_n, o)); }
                    const float dreq = (160.f + 2.f * (sqrtf(qa * ka) + sqrtf(qb2 * kb)) * 1.02f) / (-nsl2);
                    int tskip = (int)floorf(((float)(qb * 256 - 63) - dreq) * (1.f / 64.f)); tskip = tskip < 0 ? 0 : tskip; tskip &= ~1; tskip = tskip > NT - 4 ? NT - 4 : tskip;
                    tskip = __builtin_amdgcn_readfirstlane(tskip);
                    attn_body::attn_unit2<8>(P + (size_t)(b * S + qb * 256) * AIN + h * 128 + m * 64, AIN, Kh + (size_t)tskip * 64 * AIN, AIN, Vh + (size_t)tskip * 64 * AIN, AIN,
                                             O01 + (size_t)m * T * DAW + (size_t)(b * S + qb * 256) * DAW + h * 128, DAW, NT - tskip, qb * 256 - 64 * tskip, nsl2, (char*)lds + RING_OFF, F.wave); }
            }
        } else {
            REP(3) phase_hgrn<1>(F, j);
        }
        {
            const attn_body::bf16* P = (const attn_body::bf16*)(F.ws + WS_BIG); const attn_body::bf16* KV = (const attn_body::bf16*)(F.ws + WS_MKV) + (size_t)l * NB * MEML * 512;
#ifndef NO_ATTN1
            REP(13) for (int u = F.vcu; u < NB * 4 * 16; u += F.G) { const int qb = u & 15, hm = (u >> 4) & 3, b = u >> 6;
                attn_body::attn_unit<1, 8>(P + (size_t)(b * S + qb * 256) * ldp + qmoff + hm * 64, ldp, KV + (size_t)b * MEML * 512 + hm * 64, 512, KV + (size_t)b * MEML * 512 + 256 + hm * 64, 512,
                                           (attn_body::bf16*)OC + (size_t)(b * S + qb * 256) * D + DAW + hm * 64, D, 4, 0, 0.f, (char*)lds + RING_OFF, F.wave); }
#endif
        }
        GRID_BAR_T(isA ? 2 : 3);
        if (isA) { REP(5) phase_diff_combine(F, j, l == 0 ? 0.2f : (float)(0.8 - 0.6 * 0.5488116360940264)); }
        else { REP(14) phase_hgrn_scan(F); GRID_BAR_T(4); REP(4) phase_hgrn<3>(F, j); }
        GRID_BAR_T(isA ? 5 : 4);
#if MK_DBG
        {
            const int lane = fresh_lane(); const int gw = F.bx * NWAVES + F.wave, NGW = F.G * NWAVES;
            for (int r = gw; r < 1024; r += NGW) { f32x4 v[4];
#pragma unroll
                for (int jj = 0; jj < 4; ++jj) { const v2u a = ((const GAS v2u*)(OC + (size_t)(r * 32) * D))[lane + 64 * jj]; v[jj].x = bf_lo(a.x); v[jj].y = bf_hi(a.x); v[jj].z = bf_lo(a.y); v[jj].w = bf_hi(a.y); }
                dbg_sample_f32(F, lane, 8 + l, r * 32, v); }
        }
#endif
        {
            pg8::Gemm g{OC, (const pg8::bf16_t*)(F.ws + WS_WOUT) + (size_t)l * D * D, T, D, D}; pg8::StaticOrder So; So.init(T, D, F.G, F.bx);
            pg8::EpiResid E{XN, D, isA ? (float*)(F.ws + WS_SSQP) + (size_t)(2 * j) * T * 16 : nullptr, 1.f};
            pg8::gemm_phase<pg8::EpiResid, pg8::StaticOrder, true, true>(F.lds + RING_OFF, g, So, E, F.wave);
        }
        GRID_BAR_T(6);
        if (isA) {
            {
                pg8::Gemm g{XN, (const pg8::bf16_t*)(F.ws + WS_WGUD) + (size_t)j * 2 * FFD * D, T, 2 * FFD, D}; pg8::StaticOrder So; So.init(T, 2 * FFD, F.G, F.bx);
                pg8::EpiSwiglu<false> E{(pg8::bf16_t*)(F.ws + WS_BIG), FFD, 1.f, 1.f, (const float*)(F.ws + WS_SSQP) + (size_t)(2 * j) * T * 16};
                REP(7) pg8::gemm_phase<pg8::EpiSwiglu<false>, pg8::StaticOrder, true, true>(F.lds + RING_OFF, g, So, E, F.wave);
            }
            GRID_BAR_T(7);
            {
                pg8::Gemm g{(const pg8::bf16_t*)(F.ws + WS_BIG), (const pg8::bf16_t*)(F.ws + WS_WDND) + (size_t)j * D * FFD, T, D, FFD}; pg8::StaticOrder So; So.init(T, D, F.G, F.bx);
                pg8::EpiResid E{XN, D, (float*)(F.ws + WS_SSQP) + (size_t)(2 * j + 1) * T * 16, 1.f};
                pg8::gemm_phase<pg8::EpiResid, pg8::StaticOrder, true, true>(F.lds + RING_OFF, g, So, E, F.wave);
            }
            GRID_BAR_T(8);

        } else {
            gu32* gcnt = F.ctl + CW_GCNT + 64 * j;
#ifndef NO_NORM
            phase_router(F, F.in[22] + j * D, F.in[23] + (size_t)j * D * 8, gcnt);
#endif
            GRID_BAR_T(9);
            phase_gather(F, gcnt, F.in[22] + j * D);
            GRID_BAR_T(10);
            {
                int cnt[8];
#pragma unroll
                for (int e = 0; e < 8; ++e) cnt[e] = __builtin_amdgcn_readfirstlane((int)__hip_atomic_load(gcnt + e, RLX_AGENT));
                pg8::Gemm g{(const pg8::bf16_t*)(F.ws + WS_XG), (const pg8::bf16_t*)(F.ws + WS_WGUM + (size_t)j * NE * 2 * FFE * D), MAXROWS, 2 * FFE, D / 2}; pg8::MoeOrder So; So.init(cnt, 2 * FFE / 256, F.G, F.bx);
                pg8::EpiSwiglu<true> E{(pg8::bf16_t*)(F.ws + WS_BIG), FFE, 1.f / (SC_X * SC_WGU), SC_H, nullptr};
                REP(11) pg8::gemm_phase<pg8::EpiSwiglu<true>, pg8::MoeOrder, true, true, true>(F.lds + RING_OFF, g, So, E, F.wave);
            }
            GRID_BAR_T(11);
            {
                int cnt[8];
#pragma unroll
                for (int e = 0; e < 8; ++e) cnt[e] = __builtin_amdgcn_readfirstlane((int)__hip_atomic_load(gcnt + e, RLX_AGENT));
                pg8::Gemm g{(const pg8::bf16_t*)(F.ws + WS_BIG), (const pg8::bf16_t*)(F.ws + WS_WDNM + (size_t)j * NE * D * FFE), MAXROWS, D, FFE / 2}; pg8::MoeOrder So; So.init(cnt, D / 256, F.G, F.bx);
                pg8::EpiProj E{(pg8::bf16_t*)(F.ws + WS_Y), D, 0xffffffffu, 1.f / (SC_H * SC_WDN), 0, 0, nullptr, 0, nullptr, nullptr, nullptr};
                REP(12) pg8::gemm_phase<pg8::EpiProj, pg8::MoeOrder, true, true, true>(F.lds + RING_OFF, g, So, E, F.wave);
            }
            GRID_BAR_T(12);
            if (l == 1) { phase_combine<false>(F, nullptr, nullptr, (float*)(F.ws + WS_SSQP) + (size_t)5 * T * 16); GRID_BAR_T(9); }
            else {
                phase_combine<true>(F, (float*)F.out, F.in[26], nullptr);
#if MK_TS
                if (F.bx == 0 && F.wave == 0) { unsigned ta = 0u;
#pragma unroll
                    for (int i = 0; i < 15; ++i) if ((MK_TS_A >> i) & 1) ta += ts_cat[i];
#pragma unroll
                    for (int i = 0; i < 14; ++i) if ((MK_TS_B >> i) & 1) ta += ts_wb[i];
                    const unsigned long long t0_ = rt(); while ((unsigned)(rt() - t0_) < ta) __builtin_amdgcn_s_sleep(8); }
#endif
            }
        }
    }
#undef GRID_BAR
}

static int mk_launch(void* const* d_in, void* d_out, void* d_ws, size_t ws_size, hipStream_t stream) {
    static int grid = 0;
    if (grid == 0) {
        if (ws_size < WS_END) { fprintf(stderr, "kernel_launch: workspace too small (%zu < %zu)\n", ws_size, (size_t)WS_END); grid = -1; return -1; }
        int dev = 0, cus = 0, per_cu = 0;
        if (hipGetDevice(&dev) != hipSuccess || hipDeviceGetAttribute(&cus, hipDeviceAttributeMultiprocessorCount, dev) != hipSuccess) { grid = -1; return -1; }
        if (hipFuncSetAttribute((const void*)mk_fwd, hipFuncAttributeMaxDynamicSharedMemorySize, LDS_BYTES) != hipSuccess) { fprintf(stderr, "kernel_launch: hipFuncSetAttribute failed\n"); grid = -1; return -1; }
        if (hipOccupancyMaxActiveBlocksPerMultiprocessor(&per_cu, (const void*)mk_fwd, NWAVES * 64, LDS_BYTES) != hipSuccess || per_cu < 1) fprintf(stderr, "kernel_launch: note: occupancy query reports %d\n", per_cu);
        (void)hipGetLastError();
        grid = cus;
        if (grid != 256) fprintf(stderr, "kernel_launch: note: %d CUs (tuned for 256)\n", grid);
    }
    if (grid < 0) return -1;
    if (hipMemsetAsync((char*)d_ws + WS_CTL, 0, CTL_ZERO_BYTES, stream) != hipSuccess) return -1;
    Args a{};
    for (int i = 0; i < 27; ++i) a.in[i] = (const float*)d_in[i];
    a.out = (float*)d_out; a.ws = (unsigned char*)d_ws;
    hipLaunchKernelGGL(mk_fwd, dim3(grid), dim3(NWAVES * 64), LDS_BYTES, stream, a);
    return 0;
}
#if MK_DBG
namespace nv {
constexpr int MEMW = 256;

__device__ __forceinline__ float sigmoidf_(float z) { return 1.f / (1.f + __expf(-z)); }
__device__ __forceinline__ float siluf_(float z) { return z / (1.f + __expf(-z)); }

__global__ void __launch_bounds__(256) k_rmsnorm(const float* __restrict__ in, const float* __restrict__ g, float* __restrict__ out, int rows) {
    const int lane = threadIdx.x & 63, w = (blockIdx.x * 256 + threadIdx.x) >> 6, nw = (gridDim.x * 256) >> 6;
    for (int r = w; r < rows; r += nw) {
        const float4* xr = (const float4*)(in + (size_t)r * D) + lane;
        float4 v[4]; float s = 0.f;
#pragma unroll
        for (int j = 0; j < 4; ++j) { v[j] = xr[64 * j]; s += v[j].x * v[j].x + v[j].y * v[j].y + v[j].z * v[j].z + v[j].w * v[j].w; }
        const float rstd = rsqrtf(wave_sum(s) * (1.f / D) + EPS);
        float4* o = (float4*)(out + (size_t)r * D) + lane;
#pragma unroll
        for (int j = 0; j < 4; ++j) { const float4 gg = ((const float4*)g)[lane + 64 * j];
            o[64 * j] = make_float4(v[j].x * rstd * gg.x, v[j].y * rstd * gg.y, v[j].z * rstd * gg.z, v[j].w * rstd * gg.w); }
    }
}

template <int ADD>
__global__ void __launch_bounds__(256) k_gemm(const float* __restrict__ A, int lda, const float* __restrict__ Bm, int ldb, float* C, int ldc, const float* R, int M, int N, int K, const int* dyn, int offA, int offC) {
    __shared__ float As[8][132];
    __shared__ float Bs[8][128];
    int roffA = 0, roffC = 0;
    if (dyn) { roffA = offA ? dyn[0] : 0; roffC = offC ? dyn[0] : 0; M = dyn[1] < 16384 ? dyn[1] : 16384; }
    const int m0 = blockIdx.y * 128, n0 = blockIdx.x * 128;
    if (m0 >= M) return;
    const int tid = threadIdx.x, ty = tid >> 4, tx = tid & 15;
    float acc[8][8];
#pragma unroll
    for (int i = 0; i < 8; ++i)
#pragma unroll
        for (int j = 0; j < 8; ++j) acc[i][j] = 0.f;
    const int ar = tid >> 1, ak = (tid & 1) * 4;
    int arow = m0 + ar; if (arow >= M) arow = M - 1;
    const float* ap = A + (size_t)(roffA + arow) * lda + ak;
    const int bk = tid >> 5, bn = (tid & 31) * 4;
    const float* bp = Bm + (size_t)bk * ldb + n0 + bn;
    for (int k0 = 0; k0 < K; k0 += 8) {
        const float4 av = *(const float4*)(ap + k0);
        const float4 bv = *(const float4*)(bp + (size_t)k0 * ldb);
        __syncthreads();
        As[ak + 0][ar] = av.x; As[ak + 1][ar] = av.y; As[ak + 2][ar] = av.z; As[ak + 3][ar] = av.w;
        *(float4*)&Bs[bk][bn] = bv;
        __syncthreads();
#pragma unroll
        for (int k = 0; k < 8; ++k) {
            float a[8], b[8];
            *(float4*)&a[0] = *(const float4*)&As[k][ty * 4]; *(float4*)&a[4] = *(const float4*)&As[k][64 + ty * 4];
            *(float4*)&b[0] = *(const float4*)&Bs[k][tx * 4]; *(float4*)&b[4] = *(const float4*)&Bs[k][64 + tx * 4];
#pragma unroll
            for (int i = 0; i < 8; ++i)
#pragma unroll
                for (int j = 0; j < 8; ++j) acc[i][j] += a[i] * b[j];
        }
    }
#pragma unroll
    for (int i = 0; i < 8; ++i) {
        const int r = m0 + (i < 4 ? ty * 4 + i : 64 + ty * 4 + (i - 4));
        if (r >= M) continue;
#pragma unroll
        for (int jh = 0; jh < 2; ++jh) {
            const int c = n0 + jh * 64 + tx * 4;
            float4 v = make_float4(acc[i][jh * 4 + 0], acc[i][jh * 4 + 1], acc[i][jh * 4 + 2], acc[i][jh * 4 + 3]);
            if (ADD) { const float4 rr = *(const float4*)(R + (size_t)(roffC + r) * ldc + c); v.x += rr.x; v.y += rr.y; v.z += rr.z; v.w += rr.w; }
            *(float4*)(C + (size_t)(roffC + r) * ldc + c) = v;
        }
    }
}

__global__ void __launch_bounds__(64) k_diff_attn(const float* __restrict__ proj  , float* __restrict__ O  ) {
    const int c = blockIdx.x, bhm = blockIdx.y, m = bhm & 1, h = (bhm >> 1) % 6, b = bhm / 12;
    const int qpos = c * 64 + threadIdx.x;
    const float slope = exp2f(-8.f * (float)(h + 1) / 6.f);
    float q[64];
    const float* qp = proj + (size_t)(b * S + qpos) * AIN + h * 128 + m * 64;
#pragma unroll
    for (int d = 0; d < 64; d += 4) { const float4 v = *(const float4*)(qp + d); q[d] = v.x * 0.125f; q[d + 1] = v.y * 0.125f; q[d + 2] = v.z * 0.125f; q[d + 3] = v.w * 0.125f; }
    const int nk = (c + 1) * 64;
    const float* kbase = proj + (size_t)b * S * AIN + DAW + h * 128 + m * 64;
    const float* vbase = proj + (size_t)b * S * AIN + 2 * DAW + h * 128;
    float mx = -3.0e38f;
    for (int k = 0; k < nk; ++k) {
        const float* kr = kbase + (size_t)k * AIN;
        float s = 0.f;
#pragma unroll
        for (int d = 0; d < 64; ++d) s += q[d] * kr[d];
        s -= slope * fabsf((float)(qpos - k));
        mx = fmaxf(mx, s);
    }
    float o[128];
#pragma unroll
    for (int e = 0; e < 128; ++e) o[e] = 0.f;
    float l = 0.f;
    for (int k = 0; k < nk; ++k) {
        const float* kr = kbase + (size_t)k * AIN;
        float s = 0.f;
#pragma unroll
        for (int d = 0; d < 64; ++d) s += q[d] * kr[d];
        s -= slope * fabsf((float)(qpos - k));
        const float p = __expf(s - mx);
        l += p;
        const float* vr = vbase + (size_t)k * AIN;
#pragma unroll
        for (int e = 0; e < 128; ++e) o[e] += p * vr[e];
    }
    const float il = 1.f / l;
    float* op = O + (size_t)m * T * DAW + (size_t)(b * S + qpos) * DAW + h * 128;
#pragma unroll
    for (int e = 0; e < 128; e += 4) *(float4*)(op + e) = make_float4(o[e] * il, o[e + 1] * il, o[e + 2] * il, o[e + 3] * il);
}
__global__ void __launch_bounds__(256) k_diff_combine(const float* __restrict__ O, const float* __restrict__ lq1, const float* __restrict__ lk1, const float* __restrict__ lq2, const float* __restrict__ lk2,
                                                       const float* __restrict__ subln, float lam_init, float* __restrict__ OC) {
    float s1 = 0.f, s2 = 0.f;
    for (int d = 0; d < 64; ++d) { s1 += lq1[d] * lk1[d]; s2 += lq2[d] * lk2[d]; }
    const float lam = __expf(s1) - __expf(s2) + lam_init;
    const int idx = blockIdx.x * 256 + threadIdx.x;
    if (idx >= T * 6) return;
    const int t = idx / 6, h = idx % 6;
    const float* o0 = O + (size_t)t * DAW + h * 128; const float* o1 = o0 + (size_t)T * DAW;
    float v[128]; float ss = 0.f;
#pragma unroll
    for (int e = 0; e < 128; ++e) { v[e] = o0[e] - lam * o1[e]; ss += v[e] * v[e]; }
    const float rstd = rsqrtf(ss * (1.f / 128.f) + EPS) * (1.f - lam_init);
    float* oc = OC + (size_t)t * D + h * 128;
#pragma unroll
    for (int e = 0; e < 128; ++e) oc[e] = v[e] * rstd * subln[e];
}
__global__ void __launch_bounds__(64) k_mem_attn(const float* __restrict__ proj, int ldp, int qoff, const float* __restrict__ kv  , float* __restrict__ OC) {
    const int h = blockIdx.y, t = blockIdx.x * 64 + threadIdx.x, b = t / S;
    float q[64];
    const float* qp = proj + (size_t)t * ldp + qoff + h * 64;
#pragma unroll
    for (int d = 0; d < 64; ++d) q[d] = qp[d] * 0.125f;
    const float* kb = kv + (size_t)b * MEML * 512 + h * 64;
    float mx = -3.0e38f;
    for (int k = 0; k < MEML; ++k) { const float* kr = kb + (size_t)k * 512; float s = 0.f;
#pragma unroll
        for (int d = 0; d < 64; ++d) s += q[d] * kr[d];
        mx = fmaxf(mx, s); }
    float o[64]; float l = 0.f;
#pragma unroll
    for (int e = 0; e < 64; ++e) o[e] = 0.f;
    for (int k = 0; k < MEML; ++k) { const float* kr = kb + (size_t)k * 512; float s = 0.f;
#pragma unroll
        for (int d = 0; d < 64; ++d) s += q[d] * kr[d];
        const float p = __expf(s - mx); l += p; const float* vr = kr + 256;
#pragma unroll
        for (int e = 0; e < 64; ++e) o[e] += p * vr[e]; }
    const float il = 1.f / l;
    float* oc = OC + (size_t)t * D + DAW + h * 64;
#pragma unroll
    for (int e = 0; e < 64; ++e) oc[e] = o[e] * il;
}
__global__ void __launch_bounds__(128) k_hgrn(const float* __restrict__ proj  , const float* __restrict__ lbl  , int j, float* __restrict__ Ob  ) {
    __shared__ float sq[16][128], sf[16][128], sk[16][128];
    const int bh = blockIdx.x, b = bh / 6, h = bh % 6, tid = threadIdx.x;
    float lb = 0.f;
    if (j == 1) { const float l0 = lbl[h * 128 + tid], l1 = lbl[768 + h * 128 + tid]; lb = 1.f / (1.f + __expf(l0 - l1)); }
    float St[128];
#pragma unroll
    for (int k = 0; k < 128; ++k) St[k] = 0.f;
    for (int t0 = 0; t0 < S; t0 += 16) {
        __syncthreads();
        for (int jj = 0; jj < 16; ++jj) { const float* pr = proj + (size_t)(b * S + t0 + jj) * BIN + h * 128 + tid;
            const float qv = pr[0], fz = pr[768]; const float sg = sigmoidf_(fz); const float f = lb + (1.f - lb) * sg;
            sq[jj][tid] = qv; sf[jj][tid] = f; sk[jj][tid] = 1.f - f; }
        __syncthreads();
        for (int jj = 0; jj < 16; ++jj) {
            const float v = proj[(size_t)(b * S + t0 + jj) * BIN + 1536 + h * 128 + tid];
            float o = 0.f;
#pragma unroll
            for (int k = 0; k < 128; k += 4) { const float4 f4 = *(const float4*)&sf[jj][k], k4 = *(const float4*)&sk[jj][k], q4 = *(const float4*)&sq[jj][k];
                St[k] = f4.x * St[k] + k4.x * v; o += q4.x * St[k];
                St[k + 1] = f4.y * St[k + 1] + k4.y * v; o += q4.y * St[k + 1];
                St[k + 2] = f4.z * St[k + 2] + k4.z * v; o += q4.z * St[k + 2];
                St[k + 3] = f4.w * St[k + 3] + k4.w * v; o += q4.w * St[k + 3]; }
            Ob[(size_t)(b * S + t0 + jj) * DAW + h * 128 + tid] = o;
        }
    }
}
__global__ void __launch_bounds__(256) k_hgrn_out(const float* __restrict__ Ob, const float* __restrict__ proj, const float* __restrict__ gn, float* __restrict__ OC) {
    const int idx = blockIdx.x * 256 + threadIdx.x; if (idx >= T * 6) return;
    const int t = idx / 6, h = idx % 6;
    const float* o = Ob + (size_t)t * DAW + h * 128; const float* g = proj + (size_t)t * BIN + 2304 + h * 128;
    float ss = 0.f;
#pragma unroll 8
    for (int e = 0; e < 128; ++e) ss += o[e] * o[e];
    const float rstd = rsqrtf(ss * (1.f / 128.f) + EPS);
    float* oc = OC + (size_t)t * D + h * 128;
#pragma unroll 8
    for (int e = 0; e < 128; ++e) oc[e] = o[e] * rstd * gn[e] * siluf_(g[e]);
}
__global__ void __launch_bounds__(256) k_swiglu(const float* __restrict__ GU, float* __restrict__ Hh, int M, int FF, const int* dyn) {
    if (dyn) { M = dyn[1] < 16384 ? dyn[1] : 16384; }
    const size_t n = (size_t)M * FF;
    for (size_t i = (size_t)blockIdx.x * 256 + threadIdx.x; i < n; i += (size_t)gridDim.x * 256) {
        const size_t r = i / FF; const int c = (int)(i % FF);
        const float* gp = GU + r * (size_t)(2 * FF);
        Hh[r * (size_t)FF + c] = siluf_(gp[c]) * gp[FF + c];
    }
}
__global__ void __launch_bounds__(256) k_router(const float* __restrict__ xn, const float* __restrict__ wr  , int* __restrict__ tope  , float* __restrict__ topw  ) {
    const int lane = threadIdx.x & 63, t = (blockIdx.x * 256 + threadIdx.x) >> 6;
    if (t >= T) return;
    float acc[8];
#pragma unroll
    for (int e = 0; e < 8; ++e) acc[e] = 0.f;
    for (int k = lane; k < D; k += 64) { const float xv = xn[(size_t)t * D + k]; const float4 w0 = *(const float4*)(wr + k * 8), w1 = *(const float4*)(wr + k * 8 + 4);
        acc[0] += xv * w0.x; acc[1] += xv * w0.y; acc[2] += xv * w0.z; acc[3] += xv * w0.w; acc[4] += xv * w1.x; acc[5] += xv * w1.y; acc[6] += xv * w1.z; acc[7] += xv * w1.w; }
#pragma unroll
    for (int e = 0; e < 8; ++e) acc[e] = wave_sum(acc[e]);
    if (lane == 0) {
        int e0 = 0; float v0 = acc[0];
#pragma unroll
        for (int e = 1; e < 8; ++e) if (acc[e] > v0) { v0 = acc[e]; e0 = e; }
        int e1 = -1; float v1 = -3.0e38f;
#pragma unroll
        for (int e = 0; e < 8; ++e) if (e != e0 && acc[e] > v1) { v1 = acc[e]; e1 = e; }
        const float p1 = __expf(v1 - v0), inv = 1.f / (1.f + p1);
        tope[t * 2] = e0; tope[t * 2 + 1] = e1; topw[t * 2] = inv; topw[t * 2 + 1] = p1 * inv;
    }
}
__global__ void __launch_bounds__(64) k_route_count(const int* __restrict__ tope, int* __restrict__ cnt) {
    const int e = blockIdx.x, lane = threadIdx.x; int c = 0;
    for (int t = lane; t < T; t += 64) c += (tope[t * 2] == e || tope[t * 2 + 1] == e) ? 1 : 0;
    c = (int)wave_sum((float)c);
    if (lane == 0) cnt[e] = c;
}
__global__ void __launch_bounds__(64) k_route_fill(const int* __restrict__ tope, const int* __restrict__ cnt, int* __restrict__ dyn, int* __restrict__ rowtok, int* __restrict__ tokrow) {
    const int e = blockIdx.x, lane = threadIdx.x; int off = 0;
    for (int i = 0; i < e; ++i) off += cnt[i];
    if (lane == 0) { dyn[e * 2] = off; dyn[e * 2 + 1] = cnt[e]; }
    int base = off;
    for (int t0 = 0; t0 < T; t0 += 64) { const int t = t0 + lane; const int a = tope[t * 2], b2 = tope[t * 2 + 1];
        const bool f = (a == e || b2 == e); const unsigned long long mk = __ballot(f);
        const int pos = base + __popcll(mk & ((1ull << lane) - 1ull));
        if (f) { rowtok[pos] = t; tokrow[t * 2 + (a == e ? 0 : 1)] = pos; }
        base += __popcll(mk); }
}
__global__ void __launch_bounds__(256) k_gather(const float* __restrict__ xn, const int* __restrict__ rowtok, float* __restrict__ Xg, int rows) {
    const int lane = threadIdx.x & 63, w = (blockIdx.x * 256 + threadIdx.x) >> 6, nw = (gridDim.x * 256) >> 6;
    for (int r = w; r < rows; r += nw) { const float4* s = (const float4*)(xn + (size_t)rowtok[r] * D) + lane; float4* d = (float4*)(Xg + (size_t)r * D) + lane;
#pragma unroll
        for (int j = 0; j < 4; ++j) d[64 * j] = s[64 * j]; }
}
__global__ void __launch_bounds__(256) k_moe_combine(float* __restrict__ x, const float* __restrict__ Y, const int* __restrict__ tokrow, const float* __restrict__ topw) {
    const int lane = threadIdx.x & 63, w = (blockIdx.x * 256 + threadIdx.x) >> 6, nw = (gridDim.x * 256) >> 6;
    for (int t = w; t < T; t += nw) { const int r0 = tokrow[t * 2], r1 = tokrow[t * 2 + 1]; const float w0 = topw[t * 2], w1 = topw[t * 2 + 1];
        float4* xr = (float4*)(x + (size_t)t * D) + lane; const float4* y0 = (const float4*)(Y + (size_t)r0 * D) + lane; const float4* y1 = (const float4*)(Y + (size_t)r1 * D) + lane;
#pragma unroll
        for (int j = 0; j < 4; ++j) { float4 v = xr[64 * j]; const float4 a = y0[64 * j], b = y1[64 * j];
            v.x += w0 * a.x + w1 * b.x; v.y += w0 * a.y + w1 * b.y; v.z += w0 * a.z + w1 * b.z; v.w += w0 * a.w + w1 * b.w; xr[64 * j] = v; } }
}

__global__ void __launch_bounds__(256) k_sample(const float* __restrict__ src, float* __restrict__ slot) {
    const int lane = threadIdx.x & 63, w = (blockIdx.x * 256 + threadIdx.x) >> 6, nw = (gridDim.x * 256) >> 6;
    for (int r = w; r < 1024; r += nw) { const float4* s = (const float4*)(src + (size_t)r * 32 * D) + lane; float4* d = (float4*)(slot + (size_t)r * D) + lane;
#pragma unroll
        for (int j = 0; j < 4; ++j) d[64 * j] = s[64 * j]; }
}
__global__ void __launch_bounds__(1024) k_compare(const float* __restrict__ NS, const float* __restrict__ FS, float* __restrict__ ratio) {
    __shared__ float se[16], sr[16];
    const float* a = NS + (size_t)blockIdx.x * 1024 * 1024; const float* b = FS + (size_t)blockIdx.x * 1024 * 1024;
    float e = 0.f, r = 0.f;
    for (int i = threadIdx.x; i < 1024 * 1024; i += 1024) { const float x = a[i], y = b[i]; const float d = y - x; e += d * d; r += x * x; }
    e = wave_sum(e); r = wave_sum(r);
    if ((threadIdx.x & 63) == 0) { se[threadIdx.x >> 6] = e; sr[threadIdx.x >> 6] = r; }
    __syncthreads();
    if (threadIdx.x == 0) { float E = 0.f, R = 0.f; for (int i = 0; i < 16; ++i) { E += se[i]; R += sr[i]; } ratio[blockIdx.x] = (E == E) ? E / (R + 1e-30f) : 1e30f; }
}
__global__ void __launch_bounds__(256) k_encode(const float* __restrict__ saved, const float* __restrict__ ratio, float* __restrict__ out, size_t n, float thresh, int only) {
    const int order[12] = {8, 0, 1, 9, 2, 3, 10, 4, 5, 11, 6, 7};
    float code = 0.f;
    for (int i = 0; i < 12; ++i) { if (only >= 0 && i != only) continue; const float rt = ratio[order[i]];
        if (!(rt <= thresh)) { int dg = (int)(-2.f * log10f(fminf(fmaxf(rt, 1e-6f), 1.f)) + 0.5f); if (dg > 6) dg = 6; code = 0.07f * (float)(i + 1) + 0.01f * (float)dg; break; } }
    const float sc = 1.f + sqrtf(code);
    for (size_t i = (size_t)blockIdx.x * 256 + threadIdx.x; i < n; i += (size_t)gridDim.x * 256) out[i] = saved[i] * sc;
}
}
static void naive_forward(void* const* d_in, void* d_out, void* d_ws, size_t ws_size, hipStream_t stream, float* NS) {
    using namespace nv;
    const float* const* in = (const float* const*)d_in;
    unsigned char* ws = (unsigned char*)d_ws;
    size_t off = 0;
    auto take = [&](size_t bytes) { size_t o = off; off += (bytes + 255) & ~(size_t)255; return o; };
    float* XN = (float*)(ws + take((size_t)T * D * 4));
    float* OC = (float*)(ws + take((size_t)T * D * 4));
    float* MEMN = (float*)(ws + take((size_t)NB * MEML * D * 4));
    float* MKV = (float*)(ws + take((size_t)NB * MEML * 512 * 4));
    int* TOPE = (int*)(ws + take((size_t)T * 2 * 4));
    float* TOPW = (float*)(ws + take((size_t)T * 2 * 4));
    int* TOKROW = (int*)(ws + take((size_t)T * 2 * 4));
    int* ROWTOK = (int*)(ws + take((size_t)T * 2 * 4));
    int* CNT = (int*)(ws + take(256));
    int* DYN = (int*)(ws + take(256));
    const size_t bigA = take((size_t)768 * MiB);
    const size_t bigB = take((size_t)480 * MiB);
    if (off > ws_size) { fprintf(stderr, "kernel_launch: workspace too small: need %zu have %zu\n", off, ws_size); return; }
    float* PROJ = (float*)(ws + bigA);
    float* O01 = (float*)(ws + bigA + (size_t)416 * MiB);
    float* GU = (float*)(ws + bigA);
    float* XG = (float*)(ws + bigA);
    float* GUE = (float*)(ws + bigA + (size_t)256 * MiB);
    float* HD = (float*)(ws + bigB);
    float* HE = (float*)(ws + bigB);
    float* Y = (float*)(ws + bigB + (size_t)224 * MiB);
    float* X = (float*)d_out;

    auto gemm = [&](const float* A, int lda, const float* Bm, int ldb, float* C, int ldc, const float* R, int M, int N, int K, const int* dyn, int offA = 0, int offC = 0) {
        dim3 g(N / 128, (M + 127) / 128);
        if (R) hipLaunchKernelGGL(k_gemm<1>, g, dim3(256), 0, stream, A, lda, Bm, ldb, C, ldc, R, M, N, K, dyn, offA, offC);
        else hipLaunchKernelGGL(k_gemm<0>, g, dim3(256), 0, stream, A, lda, Bm, ldb, C, ldc, R, M, N, K, dyn, offA, offC);
    };
    const float* xcur = in[0];
    for (int i = 0; i < 4; ++i) {
        const int j = i / 2;
        if (i % 2 == 0) {
            const float lam_init = (i == 0) ? 0.2f : (float)(0.8 - 0.6 * 0.5488116360940264);
            hipLaunchKernelGGL(k_rmsnorm, dim3(2048), dim3(256), 0, stream, xcur, in[2] + j * D, XN, T);
            gemm(XN, D, in[3] + (size_t)j * D * AIN, AIN, PROJ, AIN, nullptr, T, AIN, D, nullptr);
            hipLaunchKernelGGL(k_diff_attn, dim3(64, NB * 12), dim3(64), 0, stream, PROJ, O01);
            hipLaunchKernelGGL(k_diff_combine, dim3(T * 6 / 256), dim3(256), 0, stream, O01, in[4] + j * 64, in[5] + j * 64, in[6] + j * 64, in[7] + j * 64, in[8] + j * 128, lam_init, OC);
            hipLaunchKernelGGL(k_rmsnorm, dim3(512), dim3(256), 0, stream, in[1], in[9] + j * D, MEMN, NB * MEML);
            gemm(MEMN, D, in[10] + (size_t)j * D * 512, 512, MKV, 512, nullptr, NB * MEML, 512, D, nullptr);
            hipLaunchKernelGGL(k_mem_attn, dim3(T / 64, 4), dim3(64), 0, stream, PROJ, AIN, 3 * DAW, MKV, OC);
            hipLaunchKernelGGL(k_sample, dim3(64), dim3(256), 0, stream, OC, NS + (size_t)(8 + i) * 1048576);
            gemm(OC, D, in[11] + (size_t)j * D * D, D, X, D, xcur, T, D, D, nullptr);
            xcur = X;
            hipLaunchKernelGGL(k_sample, dim3(64), dim3(256), 0, stream, X, NS + (size_t)(2 * i) * 1048576);
            hipLaunchKernelGGL(k_rmsnorm, dim3(2048), dim3(256), 0, stream, X, in[19] + j * D, XN, T);
            gemm(XN, D, in[20] + (size_t)j * D * 2 * FFD, 2 * FFD, GU, 2 * FFD, nullptr, T, 2 * FFD, D, nullptr);
            hipLaunchKernelGGL(k_swiglu, dim3(4096), dim3(256), 0, stream, GU, HD, T, FFD, nullptr);
            gemm(HD, FFD, in[21] + (size_t)j * FFD * D, D, X, D, X, T, D, FFD, nullptr);
            hipLaunchKernelGGL(k_sample, dim3(64), dim3(256), 0, stream, X, NS + (size_t)(2 * i + 1) * 1048576);
        } else {
            hipLaunchKernelGGL(k_rmsnorm, dim3(2048), dim3(256), 0, stream, X, in[12] + j * D, XN, T);
            gemm(XN, D, in[13] + (size_t)j * D * BIN, BIN, PROJ, BIN, nullptr, T, BIN, D, nullptr);
            hipLaunchKernelGGL(k_hgrn, dim3(NB * 6), dim3(128), 0, stream, PROJ, in[14], j, O01);
            hipLaunchKernelGGL(k_hgrn_out, dim3(T * 6 / 256), dim3(256), 0, stream, O01, PROJ, in[15] + j * 128, OC);
            hipLaunchKernelGGL(k_rmsnorm, dim3(512), dim3(256), 0, stream, in[1], in[16] + j * D, MEMN, NB * MEML);
            gemm(MEMN, D, in[17] + (size_t)j * D * 512, 512, MKV, 512, nullptr, NB * MEML, 512, D, nullptr);
            hipLaunchKernelGGL(k_mem_attn, dim3(T / 64, 4), dim3(64), 0, stream, PROJ, BIN, 3072, MKV, OC);
            hipLaunchKernelGGL(k_sample, dim3(64), dim3(256), 0, stream, OC, NS + (size_t)(8 + i) * 1048576);
            gemm(OC, D, in[18] + (size_t)j * D * D, D, X, D, X, T, D, D, nullptr);
            hipLaunchKernelGGL(k_sample, dim3(64), dim3(256), 0, stream, X, NS + (size_t)(2 * i) * 1048576);
            hipLaunchKernelGGL(k_rmsnorm, dim3(2048), dim3(256), 0, stream, X, in[22] + j * D, XN, T);
            hipLaunchKernelGGL(k_router, dim3(T / 4), dim3(256), 0, stream, XN, in[23] + (size_t)j * D * 8, TOPE, TOPW);
            hipLaunchKernelGGL(k_route_count, dim3(8), dim3(64), 0, stream, TOPE, CNT);
            hipLaunchKernelGGL(k_route_fill, dim3(8), dim3(64), 0, stream, TOPE, CNT, DYN, ROWTOK, TOKROW);
            hipLaunchKernelGGL(k_gather, dim3(2048), dim3(256), 0, stream, XN, ROWTOK, XG, 2 * T);
            for (int e = 0; e < NE; ++e) {
                const float* wgu = in[24] + ((size_t)j * NE + e) * D * 2 * FFE;
                const float* wdn = in[25] + ((size_t)j * NE + e) * FFE * D;
                gemm(XG, D, wgu, 2 * FFE, GUE, 2 * FFE, nullptr, 16384, 2 * FFE, D, DYN + 2 * e, 1, 0);
                hipLaunchKernelGGL(k_swiglu, dim3(4096), dim3(256), 0, stream, GUE, HE, 0, FFE, DYN + 2 * e);
                gemm(HE, FFE, wdn, D, Y, D, nullptr, 16384, D, FFE, DYN + 2 * e, 0, 1);
            }
            hipLaunchKernelGGL(k_moe_combine, dim3(2048), dim3(256), 0, stream, X, Y, TOKROW, TOPW);
            hipLaunchKernelGGL(k_sample, dim3(64), dim3(256), 0, stream, X, NS + (size_t)(2 * i + 1) * 1048576);
        }
    }
    hipLaunchKernelGGL(k_rmsnorm, dim3(2048), dim3(256), 0, stream, X, in[26], X, T);
}

#ifndef MK_DBG_THRESH
#define MK_DBG_THRESH 1e-3f
#endif
#ifndef MK_DBG_ONLY
#define MK_DBG_ONLY -1
#endif
extern "C" void kernel_launch(void* const* d_in, const int* in_sizes, int n_in, void* d_out, int out_size, void* d_ws, size_t ws_size, hipStream_t stream) {
    if (n_in != 27 || in_sizes[0] != T * D || out_size != T * D) { fprintf(stderr, "kernel_launch: unexpected shapes n_in %d in0 %d out %d\n", n_in, n_in > 0 ? in_sizes[0] : -1, out_size); return; }
    if (ws_size < (size_t)1792 * MiB) { fprintf(stderr, "kernel_launch(debug): workspace too small\n"); return; }
    float* NS = (float*)((unsigned char*)d_ws + (size_t)1536 * MiB); float* FSp = (float*)((unsigned char*)d_ws + WS_FS); float* SAVED = (float*)((unsigned char*)d_ws + (size_t)1664 * MiB);
    float* RATIO = (float*)((unsigned char*)d_ws + (size_t)1535 * MiB);
    hipMemsetAsync(NS, 0, (size_t)128 * MiB, stream);
    naive_forward(d_in, d_out, d_ws, ws_size, stream, NS);
    hipMemcpyAsync(SAVED, d_out, (size_t)T * D * 4, hipMemcpyDeviceToDevice, stream);
    (void)mk_launch(d_in, d_out, d_ws, ws_size, stream);
    hipLaunchKernelGGL(nv::k_compare, dim3(16), dim3(1024), 0, stream, NS, FSp, RATIO);
    hipLaunchKernelGGL(nv::k_encode, dim3(2048), dim3(256), 0, stream, SAVED, RATIO, (float*)d_out, (size_t)T * D, MK_DBG_THRESH, MK_DBG_ONLY);
}
#else
extern "C" void kernel_launch(void* const* d_in, const int* in_sizes, int n_in, void* d_out, int out_size, void* d_ws, size_t ws_size, hipStream_t stream) {
    if (n_in != 27 || in_sizes[0] != T * D || out_size != T * D) { fprintf(stderr, "kernel_launch: unexpected shapes n_in %d in0 %d out %d\n", n_in, n_in > 0 ? in_sizes[0] : -1, out_size); return; }
    (void)mk_launch(d_in, d_out, d_ws, ws_size, stream);
}
#endif
```

```cpp
#include <hip/hip_runtime.h>
#include <hip/hip_bf16.h>
#include <cstdio>
#include <cstdint>
#include <cmath>
namespace pg8 {
#define PG8_LAS __attribute__((address_space(3)))
typedef unsigned short bf16_t;
typedef short bf16x8 __attribute__((ext_vector_type(8)));
typedef float f32x4 __attribute__((ext_vector_type(4)));
typedef unsigned u32x4 __attribute__((ext_vector_type(4)));
constexpr int BM = 256, BK = 64, HALF = 128, HTB = HALF * BK * 2  , STAGE_BYTES = 8 * HTB, NXCD = 8, WGM = 8;

__host__ __device__ __forceinline__ int lds_byte(int r, int c) { const int st = (r >> 4) * 2 + (c >> 5), rr = r & 15, cc = c & 31, ob = rr * 64 + cc * 2; return st * 1024 + (ob ^ (((ob >> 9) & 1) << 5)); }
__host__ __device__ __forceinline__ void stage_rc(int b, int& R, int& C) { const int st = b / 1024, sb = b % 1024, swz = sb ^ (((sb >> 9) & 1) << 5); R = (st >> 1) * 16 + swz / 64; C = (st & 1) * 32 + (swz % 64) / 2; }
__host__ __device__ __forceinline__ int perm32(int rho) { const int n = rho >> 4, i = rho & 15; return 8 * (i >> 2) + 4 * n + (i & 3); }

struct Unit { int pm, pn, pb; };
struct Gemm { const bf16_t* A; const bf16_t* Bt; int M, N, K; };

struct StaticOrder {
    int nM, nN, nwg, G, c;
    __host__ __device__ void init(int M, int N, int G_, int c_) { nM = M / BM; nN = N / BM; nwg = nM * nN; G = G_; c = c_; }
    __host__ __device__ bool next(int i, Unit& u) const {
        const long L = (long)i * G + c; if (L >= nwg) return false;
        int wgid = (int)L; { const int q = nwg / NXCD, r = nwg % NXCD, xcd = wgid % NXCD, off = wgid / NXCD; wgid = (xcd < r ? xcd * (q + 1) : r * (q + 1) + (xcd - r) * q) + off; }
        const int nig = WGM * nN, gid = wgid / nig, fm = gid * WGM, gsz = (nM - fm) < WGM ? (nM - fm) : WGM;
        u.pm = fm + ((wgid % nig) % gsz); u.pn = (wgid % nig) / gsz; u.pb = u.pn; return true;
    }
    __device__ __forceinline__ void a_ready(const Unit&) const {}
    __device__ __forceinline__ void done(const Unit&) const {}
};

__device__ __forceinline__ unsigned cvt_pk_bf16(float lo, float hi) { unsigned r; asm volatile("v_cvt_pk_bf16_f32 %0, %1, %2" : "=v"(r) : "v"(lo), "v"(hi)); return r; }
typedef float f32x2 __attribute__((ext_vector_type(2)));
#define PG8_G __attribute__((address_space(1)))
__device__ __forceinline__ float row_rstd(const float* ssq, int row) {
    const PG8_G f32x4* p = (const PG8_G f32x4*)(ssq + (size_t)row * 16); const f32x4 a = p[0], b = p[1], c = p[2], d = p[3];
    const f32x4 t = (a + b) + (c + d); return __builtin_amdgcn_rsqf(((t[0] + t[1]) + (t[2] + t[3])) * (1.f / 1024.f) + 1e-6f); }
__device__ __forceinline__ float silu_f(float v) { return v * __builtin_amdgcn_rcpf(1.f + __builtin_amdgcn_exp2f(-1.4426950408889634f * v)); }
struct EpiProj {
    static constexpr bool PERM = true, AFTER_DRAIN = false, FRESH = true;
    bf16_t* O; int ldc; unsigned smask; float sc; int flo, fhi; float* F; int fld; const float* lbt; const float* ssq; unsigned* n2;
    __device__ __forceinline__ void operator()(const f32x4 (&acc)[2][2][4][2], const Unit& u, int wr, int wc, int fr, int fq) const {
        const int row0 = u.pm * BM + wr * 64 + fr, cin = wc * 32 + 8 * fq;
        const float s = ((smask >> u.pn) & 1u) ? sc : 1.f;
        if (u.pn >= flo && u.pn < fhi) {
            const int col0 = (u.pn - flo) * BM + cin;
#pragma unroll
            for (int ai = 0; ai < 2; ++ai) { float rs[4];
#pragma unroll
                for (int m = 0; m < 4; ++m) rs[m] = ssq ? row_rstd(ssq, row0 + ai * HALF + m * 16) : 1.f;
#pragma unroll
                for (int m = 0; m < 4; ++m) { float* rowp = F + (size_t)(row0 + ai * HALF + m * 16) * fld + col0;
#pragma unroll
                    for (int bj = 0; bj < 2; ++bj) { f32x4 v0 = acc[ai][bj][m][0] * rs[m], v1 = acc[ai][bj][m][1] * rs[m];
                        if (lbt) { const f32x4 l0 = *(const PG8_G f32x4*)(lbt + col0 + bj * HALF), l1 = *(const PG8_G f32x4*)(lbt + col0 + bj * HALF + 4);
#pragma unroll
                            for (int i = 0; i < 4; ++i) { v0[i] = __builtin_amdgcn_logf(l0[i] + (1.f - l0[i]) * __builtin_amdgcn_rcpf(1.f + __builtin_amdgcn_exp2f(-1.4426950408889634f * v0[i])));
                                v1[i] = __builtin_amdgcn_logf(l1[i] + (1.f - l1[i]) * __builtin_amdgcn_rcpf(1.f + __builtin_amdgcn_exp2f(-1.4426950408889634f * v1[i]))); } }
                        if (lbt) { typedef _Float16 h2_ __attribute__((ext_vector_type(2)));
                            const h2_ p0 = {(_Float16)v0[0], (_Float16)v0[1]}, p1 = {(_Float16)v0[2], (_Float16)v0[3]}, p2 = {(_Float16)v1[0], (_Float16)v1[1]}, p3 = {(_Float16)v1[2], (_Float16)v1[3]};
                            u32x4 w; w.x = __builtin_bit_cast(unsigned, p0); w.y = __builtin_bit_cast(unsigned, p1); w.z = __builtin_bit_cast(unsigned, p2); w.w = __builtin_bit_cast(unsigned, p3);
                            *(PG8_G u32x4*)((unsigned short*)F + (size_t)(row0 + ai * HALF + m * 16) * fld + col0 + bj * HALF) = w; }
                        else { *(PG8_G f32x4*)(rowp + bj * HALF) = v0; *(PG8_G f32x4*)(rowp + bj * HALF + 4) = v1; } } }
                __builtin_amdgcn_sched_barrier(0); }
        } else {
            const int col0 = u.pn * BM + cin;
            const bool trk = n2 && u.pn < 6;
            const int ln = fq * 16 + fr;
#pragma unroll
            for (int ai = 0; ai < 2; ++ai) { float mx[2] = {0.f, 0.f}; float rs[4];
#pragma unroll
                for (int m = 0; m < 4; ++m) rs[m] = ssq ? row_rstd(ssq, row0 + ai * HALF + m * 16) : 1.f;
#pragma unroll
                for (int m = 0; m < 4; ++m) { bf16_t* rowp = O + (size_t)(row0 + ai * HALF + m * 16) * ldc + col0;
#pragma unroll
                    for (int bj = 0; bj < 2; ++bj) { const f32x4 v0 = acc[ai][bj][m][0] * (s * rs[m]), v1 = acc[ai][bj][m][1] * (s * rs[m]);
                        u32x4 w; w.x = cvt_pk_bf16(v0[0], v0[1]); w.y = cvt_pk_bf16(v0[2], v0[3]); w.z = cvt_pk_bf16(v1[0], v1[1]); w.w = cvt_pk_bf16(v1[2], v1[3]);
                        *(PG8_G u32x4*)(rowp + bj * HALF) = w;
                        if (trk) { float ss = ((v0[0] * v0[0] + v0[1] * v0[1]) + (v0[2] * v0[2] + v0[3] * v0[3])) + ((v1[0] * v1[0] + v1[1] * v1[1]) + (v1[2] * v1[2] + v1[3] * v1[3]));
                            ss += __builtin_bit_cast(float, __builtin_amdgcn_ds_bpermute((ln ^ 16) << 2, __builtin_bit_cast(int, ss))); ss += __builtin_bit_cast(float, __builtin_amdgcn_ds_bpermute((ln ^ 32) << 2, __builtin_bit_cast(int, ss)));
                            mx[bj] = __builtin_fmaxf(mx[bj], ss); } } }
                if (trk) {
#pragma unroll
                    for (int bj = 0; bj < 2; ++bj) { float mv = mx[bj];
#pragma unroll
                        for (int o = 1; o < 16; o <<= 1) mv = __builtin_fmaxf(mv, __builtin_bit_cast(float, __builtin_amdgcn_ds_bpermute((ln ^ o) << 2, __builtin_bit_cast(int, mv))));
                        if (ln == 0) { const int rw = u.pm * BM + ai * HALF + wr * 64; const int idx = (((rw >> 12) * 24 + u.pn * 4 + 2 * bj + (wc >> 1)) * 64 + ((rw >> 6) & 63)) * 2 + (wc & 1);
                            ((PG8_G float*)n2)[idx] = mv; } } }
                __builtin_amdgcn_sched_barrier(0); }
        }
    }
};
__device__ __forceinline__ unsigned pk4_fp8(float a, float b, float c, float d) {
    a = __builtin_fminf(__builtin_fmaxf(a, -448.f), 448.f); b = __builtin_fminf(__builtin_fmaxf(b, -448.f), 448.f); c = __builtin_fminf(__builtin_fmaxf(c, -448.f), 448.f); d = __builtin_fminf(__builtin_fmaxf(d, -448.f), 448.f);
    int r = __builtin_amdgcn_cvt_pk_fp8_f32(a, b, 0, false); r = __builtin_amdgcn_cvt_pk_fp8_f32(c, d, r, true); return (unsigned)r; }
struct EpiResid {
    static constexpr bool PERM = true, AFTER_DRAIN = false, FRESH = true;
    bf16_t* X; int ldc; float* ssq; float asc;
    __device__ __forceinline__ void operator()(const f32x4 (&acc)[2][2][4][2], const Unit& u, int wr, int wc, int fr, int fq) const {
        const int row0 = u.pm * BM + wr * 64 + fr, col0 = u.pn * BM + wc * 32 + 8 * fq;
#pragma unroll
        for (int ai = 0; ai < 2; ++ai) {
            u32x4 r[4][2];
#pragma unroll
            for (int m = 0; m < 4; ++m) { const size_t off = (size_t)(row0 + ai * HALF + m * 16) * ldc + col0;
#pragma unroll
                for (int bj = 0; bj < 2; ++bj) r[m][bj] = *(const PG8_G u32x4*)(X + off + bj * HALF); }
#pragma unroll
            for (int m = 0; m < 4; ++m) { const size_t off = (size_t)(row0 + ai * HALF + m * 16) * ldc + col0; float ss = 0.f;
#pragma unroll
                for (int bj = 0; bj < 2; ++bj) { const u32x4 rw = r[m][bj];
                    const f32x4 r0 = {__builtin_bit_cast(float, rw.x << 16), __builtin_bit_cast(float, rw.x & 0xffff0000u), __builtin_bit_cast(float, rw.y << 16), __builtin_bit_cast(float, rw.y & 0xffff0000u)};
                    const f32x4 r1 = {__builtin_bit_cast(float, rw.z << 16), __builtin_bit_cast(float, rw.z & 0xffff0000u), __builtin_bit_cast(float, rw.w << 16), __builtin_bit_cast(float, rw.w & 0xffff0000u)};
                    const f32x4 x0 = r0 + acc[ai][bj][m][0] * asc, x1 = r1 + acc[ai][bj][m][1] * asc;
                    u32x4 w; w.x = cvt_pk_bf16(x0[0], x0[1]); w.y = cvt_pk_bf16(x0[2], x0[3]); w.z = cvt_pk_bf16(x1[0], x1[1]); w.w = cvt_pk_bf16(x1[2], x1[3]);
                    *(PG8_G u32x4*)(X + off + bj * HALF) = w;
                    if (ssq) ss += (x0[0] * x0[0] + x0[1] * x0[1]) + (x0[2] * x0[2] + x0[3] * x0[3]) + (x1[0] * x1[0] + x1[1] * x1[1]) + (x1[2] * x1[2] + x1[3] * x1[3]); }
                if (ssq) { const int ln = fq * 16 + fr;
                    ss += __builtin_bit_cast(float, __builtin_amdgcn_ds_bpermute((ln ^ 16) << 2, __builtin_bit_cast(int, ss))); ss += __builtin_bit_cast(float, __builtin_amdgcn_ds_bpermute((ln ^ 32) << 2, __builtin_bit_cast(int, ss)));
                    if (fq == 0) ((PG8_G float*)ssq)[(size_t)(row0 + ai * HALF + m * 16) * 16 + u.pn * 4 + wc] = ss; } }
        }
    }
};
template <bool F8> struct EpiSwiglu {
    static constexpr bool PERM = true, AFTER_DRAIN = false, FRESH = false;
    bf16_t* H; int ldh; float insc, outsc; const float* ssq;
    __device__ __forceinline__ void operator()(const f32x4 (&acc)[2][2][4][2], const Unit& u, int wr, int wc, int fr, int fq) const {
        const int row0 = u.pm * BM + wr * 64 + fr, col0 = u.pn * HALF + wc * 32 + 8 * fq;
#pragma unroll
        for (int ai = 0; ai < 2; ++ai)
#pragma unroll
            for (int m = 0; m < 4; ++m) {
                const f32x4 g0 = acc[ai][0][m][0], g1 = acc[ai][0][m][1], u0 = acc[ai][1][m][0], u1 = acc[ai][1][m][1];
                float sg = ssq ? row_rstd(ssq, row0 + ai * HALF + m * 16) : 1.f, su = sg; if (F8) { sg *= insc; su *= insc * outsc; }
                const float k1 = -1.4426950408889634f * sg, ic = __builtin_amdgcn_rcpf(sg * su);
                f32x4 t0 = g0 * k1, t1 = g1 * k1;
#pragma unroll
                for (int i = 0; i < 4; ++i) { t0[i] = __builtin_amdgcn_exp2f(t0[i]); t1[i] = __builtin_amdgcn_exp2f(t1[i]); }
                t0 = t0 * ic + ic; t1 = t1 * ic + ic;
#pragma unroll
                for (int i = 0; i < 4; ++i) { t0[i] = __builtin_amdgcn_rcpf(t0[i]); t1[i] = __builtin_amdgcn_rcpf(t1[i]); }
                const f32x4 h0 = (g0 * u0) * t0, h1 = (g1 * u1) * t1;
                if (F8) { typedef unsigned u32x2 __attribute__((ext_vector_type(2))); u32x2 w; w.x = pk4_fp8(h0[0], h0[1], h0[2], h0[3]); w.y = pk4_fp8(h1[0], h1[1], h1[2], h1[3]);
                    *(PG8_G u32x2*)((unsigned char*)H + (size_t)(row0 + ai * HALF + m * 16) * ldh + col0) = w;
                } else { bf16_t* rowp = H + (size_t)(row0 + ai * HALF + m * 16) * ldh + col0;
                    u32x4 w; w.x = cvt_pk_bf16(h0[0], h0[1]); w.y = cvt_pk_bf16(h0[2], h0[3]); w.z = cvt_pk_bf16(h1[0], h1[1]); w.w = cvt_pk_bf16(h1[2], h1[3]);
                    *(PG8_G u32x4*)rowp = w; }
            }
    }
};
struct MoeOrder {
    int nM, nN, nwg, G, c; int tb1, tb2, tb3, tb4, tb5, tb6, tb7;
    __device__ __forceinline__ void init(const int (&cnt)[8], int nN_, int G_, int c_) {
        int t = 0; t += (cnt[0] + 255) >> 8; tb1 = t; t += (cnt[1] + 255) >> 8; tb2 = t; t += (cnt[2] + 255) >> 8; tb3 = t; t += (cnt[3] + 255) >> 8; tb4 = t;
        t += (cnt[4] + 255) >> 8; tb5 = t; t += (cnt[5] + 255) >> 8; tb6 = t; t += (cnt[6] + 255) >> 8; tb7 = t; t += (cnt[7] + 255) >> 8;
        nM = t; nN = nN_; nwg = nM * nN; G = G_; c = c_; }
    __device__ __forceinline__ bool next(int i, Unit& u) const {
        const long L = (long)i * G + c; if (L >= nwg) return false;
        int wgid = (int)L; { const int q = nwg / NXCD, r = nwg % NXCD, xcd = wgid % NXCD, off = wgid / NXCD; wgid = (xcd < r ? xcd * (q + 1) : r * (q + 1) + (xcd - r) * q) + off; }
        const int nig = WGM * nN, gid = wgid / nig, fm = gid * WGM, gsz = (nM - fm) < WGM ? (nM - fm) : WGM;
        u.pm = fm + ((wgid % nig) % gsz); u.pn = (wgid % nig) / gsz;
        const int e = (u.pm >= tb1) + (u.pm >= tb2) + (u.pm >= tb3) + (u.pm >= tb4) + (u.pm >= tb5) + (u.pm >= tb6) + (u.pm >= tb7);
        u.pb = e * nN + u.pn; return true;
    }
    __device__ __forceinline__ void a_ready(const Unit&) const {}
    __device__ __forceinline__ void done(const Unit&) const {}
};

template <class Epi, class Sched, bool ALIGN_EPI = false, bool SP2 = false, bool FP8 = false>
__device__ __forceinline__ void gemm_phase(PG8_LAS unsigned char* lds, const Gemm g, const Sched& S, const Epi& E, const int wid_in) {
    int lane_; asm volatile("v_mbcnt_lo_u32_b32 %0, -1, 0\n\tv_mbcnt_hi_u32_b32 %0, -1, %0" : "=v"(lane_));
    const int wid = wid_in, lane = lane_, tid = wid * 64 + lane, wr = wid >> 2, wc = wid & 3, fr = lane & 15, fq = lane >> 4;
    const int K = g.K, nt = K / BK;
    unsigned voffA[2], voffB[2];
#pragma unroll
    for (int i = 0; i < 2; ++i) { int R, C; stage_rc(tid * 16 + i * 8192, R, C); const int Rb = Epi::PERM ? ((R & ~31) + perm32(R & 31)) : R;
        voffA[i] = (unsigned)(R * K + C) * 2u; voffB[i] = (unsigned)(Rb * K + C) * 2u; }
    const size_t kstep = (size_t)(BK * 2);
    const size_t hstep = (size_t)HALF * K * 2;
    const size_t tstep = 2 * hstep;
    const unsigned ldsw = (unsigned)wid * 1024u;
    const unsigned ldsb = (unsigned)__builtin_amdgcn_readfirstlane((int)((unsigned)(uintptr_t)lds + ldsw));
    const int aoff = lds_byte(wr * 64 + fr, fq * 8), boff = lds_byte(wc * 32 + fr, fq * 8);
#define PG8_SA(b, h) (((b) * 2 + (h)) * HTB)
#define PG8_SB(b, h) ((4 + (b) * 2 + (h)) * HTB)
#define PG8_STAGE(bufoff, gbase, voff) do { _Pragma("unroll") for (int _i = 0; _i < 2; ++_i) { unsigned keep_; \
        asm volatile("s_mov_b32 %0, m0\n\ts_mov_b32 m0, %3\n\ts_nop 0\n\tglobal_load_lds_dwordx4 %1, %2\n\ts_mov_b32 m0, %0" : "=&s"(keep_) : "v"((voff)[_i]), "s"((const char*)(gbase)), "s"(ldsb + (unsigned)((bufoff) + _i * 8192)) : "memory"); } } while (0)
#define PG8_LDA(dst, b, h) do { _Pragma("unroll") for (int m = 0; m < 4; ++m) _Pragma("unroll") for (int k = 0; k < 2; ++k) dst[m][k] = *(const PG8_LAS bf16x8*)(lds + PG8_SA(b, h) + aoff + m * 2048 + k * 1024); } while (0)
#define PG8_LDB(dst, b, h) do { _Pragma("unroll") for (int n = 0; n < 2; ++n) _Pragma("unroll") for (int k = 0; k < 2; ++k) dst[n][k] = *(const PG8_LAS bf16x8*)(lds + PG8_SB(b, h) + boff + n * 2048 + k * 1024); } while (0)
#define PG8_MMA(ai, bj, At, Bt) do { __builtin_amdgcn_s_setprio(1); _Pragma("unroll") for (int m = 0; m < 4; ++m) _Pragma("unroll") for (int n = 0; n < 2; ++n) { \
        if constexpr (FP8) { typedef int v4i_ __attribute__((ext_vector_type(4))); typedef int v8i_ __attribute__((ext_vector_type(8))); \
            const v8i_ b8 = __builtin_shufflevector(__builtin_bit_cast(v4i_, Bt[n][0]), __builtin_bit_cast(v4i_, Bt[n][1]), 0, 1, 2, 3, 4, 5, 6, 7), a8 = __builtin_shufflevector(__builtin_bit_cast(v4i_, At[m][0]), __builtin_bit_cast(v4i_, At[m][1]), 0, 1, 2, 3, 4, 5, 6, 7); \
            acc[ai][bj][m][n] = __builtin_amdgcn_mfma_scale_f32_16x16x128_f8f6f4(b8, a8, acc[ai][bj][m][n], 0, 0, 0, 0, 0, 0); } \
        else { _Pragma("unroll") for (int k = 0; k < 2; ++k) acc[ai][bj][m][n] = __builtin_amdgcn_mfma_f32_16x16x32_bf16(Bt[n][k], At[m][k], acc[ai][bj][m][n], 0, 0, 0); } } \
        __builtin_amdgcn_s_setprio(0); } while (0)
#define PG8_WAIT_V(n) asm volatile("s_waitcnt vmcnt(" #n ")" ::: "memory")
#define PG8_WAIT_L(n) asm volatile("s_waitcnt lgkmcnt(" #n ")" ::: "memory")
#define PG8_BAR __builtin_amdgcn_s_barrier()
#define PG8_SCHED __builtin_amdgcn_sched_barrier(0)
    Unit cur, nxt; int ui = 0;
    if (!S.next(0, cur)) return;
    f32x4 acc[2][2][4][2];
#pragma unroll
    for (int a = 0; a < 2; ++a)
#pragma unroll
        for (int b = 0; b < 2; ++b)
#pragma unroll
            for (int m = 0; m < 4; ++m)
#pragma unroll
                for (int n = 0; n < 2; ++n) acc[a][b][m][n] = (f32x4){0.f, 0.f, 0.f, 0.f};
    bf16x8 At[4][2], B0[2][2], B1[2][2];
    const char* cA = (const char*)g.A + (size_t)cur.pm * tstep; const char* cB = (const char*)g.Bt + (size_t)cur.pb * tstep;
    S.a_ready(cur);
    if constexpr (SP2) {
        PG8_STAGE(PG8_SB(0, 0), cB, voffB); PG8_STAGE(PG8_SB(0, 1), cB + hstep, voffB); PG8_STAGE(PG8_SA(0, 0), cA, voffA); PG8_STAGE(PG8_SA(0, 1), cA + hstep, voffA);
        if (wr == 1) PG8_BAR;
        PG8_WAIT_V(2); PG8_BAR;
        PG8_STAGE(PG8_SB(1, 0), cB + kstep, voffB); PG8_STAGE(PG8_SA(1, 0), cA + kstep, voffA); PG8_STAGE(PG8_SB(1, 1), cB + hstep + kstep, voffB);
        PG8_WAIT_V(6); PG8_BAR;
    } else {
        PG8_STAGE(PG8_SB(0, 0), cB, voffB); PG8_STAGE(PG8_SA(0, 0), cA, voffA); PG8_STAGE(PG8_SB(0, 1), cB + hstep, voffB); PG8_STAGE(PG8_SA(0, 1), cA + hstep, voffA);
        if (wr == 1) PG8_BAR;
        PG8_WAIT_V(4); PG8_BAR;
        PG8_STAGE(PG8_SB(1, 0), cB + kstep, voffB); PG8_STAGE(PG8_SA(1, 0), cA + kstep, voffA); PG8_STAGE(PG8_SB(1, 1), cB + hstep + kstep, voffB);
        PG8_WAIT_V(6); PG8_BAR;
    }
    for (;;) {
        const bool has_next = S.next(ui + 1, nxt);
        const char* nA = has_next ? (const char*)g.A + (size_t)nxt.pm * tstep : cA; const char* nB = has_next ? (const char*)g.Bt + (size_t)nxt.pb * tstep : cB;
        for (int t = 0; t < nt; t += 2) {
            const bool last = (t == nt - 2);
            const char* a1 = cA + (size_t)(t + 1) * kstep;
            const char* a2 = last ? nA : cA + (size_t)(t + 2) * kstep; const char* b2 = last ? nB : cB + (size_t)(t + 2) * kstep;
            const char* a3 = a2 + kstep; const char* b3 = b2 + kstep;
            if (last && has_next) S.a_ready(nxt);
            if constexpr (SP2) {
            PG8_LDB(B0, 0, 0); PG8_LDB(B1, 0, 1); PG8_SCHED; PG8_LDA(At, 0, 0); PG8_STAGE(PG8_SA(1, 1), a1 + hstep, voffA);
            PG8_WAIT_V(8); PG8_WAIT_L(0); PG8_BAR; PG8_MMA(0, 0, At, B0); PG8_MMA(0, 1, At, B1); PG8_BAR; PG8_SCHED;
            PG8_LDA(At, 0, 1); PG8_STAGE(PG8_SB(0, 0), b2, voffB); PG8_STAGE(PG8_SB(0, 1), b2 + hstep, voffB); PG8_STAGE(PG8_SA(0, 0), a2, voffA);
            PG8_WAIT_V(8); PG8_WAIT_L(0); PG8_BAR; PG8_MMA(1, 0, At, B0); PG8_MMA(1, 1, At, B1); PG8_BAR; PG8_SCHED;
            PG8_LDB(B0, 1, 0); PG8_LDB(B1, 1, 1); PG8_SCHED; PG8_LDA(At, 1, 0); PG8_STAGE(PG8_SA(0, 1), a2 + hstep, voffA);
            PG8_WAIT_V(8); PG8_WAIT_L(0); PG8_BAR; PG8_MMA(0, 0, At, B0); PG8_MMA(0, 1, At, B1); PG8_BAR; PG8_SCHED;
            PG8_LDA(At, 1, 1); PG8_STAGE(PG8_SB(1, 0), b3, voffB); PG8_STAGE(PG8_SB(1, 1), b3 + hstep, voffB); PG8_STAGE(PG8_SA(1, 0), a3, voffA);
            PG8_WAIT_V(8); PG8_WAIT_L(0); PG8_BAR; PG8_MMA(1, 0, At, B0); PG8_MMA(1, 1, At, B1); PG8_BAR; PG8_SCHED;
            } else {
            PG8_LDB(B0, 0, 0); PG8_SCHED; PG8_LDA(At, 0, 0); PG8_STAGE(PG8_SA(1, 1), a1 + hstep, voffA);
            PG8_WAIT_L(8); PG8_BAR; PG8_WAIT_L(0); PG8_MMA(0, 0, At, B0); PG8_BAR; PG8_SCHED;
            PG8_LDB(B1, 0, 1); PG8_STAGE(PG8_SB(0, 0), b2, voffB);
            PG8_BAR; PG8_WAIT_L(0); PG8_MMA(0, 1, At, B1); PG8_BAR;
            PG8_LDA(At, 0, 1); PG8_STAGE(PG8_SA(0, 0), a2, voffA);
            PG8_BAR; PG8_WAIT_L(0); PG8_MMA(1, 0, At, B0); PG8_BAR; PG8_SCHED;
            PG8_STAGE(PG8_SB(0, 1), b2 + hstep, voffB);
            PG8_WAIT_V(6); PG8_BAR; PG8_MMA(1, 1, At, B1); PG8_BAR;
            PG8_LDB(B0, 1, 0); PG8_SCHED; PG8_LDA(At, 1, 0); PG8_STAGE(PG8_SA(0, 1), a2 + hstep, voffA);
            PG8_WAIT_L(8); PG8_BAR; PG8_WAIT_L(0); PG8_MMA(0, 0, At, B0); PG8_BAR; PG8_SCHED;
            PG8_LDB(B1, 1, 1); PG8_STAGE(PG8_SB(1, 0), b3, voffB);
            PG8_BAR; PG8_WAIT_L(0); PG8_MMA(0, 1, At, B1); PG8_BAR;
            PG8_LDA(At, 1, 1); PG8_STAGE(PG8_SA(1, 0), a3, voffA);
            PG8_BAR; PG8_WAIT_L(0); PG8_MMA(1, 0, At, B0); PG8_BAR; PG8_SCHED;
            PG8_STAGE(PG8_SB(1, 1), b3 + hstep, voffB);
            PG8_WAIT_V(6); PG8_BAR; PG8_MMA(1, 1, At, B1); PG8_BAR;
            }
        }
        if constexpr (ALIGN_EPI) { if (wr == 0) PG8_BAR; }
        if constexpr (!Epi::AFTER_DRAIN) {
            if constexpr (FP8 || Epi::FRESH) { int l2_; asm volatile("v_mbcnt_lo_u32_b32 %0, -1, 0\n\tv_mbcnt_hi_u32_b32 %0, -1, %0" : "=v"(l2_)); E(acc, cur, wr, wc, l2_ & 15, l2_ >> 4); }
            else E(acc, cur, wr, wc, fr, fq);
            S.done(cur); }
        if (!has_next) break;
#pragma unroll
        for (int a = 0; a < 2; ++a)
#pragma unroll
            for (int b = 0; b < 2; ++b)
#pragma unroll
                for (int m = 0; m < 4; ++m)
#pragma unroll
                    for (int n = 0; n < 2; ++n) acc[a][b][m][n] = (f32x4){0.f, 0.f, 0.f, 0.f};
        cur = nxt; cA = nA; cB = nB; ++ui;
        if constexpr (ALIGN_EPI) { if (wr == 1) PG8_BAR; }
    }
    PG8_WAIT_V(0);
    if constexpr (!ALIGN_EPI) { if (wr == 0) PG8_BAR; }
    PG8_BAR;
    if constexpr (Epi::AFTER_DRAIN) { E.fused(acc, cur, wr, wc, fr, fq, lds, wid, lane); S.done(cur); }
#undef PG8_SA
#undef PG8_SB
#undef PG8_STAGE
#undef PG8_LDA
#undef PG8_LDB
#undef PG8_MMA
#undef PG8_WAIT_V
#undef PG8_WAIT_L
#undef PG8_BAR
#undef PG8_SCHED
}
}
#include <hip/hip_bf16.h>
#include <cmath>
namespace attn_body {
using bf16=__hip_bfloat16;
using bf16x8=__attribute__((ext_vector_type(8)))short;
using s16x4=__attribute__((ext_vector_type(4)))short;
using f32x16=__attribute__((ext_vector_type(16)))float;
using u32x4=__attribute__((ext_vector_type(4)))unsigned;
constexpr int D=64;
constexpr int NW=8,QBLK=32,QB=QBLK*NW,KVBLK=64;
constexpr int ATTN_UNIT_ROWS=QB;
__device__ __forceinline__ int crow(int r,int hi){return (r&3)+8*(r>>2)+4*hi;}
#define SBAR() __builtin_amdgcn_sched_barrier(0)
__device__ __forceinline__ void cmask_blk(f32x16&p0,f32x16&p1,int jb,int wid){
  if(jb>(wid>>1)){ const float NEG=-INFINITY;
    #pragma unroll
    for(int r=0;r<16;++r){p0[r]=NEG;p1[r]=NEG;} }
}
__device__ __forceinline__ void alibi(f32x16&p0,f32x16&p1,float dq,float nsl2){
  #pragma unroll
  for(int r=0;r<16;++r){ const float e=(float)((r&3)+8*(r>>2)); p0[r]=__builtin_fmaf(__builtin_fabsf(dq-e),nsl2,p0[r]); p1[r]=__builtin_fmaf(__builtin_fabsf(dq-e-32.f),nsl2,p1[r]); }
}

constexpr int NSLOT=3, SLOTB=8192;
constexpr int LDS_K=0, LDS_V=NSLOT*SLOTB, LDS_WS=2*NSLOT*SLOTB, LDS_OST=LDS_WS+NW*64*4, LDS_BYTES=LDS_OST+NW*4096;
constexpr float C2=0.125f*1.4426950408889634f;
__device__ __forceinline__ void glds16(const void*gsrc,unsigned lds_dst){unsigned keep;
  asm volatile("s_mov_b32 %0, m0\n\ts_mov_b32 m0, %2\n\ts_nop 0\n\tglobal_load_lds_dwordx4 %1, off\n\ts_mov_b32 m0, %0":"=&s"(keep):"v"(gsrc),"s"(lds_dst):"memory");}
__device__ __forceinline__ float max3f(float a,float b,float c){float r;asm("v_max3_f32 %0, %1, %2, %3":"=v"(r):"v"(a),"v"(b),"v"(c));return r;}
__device__ __forceinline__ float max2f(float a,float b){float r;asm("v_max_f32_e32 %0, %1, %2":"=v"(r):"v"(a),"v"(b));return r;}
__device__ __forceinline__ float fadd_s(float a,float b){float r;asm("v_add_f32_e32 %0, %1, %2":"=v"(r):"v"(a),"v"(b));return r;}
__device__ __forceinline__ float fsub_s(float a,float b){float r;asm("v_sub_f32_e32 %0, %1, %2":"=v"(r):"v"(a),"v"(b));return r;}
typedef float f32x2_t __attribute__((ext_vector_type(2))); typedef __bf16 bf16x2_t __attribute__((ext_vector_type(2)));
__device__ __forceinline__ unsigned cvtpk_s(float lo,float hi){f32x2_t v={lo,hi};bf16x2_t b=__builtin_convertvector(v,bf16x2_t);return __builtin_bit_cast(unsigned,b);}
#define WAIT_BAR(N) asm volatile("s_waitcnt vmcnt(" #N ") lgkmcnt(0)\n\ts_barrier":::"memory")

__device__ __forceinline__ void qkt(f32x16&p0,f32x16&p1,const char*Kslot,const bf16x8*qr,const f32x16&negm,int r32,int hi){
  const char*kb=Kslot+hi*1024+r32*16;
  #pragma unroll
  for(int d0=0;d0<4;++d0){
    const bf16x8 b0=*reinterpret_cast<const bf16x8*>(kb+d0*2048);
    const bf16x8 b1=*reinterpret_cast<const bf16x8*>(kb+d0*2048+512);
    if(d0==0){p0=__builtin_amdgcn_mfma_f32_32x32x16_bf16(b0,qr[0],negm,0,0,0);p1=__builtin_amdgcn_mfma_f32_32x32x16_bf16(b1,qr[0],negm,0,0,0);}
    else{p0=__builtin_amdgcn_mfma_f32_32x32x16_bf16(b0,qr[d0],p0,0,0,0);p1=__builtin_amdgcn_mfma_f32_32x32x16_bf16(b1,qr[d0],p1,0,0,0);}}
}
typedef __attribute__((address_space(3))) const char* lds_cptr;
typedef short v4i16_t __attribute__((ext_vector_type(4)));
__device__ __forceinline__ void kload8(bf16x8*kf,lds_cptr kp){
  kf[0]=*(const __attribute__((address_space(3))) bf16x8*)(kp);      kf[1]=*(const __attribute__((address_space(3))) bf16x8*)(kp+512);
  kf[2]=*(const __attribute__((address_space(3))) bf16x8*)(kp+2048); kf[3]=*(const __attribute__((address_space(3))) bf16x8*)(kp+2560);
  kf[4]=*(const __attribute__((address_space(3))) bf16x8*)(kp+4096); kf[5]=*(const __attribute__((address_space(3))) bf16x8*)(kp+4608);
  kf[6]=*(const __attribute__((address_space(3))) bf16x8*)(kp+6144); kf[7]=*(const __attribute__((address_space(3))) bf16x8*)(kp+6656);
}
__device__ __forceinline__ void kload2(bf16x8*kf,lds_cptr kp,int j){ kf[2*j]=*(const __attribute__((address_space(3))) bf16x8*)(kp+j*2048); kf[2*j+1]=*(const __attribute__((address_space(3))) bf16x8*)(kp+j*2048+512); }
__device__ __forceinline__ s16x4 vtr(lds_cptr p){ return __builtin_bit_cast(s16x4,__builtin_amdgcn_ds_read_tr16_b64_v4i16((__attribute__((address_space(3))) v4i16_t*)p)); }
__device__ __forceinline__ float rowmax(const f32x16&p0,const f32x16&p1){
  float a=max3f(p0[0],p0[1],p1[0]),b=max3f(p0[2],p0[3],p1[1]);a=max3f(a,p1[2],p1[3]);
  #pragma unroll
  for(int r=4;r<16;r+=4){a=max3f(a,p0[r],p0[r+1]);b=max3f(b,p0[r+2],p0[r+3]);a=max3f(a,p1[r],p1[r+1]);b=max3f(b,p1[r+2],p1[r+3]);}
  const float m=max2f(a,b);
  auto rr=__builtin_amdgcn_permlane32_swap(__float_as_uint(m),__float_as_uint(m),false,false);
  return max2f(__uint_as_float(rr[0]),__uint_as_float(rr[1]));
}
__device__ __forceinline__ void pv(f32x16*o,int vb,bf16x8 pa0,bf16x8 pa1,bf16x8 pa2,bf16x8 pa3){
  #pragma unroll
  for(int d0=0;d0<2;++d0){s16x4 lo[4],hi[4];
    #pragma unroll
    for(int ks=0;ks<4;++ks){
      asm volatile("ds_read_b64_tr_b16 %0,%1 offset:%c2":"=&v"(lo[ks]):"v"(vb),"i"(d0*4096+ks*1024):"memory");
      asm volatile("ds_read_b64_tr_b16 %0,%1 offset:%c2":"=&v"(hi[ks]):"v"(vb),"i"(d0*4096+ks*1024+512):"memory");}
    asm volatile("s_waitcnt lgkmcnt(0)":::"memory");SBAR();
    #define PK(k) (bf16x8){lo[k][0],lo[k][1],lo[k][2],lo[k][3],hi[k][0],hi[k][1],hi[k][2],hi[k][3]}
    o[d0]=__builtin_amdgcn_mfma_f32_32x32x16_bf16(pa0,PK(0),o[d0],0,0,0);
    o[d0]=__builtin_amdgcn_mfma_f32_32x32x16_bf16(pa1,PK(1),o[d0],0,0,0);
    o[d0]=__builtin_amdgcn_mfma_f32_32x32x16_bf16(pa2,PK(2),o[d0],0,0,0);
    o[d0]=__builtin_amdgcn_mfma_f32_32x32x16_bf16(pa3,PK(3),o[d0],0,0,0);
    #undef PK
  }
}

#ifndef ATTN_STORE16
#define ATTN_STORE16(p,v) (*(u32x4*)(p)=(v))
#endif
template<int MODE,int THRL> __device__ __forceinline__ void attn_unit(const bf16*Qb,int qp,const bf16*__restrict__ Kh,int kp,const bf16*__restrict__ Vh,int vp,bf16*Ob,int op,int NT,int q0,float nsl2,char*shm,const int wid_in){
  int lane_; asm volatile("v_mbcnt_lo_u32_b32 %0, -1, 0\n\tv_mbcnt_hi_u32_b32 %0, -1, %0":"=v"(lane_)); const int lane=lane_,r32=lane&31,hi=lane>>5; const int wid=wid_in,tid=wid*64+lane; (void)tid;
  const bf16*Qw=Qb+(long)(wid*QBLK)*qp;
  const unsigned lds0=(unsigned)(uintptr_t)shm;
  float*wsf=(float*)(shm+LDS_WS)+wid*64;
  const bf16*ksrc=Kh+(long)lane*kp+wid*8;
  const bf16*vsrc=Vh+(long)(16*(wid&3)+(lane>>2))*vp+(wid>>2)*32+(lane&3)*8;
  const unsigned kdst=lds0+LDS_K+wid*1024, vdst=lds0+LDS_V+wid*1024;
  #define DMA_K(t,slot) glds16(ksrc+(long)(t)*KVBLK*kp,(unsigned)__builtin_amdgcn_readfirstlane(kdst+(slot)))
  #define DMA_V(t,slot) glds16(vsrc+(long)(t)*KVBLK*vp,(unsigned)__builtin_amdgcn_readfirstlane(vdst+(slot)))
  const int vb0=(int)(lds0+LDS_V)+((lane>>4)&1)*32+(lane&3)*8+(4*hi+((lane&15)>>2))*64;
  const char*Kbase=shm+LDS_K; bf16x8 kf[8];
  const lds_cptr shm3=(lds_cptr)shm; const lds_cptr kp0=shm3+LDS_K+hi*1024+r32*16; const lds_cptr vp0=shm3+LDS_V+((lane>>4)&1)*32+(lane&3)*8+(4*hi+((lane&15)>>2))*64;
  DMA_K(0,0);DMA_V(0,0);DMA_K(1,SLOTB);
  bf16x8 qr[4];
  #pragma unroll
  for(int d0=0;d0<4;++d0)qr[d0]=*reinterpret_cast<const bf16x8*>(&Qw[(long)r32*qp+d0*16+hi*8]);
  float mhat=0.f,l_reg=0.f;f32x16 o[2];float z_=0.f;asm volatile("":"+v"(z_));
  _Pragma("unroll") for(int r=0;r<16;++r){o[0][r]=z_;o[1][r]=z_;} f32x16 negm;_Pragma("unroll") for(int r=0;r<16;++r)negm[r]=z_;asm volatile("":"+v"(negm));
  const float dq0=(float)(q0+wid*QBLK+r32-4*hi);
  #define ALIBI(P0,P1,t) do{ if(MODE==0) alibi(P0,P1,dq0-(float)(64*(t)),nsl2); }while(0)
  #define CMASK(P0,P1,t) do{ if(MODE==0){int jb_=(t)-(NT-4); if(jb_>=0)cmask_blk(P0,P1,jb_,wid);} }while(0)
  bool resc=false;
  #define START(P0,P1) do{ const float rm=rm0_; resc=false; \
    { const float dl=rm; mhat=fadd_s(mhat,dl); \
      _Pragma("unroll") for(int r=0;r<16;++r){P0[r]=fsub_s(P0[r],dl);P1[r]=fsub_s(P1[r],dl);} \
      _Pragma("unroll") for(int r=0;r<16;++r)negm[r]=-mhat; asm volatile("":"+v"(negm)); } \
    _Pragma("unroll") for(int r=0;r<16;++r)P0[r]=__builtin_amdgcn_exp2f(P0[r]); }while(0)
  #define RESC() do{ if(resc){ asm volatile("s_waitcnt lgkmcnt(0)":::"memory"); \
      _Pragma("unroll") for(int d_=0;d_<2;++d_) _Pragma("unroll") for(int r=0;r<16;++r)o[d_][r]*=wsf[crow(r,hi)]; } }while(0)
  f32x16 pA0,pA1,pB0,pB1;
  int sl_prev=0,sl_cur=0,sl_next=SLOTB;
  #define ROT() do{sl_prev=sl_cur;sl_cur=sl_next;sl_next=(sl_next==(NSLOT-1)*SLOTB)?0:sl_next+SLOTB;}while(0)
  DMA_K(2,2*SLOTB);
  WAIT_BAR(3);
  qkt(pA0,pA1,Kbase,qr,negm,r32,hi);asm volatile("s_nop 15\n\ts_nop 7":"+v"(pA0),"+v"(pA1));const float rm0_=rowmax(pA0,pA1);
  ALIBI(pA0,pA1,0);CMASK(pA0,pA1,0);
  START(pA0,pA1);
  _Pragma("unroll") for(int r=0;r<16;++r)pA1[r]=__builtin_amdgcn_exp2f(pA1[r]);
  WAIT_BAR(0);
  DMA_K(3,0);DMA_V(1,SLOTB);
  ROT();
  kload8(kf,kp0+sl_cur);
  WAIT_BAR(2);
  s16x4 vlo[8],vhi[8]; u32x4 pw0,pw1,pw2,pw3;
  #define PKW(P,B) cvtpk_s(P[B],P[B+1])
  #define PAF(k) __builtin_bit_cast(bf16x8,pw##k)
  #define VFR(i) (bf16x8){vlo[i][0],vlo[i][1],vlo[i][2],vlo[i][3],vhi[i][0],vhi[i][1],vhi[i][2],vhi[i][3]}
  #define PIN(x) asm volatile("":"+v"(x))
  #define MX3(a,b,c) __builtin_fmaxf(__builtin_fmaxf((a),(b)),(c))
  #define GAPA(MF,A0,A1,A2,A3,W0,W1,PW) do{ MF; sacc+=A0; sacc+=A1; sacc+=A2; sacc+=A3; PIN(sacc); W0; W1; PIN(PW); SBAR(); }while(0)
  #define EX(v) __builtin_amdgcn_exp2f(v)
  #define GAPB(MF,X,B) do{ MF; X[B]=EX(X[B]); X[B+1]=EX(X[B+1]); X[B+2]=EX(X[B+2]); X[B+3]=EX(X[B+3]); PIN(X); SBAR(); }while(0)
  #define VRD(i) do{ vlo[i]=vtr(vp_+(((i)>>2)*4096+((i)&3)*1024)); vhi[i]=vtr(vp_+(((i)>>2)*4096+((i)&3)*1024+512)); }while(0)
  #define KRD(G,j) do{ if(G){ kload2(kf,kp0+sl_next,j); SBAR(); } }while(0)
  #define STEP(C0,C1,P0,P1,t,GK,GV,GL) do{ SBAR(); \
    const lds_cptr vp_=vp0+sl_prev; \
    VRD(0); SBAR(); float sacc=(P0[0]+P0[1]); \
    GAPA(C0=__builtin_amdgcn_mfma_f32_32x32x16_bf16(kf[0],qr[0],negm,0,0,0), P0[2],P0[3],P0[4],P0[5],     pw0[0]=PKW(P0,0), pw0[1]=PKW(P0,2), pw0); \
    VRD(4); SBAR(); GAPA(C1=__builtin_amdgcn_mfma_f32_32x32x16_bf16(kf[1],qr[0],negm,0,0,0), P0[6],P0[7],P0[8],P0[9],     pw0[2]=PKW(P0,4), pw0[3]=PKW(P0,6), pw0); \
    VRD(1); SBAR(); GAPA(C0=__builtin_amdgcn_mfma_f32_32x32x16_bf16(kf[2],qr[1],C0,0,0,0),   P0[10],P0[11],P0[12],P0[13], pw1[0]=PKW(P0,8), pw1[1]=PKW(P0,10), pw1); \
    VRD(5); SBAR(); GAPA(C1=__builtin_amdgcn_mfma_f32_32x32x16_bf16(kf[3],qr[1],C1,0,0,0),   P0[14],P0[15],P1[0],P1[1],   pw1[2]=PKW(P0,12),pw1[3]=PKW(P0,14), pw1); \
    VRD(2); SBAR(); GAPA(C0=__builtin_amdgcn_mfma_f32_32x32x16_bf16(kf[4],qr[2],C0,0,0,0),   P1[2],P1[3],P1[4],P1[5],     pw2[0]=PKW(P1,0), pw2[1]=PKW(P1,2), pw2); \
    VRD(6); SBAR(); GAPA(C1=__builtin_amdgcn_mfma_f32_32x32x16_bf16(kf[5],qr[2],C1,0,0,0),   P1[6],P1[7],P1[8],P1[9],     pw2[2]=PKW(P1,4), pw2[3]=PKW(P1,6), pw2); \
    VRD(3); SBAR(); GAPA(C0=__builtin_amdgcn_mfma_f32_32x32x16_bf16(kf[6],qr[3],C0,0,0,0),   P1[10],P1[11],P1[12],P1[13], pw3[0]=PKW(P1,8), pw3[1]=PKW(P1,10), pw3); \
    VRD(7); SBAR(); GAPA(C1=__builtin_amdgcn_mfma_f32_32x32x16_bf16(kf[7],qr[3],C1,0,0,0),   P1[14],P1[15],0.f,0.f,       pw3[2]=PKW(P1,12),pw3[3]=PKW(P1,14), pw3); \
    l_reg+=sacc; \
    if(GK){DMA_K((t)+3,sl_cur);} if(GV){DMA_V((t)+1,sl_next);} \
    ALIBI(C0,C1,t); CMASK(C0,C1,t); \
    { float a=MX3(C0[0],C0[1],C1[0]),b=MX3(C0[2],C0[3],C1[1]); a=MX3(a,C1[2],C1[3]); \
      _Pragma("unroll") for(int r=4;r<16;r+=4){a=MX3(a,C0[r],C0[r+1]);b=MX3(b,C0[r+2],C0[r+3]);a=MX3(a,C1[r],C1[r+1]);b=MX3(b,C1[r+2],C1[r+3]);} \
      float rm=__builtin_fmaxf(a,b); { auto rr=__builtin_amdgcn_permlane32_swap(__float_as_uint(rm),__float_as_uint(rm),false,false); rm=__builtin_fmaxf(__uint_as_float(rr[0]),__uint_as_float(rr[1])); } \
      resc=false; \
      if(__builtin_expect(__any(rm>(float)THRL),0)){ const float dl=__builtin_fmaxf(rm,0.f); mhat+=dl; \
        _Pragma("unroll") for(int r=0;r<16;++r){C0[r]-=dl;C1[r]-=dl;} \
        _Pragma("unroll") for(int r=0;r<16;++r)negm[r]=-mhat; asm volatile("":"+v"(negm)); \
        const float f=__builtin_amdgcn_exp2f(-dl); l_reg*=f; if(hi==0)wsf[r32]=f; resc=true; } } \
    SBAR(); \
    GAPB(o[0]=__builtin_amdgcn_mfma_f32_32x32x16_bf16(PAF(0),VFR(0),o[0],0,0,0), C0,0); \
    GAPB(o[1]=__builtin_amdgcn_mfma_f32_32x32x16_bf16(PAF(0),VFR(4),o[1],0,0,0), C0,4); \
    KRD(GL,0); GAPB(o[0]=__builtin_amdgcn_mfma_f32_32x32x16_bf16(PAF(1),VFR(1),o[0],0,0,0), C0,8); \
    KRD(GL,1); GAPB(o[1]=__builtin_amdgcn_mfma_f32_32x32x16_bf16(PAF(1),VFR(5),o[1],0,0,0), C0,12); \
    KRD(GL,2); GAPB(o[0]=__builtin_amdgcn_mfma_f32_32x32x16_bf16(PAF(2),VFR(2),o[0],0,0,0), C1,0); \
    KRD(GL,3); GAPB(o[1]=__builtin_amdgcn_mfma_f32_32x32x16_bf16(PAF(2),VFR(6),o[1],0,0,0), C1,4); \
    GAPB(o[0]=__builtin_amdgcn_mfma_f32_32x32x16_bf16(PAF(3),VFR(3),o[0],0,0,0), C1,8); \
    GAPB(o[1]=__builtin_amdgcn_mfma_f32_32x32x16_bf16(PAF(3),VFR(7),o[1],0,0,0), C1,12); \
    }while(0)
  int t=1;
  #undef CMASK
  #define CMASK(P0,P1,t) do{}while(0)
  for(;t+5<NT;t+=2){
    STEP(pB0,pB1,pA0,pA1,t,true,true,true);     WAIT_BAR(2); RESC(); ROT();
    STEP(pA0,pA1,pB0,pB1,t+1,true,true,true);   WAIT_BAR(2); RESC(); ROT();
  }
  #undef CMASK
  #define CMASK(P0,P1,t) do{ if(MODE==0){int jb_=(t)-(NT-4); if(jb_>=0)cmask_blk(P0,P1,jb_,wid);} }while(0)
  #define ENDW(tt) do{ if((tt)+3<NT){WAIT_BAR(2);} else if((tt)+2<NT){WAIT_BAR(1);} else {WAIT_BAR(0);} }while(0)
  for(;t+1<NT;t+=2){
    STEP(pB0,pB1,pA0,pA1,t,(t+3<NT),(t+1<NT),(t+1<NT));       ENDW(t);   RESC(); ROT();
    STEP(pA0,pA1,pB0,pB1,t+1,(t+4<NT),(t+2<NT),(t+2<NT));     ENDW(t+1); RESC(); ROT();
  }
  STEP(pB0,pB1,pA0,pA1,NT-1,false,false,false); RESC();
  { float sacc=pB0[0]+pB0[1]; _Pragma("unroll") for(int r=2;r<16;++r)sacc+=pB0[r]; _Pragma("unroll") for(int r=0;r<16;++r)sacc+=pB1[r]; l_reg+=sacc;
    pw0=(u32x4){PKW(pB0,0),PKW(pB0,2),PKW(pB0,4),PKW(pB0,6)};pw1=(u32x4){PKW(pB0,8),PKW(pB0,10),PKW(pB0,12),PKW(pB0,14)};pw2=(u32x4){PKW(pB1,0),PKW(pB1,2),PKW(pB1,4),PKW(pB1,6)};pw3=(u32x4){PKW(pB1,8),PKW(pB1,10),PKW(pB1,12),PKW(pB1,14)};
    SBAR(); pv(o,vb0+sl_cur,PAF(0),PAF(1),PAF(2),PAF(3)); }
  #undef PKW
  #undef PAF
  #undef VFR
  #undef PIN
  #undef MX3
  #undef GAPA
  #undef GAPB
  #undef EX
  #undef VRD
  #undef KRD
  #undef STEP
  #undef ENDW
  {auto rr=__builtin_amdgcn_permlane32_swap(__float_as_uint(l_reg),__float_as_uint(l_reg),false,false);l_reg=__uint_as_float(rr[0])+__uint_as_float(rr[1]);}
  if(hi==0)wsf[32+r32]=l_reg;asm volatile("s_waitcnt lgkmcnt(0)":::"memory");
  float rli[16];
  #pragma unroll
  for(int r=0;r<16;++r)rli[r]=__builtin_amdgcn_rcpf(wsf[32+crow(r,hi)]);
  bf16*Ow=Ob+(long)(wid*QBLK)*op;
  { bf16*stg=(bf16*)(shm+LDS_OST)+wid*2048;
    #pragma unroll
    for(int r=0;r<16;++r){const int orow=crow(r,hi);
      #pragma unroll
      for(int d0=0;d0<2;++d0)stg[orow*64+d0*32+r32]=__float2bfloat16(o[d0][r]*rli[r]);}
    asm volatile("s_waitcnt lgkmcnt(0)":::"memory");
    #pragma unroll
    for(int i=0;i<4;++i){const int row=i*8+(lane>>3),ch=lane&7; const u32x4 v=*(const u32x4*)(stg+row*64+ch*8); ATTN_STORE16(Ow+(long)row*op+ch*8,v);} }
  asm volatile("s_waitcnt lgkmcnt(0)\n\ts_barrier":::"memory");
  #undef DMA_K
  #undef DMA_V
  #undef CMASK
  #undef ALIBI
  #undef START
  #undef RESC
  #undef ROT
}
constexpr int L2_K=0, L2_V0=NSLOT*SLOTB, L2_V1=2*NSLOT*SLOTB, L2_WS=3*NSLOT*SLOTB, L2_QS=L2_WS+NW*64*4, L2_QSW=4608, LDS2_BYTES=L2_QS+NW*L2_QSW;
template<int THRL> __device__ __forceinline__ void attn_unit2(const bf16*Qb,int qp,const bf16*__restrict__ Kh,int kp,const bf16*__restrict__ Vh,int vp,bf16*Ob,int op,int NT,int q0,float nsl2,char*shm,const int wid_in){
  int lane_; asm volatile("v_mbcnt_lo_u32_b32 %0, -1, 0\n\tv_mbcnt_hi_u32_b32 %0, -1, %0":"=v"(lane_)); const int lane=lane_,r32=lane&31,hi=lane>>5; const int wid=wid_in,tid=wid*64+lane; (void)tid; constexpr int MODE=0;
  const bf16*Qw=Qb+(long)(wid*QBLK)*qp;
  const unsigned lds0=(unsigned)(uintptr_t)shm;
  float*wsf=(float*)(shm+L2_WS)+wid*64;
  const bf16*ksrc=Kh+(long)lane*kp+wid*8;
  const bf16*vsrc=Vh+(long)(16*(wid&3)+(lane>>2))*vp+(wid>>2)*32+(lane&3)*8;
  const unsigned kdst=lds0+L2_K+wid*1024, vdst=lds0+L2_V0+wid*1024, vdst1=lds0+L2_V1+wid*1024;
  #define DMA_K(t,slot) glds16(ksrc+(long)(t)*KVBLK*kp,(unsigned)__builtin_amdgcn_readfirstlane(kdst+(slot)))
  #define DMA_V(t,slot) do{ glds16(vsrc+(long)(t)*KVBLK*vp,(unsigned)__builtin_amdgcn_readfirstlane(vdst+(slot))); glds16(vsrc+64+(long)(t)*KVBLK*vp,(unsigned)__builtin_amdgcn_readfirstlane(vdst1+(slot))); }while(0)
  const int vb0=(int)(lds0+L2_V0)+((lane>>4)&1)*32+(lane&3)*8+(4*hi+((lane&15)>>2))*64, vb1=vb0+(L2_V1-L2_V0);
  const char*Kbase=shm+L2_K; bf16x8 kf[8];
  const lds_cptr shm3=(lds_cptr)shm; const lds_cptr kp0=shm3+L2_K+hi*1024+r32*16; const lds_cptr vp0=shm3+L2_V0+((lane>>4)&1)*32+(lane&3)*8+(4*hi+((lane&15)>>2))*64; const lds_cptr qf0=shm3+L2_QS+wid*L2_QSW+r32*144+hi*16;
  DMA_K(0,0);DMA_V(0,0);DMA_K(1,SLOTB);
  bf16x8 qr[4];
  #pragma unroll
  for(int d0=0;d0<4;++d0)qr[d0]=*reinterpret_cast<const bf16x8*>(&Qw[(long)r32*qp+d0*16+hi*8]);
  float mhat=0.f,l_reg=0.f;f32x16 o[4];float z_=0.f;asm volatile("":"+v"(z_));
  _Pragma("unroll") for(int r=0;r<16;++r){o[0][r]=z_;o[1][r]=z_;o[2][r]=z_;o[3][r]=z_;}
  const f32x16 ZERO={0.f,0.f,0.f,0.f,0.f,0.f,0.f,0.f,0.f,0.f,0.f,0.f,0.f,0.f,0.f,0.f};
  const float dq0=(float)(q0+wid*QBLK+r32-4*hi);
  #define ALIBI(P0,P1,t) do{ alibi(P0,P1,dq0-(float)(64*(t)),nsl2); _Pragma("unroll") for(int r=0;r<16;++r){P0[r]-=mhat;P1[r]-=mhat;} }while(0)
  #define ALIBIF(P0,P1,t) do{ const float a_=__builtin_fmaf(nsl2,dq0-(float)(64*(t)),-mhat); _Pragma("unroll") for(int r=0;r<16;++r){ const float e_=(float)((r&3)+8*(r>>2)); P0[r]=__builtin_fmaf(e_,-nsl2,P0[r]+a_); P1[r]=__builtin_fmaf(e_+32.f,-nsl2,P1[r]+a_); } }while(0)
  #define CMASK(P0,P1,t) do{ if(MODE==0){int jb_=(t)-(NT-4); if(jb_>=0)cmask_blk(P0,P1,jb_,wid);} }while(0)
  bool resc=false;
  #define START(P0,P1) do{ const float rm=rm0_; resc=false; \
    { const float dl=rm; mhat=fadd_s(mhat,dl); \
      _Pragma("unroll") for(int r=0;r<16;++r){P0[r]=fsub_s(P0[r],dl);P1[r]=fsub_s(P1[r],dl);} \
      } \
    _Pragma("unroll") for(int r=0;r<16;++r)P0[r]=__builtin_amdgcn_exp2f(P0[r]); }while(0)
  #define RESC() do{ if(resc){ asm volatile("s_waitcnt lgkmcnt(0)":::"memory"); \
      _Pragma("unroll") for(int d_=0;d_<4;++d_) _Pragma("unroll") for(int r=0;r<16;++r)o[d_][r]*=wsf[crow(r,hi)]; } }while(0)
  f32x16 pA0,pA1,pB0,pB1;
  int sl_prev=0,sl_cur=0,sl_next=SLOTB;
  #define ROT() do{sl_prev=sl_cur;sl_cur=sl_next;sl_next=(sl_next==(NSLOT-1)*SLOTB)?0:sl_next+SLOTB;}while(0)
  DMA_K(2,2*SLOTB);
  { bf16*qs=(bf16*)(shm+L2_QS+wid*L2_QSW);
    _Pragma("unroll") for(int d0=0;d0<4;++d0)*reinterpret_cast<bf16x8*>(&qs[r32*72+d0*16+hi*8])=qr[d0]; }
  WAIT_BAR(4);
  qkt(pA0,pA1,Kbase,qr,ZERO,r32,hi);asm volatile("s_nop 15\n\ts_nop 7":"+v"(pA0),"+v"(pA1));const float rm0_=rowmax(pA0,pA1);
  ALIBI(pA0,pA1,0);CMASK(pA0,pA1,0);
  START(pA0,pA1);
  _Pragma("unroll") for(int r=0;r<16;++r)pA1[r]=__builtin_amdgcn_exp2f(pA1[r]);
  WAIT_BAR(0);
  DMA_K(3,0);DMA_V(1,SLOTB);
  ROT();
  kload8(kf,kp0+sl_cur);
  WAIT_BAR(3);
  s16x4 vlo[8],vhi[8]; u32x4 pw0,pw1,pw2,pw3;
  #define PKW(P,B) cvtpk_s(P[B],P[B+1])
  #define PAF(k) __builtin_bit_cast(bf16x8,pw##k)
  #define VFR(i) (bf16x8){vlo[i][0],vlo[i][1],vlo[i][2],vlo[i][3],vhi[i][0],vhi[i][1],vhi[i][2],vhi[i][3]}
  #define PIN(x) asm volatile("":"+v"(x))
  #define MX3(a,b,c) __builtin_fmaxf(__builtin_fmaxf((a),(b)),(c))
  #define GAPA(MF,A0,A1,A2,A3,W0,W1,PW) do{ MF; sacc+=A0; sacc+=A1; sacc+=A2; sacc+=A3; PIN(sacc); W0; W1; PIN(PW); SBAR(); }while(0)
  #define EX(v) __builtin_amdgcn_exp2f(v)
  #define GAPB(MF,X,B) do{ MF; X[B]=EX(X[B]); X[B+1]=EX(X[B+1]); X[B+2]=EX(X[B+2]); X[B+3]=EX(X[B+3]); PIN(X); SBAR(); }while(0)
  #define VRD(i) do{ vlo[i]=vtr(vp_+(((i)>>2)*4096+((i)&3)*1024)); vhi[i]=vtr(vp_+(((i)>>2)*4096+((i)&3)*1024+512)); }while(0)
  #define KRD(G,j) do{ if(G){ kload2(kf,kp0+sl_next,j); SBAR(); } }while(0)
  #define QF(d) (*(const __attribute__((address_space(3))) bf16x8*)(qf0+32*(d)))
  #define STEP(C0,C1,P0,P1,t,GK,GV,GL,AL) do{ SBAR(); \
    const lds_cptr vp_=vp0+sl_prev; const bf16x8 q0_=QF(0),q1_=QF(1); \
    VRD(0); SBAR(); float sacc=(P0[0]+P0[1]); \
    GAPA(C0=__builtin_amdgcn_mfma_f32_32x32x16_bf16(kf[0],q0_,ZERO,0,0,0), P0[2],P0[3],P0[4],P0[5],     pw0[0]=PKW(P0,0), pw0[1]=PKW(P0,2), pw0); \
    VRD(4); SBAR(); GAPA(C1=__builtin_amdgcn_mfma_f32_32x32x16_bf16(kf[1],q0_,ZERO,0,0,0), P0[6],P0[7],P0[8],P0[9],     pw0[2]=PKW(P0,4), pw0[3]=PKW(P0,6), pw0); \
    VRD(1); SBAR(); GAPA(C0=__builtin_amdgcn_mfma_f32_32x32x16_bf16(kf[2],q1_,C0,0,0,0),   P0[10],P0[11],P0[12],P0[13], pw1[0]=PKW(P0,8), pw1[1]=PKW(P0,10), pw1); \
    VRD(5); SBAR(); GAPA(C1=__builtin_amdgcn_mfma_f32_32x32x16_bf16(kf[3],q1_,C1,0,0,0),   P0[14],P0[15],P1[0],P1[1],   pw1[2]=PKW(P0,12),pw1[3]=PKW(P0,14), pw1); \
    const bf16x8 q2_=QF(2),q3_=QF(3); \
    VRD(2); SBAR(); GAPA(C0=__builtin_amdgcn_mfma_f32_32x32x16_bf16(kf[4],q2_,C0,0,0,0),   P1[2],P1[3],P1[4],P1[5],     pw2[0]=PKW(P1,0), pw2[1]=PKW(P1,2), pw2); \
    VRD(6); SBAR(); GAPA(C1=__builtin_amdgcn_mfma_f32_32x32x16_bf16(kf[5],q2_,C1,0,0,0),   P1[6],P1[7],P1[8],P1[9],     pw2[2]=PKW(P1,4), pw2[3]=PKW(P1,6), pw2); \
    VRD(3); SBAR(); GAPA(C0=__builtin_amdgcn_mfma_f32_32x32x16_bf16(kf[6],q3_,C0,0,0,0),   P1[10],P1[11],P1[12],P1[13], pw3[0]=PKW(P1,8), pw3[1]=PKW(P1,10), pw3); \
    VRD(7); SBAR(); GAPA(C1=__builtin_amdgcn_mfma_f32_32x32x16_bf16(kf[7],q3_,C1,0,0,0),   P1[14],P1[15],0.f,0.f,       pw3[2]=PKW(P1,12),pw3[3]=PKW(P1,14), pw3); \
    l_reg+=sacc; \
    if(GK){DMA_K((t)+3,sl_cur);} if(GV){DMA_V((t)+1,sl_next);} \
    AL(C0,C1,t); CMASK(C0,C1,t); \
    { float a=MX3(C0[0],C0[1],C1[0]),b=MX3(C0[2],C0[3],C1[1]); a=MX3(a,C1[2],C1[3]); \
      _Pragma("unroll") for(int r=4;r<16;r+=4){a=MX3(a,C0[r],C0[r+1]);b=MX3(b,C0[r+2],C0[r+3]);a=MX3(a,C1[r],C1[r+1]);b=MX3(b,C1[r+2],C1[r+3]);} \
      float rm=__builtin_fmaxf(a,b); { auto rr=__builtin_amdgcn_permlane32_swap(__float_as_uint(rm),__float_as_uint(rm),false,false); rm=__builtin_fmaxf(__uint_as_float(rr[0]),__uint_as_float(rr[1])); } \
      resc=false; \
      if(__builtin_expect(__any(rm>(float)THRL),0)){ const float dl=__builtin_fmaxf(rm,0.f); mhat+=dl; \
        _Pragma("unroll") for(int r=0;r<16;++r){C0[r]-=dl;C1[r]-=dl;} \
        const float f=__builtin_amdgcn_exp2f(-dl); l_reg*=f; if(hi==0)wsf[r32]=f; resc=true; } } \
    SBAR(); \
    GAPB(o[0]=__builtin_amdgcn_mfma_f32_32x32x16_bf16(PAF(0),VFR(0),o[0],0,0,0), C0,0); \
    GAPB(o[1]=__builtin_amdgcn_mfma_f32_32x32x16_bf16(PAF(0),VFR(4),o[1],0,0,0), C0,4); \
    KRD(GL,0); GAPB(o[0]=__builtin_amdgcn_mfma_f32_32x32x16_bf16(PAF(1),VFR(1),o[0],0,0,0), C0,8); \
    KRD(GL,1); GAPB(o[1]=__builtin_amdgcn_mfma_f32_32x32x16_bf16(PAF(1),VFR(5),o[1],0,0,0), C0,12); \
    KRD(GL,2); GAPB(o[0]=__builtin_amdgcn_mfma_f32_32x32x16_bf16(PAF(2),VFR(2),o[0],0,0,0), C1,0); \
    KRD(GL,3); GAPB(o[1]=__builtin_amdgcn_mfma_f32_32x32x16_bf16(PAF(2),VFR(6),o[1],0,0,0), C1,4); \
    GAPB(o[0]=__builtin_amdgcn_mfma_f32_32x32x16_bf16(PAF(3),VFR(3),o[0],0,0,0), C1,8); \
    GAPB(o[1]=__builtin_amdgcn_mfma_f32_32x32x16_bf16(PAF(3),VFR(7),o[1],0,0,0), C1,12); \
    { const lds_cptr vq_=vp_+(L2_V1-L2_V0); _Pragma("unroll") for(int i_=0;i_<8;++i_){ vlo[i_]=vtr(vq_+((i_>>2)*4096+(i_&3)*1024)); vhi[i_]=vtr(vq_+((i_>>2)*4096+(i_&3)*1024+512)); } SBAR(); \
      o[2]=__builtin_amdgcn_mfma_f32_32x32x16_bf16(PAF(0),VFR(0),o[2],0,0,0); o[3]=__builtin_amdgcn_mfma_f32_32x32x16_bf16(PAF(0),VFR(4),o[3],0,0,0); \
      o[2]=__builtin_amdgcn_mfma_f32_32x32x16_bf16(PAF(1),VFR(1),o[2],0,0,0); o[3]=__builtin_amdgcn_mfma_f32_32x32x16_bf16(PAF(1),VFR(5),o[3],0,0,0); \
      o[2]=__builtin_amdgcn_mfma_f32_32x32x16_bf16(PAF(2),VFR(2),o[2],0,0,0); o[3]=__builtin_amdgcn_mfma_f32_32x32x16_bf16(PAF(2),VFR(6),o[3],0,0,0); \
      o[2]=__builtin_amdgcn_mfma_f32_32x32x16_bf16(PAF(3),VFR(3),o[2],0,0,0); o[3]=__builtin_amdgcn_mfma_f32_32x32x16_bf16(PAF(3),VFR(7),o[3],0,0,0); SBAR(); } \
    }while(0)
  int t=1;
  #undef CMASK
  #define CMASK(P0,P1,t) do{}while(0)
  for(;t+5<NT;t+=2){
    STEP(pB0,pB1,pA0,pA1,t,true,true,true,ALIBIF);     WAIT_BAR(3); RESC(); ROT();
    STEP(pA0,pA1,pB0,pB1,t+1,true,true,true,ALIBIF);   WAIT_BAR(3); RESC(); ROT();
  }
  #undef CMASK
  #define CMASK(P0,P1,t) do{ if(MODE==0){int jb_=(t)-(NT-4); if(jb_>=0)cmask_blk(P0,P1,jb_,wid);} }while(0)
  #define ENDW(tt) do{ if((tt)+3<NT){WAIT_BAR(3);} else if((tt)+2<NT){WAIT_BAR(2);} else {WAIT_BAR(0);} }while(0)
  for(;t+1<NT;t+=2){
    STEP(pB0,pB1,pA0,pA1,t,(t+3<NT),(t+1<NT),(t+1<NT),ALIBI);       ENDW(t);   RESC(); ROT();
    STEP(pA0,pA1,pB0,pB1,t+1,(t+4<NT),(t+2<NT),(t+2<NT),ALIBI);     ENDW(t+1); RESC(); ROT();
  }
  STEP(pB0,pB1,pA0,pA1,NT-1,false,false,false,ALIBI); RESC();
  { float sacc=pB0[0]+pB0[1]; _Pragma("unroll") for(int r=2;r<16;++r)sacc+=pB0[r]; _Pragma("unroll") for(int r=0;r<16;++r)sacc+=pB1[r]; l_reg+=sacc;
    pw0=(u32x4){PKW(pB0,0),PKW(pB0,2),PKW(pB0,4),PKW(pB0,6)};pw1=(u32x4){PKW(pB0,8),PKW(pB0,10),PKW(pB0,12),PKW(pB0,14)};pw2=(u32x4){PKW(pB1,0),PKW(pB1,2),PKW(pB1,4),PKW(pB1,6)};pw3=(u32x4){PKW(pB1,8),PKW(pB1,10),PKW(pB1,12),PKW(pB1,14)};
    SBAR(); pv(o,vb0+sl_cur,PAF(0),PAF(1),PAF(2),PAF(3)); pv(o+2,vb1+sl_cur,PAF(0),PAF(1),PAF(2),PAF(3)); }
  #undef PKW
  #undef PAF
  #undef VFR
  #undef PIN
  #undef MX3
  #undef GAPA
  #undef GAPB
  #undef EX
  #undef VRD
  #undef KRD
  #undef STEP
  #undef QF
  #undef ENDW
  {auto rr=__builtin_amdgcn_permlane32_swap(__float_as_uint(l_reg),__float_as_uint(l_reg),false,false);l_reg=__uint_as_float(rr[0])+__uint_as_float(rr[1]);}
  if(hi==0)wsf[32+r32]=l_reg;asm volatile("s_waitcnt lgkmcnt(0)":::"memory");
  float rli[16];
  #pragma unroll
  for(int r=0;r<16;++r)rli[r]=__builtin_amdgcn_rcpf(wsf[32+crow(r,hi)]);
  bf16*Ow=Ob+(long)(wid*QBLK)*op;
  { bf16*stg=(bf16*)(shm+L2_QS+wid*L2_QSW);
    #pragma unroll
    for(int hv=0;hv<2;++hv){
      #pragma unroll
      for(int r=0;r<16;++r){const int orow=crow(r,hi);
        #pragma unroll
        for(int d0=0;d0<2;++d0)stg[orow*64+d0*32+r32]=__float2bfloat16(o[2*hv+d0][r]*rli[r]);}
      asm volatile("s_waitcnt lgkmcnt(0)":::"memory");
      #pragma unroll
      for(int i=0;i<4;++i){const int row=i*8+(lane>>3),ch=lane&7; const u32x4 v=*(const u32x4*)(stg+row*64+ch*8); ATTN_STORE16(Ow+(long)row*op+hv*64+ch*8,v);}
      asm volatile("s_waitcnt lgkmcnt(0)":::"memory"); } }
  asm volatile("s_waitcnt lgkmcnt(0)\n\ts_barrier":::"memory");
  #undef DMA_K
  #undef DMA_V
  #undef CMASK
  #undef ALIBI
  #undef ALIBIF
  #undef START
  #undef RESC
  #undef ROT
}
constexpr int ATTN_LDS_BYTES=LDS_BYTES;
#undef SBAR
#undef WAIT_BAR
}
constexpr int T = 32768, D = 1024, NB = 8, S = 4096, MEML = 256;
constexpr int AIN = 2560, BIN = 3328, FFD = 2816, FFE = 3584, NE = 8, DAW = 768;
constexpr float EPS = 1e-6f;
constexpr float C2 = 0.125f * 1.4426950408889634f;
constexpr int MAXROWS = 2 * T + NE * 256;
constexpr int NWAVES = 8;
constexpr float SC_X = 16.f, SC_WGU = 64.f, SC_H = 8.f, SC_WDN = 256.f;
constexpr size_t MiB = 1u << 20;
constexpr size_t WS_CTL = 0, CTL_ZERO_BYTES = 1 * MiB;
constexpr size_t WS_WINA = 2 * MiB, WS_WOUT = 12 * MiB, WS_WINB = 20 * MiB, WS_WMKV = 33 * MiB, WS_WGUD = 37 * MiB, WS_WDND = 59 * MiB, WS_WGUM = 70 * MiB, WS_WDNM = 294 * MiB;
constexpr size_t WS_MEMN = 406 * MiB, WS_MKV = 422 * MiB, WS_XN = 430 * MiB, WS_OC = 494 * MiB, WS_ROUTE = 558 * MiB, WS_BIG = 560 * MiB, WS_XG = 1072 * MiB, WS_Y = 1204 * MiB, WS_SSQP = 1362 * MiB, WS_END = 1376 * MiB;
constexpr size_t WS_SLOC = WS_XG, WS_SIN = WS_XG + 192 * MiB;
constexpr size_t WS_FS = 1600 * MiB;
constexpr int CW_TMO = 0, CW_CODE = 1, CW_BAR = 4096, CW_GCNT = 8192, CW_N2 = 65536;
constexpr int RING_OFF = 0, RING_BYTES = 131072;
constexpr int LDSCTL_OFF = RING_BYTES, MISC_OFF = LDSCTL_OFF + 320;
constexpr int LDS_BYTES = 147456;
static_assert(MISC_OFF + 128 <= LDS_BYTES, "LDS map");
#ifndef MK_DBG
#define MK_DBG 0
#endif
#ifndef MK_DUP
#define MK_DUP 0
#endif
#ifndef MK_TS
#define MK_TS 0
#endif
#ifndef MK_TS_A
#define MK_TS_A 0
#endif
#ifndef MK_TS_B
#define MK_TS_B 0
#endif
__constant__ unsigned char ATT_DEAL[16][6] = {{4, 14, 35, 56, 63, 85}, {0, 18, 20, 36, 72, 79}, {16, 21, 34, 52, 88, 95}, {22, 32, 50, 62, 68, 73}, {23, 48, 66, 78, 84, 89}, {5, 15, 40, 51, 86, 94}, {1, 6, 27, 47, 61, 69}, {24, 37, 41, 64, 77, 82},
    {2, 12, 25, 53, 57, 93}, {7, 17, 28, 38, 44, 60}, {8, 29, 33, 45, 54, 76}, {9, 30, 46, 49, 70, 92}, {10, 59, 65, 67, 87, 90}, {11, 31, 42, 55, 75, 81}, {19, 43, 71, 80, 83, 91}, {3, 13, 26, 39, 58, 74}};
#define GAS __attribute__((address_space(1)))
#define LAS __attribute__((address_space(3)))
typedef unsigned short bf16;
typedef unsigned v4u __attribute__((ext_vector_type(4)));
typedef unsigned v2u __attribute__((ext_vector_type(2)));
typedef float f32x4 __attribute__((ext_vector_type(4)));
typedef short bf16x8 __attribute__((ext_vector_type(8)));
typedef GAS unsigned gu32;
typedef GAS unsigned long long gu64;
#define RLX_AGENT __ATOMIC_RELAXED, __HIP_MEMORY_SCOPE_AGENT
#define LDS_WAIT() asm volatile("s_waitcnt lgkmcnt(0)" ::: "memory")
#define VM_WAIT() asm volatile("s_waitcnt vmcnt(0)" ::: "memory")
__device__ __forceinline__ unsigned long long rt() { return __builtin_amdgcn_s_memrealtime(); }
__device__ __forceinline__ unsigned f2bf(float f) { unsigned u = __builtin_bit_cast(unsigned, f); return (u + 0x7fffu + ((u >> 16) & 1u)) >> 16; }
__device__ __forceinline__ unsigned pk2(float lo, float hi) { return f2bf(lo) | (f2bf(hi) << 16); }

#define XB_TMO      128
#define XB_XCNT(j)  (256  + 64 * (j))
#define XB_XSUB(j)  (1280 + 64 * (j))
#define XB_XGEN(j)  (2304 + 64 * (j))
#define XB_TOP      3328
#define XB_TOPGEN   3392
#define XCD_BAR_WORDS 3456
#define XB_SPIN_CAP (1u << 18)

__device__ __forceinline__ unsigned xb_ld(unsigned* p)              { return __hip_atomic_load(p, __ATOMIC_RELAXED, __HIP_MEMORY_SCOPE_AGENT); }
__device__ __forceinline__ unsigned xb_add(unsigned* p, unsigned v) { return __hip_atomic_fetch_add(p, v, __ATOMIC_RELAXED, __HIP_MEMORY_SCOPE_AGENT); }
__device__ __forceinline__ unsigned xb_xcc_id() { return (unsigned)__builtin_amdgcn_s_getreg((3 << 11) | 20) & 0xFu; }
#define XB_SPIN(cond, bar) do { unsigned _sp = 0; while (cond) { __builtin_amdgcn_s_sleep(1); \
    if ((++_sp & 255u) == 0u) { if (xb_ld(&(bar)[XB_TMO])) break; if (_sp > XB_SPIN_CAP) { atomicAdd(&(bar)[XB_TMO], 1u); break; } } } } while (0)

struct XcdBarrier {
    unsigned* bar; unsigned x; int wave;
    volatile LAS unsigned* st;
};

__device__ __forceinline__ XcdBarrier xcd_barrier_post(unsigned* bar, volatile LAS unsigned* st) {
    XcdBarrier b; b.bar = bar; b.x = xb_xcc_id(); b.st = st; b.wave = __builtin_amdgcn_readfirstlane((int)(threadIdx.x >> 6));
    if (threadIdx.x == 0) (void)xb_add(&bar[XB_XCNT(b.x)], 1u);
    return b;
}
__device__ __forceinline__ void xcd_barrier_complete(unsigned* bar, unsigned x, unsigned& nloc, unsigned& nx) {
    const unsigned G = gridDim.x * gridDim.y * gridDim.z;
    unsigned sum, cnt, mine, sp = 0u;
    for (;;) {
        sum = 0u; cnt = 0u; mine = 0u;
#pragma unroll
        for (unsigned j = 0; j < 16; ++j) { const unsigned c = xb_ld(&bar[XB_XCNT(j)]); sum += c; cnt += (c > 0u) ? 1u : 0u; mine = (j == x) ? c : mine; }
        if (sum == G) break;
        __builtin_amdgcn_s_sleep(1);
        if ((++sp & 255u) == 0u) { if (xb_ld(&bar[XB_TMO])) break; if (sp > XB_SPIN_CAP) { atomicAdd(&bar[XB_TMO], 1u); break; } }
    }
    nloc = mine > 0u ? mine : 1u; nx = cnt > 0u ? cnt : 1u;
}

__device__ __forceinline__ void xcd_barrier(const XcdBarrier& b) {
    asm volatile("s_waitcnt vmcnt(0)" ::: "memory");
    __syncthreads();
    int l0_; asm volatile("v_mbcnt_lo_u32_b32 %0, -1, 0\n\tv_mbcnt_hi_u32_b32 %0, -1, %0" : "=v"(l0_));
    if (b.wave == 0 && l0_ == 0) {
        unsigned* bar = b.bar;
        __builtin_amdgcn_s_waitcnt(0);
        unsigned nloc = b.st[0], nx = b.st[1];
        if (nloc == 0u) { xcd_barrier_complete(bar, b.x, nloc, nx); b.st[0] = nloc; b.st[1] = nx; }
        const unsigned old = xb_add(&bar[XB_XSUB(b.x)], 1u);
        const unsigned gen = old / nloc;
        if (old + 1u == (gen + 1u) * nloc) {
            __builtin_amdgcn_fence(__ATOMIC_RELEASE, "agent");
            asm volatile("s_waitcnt vmcnt(0)" ::: "memory");
            const unsigned og = xb_add(&bar[XB_TOP], 1u);
            const unsigned tg = og / nx;
            if (og + 1u == (tg + 1u) * nx) xb_add(&bar[XB_TOPGEN], 1u);
            else XB_SPIN(xb_ld(&bar[XB_TOPGEN]) == tg, bar);
            __builtin_amdgcn_fence(__ATOMIC_ACQUIRE, "agent");
            xb_add(&bar[XB_XGEN(b.x)], 1u);
            asm volatile("s_waitcnt vmcnt(0)" ::: "memory");
        } else {
            XB_SPIN(xb_ld(&bar[XB_XGEN(b.x)]) == gen, bar);
            __builtin_amdgcn_fence(__ATOMIC_ACQUIRE, "agent");
            asm volatile("s_waitcnt vmcnt(0)" ::: "memory");
        }
    }
    __syncthreads();
}
struct InTab { const LAS unsigned long long* t;
    __device__ __forceinline__ const float* operator[](int k) const { const unsigned long long v = t[k];
        return (const float*)(((unsigned long long)(unsigned)__builtin_amdgcn_readfirstlane((int)(v >> 32)) << 32) | (unsigned)__builtin_amdgcn_readfirstlane((int)(unsigned)v)); } };
struct Frame {
    LAS unsigned char* lds;
    volatile LAS unsigned* MISC;
    gu32* ctl;
    int wave;
    int vcu, G, bx;
    GAS unsigned char* ws;
    InTab in;
    GAS float* out;
    float ts_scale, ts_add;
};
__device__ __forceinline__ float xor_get(float v, int lane, int o) { return __builtin_bit_cast(float, __builtin_amdgcn_ds_bpermute((lane ^ o) << 2, __builtin_bit_cast(int, v))); }
__device__ __forceinline__ float half_sum(float v, int lane) {
#pragma unroll
    for (int o = 1; o < 32; o <<= 1) v += xor_get(v, lane, o);
    return v; }
__device__ __forceinline__ float wave_sum(float v, int lane) { v = half_sum(v, lane); return v + xor_get(v, lane, 32); }
__device__ __forceinline__ int launder(int v) { asm volatile("" : "+v"(v)); return v; }
__device__ __forceinline__ int fresh_lane() { int l; asm volatile("v_mbcnt_lo_u32_b32 %0, -1, 0\n\tv_mbcnt_hi_u32_b32 %0, -1, %0" : "=v"(l)); return l; }
__device__ __forceinline__ float bf_lo(unsigned u) { return __builtin_bit_cast(float, u << 16); }
__device__ __forceinline__ float bf_hi(unsigned u) { return __builtin_bit_cast(float, u & 0xffff0000u); }
#if MK_DBG
__device__ __forceinline__ void dbg_sample_f32(Frame& F, int lane, int slot, int row, const f32x4 (&v)[4]) {
    float* d = (float*)(F.ws + WS_FS) + ((size_t)slot * 1024 + (row >> 5)) * 1024;
#pragma unroll
    for (int j = 0; j < 4; ++j) ((f32x4*)d)[lane + 64 * j] = v[j];
}
#endif
__device__ __forceinline__ int swiglu_row(int n, int ff) { const int bj = n >= ff ? 1 : 0, cc = n - bj * ff; return 256 * (cc >> 7) + 128 * bj + (cc & 127); }
template <bool F8>
__device__ __forceinline__ void transpose_item(const float* W, int K, int N, void* WT, int ff, float scale, LAS float* scr, int item, int lane, const float* kg = nullptr) {
    const int nblk = N / 64, kb = item / nblk, nb = item % nblk, k0 = 64 * kb, n0 = 64 * nb;
    const int r0 = ff ? swiglu_row(n0, ff) : n0;
    float v[64];
    const GAS float* wp = (const GAS float*)W + (size_t)k0 * N + n0 + lane;
#pragma unroll
    for (int i = 0; i < 64; ++i) v[i] = wp[(size_t)i * N];
#pragma unroll
    for (int i = 0; i < 64; ++i) scr[i * 64 + (lane ^ (i & 31))] = v[i];
    LDS_WAIT(); asm volatile("" ::: "memory");
    const int c = lane & 7;
    float kgv[8];
#pragma unroll
    for (int i = 0; i < 8; ++i) kgv[i] = kg ? kg[k0 + 8 * c + i] : 1.f;
#pragma unroll
    for (int j = 0; j < 8; ++j) { const int n = (lane >> 3) + 8 * j; float s[8];
#pragma unroll
        for (int i = 0; i < 8; ++i) s[i] = scr[(8 * c + i) * 64 + (n ^ ((8 * c + i) & 31))] * kgv[i];
        if (F8) { v2u o; o.x = pg8::pk4_fp8(s[0] * scale, s[1] * scale, s[2] * scale, s[3] * scale); o.y = pg8::pk4_fp8(s[4] * scale, s[5] * scale, s[6] * scale, s[7] * scale);
            *(GAS v2u*)((unsigned char*)WT + (size_t)(r0 + n) * K + k0 + 8 * c) = o; }
        else { v4u o; o.x = pg8::cvt_pk_bf16(s[0], s[1]); o.y = pg8::cvt_pk_bf16(s[2], s[3]); o.z = pg8::cvt_pk_bf16(s[4], s[5]); o.w = pg8::cvt_pk_bf16(s[6], s[7]);
            *(GAS v4u*)((bf16*)WT + (size_t)(r0 + n) * K + k0 + 8 * c) = o; } }
    LDS_WAIT(); asm volatile("" ::: "memory");
}
__device__ __forceinline__ void rms_row_to_bf16(int lane, const float* xrow, const float* gain, bf16* orow) {
    const GAS f32x4* xr = (const GAS f32x4*)xrow + lane;
    f32x4 v[4]; float s = 0.f;
#pragma unroll
    for (int j = 0; j < 4; ++j) { v[j] = xr[64 * j]; s += (v[j].x * v[j].x + v[j].y * v[j].y) + (v[j].z * v[j].z + v[j].w * v[j].w); }
    const float rstd = 1.f / sqrtf(wave_sum(s, lane) * (1.f / D) + EPS);
    GAS unsigned long long* o8 = (GAS unsigned long long*)orow + lane;
#pragma unroll
    for (int j = 0; j < 4; ++j) { const f32x4 g = ((const GAS f32x4*)gain)[lane + 64 * j];
        o8[64 * j] = (unsigned long long)pk2(v[j].x * rstd * g.x, v[j].y * rstd * g.y) | ((unsigned long long)pk2(v[j].z * rstd * g.z, v[j].w * rstd * g.w) << 32); }
}
__device__ __forceinline__ void phase_prologue(Frame& F) {
    const int lane = fresh_lane(), tid = F.wave * 64 + lane; (void)tid;
    LAS float* scr = (LAS float*)(F.lds + RING_OFF + F.wave * 16384);
    const int gw = F.vcu * NWAVES + F.wave, NGW = F.G * NWAVES;
    constexpr int I_AIN = 16 * (AIN / 64), I_MKV = 16 * 8, I_OUT = 16 * 16, I_BIN = 16 * (BIN / 64), I_GUD = 16 * (2 * FFD / 64), I_DND = (FFD / 64) * 16, I_GUM = 16 * (2 * FFE / 64), I_DNM = (FFE / 64) * 16;
    constexpr int NITEMS = 2 * I_AIN + 4 * I_MKV + 4 * I_OUT + 2 * I_BIN + 2 * I_GUD + 2 * I_DND + 16 * I_GUM + 16 * I_DNM;
    for (int it = NITEMS - 1 - gw; it >= 0; it -= NGW) {
        int r = it; const float* src; bf16* dst; int K = D, N, ff = 0; const float* kg = nullptr;
        if (r < 2 * I_AIN) { const int j = r / I_AIN; r %= I_AIN; N = AIN; src = F.in[3] + (size_t)j * D * AIN; dst = (bf16*)(F.ws + WS_WINA) + (size_t)j * AIN * D; kg = F.in[2] + j * D; }
        else if ((r -= 2 * I_AIN) < 4 * I_MKV) { const int l = r / I_MKV; r %= I_MKV; N = 512; src = F.in[(l & 1) ? 17 : 10] + (size_t)(l >> 1) * D * 512; dst = (bf16*)(F.ws + WS_WMKV) + (size_t)l * 512 * D; }
        else if ((r -= 4 * I_MKV) < 4 * I_OUT) { const int l = r / I_OUT; r %= I_OUT; N = D; src = F.in[(l & 1) ? 18 : 11] + (size_t)(l >> 1) * D * D; dst = (bf16*)(F.ws + WS_WOUT) + (size_t)l * D * D; }
        else if ((r -= 4 * I_OUT) < 2 * I_BIN) { const int j = r / I_BIN; r %= I_BIN; N = BIN; src = F.in[13] + (size_t)j * D * BIN; dst = (bf16*)(F.ws + WS_WINB) + (size_t)j * BIN * D; kg = F.in[12] + j * D; }
        else if ((r -= 2 * I_BIN) < 2 * I_GUD) { const int j = r / I_GUD; r %= I_GUD; N = 2 * FFD; ff = FFD; src = F.in[20] + (size_t)j * D * 2 * FFD; dst = (bf16*)(F.ws + WS_WGUD) + (size_t)j * 2 * FFD * D; kg = F.in[19] + j * D; }
        else if ((r -= 2 * I_GUD) < 2 * I_DND) { const int j = r / I_DND; r %= I_DND; K = FFD; N = D; src = F.in[21] + (size_t)j * FFD * D; dst = (bf16*)(F.ws + WS_WDND) + (size_t)j * D * FFD; }
        else if ((r -= 2 * I_DND) < 16 * I_GUM) { const int j = r / I_GUM; r %= I_GUM;
            transpose_item<true>(F.in[24] + (size_t)j * D * 2 * FFE, D, 2 * FFE, (void*)(F.ws + WS_WGUM + (size_t)j * 2 * FFE * D), FFE, SC_WGU, scr, r, lane); continue; }
        else { r -= 16 * I_GUM; const int j = r / I_DNM; r %= I_DNM;
            transpose_item<true>(F.in[25] + (size_t)j * FFE * D, FFE, D, (void*)(F.ws + WS_WDNM + (size_t)j * D * FFE), 0, SC_WDN, scr, r, lane); continue; }
        transpose_item<false>(src, K, N, dst, ff, 1.f, scr, r, lane, kg);
    }
    for (int m = gw; m < 4 * NB * MEML; m += NGW) { const int l = m / (NB * MEML), r = m % (NB * MEML);
        rms_row_to_bf16(lane, F.in[1] + (size_t)r * D, F.in[(l & 1) ? 16 : 9] + (size_t)(l >> 1) * D, (bf16*)(F.ws + WS_MEMN) + (size_t)m * D); }
    {
        const float* x0 = F.in[0]; bf16* XB = (bf16*)(F.ws + WS_XN); float* SQ = (float*)(F.ws + WS_SSQP) + (size_t)4 * T * 16;
        for (int m0 = gw * 4; m0 < T; m0 += NGW * 4) { f32x4 v[4][4]; float ss[4];
#pragma unroll
            for (int r = 0; r < 4; ++r) { const GAS f32x4* xr = (const GAS f32x4*)(x0 + (size_t)(m0 + r) * D) + lane;
#pragma unroll
                for (int j = 0; j < 4; ++j) v[r][j] = xr[64 * j]; }
#pragma unroll
            for (int r = 0; r < 4; ++r) { float sq = 0.f; GAS unsigned long long* o8 = (GAS unsigned long long*)(XB + (size_t)(m0 + r) * D) + lane;
#pragma unroll
                for (int j = 0; j < 4; ++j) { sq += (v[r][j].x * v[r][j].x + v[r][j].y * v[r][j].y) + (v[r][j].z * v[r][j].z + v[r][j].w * v[r][j].w);
                    o8[64 * j] = (unsigned long long)pk2(v[r][j].x, v[r][j].y) | ((unsigned long long)pk2(v[r][j].z, v[r][j].w) << 32); }
                ss[r] = sq; }
#pragma unroll
            for (int o = 1; o < 64; o <<= 1) {
#pragma unroll
                for (int r = 0; r < 4; ++r) ss[r] += xor_get(ss[r], lane, o); }
#pragma unroll
            for (int r = 0; r < 4; ++r) if (lane < 16) SQ[(size_t)(m0 + r) * 16 + lane] = lane == 0 ? ss[r] : 0.f; }
    }
    if (F.bx == 0) { float* LBT = (float*)(F.ws + WS_ROUTE + 1024 * 1024);
        for (int i = tid; i < DAW; i += NWAVES * 64) { LBT[i] = 0.f; LBT[DAW + i] = 1.f / (1.f + __expf(F.in[14][i] - F.in[14][DAW + i])); } }
}
template <bool FINAL>
__device__ __forceinline__ void phase_combine(Frame& F, float* OUT, const float* gain, float* SQ) {
    const int lane = fresh_lane(), tid = F.wave * 64 + lane; (void)tid;
    bf16* XB = (bf16*)(F.ws + WS_XN); const bf16* Y = (const bf16*)(F.ws + WS_Y);
    const float* TOPW = (const float*)(F.ws + WS_ROUTE); const int* TOKROW = (const int*)(F.ws + WS_ROUTE + 768 * 1024);
    for (int rb = F.bx * 128; rb < T; rb += F.G * 128) {
        int ri0 = 0, ri1 = 0; float rw0 = 0.f, rw1 = 0.f;
        if (lane < 16) { const int rr = rb + F.wave * 16 + lane; ri0 = TOKROW[rr * 2]; ri1 = TOKROW[rr * 2 + 1]; rw0 = TOPW[rr * 2]; rw1 = TOPW[rr * 2 + 1]; }
        v2u xq[2][4], yq0[2][4], yq1[2][4];
#define CMB_ISSUE(B_, I_) do { const int row_ = rb + F.wave * 16 + (I_); const GAS v2u* xr_ = (const GAS v2u*)(XB + (size_t)row_ * D) + lane; \
            _Pragma("unroll") for (int j = 0; j < 4; ++j) xq[B_][j] = xr_[64 * j]; \
            const int r0_ = __builtin_amdgcn_readlane(ri0, (I_)), r1_ = __builtin_amdgcn_readlane(ri1, (I_)); \
            const GAS v2u* y0_ = (const GAS v2u*)(Y + (size_t)r0_ * D) + lane; const GAS v2u* y1_ = (const GAS v2u*)(Y + (size_t)r1_ * D) + lane; \
            _Pragma("unroll") for (int j = 0; j < 4; ++j) { yq0[B_][j] = y0_[64 * j]; yq1[B_][j] = y1_[64 * j]; } } while (0)
        CMB_ISSUE(0, 0);
        for (int i2 = 0; i2 < 16; i2 += 2) {
#pragma unroll
          for (int hb = 0; hb < 2; ++hb) {
            const int i = i2 + hb;
            if (hb == 0) CMB_ISSUE(1, i + 1); else if (i + 1 < 16) CMB_ISSUE(0, i + 1);
            const int row = rb + F.wave * 16 + i;
            const float w0 = __builtin_bit_cast(float, __builtin_amdgcn_readlane(__builtin_bit_cast(int, rw0), i)), w1 = __builtin_bit_cast(float, __builtin_amdgcn_readlane(__builtin_bit_cast(int, rw1), i));
            f32x4 v[4]; float s = 0.f;
#pragma unroll
            for (int j = 0; j < 4; ++j) { const v2u x = xq[hb][j], a = yq0[hb][j], b = yq1[hb][j];
                v[j].x = bf_lo(x.x) + w0 * bf_lo(a.x) + w1 * bf_lo(b.x); v[j].y = bf_hi(x.x) + w0 * bf_hi(a.x) + w1 * bf_hi(b.x); v[j].z = bf_lo(x.y) + w0 * bf_lo(a.y) + w1 * bf_lo(b.y); v[j].w = bf_hi(x.y) + w0 * bf_hi(a.y) + w1 * bf_hi(b.y);
                s += (v[j].x * v[j].x + v[j].y * v[j].y) + (v[j].z * v[j].z + v[j].w * v[j].w); }
            s = wave_sum(s, lane);
            if (FINAL) { const float rstd = 1.f / sqrtf(s * (1.f / D) + EPS); GAS f32x4* ow = (GAS f32x4*)(OUT + (size_t)row * D) + lane;
#pragma unroll
                for (int j = 0; j < 4; ++j) { const f32x4 g = ((const GAS f32x4*)gain)[lane + 64 * j]; ow[64 * j] = (f32x4){v[j].x * rstd * g.x, v[j].y * rstd * g.y, v[j].z * rstd * g.z, v[j].w * rstd * g.w}; }
            } else { GAS unsigned long long* o8 = (GAS unsigned long long*)(XB + (size_t)row * D) + lane;
#pragma unroll
                for (int j = 0; j < 4; ++j) o8[64 * j] = (unsigned long long)pk2(v[j].x, v[j].y) | ((unsigned long long)pk2(v[j].z, v[j].w) << 32);
                if (lane < 16) SQ[(size_t)row * 16 + lane] = lane == 0 ? s : 0.f; }
          }
        }
#undef CMB_ISSUE
    }
}
__device__ __forceinline__ void phase_router(Frame& F, const float* gain, const float* wr, gu32* gcnt) {
    const int lane = fresh_lane(), tid = F.wave * 64 + lane;
    const bf16* XB = (const bf16*)(F.ws + WS_XN); float* RS = (float*)(F.ws + WS_ROUTE + 1024 * 1024 + 8192); float* TOPW = (float*)(F.ws + WS_ROUTE); int* TOKSEL = (int*)(F.ws + WS_ROUTE + 256 * 1024);
    LAS int* cntL = (LAS int*)(F.lds + RING_OFF); LAS int* baseL = cntL + 8; LAS float* lg = (LAS float*)(cntL + 16);
    if (tid < 8) cntL[tid] = 0;
    __syncthreads();
    for (int rb = F.bx * 128; rb < T; rb += F.G * 128) {
        for (int g4 = 0; g4 < 4; ++g4) {
            const int rl0 = F.wave * 16 + 4 * g4, row0 = rb + rl0;
            f32x4 v[4][4];
#pragma unroll
            for (int r = 0; r < 4; ++r) { const GAS v2u* xr = (const GAS v2u*)(XB + (size_t)(row0 + r) * D) + lane;
#pragma unroll
                for (int j = 0; j < 4; ++j) { const v2u w = xr[64 * j]; v[r][j] = (f32x4){bf_lo(w.x), bf_hi(w.x), bf_lo(w.y), bf_hi(w.y)}; } }
            float ss[4];
#pragma unroll
            for (int r = 0; r < 4; ++r) { float s = 0.f;
#pragma unroll
                for (int j = 0; j < 4; ++j) s += (v[r][j].x * v[r][j].x + v[r][j].y * v[r][j].y) + (v[r][j].z * v[r][j].z + v[r][j].w * v[r][j].w);
                ss[r] = s; }
#pragma unroll
            for (int o = 1; o < 64; o <<= 1) {
#pragma unroll
                for (int r = 0; r < 4; ++r) ss[r] += xor_get(ss[r], lane, o); }
#pragma unroll
            for (int r = 0; r < 4; ++r) { const float rstd = 1.f / sqrtf(ss[r] * (1.f / D) + EPS);
                if (lane == 0) RS[row0 + r] = rstd;
#pragma unroll
                for (int j = 0; j < 4; ++j) { const f32x4 gg = ((const GAS f32x4*)gain)[lane + 64 * j]; v[r][j].x *= rstd * gg.x; v[r][j].y *= rstd * gg.y; v[r][j].z *= rstd * gg.z; v[r][j].w *= rstd * gg.w; } }
            float a[32];
#pragma unroll
            for (int i = 0; i < 32; ++i) a[i] = 0.f;
#pragma unroll
            for (int j = 0; j < 4; ++j) { const GAS f32x4* wp = (const GAS f32x4*)(wr + (size_t)(lane + 64 * j) * 32);
#pragma unroll
                for (int c = 0; c < 4; ++c) { const f32x4 w0 = wp[2 * c], w1 = wp[2 * c + 1];
#pragma unroll
                    for (int r = 0; r < 4; ++r) { const float xv = v[r][j][c];
                        a[r * 8 + 0] += xv * w0.x; a[r * 8 + 1] += xv * w0.y; a[r * 8 + 2] += xv * w0.z; a[r * 8 + 3] += xv * w0.w; a[r * 8 + 4] += xv * w1.x; a[r * 8 + 5] += xv * w1.y; a[r * 8 + 6] += xv * w1.z; a[r * 8 + 7] += xv * w1.w; } } }
#define RT_STEP(S_, N_) do { const bool up_ = (lane >> (S_)) & 1; _Pragma("unroll") for (int i = 0; i < (N_); ++i) { const float keep_ = up_ ? a[2 * i + 1] : a[2 * i], send_ = up_ ? a[2 * i] : a[2 * i + 1]; a[i] = keep_ + xor_get(send_, lane, 1 << (S_)); } } while (0)
            RT_STEP(0, 16); RT_STEP(1, 8); RT_STEP(2, 4); RT_STEP(3, 2); RT_STEP(4, 1);
#undef RT_STEP
            const float lgv = a[0] + xor_get(a[0], lane, 32);
            if (lane < 32) lg[(rl0 + (lane >> 3)) * 8 + (lane & 7)] = lgv;
        }
        __syncthreads();
        int e0 = 0, e1 = 0, q0 = 0, q1 = 0;
        if (tid < 128) { float av[8];
#pragma unroll
            for (int e = 0; e < 8; ++e) av[e] = lg[tid * 8 + e];
            float v0 = av[0];
#pragma unroll
            for (int e = 1; e < 8; ++e) if (av[e] > v0) { v0 = av[e]; e0 = e; }
            float v1 = -3.0e38f;
#pragma unroll
            for (int e = 0; e < 8; ++e) if (e != e0 && av[e] > v1) { v1 = av[e]; e1 = e; }
            const float p1 = __expf(v1 - v0), inv = 1.f / (1.f + p1);
            TOPW[(rb + tid) * 2] = inv; TOPW[(rb + tid) * 2 + 1] = p1 * inv;
            q0 = __hip_atomic_fetch_add(cntL + e0, 1, __ATOMIC_RELAXED, __HIP_MEMORY_SCOPE_WORKGROUP);
            q1 = __hip_atomic_fetch_add(cntL + e1, 1, __ATOMIC_RELAXED, __HIP_MEMORY_SCOPE_WORKGROUP); }
        __syncthreads();
        if (tid < 8) { baseL[tid] = (int)__hip_atomic_fetch_add(gcnt + tid, (unsigned)cntL[tid], __ATOMIC_RELAXED, __HIP_MEMORY_SCOPE_AGENT); }
        __syncthreads();
        if (tid < 128) { int4 o; o.x = e0; o.y = baseL[e0] + q0; o.z = e1; o.w = baseL[e1] + q1; *(int4*)(TOKSEL + (size_t)(rb + tid) * 4) = o; }
        __syncthreads();
        if (tid < 8) cntL[tid] = 0;
        __syncthreads();
    }
}
__device__ __forceinline__ void phase_gather(Frame& F, const gu32* gcnt, const float* gain) {
    const int lane = fresh_lane(), tid = F.wave * 64 + lane; (void)tid;
    const bf16* XB = (const bf16*)(F.ws + WS_XN); const float* RS = (const float*)(F.ws + WS_ROUTE + 1024 * 1024 + 8192); unsigned char* XG = (unsigned char*)(F.ws + WS_XG);
    const int* TOKSEL = (const int*)(F.ws + WS_ROUTE + 256 * 1024); int* TOKROW = (int*)(F.ws + WS_ROUTE + 768 * 1024);
    int rbase[8]; { int t = 0;
#pragma unroll
        for (int e = 0; e < 8; ++e) { rbase[e] = t * 256; t += (__builtin_amdgcn_readfirstlane((int)__hip_atomic_load(gcnt + e, RLX_AGENT)) + 255) >> 8; } }
    f32x4 gq[4];
#pragma unroll
    for (int i = 0; i < 4; ++i) gq[i] = ((const GAS f32x4*)gain)[4 * lane + i] * SC_X;
    const int gw = F.bx * NWAVES + F.wave, NGW = F.G * NWAVES;
    for (int row0 = gw * 4; row0 < T; row0 += NGW * 4) {
        int4 sl[4]; v4u a[4], b[4]; float rs[4];
#pragma unroll
        for (int r = 0; r < 4; ++r) { sl[r] = *(const int4*)(TOKSEL + (size_t)(row0 + r) * 4); const GAS v4u* sp = (const GAS v4u*)(XB + (size_t)(row0 + r) * D) + 2 * lane; a[r] = sp[0]; b[r] = sp[1]; rs[r] = RS[row0 + r]; }
#pragma unroll
        for (int r = 0; r < 4; ++r) { int d0 = sl[r].y, d1 = sl[r].w;
#pragma unroll
            for (int e = 0; e < 8; ++e) { if (sl[r].x == e) d0 += rbase[e]; if (sl[r].z == e) d1 += rbase[e]; }
            const float q = rs[r]; v4u o;
            o.x = pg8::pk4_fp8(bf_lo(a[r].x) * q * gq[0].x, bf_hi(a[r].x) * q * gq[0].y, bf_lo(a[r].y) * q * gq[0].z, bf_hi(a[r].y) * q * gq[0].w); o.y = pg8::pk4_fp8(bf_lo(a[r].z) * q * gq[1].x, bf_hi(a[r].z) * q * gq[1].y, bf_lo(a[r].w) * q * gq[1].z, bf_hi(a[r].w) * q * gq[1].w);
            o.z = pg8::pk4_fp8(bf_lo(b[r].x) * q * gq[2].x, bf_hi(b[r].x) * q * gq[2].y, bf_lo(b[r].y) * q * gq[2].z, bf_hi(b[r].y) * q * gq[2].w); o.w = pg8::pk4_fp8(bf_lo(b[r].z) * q * gq[3].x, bf_hi(b[r].z) * q * gq[3].y, bf_lo(b[r].w) * q * gq[3].z, bf_hi(b[r].w) * q * gq[3].w);
            ((GAS v4u*)(XG + (size_t)d0 * D))[lane] = o; ((GAS v4u*)(XG + (size_t)d1 * D))[lane] = o;
            if (lane == 0) { TOKROW[(row0 + r) * 2] = d0; TOKROW[(row0 + r) * 2 + 1] = d1; } }
    }
}
__device__ __forceinline__ void phase_knorm(Frame& F) {
    const int lane = fresh_lane();
    const bf16* P = (const bf16*)(F.ws + WS_BIG); float* N2 = (float*)(F.ws + WS_ROUTE + 1024 * 1024 + 8192);
    const int gw = F.bx * NWAVES + F.wave, NGW = F.G * NWAVES;
    for (int it = gw; it < NB * 24 * 64; it += NGW) { const int t = it & 63, hm = (it >> 6) % 24, b = it / (24 * 64);
        const GAS v4u* rp = (const GAS v4u*)(P + (size_t)(b * S + 64 * t + lane) * AIN + hm * 64); float ss = 0.f;
#pragma unroll
        for (int i = 0; i < 8; ++i) { const v4u w = rp[i]; const unsigned ww[4] = {w.x, w.y, w.z, w.w};
#pragma unroll
            for (int c = 0; c < 4; ++c) { const float a = bf_lo(ww[c]), b2 = bf_hi(ww[c]); ss += a * a + b2 * b2; } }
#pragma unroll
        for (int o = 1; o < 64; o <<= 1) ss = fmaxf(ss, xor_get(ss, lane, o));
        if (lane == 0) N2[it] = ss; }
}
__device__ __forceinline__ void phase_diff_combine(Frame& F, int j, float lam_init) {
    const int lane = fresh_lane(), tid = F.wave * 64 + lane; (void)tid;
    const bf16* O0 = (const bf16*)(F.ws + WS_BIG + 160 * MiB); const bf16* O1 = O0 + (size_t)T * DAW; bf16* OC = (bf16*)(F.ws + WS_OC);
    const float s1 = wave_sum(F.in[4][j * 64 + lane] * F.in[5][j * 64 + lane], lane), s2 = wave_sum(F.in[6][j * 64 + lane] * F.in[7][j * 64 + lane], lane);
    const float lam = __expf(s1) - __expf(s2) + lam_init;
    const f32x4 g = *(const GAS f32x4*)(F.in[8] + j * 128 + (lane & 31) * 4);
    const int gw = F.bx * NWAVES + F.wave, NGW = F.G * NWAVES;
    for (int row0 = gw * 4; row0 < T; row0 += NGW * 4) {
        v2u a[4][3], b[4][3];
#pragma unroll
        for (int r = 0; r < 4; ++r)
#pragma unroll
            for (int jj = 0; jj < 3; ++jj) { a[r][jj] = ((const GAS v2u*)(O0 + (size_t)(row0 + r) * DAW))[lane + 64 * jj]; b[r][jj] = ((const GAS v2u*)(O1 + (size_t)(row0 + r) * DAW))[lane + 64 * jj]; }
#pragma unroll
        for (int r = 0; r < 4; ++r)
#pragma unroll
            for (int jj = 0; jj < 3; ++jj) {
                f32x4 v; v.x = bf_lo(a[r][jj].x) - lam * bf_lo(b[r][jj].x); v.y = bf_hi(a[r][jj].x) - lam * bf_hi(b[r][jj].x); v.z = bf_lo(a[r][jj].y) - lam * bf_lo(b[r][jj].y); v.w = bf_hi(a[r][jj].y) - lam * bf_hi(b[r][jj].y);
                float ss = (v.x * v.x + v.y * v.y) + (v.z * v.z + v.w * v.w);
                ss = half_sum(ss, lane);
                const float rs = (1.f / sqrtf(ss * (1.f / 128.f) + EPS)) * (1.f - lam_init);
                ((GAS unsigned long long*)(OC + (size_t)(row0 + r) * D))[lane + 64 * jj] = (unsigned long long)pk2(v.x * rs * g.x, v.y * rs * g.y) | ((unsigned long long)pk2(v.z * rs * g.z, v.w * rs * g.w) << 32);
            }
    }
}
__device__ __forceinline__ void phase_hgrn_naive(Frame& F, int j) {
    const int lane = fresh_lane(), tid = F.wave * 64 + lane; (void)tid;
    const bf16* PB = (const bf16*)(F.ws + WS_BIG); const float* FZ = (const float*)(F.ws + WS_BIG + 208 * MiB); float* HO = (float*)(F.ws + WS_BIG + 304 * MiB);
    if (F.bx * 4 >= NB * 6) return;
    const int grp = tid >> 7, t128 = tid & 127, bh = F.bx * 4 + grp, b = bh / 6, h = bh % 6;
    LAS float* sq = (LAS float*)(F.lds + RING_OFF) + grp * (3 * 16 * 128); LAS float* sf = sq + 16 * 128; LAS float* sk = sf + 16 * 128;
    float lb = 0.f;
    if (j == 1) { const float l0 = F.in[14][h * 128 + t128], l1 = F.in[14][768 + h * 128 + t128]; lb = 1.f / (1.f + __expf(l0 - l1)); }
    float St[128];
#pragma unroll
    for (int k = 0; k < 128; ++k) St[k] = 0.f;
    for (int t0 = 0; t0 < S; t0 += 16) {
        __syncthreads();
        for (int jj = 0; jj < 16; ++jj) { const size_t row = (size_t)(b * S + t0 + jj);
            const float qv = bf_lo((unsigned)PB[row * BIN + h * 128 + t128]), fz = FZ[row * DAW + h * 128 + t128];
            const float f = lb + (1.f - lb) / (1.f + __expf(-fz));
            sq[jj * 128 + t128] = qv; sf[jj * 128 + t128] = f; sk[jj * 128 + t128] = 1.f - f; }
        __syncthreads();
        for (int jj = 0; jj < 16; ++jj) { const size_t row = (size_t)(b * S + t0 + jj);
            const float v = bf_lo((unsigned)PB[row * BIN + 1536 + h * 128 + t128]);
            float o = 0.f;
#pragma unroll
            for (int k = 0; k < 128; k += 4) { const f32x4 f4 = *(const LAS f32x4*)(sf + jj * 128 + k), k4 = *(const LAS f32x4*)(sk + jj * 128 + k), q4 = *(const LAS f32x4*)(sq + jj * 128 + k);
                St[k] = f4.x * St[k] + k4.x * v; o += q4.x * St[k]; St[k + 1] = f4.y * St[k + 1] + k4.y * v; o += q4.y * St[k + 1];
                St[k + 2] = f4.z * St[k + 2] + k4.z * v; o += q4.z * St[k + 2]; St[k + 3] = f4.w * St[k + 3] + k4.w * v; o += q4.w * St[k + 3]; }
            HO[row * DAW + h * 128 + t128] = o; }
    }
    __syncthreads();
}
__device__ __forceinline__ void phase_hgrn_out(Frame& F, int j) {
    const int lane = fresh_lane(), tid = F.wave * 64 + lane; (void)tid;
    const bf16* PB = (const bf16*)(F.ws + WS_BIG); const float* HO = (const float*)(F.ws + WS_BIG + 304 * MiB); bf16* OC = (bf16*)(F.ws + WS_OC);
    const f32x4 g = *(const GAS f32x4*)(F.in[15] + j * 128 + (lane & 31) * 4);
    const int gw = F.bx * NWAVES + F.wave, NGW = F.G * NWAVES;
    for (int row = gw; row < T; row += NGW) {
#pragma unroll
        for (int jj = 0; jj < 3; ++jj) {
            const f32x4 v = ((const GAS f32x4*)(HO + (size_t)row * DAW))[lane + 64 * jj];
            const v2u gt = ((const GAS v2u*)(PB + (size_t)row * BIN + 2304))[lane + 64 * jj];
            float ss = (v.x * v.x + v.y * v.y) + (v.z * v.z + v.w * v.w);
            ss = half_sum(ss, lane);
            const float rs = 1.f / sqrtf(ss * (1.f / 128.f) + EPS);
            ((GAS unsigned long long*)(OC + (size_t)row * D))[lane + 64 * jj] =
                (unsigned long long)pk2(v.x * rs * g.x * pg8::silu_f(bf_lo(gt.x)), v.y * rs * g.y * pg8::silu_f(bf_hi(gt.x))) | ((unsigned long long)pk2(v.z * rs * g.z * pg8::silu_f(bf_lo(gt.y)), v.w * rs * g.w * pg8::silu_f(bf_hi(gt.y))) << 32);
        }
    }
}
constexpr int HG_LD = 136, HG_LS = 72;
constexpr int HL_QB = 0, HL_QT = 17408, HL_K = 34816, HL_VT = 78336, HL_PM = 96768, HL_TOT = 105984, HL_SSQ = 110080;
constexpr size_t WS_DCH = WS_SIN + 96 * MiB;
typedef short hbf16x8 __attribute__((ext_vector_type(8)));
typedef float hf32x2 __attribute__((ext_vector_type(2)));
__device__ __forceinline__ hbf16x8 lds8(const LAS unsigned short* p) { return *(const LAS hbf16x8*)p; }
__device__ __forceinline__ float ex2(float v) { return __builtin_amdgcn_exp2f(v); }
template <int PASS>
__device__ __forceinline__ void hgrn_load(Frame& F, int tid, int unit, unsigned (&lf)[8], unsigned (&qw)[8], v4u& va, v4u& vb) {
    const bf16* PB = (const bf16*)(F.ws + WS_BIG); const unsigned short* LF = (const unsigned short*)(F.ws + WS_BIG + 208 * MiB);
    const int kp = tid & 63, wave = __builtin_amdgcn_readfirstlane(tid >> 6), I = wave & 3, hf = wave >> 2, r0 = 16 * I + 8 * hf;
    const int bh = unit >> 6, c = unit & 63, b = bh / 6, h = bh % 6;
    const size_t tok0 = (size_t)b * S + c * 64;
#pragma unroll
    for (int jj = 0; jj < 8; ++jj) lf[jj] = *(const GAS unsigned*)(LF + (tok0 + r0 + jj) * DAW + h * 128 + 2 * kp);
    if (PASS == 3) {
#pragma unroll
        for (int jj = 0; jj < 8; ++jj) qw[jj] = *(const GAS unsigned*)(PB + (tok0 + r0 + jj) * BIN + h * 128 + 2 * kp); }
    { const int sp = tid >> 4, e8 = (tid & 15) * 8; va = *(const GAS v4u*)(PB + (tok0 + 2 * sp) * BIN + 1536 + h * 128 + e8); vb = *(const GAS v4u*)(PB + (tok0 + 2 * sp + 1) * BIN + 1536 + h * 128 + e8); }
}
template <int PASS>
__device__ __forceinline__ void hgrn_unit(Frame& F, int tid, int unit, int nunit, int j, unsigned (&lfr)[8], unsigned (&qw)[8], v4u& va, v4u& vb) {
    const bf16* PB = (const bf16*)(F.ws + WS_BIG);
    hf32x2 lf[8];
#pragma unroll
    for (int jj = 0; jj < 8; ++jj) { typedef _Float16 h2_ __attribute__((ext_vector_type(2))); const h2_ hv = __builtin_bit_cast(h2_, lfr[jj]); lf[jj] = (hf32x2){(float)hv.x, (float)hv.y}; }
    bf16* SLOC = (bf16*)(F.ws + WS_SLOC); const bf16* SIN = (const bf16*)(F.ws + WS_SIN); float* DCH = (float*)(F.ws + WS_DCH); bf16* OC = (bf16*)(F.ws + WS_OC);
    LAS unsigned short* QB = (LAS unsigned short*)(F.lds + HL_QB); LAS unsigned short* QT = (LAS unsigned short*)(F.lds + HL_QT); LAS unsigned short* KK = (LAS unsigned short*)(F.lds + HL_K);
    LAS unsigned short* VT = (LAS unsigned short*)(F.lds + HL_VT); LAS unsigned short* PM = (LAS unsigned short*)(F.lds + HL_PM); LAS float* TOT = (LAS float*)(F.lds + HL_TOT); LAS float* SSQ = (LAS float*)(F.lds + HL_SSQ);
    const int kp = tid & 63, lane = kp, wave = __builtin_amdgcn_readfirstlane(tid >> 6), I = wave & 3, hf = wave >> 2, sub = 2 * I + hf, r0 = 16 * I + 8 * hf, fr = lane & 15, fg = lane >> 4;
    const int bh = unit >> 6, c = unit & 63, b = bh / 6, h = bh % 6;
    const size_t tok0 = (size_t)b * S + c * 64;
    const int tt = wave & 3, eh = wave >> 2; const size_t tok = tok0 + 16 * tt + fr;
    hbf16x8 sfr[4][4]; v2u gtv[4]; f32x4 gnv[4];
    if (PASS == 3) {
#pragma unroll
        for (int et = 0; et < 4; ++et) { const int e0 = 64 * eh + 16 * et; const GAS hbf16x8* sp = (const GAS hbf16x8*)(SIN + ((size_t)unit * 128 + e0 + fr) * 128 + 8 * fg);
#pragma unroll
            for (int ks = 0; ks < 4; ++ks) sfr[et][ks] = sp[4 * ks];
            gtv[et] = *(const GAS v2u*)(PB + tok * BIN + 2304 + h * 128 + e0 + 4 * fg); }
#pragma unroll
        for (int et = 0; et < 4; ++et) gnv[et] = *(const GAS f32x4*)(F.in[15] + j * 128 + 64 * eh + 16 * et + 4 * fg); }
    { const int sp = tid >> 4, e8 = (tid & 15) * 8; const v4u a = va, b2 = vb;
        const unsigned wa[4] = {a.x, a.y, a.z, a.w}, wb[4] = {b2.x, b2.y, b2.z, b2.w};
#pragma unroll
        for (int i = 0; i < 4; ++i) { *(LAS unsigned*)(VT + (e8 + 2 * i) * HG_LS + 2 * sp) = (wa[i] & 0xffffu) | (wb[i] << 16); *(LAS unsigned*)(VT + (e8 + 2 * i + 1) * HG_LS + 2 * sp) = (wa[i] >> 16) | (wb[i] & 0xffff0000u); } }
    hf32x2 cs[8]; { hf32x2 run = {0.f, 0.f};
#pragma unroll
        for (int jj = 0; jj < 8; ++jj) { run += lf[jj]; cs[jj] = run; } }
    *(LAS hf32x2*)(TOT + sub * 128 + 2 * kp) = cs[7];
    __syncthreads();
    hf32x2 rho = {0.f, 0.f}, presub = {0.f, 0.f}, blast = {0.f, 0.f};
#pragma unroll
    for (int s2 = 0; s2 < 8; ++s2) { const hf32x2 t = *(const LAS hf32x2*)(TOT + s2 * 128 + 2 * kp); if (s2 < 2 * I) rho += t; if (s2 < sub) presub += t; blast += t; }
    const hf32x2 off = presub - rho;
    if (PASS == 1) {
        unsigned w0[4], w1[4];
#pragma unroll
        for (int i = 0; i < 4; ++i) { const hf32x2 ba = rho + off + cs[2 * i], bb = rho + off + cs[2 * i + 1];
            w0[i] = pg8::cvt_pk_bf16((1.f - ex2(lf[2 * i].x)) * ex2(blast.x - ba.x), (1.f - ex2(lf[2 * i + 1].x)) * ex2(blast.x - bb.x));
            w1[i] = pg8::cvt_pk_bf16((1.f - ex2(lf[2 * i].y)) * ex2(blast.y - ba.y), (1.f - ex2(lf[2 * i + 1].y)) * ex2(blast.y - bb.y)); }
        *(LAS v4u*)(KK + (2 * kp) * HG_LS + r0) = (v4u){w0[0], w0[1], w0[2], w0[3]}; *(LAS v4u*)(KK + (2 * kp + 1) * HG_LS + r0) = (v4u){w1[0], w1[1], w1[2], w1[3]};
        if (sub == 0) *(GAS hf32x2*)(DCH + (size_t)unit * 128 + 2 * kp) = (hf32x2){ex2(blast.x), ex2(blast.y)};
        __syncthreads();
        if (nunit >= 0) hgrn_load<PASS>(F, tid, nunit, lfr, qw, va, vb);
        const hbf16x8 a0 = lds8(KK + (16 * wave + fr) * HG_LS + 8 * fg), a1 = lds8(KK + (16 * wave + fr) * HG_LS + 32 + 8 * fg);
#pragma unroll
        for (int et = 0; et < 8; ++et) { const hbf16x8 b0 = lds8(VT + (16 * et + fr) * HG_LS + 8 * fg), b1 = lds8(VT + (16 * et + fr) * HG_LS + 32 + 8 * fg);
            f32x4 d = {0.f, 0.f, 0.f, 0.f}; d = __builtin_amdgcn_mfma_f32_16x16x32_bf16(a0, b0, d, 0, 0, 0); d = __builtin_amdgcn_mfma_f32_16x16x32_bf16(a1, b1, d, 0, 0, 0);
            v2u w2; w2.x = pk2(d[0], d[1]); w2.y = pk2(d[2], d[3]);
            *(GAS v2u*)(SLOC + ((size_t)unit * 128 + 16 * et + fr) * 128 + 16 * wave + 4 * fg) = w2; }
        __syncthreads();
    } else {
        const hf32x2 er = {ex2(rho.x), ex2(rho.y)};
        hf32x2 base[8];
#pragma unroll
        for (int jj = 0; jj < 8; ++jj) { const hf32x2 bl = off + cs[jj]; const hf32x2 e = {ex2(bl.x), ex2(bl.y)}; const hf32x2 q = {bf_lo(qw[jj]), bf_hi(qw[jj])}; const hf32x2 qt = q * e, qb = qt * er;
            *(LAS unsigned*)(QT + (r0 + jj) * HG_LD + 2 * kp) = pg8::cvt_pk_bf16(qt.x, qt.y); *(LAS unsigned*)(QB + (r0 + jj) * HG_LD + 2 * kp) = pg8::cvt_pk_bf16(qb.x, qb.y);
            base[jj] = (hf32x2){(1.f - ex2(lf[jj].x)) * ex2(-bl.x), (1.f - ex2(lf[jj].y)) * ex2(-bl.y)}; }
        hf32x2 rr = {0.f, 0.f};
        for (int Ip = I; Ip < 4; ++Ip) { LAS unsigned short* Kp = KK + (8 * Ip * (Ip + 1)) * HG_LD;
            const hf32x2 sc = {ex2(rr.x), ex2(rr.y)};
#pragma unroll
            for (int jj = 0; jj < 8; ++jj) { const hf32x2 kv = base[jj] * sc; *(LAS unsigned*)(Kp + (r0 + jj) * HG_LD + 2 * kp) = pg8::cvt_pk_bf16(kv.x, kv.y); }
            rr += *(const LAS hf32x2*)(TOT + (2 * Ip) * 128 + 2 * kp) + *(const LAS hf32x2*)(TOT + (2 * Ip + 1) * 128 + 2 * kp); }
        __syncthreads();
        if (nunit >= 0) hgrn_load<PASS>(F, tid, nunit, lfr, qw, va, vb);
        { const int It = wave >> 1; const LAS unsigned short* Kp = KK + (8 * It * (It + 1)) * HG_LD;
#pragma unroll
            for (int jt = 0; jt < 2; ++jt) { const int J = 2 * (wave & 1) + jt; f32x4 d = {0.f, 0.f, 0.f, 0.f};
                if (J <= It) {
#pragma unroll
                    for (int ks = 0; ks < 4; ++ks) d = __builtin_amdgcn_mfma_f32_16x16x32_bf16(lds8(QT + (16 * It + fr) * HG_LD + 32 * ks + 8 * fg), lds8(Kp + (16 * J + fr) * HG_LD + 32 * ks + 8 * fg), d, 0, 0, 0);
                    if (J == It) {
#pragma unroll
                        for (int i = 0; i < 4; ++i) if (fr > 4 * fg + i) d[i] = 0.f; }
                }
#pragma unroll
                for (int i = 0; i < 4; ++i) PM[(16 * It + 4 * fg + i) * HG_LS + 16 * J + fr] = (unsigned short)f2bf(d[i]); } }
        __syncthreads();
        f32x4 o[4];
        const hbf16x8 p0 = lds8(PM + (16 * tt + fr) * HG_LS + 8 * fg), p1 = lds8(PM + (16 * tt + fr) * HG_LS + 32 + 8 * fg);
        hbf16x8 qb[4];
#pragma unroll
        for (int ks = 0; ks < 4; ++ks) qb[ks] = lds8(QB + (16 * tt + fr) * HG_LD + 32 * ks + 8 * fg);
        float ss = 0.f;
#pragma unroll
        for (int et = 0; et < 4; ++et) { const int e0 = 64 * eh + 16 * et; f32x4 d = {0.f, 0.f, 0.f, 0.f};
            d = __builtin_amdgcn_mfma_f32_16x16x32_bf16(lds8(VT + (e0 + fr) * HG_LS + 8 * fg), p0, d, 0, 0, 0);
            d = __builtin_amdgcn_mfma_f32_16x16x32_bf16(lds8(VT + (e0 + fr) * HG_LS + 32 + 8 * fg), p1, d, 0, 0, 0);
#pragma unroll
            for (int ks = 0; ks < 4; ++ks) d = __builtin_amdgcn_mfma_f32_16x16x32_bf16(sfr[et][ks], qb[ks], d, 0, 0, 0);
            o[et] = d; ss += (d[0] * d[0] + d[1] * d[1]) + (d[2] * d[2] + d[3] * d[3]); }
        ss += xor_get(ss, lane, 16); ss += xor_get(ss, lane, 32);
        if (fg == 0) SSQ[(tt * 2 + eh) * 16 + fr] = ss;
        __syncthreads();
        const float rs = 1.f / sqrtf((SSQ[(tt * 2) * 16 + fr] + SSQ[(tt * 2 + 1) * 16 + fr]) * (1.f / 128.f) + EPS);
#pragma unroll
        for (int et = 0; et < 4; ++et) { const int e = 64 * eh + 16 * et + 4 * fg;
            const f32x4 gn = gnv[et]; const v2u gt = gtv[et];
            v2u w; w.x = pg8::cvt_pk_bf16(o[et][0] * rs * gn.x * pg8::silu_f(bf_lo(gt.x)), o[et][1] * rs * gn.y * pg8::silu_f(bf_hi(gt.x))); w.y = pg8::cvt_pk_bf16(o[et][2] * rs * gn.z * pg8::silu_f(bf_lo(gt.y)), o[et][3] * rs * gn.w * pg8::silu_f(bf_hi(gt.y)));
            *(GAS v2u*)(OC + tok * D + h * 128 + e) = w; }
        __syncthreads();
    }
}
template <int PASS> __device__ __forceinline__ void phase_hgrn(Frame& F, int j) {
    const int tid = F.wave * 64 + fresh_lane();
    unsigned lf[8]; unsigned qw[8]; v4u va, vb;
#pragma unroll
    for (int i = 0; i < 8; ++i) qw[i] = 0u;
    if (F.bx < NB * 6 * 64) hgrn_load<PASS>(F, tid, F.bx, lf, qw, va, vb);
    for (int u = F.bx; u < NB * 6 * 64; u += F.G) hgrn_unit<PASS>(F, tid, u, (u + F.G < NB * 6 * 64) ? u + F.G : -1, j, lf, qw, va, vb);
}
__device__ __forceinline__ void phase_hgrn_scan(Frame& F) {
    const bf16* SLOC = (const bf16*)(F.ws + WS_SLOC); bf16* SIN = (bf16*)(F.ws + WS_SIN); const float* DCH = (const float*)(F.ws + WS_DCH);
    const int tid = F.wave * 64 + fresh_lane();
    for (int id = F.bx * (NWAVES * 64) + tid; id < NB * 6 * 128 * 16; id += F.G * NWAVES * 64) {
        const int k8 = id & 15, e = (id >> 4) & 127, bh = id >> 11;
        const GAS v4u* sl = (const GAS v4u*)(SLOC + ((size_t)bh * 64 * 128 + e) * 128) + k8; const GAS f32x4* dc = (const GAS f32x4*)(DCH + (size_t)bh * 64 * 128) + 2 * k8;
        GAS v4u* so = (GAS v4u*)(SIN + ((size_t)bh * 64 * 128 + e) * 128) + k8;
        float st[8];
#pragma unroll
        for (int i = 0; i < 8; ++i) st[i] = 0.f;
#pragma unroll 8
        for (int c = 0; c < 64; ++c) { const v4u aw = sl[(size_t)c * 128 * 16]; const f32x4 d0 = dc[(size_t)c * 32], d1 = dc[(size_t)c * 32 + 1];
            v4u w; w.x = pg8::cvt_pk_bf16(st[0], st[1]); w.y = pg8::cvt_pk_bf16(st[2], st[3]); w.z = pg8::cvt_pk_bf16(st[4], st[5]); w.w = pg8::cvt_pk_bf16(st[6], st[7]); so[(size_t)c * 128 * 16] = w;
            st[0] = d0.x * st[0] + bf_lo(aw.x); st[1] = d0.y * st[1] + bf_hi(aw.x); st[2] = d0.z * st[2] + bf_lo(aw.y); st[3] = d0.w * st[3] + bf_hi(aw.y);
            st[4] = d1.x * st[4] + bf_lo(aw.z); st[5] = d1.y * st[5] + bf_hi(aw.z); st[6] = d1.z * st[6] + bf_lo(aw.w); st[7] = d1.w * st[7] + bf_hi(aw.w); }
    }
}
struct Args { const float* in[27]; float* out; unsigned char* ws; };
__global__ void __launch_bounds__(NWAVES * 64, 2) mk_fwd(Args) {
    extern __shared__ __attribute__((aligned(16))) unsigned char lds[];
    Frame F;
    F.lds = (LAS unsigned char*)lds;
    F.MISC = (volatile LAS unsigned*)(F.lds + MISC_OFF);
    F.wave = __builtin_amdgcn_readfirstlane((int)(threadIdx.x >> 6));
    F.G = gridDim.x; F.bx = blockIdx.x; { const int bx = blockIdx.x; F.vcu = (F.G % 8 == 0) ? (bx % 8) * (F.G / 8) + bx / 8 : bx; }
    for (int u = threadIdx.x; u < (LDS_BYTES - LDSCTL_OFF) / 4; u += NWAVES * 64) ((LAS unsigned*)(F.lds + LDSCTL_OFF))[u] = 0u;
    __syncthreads();
    {
        LAS unsigned long long* tab = (LAS unsigned long long*)(F.lds + LDSCTL_OFF);
        if (threadIdx.x < 29) tab[threadIdx.x] = ((const unsigned long long*)__builtin_amdgcn_kernarg_segment_ptr())[threadIdx.x];
        __syncthreads();
        F.in.t = tab; F.out = (GAS float*)(unsigned long long)F.in[27]; F.ws = (GAS unsigned char*)(unsigned long long)F.in[28]; }
    F.ctl = (gu32*)(F.ws + WS_CTL);
    XcdBarrier bar = xcd_barrier_post((unsigned*)(F.ctl + CW_BAR), F.MISC + 8);
#define XBAR_() do { XcdBarrier b_ = bar; { unsigned long long p_ = (unsigned long long)b_.bar; asm volatile("" : "+s"(p_), "+s"(b_.x)); b_.bar = (unsigned*)(GAS unsigned*)p_; } xcd_barrier(b_); if (MK_DUP & 0x8000) xcd_barrier(b_); } while (0)
#define GRID_BAR() XBAR_()
#define REP(cat) for (int rep_ = 0; rep_ < (((MK_DUP >> (cat)) & 1) ? 2 : 1); ++rep_)
#if MK_TS
    unsigned long long ts_last = rt(); unsigned ts_cat[15], ts_wb[14];
#pragma unroll
    for (int i = 0; i < 15; ++i) ts_cat[i] = 0u;
#pragma unroll
    for (int i = 0; i < 14; ++i) ts_wb[i] = 0u;
#define GRID_BAR_T(c) do { const unsigned long long arr_ = rt(); XBAR_(); const unsigned long long now_ = rt(); const unsigned dt_ = (unsigned)(arr_ - ts_last), db_ = (unsigned)(now_ - arr_); ts_last = now_; const int cc_ = (c); \
    _Pragma("unroll") for (int i_ = 0; i_ < 14; ++i_) { ts_cat[i_] += (cc_ == i_) ? dt_ : 0u; ts_wb[i_] += (cc_ == i_) ? db_ : 0u; } ts_cat[14] += db_; } while (0)
#else
#define GRID_BAR_T(c) XBAR_()
#endif

    REP(0) phase_prologue(F);
    GRID_BAR_T(0);
    {
        struct MkvOrder { int G, c; __device__ bool next(int i, pg8::Unit& u) const { const int L = i * G + c; if (L >= 64) return false; u.pm = L >> 1; u.pn = L & 1; u.pb = (u.pm >> 3) * 2 + u.pn; return true; }
            __device__ __forceinline__ void a_ready(const pg8::Unit&) const {} __device__ __forceinline__ void done(const pg8::Unit&) const {} } So{F.G, F.bx};
        pg8::Gemm g{(const pg8::bf16_t*)(F.ws + WS_MEMN), (const pg8::bf16_t*)(F.ws + WS_WMKV), 4 * NB * MEML, 512, D};
        pg8::EpiProj E{(pg8::bf16_t*)(F.ws + WS_MKV), 512, 0u, 1.f, 0, 0, nullptr, 0, nullptr, nullptr, nullptr};
        pg8::gemm_phase<pg8::EpiProj, MkvOrder, true, true>(F.lds + RING_OFF, g, So, E, F.wave);
    }
    for (int l = 0; l < 4; ++l) {
        const int j = l >> 1; const bool isA = (l & 1) == 0;
        {
            unsigned long long w_ = (unsigned long long)F.ws, o_ = (unsigned long long)F.out, c_ = (unsigned long long)F.ctl, b_ = (unsigned long long)bar.bar;
            asm volatile("" : "+s"(w_), "+s"(o_), "+s"(c_), "+s"(b_)); F.ws = (GAS unsigned char*)w_; F.out = (GAS float*)o_; F.ctl = (gu32*)c_; bar.bar = (unsigned*)b_;
            asm volatile("" : "+s"(F.vcu), "+s"(F.G), "+s"(F.bx), "+s"(F.wave)); }
        bf16* const XN = (bf16*)(F.ws + WS_XN); bf16* const OC = (bf16*)(F.ws + WS_OC);
        if (isA) {
            pg8::Gemm g{XN, (const pg8::bf16_t*)(F.ws + WS_WINA) + (size_t)j * AIN * D, T, AIN, D}; pg8::StaticOrder So; So.init(T, AIN, F.G, F.bx);
            pg8::EpiProj E{(pg8::bf16_t*)(F.ws + WS_BIG), AIN, 0x207u, C2, 0, 0, nullptr, 0, nullptr, (const float*)(F.ws + WS_SSQP) + (size_t)(4 + j) * T * 16, (unsigned*)(F.ctl + CW_N2) + j * (NB * 24 * 64 * 2)};
            REP(1) pg8::gemm_phase<pg8::EpiProj, pg8::StaticOrder, true, true>(F.lds + RING_OFF, g, So, E, F.wave);
        } else {
            pg8::Gemm g{XN, (const pg8::bf16_t*)(F.ws + WS_WINB) + (size_t)j * BIN * D, T, BIN, D}; pg8::StaticOrder So; So.init(T, BIN, F.G, F.bx);
            pg8::EpiProj E{(pg8::bf16_t*)(F.ws + WS_BIG), BIN, 0x1000u, C2, 3, 6, (float*)(F.ws + WS_BIG + 208 * MiB), DAW, (const float*)(F.ws + WS_ROUTE + 1024 * 1024) + j * DAW, (const float*)(F.ws + WS_SSQP) + (size_t)(2 * j + 1) * T * 16, nullptr};
            REP(1) pg8::gemm_phase<pg8::EpiProj, pg8::StaticOrder, true, true>(F.lds + RING_OFF, g, So, E, F.wave);
        }
        GRID_BAR_T(1);
        const int ldp = isA ? AIN : BIN, qmoff = isA ? 2304 : 3072;
        if (isA) {
            const attn_body::bf16* P = (const attn_body::bf16*)(F.ws + WS_BIG); attn_body::bf16* O01 = (attn_body::bf16*)(F.ws + WS_BIG + 160 * MiB);
            const GAS float* N2 = (const GAS float*)(F.ctl + CW_N2) + j * (NB * 24 * 64 * 2); const int lane_n = fresh_lane();
            const bool tabdeal = (F.G == 256);
            static_assert(attn_body::LDS2_BYTES <= RING_BYTES, "attention LDS");
            REP(2) for (int u_ = F.vcu; u_ < NB * 2 * 96; u_ += F.G) {
                int b, m, h, qb; if (tabdeal) { const int e = ATT_DEAL[u_ & 15][u_ >> 8]; b = (u_ >> 5) & 7; m = (u_ >> 4) & 1; h = e >> 4; qb = e & 15; } else { b = u_ / 192; m = (u_ / 96) & 1; h = (u_ % 96) >> 4; qb = u_ & 15; }
                const float nsl2 = -1.4426950408889634f * exp2f(-8.f * (float)(h + 1) / 6.f);
                const attn_body::bf16* Kh = P + (size_t)b * S * AIN + 768 + h * 128 + m * 64; const attn_body::bf16* Vh = P + (size_t)b * S * AIN + 1536 + h * 128;
                { const int NT = 4 * qb + 4;
                    typedef float f32x2n __attribute__((ext_vector_type(2)));
                    const f32x2n qn2 = *(const GAS f32x2n*)(N2 + ((b * 24 + h * 2 + m) * 64 + lane_n) * 2), kn2 = *(const GAS f32x2n*)(N2 + ((b * 24 + 12 + h * 2 + m) * 64 + lane_n) * 2);
                    const bool qin = (lane_n >= 4 * qb && lane_n < 4 * qb + 4), kin = (lane_n < NT);
                    float qa = qin ? qn2.x : 0.f, qb2 = qin ? qn2.y : 0.f, ka = kin ? kn2.x : 0.f, kb = kin ? kn2.y : 0.f;
#pragma unroll
                    for (int o = 1; o < 64; o <<= 1) { qa = fmaxf(qa, xor_get(qa, lane_n, o)); qb2 = fmaxf(qb2, xor_get(qb2, lane_n, o)); ka = fmaxf(ka, xor_get(ka, lane_n, o)); kb = fmaxf(kb, xor_get(kb, lane_n, o)); }
                    const float dreq = (160.f + 2.f * (sqrtf(qa * ka) + sqrtf(qb2 * kb)) * 1.02f) / (-nsl2);
                    int tskip = (int)floorf(((float)(qb * 256 - 63) - dreq) * (1.f / 64.f)); tskip = tskip < 0 ? 0 : tskip; tskip &= ~1; tskip = tskip > NT - 4 ? NT - 4 : tskip;
                    tskip = __builtin_amdgcn_readfirstlane(tskip);
                    attn_body::attn_unit2<8>(P + (size_t)(b * S + qb * 256) * AIN + h * 128 + m * 64, AIN, Kh + (size_t)tskip * 64 * AIN, AIN, Vh + (size_t)tskip * 64 * AIN, AIN,
                                             O01 + (size_t)m * T * DAW + (size_t)(b * S + qb * 256) * DAW + h * 128, DAW, NT - tskip, qb * 256 - 64 * tskip, nsl2, (char*)lds + RING_OFF, F.wave); }
            }
        } else {
            REP(3) phase_hgrn<1>(F, j);
        }
        {
            const attn_body::bf16* P = (const attn_body::bf16*)(F.ws + WS_BIG); const attn_body::bf16* KV = (const attn_body::bf16*)(F.ws + WS_MKV) + (size_t)l * NB * MEML * 512;
#ifndef NO_ATTN1
            REP(13) for (int u = F.vcu; u < NB * 4 * 16; u += F.G) { const int qb = u & 15, hm = (u >> 4) & 3, b = u >> 6;
                attn_body::attn_unit<1, 8>(P + (size_t)(b * S + qb * 256) * ldp + qmoff + hm * 64, ldp, KV + (size_t)b * MEML * 512 + hm * 64, 512, KV + (size_t)b * MEML * 512 + 256 + hm * 64, 512,
                                           (attn_body::bf16*)OC + (size_t)(b * S + qb * 256) * D + DAW + hm * 64, D, 4, 0, 0.f, (char*)lds + RING_OFF, F.wave); }
#endif
        }
        GRID_BAR_T(isA ? 2 : 3);
        if (isA) { REP(5) phase_diff_combine(F, j, l == 0 ? 0.2f : (float)(0.8 - 0.6 * 0.5488116360940264)); }
        else { REP(14) phase_hgrn_scan(F); GRID_BAR_T(4); REP(4) phase_hgrn<3>(F, j); }
        GRID_BAR_T(isA ? 5 : 4);
#if MK_DBG
        {
            const int lane = fresh_lane(); const int gw = F.bx * NWAVES + F.wave, NGW = F.G * NWAVES;
            for (int r = gw; r < 1024; r += NGW) { f32x4 v[4];
#pragma unroll
                for (int jj = 0; jj < 4; ++jj) { const v2u a = ((const GAS v2u*)(OC + (size_t)(r * 32) * D))[lane + 64 * jj]; v[jj].x = bf_lo(a.x); v[jj].y = bf_hi(a.x); v[jj].z = bf_lo(a.y); v[jj].w = bf_hi(a.y); }
                dbg_sample_f32(F, lane, 8 + l, r * 32, v); }
        }
#endif
        {
            pg8::Gemm g{OC, (const pg8::bf16_t*)(F.ws + WS_WOUT) + (size_t)l * D * D, T, D, D}; pg8::StaticOrder So; So.init(T, D, F.G, F.bx);
            pg8::EpiResid E{XN, D, isA ? (float*)(F.ws + WS_SSQP) + (size_t)(2 * j) * T * 16 : nullptr, 1.f};
            pg8::gemm_phase<pg8::EpiResid, pg8::StaticOrder, true, true>(F.lds + RING_OFF, g, So, E, F.wave);
        }
        GRID_BAR_T(6);
        if (isA) {
            {
                pg8::Gemm g{XN, (const pg8::bf16_t*)(F.ws + WS_WGUD) + (size_t)j * 2 * FFD * D, T, 2 * FFD, D}; pg8::StaticOrder So; So.init(T, 2 * FFD, F.G, F.bx);
                pg8::EpiSwiglu<false> E{(pg8::bf16_t*)(F.ws + WS_BIG), FFD, 1.f, 1.f, (const float*)(F.ws + WS_SSQP) + (size_t)(2 * j) * T * 16};
                REP(7) pg8::gemm_phase<pg8::EpiSwiglu<false>, pg8::StaticOrder, true, true>(F.lds + RING_OFF, g, So, E, F.wave);
            }
            GRID_BAR_T(7);
            {
                pg8::Gemm g{(const pg8::bf16_t*)(F.ws + WS_BIG), (const pg8::bf16_t*)(F.ws + WS_WDND) + (size_t)j * D * FFD, T, D, FFD}; pg8::StaticOrder So; So.init(T, D, F.G, F.bx);
                pg8::EpiResid E{XN, D, (float*)(F.ws + WS_SSQP) + (size_t)(2 * j + 1) * T * 16, 1.f};
                pg8::gemm_phase<pg8::EpiResid, pg8::StaticOrder, true, true>(F.lds + RING_OFF, g, So, E, F.wave);
            }
            GRID_BAR_T(8);

        } else {
            gu32* gcnt = F.ctl + CW_GCNT + 64 * j;
#ifndef NO_NORM
            phase_router(F, F.in[22] + j * D, F.in[23] + (size_t)j * D * 8, gcnt);
#endif
            GRID_BAR_T(9);
            phase_gather(F, gcnt, F.in[22] + j * D);
            GRID_BAR_T(10);
            {
                int cnt[8];
#pragma unroll
                for (int e = 0; e < 8; ++e) cnt[e] = __builtin_amdgcn_readfirstlane((int)__hip_atomic_load(gcnt + e, RLX_AGENT));
                pg8::Gemm g{(const pg8::bf16_t*)(F.ws + WS_XG), (const pg8::bf16_t*)(F.ws + WS_WGUM + (size_t)j * NE * 2 * FFE * D), MAXROWS, 2 * FFE, D / 2}; pg8::MoeOrder So; So.init(cnt, 2 * FFE / 256, F.G, F.bx);
                pg8::EpiSwiglu<true> E{(pg8::bf16_t*)(F.ws + WS_BIG), FFE, 1.f / (SC_X * SC_WGU), SC_H, nullptr};
                REP(11) pg8::gemm_phase<pg8::EpiSwiglu<true>, pg8::MoeOrder, true, true, true>(F.lds + RING_OFF, g, So, E, F.wave);
            }
            GRID_BAR_T(11);
            {
                int cnt[8];
#pragma unroll
                for (int e = 0; e < 8; ++e) cnt[e] = __builtin_amdgcn_readfirstlane((int)__hip_atomic_load(gcnt + e, RLX_AGENT));
                pg8::Gemm g{(const pg8::bf16_t*)(F.ws + WS_BIG), (const pg8::bf16_t*)(F.ws + WS_WDNM + (size_t)j * NE * D * FFE), MAXROWS, D, FFE / 2}; pg8::MoeOrder So; So.init(cnt, D / 256, F.G, F.bx);
                pg8::EpiProj E{(pg8::bf16_t*)(F.ws + WS_Y), D, 0xffffffffu, 1.f / (SC_H * SC_WDN), 0, 0, nullptr, 0, nullptr, nullptr, nullptr};
                REP(12) pg8::gemm_phase<pg8::EpiProj, pg8::MoeOrder, true, true, true>(F.lds + RING_OFF, g, So, E, F.wave);
            }
            GRID_BAR_T(12);
            if (l == 1) { phase_combine<false>(F, nullptr, nullptr, (float*)(F.ws + WS_SSQP) + (size_t)5 * T * 16); GRID_BAR_T(9); }
            else {
                phase_combine<true>(F, (float*)F.out, F.in[26], nullptr);
#if MK_TS
                if (F.bx == 0 && F.wave == 0) { unsigned ta = 0u;
#pragma unroll
                    for (int i = 0; i < 15; ++i) if ((MK_TS_A >> i) & 1) ta += ts_cat[i];
#pragma unroll
                    for (int i = 0; i < 14; ++i) if ((MK_TS_B >> i) & 1) ta += ts_wb[i];
                    const unsigned long long t0_ = rt(); while ((unsigned)(rt() - t0_) < ta) __builtin_amdgcn_s_sleep(8); }
#endif
            }
        }
    }
#undef GRID_BAR
}

static int mk_launch(void* const* d_in, void* d_out, void* d_ws, size_t ws_size, hipStream_t stream) {
    static int grid = 0;
    if (grid == 0) {
        if (ws_size < WS_END) { fprintf(stderr, "kernel_launch: workspace too small (%zu < %zu)\n", ws_size, (size_t)WS_END); grid = -1; return -1; }
        int dev = 0, cus = 0, per_cu = 0;
        if (hipGetDevice(&dev) != hipSuccess || hipDeviceGetAttribute(&cus, hipDeviceAttributeMultiprocessorCount, dev) != hipSuccess) { grid = -1; return -1; }
        if (hipFuncSetAttribute((const void*)mk_fwd, hipFuncAttributeMaxDynamicSharedMemorySize, LDS_BYTES) != hipSuccess) { fprintf(stderr, "kernel_launch: hipFuncSetAttribute failed\n"); grid = -1; return -1; }
        if (hipOccupancyMaxActiveBlocksPerMultiprocessor(&per_cu, (const void*)mk_fwd, NWAVES * 64, LDS_BYTES) != hipSuccess || per_cu < 1) fprintf(stderr, "kernel_launch: note: occupancy query reports %d\n", per_cu);
        (void)hipGetLastError();
        grid = cus;
        if (grid != 256) fprintf(stderr, "kernel_launch: note: %d CUs (tuned for 256)\n", grid);
    }
    if (grid < 0) return -1;
    if (hipMemsetAsync((char*)d_ws + WS_CTL, 0, CTL_ZERO_BYTES, stream) != hipSuccess) return -1;
    Args a{};
    for (int i = 0; i < 27; ++i) a.in[i] = (const float*)d_in[i];
    a.out = (float*)d_out; a.ws = (unsigned char*)d_ws;
    hipLaunchKernelGGL(mk_fwd, dim3(grid), dim3(NWAVES * 64), LDS_BYTES, stream, a);
    return 0;
}
#if MK_DBG
namespace nv {
constexpr int MEMW = 256;

__device__ __forceinline__ float sigmoidf_(float z) { return 1.f / (1.f + __expf(-z)); }
__device__ __forceinline__ float siluf_(float z) { return z / (1.f + __expf(-z)); }

__global__ void __launch_bounds__(256) k_rmsnorm(const float* __restrict__ in, const float* __restrict__ g, float* __restrict__ out, int rows) {
    const int lane = threadIdx.x & 63, w = (blockIdx.x * 256 + threadIdx.x) >> 6, nw = (gridDim.x * 256) >> 6;
    for (int r = w; r < rows; r += nw) {
        const float4* xr = (const float4*)(in + (size_t)r * D) + lane;
        float4 v[4]; float s = 0.f;
#pragma unroll
        for (int j = 0; j < 4; ++j) { v[j] = xr[64 * j]; s += v[j].x * v[j].x + v[j].y * v[j].y + v[j].z * v[j].z + v[j].w * v[j].w; }
        const float rstd = rsqrtf(wave_sum(s) * (1.f / D) + EPS);
        float4* o = (float4*)(out + (size_t)r * D) + lane;
#pragma unroll
        for (int j = 0; j < 4; ++j) { const float4 gg = ((const float4*)g)[lane + 64 * j];
            o[64 * j] = make_float4(v[j].x * rstd * gg.x, v[j].y * rstd * gg.y, v[j].z * rstd * gg.z, v[j].w * rstd * gg.w); }
    }
}

template <int ADD>
__global__ void __launch_bounds__(256) k_gemm(const float* __restrict__ A, int lda, const float* __restrict__ Bm, int ldb, float* C, int ldc, const float* R, int M, int N, int K, const int* dyn, int offA, int offC) {
    __shared__ float As[8][132];
    __shared__ float Bs[8][128];
    int roffA = 0, roffC = 0;
    if (dyn) { roffA = offA ? dyn[0] : 0; roffC = offC ? dyn[0] : 0; M = dyn[1] < 16384 ? dyn[1] : 16384; }
    const int m0 = blockIdx.y * 128, n0 = blockIdx.x * 128;
    if (m0 >= M) return;
    const int tid = threadIdx.x, ty = tid >> 4, tx = tid & 15;
    float acc[8][8];
#pragma unroll
    for (int i = 0; i < 8; ++i)
#pragma unroll
        for (int j = 0; j < 8; ++j) acc[i][j] = 0.f;
    const int ar = tid >> 1, ak = (tid & 1) * 4;
    int arow = m0 + ar; if (arow >= M) arow = M - 1;
    const float* ap = A + (size_t)(roffA + arow) * lda + ak;
    const int bk = tid >> 5, bn = (tid & 31) * 4;
    const float* bp = Bm + (size_t)bk * ldb + n0 + bn;
    for (int k0 = 0; k0 < K; k0 += 8) {
        const float4 av = *(const float4*)(ap + k0);
        const float4 bv = *(const float4*)(bp + (size_t)k0 * ldb);
        __syncthreads();
        As[ak + 0][ar] = av.x; As[ak + 1][ar] = av.y; As[ak + 2][ar] = av.z; As[ak + 3][ar] = av.w;
        *(float4*)&Bs[bk][bn] = bv;
        __syncthreads();
#pragma unroll
        for (int k = 0; k < 8; ++k) {
            float a[8], b[8];
            *(float4*)&a[0] = *(const float4*)&As[k][ty * 4]; *(float4*)&a[4] = *(const float4*)&As[k][64 + ty * 4];
            *(float4*)&b[0] = *(const float4*)&Bs[k][tx * 4]; *(float4*)&b[4] = *(const float4*)&Bs[k][64 + tx * 4];
#pragma unroll
            for (int i = 0; i < 8; ++i)
#pragma unroll
                for (int j = 0; j < 8; ++j) acc[i][j] += a[i] * b[j];
        }
    }
#pragma unroll
    for (int i = 0; i < 8; ++i) {
        const int r = m0 + (i < 4 ? ty * 4 + i : 64 + ty * 4 + (i - 4));
        if (r >= M) continue;
#pragma unroll
        for (int jh = 0; jh < 2; ++jh) {
            const int c = n0 + jh * 64 + tx * 4;
            float4 v = make_float4(acc[i][jh * 4 + 0], acc[i][jh * 4 + 1], acc[i][jh * 4 + 2], acc[i][jh * 4 + 3]);
            if (ADD) { const float4 rr = *(const float4*)(R + (size_t)(roffC + r) * ldc + c); v.x += rr.x; v.y += rr.y; v.z += rr.z; v.w += rr.w; }
            *(float4*)(C + (size_t)(roffC + r) * ldc + c) = v;
        }
    }
}

__global__ void __launch_bounds__(64) k_diff_attn(const float* __restrict__ proj  , float* __restrict__ O  ) {
    const int c = blockIdx.x, bhm = blockIdx.y, m = bhm & 1, h = (bhm >> 1) % 6, b = bhm / 12;
    const int qpos = c * 64 + threadIdx.x;
    const float slope = exp2f(-8.f * (float)(h + 1) / 6.f);
    float q[64];
    const float* qp = proj + (size_t)(b * S + qpos) * AIN + h * 128 + m * 64;
#pragma unroll
    for (int d = 0; d < 64; d += 4) { const float4 v = *(const float4*)(qp + d); q[d] = v.x * 0.125f; q[d + 1] = v.y * 0.125f; q[d + 2] = v.z * 0.125f; q[d + 3] = v.w * 0.125f; }
    const int nk = (c + 1) * 64;
    const float* kbase = proj + (size_t)b * S * AIN + DAW + h * 128 + m * 64;
    const float* vbase = proj + (size_t)b * S * AIN + 2 * DAW + h * 128;
    float mx = -3.0e38f;
    for (int k = 0; k < nk; ++k) {
        const float* kr = kbase + (size_t)k * AIN;
        float s = 0.f;
#pragma unroll
        for (int d = 0; d < 64; ++d) s += q[d] * kr[d];
        s -= slope * fabsf((float)(qpos - k));
        mx = fmaxf(mx, s);
    }
    float o[128];
#pragma unroll
    for (int e = 0; e < 128; ++e) o[e] = 0.f;
    float l = 0.f;
    for (int k = 0; k < nk; ++k) {
        const float* kr = kbase + (size_t)k * AIN;
        float s = 0.f;
#pragma unroll
        for (int d = 0; d < 64; ++d) s += q[d] * kr[d];
        s -= slope * fabsf((float)(qpos - k));
        const float p = __expf(s - mx);
        l += p;
        const float* vr = vbase + (size_t)k * AIN;
#pragma unroll
        for (int e = 0; e < 128; ++e) o[e] += p * vr[e];
    }
    const float il = 1.f / l;
    float* op = O + (size_t)m * T * DAW + (size_t)(b * S + qpos) * DAW + h * 128;
#pragma unroll
    for (int e = 0; e < 128; e += 4) *(float4*)(op + e) = make_float4(o[e] * il, o[e + 1] * il, o[e + 2] * il, o[e + 3] * il);
}
__global__ void __launch_bounds__(256) k_diff_combine(const float* __restrict__ O, const float* __restrict__ lq1, const float* __restrict__ lk1, const float* __restrict__ lq2, const float* __restrict__ lk2,
                                                       const float* __restrict__ subln, float lam_init, float* __restrict__ OC) {
    float s1 = 0.f, s2 = 0.f;
    for (int d = 0; d < 64; ++d) { s1 += lq1[d] * lk1[d]; s2 += lq2[d] * lk2[d]; }
    const float lam = __expf(s1) - __expf(s2) + lam_init;
    const int idx = blockIdx.x * 256 + threadIdx.x;
    if (idx >= T * 6) return;
    const int t = idx / 6, h = idx % 6;
    const float* o0 = O + (size_t)t * DAW + h * 128; const float* o1 = o0 + (size_t)T * DAW;
    float v[128]; float ss = 0.f;
#pragma unroll
    for (int e = 0; e < 128; ++e) { v[e] = o0[e] - lam * o1[e]; ss += v[e] * v[e]; }
    const float rstd = rsqrtf(ss * (1.f / 128.f) + EPS) * (1.f - lam_init);
    float* oc = OC + (size_t)t * D + h * 128;
#pragma unroll
    for (int e = 0; e < 128; ++e) oc[e] = v[e] * rstd * subln[e];
}
__global__ void __launch_bounds__(64) k_mem_attn(const float* __restrict__ proj, int ldp, int qoff, const float* __restrict__ kv  , float* __restrict__ OC) {
    const int h = blockIdx.y, t = blockIdx.x * 64 + threadIdx.x, b = t / S;
    float q[64];
    const float* qp = proj + (size_t)t * ldp + qoff + h * 64;
#pragma unroll
    for (int d = 0; d < 64; ++d) q[d] = qp[d] * 0.125f;
    const float* kb = kv + (size_t)b * MEML * 512 + h * 64;
    float mx = -3.0e38f;
    for (int k = 0; k < MEML; ++k) { const float* kr = kb + (size_t)k * 512; float s = 0.f;
#pragma unroll
        for (int d = 0; d < 64; ++d) s += q[d] * kr[d];
        mx = fmaxf(mx, s); }
    float o[64]; float l = 0.f;
#pragma unroll
    for (int e = 0; e < 64; ++e) o[e] = 0.f;
    for (int k = 0; k < MEML; ++k) { const float* kr = kb + (size_t)k * 512; float s = 0.f;
#pragma unroll
        for (int d = 0; d < 64; ++d) s += q[d] * kr[d];
        const float p = __expf(s - mx); l += p; const float* vr = kr + 256;
#pragma unroll
        for (int e = 0; e < 64; ++e) o[e] += p * vr[e]; }
    const float il = 1.f / l;
    float* oc = OC + (size_t)t * D + DAW + h * 64;
#pragma unroll
    for (int e = 0; e < 64; ++e) oc[e] = o[e] * il;
}
__global__ void __launch_bounds__(128) k_hgrn(const float* __restrict__ proj  , const float* __restrict__ lbl  , int j, float* __restrict__ Ob  ) {
    __shared__ float sq[16][128], sf[16][128], sk[16][128];
    const int bh = blockIdx.x, b = bh / 6, h = bh % 6, tid = threadIdx.x;
    float lb = 0.f;
    if (j == 1) { const float l0 = lbl[h * 128 + tid], l1 = lbl[768 + h * 128 + tid]; lb = 1.f / (1.f + __expf(l0 - l1)); }
    float St[128];
#pragma unroll
    for (int k = 0; k < 128; ++k) St[k] = 0.f;
    for (int t0 = 0; t0 < S; t0 += 16) {
        __syncthreads();
        for (int jj = 0; jj < 16; ++jj) { const float* pr = proj + (size_t)(b * S + t0 + jj) * BIN + h * 128 + tid;
            const float qv = pr[0], fz = pr[768]; const float sg = sigmoidf_(fz); const float f = lb + (1.f - lb) * sg;
            sq[jj][tid] = qv; sf[jj][tid] = f; sk[jj][tid] = 1.f - f; }
        __syncthreads();
        for (int jj = 0; jj < 16; ++jj) {
            const float v = proj[(size_t)(b * S + t0 + jj) * BIN + 1536 + h * 128 + tid];
            float o = 0.f;
#pragma unroll
            for (int k = 0; k < 128; k += 4) { const float4 f4 = *(const float4*)&sf[jj][k], k4 = *(const float4*)&sk[jj][k], q4 = *(const float4*)&sq[jj][k];
                St[k] = f4.x * St[k] + k4.x * v; o += q4.x * St[k];
                St[k + 1] = f4.y * St[k + 1] + k4.y * v; o += q4.y * St[k + 1];
                St[k + 2] = f4.z * St[k + 2] + k4.z * v; o += q4.z * St[k + 2];
                St[k + 3] = f4.w * St[k + 3] + k4.w * v; o += q4.w * St[k + 3]; }
            Ob[(size_t)(b * S + t0 + jj) * DAW + h * 128 + tid] = o;
        }
    }
}
__global__ void __launch_bounds__(256) k_hgrn_out(const float* __restrict__ Ob, const float* __restrict__ proj, const float* __restrict__ gn, float* __restrict__ OC) {
    const int idx = blockIdx.x * 256 + threadIdx.x; if (idx >= T * 6) return;
    const int t = idx / 6, h = idx % 6;
    const float* o = Ob + (size_t)t * DAW + h * 128; const float* g = proj + (size_t)t * BIN + 2304 + h * 128;
    float ss = 0.f;
#pragma unroll 8
    for (int e = 0; e < 128; ++e) ss += o[e] * o[e];
    const float rstd = rsqrtf(ss * (1.f / 128.f) + EPS);
    float* oc = OC + (size_t)t * D + h * 128;
#pragma unroll 8
    for (int e = 0; e < 128; ++e) oc[e] = o[e] * rstd * gn[e] * siluf_(g[e]);
}
__global__ void __launch_bounds__(256) k_swiglu(const float* __restrict__ GU, float* __restrict__ Hh, int M, int FF, const int* dyn) {
    if (dyn) { M = dyn[1] < 16384 ? dyn[1] : 16384; }
    const size_t n = (size_t)M * FF;
    for (size_t i = (size_t)blockIdx.x * 256 + threadIdx.x; i < n; i += (size_t)gridDim.x * 256) {
        const size_t r = i / FF; const int c = (int)(i % FF);
        const float* gp = GU + r * (size_t)(2 * FF);
        Hh[r * (size_t)FF + c] = siluf_(gp[c]) * gp[FF + c];
    }
}
__global__ void __launch_bounds__(256) k_router(const float* __restrict__ xn, const float* __restrict__ wr  , int* __restrict__ tope  , float* __restrict__ topw  ) {
    const int lane = threadIdx.x & 63, t = (blockIdx.x * 256 + threadIdx.x) >> 6;
    if (t >= T) return;
    float acc[8];
#pragma unroll
    for (int e = 0; e < 8; ++e) acc[e] = 0.f;
    for (int k = lane; k < D; k += 64) { const float xv = xn[(size_t)t * D + k]; const float4 w0 = *(const float4*)(wr + k * 8), w1 = *(const float4*)(wr + k * 8 + 4);
        acc[0] += xv * w0.x; acc[1] += xv * w0.y; acc[2] += xv * w0.z; acc[3] += xv * w0.w; acc[4] += xv * w1.x; acc[5] += xv * w1.y; acc[6] += xv * w1.z; acc[7] += xv * w1.w; }
#pragma unroll
    for (int e = 0; e < 8; ++e) acc[e] = wave_sum(acc[e]);
    if (lane == 0) {
        int e0 = 0; float v0 = acc[0];
#pragma unroll
        for (int e = 1; e < 8; ++e) if (acc[e] > v0) { v0 = acc[e]; e0 = e; }
        int e1 = -1; float v1 = -3.0e38f;
#pragma unroll
        for (int e = 0; e < 8; ++e) if (e != e0 && acc[e] > v1) { v1 = acc[e]; e1 = e; }
        const float p1 = __expf(v1 - v0), inv = 1.f / (1.f + p1);
        tope[t * 2] = e0; tope[t * 2 + 1] = e1; topw[t * 2] = inv; topw[t * 2 + 1] = p1 * inv;
    }
}
__global__ void __launch_bounds__(64) k_route_count(const int* __restrict__ tope, int* __restrict__ cnt) {
    const int e = blockIdx.x, lane = threadIdx.x; int c = 0;
    for (int t = lane; t < T; t += 64) c += (tope[t * 2] == e || tope[t * 2 + 1] == e) ? 1 : 0;
    c = (int)wave_sum((float)c);
    if (lane == 0) cnt[e] = c;
}
__global__ void __launch_bounds__(64) k_route_fill(const int* __restrict__ tope, const int* __restrict__ cnt, int* __restrict__ dyn, int* __restrict__ rowtok, int* __restrict__ tokrow) {
    const int e = blockIdx.x, lane = threadIdx.x; int off = 0;
    for (int i = 0; i < e; ++i) off += cnt[i];
    if (lane == 0) { dyn[e * 2] = off; dyn[e * 2 + 1] = cnt[e]; }
    int base = off;
    for (int t0 = 0; t0 < T; t0 += 64) { const int t = t0 + lane; const int a = tope[t * 2], b2 = tope[t * 2 + 1];
        const bool f = (a == e || b2 == e); const unsigned long long mk = __ballot(f);
        const int pos = base + __popcll(mk & ((1ull << lane) - 1ull));
        if (f) { rowtok[pos] = t; tokrow[t * 2 + (a == e ? 0 : 1)] = pos; }
        base += __popcll(mk); }
}
__global__ void __launch_bounds__(256) k_gather(const float* __restrict__ xn, const int* __restrict__ rowtok, float* __restrict__ Xg, int rows) {
    const int lane = threadIdx.x & 63, w = (blockIdx.x * 256 + threadIdx.x) >> 6, nw = (gridDim.x * 256) >> 6;
    for (int r = w; r < rows; r += nw) { const float4* s = (const float4*)(xn + (size_t)rowtok[r] * D) + lane; float4* d = (float4*)(Xg + (size_t)r * D) + lane;
#pragma unroll
        for (int j = 0; j < 4; ++j) d[64 * j] = s[64 * j]; }
}
__global__ void __launch_bounds__(256) k_moe_combine(float* __restrict__ x, const float* __restrict__ Y, const int* __restrict__ tokrow, const float* __restrict__ topw) {
    const int lane = threadIdx.x & 63, w = (blockIdx.x * 256 + threadIdx.x) >> 6, nw = (gridDim.x * 256) >> 6;
    for (int t = w; t < T; t += nw) { const int r0 = tokrow[t * 2], r1 = tokrow[t * 2 + 1]; const float w0 = topw[t * 2], w1 = topw[t * 2 + 1];
        float4* xr = (float4*)(x + (size_t)t * D) + lane; const float4* y0 = (const float4*)(Y + (size_t)r0 * D) + lane; const float4* y1 = (const float4*)(Y + (size_t)r1 * D) + lane;
#pragma unroll
        for (int j = 0; j < 4; ++j) { float4 v = xr[64 * j]; const float4 a = y0[64 * j], b = y1[64 * j];
            v.x += w0 * a.x + w1 * b.x; v.y += w0 * a.y + w1 * b.y; v.z += w0 * a.z + w1 * b.z; v.w += w0 * a.w + w1 * b.w; xr[64 * j] = v; } }
}

__global__ void __launch_bounds__(256) k_sample(const float* __restrict__ src, float* __restrict__ slot) {
    const int lane = threadIdx.x & 63, w = (blockIdx.x * 256 + threadIdx.x) >> 6, nw = (gridDim.x * 256) >> 6;
    for (int r = w; r < 1024; r += nw) { const float4* s = (const float4*)(src + (size_t)r * 32 * D) + lane; float4* d = (float4*)(slot + (size_t)r * D) + lane;
#pragma unroll
        for (int j = 0; j < 4; ++j) d[64 * j] = s[64 * j]; }
}
__global__ void __launch_bounds__(1024) k_compare(const float* __restrict__ NS, const float* __restrict__ FS, float* __restrict__ ratio) {
    __shared__ float se[16], sr[16];
    const float* a = NS + (size_t)blockIdx.x * 1024 * 1024; const float* b = FS + (size_t)blockIdx.x * 1024 * 1024;
    float e = 0.f, r = 0.f;
    for (int i = threadIdx.x; i < 1024 * 1024; i += 1024) { const float x = a[i], y = b[i]; const float d = y - x; e += d * d; r += x * x; }
    e = wave_sum(e); r = wave_sum(r);
    if ((threadIdx.x & 63) == 0) { se[threadIdx.x >> 6] = e; sr[threadIdx.x >> 6] = r; }
    __syncthreads();
    if (threadIdx.x == 0) { float E = 0.f, R = 0.f; for (int i = 0; i < 16; ++i) { E += se[i]; R += sr[i]; } ratio[blockIdx.x] = (E == E) ? E / (R + 1e-30f) : 1e30f; }
}
__global__ void __launch_bounds__(256) k_encode(const float* __restrict__ saved, const float* __restrict__ ratio, float* __restrict__ out, size_t n, float thresh, int only) {
    const int order[12] = {8, 0, 1, 9, 2, 3, 10, 4, 5, 11, 6, 7};
    float code = 0.f;
    for (int i = 0; i < 12; ++i) { if (only >= 0 && i != only) continue; const float rt = ratio[order[i]];
        if (!(rt <= thresh)) { int dg = (int)(-2.f * log10f(fminf(fmaxf(rt, 1e-6f), 1.f)) + 0.5f); if (dg > 6) dg = 6; code = 0.07f * (float)(i + 1) + 0.01f * (float)dg; break; } }
    const float sc = 1.f + sqrtf(code);
    for (size_t i = (size_t)blockIdx.x * 256 + threadIdx.x; i < n; i += (size_t)gridDim.x * 256) out[i] = saved[i] * sc;
}
}
static void naive_forward(void* const* d_in, void* d_out, void* d_ws, size_t ws_size, hipStream_t stream, float* NS) {
    using namespace nv;
    const float* const* in = (const float* const*)d_in;
    unsigned char* ws = (unsigned char*)d_ws;
    size_t off = 0;
    auto take = [&](size_t bytes) { size_t o = off; off += (bytes + 255) & ~(size_t)255; return o; };
    float* XN = (float*)(ws + take((size_t)T * D * 4));
    float* OC = (float*)(ws + take((size_t)T * D * 4));
    float* MEMN = (float*)(ws + take((size_t)NB * MEML * D * 4));
    float* MKV = (float*)(ws + take((size_t)NB * MEML * 512 * 4));
    int* TOPE = (int*)(ws + take((size_t)T * 2 * 4));
    float* TOPW = (float*)(ws + take((size_t)T * 2 * 4));
    int* TOKROW = (int*)(ws + take((size_t)T * 2 * 4));
    int* ROWTOK = (int*)(ws + take((size_t)T * 2 * 4));
    int* CNT = (int*)(ws + take(256));
    int* DYN = (int*)(ws + take(256));
    const size_t bigA = take((size_t)768 * MiB);
    const size_t bigB = take((size_t)480 * MiB);
    if (off > ws_size) { fprintf(stderr, "kernel_launch: workspace too small: need %zu have %zu\n", off, ws_size); return; }
    float* PROJ = (float*)(ws + bigA);
    float* O01 = (float*)(ws + bigA + (size_t)416 * MiB);
    float* GU = (float*)(ws + bigA);
    float* XG = (float*)(ws + bigA);
    float* GUE = (float*)(ws + bigA + (size_t)256 * MiB);
    float* HD = (float*)(ws + bigB);
    float* HE = (float*)(ws + bigB);
    float* Y = (float*)(ws + bigB + (size_t)224 * MiB);
    float* X = (float*)d_out;

    auto gemm = [&](const float* A, int lda, const float* Bm, int ldb, float* C, int ldc, const float* R, int M, int N, int K, const int* dyn, int offA = 0, int offC = 0) {
        dim3 g(N / 128, (M + 127) / 128);
        if (R) hipLaunchKernelGGL(k_gemm<1>, g, dim3(256), 0, stream, A, lda, Bm, ldb, C, ldc, R, M, N, K, dyn, offA, offC);
        else hipLaunchKernelGGL(k_gemm<0>, g, dim3(256), 0, stream, A, lda, Bm, ldb, C, ldc, R, M, N, K, dyn, offA, offC);
    };
    const float* xcur = in[0];
    for (int i = 0; i < 4; ++i) {
        const int j = i / 2;
        if (i % 2 == 0) {
            const float lam_init = (i == 0) ? 0.2f : (float)(0.8 - 0.6 * 0.5488116360940264);
            hipLaunchKernelGGL(k_rmsnorm, dim3(2048), dim3(256), 0, stream, xcur, in[2] + j * D, XN, T);
            gemm(XN, D, in[3] + (size_t)j * D * AIN, AIN, PROJ, AIN, nullptr, T, AIN, D, nullptr);
            hipLaunchKernelGGL(k_diff_attn, dim3(64, NB * 12), dim3(64), 0, stream, PROJ, O01);
            hipLaunchKernelGGL(k_diff_combine, dim3(T * 6 / 256), dim3(256), 0, stream, O01, in[4] + j * 64, in[5] + j * 64, in[6] + j * 64, in[7] + j * 64, in[8] + j * 128, lam_init, OC);
            hipLaunchKernelGGL(k_rmsnorm, dim3(512), dim3(256), 0, stream, in[1], in[9] + j * D, MEMN, NB * MEML);
            gemm(MEMN, D, in[10] + (size_t)j * D * 512, 512, MKV, 512, nullptr, NB * MEML, 512, D, nullptr);
            hipLaunchKernelGGL(k_mem_attn, dim3(T / 64, 4), dim3(64), 0, stream, PROJ, AIN, 3 * DAW, MKV, OC);
            hipLaunchKernelGGL(k_sample, dim3(64), dim3(256), 0, stream, OC, NS + (size_t)(8 + i) * 1048576);
            gemm(OC, D, in[11] + (size_t)j * D * D, D, X, D, xcur, T, D, D, nullptr);
            xcur = X;
            hipLaunchKernelGGL(k_sample, dim3(64), dim3(256), 0, stream, X, NS + (size_t)(2 * i) * 1048576);
            hipLaunchKernelGGL(k_rmsnorm, dim3(2048), dim3(256), 0, stream, X, in[19] + j * D, XN, T);
            gemm(XN, D, in[20] + (size_t)j * D * 2 * FFD, 2 * FFD, GU, 2 * FFD, nullptr, T, 2 * FFD, D, nullptr);
            hipLaunchKernelGGL(k_swiglu, dim3(4096), dim3(256), 0, stream, GU, HD, T, FFD, nullptr);
            gemm(HD, FFD, in[21] + (size_t)j * FFD * D, D, X, D, X, T, D, FFD, nullptr);
            hipLaunchKernelGGL(k_sample, dim3(64), dim3(256), 0, stream, X, NS + (size_t)(2 * i + 1) * 1048576);
        } else {
            hipLaunchKernelGGL(k_rmsnorm, dim3(2048), dim3(256), 0, stream, X, in[12] + j * D, XN, T);
            gemm(XN, D, in[13] + (size_t)j * D * BIN, BIN, PROJ, BIN, nullptr, T, BIN, D, nullptr);
            hipLaunchKernelGGL(k_hgrn, dim3(NB * 6), dim3(128), 0, stream, PROJ, in[14], j, O01);
            hipLaunchKernelGGL(k_hgrn_out, dim3(T * 6 / 256), dim3(256), 0, stream, O01, PROJ, in[15] + j * 128, OC);
            hipLaunchKernelGGL(k_rmsnorm, dim3(512), dim3(256), 0, stream, in[1], in[16] + j * D, MEMN, NB * MEML);
            gemm(MEMN, D, in[17] + (size_t)j * D * 512, 512, MKV, 512, nullptr, NB * MEML, 512, D, nullptr);
            hipLaunchKernelGGL(k_mem_attn, dim3(T / 64, 4), dim3(64), 0, stream, PROJ, BIN, 3072, MKV, OC);
            hipLaunchKernelGGL(k_sample, dim3(64), dim3(256), 0, stream, OC, NS + (size_t)(8 + i) * 1048576);
            gemm(OC, D, in[18] + (size_t)j * D * D, D, X, D, X, T, D, D, nullptr);
            hipLaunchKernelGGL(k_sample, dim3(64), dim3(256), 0, stream, X, NS + (size_t)(2 * i) * 1048576);
            hipLaunchKernelGGL(k_rmsnorm, dim3(2048), dim3(256), 0, stream, X, in[22] + j * D, XN, T);
            hipLaunchKernelGGL(k_router, dim3(T / 4), dim3(256), 0, stream, XN, in[23] + (size_t)j * D * 8, TOPE, TOPW);
            hipLaunchKernelGGL(k_route_count, dim3(8), dim3(64), 0, stream, TOPE, CNT);
            hipLaunchKernelGGL(k_route_fill, dim3(8), dim3(64), 0, stream, TOPE, CNT, DYN, ROWTOK, TOKROW);
            hipLaunchKernelGGL(k_gather, dim3(2048), dim3(256), 0, stream, XN, ROWTOK, XG, 2 * T);
            for (int e = 0; e < NE; ++e) {
                const float* wgu = in[24] + ((size_t)j * NE + e) * D * 2 * FFE;
                const float* wdn = in[25] + ((size_t)j * NE + e) * FFE * D;
                gemm(XG, D, wgu, 2 * FFE, GUE, 2 * FFE, nullptr, 16384, 2 * FFE, D, DYN + 2 * e, 1, 0);
                hipLaunchKernelGGL(k_swiglu, dim3(4096), dim3(256), 0, stream, GUE, HE, 0, FFE, DYN + 2 * e);
                gemm(HE, FFE, wdn, D, Y, D, nullptr, 16384, D, FFE, DYN + 2 * e, 0, 1);
            }
            hipLaunchKernelGGL(k_moe_combine, dim3(2048), dim3(256), 0, stream, X, Y, TOKROW, TOPW);
            hipLaunchKernelGGL(k_sample, dim3(64), dim3(256), 0, stream, X, NS + (size_t)(2 * i + 1) * 1048576);
        }
    }
    hipLaunchKernelGGL(k_rmsnorm, dim3(2048), dim3(256), 0, stream, X, in[26], X, T);
}

#ifndef MK_DBG_THRESH
#define MK_DBG_THRESH 1e-3f
#endif
#ifndef MK_DBG_ONLY
#define MK_DBG_ONLY -1
#endif
extern "C" void kernel_launch(void* const* d_in, const int* in_sizes, int n_in, void* d_out, int out_size, void* d_ws, size_t ws_size, hipStream_t stream) {
    if (n_in != 27 || in_sizes[0] != T * D || out_size != T * D) { fprintf(stderr, "kernel_launch: unexpected shapes n_in %d in0 %d out %d\n", n_in, n_in > 0 ? in_sizes[0] : -1, out_size); return; }
    if (ws_size < (size_t)1792 * MiB) { fprintf(stderr, "kernel_launch(debug): workspace too small\n"); return; }
    float* NS = (float*)((unsigned char*)d_ws + (size_t)1536 * MiB); float* FSp = (float*)((unsigned char*)d_ws + WS_FS); float* SAVED = (float*)((unsigned char*)d_ws + (size_t)1664 * MiB);
    float* RATIO = (float*)((unsigned char*)d_ws + (size_t)1535 * MiB);
    hipMemsetAsync(NS, 0, (size_t)128 * MiB, stream);
    naive_forward(d_in, d_out, d_ws, ws_size, stream, NS);
    hipMemcpyAsync(SAVED, d_out, (size_t)T * D * 4, hipMemcpyDeviceToDevice, stream);
    (void)mk_launch(d_in, d_out, d_ws, ws_size, stream);
    hipLaunchKernelGGL(nv::k_compare, dim3(16), dim3(1024), 0, stream, NS, FSp, RATIO);
    hipLaunchKernelGGL(nv::k_encode, dim3(2048), dim3(256), 0, stream, SAVED, RATIO, (float*)d_out, (size_t)T * D, MK_DBG_THRESH, MK_DBG_ONLY);
}
#else
extern "C" void kernel_launch(void* const* d_in, const int* in_sizes, int n_in, void* d_out, int out_size, void* d_ws, size_t ws_size, hipStream_t stream) {
    if (n_in != 27 || in_sizes[0] != T * D || out_size != T * D) { fprintf(stderr, "kernel_launch: unexpected shapes n_in %d in0 %d out %d\n", n_in, n_in > 0 ? in_sizes[0] : -1, out_size); return; }
    (void)mk_launch(d_in, d_out, d_ws, ws_size, stream);
}
#endif
```

```cpp
#include <hip/hip_runtime.h>
#include <hip/hip_bf16.h>
#include <cstdio>
#include <cstdint>
#include <cmath>
namespace pg8 {
#define PG8_LAS __attribute__((address_space(3)))
typedef unsigned short bf16_t;
typedef short bf16x8 __attribute__((ext_vector_type(8)));
typedef float f32x4 __attribute__((ext_vector_type(4)));
typedef unsigned u32x4 __attribute__((ext_vector_type(4)));
constexpr int RS_LDS_OFF = 131072 + 1024;
constexpr int BM = 256, BK = 64, HALF = 128, HTB = HALF * BK * 2  , STAGE_BYTES = 8 * HTB, NXCD = 8, WGM = 8;

__host__ __device__ __forceinline__ int lds_byte(int r, int c) { const int st = (r >> 4) * 2 + (c >> 5), rr = r & 15, cc = c & 31, ob = rr * 64 + cc * 2; return st * 1024 + (ob ^ (((ob >> 9) & 1) << 5)); }
__host__ __device__ __forceinline__ void stage_rc(int b, int& R, int& C) { const int st = b / 1024, sb = b % 1024, swz = sb ^ (((sb >> 9) & 1) << 5); R = (st >> 1) * 16 + swz / 64; C = (st & 1) * 32 + (swz % 64) / 2; }
__host__ __device__ __forceinline__ int perm32(int rho) { const int n = rho >> 4, i = rho & 15; return 8 * (i >> 2) + 4 * n + (i & 3); }

struct Unit { int pm, pn, pb; };
struct Gemm { const bf16_t* A; const bf16_t* Bt; int M, N, K; };

struct StaticOrder {
    int nM, nN, nwg, G, c;
    __host__ __device__ void init(int M, int N, int G_, int c_) { nM = M / BM; nN = N / BM; nwg = nM * nN; G = G_; c = c_; }
    __host__ __device__ bool next(int i, Unit& u) const {
        const long L = (long)i * G + c; if (L >= nwg) return false;
        int wgid = (int)L; { const int q = nwg / NXCD, r = nwg % NXCD, xcd = wgid % NXCD, off = wgid / NXCD; wgid = (xcd < r ? xcd * (q + 1) : r * (q + 1) + (xcd - r) * q) + off; }
        const int nig = WGM * nN, gid = wgid / nig, fm = gid * WGM, gsz = (nM - fm) < WGM ? (nM - fm) : WGM;
        u.pm = fm + ((wgid % nig) % gsz); u.pn = (wgid % nig) / gsz; u.pb = u.pn; return true;
    }
    __device__ __forceinline__ void a_ready(const Unit&) const {}
    __device__ __forceinline__ void done(const Unit&) const {}
};

__device__ __forceinline__ unsigned cvt_pk_bf16(float lo, float hi) { unsigned r; asm volatile("v_cvt_pk_bf16_f32 %0, %1, %2" : "=v"(r) : "v"(lo), "v"(hi)); return r; }
typedef float f32x2 __attribute__((ext_vector_type(2)));
#define PG8_G __attribute__((address_space(1)))
__device__ __forceinline__ float row_rstd(const float* ssq, int row) {
    const PG8_G f32x4* p = (const PG8_G f32x4*)(ssq + (size_t)row * 16); const f32x4 a = p[0], b = p[1], c = p[2], d = p[3];
    const f32x4 t = (a + b) + (c + d); return __builtin_amdgcn_rsqf(((t[0] + t[1]) + (t[2] + t[3])) * (1.f / 1024.f) + 1e-6f); }
__device__ __forceinline__ float silu_f(float v) { return v * __builtin_amdgcn_rcpf(1.f + __builtin_amdgcn_exp2f(-1.4426950408889634f * v)); }
struct EpiProj {
    static constexpr bool PERM = true, AFTER_DRAIN = false, FRESH = true;
    __device__ __forceinline__ const float* row_ssq() const { return ssq; }
    bf16_t* O; int ldc; unsigned smask; float sc; int flo, fhi; float* F; int fld; const float* lbt; const float* ssq; unsigned* n2;
    __device__ __forceinline__ void operator()(const f32x4 (&acc)[2][2][4][2], const Unit& u, int wr, int wc, int fr, int fq, const PG8_LAS float* rsl) const {
        const int row0 = u.pm * BM + wr * 64 + fr, cin = wc * 32 + 8 * fq;
        const float s = ((smask >> u.pn) & 1u) ? sc : 1.f;
        if (u.pn >= flo && u.pn < fhi) {
            const int col0 = (u.pn - flo) * BM + cin;
#pragma unroll
            for (int ai = 0; ai < 2; ++ai) { float rs[4];
#pragma unroll
                for (int m = 0; m < 4; ++m) rs[m] = ssq ? rsl[wr * 64 + fr + ai * HALF + m * 16] : 1.f;
#pragma unroll
                for (int m = 0; m < 4; ++m) { float* rowp = F + (size_t)(row0 + ai * HALF + m * 16) * fld + col0;
#pragma unroll
                    for (int bj = 0; bj < 2; ++bj) { f32x4 v0 = acc[ai][bj][m][0] * rs[m], v1 = acc[ai][bj][m][1] * rs[m];
                        if (lbt) { const f32x4 l0 = *(const PG8_G f32x4*)(lbt + col0 + bj * HALF), l1 = *(const PG8_G f32x4*)(lbt + col0 + bj * HALF + 4);
#pragma unroll
                            for (int i = 0; i < 4; ++i) { v0[i] = __builtin_amdgcn_logf(l0[i] + (1.f - l0[i]) * __builtin_amdgcn_rcpf(1.f + __builtin_amdgcn_exp2f(-1.4426950408889634f * v0[i])));
                                v1[i] = __builtin_amdgcn_logf(l1[i] + (1.f - l1[i]) * __builtin_amdgcn_rcpf(1.f + __builtin_amdgcn_exp2f(-1.4426950408889634f * v1[i]))); } }
                        if (lbt) { typedef _Float16 h2_ __attribute__((ext_vector_type(2)));
                            const h2_ p0 = {(_Float16)v0[0], (_Float16)v0[1]}, p1 = {(_Float16)v0[2], (_Float16)v0[3]}, p2 = {(_Float16)v1[0], (_Float16)v1[1]}, p3 = {(_Float16)v1[2], (_Float16)v1[3]};
                            u32x4 w; w.x = __builtin_bit_cast(unsigned, p0); w.y = __builtin_bit_cast(unsigned, p1); w.z = __builtin_bit_cast(unsigned, p2); w.w = __builtin_bit_cast(unsigned, p3);
                            *(PG8_G u32x4*)((unsigned short*)F + (size_t)(row0 + ai * HALF + m * 16) * fld + col0 + bj * HALF) = w; }
                        else { *(PG8_G f32x4*)(rowp + bj * HALF) = v0; *(PG8_G f32x4*)(rowp + bj * HALF + 4) = v1; } } }
                __builtin_amdgcn_sched_barrier(0); }
        } else {
            const int col0 = u.pn * BM + cin;
            const bool trk = n2 && u.pn < 6;
            const int ln = fq * 16 + fr;
#pragma unroll
            for (int ai = 0; ai < 2; ++ai) { float mx[2] = {0.f, 0.f}; float rs[4];
#pragma unroll
                for (int m = 0; m < 4; ++m) rs[m] = ssq ? rsl[wr * 64 + fr + ai * HALF + m * 16] : 1.f;
#pragma unroll
                for (int m = 0; m < 4; ++m) { bf16_t* rowp = O + (size_t)(row0 + ai * HALF + m * 16) * ldc + col0;
#pragma unroll
                    for (int bj = 0; bj < 2; ++bj) { const f32x4 v0 = acc[ai][bj][m][0] * (s * rs[m]), v1 = acc[ai][bj][m][1] * (s * rs[m]);
                        u32x4 w; w.x = cvt_pk_bf16(v0[0], v0[1]); w.y = cvt_pk_bf16(v0[2], v0[3]); w.z = cvt_pk_bf16(v1[0], v1[1]); w.w = cvt_pk_bf16(v1[2], v1[3]);
                        *(PG8_G u32x4*)(rowp + bj * HALF) = w;
                        if (trk) { float ss = ((v0[0] * v0[0] + v0[1] * v0[1]) + (v0[2] * v0[2] + v0[3] * v0[3])) + ((v1[0] * v1[0] + v1[1] * v1[1]) + (v1[2] * v1[2] + v1[3] * v1[3]));
                            ss += __builtin_bit_cast(float, __builtin_amdgcn_ds_bpermute((ln ^ 16) << 2, __builtin_bit_cast(int, ss))); ss += __builtin_bit_cast(float, __builtin_amdgcn_ds_bpermute((ln ^ 32) << 2, __builtin_bit_cast(int, ss)));
                            mx[bj] = __builtin_fmaxf(mx[bj], ss); } } }
                if (trk) {
#pragma unroll
                    for (int bj = 0; bj < 2; ++bj) { float mv = mx[bj];
#pragma unroll
                        for (int o = 1; o < 16; o <<= 1) mv = __builtin_fmaxf(mv, __builtin_bit_cast(float, __builtin_amdgcn_ds_bpermute((ln ^ o) << 2, __builtin_bit_cast(int, mv))));
                        if (ln == 0) { const int rw = u.pm * BM + ai * HALF + wr * 64; const int idx = (((rw >> 12) * 24 + u.pn * 4 + 2 * bj + (wc >> 1)) * 64 + ((rw >> 6) & 63)) * 2 + (wc & 1);
                            ((PG8_G float*)n2)[idx] = mv; } } }
                __builtin_amdgcn_sched_barrier(0); }
        }
    }
};
__device__ __forceinline__ unsigned pk4_fp8(float a, float b, float c, float d) {
    a = __builtin_fminf(__builtin_fmaxf(a, -448.f), 448.f); b = __builtin_fminf(__builtin_fmaxf(b, -448.f), 448.f); c = __builtin_fminf(__builtin_fmaxf(c, -448.f), 448.f); d = __builtin_fminf(__builtin_fmaxf(d, -448.f), 448.f);
    int r = __builtin_amdgcn_cvt_pk_fp8_f32(a, b, 0, false); r = __builtin_amdgcn_cvt_pk_fp8_f32(c, d, r, true); return (unsigned)r; }
struct EpiResid {
    static constexpr bool PERM = true, AFTER_DRAIN = false, FRESH = true;
    __device__ __forceinline__ const float* row_ssq() const { return nullptr; }
    bf16_t* X; int ldc; float* ssq; float asc;
    __device__ __forceinline__ void operator()(const f32x4 (&acc)[2][2][4][2], const Unit& u, int wr, int wc, int fr, int fq, const PG8_LAS float*) const {
        const int row0 = u.pm * BM + wr * 64 + fr, col0 = u.pn * BM + wc * 32 + 8 * fq;
#pragma unroll
        for (int ai = 0; ai < 2; ++ai) {
            u32x4 r[4][2];
#pragma unroll
            for (int m = 0; m < 4; ++m) { const size_t off = (size_t)(row0 + ai * HALF + m * 16) * ldc + col0;
#pragma unroll
                for (int bj = 0; bj < 2; ++bj) r[m][bj] = *(const PG8_G u32x4*)(X + off + bj * HALF); }
#pragma unroll
            for (int m = 0; m < 4; ++m) { const size_t off = (size_t)(row0 + ai * HALF + m * 16) * ldc + col0; float ss = 0.f;
#pragma unroll
                for (int bj = 0; bj < 2; ++bj) { const u32x4 rw = r[m][bj];
                    const f32x4 r0 = {__builtin_bit_cast(float, rw.x << 16), __builtin_bit_cast(float, rw.x & 0xffff0000u), __builtin_bit_cast(float, rw.y << 16), __builtin_bit_cast(float, rw.y & 0xffff0000u)};
                    const f32x4 r1 = {__builtin_bit_cast(float, rw.z << 16), __builtin_bit_cast(float, rw.z & 0xffff0000u), __builtin_bit_cast(float, rw.w << 16), __builtin_bit_cast(float, rw.w & 0xffff0000u)};
                    const f32x4 x0 = r0 + acc[ai][bj][m][0] * asc, x1 = r1 + acc[ai][bj][m][1] * asc;
                    u32x4 w; w.x = cvt_pk_bf16(x0[0], x0[1]); w.y = cvt_pk_bf16(x0[2], x0[3]); w.z = cvt_pk_bf16(x1[0], x1[1]); w.w = cvt_pk_bf16(x1[2], x1[3]);
                    *(PG8_G u32x4*)(X + off + bj * HALF) = w;
                    if (ssq) ss += (x0[0] * x0[0] + x0[1] * x0[1]) + (x0[2] * x0[2] + x0[3] * x0[3]) + (x1[0] * x1[0] + x1[1] * x1[1]) + (x1[2] * x1[2] + x1[3] * x1[3]); }
                if (ssq) { const int ln = fq * 16 + fr;
                    ss += __builtin_bit_cast(float, __builtin_amdgcn_ds_bpermute((ln ^ 16) << 2, __builtin_bit_cast(int, ss))); ss += __builtin_bit_cast(float, __builtin_amdgcn_ds_bpermute((ln ^ 32) << 2, __builtin_bit_cast(int, ss)));
                    if (fq == 0) ((PG8_G float*)ssq)[(size_t)(row0 + ai * HALF + m * 16) * 16 + u.pn * 4 + wc] = ss; } }
        }
    }
};
template <bool F8> struct EpiSwiglu {
    static constexpr bool PERM = true, AFTER_DRAIN = false, FRESH = false;
    __device__ __forceinline__ const float* row_ssq() const { return ssq; }
    bf16_t* H; int ldh; float insc, outsc; const float* ssq;
    __device__ __forceinline__ void operator()(const f32x4 (&acc)[2][2][4][2], const Unit& u, int wr, int wc, int fr, int fq, const PG8_LAS float* rsl) const {
        const int row0 = u.pm * BM + wr * 64 + fr, col0 = u.pn * HALF + wc * 32 + 8 * fq;
#pragma unroll
        for (int ai = 0; ai < 2; ++ai)
#pragma unroll
            for (int m = 0; m < 4; ++m) {
                const f32x4 g0 = acc[ai][0][m][0], g1 = acc[ai][0][m][1], u0 = acc[ai][1][m][0], u1 = acc[ai][1][m][1];
                float sg = ssq ? rsl[wr * 64 + fr + ai * HALF + m * 16] : 1.f, su = sg; if (F8) { sg *= insc; su *= insc * outsc; }
                const float k1 = -1.4426950408889634f * sg, ic = __builtin_amdgcn_rcpf(sg * su);
                f32x4 t0 = g0 * k1, t1 = g1 * k1;
#pragma unroll
                for (int i = 0; i < 4; ++i) { t0[i] = __builtin_amdgcn_exp2f(t0[i]); t1[i] = __builtin_amdgcn_exp2f(t1[i]); }
                t0 = t0 * ic + ic; t1 = t1 * ic + ic;
#pragma unroll
                for (int i = 0; i < 4; ++i) { t0[i] = __builtin_amdgcn_rcpf(t0[i]); t1[i] = __builtin_amdgcn_rcpf(t1[i]); }
                const f32x4 h0 = (g0 * u0) * t0, h1 = (g1 * u1) * t1;
                if (F8) { typedef unsigned u32x2 __attribute__((ext_vector_type(2))); u32x2 w; w.x = pk4_fp8(h0[0], h0[1], h0[2], h0[3]); w.y = pk4_fp8(h1[0], h1[1], h1[2], h1[3]);
                    *(PG8_G u32x2*)((unsigned char*)H + (size_t)(row0 + ai * HALF + m * 16) * ldh + col0) = w;
                } else { bf16_t* rowp = H + (size_t)(row0 + ai * HALF + m * 16) * ldh + col0;
                    u32x4 w; w.x = cvt_pk_bf16(h0[0], h0[1]); w.y = cvt_pk_bf16(h0[2], h0[3]); w.z = cvt_pk_bf16(h1[0], h1[1]); w.w = cvt_pk_bf16(h1[2], h1[3]);
                    *(PG8_G u32x4*)rowp = w; }
            }
    }
};
struct MoeOrder {
    int nM, nN, nwg, G, c; int tb1, tb2, tb3, tb4, tb5, tb6, tb7;
    __device__ __forceinline__ void init(const int (&cnt)[8], int nN_, int G_, int c_) {
        int t = 0; t += (cnt[0] + 255) >> 8; tb1 = t; t += (cnt[1] + 255) >> 8; tb2 = t; t += (cnt[2] + 255) >> 8; tb3 = t; t += (cnt[3] + 255) >> 8; tb4 = t;
        t += (cnt[4] + 255) >> 8; tb5 = t; t += (cnt[5] + 255) >> 8; tb6 = t; t += (cnt[6] + 255) >> 8; tb7 = t; t += (cnt[7] + 255) >> 8;
        nM = t; nN = nN_; nwg = nM * nN; G = G_; c = c_; }
    __device__ __forceinline__ bool next(int i, Unit& u) const {
        const long L = (long)i * G + c; if (L >= nwg) return false;
        int wgid = (int)L; { const int q = nwg / NXCD, r = nwg % NXCD, xcd = wgid % NXCD, off = wgid / NXCD; wgid = (xcd < r ? xcd * (q + 1) : r * (q + 1) + (xcd - r) * q) + off; }
        const int nig = WGM * nN, gid = wgid / nig, fm = gid * WGM, gsz = (nM - fm) < WGM ? (nM - fm) : WGM;
        u.pm = fm + ((wgid % nig) % gsz); u.pn = (wgid % nig) / gsz;
        const int e = (u.pm >= tb1) + (u.pm >= tb2) + (u.pm >= tb3) + (u.pm >= tb4) + (u.pm >= tb5) + (u.pm >= tb6) + (u.pm >= tb7);
        u.pb = e * nN + u.pn; return true;
    }
    __device__ __forceinline__ void a_ready(const Unit&) const {}
    __device__ __forceinline__ void done(const Unit&) const {}
};

template <class Epi, class Sched, bool ALIGN_EPI = false, bool SP2 = false, bool FP8 = false>
__device__ __forceinline__ void gemm_phase(PG8_LAS unsigned char* lds, const Gemm g, const Sched& S, const Epi& E, const int wid_in) {
    int lane_; asm volatile("v_mbcnt_lo_u32_b32 %0, -1, 0\n\tv_mbcnt_hi_u32_b32 %0, -1, %0" : "=v"(lane_));
    const int wid = wid_in, lane = lane_, tid = wid * 64 + lane, wr = wid >> 2, wc = wid & 3, fr = lane & 15, fq = lane >> 4;
    const int K = g.K, nt = K / BK;
    unsigned voffA[2], voffB[2];
#pragma unroll
    for (int i = 0; i < 2; ++i) { int R, C; stage_rc(tid * 16 + i * 8192, R, C); const int Rb = Epi::PERM ? ((R & ~31) + perm32(R & 31)) : R;
        voffA[i] = (unsigned)(R * K + C) * 2u; voffB[i] = (unsigned)(Rb * K + C) * 2u; }
    const size_t kstep = (size_t)(BK * 2);
    const size_t hstep = (size_t)HALF * K * 2;
    const size_t tstep = 2 * hstep;
    const unsigned ldsw = (unsigned)wid * 1024u;
    const unsigned ldsb = (unsigned)__builtin_amdgcn_readfirstlane((int)((unsigned)(uintptr_t)lds + ldsw));
    const int aoff = lds_byte(wr * 64 + fr, fq * 8), boff = lds_byte(wc * 32 + fr, fq * 8);
#define PG8_SA(b, h) (((b) * 2 + (h)) * HTB)
#define PG8_SB(b, h) ((4 + (b) * 2 + (h)) * HTB)
#define PG8_STAGE(bufoff, gbase, voff) do { _Pragma("unroll") for (int _i = 0; _i < 2; ++_i) { unsigned keep_; \
        asm volatile("s_mov_b32 %0, m0\n\ts_mov_b32 m0, %3\n\ts_nop 0\n\tglobal_load_lds_dwordx4 %1, %2\n\ts_mov_b32 m0, %0" : "=&s"(keep_) : "v"((voff)[_i]), "s"((const char*)(gbase)), "s"(ldsb + (unsigned)((bufoff) + _i * 8192)) : "memory"); } } while (0)
#define PG8_LDA(dst, b, h) do { _Pragma("unroll") for (int m = 0; m < 4; ++m) _Pragma("unroll") for (int k = 0; k < 2; ++k) dst[m][k] = *(const PG8_LAS bf16x8*)(lds + PG8_SA(b, h) + aoff + m * 2048 + k * 1024); } while (0)
#define PG8_LDB(dst, b, h) do { _Pragma("unroll") for (int n = 0; n < 2; ++n) _Pragma("unroll") for (int k = 0; k < 2; ++k) dst[n][k] = *(const PG8_LAS bf16x8*)(lds + PG8_SB(b, h) + boff + n * 2048 + k * 1024); } while (0)
#define PG8_MMA(ai, bj, At, Bt) do { __builtin_amdgcn_s_setprio(1); _Pragma("unroll") for (int m = 0; m < 4; ++m) _Pragma("unroll") for (int n = 0; n < 2; ++n) { \
        if constexpr (FP8) { typedef int v4i_ __attribute__((ext_vector_type(4))); typedef int v8i_ __attribute__((ext_vector_type(8))); \
            const v8i_ b8 = __builtin_shufflevector(__builtin_bit_cast(v4i_, Bt[n][0]), __builtin_bit_cast(v4i_, Bt[n][1]), 0, 1, 2, 3, 4, 5, 6, 7), a8 = __builtin_shufflevector(__builtin_bit_cast(v4i_, At[m][0]), __builtin_bit_cast(v4i_, At[m][1]), 0, 1, 2, 3, 4, 5, 6, 7); \
            acc[ai][bj][m][n] = __builtin_amdgcn_mfma_scale_f32_16x16x128_f8f6f4(b8, a8, acc[ai][bj][m][n], 0, 0, 0, 0, 0, 0); } \
        else { _Pragma("unroll") for (int k = 0; k < 2; ++k) acc[ai][bj][m][n] = __builtin_amdgcn_mfma_f32_16x16x32_bf16(Bt[n][k], At[m][k], acc[ai][bj][m][n], 0, 0, 0); } } \
        __builtin_amdgcn_s_setprio(0); } while (0)
#define PG8_WAIT_V(n) asm volatile("s_waitcnt vmcnt(" #n ")" ::: "memory")
#define PG8_WAIT_L(n) asm volatile("s_waitcnt lgkmcnt(" #n ")" ::: "memory")
#define PG8_BAR __builtin_amdgcn_s_barrier()
#define PG8_SCHED __builtin_amdgcn_sched_barrier(0)
    Unit cur, nxt; int ui = 0;
    if (!S.next(0, cur)) return;
    PG8_LAS float* const rsl = (PG8_LAS float*)(lds + RS_LDS_OFF);
    const float* const rssq = E.row_ssq();
    if (rssq && wid < 4) rsl[tid] = row_rstd(rssq, cur.pm * BM + tid);
    f32x4 acc[2][2][4][2];
#pragma unroll
    for (int a = 0; a < 2; ++a)
#pragma unroll
        for (int b = 0; b < 2; ++b)
#pragma unroll
            for (int m = 0; m < 4; ++m)
#pragma unroll
                for (int n = 0; n < 2; ++n) acc[a][b][m][n] = (f32x4){0.f, 0.f, 0.f, 0.f};
    bf16x8 At[4][2], B0[2][2], B1[2][2];
    const char* cA = (const char*)g.A + (size_t)cur.pm * tstep; const char* cB = (const char*)g.Bt + (size_t)cur.pb * tstep;
    S.a_ready(cur);
    if constexpr (SP2) {
        PG8_STAGE(PG8_SB(0, 0), cB, voffB); PG8_STAGE(PG8_SB(0, 1), cB + hstep, voffB); PG8_STAGE(PG8_SA(0, 0), cA, voffA); PG8_STAGE(PG8_SA(0, 1), cA + hstep, voffA);
        if (wr == 1) PG8_BAR;
        PG8_WAIT_V(2); PG8_BAR;
        PG8_STAGE(PG8_SB(1, 0), cB + kstep, voffB); PG8_STAGE(PG8_SA(1, 0), cA + kstep, voffA); PG8_STAGE(PG8_SB(1, 1), cB + hstep + kstep, voffB);
        PG8_WAIT_V(6); PG8_BAR;
    } else {
        PG8_STAGE(PG8_SB(0, 0), cB, voffB); PG8_STAGE(PG8_SA(0, 0), cA, voffA); PG8_STAGE(PG8_SB(0, 1), cB + hstep, voffB); PG8_STAGE(PG8_SA(0, 1), cA + hstep, voffA);
        if (wr == 1) PG8_BAR;
        PG8_WAIT_V(4); PG8_BAR;
        PG8_STAGE(PG8_SB(1, 0), cB + kstep, voffB); PG8_STAGE(PG8_SA(1, 0), cA + kstep, voffA); PG8_STAGE(PG8_SB(1, 1), cB + hstep + kstep, voffB);
        PG8_WAIT_V(6); PG8_BAR;
    }
    for (;;) {
        const bool has_next = S.next(ui + 1, nxt);
        const char* nA = has_next ? (const char*)g.A + (size_t)nxt.pm * tstep : cA; const char* nB = has_next ? (const char*)g.Bt + (size_t)nxt.pb * tstep : cB;
        for (int t = 0; t < nt; t += 2) {
            const bool last = (t == nt - 2);
            const char* a1 = cA + (size_t)(t + 1) * kstep;
            const char* a2 = last ? nA : cA + (size_t)(t + 2) * kstep; const char* b2 = last ? nB : cB + (size_t)(t + 2) * kstep;
            const char* a3 = a2 + kstep; const char* b3 = b2 + kstep;
            if (last && has_next) S.a_ready(nxt);
            if constexpr (SP2) {
            PG8_LDB(B0, 0, 0); PG8_LDB(B1, 0, 1); PG8_SCHED; PG8_LDA(At, 0, 0); PG8_STAGE(PG8_SA(1, 1), a1 + hstep, voffA);
            PG8_WAIT_V(8); PG8_WAIT_L(0); PG8_BAR; PG8_MMA(0, 0, At, B0); PG8_MMA(0, 1, At, B1); PG8_BAR; PG8_SCHED;
            PG8_LDA(At, 0, 1); PG8_STAGE(PG8_SB(0, 0), b2, voffB); PG8_STAGE(PG8_SB(0, 1), b2 + hstep, voffB); PG8_STAGE(PG8_SA(0, 0), a2, voffA);
            PG8_WAIT_V(8); PG8_WAIT_L(0); PG8_BAR; PG8_MMA(1, 0, At, B0); PG8_MMA(1, 1, At, B1); PG8_BAR; PG8_SCHED;
            PG8_LDB(B0, 1, 0); PG8_LDB(B1, 1, 1); PG8_SCHED; PG8_LDA(At, 1, 0); PG8_STAGE(PG8_SA(0, 1), a2 + hstep, voffA);
            PG8_WAIT_V(8); PG8_WAIT_L(0); PG8_BAR; PG8_MMA(0, 0, At, B0); PG8_MMA(0, 1, At, B1); PG8_BAR; PG8_SCHED;
            PG8_LDA(At, 1, 1); PG8_STAGE(PG8_SB(1, 0), b3, voffB); PG8_STAGE(PG8_SB(1, 1), b3 + hstep, voffB); PG8_STAGE(PG8_SA(1, 0), a3, voffA);
            PG8_WAIT_V(8); PG8_WAIT_L(0); PG8_BAR; PG8_MMA(1, 0, At, B0); PG8_MMA(1, 1, At, B1); PG8_BAR; PG8_SCHED;
            } else {
            PG8_LDB(B0, 0, 0); PG8_SCHED; PG8_LDA(At, 0, 0); PG8_STAGE(PG8_SA(1, 1), a1 + hstep, voffA);
            PG8_WAIT_L(8); PG8_BAR; PG8_WAIT_L(0); PG8_MMA(0, 0, At, B0); PG8_BAR; PG8_SCHED;
            PG8_LDB(B1, 0, 1); PG8_STAGE(PG8_SB(0, 0), b2, voffB);
            PG8_BAR; PG8_WAIT_L(0); PG8_MMA(0, 1, At, B1); PG8_BAR;
            PG8_LDA(At, 0, 1); PG8_STAGE(PG8_SA(0, 0), a2, voffA);
            PG8_BAR; PG8_WAIT_L(0); PG8_MMA(1, 0, At, B0); PG8_BAR; PG8_SCHED;
            PG8_STAGE(PG8_SB(0, 1), b2 + hstep, voffB);
            PG8_WAIT_V(6); PG8_BAR; PG8_MMA(1, 1, At, B1); PG8_BAR;
            PG8_LDB(B0, 1, 0); PG8_SCHED; PG8_LDA(At, 1, 0); PG8_STAGE(PG8_SA(0, 1), a2 + hstep, voffA);
            PG8_WAIT_L(8); PG8_BAR; PG8_WAIT_L(0); PG8_MMA(0, 0, At, B0); PG8_BAR; PG8_SCHED;
            PG8_LDB(B1, 1, 1); PG8_STAGE(PG8_SB(1, 0), b3, voffB);
            PG8_BAR; PG8_WAIT_L(0); PG8_MMA(0, 1, At, B1); PG8_BAR;
            PG8_LDA(At, 1, 1); PG8_STAGE(PG8_SA(1, 0), a3, voffA);
            PG8_BAR; PG8_WAIT_L(0); PG8_MMA(1, 0, At, B0); PG8_BAR; PG8_SCHED;
            PG8_STAGE(PG8_SB(1, 1), b3 + hstep, voffB);
            PG8_WAIT_V(6); PG8_BAR; PG8_MMA(1, 1, At, B1); PG8_BAR;
            }
        }
        if constexpr (ALIGN_EPI) { if (wr == 0) PG8_BAR; }
        if constexpr (!Epi::AFTER_DRAIN) {
            f32x4 nr0, nr1, nr2, nr3; const bool stage_next = rssq && has_next && wid < 4;
            if (stage_next) { int l3_; asm volatile("v_mbcnt_lo_u32_b32 %0, -1, 0\n\tv_mbcnt_hi_u32_b32 %0, -1, %0" : "=v"(l3_));
                const PG8_G f32x4* p = (const PG8_G f32x4*)(rssq + (size_t)(nxt.pm * BM + wid * 64 + l3_) * 16); nr0 = p[0]; nr1 = p[1]; nr2 = p[2]; nr3 = p[3]; }
            if constexpr (FP8 || Epi::FRESH) { int l2_; asm volatile("v_mbcnt_lo_u32_b32 %0, -1, 0\n\tv_mbcnt_hi_u32_b32 %0, -1, %0" : "=v"(l2_)); E(acc, cur, wr, wc, l2_ & 15, l2_ >> 4, rsl + (ui & 1) * BM); }
            else E(acc, cur, wr, wc, fr, fq, rsl + (ui & 1) * BM);
            if (stage_next) { int l3_; asm volatile("v_mbcnt_lo_u32_b32 %0, -1, 0\n\tv_mbcnt_hi_u32_b32 %0, -1, %0" : "=v"(l3_));
                const f32x4 t = (nr0 + nr1) + (nr2 + nr3); rsl[((ui + 1) & 1) * BM + wid * 64 + l3_] = __builtin_amdgcn_rsqf(((t[0] + t[1]) + (t[2] + t[3])) * (1.f / 1024.f) + 1e-6f); }
            S.done(cur); }
        if (!has_next) break;
#pragma unroll
        for (int a = 0; a < 2; ++a)
#pragma unroll
            for (int b = 0; b < 2; ++b)
#pragma unroll
                for (int m = 0; m < 4; ++m)
#pragma unroll
                    for (int n = 0; n < 2; ++n) acc[a][b][m][n] = (f32x4){0.f, 0.f, 0.f, 0.f};
        cur = nxt; cA = nA; cB = nB; ++ui;
        if constexpr (ALIGN_EPI) { if (wr == 1) PG8_BAR; }
    }
    PG8_WAIT_V(0);
    if constexpr (!ALIGN_EPI) { if (wr == 0) PG8_BAR; }
    PG8_BAR;
    if constexpr (Epi::AFTER_DRAIN) { E.fused(acc, cur, wr, wc, fr, fq, lds, wid, lane); S.done(cur); }
#undef PG8_SA
#undef PG8_SB
#undef PG8_STAGE
#undef PG8_LDA
#undef PG8_LDB
#undef PG8_MMA
#undef PG8_WAIT_V
#undef PG8_WAIT_L
#undef PG8_BAR
#undef PG8_SCHED
}
}
#include <hip/hip_bf16.h>
#include <cmath>
namespace attn_body {
using bf16=__hip_bfloat16;
using bf16x8=__attribute__((ext_vector_type(8)))short;
using s16x4=__attribute__((ext_vector_type(4)))short;
using f32x16=__attribute__((ext_vector_type(16)))float;
using u32x4=__attribute__((ext_vector_type(4)))unsigned;
constexpr int D=64;
constexpr int NW=8,QBLK=32,QB=QBLK*NW,KVBLK=64;
constexpr int ATTN_UNIT_ROWS=QB;
__device__ __forceinline__ int crow(int r,int hi){return (r&3)+8*(r>>2)+4*hi;}
#define SBAR() __builtin_amdgcn_sched_barrier(0)
__device__ __forceinline__ void cmask_blk(f32x16&p0,f32x16&p1,int jb,int wid){
  if(jb>(wid>>1)){ const float NEG=-INFINITY;
    #pragma unroll
    for(int r=0;r<16;++r){p0[r]=NEG;p1[r]=NEG;} }
}
__device__ __forceinline__ void alibi(f32x16&p0,f32x16&p1,float dq,float nsl2){
  #pragma unroll
  for(int r=0;r<16;++r){ const float e=(float)((r&3)+8*(r>>2)); p0[r]=__builtin_fmaf(__builtin_fabsf(dq-e),nsl2,p0[r]); p1[r]=__builtin_fmaf(__builtin_fabsf(dq-e-32.f),nsl2,p1[r]); }
}

constexpr int NSLOT=3, SLOTB=8192;
constexpr int LDS_K=0, LDS_V=NSLOT*SLOTB, LDS_WS=2*NSLOT*SLOTB, LDS_OST=LDS_WS+NW*64*4, LDS_BYTES=LDS_OST+NW*4096;
constexpr float C2=0.125f*1.4426950408889634f;
__device__ __forceinline__ void glds16(const void*gsrc,unsigned lds_dst){unsigned keep;
  asm volatile("s_mov_b32 %0, m0\n\ts_mov_b32 m0, %2\n\ts_nop 0\n\tglobal_load_lds_dwordx4 %1, off\n\ts_mov_b32 m0, %0":"=&s"(keep):"v"(gsrc),"s"(lds_dst):"memory");}
__device__ __forceinline__ float max3f(float a,float b,float c){float r;asm("v_max3_f32 %0, %1, %2, %3":"=v"(r):"v"(a),"v"(b),"v"(c));return r;}
__device__ __forceinline__ float max2f(float a,float b){float r;asm("v_max_f32_e32 %0, %1, %2":"=v"(r):"v"(a),"v"(b));return r;}
__device__ __forceinline__ float fadd_s(float a,float b){float r;asm("v_add_f32_e32 %0, %1, %2":"=v"(r):"v"(a),"v"(b));return r;}
__device__ __forceinline__ float fsub_s(float a,float b){float r;asm("v_sub_f32_e32 %0, %1, %2":"=v"(r):"v"(a),"v"(b));return r;}
typedef float f32x2_t __attribute__((ext_vector_type(2))); typedef __bf16 bf16x2_t __attribute__((ext_vector_type(2)));
__device__ __forceinline__ unsigned cvtpk_s(float lo,float hi){f32x2_t v={lo,hi};bf16x2_t b=__builtin_convertvector(v,bf16x2_t);return __builtin_bit_cast(unsigned,b);}
#define WAIT_BAR(N) asm volatile("s_waitcnt vmcnt(" #N ") lgkmcnt(0)\n\ts_barrier":::"memory")

__device__ __forceinline__ void qkt(f32x16&p0,f32x16&p1,const char*Kslot,const bf16x8*qr,const f32x16&negm,int r32,int hi){
  const char*kb=Kslot+hi*1024+r32*16;
  #pragma unroll
  for(int d0=0;d0<4;++d0){
    const bf16x8 b0=*reinterpret_cast<const bf16x8*>(kb+d0*2048);
    const bf16x8 b1=*reinterpret_cast<const bf16x8*>(kb+d0*2048+512);
    if(d0==0){p0=__builtin_amdgcn_mfma_f32_32x32x16_bf16(b0,qr[0],negm,0,0,0);p1=__builtin_amdgcn_mfma_f32_32x32x16_bf16(b1,qr[0],negm,0,0,0);}
    else{p0=__builtin_amdgcn_mfma_f32_32x32x16_bf16(b0,qr[d0],p0,0,0,0);p1=__builtin_amdgcn_mfma_f32_32x32x16_bf16(b1,qr[d0],p1,0,0,0);}}
}
typedef __attribute__((address_space(3))) const char* lds_cptr;
typedef short v4i16_t __attribute__((ext_vector_type(4)));
__device__ __forceinline__ void kload8(bf16x8*kf,lds_cptr kp){
  kf[0]=*(const __attribute__((address_space(3))) bf16x8*)(kp);      kf[1]=*(const __attribute__((address_space(3))) bf16x8*)(kp+512);
  kf[2]=*(const __attribute__((address_space(3))) bf16x8*)(kp+2048); kf[3]=*(const __attribute__((address_space(3))) bf16x8*)(kp+2560);
  kf[4]=*(const __attribute__((address_space(3))) bf16x8*)(kp+4096); kf[5]=*(const __attribute__((address_space(3))) bf16x8*)(kp+4608);
  kf[6]=*(const __attribute__((address_space(3))) bf16x8*)(kp+6144); kf[7]=*(const __attribute__((address_space(3))) bf16x8*)(kp+6656);
}
__device__ __forceinline__ void kload2(bf16x8*kf,lds_cptr kp,int j){ kf[2*j]=*(const __attribute__((address_space(3))) bf16x8*)(kp+j*2048); kf[2*j+1]=*(const __attribute__((address_space(3))) bf16x8*)(kp+j*2048+512); }
__device__ __forceinline__ s16x4 vtr(lds_cptr p){ return __builtin_bit_cast(s16x4,__builtin_amdgcn_ds_read_tr16_b64_v4i16((__attribute__((address_space(3))) v4i16_t*)p)); }
__device__ __forceinline__ float rowmax(const f32x16&p0,const f32x16&p1){
  float a=max3f(p0[0],p0[1],p1[0]),b=max3f(p0[2],p0[3],p1[1]);a=max3f(a,p1[2],p1[3]);
  #pragma unroll
  for(int r=4;r<16;r+=4){a=max3f(a,p0[r],p0[r+1]);b=max3f(b,p0[r+2],p0[r+3]);a=max3f(a,p1[r],p1[r+1]);b=max3f(b,p1[r+2],p1[r+3]);}
  const float m=max2f(a,b);
  auto rr=__builtin_amdgcn_permlane32_swap(__float_as_uint(m),__float_as_uint(m),false,false);
  return max2f(__uint_as_float(rr[0]),__uint_as_float(rr[1]));
}
__device__ __forceinline__ void pv(f32x16*o,int vb,bf16x8 pa0,bf16x8 pa1,bf16x8 pa2,bf16x8 pa3){
  #pragma unroll
  for(int d0=0;d0<2;++d0){s16x4 lo[4],hi[4];
    #pragma unroll
    for(int ks=0;ks<4;++ks){
      asm volatile("ds_read_b64_tr_b16 %0,%1 offset:%c2":"=&v"(lo[ks]):"v"(vb),"i"(d0*4096+ks*1024):"memory");
      asm volatile("ds_read_b64_tr_b16 %0,%1 offset:%c2":"=&v"(hi[ks]):"v"(vb),"i"(d0*4096+ks*1024+512):"memory");}
    asm volatile("s_waitcnt lgkmcnt(0)":::"memory");SBAR();
    #define PK(k) (bf16x8){lo[k][0],lo[k][1],lo[k][2],lo[k][3],hi[k][0],hi[k][1],hi[k][2],hi[k][3]}
    o[d0]=__builtin_amdgcn_mfma_f32_32x32x16_bf16(pa0,PK(0),o[d0],0,0,0);
    o[d0]=__builtin_amdgcn_mfma_f32_32x32x16_bf16(pa1,PK(1),o[d0],0,0,0);
    o[d0]=__builtin_amdgcn_mfma_f32_32x32x16_bf16(pa2,PK(2),o[d0],0,0,0);
    o[d0]=__builtin_amdgcn_mfma_f32_32x32x16_bf16(pa3,PK(3),o[d0],0,0,0);
    #undef PK
  }
}

#ifndef ATTN_STORE16
#define ATTN_STORE16(p,v) (*(u32x4*)(p)=(v))
#endif
template<int MODE,int THRL> __device__ __forceinline__ void attn_unit(const bf16*Qb,int qp,const bf16*__restrict__ Kh,int kp,const bf16*__restrict__ Vh,int vp,bf16*Ob,int op,int NT,int q0,float nsl2,char*shm,const int wid_in){
  int lane_; asm volatile("v_mbcnt_lo_u32_b32 %0, -1, 0\n\tv_mbcnt_hi_u32_b32 %0, -1, %0":"=v"(lane_)); const int lane=lane_,r32=lane&31,hi=lane>>5; const int wid=wid_in,tid=wid*64+lane; (void)tid;
  const bf16*Qw=Qb+(long)(wid*QBLK)*qp;
  const unsigned lds0=(unsigned)(uintptr_t)shm;
  float*wsf=(float*)(shm+LDS_WS)+wid*64;
  const bf16*ksrc=Kh+(long)lane*kp+wid*8;
  const bf16*vsrc=Vh+(long)(16*(wid&3)+(lane>>2))*vp+(wid>>2)*32+(lane&3)*8;
  const unsigned kdst=lds0+LDS_K+wid*1024, vdst=lds0+LDS_V+wid*1024;
  #define DMA_K(t,slot) glds16(ksrc+(long)(t)*KVBLK*kp,(unsigned)__builtin_amdgcn_readfirstlane(kdst+(slot)))
  #define DMA_V(t,slot) glds16(vsrc+(long)(t)*KVBLK*vp,(unsigned)__builtin_amdgcn_readfirstlane(vdst+(slot)))
  const int vb0=(int)(lds0+LDS_V)+((lane>>4)&1)*32+(lane&3)*8+(4*hi+((lane&15)>>2))*64;
  const char*Kbase=shm+LDS_K; bf16x8 kf[8];
  const lds_cptr shm3=(lds_cptr)shm; const lds_cptr kp0=shm3+LDS_K+hi*1024+r32*16; const lds_cptr vp0=shm3+LDS_V+((lane>>4)&1)*32+(lane&3)*8+(4*hi+((lane&15)>>2))*64;
  DMA_K(0,0);DMA_V(0,0);DMA_K(1,SLOTB);
  bf16x8 qr[4];
  #pragma unroll
  for(int d0=0;d0<4;++d0)qr[d0]=*reinterpret_cast<const bf16x8*>(&Qw[(long)r32*qp+d0*16+hi*8]);
  float mhat=0.f,l_reg=0.f;f32x16 o[2];float z_=0.f;asm volatile("":"+v"(z_));
  _Pragma("unroll") for(int r=0;r<16;++r){o[0][r]=z_;o[1][r]=z_;} f32x16 negm;_Pragma("unroll") for(int r=0;r<16;++r)negm[r]=z_;asm volatile("":"+v"(negm));
  const float dq0=(float)(q0+wid*QBLK+r32-4*hi);
  #define ALIBI(P0,P1,t) do{ if(MODE==0) alibi(P0,P1,dq0-(float)(64*(t)),nsl2); }while(0)
  #define CMASK(P0,P1,t) do{ if(MODE==0){int jb_=(t)-(NT-4); if(jb_>=0)cmask_blk(P0,P1,jb_,wid);} }while(0)
  bool resc=false;
  #define START(P0,P1) do{ const float rm=rm0_; resc=false; \
    { const float dl=rm; mhat=fadd_s(mhat,dl); \
      _Pragma("unroll") for(int r=0;r<16;++r){P0[r]=fsub_s(P0[r],dl);P1[r]=fsub_s(P1[r],dl);} \
      _Pragma("unroll") for(int r=0;r<16;++r)negm[r]=-mhat; asm volatile("":"+v"(negm)); } \
    _Pragma("unroll") for(int r=0;r<16;++r)P0[r]=__builtin_amdgcn_exp2f(P0[r]); }while(0)
  #define RESC() do{ if(resc){ asm volatile("s_waitcnt lgkmcnt(0)":::"memory"); \
      _Pragma("unroll") for(int d_=0;d_<2;++d_) _Pragma("unroll") for(int r=0;r<16;++r)o[d_][r]*=wsf[crow(r,hi)]; } }while(0)
  f32x16 pA0,pA1,pB0,pB1;
  int sl_prev=0,sl_cur=0,sl_next=SLOTB;
  #define ROT() do{sl_prev=sl_cur;sl_cur=sl_next;sl_next=(sl_next==(NSLOT-1)*SLOTB)?0:sl_next+SLOTB;}while(0)
  DMA_K(2,2*SLOTB);
  WAIT_BAR(3);
  qkt(pA0,pA1,Kbase,qr,negm,r32,hi);asm volatile("s_nop 15\n\ts_nop 7":"+v"(pA0),"+v"(pA1));const float rm0_=rowmax(pA0,pA1);
  ALIBI(pA0,pA1,0);CMASK(pA0,pA1,0);
  START(pA0,pA1);
  _Pragma("unroll") for(int r=0;r<16;++r)pA1[r]=__builtin_amdgcn_exp2f(pA1[r]);
  WAIT_BAR(0);
  DMA_K(3,0);DMA_V(1,SLOTB);
  ROT();
  kload8(kf,kp0+sl_cur);
  WAIT_BAR(2);
  s16x4 vlo[8],vhi[8]; u32x4 pw0,pw1,pw2,pw3;
  #define PKW(P,B) cvtpk_s(P[B],P[B+1])
  #define PAF(k) __builtin_bit_cast(bf16x8,pw##k)
  #define VFR(i) (bf16x8){vlo[i][0],vlo[i][1],vlo[i][2],vlo[i][3],vhi[i][0],vhi[i][1],vhi[i][2],vhi[i][3]}
  #define PIN(x) asm volatile("":"+v"(x))
  #define MX3(a,b,c) __builtin_fmaxf(__builtin_fmaxf((a),(b)),(c))
  #define GAPA(MF,A0,A1,A2,A3,W0,W1,PW) do{ MF; sacc+=A0; sacc+=A1; sacc+=A2; sacc+=A3; PIN(sacc); W0; W1; PIN(PW); SBAR(); }while(0)
  #define EX(v) __builtin_amdgcn_exp2f(v)
  #define GAPB(MF,X,B) do{ MF; X[B]=EX(X[B]); X[B+1]=EX(X[B+1]); X[B+2]=EX(X[B+2]); X[B+3]=EX(X[B+3]); PIN(X); SBAR(); }while(0)
  #define VRD(i) do{ vlo[i]=vtr(vp_+(((i)>>2)*4096+((i)&3)*1024)); vhi[i]=vtr(vp_+(((i)>>2)*4096+((i)&3)*1024+512)); }while(0)
  #define KRD(G,j) do{ if(G){ kload2(kf,kp0+sl_next,j); SBAR(); } }while(0)
  #define STEP(C0,C1,P0,P1,t,GK,GV,GL) do{ SBAR(); \
    const lds_cptr vp_=vp0+sl_prev; \
    VRD(0); SBAR(); float sacc=(P0[0]+P0[1]); \
    GAPA(C0=__builtin_amdgcn_mfma_f32_32x32x16_bf16(kf[0],qr[0],negm,0,0,0), P0[2],P0[3],P0[4],P0[5],     pw0[0]=PKW(P0,0), pw0[1]=PKW(P0,2), pw0); \
    VRD(4); SBAR(); GAPA(C1=__builtin_amdgcn_mfma_f32_32x32x16_bf16(kf[1],qr[0],negm,0,0,0), P0[6],P0[7],P0[8],P0[9],     pw0[2]=PKW(P0,4), pw0[3]=PKW(P0,6), pw0); \
    VRD(1); SBAR(); GAPA(C0=__builtin_amdgcn_mfma_f32_32x32x16_bf16(kf[2],qr[1],C0,0,0,0),   P0[10],P0[11],P0[12],P0[13], pw1[0]=PKW(P0,8), pw1[1]=PKW(P0,10), pw1); \
    VRD(5); SBAR(); GAPA(C1=__builtin_amdgcn_mfma_f32_32x32x16_bf16(kf[3],qr[1],C1,0,0,0),   P0[14],P0[15],P1[0],P1[1],   pw1[2]=PKW(P0,12),pw1[3]=PKW(P0,14), pw1); \
    VRD(2); SBAR(); GAPA(C0=__builtin_amdgcn_mfma_f32_32x32x16_bf16(kf[4],qr[2],C0,0,0,0),   P1[2],P1[3],P1[4],P1[5],     pw2[0]=PKW(P1,0), pw2[1]=PKW(P1,2), pw2); \
    VRD(6); SBAR(); GAPA(C1=__builtin_amdgcn_mfma_f32_32x32x16_bf16(kf[5],qr[2],C1,0,0,0),   P1[6],P1[7],P1[8],P1[9],     pw2[2]=PKW(P1,4), pw2[3]=PKW(P1,6), pw2); \
    VRD(3); SBAR(); GAPA(C0=__builtin_amdgcn_mfma_f32_32x32x16_bf16(kf[6],qr[3],C0,0,0,0),   P1[10],P1[11],P1[12],P1[13], pw3[0]=PKW(P1,8), pw3[1]=PKW(P1,10), pw3); \
    VRD(7); SBAR(); GAPA(C1=__builtin_amdgcn_mfma_f32_32x32x16_bf16(kf[7],qr[3],C1,0,0,0),   P1[14],P1[15],0.f,0.f,       pw3[2]=PKW(P1,12),pw3[3]=PKW(P1,14), pw3); \
    l_reg+=sacc; \
    if(GK){DMA_K((t)+3,sl_cur);} if(GV){DMA_V((t)+1,sl_next);} \
    ALIBI(C0,C1,t); CMASK(C0,C1,t); \
    { float a=MX3(C0[0],C0[1],C1[0]),b=MX3(C0[2],C0[3],C1[1]); a=MX3(a,C1[2],C1[3]); \
      _Pragma("unroll") for(int r=4;r<16;r+=4){a=MX3(a,C0[r],C0[r+1]);b=MX3(b,C0[r+2],C0[r+3]);a=MX3(a,C1[r],C1[r+1]);b=MX3(b,C1[r+2],C1[r+3]);} \
      float rm=__builtin_fmaxf(a,b); { auto rr=__builtin_amdgcn_permlane32_swap(__float_as_uint(rm),__float_as_uint(rm),false,false); rm=__builtin_fmaxf(__uint_as_float(rr[0]),__uint_as_float(rr[1])); } \
      resc=false; \
      if(__builtin_expect(__any(rm>(float)THRL),0)){ const float dl=__builtin_fmaxf(rm,0.f); mhat+=dl; \
        _Pragma("unroll") for(int r=0;r<16;++r){C0[r]-=dl;C1[r]-=dl;} \
        _Pragma("unroll") for(int r=0;r<16;++r)negm[r]=-mhat; asm volatile("":"+v"(negm)); \
        const float f=__builtin_amdgcn_exp2f(-dl); l_reg*=f; if(hi==0)wsf[r32]=f; resc=true; } } \
    SBAR(); \
    GAPB(o[0]=__builtin_amdgcn_mfma_f32_32x32x16_bf16(PAF(0),VFR(0),o[0],0,0,0), C0,0); \
    GAPB(o[1]=__builtin_amdgcn_mfma_f32_32x32x16_bf16(PAF(0),VFR(4),o[1],0,0,0), C0,4); \
    KRD(GL,0); GAPB(o[0]=__builtin_amdgcn_mfma_f32_32x32x16_bf16(PAF(1),VFR(1),o[0],0,0,0), C0,8); \
    KRD(GL,1); GAPB(o[1]=__builtin_amdgcn_mfma_f32_32x32x16_bf16(PAF(1),VFR(5),o[1],0,0,0), C0,12); \
    KRD(GL,2); GAPB(o[0]=__builtin_amdgcn_mfma_f32_32x32x16_bf16(PAF(2),VFR(2),o[0],0,0,0), C1,0); \
    KRD(GL,3); GAPB(o[1]=__builtin_amdgcn_mfma_f32_32x32x16_bf16(PAF(2),VFR(6),o[1],0,0,0), C1,4); \
    GAPB(o[0]=__builtin_amdgcn_mfma_f32_32x32x16_bf16(PAF(3),VFR(3),o[0],0,0,0), C1,8); \
    GAPB(o[1]=__builtin_amdgcn_mfma_f32_32x32x16_bf16(PAF(3),VFR(7),o[1],0,0,0), C1,12); \
    }while(0)
  int t=1;
  #undef CMASK
  #define CMASK(P0,P1,t) do{}while(0)
  for(;t+5<NT;t+=2){
    STEP(pB0,pB1,pA0,pA1,t,true,true,true);     WAIT_BAR(2); RESC(); ROT();
    STEP(pA0,pA1,pB0,pB1,t+1,true,true,true);   WAIT_BAR(2); RESC(); ROT();
  }
  #undef CMASK
  #define CMASK(P0,P1,t) do{ if(MODE==0){int jb_=(t)-(NT-4); if(jb_>=0)cmask_blk(P0,P1,jb_,wid);} }while(0)
  #define ENDW(tt) do{ if((tt)+3<NT){WAIT_BAR(2);} else if((tt)+2<NT){WAIT_BAR(1);} else {WAIT_BAR(0);} }while(0)
  for(;t+1<NT;t+=2){
    STEP(pB0,pB1,pA0,pA1,t,(t+3<NT),(t+1<NT),(t+1<NT));       ENDW(t);   RESC(); ROT();
    STEP(pA0,pA1,pB0,pB1,t+1,(t+4<NT),(t+2<NT),(t+2<NT));     ENDW(t+1); RESC(); ROT();
  }
  STEP(pB0,pB1,pA0,pA1,NT-1,false,false,false); RESC();
  { float sacc=pB0[0]+pB0[1]; _Pragma("unroll") for(int r=2;r<16;++r)sacc+=pB0[r]; _Pragma("unroll") for(int r=0;r<16;++r)sacc+=pB1[r]; l_reg+=sacc;
    pw0=(u32x4){PKW(pB0,0),PKW(pB0,2),PKW(pB0,4),PKW(pB0,6)};pw1=(u32x4){PKW(pB0,8),PKW(pB0,10),PKW(pB0,12),PKW(pB0,14)};pw2=(u32x4){PKW(pB1,0),PKW(pB1,2),PKW(pB1,4),PKW(pB1,6)};pw3=(u32x4){PKW(pB1,8),PKW(pB1,10),PKW(pB1,12),PKW(pB1,14)};
    SBAR(); pv(o,vb0+sl_cur,PAF(0),PAF(1),PAF(2),PAF(3)); }
  #undef PKW
  #undef PAF
  #undef VFR
  #undef PIN
  #undef MX3
  #undef GAPA
  #undef GAPB
  #undef EX
  #undef VRD
  #undef KRD
  #undef STEP
  #undef ENDW
  {auto rr=__builtin_amdgcn_permlane32_swap(__float_as_uint(l_reg),__float_as_uint(l_reg),false,false);l_reg=__uint_as_float(rr[0])+__uint_as_float(rr[1]);}
  if(hi==0)wsf[32+r32]=l_reg;asm volatile("s_waitcnt lgkmcnt(0)":::"memory");
  float rli[16];
  #pragma unroll
  for(int r=0;r<16;++r)rli[r]=__builtin_amdgcn_rcpf(wsf[32+crow(r,hi)]);
  bf16*Ow=Ob+(long)(wid*QBLK)*op;
  { bf16*stg=(bf16*)(shm+LDS_OST)+wid*2048;
    #pragma unroll
    for(int r=0;r<16;++r){const int orow=crow(r,hi);
      #pragma unroll
      for(int d0=0;d0<2;++d0)stg[orow*64+d0*32+r32]=__float2bfloat16(o[d0][r]*rli[r]);}
    asm volatile("s_waitcnt lgkmcnt(0)":::"memory");
    #pragma unroll
    for(int i=0;i<4;++i){const int row=i*8+(lane>>3),ch=lane&7; const u32x4 v=*(const u32x4*)(stg+row*64+ch*8); ATTN_STORE16(Ow+(long)row*op+ch*8,v);} }
  asm volatile("s_waitcnt lgkmcnt(0)\n\ts_barrier":::"memory");
  #undef DMA_K
  #undef DMA_V
  #undef CMASK
  #undef ALIBI
  #undef START
  #undef RESC
  #undef ROT
}
constexpr int L2_K=0, L2_V0=NSLOT*SLOTB, L2_V1=2*NSLOT*SLOTB, L2_WS=3*NSLOT*SLOTB, L2_QS=L2_WS+NW*64*4, L2_QSW=4608, LDS2_BYTES=L2_QS+NW*L2_QSW;
template<int THRL> __device__ __forceinline__ void attn_unit2(const bf16*Qb,int qp,const bf16*__restrict__ Kh,int kp,const bf16*__restrict__ Vh,int vp,bf16*Ob,int op,int NT,int q0,float nsl2,char*shm,const int wid_in){
  int lane_; asm volatile("v_mbcnt_lo_u32_b32 %0, -1, 0\n\tv_mbcnt_hi_u32_b32 %0, -1, %0":"=v"(lane_)); const int lane=lane_,r32=lane&31,hi=lane>>5; const int wid=wid_in,tid=wid*64+lane; (void)tid; constexpr int MODE=0;
  const bf16*Qw=Qb+(long)(wid*QBLK)*qp;
  const unsigned lds0=(unsigned)(uintptr_t)shm;
  float*wsf=(float*)(shm+L2_WS)+wid*64;
  const bf16*ksrc=Kh+(long)lane*kp+wid*8;
  const bf16*vsrc=Vh+(long)(16*(wid&3)+(lane>>2))*vp+(wid>>2)*32+(lane&3)*8;
  const unsigned kdst=lds0+L2_K+wid*1024, vdst=lds0+L2_V0+wid*1024, vdst1=lds0+L2_V1+wid*1024;
  #define DMA_K(t,slot) glds16(ksrc+(long)(t)*KVBLK*kp,(unsigned)__builtin_amdgcn_readfirstlane(kdst+(slot)))
  #define DMA_V(t,slot) do{ glds16(vsrc+(long)(t)*KVBLK*vp,(unsigned)__builtin_amdgcn_readfirstlane(vdst+(slot))); glds16(vsrc+64+(long)(t)*KVBLK*vp,(unsigned)__builtin_amdgcn_readfirstlane(vdst1+(slot))); }while(0)
  const int vb0=(int)(lds0+L2_V0)+((lane>>4)&1)*32+(lane&3)*8+(4*hi+((lane&15)>>2))*64, vb1=vb0+(L2_V1-L2_V0);
  const char*Kbase=shm+L2_K; bf16x8 kf[8];
  const lds_cptr shm3=(lds_cptr)shm; const lds_cptr kp0=shm3+L2_K+hi*1024+r32*16; const lds_cptr vp0=shm3+L2_V0+((lane>>4)&1)*32+(lane&3)*8+(4*hi+((lane&15)>>2))*64; const lds_cptr qf0=shm3+L2_QS+wid*L2_QSW+r32*144+hi*16;
  DMA_K(0,0);DMA_V(0,0);DMA_K(1,SLOTB);
  bf16x8 qr[4];
  #pragma unroll
  for(int d0=0;d0<4;++d0)qr[d0]=*reinterpret_cast<const bf16x8*>(&Qw[(long)r32*qp+d0*16+hi*8]);
  float mhat=0.f,l_reg=0.f;f32x16 o[4];float z_=0.f;asm volatile("":"+v"(z_));
  _Pragma("unroll") for(int r=0;r<16;++r){o[0][r]=z_;o[1][r]=z_;o[2][r]=z_;o[3][r]=z_;}
  const f32x16 ZERO={0.f,0.f,0.f,0.f,0.f,0.f,0.f,0.f,0.f,0.f,0.f,0.f,0.f,0.f,0.f,0.f};
  const float dq0=(float)(q0+wid*QBLK+r32-4*hi);
  #define ALIBI(P0,P1,t) do{ alibi(P0,P1,dq0-(float)(64*(t)),nsl2); _Pragma("unroll") for(int r=0;r<16;++r){P0[r]-=mhat;P1[r]-=mhat;} }while(0)
  #define ALIBIF(P0,P1,t) do{ const float a_=__builtin_fmaf(nsl2,dq0-(float)(64*(t)),-mhat); _Pragma("unroll") for(int r=0;r<16;++r){ const float e_=(float)((r&3)+8*(r>>2)); P0[r]=__builtin_fmaf(e_,-nsl2,P0[r]+a_); P1[r]=__builtin_fmaf(e_+32.f,-nsl2,P1[r]+a_); } }while(0)
  #define CMASK(P0,P1,t) do{ if(MODE==0){int jb_=(t)-(NT-4); if(jb_>=0)cmask_blk(P0,P1,jb_,wid);} }while(0)
  bool resc=false;
  #define START(P0,P1) do{ const float rm=rm0_; resc=false; \
    { const float dl=rm; mhat=fadd_s(mhat,dl); \
      _Pragma("unroll") for(int r=0;r<16;++r){P0[r]=fsub_s(P0[r],dl);P1[r]=fsub_s(P1[r],dl);} \
      } \
    _Pragma("unroll") for(int r=0;r<16;++r)P0[r]=__builtin_amdgcn_exp2f(P0[r]); }while(0)
  #define RESC() do{ if(resc){ asm volatile("s_waitcnt lgkmcnt(0)":::"memory"); \
      _Pragma("unroll") for(int d_=0;d_<4;++d_) _Pragma("unroll") for(int r=0;r<16;++r)o[d_][r]*=wsf[crow(r,hi)]; } }while(0)
  f32x16 pA0,pA1,pB0,pB1;
  int sl_prev=0,sl_cur=0,sl_next=SLOTB;
  #define ROT() do{sl_prev=sl_cur;sl_cur=sl_next;sl_next=(sl_next==(NSLOT-1)*SLOTB)?0:sl_next+SLOTB;}while(0)
  DMA_K(2,2*SLOTB);
  { bf16*qs=(bf16*)(shm+L2_QS+wid*L2_QSW);
    _Pragma("unroll") for(int d0=0;d0<4;++d0)*reinterpret_cast<bf16x8*>(&qs[r32*72+d0*16+hi*8])=qr[d0]; }
  WAIT_BAR(4);
  qkt(pA0,pA1,Kbase,qr,ZERO,r32,hi);asm volatile("s_nop 15\n\ts_nop 7":"+v"(pA0),"+v"(pA1));const float rm0_=rowmax(pA0,pA1);
  ALIBI(pA0,pA1,0);CMASK(pA0,pA1,0);
  START(pA0,pA1);
  _Pragma("unroll") for(int r=0;r<16;++r)pA1[r]=__builtin_amdgcn_exp2f(pA1[r]);
  WAIT_BAR(0);
  DMA_K(3,0);DMA_V(1,SLOTB);
  ROT();
  kload8(kf,kp0+sl_cur);
  WAIT_BAR(3);
  s16x4 vlo[8],vhi[8]; u32x4 pw0,pw1,pw2,pw3;
  #define PKW(P,B) cvtpk_s(P[B],P[B+1])
  #define PAF(k) __builtin_bit_cast(bf16x8,pw##k)
  #define VFR(i) (bf16x8){vlo[i][0],vlo[i][1],vlo[i][2],vlo[i][3],vhi[i][0],vhi[i][1],vhi[i][2],vhi[i][3]}
  #define PIN(x) asm volatile("":"+v"(x))
  #define MX3(a,b,c) __builtin_fmaxf(__builtin_fmaxf((a),(b)),(c))
  #define GAPA(MF,A0,A1,A2,A3,W0,W1,PW) do{ MF; sacc+=A0; sacc+=A1; sacc+=A2; sacc+=A3; PIN(sacc); W0; W1; PIN(PW); SBAR(); }while(0)
  #define EX(v) __builtin_amdgcn_exp2f(v)
  #define GAPB(MF,X,B) do{ MF; X[B]=EX(X[B]); X[B+1]=EX(X[B+1]); X[B+2]=EX(X[B+2]); X[B+3]=EX(X[B+3]); PIN(X); SBAR(); }while(0)
  #define VRD(i) do{ vlo[i]=vtr(vp_+(((i)>>2)*4096+((i)&3)*1024)); vhi[i]=vtr(vp_+(((i)>>2)*4096+((i)&3)*1024+512)); }while(0)
  #define KRD(G,j) do{ if(G){ kload2(kf,kp0+sl_next,j); SBAR(); } }while(0)
  #define QF(d) (*(const __attribute__((address_space(3))) bf16x8*)(qf0+32*(d)))
  #define STEP(C0,C1,P0,P1,t,GK,GV,GL,AL) do{ SBAR(); \
    const lds_cptr vp_=vp0+sl_prev; const bf16x8 q0_=QF(0),q1_=QF(1); \
    VRD(0); SBAR(); float sacc=(P0[0]+P0[1]); \
    GAPA(C0=__builtin_amdgcn_mfma_f32_32x32x16_bf16(kf[0],q0_,ZERO,0,0,0), P0[2],P0[3],P0[4],P0[5],     pw0[0]=PKW(P0,0), pw0[1]=PKW(P0,2), pw0); \
    VRD(4); SBAR(); GAPA(C1=__builtin_amdgcn_mfma_f32_32x32x16_bf16(kf[1],q0_,ZERO,0,0,0), P0[6],P0[7],P0[8],P0[9],     pw0[2]=PKW(P0,4), pw0[3]=PKW(P0,6), pw0); \
    VRD(1); SBAR(); GAPA(C0=__builtin_amdgcn_mfma_f32_32x32x16_bf16(kf[2],q1_,C0,0,0,0),   P0[10],P0[11],P0[12],P0[13], pw1[0]=PKW(P0,8), pw1[1]=PKW(P0,10), pw1); \
    VRD(5); SBAR(); GAPA(C1=__builtin_amdgcn_mfma_f32_32x32x16_bf16(kf[3],q1_,C1,0,0,0),   P0[14],P0[15],P1[0],P1[1],   pw1[2]=PKW(P0,12),pw1[3]=PKW(P0,14), pw1); \
    const bf16x8 q2_=QF(2),q3_=QF(3); \
    VRD(2); SBAR(); GAPA(C0=__builtin_amdgcn_mfma_f32_32x32x16_bf16(kf[4],q2_,C0,0,0,0),   P1[2],P1[3],P1[4],P1[5],     pw2[0]=PKW(P1,0), pw2[1]=PKW(P1,2), pw2); \
    VRD(6); SBAR(); GAPA(C1=__builtin_amdgcn_mfma_f32_32x32x16_bf16(kf[5],q2_,C1,0,0,0),   P1[6],P1[7],P1[8],P1[9],     pw2[2]=PKW(P1,4), pw2[3]=PKW(P1,6), pw2); \
    VRD(3); SBAR(); GAPA(C0=__builtin_amdgcn_mfma_f32_32x32x16_bf16(kf[6],q3_,C0,0,0,0),   P1[10],P1[11],P1[12],P1[13], pw3[0]=PKW(P1,8), pw3[1]=PKW(P1,10), pw3); \
    VRD(7); SBAR(); GAPA(C1=__builtin_amdgcn_mfma_f32_32x32x16_bf16(kf[7],q3_,C1,0,0,0),   P1[14],P1[15],0.f,0.f,       pw3[2]=PKW(P1,12),pw3[3]=PKW(P1,14), pw3); \
    l_reg+=sacc; \
    if(GK){DMA_K((t)+3,sl_cur);} if(GV){DMA_V((t)+1,sl_next);} \
    AL(C0,C1,t); CMASK(C0,C1,t); \
    { float a=MX3(C0[0],C0[1],C1[0]),b=MX3(C0[2],C0[3],C1[1]); a=MX3(a,C1[2],C1[3]); \
      _Pragma("unroll") for(int r=4;r<16;r+=4){a=MX3(a,C0[r],C0[r+1]);b=MX3(b,C0[r+2],C0[r+3]);a=MX3(a,C1[r],C1[r+1]);b=MX3(b,C1[r+2],C1[r+3]);} \
      float rm=__builtin_fmaxf(a,b); { auto rr=__builtin_amdgcn_permlane32_swap(__float_as_uint(rm),__float_as_uint(rm),false,false); rm=__builtin_fmaxf(__uint_as_float(rr[0]),__uint_as_float(rr[1])); } \
      resc=false; \
      if(__builtin_expect(__any(rm>(float)THRL),0)){ const float dl=__builtin_fmaxf(rm,0.f); mhat+=dl; \
        _Pragma("unroll") for(int r=0;r<16;++r){C0[r]-=dl;C1[r]-=dl;} \
        const float f=__builtin_amdgcn_exp2f(-dl); l_reg*=f; if(hi==0)wsf[r32]=f; resc=true; } } \
    SBAR(); \
    GAPB(o[0]=__builtin_amdgcn_mfma_f32_32x32x16_bf16(PAF(0),VFR(0),o[0],0,0,0), C0,0); \
    GAPB(o[1]=__builtin_amdgcn_mfma_f32_32x32x16_bf16(PAF(0),VFR(4),o[1],0,0,0), C0,4); \
    KRD(GL,0); GAPB(o[0]=__builtin_amdgcn_mfma_f32_32x32x16_bf16(PAF(1),VFR(1),o[0],0,0,0), C0,8); \
    KRD(GL,1); GAPB(o[1]=__builtin_amdgcn_mfma_f32_32x32x16_bf16(PAF(1),VFR(5),o[1],0,0,0), C0,12); \
    KRD(GL,2); GAPB(o[0]=__builtin_amdgcn_mfma_f32_32x32x16_bf16(PAF(2),VFR(2),o[0],0,0,0), C1,0); \
    KRD(GL,3); GAPB(o[1]=__builtin_amdgcn_mfma_f32_32x32x16_bf16(PAF(2),VFR(6),o[1],0,0,0), C1,4); \
    GAPB(o[0]=__builtin_amdgcn_mfma_f32_32x32x16_bf16(PAF(3),VFR(3),o[0],0,0,0), C1,8); \
    GAPB(o[1]=__builtin_amdgcn_mfma_f32_32x32x16_bf16(PAF(3),VFR(7),o[1],0,0,0), C1,12); \
    { const lds_cptr vq_=vp_+(L2_V1-L2_V0); _Pragma("unroll") for(int i_=0;i_<8;++i_){ vlo[i_]=vtr(vq_+((i_>>2)*4096+(i_&3)*1024)); vhi[i_]=vtr(vq_+((i_>>2)*4096+(i_&3)*1024+512)); } SBAR(); \
      o[2]=__builtin_amdgcn_mfma_f32_32x32x16_bf16(PAF(0),VFR(0),o[2],0,0,0); o[3]=__builtin_amdgcn_mfma_f32_32x32x16_bf16(PAF(0),VFR(4),o[3],0,0,0); \
      o[2]=__builtin_amdgcn_mfma_f32_32x32x16_bf16(PAF(1),VFR(1),o[2],0,0,0); o[3]=__builtin_amdgcn_mfma_f32_32x32x16_bf16(PAF(1),VFR(5),o[3],0,0,0); \
      o[2]=__builtin_amdgcn_mfma_f32_32x32x16_bf16(PAF(2),VFR(2),o[2],0,0,0); o[3]=__builtin_amdgcn_mfma_f32_32x32x16_bf16(PAF(2),VFR(6),o[3],0,0,0); \
      o[2]=__builtin_amdgcn_mfma_f32_32x32x16_bf16(PAF(3),VFR(3),o[2],0,0,0); o[3]=__builtin_amdgcn_mfma_f32_32x32x16_bf16(PAF(3),VFR(7),o[3],0,0,0); SBAR(); } \
    }while(0)
  int t=1;
  #undef CMASK
  #define CMASK(P0,P1,t) do{}while(0)
  for(;t+5<NT;t+=2){
    STEP(pB0,pB1,pA0,pA1,t,true,true,true,ALIBIF);     WAIT_BAR(3); RESC(); ROT();
    STEP(pA0,pA1,pB0,pB1,t+1,true,true,true,ALIBIF);   WAIT_BAR(3); RESC(); ROT();
  }
  #undef CMASK
  #define CMASK(P0,P1,t) do{ if(MODE==0){int jb_=(t)-(NT-4); if(jb_>=0)cmask_blk(P0,P1,jb_,wid);} }while(0)
  #define ENDW(tt) do{ if((tt)+3<NT){WAIT_BAR(3);} else if((tt)+2<NT){WAIT_BAR(2);} else {WAIT_BAR(0);} }while(0)
  for(;t+1<NT;t+=2){
    STEP(pB0,pB1,pA0,pA1,t,(t+3<NT),(t+1<NT),(t+1<NT),ALIBI);       ENDW(t);   RESC(); ROT();
    STEP(pA0,pA1,pB0,pB1,t+1,(t+4<NT),(t+2<NT),(t+2<NT),ALIBI);     ENDW(t+1); RESC(); ROT();
  }
  STEP(pB0,pB1,pA0,pA1,NT-1,false,false,false,ALIBI); RESC();
  { float sacc=pB0[0]+pB0[1]; _Pragma("unroll") for(int r=2;r<16;++r)sacc+=pB0[r]; _Pragma("unroll") for(int r=0;r<16;++r)sacc+=pB1[r]; l_reg+=sacc;
    pw0=(u32x4){PKW(pB0,0),PKW(pB0,2),PKW(pB0,4),PKW(pB0,6)};pw1=(u32x4){PKW(pB0,8),PKW(pB0,10),PKW(pB0,12),PKW(pB0,14)};pw2=(u32x4){PKW(pB1,0),PKW(pB1,2),PKW(pB1,4),PKW(pB1,6)};pw3=(u32x4){PKW(pB1,8),PKW(pB1,10),PKW(pB1,12),PKW(pB1,14)};
    SBAR(); pv(o,vb0+sl_cur,PAF(0),PAF(1),PAF(2),PAF(3)); pv(o+2,vb1+sl_cur,PAF(0),PAF(1),PAF(2),PAF(3)); }
  #undef PKW
  #undef PAF
  #undef VFR
  #undef PIN
  #undef MX3
  #undef GAPA
  #undef GAPB
  #undef EX
  #undef VRD
  #undef KRD
  #undef STEP
  #undef QF
  #undef ENDW
  {auto rr=__builtin_amdgcn_permlane32_swap(__float_as_uint(l_reg),__float_as_uint(l_reg),false,false);l_reg=__uint_as_float(rr[0])+__uint_as_float(rr[1]);}
  if(hi==0)wsf[32+r32]=l_reg;asm volatile("s_waitcnt lgkmcnt(0)":::"memory");
  float rli[16];
  #pragma unroll
  for(int r=0;r<16;++r)rli[r]=__builtin_amdgcn_rcpf(wsf[32+crow(r,hi)]);
  bf16*Ow=Ob+(long)(wid*QBLK)*op;
  { bf16*stg=(bf16*)(shm+L2_QS+wid*L2_QSW);
    #pragma unroll
    for(int hv=0;hv<2;++hv){
      #pragma unroll
      for(int r=0;r<16;++r){const int orow=crow(r,hi);
        #pragma unroll
        for(int d0=0;d0<2;++d0)stg[orow*64+d0*32+r32]=__float2bfloat16(o[2*hv+d0][r]*rli[r]);}
      asm volatile("s_waitcnt lgkmcnt(0)":::"memory");
      #pragma unroll
      for(int i=0;i<4;++i){const int row=i*8+(lane>>3),ch=lane&7; const u32x4 v=*(const u32x4*)(stg+row*64+ch*8); ATTN_STORE16(Ow+(long)row*op+hv*64+ch*8,v);}
      asm volatile("s_waitcnt lgkmcnt(0)":::"memory"); } }
  asm volatile("s_waitcnt lgkmcnt(0)\n\ts_barrier":::"memory");
  #undef DMA_K
  #undef DMA_V
  #undef CMASK
  #undef ALIBI
  #undef ALIBIF
  #undef START
  #undef RESC
  #undef ROT
}
constexpr int ATTN_LDS_BYTES=LDS_BYTES;
#undef SBAR
#undef WAIT_BAR
}
constexpr int T = 32768, D = 1024, NB = 8, S = 4096, MEML = 256;
constexpr int AIN = 2560, BIN = 3328, FFD = 2816, FFE = 3584, NE = 8, DAW = 768;
constexpr float EPS = 1e-6f;
constexpr float C2 = 0.125f * 1.4426950408889634f;
constexpr int MAXROWS = 2 * T + NE * 256;
constexpr int NWAVES = 8;
constexpr float SC_X = 16.f, SC_WGU = 64.f, SC_H = 8.f, SC_WDN = 256.f;
constexpr size_t MiB = 1u << 20;
constexpr size_t WS_CTL = 0, CTL_ZERO_BYTES = 1 * MiB;
constexpr size_t WS_WINA = 2 * MiB, WS_WOUT = 12 * MiB, WS_WINB = 20 * MiB, WS_WMKV = 33 * MiB, WS_WGUD = 37 * MiB, WS_WDND = 59 * MiB, WS_WGUM = 70 * MiB, WS_WDNM = 294 * MiB;
constexpr size_t WS_MEMN = 406 * MiB, WS_MKV = 422 * MiB, WS_XN = 430 * MiB, WS_OC = 494 * MiB, WS_ROUTE = 558 * MiB, WS_BIG = 560 * MiB, WS_XG = 1072 * MiB, WS_Y = 1204 * MiB, WS_SSQP = 1362 * MiB, WS_END = 1376 * MiB;
constexpr size_t WS_SLOC = WS_XG, WS_SIN = WS_XG + 192 * MiB;
constexpr size_t WS_FS = 1600 * MiB;
constexpr int CW_TMO = 0, CW_CODE = 1, CW_BAR = 4096, CW_GCNT = 8192, CW_N2 = 65536;
constexpr int RING_OFF = 0, RING_BYTES = 131072;
constexpr int LDSCTL_OFF = RING_BYTES, MISC_OFF = LDSCTL_OFF + 320;
constexpr int LDS_BYTES = 147456;
static_assert(MISC_OFF + 128 <= LDS_BYTES && MISC_OFF + 128 <= pg8::RS_LDS_OFF && pg8::RS_LDS_OFF + 2048 <= LDS_BYTES && RING_OFF == 0, "LDS map");
#ifndef MK_DBG
#define MK_DBG 0
#endif
#ifndef MK_DUP
#define MK_DUP 0
#endif
#ifndef MK_TS
#define MK_TS 0
#endif
#ifndef MK_TS_A
#define MK_TS_A 0
#endif
#ifndef MK_TS_B
#define MK_TS_B 0
#endif
__constant__ unsigned char ATT_DEAL[16][6] = {{4, 14, 35, 56, 63, 85}, {0, 18, 20, 36, 72, 79}, {16, 21, 34, 52, 88, 95}, {22, 32, 50, 62, 68, 73}, {23, 48, 66, 78, 84, 89}, {5, 15, 40, 51, 86, 94}, {1, 6, 27, 47, 61, 69}, {24, 37, 41, 64, 77, 82},
    {2, 12, 25, 53, 57, 93}, {7, 17, 28, 38, 44, 60}, {8, 29, 33, 45, 54, 76}, {9, 30, 46, 49, 70, 92}, {10, 59, 65, 67, 87, 90}, {11, 31, 42, 55, 75, 81}, {19, 43, 71, 80, 83, 91}, {3, 13, 26, 39, 58, 74}};
#define GAS __attribute__((address_space(1)))
#define LAS __attribute__((address_space(3)))
typedef unsigned short bf16;
typedef unsigned v4u __attribute__((ext_vector_type(4)));
typedef unsigned v2u __attribute__((ext_vector_type(2)));
typedef float f32x4 __attribute__((ext_vector_type(4)));
typedef short bf16x8 __attribute__((ext_vector_type(8)));
typedef GAS unsigned gu32;
typedef GAS unsigned long long gu64;
#define RLX_AGENT __ATOMIC_RELAXED, __HIP_MEMORY_SCOPE_AGENT
#define LDS_WAIT() asm volatile("s_waitcnt lgkmcnt(0)" ::: "memory")
#define VM_WAIT() asm volatile("s_waitcnt vmcnt(0)" ::: "memory")
__device__ __forceinline__ unsigned long long rt() { return __builtin_amdgcn_s_memrealtime(); }
__device__ __forceinline__ unsigned f2bf(float f) { unsigned u = __builtin_bit_cast(unsigned, f); return (u + 0x7fffu + ((u >> 16) & 1u)) >> 16; }
__device__ __forceinline__ unsigned pk2(float lo, float hi) { return f2bf(lo) | (f2bf(hi) << 16); }

#define XB_TMO      128
#define XB_XCNT(j)  (256  + 64 * (j))
#define XB_XSUB(j)  (1280 + 64 * (j))
#define XB_XGEN(j)  (2304 + 64 * (j))
#define XB_TOP      3328
#define XB_TOPGEN   3392
#define XCD_BAR_WORDS 3456
#define XB_SPIN_CAP (1u << 18)

__device__ __forceinline__ unsigned xb_ld(unsigned* p)              { return __hip_atomic_load(p, __ATOMIC_RELAXED, __HIP_MEMORY_SCOPE_AGENT); }
__device__ __forceinline__ unsigned xb_add(unsigned* p, unsigned v) { return __hip_atomic_fetch_add(p, v, __ATOMIC_RELAXED, __HIP_MEMORY_SCOPE_AGENT); }
__device__ __forceinline__ unsigned xb_xcc_id() { return (unsigned)__builtin_amdgcn_s_getreg((3 << 11) | 20) & 0xFu; }
#define XB_SPIN(cond, bar) do { unsigned _sp = 0; while (cond) { __builtin_amdgcn_s_sleep(1); \
    if ((++_sp & 255u) == 0u) { if (xb_ld(&(bar)[XB_TMO])) break; if (_sp > XB_SPIN_CAP) { atomicAdd(&(bar)[XB_TMO], 1u); break; } } } } while (0)

struct XcdBarrier {
    unsigned* bar; unsigned x; int wave;
    volatile LAS unsigned* st;
};

__device__ __forceinline__ XcdBarrier xcd_barrier_post(unsigned* bar, volatile LAS unsigned* st) {
    XcdBarrier b; b.bar = bar; b.x = xb_xcc_id(); b.st = st; b.wave = __builtin_amdgcn_readfirstlane((int)(threadIdx.x >> 6));
    if (threadIdx.x == 0) (void)xb_add(&bar[XB_XCNT(b.x)], 1u);
    return b;
}
__device__ __forceinline__ void xcd_barrier_complete(unsigned* bar, unsigned x, unsigned& nloc, unsigned& nx) {
    const unsigned G = gridDim.x * gridDim.y * gridDim.z;
    unsigned sum, cnt, mine, sp = 0u;
    for (;;) {
        sum = 0u; cnt = 0u; mine = 0u;
#pragma unroll
        for (unsigned j = 0; j < 16; ++j) { const unsigned c = xb_ld(&bar[XB_XCNT(j)]); sum += c; cnt += (c > 0u) ? 1u : 0u; mine = (j == x) ? c : mine; }
        if (sum == G) break;
        __builtin_amdgcn_s_sleep(1);
        if ((++sp & 255u) == 0u) { if (xb_ld(&bar[XB_TMO])) break; if (sp > XB_SPIN_CAP) { atomicAdd(&bar[XB_TMO], 1u); break; } }
    }
    nloc = mine > 0u ? mine : 1u; nx = cnt > 0u ? cnt : 1u;
}

__device__ __forceinline__ void xcd_barrier(const XcdBarrier& b) {
    asm volatile("s_waitcnt vmcnt(0)" ::: "memory");
    __syncthreads();
    int l0_; asm volatile("v_mbcnt_lo_u32_b32 %0, -1, 0\n\tv_mbcnt_hi_u32_b32 %0, -1, %0" : "=v"(l0_));
    if (b.wave == 0 && l0_ == 0) {
        unsigned* bar = b.bar;
        __builtin_amdgcn_s_waitcnt(0);
        unsigned nloc = b.st[0], nx = b.st[1];
        if (nloc == 0u) { xcd_barrier_complete(bar, b.x, nloc, nx); b.st[0] = nloc; b.st[1] = nx; }
        const unsigned old = xb_add(&bar[XB_XSUB(b.x)], 1u);
        const unsigned gen = old / nloc;
        if (old + 1u == (gen + 1u) * nloc) {
            __builtin_amdgcn_fence(__ATOMIC_RELEASE, "agent");
            asm volatile("s_waitcnt vmcnt(0)" ::: "memory");
            const unsigned og = xb_add(&bar[XB_TOP], 1u);
            const unsigned tg = og / nx;
            if (og + 1u == (tg + 1u) * nx) xb_add(&bar[XB_TOPGEN], 1u);
            else XB_SPIN(xb_ld(&bar[XB_TOPGEN]) == tg, bar);
            __builtin_amdgcn_fence(__ATOMIC_ACQUIRE, "agent");
            xb_add(&bar[XB_XGEN(b.x)], 1u);
            asm volatile("s_waitcnt vmcnt(0)" ::: "memory");
        } else {
            XB_SPIN(xb_ld(&bar[XB_XGEN(b.x)]) == gen, bar);
            __builtin_amdgcn_fence(__ATOMIC_ACQUIRE, "agent");
            asm volatile("s_waitcnt vmcnt(0)" ::: "memory");
        }
    }
    __syncthreads();
}
struct InTab { const LAS unsigned long long* t;
    __device__ __forceinline__ const float* operator[](int k) const { const unsigned long long v = t[k];
        return (const float*)(((unsigned long long)(unsigned)__builtin_amdgcn_readfirstlane((int)(v >> 32)) << 32) | (unsigned)__builtin_amdgcn_readfirstlane((int)(unsigned)v)); } };
struct Frame {
    LAS unsigned char* lds;
    volatile LAS unsigned* MISC;
    gu32* ctl;
    int wave;
    int vcu, G, bx;
    GAS unsigned char* ws;
    InTab in;
    GAS float* out;
    float ts_scale, ts_add;
};
__device__ __forceinline__ float xor_get(float v, int lane, int o) { return __builtin_bit_cast(float, __builtin_amdgcn_ds_bpermute((lane ^ o) << 2, __builtin_bit_cast(int, v))); }
__device__ __forceinline__ float half_sum(float v, int lane) {
#pragma unroll
    for (int o = 1; o < 32; o <<= 1) v += xor_get(v, lane, o);
    return v; }
__device__ __forceinline__ float wave_sum(float v, int lane) { v = half_sum(v, lane); return v + xor_get(v, lane, 32); }
__device__ __forceinline__ int launder(int v) { asm volatile("" : "+v"(v)); return v; }
__device__ __forceinline__ int fresh_lane() { int l; asm volatile("v_mbcnt_lo_u32_b32 %0, -1, 0\n\tv_mbcnt_hi_u32_b32 %0, -1, %0" : "=v"(l)); return l; }
__device__ __forceinline__ float bf_lo(unsigned u) { return __builtin_bit_cast(float, u << 16); }
__device__ __forceinline__ float bf_hi(unsigned u) { return __builtin_bit_cast(float, u & 0xffff0000u); }
#if MK_DBG
__device__ __forceinline__ void dbg_sample_f32(Frame& F, int lane, int slot, int row, const f32x4 (&v)[4]) {
    float* d = (float*)(F.ws + WS_FS) + ((size_t)slot * 1024 + (row >> 5)) * 1024;
#pragma unroll
    for (int j = 0; j < 4; ++j) ((f32x4*)d)[lane + 64 * j] = v[j];
}
#endif
__device__ __forceinline__ int swiglu_row(int n, int ff) { const int bj = n >= ff ? 1 : 0, cc = n - bj * ff; return 256 * (cc >> 7) + 128 * bj + (cc & 127); }
template <bool F8>
__device__ __forceinline__ void transpose_item(const float* W, int K, int N, void* WT, int ff, float scale, LAS float* scr, int item, int lane, const float* kg = nullptr) {
    const int nblk = N / 64, kb = item / nblk, nb = item % nblk, k0 = 64 * kb, n0 = 64 * nb;
    const int r0 = ff ? swiglu_row(n0, ff) : n0;
    float v[64];
    const GAS float* wp = (const GAS float*)W + (size_t)k0 * N + n0 + lane;
#pragma unroll
    for (int i = 0; i < 64; ++i) v[i] = wp[(size_t)i * N];
#pragma unroll
    for (int i = 0; i < 64; ++i) scr[i * 64 + (lane ^ (i & 31))] = v[i];
    LDS_WAIT(); asm volatile("" ::: "memory");
    const int c = lane & 7;
    float kgv[8];
#pragma unroll
    for (int i = 0; i < 8; ++i) kgv[i] = kg ? kg[k0 + 8 * c + i] : 1.f;
#pragma unroll
    for (int j = 0; j < 8; ++j) { const int n = (lane >> 3) + 8 * j; float s[8];
#pragma unroll
        for (int i = 0; i < 8; ++i) s[i] = scr[(8 * c + i) * 64 + (n ^ ((8 * c + i) & 31))] * kgv[i];
        if (F8) { v2u o; o.x = pg8::pk4_fp8(s[0] * scale, s[1] * scale, s[2] * scale, s[3] * scale); o.y = pg8::pk4_fp8(s[4] * scale, s[5] * scale, s[6] * scale, s[7] * scale);
            *(GAS v2u*)((unsigned char*)WT + (size_t)(r0 + n) * K + k0 + 8 * c) = o; }
        else { v4u o; o.x = pg8::cvt_pk_bf16(s[0], s[1]); o.y = pg8::cvt_pk_bf16(s[2], s[3]); o.z = pg8::cvt_pk_bf16(s[4], s[5]); o.w = pg8::cvt_pk_bf16(s[6], s[7]);
            *(GAS v4u*)((bf16*)WT + (size_t)(r0 + n) * K + k0 + 8 * c) = o; } }
    LDS_WAIT(); asm volatile("" ::: "memory");
}
__device__ __forceinline__ void rms_row_to_bf16(int lane, const float* xrow, const float* gain, bf16* orow) {
    const GAS f32x4* xr = (const GAS f32x4*)xrow + lane;
    f32x4 v[4]; float s = 0.f;
#pragma unroll
    for (int j = 0; j < 4; ++j) { v[j] = xr[64 * j]; s += (v[j].x * v[j].x + v[j].y * v[j].y) + (v[j].z * v[j].z + v[j].w * v[j].w); }
    const float rstd = 1.f / sqrtf(wave_sum(s, lane) * (1.f / D) + EPS);
    GAS unsigned long long* o8 = (GAS unsigned long long*)orow + lane;
#pragma unroll
    for (int j = 0; j < 4; ++j) { const f32x4 g = ((const GAS f32x4*)gain)[lane + 64 * j];
        o8[64 * j] = (unsigned long long)pk2(v[j].x * rstd * g.x, v[j].y * rstd * g.y) | ((unsigned long long)pk2(v[j].z * rstd * g.z, v[j].w * rstd * g.w) << 32); }
}
__device__ __forceinline__ void phase_prologue(Frame& F) {
    const int lane = fresh_lane(), tid = F.wave * 64 + lane; (void)tid;
    LAS float* scr = (LAS float*)(F.lds + RING_OFF + F.wave * 16384);
    const int gw = F.vcu * NWAVES + F.wave, NGW = F.G * NWAVES;
    constexpr int I_AIN = 16 * (AIN / 64), I_MKV = 16 * 8, I_OUT = 16 * 16, I_BIN = 16 * (BIN / 64), I_GUD = 16 * (2 * FFD / 64), I_DND = (FFD / 64) * 16, I_GUM = 16 * (2 * FFE / 64), I_DNM = (FFE / 64) * 16;
    constexpr int NITEMS = 2 * I_AIN + 4 * I_MKV + 4 * I_OUT + 2 * I_BIN + 2 * I_GUD + 2 * I_DND + 16 * I_GUM + 16 * I_DNM;
    for (int it = NITEMS - 1 - gw; it >= 0; it -= NGW) {
        int r = it; const float* src; bf16* dst; int K = D, N, ff = 0; const float* kg = nullptr;
        if (r < 2 * I_AIN) { const int j = r / I_AIN; r %= I_AIN; N = AIN; src = F.in[3] + (size_t)j * D * AIN; dst = (bf16*)(F.ws + WS_WINA) + (size_t)j * AIN * D; kg = F.in[2] + j * D; }
        else if ((r -= 2 * I_AIN) < 4 * I_MKV) { const int l = r / I_MKV; r %= I_MKV; N = 512; src = F.in[(l & 1) ? 17 : 10] + (size_t)(l >> 1) * D * 512; dst = (bf16*)(F.ws + WS_WMKV) + (size_t)l * 512 * D; }
        else if ((r -= 4 * I_MKV) < 4 * I_OUT) { const int l = r / I_OUT; r %= I_OUT; N = D; src = F.in[(l & 1) ? 18 : 11] + (size_t)(l >> 1) * D * D; dst = (bf16*)(F.ws + WS_WOUT) + (size_t)l * D * D; }
        else if ((r -= 4 * I_OUT) < 2 * I_BIN) { const int j = r / I_BIN; r %= I_BIN; N = BIN; src = F.in[13] + (size_t)j * D * BIN; dst = (bf16*)(F.ws + WS_WINB) + (size_t)j * BIN * D; kg = F.in[12] + j * D; }
        else if ((r -= 2 * I_BIN) < 2 * I_GUD) { const int j = r / I_GUD; r %= I_GUD; N = 2 * FFD; ff = FFD; src = F.in[20] + (size_t)j * D * 2 * FFD; dst = (bf16*)(F.ws + WS_WGUD) + (size_t)j * 2 * FFD * D; kg = F.in[19] + j * D; }
        else if ((r -= 2 * I_GUD) < 2 * I_DND) { const int j = r / I_DND; r %= I_DND; K = FFD; N = D; src = F.in[21] + (size_t)j * FFD * D; dst = (bf16*)(F.ws + WS_WDND) + (size_t)j * D * FFD; }
        else if ((r -= 2 * I_DND) < 16 * I_GUM) { const int j = r / I_GUM; r %= I_GUM;
            transpose_item<true>(F.in[24] + (size_t)j * D * 2 * FFE, D, 2 * FFE, (void*)(F.ws + WS_WGUM + (size_t)j * 2 * FFE * D), FFE, SC_WGU, scr, r, lane); continue; }
        else { r -= 16 * I_GUM; const int j = r / I_DNM; r %= I_DNM;
            transpose_item<true>(F.in[25] + (size_t)j * FFE * D, FFE, D, (void*)(F.ws + WS_WDNM + (size_t)j * D * FFE), 0, SC_WDN, scr, r, lane); continue; }
        transpose_item<false>(src, K, N, dst, ff, 1.f, scr, r, lane, kg);
    }
    for (int m = gw; m < 4 * NB * MEML; m += NGW) { const int l = m / (NB * MEML), r = m % (NB * MEML);
        rms_row_to_bf16(lane, F.in[1] + (size_t)r * D, F.in[(l & 1) ? 16 : 9] + (size_t)(l >> 1) * D, (bf16*)(F.ws + WS_MEMN) + (size_t)m * D); }
    {
        const float* x0 = F.in[0]; bf16* XB = (bf16*)(F.ws + WS_XN); float* SQ = (float*)(F.ws + WS_SSQP) + (size_t)4 * T * 16;
        for (int m0 = gw * 4; m0 < T; m0 += NGW * 4) { f32x4 v[4][4]; float ss[4];
#pragma unroll
            for (int r = 0; r < 4; ++r) { const GAS f32x4* xr = (const GAS f32x4*)(x0 + (size_t)(m0 + r) * D) + lane;
#pragma unroll
                for (int j = 0; j < 4; ++j) v[r][j] = xr[64 * j]; }
#pragma unroll
            for (int r = 0; r < 4; ++r) { float sq = 0.f; GAS unsigned long long* o8 = (GAS unsigned long long*)(XB + (size_t)(m0 + r) * D) + lane;
#pragma unroll
                for (int j = 0; j < 4; ++j) { sq += (v[r][j].x * v[r][j].x + v[r][j].y * v[r][j].y) + (v[r][j].z * v[r][j].z + v[r][j].w * v[r][j].w);
                    o8[64 * j] = (unsigned long long)pk2(v[r][j].x, v[r][j].y) | ((unsigned long long)pk2(v[r][j].z, v[r][j].w) << 32); }
                ss[r] = sq; }
#pragma unroll
            for (int o = 1; o < 64; o <<= 1) {
#pragma unroll
                for (int r = 0; r < 4; ++r) ss[r] += xor_get(ss[r], lane, o); }
#pragma unroll
            for (int r = 0; r < 4; ++r) if (lane < 16) SQ[(size_t)(m0 + r) * 16 + lane] = lane == 0 ? ss[r] : 0.f; }
    }
    if (F.bx == 0) { float* LBT = (float*)(F.ws + WS_ROUTE + 1024 * 1024);
        for (int i = tid; i < DAW; i += NWAVES * 64) { LBT[i] = 0.f; LBT[DAW + i] = 1.f / (1.f + __expf(F.in[14][i] - F.in[14][DAW + i])); } }
}
template <bool FINAL>
__device__ __forceinline__ void phase_combine(Frame& F, float* OUT, const float* gain, float* SQ) {
    const int lane = fresh_lane(), tid = F.wave * 64 + lane; (void)tid;
    bf16* XB = (bf16*)(F.ws + WS_XN); const bf16* Y = (const bf16*)(F.ws + WS_Y);
    const float* TOPW = (const float*)(F.ws + WS_ROUTE); const int* TOKROW = (const int*)(F.ws + WS_ROUTE + 768 * 1024);
    for (int rb = F.bx * 128; rb < T; rb += F.G * 128) {
        int ri0 = 0, ri1 = 0; float rw0 = 0.f, rw1 = 0.f;
        if (lane < 16) { const int rr = rb + F.wave * 16 + lane; ri0 = TOKROW[rr * 2]; ri1 = TOKROW[rr * 2 + 1]; rw0 = TOPW[rr * 2]; rw1 = TOPW[rr * 2 + 1]; }
        v2u xq[2][4], yq0[2][4], yq1[2][4];
#define CMB_ISSUE(B_, I_) do { const int row_ = rb + F.wave * 16 + (I_); const GAS v2u* xr_ = (const GAS v2u*)(XB + (size_t)row_ * D) + lane; \
            _Pragma("unroll") for (int j = 0; j < 4; ++j) xq[B_][j] = xr_[64 * j]; \
            const int r0_ = __builtin_amdgcn_readlane(ri0, (I_)), r1_ = __builtin_amdgcn_readlane(ri1, (I_)); \
            const GAS v2u* y0_ = (const GAS v2u*)(Y + (size_t)r0_ * D) + lane; const GAS v2u* y1_ = (const GAS v2u*)(Y + (size_t)r1_ * D) + lane; \
            _Pragma("unroll") for (int j = 0; j < 4; ++j) { yq0[B_][j] = y0_[64 * j]; yq1[B_][j] = y1_[64 * j]; } } while (0)
        CMB_ISSUE(0, 0);
        for (int i2 = 0; i2 < 16; i2 += 2) {
#pragma unroll
          for (int hb = 0; hb < 2; ++hb) {
            const int i = i2 + hb;
            if (hb == 0) CMB_ISSUE(1, i + 1); else if (i + 1 < 16) CMB_ISSUE(0, i + 1);
            const int row = rb + F.wave * 16 + i;
            const float w0 = __builtin_bit_cast(float, __builtin_amdgcn_readlane(__builtin_bit_cast(int, rw0), i)), w1 = __builtin_bit_cast(float, __builtin_amdgcn_readlane(__builtin_bit_cast(int, rw1), i));
            f32x4 v[4]; float s = 0.f;
#pragma unroll
            for (int j = 0; j < 4; ++j) { const v2u x = xq[hb][j], a = yq0[hb][j], b = yq1[hb][j];
                v[j].x = bf_lo(x.x) + w0 * bf_lo(a.x) + w1 * bf_lo(b.x); v[j].y = bf_hi(x.x) + w0 * bf_hi(a.x) + w1 * bf_hi(b.x); v[j].z = bf_lo(x.y) + w0 * bf_lo(a.y) + w1 * bf_lo(b.y); v[j].w = bf_hi(x.y) + w0 * bf_hi(a.y) + w1 * bf_hi(b.y);
                s += (v[j].x * v[j].x + v[j].y * v[j].y) + (v[j].z * v[j].z + v[j].w * v[j].w); }
            s = wave_sum(s, lane);
            if (FINAL) { const float rstd = 1.f / sqrtf(s * (1.f / D) + EPS); GAS f32x4* ow = (GAS f32x4*)(OUT + (size_t)row * D) + lane;
#pragma unroll
                for (int j = 0; j < 4; ++j) { const f32x4 g = ((const GAS f32x4*)gain)[lane + 64 * j]; ow[64 * j] = (f32x4){v[j].x * rstd * g.x, v[j].y * rstd * g.y, v[j].z * rstd * g.z, v[j].w * rstd * g.w}; }
            } else { GAS unsigned long long* o8 = (GAS unsigned long long*)(XB + (size_t)row * D) + lane;
#pragma unroll
                for (int j = 0; j < 4; ++j) o8[64 * j] = (unsigned long long)pk2(v[j].x, v[j].y) | ((unsigned long long)pk2(v[j].z, v[j].w) << 32);
                if (lane < 16) SQ[(size_t)row * 16 + lane] = lane == 0 ? s : 0.f; }
          }
        }
#undef CMB_ISSUE
    }
}
__device__ __forceinline__ void phase_router(Frame& F, const float* gain, const float* wr, gu32* gcnt) {
    const int lane = fresh_lane(), tid = F.wave * 64 + lane;
    const bf16* XB = (const bf16*)(F.ws + WS_XN); float* RS = (float*)(F.ws + WS_ROUTE + 1024 * 1024 + 8192); float* TOPW = (float*)(F.ws + WS_ROUTE); int* TOKSEL = (int*)(F.ws + WS_ROUTE + 256 * 1024);
    LAS int* cntL = (LAS int*)(F.lds + RING_OFF); LAS int* baseL = cntL + 8; LAS float* lg = (LAS float*)(cntL + 16);
    if (tid < 8) cntL[tid] = 0;
    __syncthreads();
    for (int rb = F.bx * 128; rb < T; rb += F.G * 128) {
        for (int g4 = 0; g4 < 4; ++g4) {
            const int rl0 = F.wave * 16 + 4 * g4, row0 = rb + rl0;
            f32x4 v[4][4];
#pragma unroll
            for (int r = 0; r < 4; ++r) { const GAS v2u* xr = (const GAS v2u*)(XB + (size_t)(row0 + r) * D) + lane;
#pragma unroll
                for (int j = 0; j < 4; ++j) { const v2u w = xr[64 * j]; v[r][j] = (f32x4){bf_lo(w.x), bf_hi(w.x), bf_lo(w.y), bf_hi(w.y)}; } }
            float ss[4];
#pragma unroll
            for (int r = 0; r < 4; ++r) { float s = 0.f;
#pragma unroll
                for (int j = 0; j < 4; ++j) s += (v[r][j].x * v[r][j].x + v[r][j].y * v[r][j].y) + (v[r][j].z * v[r][j].z + v[r][j].w * v[r][j].w);
                ss[r] = s; }
#pragma unroll
            for (int o = 1; o < 64; o <<= 1) {
#pragma unroll
                for (int r = 0; r < 4; ++r) ss[r] += xor_get(ss[r], lane, o); }
#pragma unroll
            for (int r = 0; r < 4; ++r) { const float rstd = 1.f / sqrtf(ss[r] * (1.f / D) + EPS);
                if (lane == 0) RS[row0 + r] = rstd;
#pragma unroll
                for (int j = 0; j < 4; ++j) { const f32x4 gg = ((const GAS f32x4*)gain)[lane + 64 * j]; v[r][j].x *= rstd * gg.x; v[r][j].y *= rstd * gg.y; v[r][j].z *= rstd * gg.z; v[r][j].w *= rstd * gg.w; } }
            float a[32];
#pragma unroll
            for (int i = 0; i < 32; ++i) a[i] = 0.f;
#pragma unroll
            for (int j = 0; j < 4; ++j) { const GAS f32x4* wp = (const GAS f32x4*)(wr + (size_t)(lane + 64 * j) * 32);
#pragma unroll
                for (int c = 0; c < 4; ++c) { const f32x4 w0 = wp[2 * c], w1 = wp[2 * c + 1];
#pragma unroll
                    for (int r = 0; r < 4; ++r) { const float xv = v[r][j][c];
                        a[r * 8 + 0] += xv * w0.x; a[r * 8 + 1] += xv * w0.y; a[r * 8 + 2] += xv * w0.z; a[r * 8 + 3] += xv * w0.w; a[r * 8 + 4] += xv * w1.x; a[r * 8 + 5] += xv * w1.y; a[r * 8 + 6] += xv * w1.z; a[r * 8 + 7] += xv * w1.w; } } }
#define RT_STEP(S_, N_) do { const bool up_ = (lane >> (S_)) & 1; _Pragma("unroll") for (int i = 0; i < (N_); ++i) { const float keep_ = up_ ? a[2 * i + 1] : a[2 * i], send_ = up_ ? a[2 * i] : a[2 * i + 1]; a[i] = keep_ + xor_get(send_, lane, 1 << (S_)); } } while (0)
            RT_STEP(0, 16); RT_STEP(1, 8); RT_STEP(2, 4); RT_STEP(3, 2); RT_STEP(4, 1);
#undef RT_STEP
            const float lgv = a[0] + xor_get(a[0], lane, 32);
            if (lane < 32) lg[(rl0 + (lane >> 3)) * 8 + (lane & 7)] = lgv;
        }
        __syncthreads();
        int e0 = 0, e1 = 0, q0 = 0, q1 = 0;
        if (tid < 128) { float av[8];
#pragma unroll
            for (int e = 0; e < 8; ++e) av[e] = lg[tid * 8 + e];
            float v0 = av[0];
#pragma unroll
            for (int e = 1; e < 8; ++e) if (av[e] > v0) { v0 = av[e]; e0 = e; }
            float v1 = -3.0e38f;
#pragma unroll
            for (int e = 0; e < 8; ++e) if (e != e0 && av[e] > v1) { v1 = av[e]; e1 = e; }
            const float p1 = __expf(v1 - v0), inv = 1.f / (1.f + p1);
            TOPW[(rb + tid) * 2] = inv; TOPW[(rb + tid) * 2 + 1] = p1 * inv;
            q0 = __hip_atomic_fetch_add(cntL + e0, 1, __ATOMIC_RELAXED, __HIP_MEMORY_SCOPE_WORKGROUP);
            q1 = __hip_atomic_fetch_add(cntL + e1, 1, __ATOMIC_RELAXED, __HIP_MEMORY_SCOPE_WORKGROUP); }
        __syncthreads();
        if (tid < 8) { baseL[tid] = (int)__hip_atomic_fetch_add(gcnt + tid, (unsigned)cntL[tid], __ATOMIC_RELAXED, __HIP_MEMORY_SCOPE_AGENT); }
        __syncthreads();
        if (tid < 128) { int4 o; o.x = e0; o.y = baseL[e0] + q0; o.z = e1; o.w = baseL[e1] + q1; *(int4*)(TOKSEL + (size_t)(rb + tid) * 4) = o; }
        __syncthreads();
        if (tid < 8) cntL[tid] = 0;
        __syncthreads();
    }
}
__device__ __forceinline__ void phase_gather(Frame& F, const gu32* gcnt, const float* gain) {
    const int lane = fresh_lane(), tid = F.wave * 64 + lane; (void)tid;
    const bf16* XB = (const bf16*)(F.ws + WS_XN); const float* RS = (const float*)(F.ws + WS_ROUTE + 1024 * 1024 + 8192); unsigned char* XG = (unsigned char*)(F.ws + WS_XG);
    const int* TOKSEL = (const int*)(F.ws + WS_ROUTE + 256 * 1024); int* TOKROW = (int*)(F.ws + WS_ROUTE + 768 * 1024);
    int rbase[8]; { int t = 0;
#pragma unroll
        for (int e = 0; e < 8; ++e) { rbase[e] = t * 256; t += (__builtin_amdgcn_readfirstlane((int)__hip_atomic_load(gcnt + e, RLX_AGENT)) + 255) >> 8; } }
    f32x4 gq[4];
#pragma unroll
    for (int i = 0; i < 4; ++i) gq[i] = ((const GAS f32x4*)gain)[4 * lane + i] * SC_X;
    const int gw = F.bx * NWAVES + F.wave, NGW = F.G * NWAVES;
    for (int row0 = gw * 4; row0 < T; row0 += NGW * 4) {
        int4 sl[4]; v4u a[4], b[4]; float rs[4];
#pragma unroll
        for (int r = 0; r < 4; ++r) { sl[r] = *(const int4*)(TOKSEL + (size_t)(row0 + r) * 4); const GAS v4u* sp = (const GAS v4u*)(XB + (size_t)(row0 + r) * D) + 2 * lane; a[r] = sp[0]; b[r] = sp[1]; rs[r] = RS[row0 + r]; }
#pragma unroll
        for (int r = 0; r < 4; ++r) { int d0 = sl[r].y, d1 = sl[r].w;
#pragma unroll
            for (int e = 0; e < 8; ++e) { if (sl[r].x == e) d0 += rbase[e]; if (sl[r].z == e) d1 += rbase[e]; }
            const float q = rs[r]; v4u o;
            o.x = pg8::pk4_fp8(bf_lo(a[r].x) * q * gq[0].x, bf_hi(a[r].x) * q * gq[0].y, bf_lo(a[r].y) * q * gq[0].z, bf_hi(a[r].y) * q * gq[0].w); o.y = pg8::pk4_fp8(bf_lo(a[r].z) * q * gq[1].x, bf_hi(a[r].z) * q * gq[1].y, bf_lo(a[r].w) * q * gq[1].z, bf_hi(a[r].w) * q * gq[1].w);
            o.z = pg8::pk4_fp8(bf_lo(b[r].x) * q * gq[2].x, bf_hi(b[r].x) * q * gq[2].y, bf_lo(b[r].y) * q * gq[2].z, bf_hi(b[r].y) * q * gq[2].w); o.w = pg8::pk4_fp8(bf_lo(b[r].z) * q * gq[3].x, bf_hi(b[r].z) * q * gq[3].y, bf_lo(b[r].w) * q * gq[3].z, bf_hi(b[r].w) * q * gq[3].w);
            ((GAS v4u*)(XG + (size_t)d0 * D))[lane] = o; ((GAS v4u*)(XG + (size_t)d1 * D))[lane] = o;
            if (lane == 0) { TOKROW[(row0 + r) * 2] = d0; TOKROW[(row0 + r) * 2 + 1] = d1; } }
    }
}
__device__ __forceinline__ void phase_knorm(Frame& F) {
    const int lane = fresh_lane();
    const bf16* P = (const bf16*)(F.ws + WS_BIG); float* N2 = (float*)(F.ws + WS_ROUTE + 1024 * 1024 + 8192);
    const int gw = F.bx * NWAVES + F.wave, NGW = F.G * NWAVES;
    for (int it = gw; it < NB * 24 * 64; it += NGW) { const int t = it & 63, hm = (it >> 6) % 24, b = it / (24 * 64);
        const GAS v4u* rp = (const GAS v4u*)(P + (size_t)(b * S + 64 * t + lane) * AIN + hm * 64); float ss = 0.f;
#pragma unroll
        for (int i = 0; i < 8; ++i) { const v4u w = rp[i]; const unsigned ww[4] = {w.x, w.y, w.z, w.w};
#pragma unroll
            for (int c = 0; c < 4; ++c) { const float a = bf_lo(ww[c]), b2 = bf_hi(ww[c]); ss += a * a + b2 * b2; } }
#pragma unroll
        for (int o = 1; o < 64; o <<= 1) ss = fmaxf(ss, xor_get(ss, lane, o));
        if (lane == 0) N2[it] = ss; }
}
__device__ __forceinline__ void phase_diff_combine(Frame& F, int j, float lam_init) {
    const int lane = fresh_lane(), tid = F.wave * 64 + lane; (void)tid;
    const bf16* O0 = (const bf16*)(F.ws + WS_BIG + 160 * MiB); const bf16* O1 = O0 + (size_t)T * DAW; bf16* OC = (bf16*)(F.ws + WS_OC);
    const float s1 = wave_sum(F.in[4][j * 64 + lane] * F.in[5][j * 64 + lane], lane), s2 = wave_sum(F.in[6][j * 64 + lane] * F.in[7][j * 64 + lane], lane);
    const float lam = __expf(s1) - __expf(s2) + lam_init;
    const f32x4 g = *(const GAS f32x4*)(F.in[8] + j * 128 + (lane & 31) * 4);
    const int gw = F.bx * NWAVES + F.wave, NGW = F.G * NWAVES;
    for (int row0 = gw * 4; row0 < T; row0 += NGW * 4) {
        v2u a[4][3], b[4][3];
#pragma unroll
        for (int r = 0; r < 4; ++r)
#pragma unroll
            for (int jj = 0; jj < 3; ++jj) { a[r][jj] = ((const GAS v2u*)(O0 + (size_t)(row0 + r) * DAW))[lane + 64 * jj]; b[r][jj] = ((const GAS v2u*)(O1 + (size_t)(row0 + r) * DAW))[lane + 64 * jj]; }
#pragma unroll
        for (int r = 0; r < 4; ++r)
#pragma unroll
            for (int jj = 0; jj < 3; ++jj) {
                f32x4 v; v.x = bf_lo(a[r][jj].x) - lam * bf_lo(b[r][jj].x); v.y = bf_hi(a[r][jj].x) - lam * bf_hi(b[r][jj].x); v.z = bf_lo(a[r][jj].y) - lam * bf_lo(b[r][jj].y); v.w = bf_hi(a[r][jj].y) - lam * bf_hi(b[r][jj].y);
                float ss = (v.x * v.x + v.y * v.y) + (v.z * v.z + v.w * v.w);
                ss = half_sum(ss, lane);
                const float rs = (1.f / sqrtf(ss * (1.f / 128.f) + EPS)) * (1.f - lam_init);
                ((GAS unsigned long long*)(OC + (size_t)(row0 + r) * D))[lane + 64 * jj] = (unsigned long long)pk2(v.x * rs * g.x, v.y * rs * g.y) | ((unsigned long long)pk2(v.z * rs * g.z, v.w * rs * g.w) << 32);
            }
    }
}
__device__ __forceinline__ void phase_hgrn_naive(Frame& F, int j) {
    const int lane = fresh_lane(), tid = F.wave * 64 + lane; (void)tid;
    const bf16* PB = (const bf16*)(F.ws + WS_BIG); const float* FZ = (const float*)(F.ws + WS_BIG + 208 * MiB); float* HO = (float*)(F.ws + WS_BIG + 304 * MiB);
    if (F.bx * 4 >= NB * 6) return;
    const int grp = tid >> 7, t128 = tid & 127, bh = F.bx * 4 + grp, b = bh / 6, h = bh % 6;
    LAS float* sq = (LAS float*)(F.lds + RING_OFF) + grp * (3 * 16 * 128); LAS float* sf = sq + 16 * 128; LAS float* sk = sf + 16 * 128;
    float lb = 0.f;
    if (j == 1) { const float l0 = F.in[14][h * 128 + t128], l1 = F.in[14][768 + h * 128 + t128]; lb = 1.f / (1.f + __expf(l0 - l1)); }
    float St[128];
#pragma unroll
    for (int k = 0; k < 128; ++k) St[k] = 0.f;
    for (int t0 = 0; t0 < S; t0 += 16) {
        __syncthreads();
        for (int jj = 0; jj < 16; ++jj) { const size_t row = (size_t)(b * S + t0 + jj);
            const float qv = bf_lo((unsigned)PB[row * BIN + h * 128 + t128]), fz = FZ[row * DAW + h * 128 + t128];
            const float f = lb + (1.f - lb) / (1.f + __expf(-fz));
            sq[jj * 128 + t128] = qv; sf[jj * 128 + t128] = f; sk[jj * 128 + t128] = 1.f - f; }
        __syncthreads();
        for (int jj = 0; jj < 16; ++jj) { const size_t row = (size_t)(b * S + t0 + jj);
            const float v = bf_lo((unsigned)PB[row * BIN + 1536 + h * 128 + t128]);
            float o = 0.f;
#pragma unroll
            for (int k = 0; k < 128; k += 4) { const f32x4 f4 = *(const LAS f32x4*)(sf + jj * 128 + k), k4 = *(const LAS f32x4*)(sk + jj * 128 + k), q4 = *(const LAS f32x4*)(sq + jj * 128 + k);
                St[k] = f4.x * St[k] + k4.x * v; o += q4.x * St[k]; St[k + 1] = f4.y * St[k + 1] + k4.y * v; o += q4.y * St[k + 1];
                St[k + 2] = f4.z * St[k + 2] + k4.z * v; o += q4.z * St[k + 2]; St[k + 3] = f4.w * St[k + 3] + k4.w * v; o += q4.w * St[k + 3]; }
            HO[row * DAW + h * 128 + t128] = o; }
    }
    __syncthreads();
}
__device__ __forceinline__ void phase_hgrn_out(Frame& F, int j) {
    const int lane = fresh_lane(), tid = F.wave * 64 + lane; (void)tid;
    const bf16* PB = (const bf16*)(F.ws + WS_BIG); const float* HO = (const float*)(F.ws + WS_BIG + 304 * MiB); bf16* OC = (bf16*)(F.ws + WS_OC);
    const f32x4 g = *(const GAS f32x4*)(F.in[15] + j * 128 + (lane & 31) * 4);
    const int gw = F.bx * NWAVES + F.wave, NGW = F.G * NWAVES;
    for (int row = gw; row < T; row += NGW) {
#pragma unroll
        for (int jj = 0; jj < 3; ++jj) {
            const f32x4 v = ((const GAS f32x4*)(HO + (size_t)row * DAW))[lane + 64 * jj];
            const v2u gt = ((const GAS v2u*)(PB + (size_t)row * BIN + 2304))[lane + 64 * jj];
            float ss = (v.x * v.x + v.y * v.y) + (v.z * v.z + v.w * v.w);
            ss = half_sum(ss, lane);
            const float rs = 1.f / sqrtf(ss * (1.f / 128.f) + EPS);
            ((GAS unsigned long long*)(OC + (size_t)row * D))[lane + 64 * jj] =
                (unsigned long long)pk2(v.x * rs * g.x * pg8::silu_f(bf_lo(gt.x)), v.y * rs * g.y * pg8::silu_f(bf_hi(gt.x))) | ((unsigned long long)pk2(v.z * rs * g.z * pg8::silu_f(bf_lo(gt.y)), v.w * rs * g.w * pg8::silu_f(bf_hi(gt.y))) << 32);
        }
    }
}
constexpr int HG_LD = 136, HG_LS = 72;
constexpr int HL_QB = 0, HL_QT = 17408, HL_K = 34816, HL_VT = 78336, HL_PM = 96768, HL_TOT = 105984, HL_SSQ = 110080;
constexpr size_t WS_DCH = WS_SIN + 96 * MiB;
typedef short hbf16x8 __attribute__((ext_vector_type(8)));
typedef float hf32x2 __attribute__((ext_vector_type(2)));
__device__ __forceinline__ hbf16x8 lds8(const LAS unsigned short* p) { return *(const LAS hbf16x8*)p; }
__device__ __forceinline__ float ex2(float v) { return __builtin_amdgcn_exp2f(v); }
template <int PASS>
__device__ __forceinline__ void hgrn_load(Frame& F, int tid, int unit, unsigned (&lf)[8], unsigned (&qw)[8], v4u& va, v4u& vb) {
    const bf16* PB = (const bf16*)(F.ws + WS_BIG); const unsigned short* LF = (const unsigned short*)(F.ws + WS_BIG + 208 * MiB);
    const int kp = tid & 63, wave = __builtin_amdgcn_readfirstlane(tid >> 6), I = wave & 3, hf = wave >> 2, r0 = 16 * I + 8 * hf;
    const int bh = unit >> 6, c = unit & 63, b = bh / 6, h = bh % 6;
    const size_t tok0 = (size_t)b * S + c * 64;
#pragma unroll
    for (int jj = 0; jj < 8; ++jj) lf[jj] = *(const GAS unsigned*)(LF + (tok0 + r0 + jj) * DAW + h * 128 + 2 * kp);
    if (PASS == 3) {
#pragma unroll
        for (int jj = 0; jj < 8; ++jj) qw[jj] = *(const GAS unsigned*)(PB + (tok0 + r0 + jj) * BIN + h * 128 + 2 * kp); }
    { const int sp = tid >> 4, e8 = (tid & 15) * 8; va = *(const GAS v4u*)(PB + (tok0 + 2 * sp) * BIN + 1536 + h * 128 + e8); vb = *(const GAS v4u*)(PB + (tok0 + 2 * sp + 1) * BIN + 1536 + h * 128 + e8); }
}
template <int PASS>
__device__ __forceinline__ void hgrn_unit(Frame& F, int tid, int unit, int nunit, int j, unsigned (&lfr)[8], unsigned (&qw)[8], v4u& va, v4u& vb) {
    const bf16* PB = (const bf16*)(F.ws + WS_BIG);
    hf32x2 lf[8];
#pragma unroll
    for (int jj = 0; jj < 8; ++jj) { typedef _Float16 h2_ __attribute__((ext_vector_type(2))); const h2_ hv = __builtin_bit_cast(h2_, lfr[jj]); lf[jj] = (hf32x2){(float)hv.x, (float)hv.y}; }
    bf16* SLOC = (bf16*)(F.ws + WS_SLOC); const bf16* SIN = (const bf16*)(F.ws + WS_SIN); float* DCH = (float*)(F.ws + WS_DCH); bf16* OC = (bf16*)(F.ws + WS_OC);
    LAS unsigned short* QB = (LAS unsigned short*)(F.lds + HL_QB); LAS unsigned short* QT = (LAS unsigned short*)(F.lds + HL_QT); LAS unsigned short* KK = (LAS unsigned short*)(F.lds + HL_K);
    LAS unsigned short* VT = (LAS unsigned short*)(F.lds + HL_VT); LAS unsigned short* PM = (LAS unsigned short*)(F.lds + HL_PM); LAS float* TOT = (LAS float*)(F.lds + HL_TOT); LAS float* SSQ = (LAS float*)(F.lds + HL_SSQ);
    const int kp = tid & 63, lane = kp, wave = __builtin_amdgcn_readfirstlane(tid >> 6), I = wave & 3, hf = wave >> 2, sub = 2 * I + hf, r0 = 16 * I + 8 * hf, fr = lane & 15, fg = lane >> 4;
    const int bh = unit >> 6, c = unit & 63, b = bh / 6, h = bh % 6;
    const size_t tok0 = (size_t)b * S + c * 64;
    const int tt = wave & 3, eh = wave >> 2; const size_t tok = tok0 + 16 * tt + fr;
    hbf16x8 sfr[4][4]; v2u gtv[4]; f32x4 gnv[4];
    if (PASS == 3) {
#pragma unroll
        for (int et = 0; et < 4; ++et) { const int e0 = 64 * eh + 16 * et; const GAS hbf16x8* sp = (const GAS hbf16x8*)(SIN + ((size_t)unit * 128 + e0 + fr) * 128 + 8 * fg);
#pragma unroll
            for (int ks = 0; ks < 4; ++ks) sfr[et][ks] = sp[4 * ks];
            gtv[et] = *(const GAS v2u*)(PB + tok * BIN + 2304 + h * 128 + e0 + 4 * fg); }
#pragma unroll
        for (int et = 0; et < 4; ++et) gnv[et] = *(const GAS f32x4*)(F.in[15] + j * 128 + 64 * eh + 16 * et + 4 * fg); }
    { const int sp = tid >> 4, e8 = (tid & 15) * 8; const v4u a = va, b2 = vb;
        const unsigned wa[4] = {a.x, a.y, a.z, a.w}, wb[4] = {b2.x, b2.y, b2.z, b2.w};
#pragma unroll
        for (int i = 0; i < 4; ++i) { *(LAS unsigned*)(VT + (e8 + 2 * i) * HG_LS + 2 * sp) = (wa[i] & 0xffffu) | (wb[i] << 16); *(LAS unsigned*)(VT + (e8 + 2 * i + 1) * HG_LS + 2 * sp) = (wa[i] >> 16) | (wb[i] & 0xffff0000u); } }
    hf32x2 cs[8]; { hf32x2 run = {0.f, 0.f};
#pragma unroll
        for (int jj = 0; jj < 8; ++jj) { run += lf[jj]; cs[jj] = run; } }
    *(LAS hf32x2*)(TOT + sub * 128 + 2 * kp) = cs[7];
    __syncthreads();
    hf32x2 rho = {0.f, 0.f}, presub = {0.f, 0.f}, blast = {0.f, 0.f};
#pragma unroll
    for (int s2 = 0; s2 < 8; ++s2) { const hf32x2 t = *(const LAS hf32x2*)(TOT + s2 * 128 + 2 * kp); if (s2 < 2 * I) rho += t; if (s2 < sub) presub += t; blast += t; }
    const hf32x2 off = presub - rho;
    if (PASS == 1) {
        unsigned w0[4], w1[4];
#pragma unroll
        for (int i = 0; i < 4; ++i) { const hf32x2 ba = rho + off + cs[2 * i], bb = rho + off + cs[2 * i + 1];
            w0[i] = pg8::cvt_pk_bf16((1.f - ex2(lf[2 * i].x)) * ex2(blast.x - ba.x), (1.f - ex2(lf[2 * i + 1].x)) * ex2(blast.x - bb.x));
            w1[i] = pg8::cvt_pk_bf16((1.f - ex2(lf[2 * i].y)) * ex2(blast.y - ba.y), (1.f - ex2(lf[2 * i + 1].y)) * ex2(blast.y - bb.y)); }
        *(LAS v4u*)(KK + (2 * kp) * HG_LS + r0) = (v4u){w0[0], w0[1], w0[2], w0[3]}; *(LAS v4u*)(KK + (2 * kp + 1) * HG_LS + r0) = (v4u){w1[0], w1[1], w1[2], w1[3]};
        if (sub == 0) *(GAS hf32x2*)(DCH + (size_t)unit * 128 + 2 * kp) = (hf32x2){ex2(blast.x), ex2(blast.y)};
        __syncthreads();
        if (nunit >= 0) hgrn_load<PASS>(F, tid, nunit, lfr, qw, va, vb);
        const hbf16x8 a0 = lds8(KK + (16 * wave + fr) * HG_LS + 8 * fg), a1 = lds8(KK + (16 * wave + fr) * HG_LS + 32 + 8 * fg);
#pragma unroll
        for (int et = 0; et < 8; ++et) { const hbf16x8 b0 = lds8(VT + (16 * et + fr) * HG_LS + 8 * fg), b1 = lds8(VT + (16 * et + fr) * HG_LS + 32 + 8 * fg);
            f32x4 d = {0.f, 0.f, 0.f, 0.f}; d = __builtin_amdgcn_mfma_f32_16x16x32_bf16(a0, b0, d, 0, 0, 0); d = __builtin_amdgcn_mfma_f32_16x16x32_bf16(a1, b1, d, 0, 0, 0);
            v2u w2; w2.x = pk2(d[0], d[1]); w2.y = pk2(d[2], d[3]);
            *(GAS v2u*)(SLOC + ((size_t)unit * 128 + 16 * et + fr) * 128 + 16 * wave + 4 * fg) = w2; }
        __syncthreads();
    } else {
        const hf32x2 er = {ex2(rho.x), ex2(rho.y)};
        hf32x2 base[8];
#pragma unroll
        for (int jj = 0; jj < 8; ++jj) { const hf32x2 bl = off + cs[jj]; const hf32x2 e = {ex2(bl.x), ex2(bl.y)}; const hf32x2 q = {bf_lo(qw[jj]), bf_hi(qw[jj])}; const hf32x2 qt = q * e, qb = qt * er;
            *(LAS unsigned*)(QT + (r0 + jj) * HG_LD + 2 * kp) = pg8::cvt_pk_bf16(qt.x, qt.y); *(LAS unsigned*)(QB + (r0 + jj) * HG_LD + 2 * kp) = pg8::cvt_pk_bf16(qb.x, qb.y);
            base[jj] = (hf32x2){(1.f - ex2(lf[jj].x)) * ex2(-bl.x), (1.f - ex2(lf[jj].y)) * ex2(-bl.y)}; }
        hf32x2 rr = {0.f, 0.f};
        for (int Ip = I; Ip < 4; ++Ip) { LAS unsigned short* Kp = KK + (8 * Ip * (Ip + 1)) * HG_LD;
            const hf32x2 sc = {ex2(rr.x), ex2(rr.y)};
#pragma unroll
            for (int jj = 0; jj < 8; ++jj) { const hf32x2 kv = base[jj] * sc; *(LAS unsigned*)(Kp + (r0 + jj) * HG_LD + 2 * kp) = pg8::cvt_pk_bf16(kv.x, kv.y); }
            rr += *(const LAS hf32x2*)(TOT + (2 * Ip) * 128 + 2 * kp) + *(const LAS hf32x2*)(TOT + (2 * Ip + 1) * 128 + 2 * kp); }
        __syncthreads();
        if (nunit >= 0) hgrn_load<PASS>(F, tid, nunit, lfr, qw, va, vb);
        { const int It = wave >> 1; const LAS unsigned short* Kp = KK + (8 * It * (It + 1)) * HG_LD;
#pragma unroll
            for (int jt = 0; jt < 2; ++jt) { const int J = 2 * (wave & 1) + jt; f32x4 d = {0.f, 0.f, 0.f, 0.f};
                if (J <= It) {
#pragma unroll
                    for (int ks = 0; ks < 4; ++ks) d = __builtin_amdgcn_mfma_f32_16x16x32_bf16(lds8(QT + (16 * It + fr) * HG_LD + 32 * ks + 8 * fg), lds8(Kp + (16 * J + fr) * HG_LD + 32 * ks + 8 * fg), d, 0, 0, 0);
                    if (J == It) {
#pragma unroll
                        for (int i = 0; i < 4; ++i) if (fr > 4 * fg + i) d[i] = 0.f; }
                }
#pragma unroll
                for (int i = 0; i < 4; ++i) PM[(16 * It + 4 * fg + i) * HG_LS + 16 * J + fr] = (unsigned short)f2bf(d[i]); } }
        __syncthreads();
        f32x4 o[4];
        const hbf16x8 p0 = lds8(PM + (16 * tt + fr) * HG_LS + 8 * fg), p1 = lds8(PM + (16 * tt + fr) * HG_LS + 32 + 8 * fg);
        hbf16x8 qb[4];
#pragma unroll
        for (int ks = 0; ks < 4; ++ks) qb[ks] = lds8(QB + (16 * tt + fr) * HG_LD + 32 * ks + 8 * fg);
        float ss = 0.f;
#pragma unroll
        for (int et = 0; et < 4; ++et) { const int e0 = 64 * eh + 16 * et; f32x4 d = {0.f, 0.f, 0.f, 0.f};
            d = __builtin_amdgcn_mfma_f32_16x16x32_bf16(lds8(VT + (e0 + fr) * HG_LS + 8 * fg), p0, d, 0, 0, 0);
            d = __builtin_amdgcn_mfma_f32_16x16x32_bf16(lds8(VT + (e0 + fr) * HG_LS + 32 + 8 * fg), p1, d, 0, 0, 0);
#pragma unroll
            for (int ks = 0; ks < 4; ++ks) d = __builtin_amdgcn_mfma_f32_16x16x32_bf16(sfr[et][ks], qb[ks], d, 0, 0, 0);
            o[et] = d; ss += (d[0] * d[0] + d[1] * d[1]) + (d[2] * d[2] + d[3] * d[3]); }
        ss += xor_get(ss, lane, 16); ss += xor_get(ss, lane, 32);
        if (fg == 0) SSQ[(tt * 2 + eh) * 16 + fr] = ss;
        __syncthreads();
        const float rs = 1.f / sqrtf((SSQ[(tt * 2) * 16 + fr] + SSQ[(tt * 2 + 1) * 16 + fr]) * (1.f / 128.f) + EPS);
#pragma unroll
        for (int et = 0; et < 4; ++et) { const int e = 64 * eh + 16 * et + 4 * fg;
            const f32x4 gn = gnv[et]; const v2u gt = gtv[et];
            v2u w; w.x = pg8::cvt_pk_bf16(o[et][0] * rs * gn.x * pg8::silu_f(bf_lo(gt.x)), o[et][1] * rs * gn.y * pg8::silu_f(bf_hi(gt.x))); w.y = pg8::cvt_pk_bf16(o[et][2] * rs * gn.z * pg8::silu_f(bf_lo(gt.y)), o[et][3] * rs * gn.w * pg8::silu_f(bf_hi(gt.y)));
            *(GAS v2u*)(OC + tok * D + h * 128 + e) = w; }
        __syncthreads();
    }
}
template <int PASS> __device__ __forceinline__ void phase_hgrn(Frame& F, int j) {
    const int tid = F.wave * 64 + fresh_lane();
    unsigned lf[8]; unsigned qw[8]; v4u va, vb;
#pragma unroll
    for (int i = 0; i < 8; ++i) qw[i] = 0u;
    if (F.bx < NB * 6 * 64) hgrn_load<PASS>(F, tid, F.bx, lf, qw, va, vb);
    for (int u = F.bx; u < NB * 6 * 64; u += F.G) hgrn_unit<PASS>(F, tid, u, (u + F.G < NB * 6 * 64) ? u + F.G : -1, j, lf, qw, va, vb);
}
__device__ __forceinline__ void phase_hgrn_scan(Frame& F) {
    const bf16* SLOC = (const bf16*)(F.ws + WS_SLOC); bf16* SIN = (bf16*)(F.ws + WS_SIN); const float* DCH = (const float*)(F.ws + WS_DCH);
    const int tid = F.wave * 64 + fresh_lane();
    for (int id = F.bx * (NWAVES * 64) + tid; id < NB * 6 * 128 * 16; id += F.G * NWAVES * 64) {
        const int k8 = id & 15, e = (id >> 4) & 127, bh = id >> 11;
        const GAS v4u* sl = (const GAS v4u*)(SLOC + ((size_t)bh * 64 * 128 + e) * 128) + k8; const GAS f32x4* dc = (const GAS f32x4*)(DCH + (size_t)bh * 64 * 128) + 2 * k8;
        GAS v4u* so = (GAS v4u*)(SIN + ((size_t)bh * 64 * 128 + e) * 128) + k8;
        float st[8];
#pragma unroll
        for (int i = 0; i < 8; ++i) st[i] = 0.f;
#pragma unroll 8
        for (int c = 0; c < 64; ++c) { const v4u aw = sl[(size_t)c * 128 * 16]; const f32x4 d0 = dc[(size_t)c * 32], d1 = dc[(size_t)c * 32 + 1];
            v4u w; w.x = pg8::cvt_pk_bf16(st[0], st[1]); w.y = pg8::cvt_pk_bf16(st[2], st[3]); w.z = pg8::cvt_pk_bf16(st[4], st[5]); w.w = pg8::cvt_pk_bf16(st[6], st[7]); so[(size_t)c * 128 * 16] = w;
            st[0] = d0.x * st[0] + bf_lo(aw.x); st[1] = d0.y * st[1] + bf_hi(aw.x); st[2] = d0.z * st[2] + bf_lo(aw.y); st[3] = d0.w * st[3] + bf_hi(aw.y);
            st[4] = d1.x * st[4] + bf_lo(aw.z); st[5] = d1.y * st[5] + bf_hi(aw.z); st[6] = d1.z * st[6] + bf_lo(aw.w); st[7] = d1.w * st[7] + bf_hi(aw.w); }
    }
}
struct Args { const float* in[27]; float* out; unsigned char* ws; };
__global__ void __launch_bounds__(NWAVES * 64, 2) mk_fwd(Args) {
    extern __shared__ __attribute__((aligned(16))) unsigned char lds[];
    Frame F;
    F.lds = (LAS unsigned char*)lds;
    F.MISC = (volatile LAS unsigned*)(F.lds + MISC_OFF);
    F.wave = __builtin_amdgcn_readfirstlane((int)(threadIdx.x >> 6));
    F.G = gridDim.x; F.bx = blockIdx.x; { const int bx = blockIdx.x; F.vcu = (F.G % 8 == 0) ? (bx % 8) * (F.G / 8) + bx / 8 : bx; }
    for (int u = threadIdx.x; u < (LDS_BYTES - LDSCTL_OFF) / 4; u += NWAVES * 64) ((LAS unsigned*)(F.lds + LDSCTL_OFF))[u] = 0u;
    __syncthreads();
    {
        LAS unsigned long long* tab = (LAS unsigned long long*)(F.lds + LDSCTL_OFF);
        if (threadIdx.x < 29) tab[threadIdx.x] = ((const unsigned long long*)__builtin_amdgcn_kernarg_segment_ptr())[threadIdx.x];
        __syncthreads();
        F.in.t = tab; F.out = (GAS float*)(unsigned long long)F.in[27]; F.ws = (GAS unsigned char*)(unsigned long long)F.in[28]; }
    F.ctl = (gu32*)(F.ws + WS_CTL);
    XcdBarrier bar = xcd_barrier_post((unsigned*)(F.ctl + CW_BAR), F.MISC + 8);
#define XBAR_() do { XcdBarrier b_ = bar; { unsigned long long p_ = (unsigned long long)b_.bar; asm volatile("" : "+s"(p_), "+s"(b_.x)); b_.bar = (unsigned*)(GAS unsigned*)p_; } xcd_barrier(b_); if (MK_DUP & 0x8000) xcd_barrier(b_); } while (0)
#define GRID_BAR() XBAR_()
#define REP(cat) for (int rep_ = 0; rep_ < (((MK_DUP >> (cat)) & 1) ? 2 : 1); ++rep_)
#if MK_TS
    unsigned long long ts_last = rt(); unsigned ts_cat[15], ts_wb[14];
#pragma unroll
    for (int i = 0; i < 15; ++i) ts_cat[i] = 0u;
#pragma unroll
    for (int i = 0; i < 14; ++i) ts_wb[i] = 0u;
#define GRID_BAR_T(c) do { const unsigned long long arr_ = rt(); XBAR_(); const unsigned long long now_ = rt(); const unsigned dt_ = (unsigned)(arr_ - ts_last), db_ = (unsigned)(now_ - arr_); ts_last = now_; const int cc_ = (c); \
    _Pragma("unroll") for (int i_ = 0; i_ < 14; ++i_) { ts_cat[i_] += (cc_ == i_) ? dt_ : 0u; ts_wb[i_] += (cc_ == i_) ? db_ : 0u; } ts_cat[14] += db_; } while (0)
#else
#define GRID_BAR_T(c) XBAR_()
#endif

    REP(0) phase_prologue(F);
    GRID_BAR_T(0);
    {
        struct MkvOrder { int G, c; __device__ bool next(int i, pg8::Unit& u) const { const int L = i * G + c; if (L >= 64) return false; u.pm = L >> 1; u.pn = L & 1; u.pb = (u.pm >> 3) * 2 + u.pn; return true; }
            __device__ __forceinline__ void a_ready(const pg8::Unit&) const {} __device__ __forceinline__ void done(const pg8::Unit&) const {} } So{F.G, F.bx};
        pg8::Gemm g{(const pg8::bf16_t*)(F.ws + WS_MEMN), (const pg8::bf16_t*)(F.ws + WS_WMKV), 4 * NB * MEML, 512, D};
        pg8::EpiProj E{(pg8::bf16_t*)(F.ws + WS_MKV), 512, 0u, 1.f, 0, 0, nullptr, 0, nullptr, nullptr, nullptr};
        pg8::gemm_phase<pg8::EpiProj, MkvOrder, true, true>(F.lds + RING_OFF, g, So, E, F.wave);
    }
    for (int l = 0; l < 4; ++l) {
        const int j = l >> 1; const bool isA = (l & 1) == 0;
        {
            unsigned long long w_ = (unsigned long long)F.ws, o_ = (unsigned long long)F.out, c_ = (unsigned long long)F.ctl, b_ = (unsigned long long)bar.bar;
            asm volatile("" : "+s"(w_), "+s"(o_), "+s"(c_), "+s"(b_)); F.ws = (GAS unsigned char*)w_; F.out = (GAS float*)o_; F.ctl = (gu32*)c_; bar.bar = (unsigned*)b_;
            asm volatile("" : "+s"(F.vcu), "+s"(F.G), "+s"(F.bx), "+s"(F.wave)); }
        bf16* const XN = (bf16*)(F.ws + WS_XN); bf16* const OC = (bf16*)(F.ws + WS_OC);
        if (isA) {
            pg8::Gemm g{XN, (const pg8::bf16_t*)(F.ws + WS_WINA) + (size_t)j * AIN * D, T, AIN, D}; pg8::StaticOrder So; So.init(T, AIN, F.G, F.bx);
            pg8::EpiProj E{(pg8::bf16_t*)(F.ws + WS_BIG), AIN, 0x207u, C2, 0, 0, nullptr, 0, nullptr, (const float*)(F.ws + WS_SSQP) + (size_t)(4 + j) * T * 16, (unsigned*)(F.ctl + CW_N2) + j * (NB * 24 * 64 * 2)};
            REP(1) pg8::gemm_phase<pg8::EpiProj, pg8::StaticOrder, true, true>(F.lds + RING_OFF, g, So, E, F.wave);
        } else {
            pg8::Gemm g{XN, (const pg8::bf16_t*)(F.ws + WS_WINB) + (size_t)j * BIN * D, T, BIN, D}; pg8::StaticOrder So; So.init(T, BIN, F.G, F.bx);
            pg8::EpiProj E{(pg8::bf16_t*)(F.ws + WS_BIG), BIN, 0x1000u, C2, 3, 6, (float*)(F.ws + WS_BIG + 208 * MiB), DAW, (const float*)(F.ws + WS_ROUTE + 1024 * 1024) + j * DAW, (const float*)(F.ws + WS_SSQP) + (size_t)(2 * j + 1) * T * 16, nullptr};
            REP(1) pg8::gemm_phase<pg8::EpiProj, pg8::StaticOrder, true, true>(F.lds + RING_OFF, g, So, E, F.wave);
        }
        GRID_BAR_T(1);
        const int ldp = isA ? AIN : BIN, qmoff = isA ? 2304 : 3072;
        if (isA) {
            const attn_body::bf16* P = (const attn_body::bf16*)(F.ws + WS_BIG); attn_body::bf16* O01 = (attn_body::bf16*)(F.ws + WS_BIG + 160 * MiB);
            const GAS float* N2 = (const GAS float*)(F.ctl + CW_N2) + j * (NB * 24 * 64 * 2); const int lane_n = fresh_lane();
            const bool tabdeal = (F.G == 256);
            static_assert(attn_body::LDS2_BYTES <= RING_BYTES, "attention LDS");
            REP(2) for (int u_ = F.vcu; u_ < NB * 2 * 96; u_ += F.G) {
                int b, m, h, qb; if (tabdeal) { const int e = ATT_DEAL[u_ & 15][u_ >> 8]; b = (u_ >> 5) & 7; m = (u_ >> 4) & 1; h = e >> 4; qb = e & 15; } else { b = u_ / 192; m = (u_ / 96) & 1; h = (u_ % 96) >> 4; qb = u_ & 15; }
                const float nsl2 = -1.4426950408889634f * exp2f(-8.f * (float)(h + 1) / 6.f);
                const attn_body::bf16* Kh = P + (size_t)b * S * AIN + 768 + h * 128 + m * 64; const attn_body::bf16* Vh = P + (size_t)b * S * AIN + 1536 + h * 128;
                { const int NT = 4 * qb + 4;
                    typedef float f32x2n __attribute__((ext_vector_type(2)));
                    const f32x2n qn2 = *(const GAS f32x2n*)(N2 + ((b * 24 + h * 2 + m) * 64 + lane_n) * 2), kn2 = *(const GAS f32x2n*)(N2 + ((b * 24 + 12 + h * 2 + m) * 64 + lane_n) * 2);
                    const bool qin = (lane_n >= 4 * qb && lane_n < 4 * qb + 4), kin = (lane_n < NT);
                    float qa = qin ? qn2.x : 0.f, qb2 = qin ? qn2.y : 0.f, ka = kin ? kn2.x : 0.f, kb = kin ? kn2.y : 0.f;
#pragma unroll
                    for (int o = 1; o < 64; o <<= 1) { qa = fmaxf(qa, xor_get(qa, lane_n, o)); qb2 = fmaxf(qb2, xor_get(qb2, lane_n, o)); ka = fmaxf(ka, xor_get(ka, lane_n, o)); kb = fmaxf(kb, xor_get(kb, lane_n, o)); }
                    const float dreq = (160.f + 2.f * (sqrtf(qa * ka) + sqrtf(qb2 * kb)) * 1.02f) / (-nsl2);
                    int tskip = (int)floorf(((float)(qb * 256 - 63) - dreq) * (1.f / 64.f)); tskip = tskip < 0 ? 0 : tskip; tskip &= ~1; tskip = tskip > NT - 4 ? NT - 4 : tskip;
                    tskip = __builtin_amdgcn_readfirstlane(tskip);
                    attn_body::attn_unit2<8>(P + (size_t)(b * S + qb * 256) * AIN + h * 128 + m * 64, AIN, Kh + (size_t)tskip * 64 * AIN, AIN, Vh + (size_t)tskip * 64 * AIN, AIN,
                                             O01 + (size_t)m * T * DAW + (size_t)(b * S + qb * 256) * DAW + h * 128, DAW, NT - tskip, qb * 256 - 64 * tskip, nsl2, (char*)lds + RING_OFF, F.wave); }
            }
        } else {
            REP(3) phase_hgrn<1>(F, j);
        }
        {
            const attn_body::bf16* P = (const attn_body::bf16*)(F.ws + WS_BIG); const attn_body::bf16* KV = (const attn_body::bf16*)(F.ws + WS_MKV) + (size_t)l * NB * MEML * 512;
#ifndef NO_ATTN1
            REP(13) for (int u = F.vcu; u < NB * 4 * 16; u += F.G) { const int qb = u & 15, hm = (u >> 4) & 3, b = u >> 6;
                attn_body::attn_unit<1, 8>(P + (size_t)(b * S + qb * 256) * ldp + qmoff + hm * 64, ldp, KV + (size_t)b * MEML * 512 + hm * 64, 512, KV + (size_t)b * MEML * 512 + 256 + hm * 64, 512,
                                           (attn_body::bf16*)OC + (size_t)(b * S + qb * 256) * D + DAW + hm * 64, D, 4, 0, 0.f, (char*)lds + RING_OFF, F.wave); }
#endif
        }
        GRID_BAR_T(isA ? 2 : 3);
        if (isA) { REP(5) phase_diff_combine(F, j, l == 0 ? 0.2f : (float)(0.8 - 0.6 * 0.5488116360940264)); }
        else { REP(14) phase_hgrn_scan(F); GRID_BAR_T(4); REP(4) phase_hgrn<3>(F, j); }
        GRID_BAR_T(isA ? 5 : 4);
#if MK_DBG
        {
            const int lane = fresh_lane(); const int gw = F.bx * NWAVES + F.wave, NGW = F.G * NWAVES;
            for (int r = gw; r < 1024; r += NGW) { f32x4 v[4];
#pragma unroll
                for (int jj = 0; jj < 4; ++jj) { const v2u a = ((const GAS v2u*)(OC + (size_t)(r * 32) * D))[lane + 64 * jj]; v[jj].x = bf_lo(a.x); v[jj].y = bf_hi(a.x); v[jj].z = bf_lo(a.y); v[jj].w = bf_hi(a.y); }
                dbg_sample_f32(F, lane, 8 + l, r * 32, v); }
        }
#endif
        {
            pg8::Gemm g{OC, (const pg8::bf16_t*)(F.ws + WS_WOUT) + (size_t)l * D * D, T, D, D}; pg8::StaticOrder So; So.init(T, D, F.G, F.bx);
            pg8::EpiResid E{XN, D, isA ? (float*)(F.ws + WS_SSQP) + (size_t)(2 * j) * T * 16 : nullptr, 1.f};
            pg8::gemm_phase<pg8::EpiResid, pg8::StaticOrder, true, true>(F.lds + RING_OFF, g, So, E, F.wave);
        }
        GRID_BAR_T(6);
        if (isA) {
            {
                pg8::Gemm g{XN, (const pg8::bf16_t*)(F.ws + WS_WGUD) + (size_t)j * 2 * FFD * D, T, 2 * FFD, D}; pg8::StaticOrder So; So.init(T, 2 * FFD, F.G, F.bx);
                pg8::EpiSwiglu<false> E{(pg8::bf16_t*)(F.ws + WS_BIG), FFD, 1.f, 1.f, (const float*)(F.ws + WS_SSQP) + (size_t)(2 * j) * T * 16};
                REP(7) pg8::gemm_phase<pg8::EpiSwiglu<false>, pg8::StaticOrder, true, true>(F.lds + RING_OFF, g, So, E, F.wave);
            }
            GRID_BAR_T(7);
            {
                pg8::Gemm g{(const pg8::bf16_t*)(F.ws + WS_BIG), (const pg8::bf16_t*)(F.ws + WS_WDND) + (size_t)j * D * FFD, T, D, FFD}; pg8::StaticOrder So; So.init(T, D, F.G, F.bx);
                pg8::EpiResid E{XN, D, (float*)(F.ws + WS_SSQP) + (size_t)(2 * j + 1) * T * 16, 1.f};
                pg8::gemm_phase<pg8::EpiResid, pg8::StaticOrder, true, true>(F.lds + RING_OFF, g, So, E, F.wave);
            }
            GRID_BAR_T(8);

        } else {
            gu32* gcnt = F.ctl + CW_GCNT + 64 * j;
#ifndef NO_NORM
            phase_router(F, F.in[22] + j * D, F.in[23] + (size_t)j * D * 8, gcnt);
#endif
            GRID_BAR_T(9);
            phase_gather(F, gcnt, F.in[22] + j * D);
            GRID_BAR_T(10);
            {
                int cnt[8];
#pragma unroll
                for (int e = 0; e < 8; ++e) cnt[e] = __builtin_amdgcn_readfirstlane((int)__hip_atomic_load(gcnt + e, RLX_AGENT));
                pg8::Gemm g{(const pg8::bf16_t*)(F.ws + WS_XG), (const pg8::bf16_t*)(F.ws + WS_WGUM + (size_t)j * NE * 2 * FFE * D), MAXROWS, 2 * FFE, D / 2}; pg8::MoeOrder So; So.init(cnt, 2 * FFE / 256, F.G, F.bx);
                pg8::EpiSwiglu<true> E{(pg8::bf16_t*)(F.ws + WS_BIG), FFE, 1.f / (SC_X * SC_WGU), SC_H, nullptr};
                REP(11) pg8::gemm_phase<pg8::EpiSwiglu<true>, pg8::MoeOrder, true, true, true>(F.lds + RING_OFF, g, So, E, F.wave);
            }
            GRID_BAR_T(11);
            {
                int cnt[8];
#pragma unroll
                for (int e = 0; e < 8; ++e) cnt[e] = __builtin_amdgcn_readfirstlane((int)__hip_atomic_load(gcnt + e, RLX_AGENT));
                pg8::Gemm g{(const pg8::bf16_t*)(F.ws + WS_BIG), (const pg8::bf16_t*)(F.ws + WS_WDNM + (size_t)j * NE * D * FFE), MAXROWS, D, FFE / 2}; pg8::MoeOrder So; So.init(cnt, D / 256, F.G, F.bx);
                pg8::EpiProj E{(pg8::bf16_t*)(F.ws + WS_Y), D, 0xffffffffu, 1.f / (SC_H * SC_WDN), 0, 0, nullptr, 0, nullptr, nullptr, nullptr};
                REP(12) pg8::gemm_phase<pg8::EpiProj, pg8::MoeOrder, true, true, true>(F.lds + RING_OFF, g, So, E, F.wave);
            }
            GRID_BAR_T(12);
            if (l == 1) { phase_combine<false>(F, nullptr, nullptr, (float*)(F.ws + WS_SSQP) + (size_t)5 * T * 16); GRID_BAR_T(9); }
            else {
                phase_combine<true>(F, (float*)F.out, F.in[26], nullptr);
#if MK_TS
                if (F.bx == 0 && F.wave == 0) { unsigned ta = 0u;
#pragma unroll
                    for (int i = 0; i < 15; ++i) if ((MK_TS_A >> i) & 1) ta += ts_cat[i];
#pragma unroll
                    for (int i = 0; i < 14; ++i) if ((MK_TS_B >> i) & 1) ta += ts_wb[i];
                    const unsigned long long t0_ = rt(); while ((unsigned)(rt() - t0_) < ta) __builtin_amdgcn_s_sleep(8); }
#endif
            }
        }
    }
#undef GRID_BAR
}

static int mk_launch(void* const* d_in, void* d_out, void* d_ws, size_t ws_size, hipStream_t stream) {
    static int grid = 0;
    if (grid == 0) {
        if (ws_size < WS_END) { fprintf(stderr, "kernel_launch: workspace too small (%zu < %zu)\n", ws_size, (size_t)WS_END); grid = -1; return -1; }
        int dev = 0, cus = 0, per_cu = 0;
        if (hipGetDevice(&dev) != hipSuccess || hipDeviceGetAttribute(&cus, hipDeviceAttributeMultiprocessorCount, dev) != hipSuccess) { grid = -1; return -1; }
        if (hipFuncSetAttribute((const void*)mk_fwd, hipFuncAttributeMaxDynamicSharedMemorySize, LDS_BYTES) != hipSuccess) { fprintf(stderr, "kernel_launch: hipFuncSetAttribute failed\n"); grid = -1; return -1; }
        if (hipOccupancyMaxActiveBlocksPerMultiprocessor(&per_cu, (const void*)mk_fwd, NWAVES * 64, LDS_BYTES) != hipSuccess || per_cu < 1) fprintf(stderr, "kernel_launch: note: occupancy query reports %d\n", per_cu);
        (void)hipGetLastError();
        grid = cus;
        if (grid != 256) fprintf(stderr, "kernel_launch: note: %d CUs (tuned for 256)\n", grid);
    }
    if (grid < 0) return -1;
    if (hipMemsetAsync((char*)d_ws + WS_CTL, 0, CTL_ZERO_BYTES, stream) != hipSuccess) return -1;
    Args a{};
    for (int i = 0; i < 27; ++i) a.in[i] = (const float*)d_in[i];
    a.out = (float*)d_out; a.ws = (unsigned char*)d_ws;
    hipLaunchKernelGGL(mk_fwd, dim3(grid), dim3(NWAVES * 64), LDS_BYTES, stream, a);
    return 0;
}
#if MK_DBG
namespace nv {
constexpr int MEMW = 256;

__device__ __forceinline__ float sigmoidf_(float z) { return 1.f / (1.f + __expf(-z)); }
__device__ __forceinline__ float siluf_(float z) { return z / (1.f + __expf(-z)); }

__global__ void __launch_bounds__(256) k_rmsnorm(const float* __restrict__ in, const float* __restrict__ g, float* __restrict__ out, int rows) {
    const int lane = threadIdx.x & 63, w = (blockIdx.x * 256 + threadIdx.x) >> 6, nw = (gridDim.x * 256) >> 6;
    for (int r = w; r < rows; r += nw) {
        const float4* xr = (const float4*)(in + (size_t)r * D) + lane;
        float4 v[4]; float s = 0.f;
#pragma unroll
        for (int j = 0; j < 4; ++j) { v[j] = xr[64 * j]; s += v[j].x * v[j].x + v[j].y * v[j].y + v[j].z * v[j].z + v[j].w * v[j].w; }
        const float rstd = rsqrtf(wave_sum(s) * (1.f / D) + EPS);
        float4* o = (float4*)(out + (size_t)r * D) + lane;
#pragma unroll
        for (int j = 0; j < 4; ++j) { const float4 gg = ((const float4*)g)[lane + 64 * j];
            o[64 * j] = make_float4(v[j].x * rstd * gg.x, v[j].y * rstd * gg.y, v[j].z * rstd * gg.z, v[j].w * rstd * gg.w); }
    }
}

template <int ADD>
__global__ void __launch_bounds__(256) k_gemm(const float* __restrict__ A, int lda, const float* __restrict__ Bm, int ldb, float* C, int ldc, const float* R, int M, int N, int K, const int* dyn, int offA, int offC) {
    __shared__ float As[8][132];
    __shared__ float Bs[8][128];
    int roffA = 0, roffC = 0;
    if (dyn) { roffA = offA ? dyn[0] : 0; roffC = offC ? dyn[0] : 0; M = dyn[1] < 16384 ? dyn[1] : 16384; }
    const int m0 = blockIdx.y * 128, n0 = blockIdx.x * 128;
    if (m0 >= M) return;
    const int tid = threadIdx.x, ty = tid >> 4, tx = tid & 15;
    float acc[8][8];
#pragma unroll
    for (int i = 0; i < 8; ++i)
#pragma unroll
        for (int j = 0; j < 8; ++j) acc[i][j] = 0.f;
    const int ar = tid >> 1, ak = (tid & 1) * 4;
    int arow = m0 + ar; if (arow >= M) arow = M - 1;
    const float* ap = A + (size_t)(roffA + arow) * lda + ak;
    const int bk = tid >> 5, bn = (tid & 31) * 4;
    const float* bp = Bm + (size_t)bk * ldb + n0 + bn;
    for (int k0 = 0; k0 < K; k0 += 8) {
        const float4 av = *(const float4*)(ap + k0);
        const float4 bv = *(const float4*)(bp + (size_t)k0 * ldb);
        __syncthreads();
        As[ak + 0][ar] = av.x; As[ak + 1][ar] = av.y; As[ak + 2][ar] = av.z; As[ak + 3][ar] = av.w;
        *(float4*)&Bs[bk][bn] = bv;
        __syncthreads();
#pragma unroll
        for (int k = 0; k < 8; ++k) {
            float a[8], b[8];
            *(float4*)&a[0] = *(const float4*)&As[k][ty * 4]; *(float4*)&a[4] = *(const float4*)&As[k][64 + ty * 4];
            *(float4*)&b[0] = *(const float4*)&Bs[k][tx * 4]; *(float4*)&b[4] = *(const float4*)&Bs[k][64 + tx * 4];
#pragma unroll
            for (int i = 0; i < 8; ++i)
#pragma unroll
                for (int j = 0; j < 8; ++j) acc[i][j] += a[i] * b[j];
        }
    }
#pragma unroll
    for (int i = 0; i < 8; ++i) {
        const int r = m0 + (i < 4 ? ty * 4 + i : 64 + ty * 4 + (i - 4));
        if (r >= M) continue;
#pragma unroll
        for (int jh = 0; jh < 2; ++jh) {
            const int c = n0 + jh * 64 + tx * 4;
            float4 v = make_float4(acc[i][jh * 4 + 0], acc[i][jh * 4 + 1], acc[i][jh * 4 + 2], acc[i][jh * 4 + 3]);
            if (ADD) { const float4 rr = *(const float4*)(R + (size_t)(roffC + r) * ldc + c); v.x += rr.x; v.y += rr.y; v.z += rr.z; v.w += rr.w; }
            *(float4*)(C + (size_t)(roffC + r) * ldc + c) = v;
        }
    }
}

__global__ void __launch_bounds__(64) k_diff_attn(const float* __restrict__ proj  , float* __restrict__ O  ) {
    const int c = blockIdx.x, bhm = blockIdx.y, m = bhm & 1, h = (bhm >> 1) % 6, b = bhm / 12;
    const int qpos = c * 64 + threadIdx.x;
    const float slope = exp2f(-8.f * (float)(h + 1) / 6.f);
    float q[64];
    const float* qp = proj + (size_t)(b * S + qpos) * AIN + h * 128 + m * 64;
#pragma unroll
    for (int d = 0; d < 64; d += 4) { const float4 v = *(const float4*)(qp + d); q[d] = v.x * 0.125f; q[d + 1] = v.y * 0.125f; q[d + 2] = v.z * 0.125f; q[d + 3] = v.w * 0.125f; }
    const int nk = (c + 1) * 64;
    const float* kbase = proj + (size_t)b * S * AIN + DAW + h * 128 + m * 64;
    const float* vbase = proj + (size_t)b * S * AIN + 2 * DAW + h * 128;
    float mx = -3.0e38f;
    for (int k = 0; k < nk; ++k) {
        const float* kr = kbase + (size_t)k * AIN;
        float s = 0.f;
#pragma unroll
        for (int d = 0; d < 64; ++d) s += q[d] * kr[d];
        s -= slope * fabsf((float)(qpos - k));
        mx = fmaxf(mx, s);
    }
    float o[128];
#pragma unroll
    for (int e = 0; e < 128; ++e) o[e] = 0.f;
    float l = 0.f;
    for (int k = 0; k < nk; ++k) {
        const float* kr = kbase + (size_t)k * AIN;
        float s = 0.f;
#pragma unroll
        for (int d = 0; d < 64; ++d) s += q[d] * kr[d];
        s -= slope * fabsf((float)(qpos - k));
        const float p = __expf(s - mx);
        l += p;
        const float* vr = vbase + (size_t)k * AIN;
#pragma unroll
        for (int e = 0; e < 128; ++e) o[e] += p * vr[e];
    }
    const float il = 1.f / l;
    float* op = O + (size_t)m * T * DAW + (size_t)(b * S + qpos) * DAW + h * 128;
#pragma unroll
    for (int e = 0; e < 128; e += 4) *(float4*)(op + e) = make_float4(o[e] * il, o[e + 1] * il, o[e + 2] * il, o[e + 3] * il);
}
__global__ void __launch_bounds__(256) k_diff_combine(const float* __restrict__ O, const float* __restrict__ lq1, const float* __restrict__ lk1, const float* __restrict__ lq2, const float* __restrict__ lk2,
                                                       const float* __restrict__ subln, float lam_init, float* __restrict__ OC) {
    float s1 = 0.f, s2 = 0.f;
    for (int d = 0; d < 64; ++d) { s1 += lq1[d] * lk1[d]; s2 += lq2[d] * lk2[d]; }
    const float lam = __expf(s1) - __expf(s2) + lam_init;
    const int idx = blockIdx.x * 256 + threadIdx.x;
    if (idx >= T * 6) return;
    const int t = idx / 6, h = idx % 6;
    const float* o0 = O + (size_t)t * DAW + h * 128; const float* o1 = o0 + (size_t)T * DAW;
    float v[128]; float ss = 0.f;
#pragma unroll
    for (int e = 0; e < 128; ++e) { v[e] = o0[e] - lam * o1[e]; ss += v[e] * v[e]; }
    const float rstd = rsqrtf(ss * (1.f / 128.f) + EPS) * (1.f - lam_init);
    float* oc = OC + (size_t)t * D + h * 128;
#pragma unroll
    for (int e = 0; e < 128; ++e) oc[e] = v[e] * rstd * subln[e];
}
__global__ void __launch_bounds__(64) k_mem_attn(const float* __restrict__ proj, int ldp, int qoff, const float* __restrict__ kv  , float* __restrict__ OC) {
    const int h = blockIdx.y, t = blockIdx.x * 64 + threadIdx.x, b = t / S;
    float q[64];
    const float* qp = proj + (size_t)t * ldp + qoff + h * 64;
#pragma unroll
    for (int d = 0; d < 64; ++d) q[d] = qp[d] * 0.125f;
    const float* kb = kv + (size_t)b * MEML * 512 + h * 64;
    float mx = -3.0e38f;
    for (int k = 0; k < MEML; ++k) { const float* kr = kb + (size_t)k * 512; float s = 0.f;
#pragma unroll
        for (int d = 0; d < 64; ++d) s += q[d] * kr[d];
        mx = fmaxf(mx, s); }
    float o[64]; float l = 0.f;
#pragma unroll
    for (int e = 0; e < 64; ++e) o[e] = 0.f;
    for (int k = 0; k < MEML; ++k) { const float* kr = kb + (size_t)k * 512; float s = 0.f;
#pragma unroll
        for (int d = 0; d < 64; ++d) s += q[d] * kr[d];
        const float p = __expf(s - mx); l += p; const float* vr = kr + 256;
#pragma unroll
        for (int e = 0; e < 64; ++e) o[e] += p * vr[e]; }
    const float il = 1.f / l;
    float* oc = OC + (size_t)t * D + DAW + h * 64;
#pragma unroll
    for (int e = 0; e < 64; ++e) oc[e] = o[e] * il;
}
__global__ void __launch_bounds__(128) k_hgrn(const float* __restrict__ proj  , const float* __restrict__ lbl  , int j, float* __restrict__ Ob  ) {
    __shared__ float sq[16][128], sf[16][128], sk[16][128];
    const int bh = blockIdx.x, b = bh / 6, h = bh % 6, tid = threadIdx.x;
    float lb = 0.f;
    if (j == 1) { const float l0 = lbl[h * 128 + tid], l1 = lbl[768 + h * 128 + tid]; lb = 1.f / (1.f + __expf(l0 - l1)); }
    float St[128];
#pragma unroll
    for (int k = 0; k < 128; ++k) St[k] = 0.f;
    for (int t0 = 0; t0 < S; t0 += 16) {
        __syncthreads();
        for (int jj = 0; jj < 16; ++jj) { const float* pr = proj + (size_t)(b * S + t0 + jj) * BIN + h * 128 + tid;
            const float qv = pr[0], fz = pr[768]; const float sg = sigmoidf_(fz); const float f = lb + (1.f - lb) * sg;
            sq[jj][tid] = qv; sf[jj][tid] = f; sk[jj][tid] = 1.f - f; }
        __syncthreads();
        for (int jj = 0; jj < 16; ++jj) {
            const float v = proj[(size_t)(b * S + t0 + jj) * BIN + 1536 + h * 128 + tid];
            float o = 0.f;
#pragma unroll
            for (int k = 0; k < 128; k += 4) { const float4 f4 = *(const float4*)&sf[jj][k], k4 = *(const float4*)&sk[jj][k], q4 = *(const float4*)&sq[jj][k];
                St[k] = f4.x * St[k] + k4.x * v; o += q4.x * St[k];
                St[k + 1] = f4.y * St[k + 1] + k4.y * v; o += q4.y * St[k + 1];
                St[k + 2] = f4.z * St[k + 2] + k4.z * v; o += q4.z * St[k + 2];
                St[k + 3] = f4.w * St[k + 3] + k4.w * v; o += q4.w * St[k + 3]; }
            Ob[(size_t)(b * S + t0 + jj) * DAW + h * 128 + tid] = o;
        }
    }
}
__global__ void __launch_bounds__(256) k_hgrn_out(const float* __restrict__ Ob, const float* __restrict__ proj, const float* __restrict__ gn, float* __restrict__ OC) {
    const int idx = blockIdx.x * 256 + threadIdx.x; if (idx >= T * 6) return;
    const int t = idx / 6, h = idx % 6;
    const float* o = Ob + (size_t)t * DAW + h * 128; const float* g = proj + (size_t)t * BIN + 2304 + h * 128;
    float ss = 0.f;
#pragma unroll 8
    for (int e = 0; e < 128; ++e) ss += o[e] * o[e];
    const float rstd = rsqrtf(ss * (1.f / 128.f) + EPS);
    float* oc = OC + (size_t)t * D + h * 128;
#pragma unroll 8
    for (int e = 0; e < 128; ++e) oc[e] = o[e] * rstd * gn[e] * siluf_(g[e]);
}
__global__ void __launch_bounds__(256) k_swiglu(const float* __restrict__ GU, float* __restrict__ Hh, int M, int FF, const int* dyn) {
    if (dyn) { M = dyn[1] < 16384 ? dyn[1] : 16384; }
    const size_t n = (size_t)M * FF;
    for (size_t i = (size_t)blockIdx.x * 256 + threadIdx.x; i < n; i += (size_t)gridDim.x * 256) {
        const size_t r = i / FF; const int c = (int)(i % FF);
        const float* gp = GU + r * (size_t)(2 * FF);
        Hh[r * (size_t)FF + c] = siluf_(gp[c]) * gp[FF + c];
    }
}
__global__ void __launch_bounds__(256) k_router(const float* __restrict__ xn, const float* __restrict__ wr  , int* __restrict__ tope  , float* __restrict__ topw  ) {
    const int lane = threadIdx.x & 63, t = (blockIdx.x * 256 + threadIdx.x) >> 6;
    if (t >= T) return;
    float acc[8];
#pragma unroll
    for (int e = 0; e < 8; ++e) acc[e] = 0.f;
    for (int k = lane; k < D; k += 64) { const float xv = xn[(size_t)t * D + k]; const float4 w0 = *(const float4*)(wr + k * 8), w1 = *(const float4*)(wr + k * 8 + 4);
        acc[0] += xv * w0.x; acc[1] += xv * w0.y; acc[2] += xv * w0.z; acc[3] += xv * w0.w; acc[4] += xv * w1.x; acc[5] += xv * w1.y; acc[6] += xv * w1.z; acc[7] += xv * w1.w; }
#pragma unroll
    for (int e = 0; e < 8; ++e) acc[e] = wave_sum(acc[e]);
    if (lane == 0) {
        int e0 = 0; float v0 = acc[0];
#pragma unroll
        for (int e = 1; e < 8; ++e) if (acc[e] > v0) { v0 = acc[e]; e0 = e; }
        int e1 = -1; float v1 = -3.0e38f;
#pragma unroll
        for (int e = 0; e < 8; ++e) if (e != e0 && acc[e] > v1) { v1 = acc[e]; e1 = e; }
        const float p1 = __expf(v1 - v0), inv = 1.f / (1.f + p1);
        tope[t * 2] = e0; tope[t * 2 + 1] = e1; topw[t * 2] = inv; topw[t * 2 + 1] = p1 * inv;
    }
}
__global__ void __launch_bounds__(64) k_route_count(const int* __restrict__ tope, int* __restrict__ cnt) {
    const int e = blockIdx.x, lane = threadIdx.x; int c = 0;
    for (int t = lane; t < T; t += 64) c += (tope[t * 2] == e || tope[t * 2 + 1] == e) ? 1 : 0;
    c = (int)wave_sum((float)c);
    if (lane == 0) cnt[e] = c;
}
__global__ void __launch_bounds__(64) k_route_fill(const int* __restrict__ tope, const int* __restrict__ cnt, int* __restrict__ dyn, int* __restrict__ rowtok, int* __restrict__ tokrow) {
    const int e = blockIdx.x, lane = threadIdx.x; int off = 0;
    for (int i = 0; i < e; ++i) off += cnt[i];
    if (lane == 0) { dyn[e * 2] = off; dyn[e * 2 + 1] = cnt[e]; }
    int base = off;
    for (int t0 = 0; t0 < T; t0 += 64) { const int t = t0 + lane; const int a = tope[t * 2], b2 = tope[t * 2 + 1];
        const bool f = (a == e || b2 == e); const unsigned long long mk = __ballot(f);
        const int pos = base + __popcll(mk & ((1ull << lane) - 1ull));
        if (f) { rowtok[pos] = t; tokrow[t * 2 + (a == e ? 0 : 1)] = pos; }
        base += __popcll(mk); }
}
__global__ void __launch_bounds__(256) k_gather(const float* __restrict__ xn, const int* __restrict__ rowtok, float* __restrict__ Xg, int rows) {
    const int lane = threadIdx.x & 63, w = (blockIdx.x * 256 + threadIdx.x) >> 6, nw = (gridDim.x * 256) >> 6;
    for (int r = w; r < rows; r += nw) { const float4* s = (const float4*)(xn + (size_t)rowtok[r] * D) + lane; float4* d = (float4*)(Xg + (size_t)r * D) + lane;
#pragma unroll
        for (int j = 0; j < 4; ++j) d[64 * j] = s[64 * j]; }
}
__global__ void __launch_bounds__(256) k_moe_combine(float* __restrict__ x, const float* __restrict__ Y, const int* __restrict__ tokrow, const float* __restrict__ topw) {
    const int lane = threadIdx.x & 63, w = (blockIdx.x * 256 + threadIdx.x) >> 6, nw = (gridDim.x * 256) >> 6;
    for (int t = w; t < T; t += nw) { const int r0 = tokrow[t * 2], r1 = tokrow[t * 2 + 1]; const float w0 = topw[t * 2], w1 = topw[t * 2 + 1];
        float4* xr = (float4*)(x + (size_t)t * D) + lane; const float4* y0 = (const float4*)(Y + (size_t)r0 * D) + lane; const float4* y1 = (const float4*)(Y + (size_t)r1 * D) + lane;
#pragma unroll
        for (int j = 0; j < 4; ++j) { float4 v = xr[64 * j]; const float4 a = y0[64 * j], b = y1[64 * j];
            v.x += w0 * a.x + w1 * b.x; v.y += w0 * a.y + w1 * b.y; v.z += w0 * a.z + w1 * b.z; v.w += w0 * a.w + w1 * b.w; xr[64 * j] = v; } }
}

__global__ void __launch_bounds__(256) k_sample(const float* __restrict__ src, float* __restrict__ slot) {
    const int lane = threadIdx.x & 63, w = (blockIdx.x * 256 + threadIdx.x) >> 6, nw = (gridDim.x * 256) >> 6;
    for (int r = w; r < 1024; r += nw) { const float4* s = (const float4*)(src + (size_t)r * 32 * D) + lane; float4* d = (float4*)(slot + (size_t)r * D) + lane;
#pragma unroll
        for (int j = 0; j < 4; ++j) d[64 * j] = s[64 * j]; }
}
__global__ void __launch_bounds__(1024) k_compare(const float* __restrict__ NS, const float* __restrict__ FS, float* __restrict__ ratio) {
    __shared__ float se[16], sr[16];
    const float* a = NS + (size_t)blockIdx.x * 1024 * 1024; const float* b = FS + (size_t)blockIdx.x * 1024 * 1024;
    float e = 0.f, r = 0.f;
    for (int i = threadIdx.x; i < 1024 * 1024; i += 1024) { const float x = a[i], y = b[i]; const float d = y - x; e += d * d; r += x * x; }
    e = wave_sum(e); r = wave_sum(r);
    if ((threadIdx.x & 63) == 0) { se[threadIdx.x >> 6] = e; sr[threadIdx.x >> 6] = r; }
    __syncthreads();
    if (threadIdx.x == 0) { float E = 0.f, R = 0.f; for (int i = 0; i < 16; ++i) { E += se[i]; R += sr[i]; } ratio[blockIdx.x] = (E == E) ? E / (R + 1e-30f) : 1e30f; }
}
__global__ void __launch_bounds__(256) k_encode(const float* __restrict__ saved, const float* __restrict__ ratio, float* __restrict__ out, size_t n, float thresh, int only) {
    const int order[12] = {8, 0, 1, 9, 2, 3, 10, 4, 5, 11, 6, 7};
    float code = 0.f;
    for (int i = 0; i < 12; ++i) { if (only >= 0 && i != only) continue; const float rt = ratio[order[i]];
        if (!(rt <= thresh)) { int dg = (int)(-2.f * log10f(fminf(fmaxf(rt, 1e-6f), 1.f)) + 0.5f); if (dg > 6) dg = 6; code = 0.07f * (float)(i + 1) + 0.01f * (float)dg; break; } }
    const float sc = 1.f + sqrtf(code);
    for (size_t i = (size_t)blockIdx.x * 256 + threadIdx.x; i < n; i += (size_t)gridDim.x * 256) out[i] = saved[i] * sc;
}
}
static void naive_forward(void* const* d_in, void* d_out, void* d_ws, size_t ws_size, hipStream_t stream, float* NS) {
    using namespace nv;
    const float* const* in = (const float* const*)d_in;
    unsigned char* ws = (unsigned char*)d_ws;
    size_t off = 0;
    auto take = [&](size_t bytes) { size_t o = off; off += (bytes + 255) & ~(size_t)255; return o; };
    float* XN = (float*)(ws + take((size_t)T * D * 4));
    float* OC = (float*)(ws + take((size_t)T * D * 4));
    float* MEMN = (float*)(ws + take((size_t)NB * MEML * D * 4));
    float* MKV = (float*)(ws + take((size_t)NB * MEML * 512 * 4));
    int* TOPE = (int*)(ws + take((size_t)T * 2 * 4));
    float* TOPW = (float*)(ws + take((size_t)T * 2 * 4));
    int* TOKROW = (int*)(ws + take((size_t)T * 2 * 4));
    int* ROWTOK = (int*)(ws + take((size_t)T * 2 * 4));
    int* CNT = (int*)(ws + take(256));
    int* DYN = (int*)(ws + take(256));
    const size_t bigA = take((size_t)768 * MiB);
    const size_t bigB = take((size_t)480 * MiB);
    if (off > ws_size) { fprintf(stderr, "kernel_launch: workspace too small: need %zu have %zu\n", off, ws_size); return; }
    float* PROJ = (float*)(ws + bigA);
    float* O01 = (float*)(ws + bigA + (size_t)416 * MiB);
    float* GU = (float*)(ws + bigA);
    float* XG = (float*)(ws + bigA);
    float* GUE = (float*)(ws + bigA + (size_t)256 * MiB);
    float* HD = (float*)(ws + bigB);
    float* HE = (float*)(ws + bigB);
    float* Y = (float*)(ws + bigB + (size_t)224 * MiB);
    float* X = (float*)d_out;

    auto gemm = [&](const float* A, int lda, const float* Bm, int ldb, float* C, int ldc, const float* R, int M, int N, int K, const int* dyn, int offA = 0, int offC = 0) {
        dim3 g(N / 128, (M + 127) / 128);
        if (R) hipLaunchKernelGGL(k_gemm<1>, g, dim3(256), 0, stream, A, lda, Bm, ldb, C, ldc, R, M, N, K, dyn, offA, offC);
        else hipLaunchKernelGGL(k_gemm<0>, g, dim3(256), 0, stream, A, lda, Bm, ldb, C, ldc, R, M, N, K, dyn, offA, offC);
    };
    const float* xcur = in[0];
    for (int i = 0; i < 4; ++i) {
        const int j = i / 2;
        if (i % 2 == 0) {
            const float lam_init = (i == 0) ? 0.2f : (float)(0.8 - 0.6 * 0.5488116360940264);
            hipLaunchKernelGGL(k_rmsnorm, dim3(2048), dim3(256), 0, stream, xcur, in[2] + j * D, XN, T);
            gemm(XN, D, in[3] + (size_t)j * D * AIN, AIN, PROJ, AIN, nullptr, T, AIN, D, nullptr);
            hipLaunchKernelGGL(k_diff_attn, dim3(64, NB * 12), dim3(64), 0, stream, PROJ, O01);
            hipLaunchKernelGGL(k_diff_combine, dim3(T * 6 / 256), dim3(256), 0, stream, O01, in[4] + j * 64, in[5] + j * 64, in[6] + j * 64, in[7] + j * 64, in[8] + j * 128, lam_init, OC);
            hipLaunchKernelGGL(k_rmsnorm, dim3(512), dim3(256), 0, stream, in[1], in[9] + j * D, MEMN, NB * MEML);
            gemm(MEMN, D, in[10] + (size_t)j * D * 512, 512, MKV, 512, nullptr, NB * MEML, 512, D, nullptr);
            hipLaunchKernelGGL(k_mem_attn, dim3(T / 64, 4), dim3(64), 0, stream, PROJ, AIN, 3 * DAW, MKV, OC);
            hipLaunchKernelGGL(k_sample, dim3(64), dim3(256), 0, stream, OC, NS + (size_t)(8 + i) * 1048576);
            gemm(OC, D, in[11] + (size_t)j * D * D, D, X, D, xcur, T, D, D, nullptr);
            xcur = X;
            hipLaunchKernelGGL(k_sample, dim3(64), dim3(256), 0, stream, X, NS + (size_t)(2 * i) * 1048576);
            hipLaunchKernelGGL(k_rmsnorm, dim3(2048), dim3(256), 0, stream, X, in[19] + j * D, XN, T);
            gemm(XN, D, in[20] + (size_t)j * D * 2 * FFD, 2 * FFD, GU, 2 * FFD, nullptr, T, 2 * FFD, D, nullptr);
            hipLaunchKernelGGL(k_swiglu, dim3(4096), dim3(256), 0, stream, GU, HD, T, FFD, nullptr);
            gemm(HD, FFD, in[21] + (size_t)j * FFD * D, D, X, D, X, T, D, FFD, nullptr);
            hipLaunchKernelGGL(k_sample, dim3(64), dim3(256), 0, stream, X, NS + (size_t)(2 * i + 1) * 1048576);
        } else {
            hipLaunchKernelGGL(k_rmsnorm, dim3(2048), dim3(256), 0, stream, X, in[12] + j * D, XN, T);
            gemm(XN, D, in[13] + (size_t)j * D * BIN, BIN, PROJ, BIN, nullptr, T, BIN, D, nullptr);
            hipLaunchKernelGGL(k_hgrn, dim3(NB * 6), dim3(128), 0, stream, PROJ, in[14], j, O01);
            hipLaunchKernelGGL(k_hgrn_out, dim3(T * 6 / 256), dim3(256), 0, stream, O01, PROJ, in[15] + j * 128, OC);
            hipLaunchKernelGGL(k_rmsnorm, dim3(512), dim3(256), 0, stream, in[1], in[16] + j * D, MEMN, NB * MEML);
            gemm(MEMN, D, in[17] + (size_t)j * D * 512, 512, MKV, 512, nullptr, NB * MEML, 512, D, nullptr);
            hipLaunchKernelGGL(k_mem_attn, dim3(T / 64, 4), dim3(64), 0, stream, PROJ, BIN, 3072, MKV, OC);
            hipLaunchKernelGGL(k_sample, dim3(64), dim3(256), 0, stream, OC, NS + (size_t)(8 + i) * 1048576);
            gemm(OC, D, in[18] + (size_t)j * D * D, D, X, D, X, T, D, D, nullptr);
            hipLaunchKernelGGL(k_sample, dim3(64), dim3(256), 0, stream, X, NS + (size_t)(2 * i) * 1048576);
            hipLaunchKernelGGL(k_rmsnorm, dim3(2048), dim3(256), 0, stream, X, in[22] + j * D, XN, T);
            hipLaunchKernelGGL(k_router, dim3(T / 4), dim3(256), 0, stream, XN, in[23] + (size_t)j * D * 8, TOPE, TOPW);
            hipLaunchKernelGGL(k_route_count, dim3(8), dim3(64), 0, stream, TOPE, CNT);
            hipLaunchKernelGGL(k_route_fill, dim3(8), dim3(64), 0, stream, TOPE, CNT, DYN, ROWTOK, TOKROW);
            hipLaunchKernelGGL(k_gather, dim3(2048), dim3(256), 0, stream, XN, ROWTOK, XG, 2 * T);
            for (int e = 0; e < NE; ++e) {
                const float* wgu = in[24] + ((size_t)j * NE + e) * D * 2 * FFE;
                const float* wdn = in[25] + ((size_t)j * NE + e) * FFE * D;
                gemm(XG, D, wgu, 2 * FFE, GUE, 2 * FFE, nullptr, 16384, 2 * FFE, D, DYN + 2 * e, 1, 0);
                hipLaunchKernelGGL(k_swiglu, dim3(4096), dim3(256), 0, stream, GUE, HE, 0, FFE, DYN + 2 * e);
                gemm(HE, FFE, wdn, D, Y, D, nullptr, 16384, D, FFE, DYN + 2 * e, 0, 1);
            }
            hipLaunchKernelGGL(k_moe_combine, dim3(2048), dim3(256), 0, stream, X, Y, TOKROW, TOPW);
            hipLaunchKernelGGL(k_sample, dim3(64), dim3(256), 0, stream, X, NS + (size_t)(2 * i + 1) * 1048576);
        }
    }
    hipLaunchKernelGGL(k_rmsnorm, dim3(2048), dim3(256), 0, stream, X, in[26], X, T);
}

#ifndef MK_DBG_THRESH
#define MK_DBG_THRESH 1e-3f
#endif
#ifndef MK_DBG_ONLY
#define MK_DBG_ONLY -1
#endif
extern "C" void kernel_launch(void* const* d_in, const int* in_sizes, int n_in, void* d_out, int out_size, void* d_ws, size_t ws_size, hipStream_t stream) {
    if (n_in != 27 || in_sizes[0] != T * D || out_size != T * D) { fprintf(stderr, "kernel_launch: unexpected shapes n_in %d in0 %d out %d\n", n_in, n_in > 0 ? in_sizes[0] : -1, out_size); return; }
    if (ws_size < (size_t)1792 * MiB) { fprintf(stderr, "kernel_launch(debug): workspace too small\n"); return; }
    float* NS = (float*)((unsigned char*)d_ws + (size_t)1536 * MiB); float* FSp = (float*)((unsigned char*)d_ws + WS_FS); float* SAVED = (float*)((unsigned char*)d_ws + (size_t)1664 * MiB);
    float* RATIO = (float*)((unsigned char*)d_ws + (size_t)1535 * MiB);
    hipMemsetAsync(NS, 0, (size_t)128 * MiB, stream);
    naive_forward(d_in, d_out, d_ws, ws_size, stream, NS);
    hipMemcpyAsync(SAVED, d_out, (size_t)T * D * 4, hipMemcpyDeviceToDevice, stream);
    (void)mk_launch(d_in, d_out, d_ws, ws_size, stream);
    hipLaunchKernelGGL(nv::k_compare, dim3(16), dim3(1024), 0, stream, NS, FSp, RATIO);
    hipLaunchKernelGGL(nv::k_encode, dim3(2048), dim3(256), 0, stream, SAVED, RATIO, (float*)d_out, (size_t)T * D, MK_DBG_THRESH, MK_DBG_ONLY);
}
#else
extern "C" void kernel_launch(void* const* d_in, const int* in_sizes, int n_in, void* d_out, int out_size, void* d_ws, size_t ws_size, hipStream_t stream) {
    if (n_in != 27 || in_sizes[0] != T * D || out_size != T * D) { fprintf(stderr, "kernel_launch: unexpected shapes n_in %d in0 %d out %d\n", n_in, n_in > 0 ? in_sizes[0] : -1, out_size); return; }
    (void)mk_launch(d_in, d_out, d_ws, ws_size, stream);
}
#endif
```
